# Optimizing an MI355X kernel written in HIP

```python
import math
import jax, jax.numpy as jnp
from jax import lax
import numpy as np

D_MODEL = 1024
BATCH = 16
SEQ = 2048
DEPTH = 4
DEC_BATCH = 32
DEC_SEQ = 32
PAST_LEN = 4096

CHUNK = 64
Q_BLOCK = 128
GMLP_CHUNK = 128
D_A = D_MODEL // 4
N_A_HEADS = 4
A_HEAD = D_A // N_A_HEADS
D_B = D_MODEL // 2
N_B_HEADS = 8
V_DIM = D_B // N_B_HEADS
NOPE_DIM = 64
ROPE_DIM = 32
Q_LORA = 384
KV_LORA = 256
ROPE_THETA = 10000.0
ATTN_SCALE = (NOPE_DIM + ROPE_DIM) ** -0.5
D_C = D_MODEL // 4
N_C_BLOCKS = 4
C_HEAD = D_C // N_C_BLOCKS
LRU_CONV = 4
LRU_C = 8.0
D_MIX = D_A + D_B + D_C
IN_SPLITS = (D_A, D_A, Q_LORA, KV_LORA, ROPE_DIM, D_C, D_C)
D_IN = sum(IN_SPLITS)
D_FF = 2816
FFN_CONV = 3
ALPHA = (2.0 * DEPTH) ** 0.25
BETA = (8.0 * DEPTH) ** -0.25
LN_EPS = 1e-5
RMS_EPS = 1e-6

kernel_name = "hymba_style_gmlp_mla_rglru_streaming_step"


def _split_points(sizes):
    pts, acc = [], 0
    for s in sizes[:-1]:
        acc += s
        pts.append(acc)
    return pts


def layer_norm(x, g, b):
    xf = x.astype(jnp.float32)
    mu = jnp.mean(xf, axis=-1, keepdims=True)
    var = jnp.mean(jnp.square(xf - mu), axis=-1, keepdims=True)
    return ((xf - mu) * lax.rsqrt(var + LN_EPS) * g + b).astype(x.dtype)


def rms_norm(x, g):
    xf = x.astype(jnp.float32)
    ms = jnp.mean(jnp.square(xf), axis=-1, keepdims=True)
    return (xf * lax.rsqrt(ms + RMS_EPS) * g).astype(x.dtype)


def apply_rope(x, pos):
    r = x.shape[-1]
    inv = 1.0 / (ROPE_THETA ** (jnp.arange(0, r, 2, dtype=jnp.float32) / r))
    ang = pos.astype(jnp.float32)[:, None] * inv[None, :]
    cos = jnp.cos(ang)[None, :, None, :]
    sin = jnp.sin(ang)[None, :, None, :]
    xf = x.astype(jnp.float32)
    x1, x2 = xf[..., : r // 2], xf[..., r // 2:]
    return jnp.concatenate([x1 * cos - x2 * sin, x1 * sin + x2 * cos], axis=-1).astype(x.dtype)


def causal_dwconv(x, prev, w, b):
    k = w.shape[0]
    t = x.shape[1]
    xp = jnp.concatenate([prev.astype(x.dtype), x], axis=1)
    y = b + xp[:, 0:t] * w[0]
    for j in range(1, k):
        y = y + xp[:, j:j + t] * w[j]
    return y, xp[:, t:]


def gmlp_spatial_gate(u, v, w_s, b_s):
    bsz, t, _ = v.shape
    ln = min(t, GMLP_CHUNK)
    n = t // ln
    w = jnp.tril(w_s[:, :ln, :ln])
    vb = v.reshape(bsz, n, ln, N_A_HEADS, A_HEAD)
    s = jnp.einsum('hij,bnjhd->bnihd', w, vb) + b_s[:, :ln].T[None, None, :, :, None]
    return u * s.reshape(bsz, t, D_A)


def mla_prompt_attention(q_nope, q_rope, k_nope, k_rope, v):
    bsz, t, h, _ = q_nope.shape
    nb = t // Q_BLOCK
    kchunk = jnp.arange(t) // CHUNK
    neg = jnp.finfo(jnp.float32).min

    def block(args):
        qn, qr, qc = args
        s = (jnp.einsum('bqhd,bkhd->bhqk', qn, k_nope)
             + jnp.einsum('bqhr,bkr->bhqk', qr, k_rope)).astype(jnp.float32) * ATTN_SCALE
        s = jnp.where(kchunk[None, :] <= qc[:, None], s, neg)
        p = jax.nn.softmax(s, axis=-1).astype(v.dtype)
        return jnp.einsum('bhqk,bkhd->bqhd', p, v)

    qn_b = q_nope.reshape(bsz, nb, Q_BLOCK, h, NOPE_DIM).swapaxes(0, 1)
    qr_b = q_rope.reshape(bsz, nb, Q_BLOCK, h, ROPE_DIM).swapaxes(0, 1)
    qc_b = (jnp.arange(t) // CHUNK).reshape(nb, Q_BLOCK)
    out = lax.map(block, (qn_b, qr_b, qc_b))
    return out.swapaxes(0, 1).reshape(bsz, t, h, V_DIM)


def mla_sample_attention(q_nope, q_rope, c_all, kr_all, w_uk, w_uv):
    q_lat = jnp.einsum('bqhd,chd->bqhc', q_nope, w_uk)
    s = (jnp.einsum('bqhc,bkc->bhqk', q_lat, c_all)
         + jnp.einsum('bqhr,bkr->bhqk', q_rope, kr_all)).astype(jnp.float32) * ATTN_SCALE
    p = jax.nn.softmax(s, axis=-1).astype(c_all.dtype)
    o_lat = jnp.einsum('bhqk,bkc->bqhc', p, c_all)
    return jnp.einsum('bqhc,chd->bqhd', o_lat, w_uv)


def linear_recurrence(a, b, h0):
    def combine(left, right):
        a1, b1 = left
        a2, b2 = right
        return a1 * a2, a2 * b1 + b2
    a_cum, b_cum = lax.associative_scan(combine, (a, b), axis=1)
    h = a_cum * h0[:, None, :] + b_cum
    return h, h[:, -1]


def trunk_layer(x, pos, lp, lat_cache, kr_cache, lru_conv_prev, lru_h0, ffn_conv_prev):
    bsz, t, _ = x.shape
    z = x @ lp['w_in']
    u, v, cq, ckv, kr, xc_in, gate_c = jnp.split(z, _split_points(IN_SPLITS), axis=-1)

    u = jax.nn.gelu(u)
    v = jax.nn.gelu(v)
    a_out = gmlp_spatial_gate(u, v, lp['gmlp_w_s'], lp['gmlp_b_s'])

    cq_n = rms_norm(cq, lp['mla_q_norm_g'])
    q = (cq_n @ lp['mla_w_uq']).reshape(bsz, t, N_B_HEADS, NOPE_DIM + ROPE_DIM)
    q_nope = q[..., :NOPE_DIM]
    q_rope = apply_rope(q[..., NOPE_DIM:], pos)
    ckv_n = rms_norm(ckv, lp['mla_kv_norm_g'])
    kr_rot = apply_rope(kr[:, :, None, :], pos)[:, :, 0, :]
    if lat_cache is None:
        k_nope = jnp.einsum('btc,chd->bthd', ckv_n, lp['mla_w_uk'])
        v_b = jnp.einsum('btc,chd->bthd', ckv_n, lp['mla_w_uv'])
        b_out = mla_prompt_attention(q_nope, q_rope, k_nope, kr_rot, v_b)
    else:
        c_all = jnp.concatenate([lat_cache.astype(ckv_n.dtype), ckv_n], axis=1)
        kr_all = jnp.concatenate([kr_cache.astype(kr_rot.dtype), kr_rot], axis=1)
        b_out = mla_sample_attention(q_nope, q_rope, c_all, kr_all, lp['mla_w_uk'], lp['mla_w_uv'])

    xc, lru_conv_new = causal_dwconv(xc_in, lru_conv_prev, lp['lru_conv_w'], lp['lru_conv_b'])
    xb = xc.reshape(bsz, t, N_C_BLOCKS, C_HEAD)
    r = jax.nn.sigmoid(jnp.einsum('btnd,nde->btne', xb, lp['lru_w_r']).reshape(bsz, t, D_C) + lp['lru_b_r'])
    ig = jax.nn.sigmoid(jnp.einsum('btnd,nde->btne', xb, lp['lru_w_i']).reshape(bsz, t, D_C) + lp['lru_b_i'])
    log_a = -LRU_C * r.astype(jnp.float32) * jax.nn.softplus(-lp['lru_lam'].astype(jnp.float32))
    a = jnp.exp(log_a)
    b_in = jnp.sqrt(-jnp.expm1(2.0 * log_a)) * (ig * xc).astype(jnp.float32)
    h, h_last = linear_recurrence(a, b_in, lru_h0.astype(jnp.float32))
    c_out = h.astype(x.dtype) * jax.nn.gelu(gate_c)

    mix = jnp.concatenate([a_out, b_out.reshape(bsz, t, D_B), c_out], axis=-1) @ lp['w_o']
    x = layer_norm(ALPHA * x + mix, lp['ln1_g'], lp['ln1_b'])

    up = x @ lp['ffn_w_up']
    upc, ffn_conv_new = causal_dwconv(up, ffn_conv_prev, lp['ffn_conv_w'], lp['ffn_conv_b'])
    g_ff, val = upc[..., :D_FF], upc[..., D_FF:]
    f = (jax.nn.gelu(g_ff) * val) @ lp['ffn_w_down']
    x = layer_norm(ALPHA * x + f, lp['ln2_g'], lp['ln2_b'])
    return x, v, ckv_n, kr_rot, lru_conv_new, h_last.astype(x.dtype), ffn_conv_new


def setup_inputs(seed: int = 0) -> dict:
    key = jax.random.key(seed)
    ks = iter(jax.random.split(key, 40))
    f32 = jnp.float32

    def nrm(shape, scale):
        return jax.random.normal(next(ks), shape, f32) * scale

    u = jax.random.uniform(next(ks), (DEPTH, D_C), f32, minval=0.9, maxval=0.999)
    a_base = u ** (1.0 / LRU_C)
    lam = jnp.log(a_base) - jnp.log1p(-a_base)
    return {
        'x_prompt': nrm((BATCH, SEQ, D_MODEL), 1.0),
        'x_sample': nrm((DEC_BATCH, DEC_SEQ, D_MODEL), 1.0),
        'cache_kv_latent': nrm((DEPTH, DEC_BATCH, PAST_LEN, KV_LORA), 1.0),
        'cache_k_rope': nrm((DEPTH, DEC_BATCH, PAST_LEN, ROPE_DIM), 1.0),
        'state_lru_h': nrm((DEPTH, DEC_BATCH, D_C), 0.5),
        'state_lru_conv': nrm((DEPTH, DEC_BATCH, LRU_CONV - 1, D_C), 1.0),
        'state_ffn_conv': nrm((DEPTH, DEC_BATCH, FFN_CONV - 1, 2 * D_FF), 1.0),
        'ln1_g': 1.0 + nrm((DEPTH, D_MODEL), 0.02),
        'ln1_b': nrm((DEPTH, D_MODEL), 0.02),
        'ln2_g': 1.0 + nrm((DEPTH, D_MODEL), 0.02),
        'ln2_b': nrm((DEPTH, D_MODEL), 0.02),
        'w_in': nrm((DEPTH, D_MODEL, D_IN), D_MODEL ** -0.5),
        'w_o': nrm((DEPTH, D_MIX, D_MODEL), BETA * D_MIX ** -0.5),
        'gmlp_w_s': nrm((DEPTH, N_A_HEADS, GMLP_CHUNK, GMLP_CHUNK), GMLP_CHUNK ** -0.5),
        'gmlp_b_s': 1.0 + nrm((DEPTH, N_A_HEADS, GMLP_CHUNK), 0.02),
        'mla_q_norm_g': 1.0 + nrm((DEPTH, Q_LORA), 0.02),
        'mla_w_uq': nrm((DEPTH, Q_LORA, N_B_HEADS * (NOPE_DIM + ROPE_DIM)), Q_LORA ** -0.5),
        'mla_kv_norm_g': 1.0 + nrm((DEPTH, KV_LORA), 0.02),
        'mla_w_uk': nrm((DEPTH, KV_LORA, N_B_HEADS, NOPE_DIM), KV_LORA ** -0.5),
        'mla_w_uv': nrm((DEPTH, KV_LORA, N_B_HEADS, V_DIM), KV_LORA ** -0.5),
        'lru_conv_w': nrm((DEPTH, LRU_CONV, D_C), LRU_CONV ** -0.5),
        'lru_conv_b': nrm((DEPTH, D_C), 0.01),
        'lru_w_r': nrm((DEPTH, N_C_BLOCKS, C_HEAD, C_HEAD), C_HEAD ** -0.5),
        'lru_b_r': nrm((DEPTH, D_C), 0.01),
        'lru_w_i': nrm((DEPTH, N_C_BLOCKS, C_HEAD, C_HEAD), C_HEAD ** -0.5),
        'lru_b_i': nrm((DEPTH, D_C), 0.01),
        'lru_lam': lam,
        'ffn_w_up': nrm((DEPTH, D_MODEL, 2 * D_FF), D_MODEL ** -0.5),
        'ffn_conv_w': nrm((DEPTH, FFN_CONV, 2 * D_FF), FFN_CONV ** -0.5),
        'ffn_conv_b': nrm((DEPTH, 2 * D_FF), 0.01),
        'ffn_w_down': nrm((DEPTH, D_FF, D_MODEL), BETA * D_FF ** -0.5),
    }


def reference(x_prompt, x_sample, cache_kv_latent, cache_k_rope, state_lru_h, state_lru_conv,
              state_ffn_conv, ln1_g, ln1_b, ln2_g, ln2_b, w_in, w_o, gmlp_w_s, gmlp_b_s,
              mla_q_norm_g, mla_w_uq, mla_kv_norm_g, mla_w_uk, mla_w_uv, lru_conv_w, lru_conv_b,
              lru_w_r, lru_b_r, lru_w_i, lru_b_i, lru_lam, ffn_w_up, ffn_conv_w, ffn_conv_b,
              ffn_w_down):
    bp, s_len, _ = x_prompt.shape
    t_len = x_sample.shape[1]
    past = cache_kv_latent.shape[2]
    pos_p = jnp.arange(s_len)
    pos_d = past + jnp.arange(t_len)
    zeros_lru_conv = jnp.zeros((bp, LRU_CONV - 1, D_C), x_prompt.dtype)
    zeros_lru_h = jnp.zeros((bp, D_C), x_prompt.dtype)
    zeros_ffn_conv = jnp.zeros((bp, FFN_CONV - 1, 2 * D_FF), x_prompt.dtype)

    xp, xd = x_prompt, x_sample
    p_lat, p_kr, p_h, p_lconv, p_fconv = [], [], [], [], []
    s_lat, s_kr, s_v, s_h, s_lconv, s_fconv = [], [], [], [], [], []
    for l in range(DEPTH):
        lp = {
            'w_in': w_in[l], 'w_o': w_o[l], 'ln1_g': ln1_g[l], 'ln1_b': ln1_b[l],
            'ln2_g': ln2_g[l], 'ln2_b': ln2_b[l], 'gmlp_w_s': gmlp_w_s[l], 'gmlp_b_s': gmlp_b_s[l],
            'mla_q_norm_g': mla_q_norm_g[l], 'mla_w_uq': mla_w_uq[l],
            'mla_kv_norm_g': mla_kv_norm_g[l], 'mla_w_uk': mla_w_uk[l], 'mla_w_uv': mla_w_uv[l],
            'lru_conv_w': lru_conv_w[l], 'lru_conv_b': lru_conv_b[l], 'lru_w_r': lru_w_r[l],
            'lru_b_r': lru_b_r[l], 'lru_w_i': lru_w_i[l], 'lru_b_i': lru_b_i[l], 'lru_lam': lru_lam[l],
            'ffn_w_up': ffn_w_up[l], 'ffn_conv_w': ffn_conv_w[l], 'ffn_conv_b': ffn_conv_b[l],
            'ffn_w_down': ffn_w_down[l],
        }
        xp, _, lat_p, kr_p, lconv_p, h_p, fconv_p = trunk_layer(
            xp, pos_p, lp, None, None, zeros_lru_conv, zeros_lru_h, zeros_ffn_conv)
        xd, v_d, lat_d, kr_d, lconv_d, h_d, fconv_d = trunk_layer(
            xd, pos_d, lp, cache_kv_latent[l], cache_k_rope[l], state_lru_conv[l],
            state_lru_h[l], state_ffn_conv[l])
        p_lat.append(lat_p); p_kr.append(kr_p); p_h.append(h_p)
        p_lconv.append(lconv_p); p_fconv.append(fconv_p)
        s_lat.append(lat_d); s_kr.append(kr_d); s_v.append(v_d); s_h.append(h_d)
        s_lconv.append(lconv_d); s_fconv.append(fconv_d)

    return (xp, xd,
            jnp.stack(p_lat), jnp.stack(p_kr), jnp.stack(p_h), jnp.stack(p_lconv), jnp.stack(p_fconv),
            jnp.stack(s_lat), jnp.stack(s_kr), jnp.stack(s_v), jnp.stack(s_h), jnp.stack(s_lconv),
            jnp.stack(s_fconv))
```

```cpp
#include <hip/hip_runtime.h>
#include <hip/hip_cooperative_groups.h>
#include <cstdio>
#include <cstdint>
namespace cg = cooperative_groups;

typedef _Float16 h16;
typedef _Float16 h8 __attribute__((ext_vector_type(8)));
typedef _Float16 h4 __attribute__((ext_vector_type(4)));
typedef _Float16 h2 __attribute__((ext_vector_type(2)));
typedef float f4 __attribute__((ext_vector_type(4)));
typedef short s4v __attribute__((__vector_size__(8)));
#define LAS __attribute__((address_space(3)))
#define DEVI __device__ __forceinline__

constexpr int DM = 1024, NB = 16, SEQ = 2048, DEPTH = 4, DBATCH = 32, DSEQ = 32, PAST = 4096;
constexpr int MP = NB * SEQ, MS = DBATCH * DSEQ, MT = MP + MS;
constexpr int DIN = 1696, ZW = 1792, DFF = 2816, DFF2 = 5632;
constexpr int QW = 768, KW = 768, VW = 512, QLW = 2304, CSW = 2560, KNW = 288;
constexpr float ALPHA = 1.681792830507429f;
constexpr float QSCALE = 0.14724444f;
constexpr int NPOS = SEQ + DSEQ;

constexpr size_t O_Y = 0;
constexpr size_t O_PLAT = (size_t)MT * DM;
constexpr size_t O_PKR = O_PLAT + (size_t)DEPTH * MP * 256;
constexpr size_t O_PH = O_PKR + (size_t)DEPTH * MP * 32;
constexpr size_t O_PLC = O_PH + (size_t)DEPTH * NB * 256;
constexpr size_t O_PFC = O_PLC + (size_t)DEPTH * NB * 3 * 256;
constexpr size_t O_SLAT = O_PFC + (size_t)DEPTH * NB * 2 * DFF2;
constexpr size_t O_SKR = O_SLAT + (size_t)DEPTH * MS * 256;
constexpr size_t O_SV = O_SKR + (size_t)DEPTH * MS * 32;
constexpr size_t O_SH = O_SV + (size_t)DEPTH * MS * 256;
constexpr size_t O_SLC = O_SH + (size_t)DEPTH * DBATCH * 256;
constexpr size_t O_SFC = O_SLC + (size_t)DEPTH * DBATCH * 3 * 256;
constexpr size_t O_END = O_SFC + (size_t)DEPTH * DBATCH * 2 * DFF2;

constexpr size_t al(size_t x) { return (x + 255) & ~(size_t)255; }
constexpr size_t W_CTR = 0;
constexpr size_t W_PARAMS = 2048;
constexpr size_t W_ROPE = 4096;
constexpr size_t W_SP = al(W_ROPE + (size_t)NPOS * 16 * 2 * 4);
constexpr size_t W_WIN = al(W_SP + (size_t)DEPTH * 256 * 4);
constexpr size_t SZ_WIN = (size_t)ZW * 1024 * 2;
constexpr size_t W_WUQ = W_WIN + DEPTH * SZ_WIN;   constexpr size_t SZ_WUQ = (size_t)768 * 384 * 2;
constexpr size_t W_WQL = W_WUQ + DEPTH * SZ_WUQ;   constexpr size_t SZ_WQL = (size_t)2048 * 384 * 2;
constexpr size_t W_WKV = W_WQL + DEPTH * SZ_WQL;   constexpr size_t SZ_WKV = (size_t)1024 * 256 * 2;
constexpr size_t W_WG = W_WKV + DEPTH * SZ_WKV;    constexpr size_t SZ_WG = (size_t)512 * 256 * 2;
constexpr size_t W_WO = W_WG + DEPTH * SZ_WG;      constexpr size_t SZ_WO = (size_t)1024 * 1024 * 2;
constexpr size_t W_WOS = W_WO + DEPTH * SZ_WO;     constexpr size_t SZ_WOS = (size_t)1024 * CSW * 2;
constexpr size_t W_WUP = W_WOS + DEPTH * SZ_WOS;   constexpr size_t SZ_WUP = (size_t)DFF2 * 1024 * 2;
constexpr size_t W_WDN = W_WUP + DEPTH * SZ_WUP;   constexpr size_t SZ_WDN = (size_t)1024 * DFF * 2;
constexpr size_t W_XH = W_WDN + DEPTH * SZ_WDN;
constexpr size_t W_Z = W_XH + (size_t)MT * 1024 * 2;
constexpr size_t W_CQN = W_Z + (size_t)MT * ZW * 2;
constexpr size_t W_CKVN = W_CQN + (size_t)MT * 384 * 2;
constexpr size_t W_XC = W_CKVN + (size_t)MP * 256 * 2;
constexpr size_t W_Q = W_XC + (size_t)MT * 256 * 2;
constexpr size_t W_K = W_Q + (size_t)MP * QW * 2;
constexpr size_t W_V = W_K + (size_t)MP * KW * 2;
constexpr size_t W_A = W_V + (size_t)MP * VW * 2;
constexpr size_t W_B = W_A + (size_t)MT * 256 * 4;
constexpr size_t W_CAT = W_B + (size_t)MT * 256 * 4;
constexpr size_t W_CATS = W_CAT + (size_t)MP * 1024 * 2;
constexpr size_t W_QLAT = W_CATS + (size_t)MS * CSW * 2;
constexpr size_t W_KNEW = W_QLAT + (size_t)MS * QLW * 2;
constexpr size_t W_PRE = al(W_KNEW + (size_t)MS * KNW * 2);
constexpr size_t W_X1F = W_PRE + (size_t)MT * 1024 * 4;
constexpr size_t W_UP = W_X1F + (size_t)MT * 1024 * 4;
constexpr size_t W_ACT = W_UP + (size_t)MT * DFF2 * 2;
constexpr size_t W_END = W_ACT + (size_t)MT * DFF * 2;

struct Params { const float* in[31]; float* out; unsigned char* ws; };

DEVI float gelu_f(float x) { const float u = 1.5957691216057308f * (x + 0.044715f * x * x * x); return x / (1.f + __expf(-u)); }
DEVI float sigmoid_f(float x) { return 1.f / (1.f + __expf(-x)); }
DEVI h8 pack8(f4 a, f4 b) { h8 r; r[0] = (h16)a[0]; r[1] = (h16)a[1]; r[2] = (h16)a[2]; r[3] = (h16)a[3]; r[4] = (h16)b[0]; r[5] = (h16)b[1]; r[6] = (h16)b[2]; r[7] = (h16)b[3]; return r; }
DEVI h4 pack4(f4 a) { h4 r; r[0] = (h16)a[0]; r[1] = (h16)a[1]; r[2] = (h16)a[2]; r[3] = (h16)a[3]; return r; }
DEVI float shx(float v, int o, int lane) { return __builtin_bit_cast(float, __builtin_amdgcn_ds_bpermute((lane ^ o) << 2, __builtin_bit_cast(int, v))); }
DEVI float wave_sum(float v, int lane) {
#pragma unroll
    for (int o = 1; o < 64; o <<= 1) v += shx(v, o, lane);
    return v;
}
DEVI int opaque_lane() { unsigned ones = ~0u; asm volatile("" : "+s"(ones)); return (int)__builtin_amdgcn_mbcnt_hi(ones, __builtin_amdgcn_mbcnt_lo(ones, 0u)); }
DEVI h4 trrd(LAS unsigned char* p) { s4v r = __builtin_amdgcn_ds_read_tr16_b64_v4i16((LAS s4v*)p); return __builtin_bit_cast(h4, r); }
DEVI h8 cat44(h4 a, h4 b) { return __builtin_shufflevector(a, b, 0, 1, 2, 3, 4, 5, 6, 7); }

constexpr int BM = 256, BK = 64, HALF = 128, HTB = HALF * BK * 2, STAGE_BYTES = 8 * HTB, NXCD = 8, WGM = 8;
DEVI int lds_byte(int r, int c) { const int st = (r >> 4) * 2 + (c >> 5), rr = r & 15, cc = c & 31, ob = rr * 64 + cc * 2; return st * 1024 + (ob ^ (((ob >> 9) & 1) << 5)); }
DEVI void stage_rc(int b, int& R, int& C) { const int st = b / 1024, sb = b % 1024, swz = sb ^ (((sb >> 9) & 1) << 5); R = (st >> 1) * 16 + swz / 64; C = (st & 1) * 32 + (swz % 64) / 2; }
DEVI int perm32(int rho) { const int n = rho >> 4, i = rho & 15; return 8 * (i >> 2) + 4 * n + (i & 3); }
struct Unit { int pm, pn; };
struct Gemm { const h16* A; const h16* Bt; int M, N, K, lda, ldb; };
struct StaticOrder {
    int nM, nN, nwg, G, c;
    DEVI void init(int M, int N, int G_, int c_) { nM = M / BM; nN = N / BM; nwg = nM * nN; G = G_; c = c_; }
    DEVI bool next(int i, Unit& u) const {
        if (c < 0) return false;
        const long L = (long)i * G + c; if (L >= nwg) return false;
        int wgid = (int)L; { const int q = nwg / NXCD, r = nwg % NXCD, xcd = wgid % NXCD, off = wgid / NXCD; wgid = (xcd < r ? xcd * (q + 1) : r * (q + 1) + (xcd - r) * q) + off; }
        const int nig = WGM * nN, gid = wgid / nig, fm = gid * WGM, gsz = (nM - fm) < WGM ? (nM - fm) : WGM;
        u.pm = fm + ((wgid % nig) % gsz); u.pn = (wgid % nig) / gsz; return true;
    }
};
template <class Epi>
DEVI void gemm_phase(LAS unsigned char* lds, const Gemm g, const StaticOrder& S, const Epi& E, const int tid) {
    const int wid = __builtin_amdgcn_readfirstlane(tid >> 6), lane = tid & 63, wr = wid >> 2, wc = wid & 3, fr = lane & 15, fq = lane >> 4;
    const int K = g.K, nt = K / BK;
    unsigned voffA[2], voffB[2];
#pragma unroll
    for (int i = 0; i < 2; ++i) { int R, C; stage_rc(tid * 16 + i * 8192, R, C); const int Rb = Epi::PERM ? ((R & ~31) + perm32(R & 31)) : R;
        voffA[i] = (unsigned)(R * g.lda + C) * 2u; voffB[i] = (unsigned)(Rb * g.ldb + C) * 2u; }
    const size_t kstep = (size_t)(BK * 2);
    const size_t hstepA = (size_t)HALF * g.lda * 2, hstepB = (size_t)HALF * g.ldb * 2;
    const size_t tstepA = 2 * hstepA, tstepB = 2 * hstepB;
    const unsigned ldsw = (unsigned)wid * 1024u;
    const int aoff = lds_byte(wr * 64 + fr, fq * 8), boff = lds_byte(wc * 32 + fr, fq * 8);
#define PG8_SA(b, h) (((b) * 2 + (h)) * HTB)
#define PG8_SB(b, h) ((4 + (b) * 2 + (h)) * HTB)
#define PG8_STAGE(bufoff, gbase, voff) do { _Pragma("unroll") for (int _i = 0; _i < 2; ++_i) \
        __builtin_amdgcn_global_load_lds((const unsigned*)((const char*)(gbase) + (voff)[_i]), (LAS unsigned*)(lds + (bufoff) + ldsw + _i * 8192), 16, 0, 0); } while (0)
#define PG8_LDA(dst, b, h) do { _Pragma("unroll") for (int m = 0; m < 4; ++m) _Pragma("unroll") for (int k = 0; k < 2; ++k) dst[m][k] = *(const LAS h8*)(lds + PG8_SA(b, h) + aoff + m * 2048 + k * 1024); } while (0)
#define PG8_LDB(dst, b, h) do { _Pragma("unroll") for (int n = 0; n < 2; ++n) _Pragma("unroll") for (int k = 0; k < 2; ++k) dst[n][k] = *(const LAS h8*)(lds + PG8_SB(b, h) + boff + n * 2048 + k * 1024); } while (0)
#define PG8_MMA(ai, bj, At, Bt) do { __builtin_amdgcn_s_setprio(1); _Pragma("unroll") for (int m = 0; m < 4; ++m) _Pragma("unroll") for (int n = 0; n < 2; ++n) _Pragma("unroll") for (int k = 0; k < 2; ++k) \
        acc[ai][bj][m][n] = __builtin_amdgcn_mfma_f32_16x16x32_f16(Bt[n][k], At[m][k], acc[ai][bj][m][n], 0, 0, 0); __builtin_amdgcn_s_setprio(0); } while (0)
#define PG8_WAIT_V(n) asm volatile("s_waitcnt vmcnt(" #n ")" ::: "memory")
#define PG8_WAIT_L(n) asm volatile("s_waitcnt lgkmcnt(" #n ")" ::: "memory")
#define PG8_BAR __builtin_amdgcn_s_barrier()
#define PG8_SCHED __builtin_amdgcn_sched_barrier(0)
    Unit cur, nxt; int ui = 0;
    if (!S.next(0, cur)) return;
    f4 acc[2][2][4][2];
#pragma unroll
    for (int a = 0; a < 2; ++a)
#pragma unroll
        for (int b = 0; b < 2; ++b)
#pragma unroll
            for (int m = 0; m < 4; ++m)
#pragma unroll
                for (int n = 0; n < 2; ++n) acc[a][b][m][n] = (f4){0.f, 0.f, 0.f, 0.f};
    h8 At[4][2], B0[2][2], B1[2][2];
    const char* cA = (const char*)g.A + (size_t)cur.pm * tstepA; const char* cB = (const char*)g.Bt + (size_t)cur.pn * tstepB;
    PG8_STAGE(PG8_SB(0, 0), cB, voffB); PG8_STAGE(PG8_SA(0, 0), cA, voffA); PG8_STAGE(PG8_SB(0, 1), cB + hstepB, voffB); PG8_STAGE(PG8_SA(0, 1), cA + hstepA, voffA);
    if (wr == 1) PG8_BAR;
    PG8_WAIT_V(4); PG8_BAR;
    PG8_STAGE(PG8_SB(1, 0), cB + kstep, voffB); PG8_STAGE(PG8_SA(1, 0), cA + kstep, voffA); PG8_STAGE(PG8_SB(1, 1), cB + hstepB + kstep, voffB);
    PG8_WAIT_V(6); PG8_BAR;
    for (;;) {
        const bool has_next = S.next(ui + 1, nxt);
        const char* nA = has_next ? (const char*)g.A + (size_t)nxt.pm * tstepA : cA; const char* nB = has_next ? (const char*)g.Bt + (size_t)nxt.pn * tstepB : cB;
        for (int t = 0; t < nt; t += 2) {
            const bool last = (t == nt - 2);
            const char* a1 = cA + (size_t)(t + 1) * kstep;
            const char* a2 = last ? nA : cA + (size_t)(t + 2) * kstep; const char* b2 = last ? nB : cB + (size_t)(t + 2) * kstep;
            const char* a3 = a2 + kstep; const char* b3 = b2 + kstep;
            PG8_LDB(B0, 0, 0); PG8_SCHED; PG8_LDA(At, 0, 0); PG8_STAGE(PG8_SA(1, 1), a1 + hstepA, voffA);
            PG8_WAIT_L(8); PG8_BAR; PG8_WAIT_L(0); PG8_MMA(0, 0, At, B0); PG8_BAR; PG8_SCHED;
            PG8_LDB(B1, 0, 1); PG8_STAGE(PG8_SB(0, 0), b2, voffB);
            PG8_BAR; PG8_WAIT_L(0); PG8_MMA(0, 1, At, B1); PG8_BAR;
            PG8_LDA(At, 0, 1); PG8_STAGE(PG8_SA(0, 0), a2, voffA);
            PG8_BAR; PG8_WAIT_L(0); PG8_MMA(1, 0, At, B0); PG8_BAR; PG8_SCHED;
            PG8_STAGE(PG8_SB(0, 1), b2 + hstepB, voffB);
            PG8_WAIT_V(6); PG8_BAR; PG8_MMA(1, 1, At, B1); PG8_BAR;
            PG8_LDB(B0, 1, 0); PG8_SCHED; PG8_LDA(At, 1, 0); PG8_STAGE(PG8_SA(0, 1), a2 + hstepA, voffA);
            PG8_WAIT_L(8); PG8_BAR; PG8_WAIT_L(0); PG8_MMA(0, 0, At, B0); PG8_BAR; PG8_SCHED;
            PG8_LDB(B1, 1, 1); PG8_STAGE(PG8_SB(1, 0), b3, voffB);
            PG8_BAR; PG8_WAIT_L(0); PG8_MMA(0, 1, At, B1); PG8_BAR;
            PG8_LDA(At, 1, 1); PG8_STAGE(PG8_SA(1, 0), a3, voffA);
            PG8_BAR; PG8_WAIT_L(0); PG8_MMA(1, 0, At, B0); PG8_BAR; PG8_SCHED;
            PG8_STAGE(PG8_SB(1, 1), b3 + hstepB, voffB);
            PG8_WAIT_V(6); PG8_BAR; PG8_MMA(1, 1, At, B1); PG8_BAR;
        }
        { int t2 = tid; asm volatile("" : "+v"(t2)); const int l2 = t2 & 63; E(acc, cur, wr, wc, l2 & 15, l2 >> 4); }
        if (!has_next) break;
#pragma unroll
        for (int a = 0; a < 2; ++a)
#pragma unroll
            for (int b = 0; b < 2; ++b)
#pragma unroll
                for (int m = 0; m < 4; ++m)
#pragma unroll
                    for (int n = 0; n < 2; ++n) acc[a][b][m][n] = (f4){0.f, 0.f, 0.f, 0.f};
        cur = nxt; cA = nA; cB = nB; ++ui;
    }
    PG8_WAIT_V(0);
    if (wr == 0) PG8_BAR;
    PG8_BAR;
#undef PG8_SA
#undef PG8_SB
#undef PG8_STAGE
#undef PG8_LDA
#undef PG8_LDB
#undef PG8_MMA
#undef PG8_WAIT_V
#undef PG8_WAIT_L
#undef PG8_BAR
#undef PG8_SCHED
}

typedef f4 Acc[2][2][4][2];
#define EPI_ROWS for (int ai = 0; ai < 2; ++ai) _Pragma("unroll") for (int m = 0; m < 4; ++m)

struct EpiZ {
    static constexpr bool PERM = true;
    h16* z; float* sv;
    DEVI void operator()(const Acc& acc, const Unit& u, int wr, int wc, int fr, int fq) const {
#pragma unroll
        EPI_ROWS { const int row = u.pm * BM + ai * HALF + wr * 64 + m * 16 + fr;
#pragma unroll
            for (int bj = 0; bj < 2; ++bj) { const int col = u.pn * BM + bj * HALF + wc * 32 + fq * 8;
                f4 v0 = acc[ai][bj][m][0], v1 = acc[ai][bj][m][1];
                if (col < 512 || (col >= 1440 && col < 1696)) {
#pragma unroll
                    for (int e = 0; e < 4; ++e) { v0[e] = gelu_f(v0[e]); v1[e] = gelu_f(v1[e]); } }
                *(h8*)(z + (size_t)row * ZW + col) = pack8(v0, v1);
                if (row >= MP && col >= 256 && col < 512) { float* o = sv + (size_t)(row - MP) * 256 + (col - 256); *(f4*)o = v0; *(f4*)(o + 4) = v1; } } }
    }
};
struct EpiQ {
    static constexpr bool PERM = true;
    h16* q; h16* qlat; const float* ropec; const float* ropes;
    DEVI void operator()(const Acc& acc, const Unit& u, int wr, int wc, int fr, int fq) const {
        const bool samp = u.pm * BM >= MP;
        if (u.pn < 2) { if (samp) return;
#pragma unroll
            EPI_ROWS { const int row = u.pm * BM + ai * HALF + wr * 64 + m * 16 + fr;
#pragma unroll
                for (int bj = 0; bj < 2; ++bj) { const int col = u.pn * BM + bj * HALF + wc * 32 + fq * 8;
                    *(h8*)(q + (size_t)row * QW + (col >> 6) * 96 + (col & 63)) = pack8(acc[ai][bj][m][0] * QSCALE, acc[ai][bj][m][1] * QSCALE); } }
        } else {
            const int j = wc * 32 + fq * 8, head = j >> 4, i0 = j & 15;
#pragma unroll
            EPI_ROWS { const int row = u.pm * BM + ai * HALF + wr * 64 + m * 16 + fr;
                const int pidx = samp ? SEQ + ((row - MP) & 31) : (row & (SEQ - 1));
                const size_t po = samp ? (W_QLAT - W_Q) / 2 + (size_t)(row - MP) * QLW + head * 288 + 256 + i0 : (size_t)row * QW + head * 96 + 64 + i0;
#pragma unroll
                for (int n = 0; n < 2; ++n) { const f4 c0 = *(const f4*)(ropec + pidx * 16 + i0 + 4 * n), s0 = *(const f4*)(ropes + pidx * 16 + i0 + 4 * n);
                    const f4 a0 = acc[ai][0][m][n], b0 = acc[ai][1][m][n];
                    *(h4*)(q + po + 4 * n) = pack4((a0 * c0 - b0 * s0) * QSCALE); *(h4*)(q + po + 16 + 4 * n) = pack4((a0 * s0 + b0 * c0) * QSCALE); }
                asm volatile("" ::: "memory"); }
        }
    }
};
struct EpiKV {
    static constexpr bool PERM = true;
    h16* k; h16* v;
    DEVI void operator()(const Acc& acc, const Unit& u, int wr, int wc, int fr, int fq) const {
#pragma unroll
        EPI_ROWS { const int row = u.pm * BM + ai * HALF + wr * 64 + m * 16 + fr;
#pragma unroll
            for (int bj = 0; bj < 2; ++bj) { const int col = u.pn * BM + bj * HALF + wc * 32 + fq * 8; const h8 o = pack8(acc[ai][bj][m][0], acc[ai][bj][m][1]);
                if (u.pn < 2) *(h8*)(k + (size_t)row * KW + (col >> 6) * 96 + (col & 63)) = o; else *(h8*)(v + (size_t)row * VW + (col - 512)) = o; } }
    }
};
DEVI float one_minus_exp(float x) {
    const float pser = -x * (1.f + x * (0.5f + x * (0.16666667f + x * (0.041666668f + x * (0.0083333338f + x * 0.0013888889f)))));
    return x > -0.25f ? pser : 1.f - __expf(x);
}
struct EpiGate {
    static constexpr bool PERM = false;
    const h16* xc; float* a; float* b; const float* br; const float* bi; const float* sp;
    DEVI void operator()(const Acc& acc, const Unit& u, int wr, int wc, int fr, int fq) const {
#pragma unroll
        for (int n = 0; n < 2; ++n) { const int ch = u.pn * 128 + wc * 32 + n * 16 + fq * 4;
            const f4 vbr = *(const f4*)(br + ch), vbi = *(const f4*)(bi + ch), vsp = *(const f4*)(sp + ch) * -8.f;
#pragma unroll
            EPI_ROWS { const int row = u.pm * BM + ai * HALF + wr * 64 + m * 16 + fr;
                const h4 xv = *(const h4*)(xc + (size_t)row * 256 + ch); f4 oa, ob;
#pragma unroll
                for (int e = 0; e < 4; ++e) { const float r = sigmoid_f(acc[ai][0][m][n][e] + vbr[e]), ig = sigmoid_f(acc[ai][1][m][n][e] + vbi[e]);
                    const float la = r * vsp[e]; oa[e] = __expf(la); ob[e] = sqrtf(one_minus_exp(2.f * la)) * (ig * (float)xv[e]); }
                *(f4*)(a + (size_t)row * 256 + ch) = oa; *(f4*)(b + (size_t)row * 256 + ch) = ob;
                asm volatile("" ::: "memory"); } }
    }
};
struct EpiQlat {
    static constexpr bool PERM = true;
    h16* qlat;
    DEVI void operator()(const Acc& acc, const Unit& u, int wr, int wc, int fr, int fq) const {
#pragma unroll
        EPI_ROWS { const int row = u.pm * BM + ai * HALF + wr * 64 + m * 16 + fr;
#pragma unroll
            for (int bj = 0; bj < 2; ++bj) { const int c = bj * HALF + wc * 32 + fq * 8;
                *(h8*)(qlat + (size_t)row * QLW + u.pn * 288 + c) = pack8(acc[ai][bj][m][0] * QSCALE, acc[ai][bj][m][1] * QSCALE); } }
    }
};
struct EpiRes {
    static constexpr bool PERM = false;
    const float* xres; float* pre;
    DEVI void operator()(const Acc& acc, const Unit& u, int wr, int wc, int fr, int fq) const {
#pragma unroll
        EPI_ROWS { const int row = u.pm * BM + ai * HALF + wr * 64 + m * 16 + fr;
#pragma unroll
            for (int bj = 0; bj < 2; ++bj)
#pragma unroll
                for (int n = 0; n < 2; ++n) { const int col = u.pn * BM + bj * HALF + wc * 32 + n * 16 + fq * 4; const size_t o = (size_t)row * DM + col;
                    *(f4*)(pre + o) = *(const f4*)(xres + o) * ALPHA + acc[ai][bj][m][n]; } }
    }
};
struct EpiUp {
    static constexpr bool PERM = true;
    h16* up; float* pfc; size_t sdelta;
    DEVI void operator()(const Acc& acc, const Unit& u, int wr, int wc, int fr, int fq) const {
#pragma unroll
        EPI_ROWS { const int row = u.pm * BM + ai * HALF + wr * 64 + m * 16 + fr;
            bool has_st; size_t so;
            if (row < MP) { const int t = row & (SEQ - 1); has_st = t >= SEQ - 2; so = ((size_t)(row >> 11) * 2 + (t - (SEQ - 2))) * DFF2; }
            else { const int rs = row - MP, t = rs & 31; has_st = t >= DSEQ - 2; so = sdelta + ((size_t)(rs >> 5) * 2 + (t - (DSEQ - 2))) * DFF2; }
            float* st = pfc + so;
#pragma unroll
            for (int bj = 0; bj < 2; ++bj) { const int col = u.pn * BM + bj * HALF + wc * 32 + fq * 8;
                *(h8*)(up + (size_t)row * DFF2 + col) = pack8(acc[ai][bj][m][0], acc[ai][bj][m][1]);
                if (has_st) { *(f4*)(st + col) = acc[ai][bj][m][0]; *(f4*)(st + col + 4) = acc[ai][bj][m][1]; } } }
    }
};

template <int MODE>
DEVI void transpose_item(const float* W, int ldw, int nblk, h16* WT, int ldd, LAS float* scr, int item, int lane) {
    const int kb = item / nblk, nb = item % nblk, k0 = 64 * kb, n0 = 32 * nb;
    int nsrc = n0 + (lane & 31);
    if (MODE == 1) { const int n = nsrc; if (n < 512) nsrc = (n >> 6) * 96 + (n & 63); else if (n < 640) nsrc = ((n - 512) >> 4) * 96 + 64 + ((n - 512) & 15); else nsrc = ((n - 640) >> 4) * 96 + 80 + ((n - 640) & 15); }
#pragma unroll 8
    for (int i = 0; i < 32; ++i) { const int kk = 2 * i + (lane >> 5); scr[kk * 33 + (lane & 31)] = W[(size_t)(k0 + kk) * ldw + nsrc]; }
    __builtin_amdgcn_fence(__ATOMIC_RELEASE, "wavefront"); asm volatile("s_waitcnt lgkmcnt(0)" ::: "memory");
    const int c = lane & 7;
#pragma unroll
    for (int j = 0; j < 4; ++j) { const int n = (lane >> 3) + 8 * j; const LAS float* s = scr + (8 * c) * 33 + n;
        h8 o; o[0] = (h16)s[0 * 33]; o[1] = (h16)s[1 * 33]; o[2] = (h16)s[2 * 33]; o[3] = (h16)s[3 * 33]; o[4] = (h16)s[4 * 33]; o[5] = (h16)s[5 * 33]; o[6] = (h16)s[6 * 33]; o[7] = (h16)s[7 * 33];
        *(h8*)(WT + (size_t)(n0 + n) * ldd + k0 + 8 * c) = o; }
    asm volatile("s_waitcnt lgkmcnt(0)" ::: "memory");
}

template <int NKS, int NCT, int NQS, int KSTR>
DEVI void attn_qk(LAS unsigned char* kbase, const h8 (&qf)[NQS][NKS], f4 (&o)[NQS][NCT], float (&mrow)[NQS], float (&lrow)[NQS], h8 (&pf)[NQS][2], const int nkt, const int lane) {
    const int fr = lane & 15, g = lane >> 4;
    f4 s[NQS][4];
#pragma unroll
    for (int qs = 0; qs < NQS; ++qs)
#pragma unroll
        for (int kt = 0; kt < 4; ++kt) s[qs][kt] = (f4){-1e30f, -1e30f, -1e30f, -1e30f};
#pragma unroll
    for (int kt = 0; kt < 4; ++kt) if (kt < nkt) {
#pragma unroll
        for (int qs = 0; qs < NQS; ++qs) s[qs][kt] = (f4){0.f, 0.f, 0.f, 0.f};
#pragma unroll
        for (int ks = 0; ks < NKS; ++ks) { const h8 kf = *(const LAS h8*)(kbase + (kt * 16 + fr) * KSTR + ks * 64 + g * 16);
#pragma unroll
            for (int qs = 0; qs < NQS; ++qs) s[qs][kt] = __builtin_amdgcn_mfma_f32_16x16x32_f16(kf, qf[qs][ks], s[qs][kt], 0, 0, 0); } }
    __builtin_amdgcn_sched_barrier(0);
#pragma unroll
    for (int qs = 0; qs < NQS; ++qs) {
        float mx = -1e30f;
#pragma unroll
        for (int kt = 0; kt < 4; ++kt)
#pragma unroll
            for (int e = 0; e < 4; ++e) mx = fmaxf(mx, s[qs][kt][e]);
        mx = fmaxf(mx, shx(mx, 16, lane)); mx = fmaxf(mx, shx(mx, 32, lane));
        const float mnew = fmaxf(mrow[qs], mx), alpha = exp2f(mrow[qs] - mnew); mrow[qs] = mnew;
        float ps = 0.f;
#pragma unroll
        for (int kt = 0; kt < 4; ++kt)
#pragma unroll
            for (int e = 0; e < 4; ++e) { const float p = exp2f(s[qs][kt][e] - mnew); s[qs][kt][e] = p; ps += p; }
        lrow[qs] = lrow[qs] * alpha + ps;
#pragma unroll
        for (int ct = 0; ct < NCT; ++ct) o[qs][ct] *= alpha;
#pragma unroll
        for (int k2 = 0; k2 < 2; ++k2) pf[qs][k2] = pack8(s[qs][2 * k2], s[qs][2 * k2 + 1]);
    }
    __builtin_amdgcn_sched_barrier(0);
}
template <int NCT, int NQS, int VSTR>
DEVI void attn_pv(LAS unsigned char* vbase, f4 (&o)[NQS][NCT], const h8 (&pf)[NQS][2], const int nkt, const int lane) {
    const int fr = lane & 15, g = lane >> 4, q_ = fr >> 2, p_ = fr & 3;
#pragma unroll
    for (int k2 = 0; k2 < 2; ++k2) if (2 * k2 < nkt) {
#pragma unroll
        for (int ct = 0; ct < NCT; ++ct) {
            const h4 lo = trrd(vbase + (32 * k2 + 4 * g + q_) * VSTR + (16 * ct + 4 * p_) * 2);
            const h4 hi = trrd(vbase + (32 * k2 + 16 + 4 * g + q_) * VSTR + (16 * ct + 4 * p_) * 2);
            const h8 vf = cat44(lo, hi);
#pragma unroll
            for (int qs = 0; qs < NQS; ++qs) o[qs][ct] = __builtin_amdgcn_mfma_f32_16x16x32_f16(vf, pf[qs][k2], o[qs][ct], 0, 0, 0); } }
    __builtin_amdgcn_sched_barrier(0);
}
template <int NKS, int NCT, int NQS, int KSTR, int VSTR>
DEVI void attn_tile(LAS unsigned char* kbase, LAS unsigned char* vbase, const h8 (&qf)[NQS][NKS], f4 (&o)[NQS][NCT], float (&mrow)[NQS], float (&lrow)[NQS], const int nkt, const int lane) {
    h8 pf[NQS][2];
    attn_qk<NKS, NCT, NQS, KSTR>(kbase, qf, o, mrow, lrow, pf, nkt, lane);
    attn_pv<NCT, NQS, VSTR>(vbase, o, pf, nkt, lane);
}

#ifndef PHM
#define PHM 0xFFFFFFFFu
#endif
__global__ void __launch_bounds__(512, 2) trunk_fwd(Params p) {
    extern __shared__ __attribute__((aligned(16))) unsigned char shm_raw[];
    LAS unsigned char* lds = (LAS unsigned char*)shm_raw;
    __shared__ int s_item;
    cg::grid_group grid = cg::this_grid();
    const int wave_s = __builtin_amdgcn_readfirstlane((int)threadIdx.x >> 6);
#define PH_BEGIN \
    int tid = wave_s * 64 + opaque_lane(); asm volatile("" : "+v"(tid)); \
    int bid = blockIdx.x, G = gridDim.x, lq = l; asm volatile("" : "+s"(bid), "+s"(G), "+s"(lq)); \
    const int lane = tid & 63, wave = __builtin_amdgcn_readfirstlane(tid >> 6); \
    const int gw = bid * 8 + wave, NGW = G * 8; const size_t gtid = (size_t)bid * 512 + tid, NGT = (size_t)G * 512; \
    const __attribute__((address_space(4))) Params* kp = (const __attribute__((address_space(4))) Params*)__builtin_amdgcn_kernarg_segment_ptr(); asm volatile("" : "+s"(kp)); \
    unsigned char* ws = kp->ws; float* out = kp->out; \
    (void)lane; (void)wave; (void)gw; (void)NGW; (void)gtid; (void)NGT; (void)out; (void)lq;
#define WSP(T, off) ((T*)(ws + (off)))
    if (PHM & 1u) {
        int tid = wave_s * 64 + opaque_lane(); asm volatile("" : "+v"(tid));
        const int bid = blockIdx.x, G = gridDim.x, lane = tid & 63, wave = __builtin_amdgcn_readfirstlane(tid >> 6);
        const int gw = bid * 8 + wave, NGW = G * 8; const size_t gtid = (size_t)bid * 512 + tid, NGT = (size_t)G * 512;
        unsigned char* ws = p.ws;
        h16* xh = WSP(h16, W_XH); float* ropec = WSP(float, W_ROPE); float* ropes = ropec + NPOS * 16;
        for (size_t i = gtid; i < (size_t)MT * DM / 8; i += NGT) { const size_t e = i * 8; const float* src = e < (size_t)MP * DM ? p.in[0] + e : p.in[1] + (e - (size_t)MP * DM);
            *(h8*)(xh + e) = pack8(*(const f4*)src, *(const f4*)(src + 4)); }
        for (size_t i = gtid; i < (size_t)NPOS * 16; i += NGT) { const int pi = (int)(i >> 4), fi = (int)(i & 15); const double pos = pi < SEQ ? (double)pi : (double)(PAST + pi - SEQ);
            const double ang = pos * exp(-(double)fi / 16.0 * 9.210340371976184); ropec[i] = (float)cos(ang); ropes[i] = (float)sin(ang); }
        for (size_t i = gtid; i < (size_t)DEPTH * 256; i += NGT) WSP(float, W_SP)[i] = log1pf(expf(-p.in[26][i]));
        LAS float* scr = (LAS float*)(lds + wave * 8448);
        for (int l = 0; l < DEPTH; ++l) {
            h16* wt_in = WSP(h16, W_WIN + l * SZ_WIN); h16* wt_uq = WSP(h16, W_WUQ + l * SZ_WUQ); h16* wt_kv = WSP(h16, W_WKV + l * SZ_WKV);
            h16* wt_o = WSP(h16, W_WO + l * SZ_WO); h16* wt_os = WSP(h16, W_WOS + l * SZ_WOS); h16* wt_up = WSP(h16, W_WUP + l * SZ_WUP); h16* wt_dn = WSP(h16, W_WDN + l * SZ_WDN);
            h16* wt_ql = WSP(h16, W_WQL + l * SZ_WQL); h16* wt_g = WSP(h16, W_WG + l * SZ_WG);
            const float* w_in = p.in[11] + (size_t)l * DM * DIN; const float* w_o = p.in[12] + (size_t)l * DM * DM; const float* w_uq = p.in[16] + (size_t)l * 384 * 768;
            const float* w_uk = p.in[18] + (size_t)l * 256 * 512; const float* w_uv = p.in[19] + (size_t)l * 256 * 512; const float* w_up = p.in[27] + (size_t)l * DM * DFF2; const float* w_dn = p.in[30] + (size_t)l * DFF * DM;
            const float* w_r = p.in[22] + (size_t)l * 4 * 64 * 64; const float* w_i = p.in[24] + (size_t)l * 4 * 64 * 64;
            for (int it = gw; it < 16 * 53; it += NGW) transpose_item<0>(w_in, DIN, 53, wt_in, 1024, scr, it, lane);
            for (int it = gw; it < 6 * 24; it += NGW) transpose_item<1>(w_uq, 768, 24, wt_uq, 384, scr, it, lane);
            for (int it = gw; it < 4 * 16; it += NGW) transpose_item<0>(w_uk, 512, 16, wt_kv, 256, scr, it, lane);
            for (int it = gw; it < 4 * 16; it += NGW) transpose_item<0>(w_uv, 512, 16, wt_kv + 512 * 256, 256, scr, it, lane);
            for (int it = gw; it < 16 * 32; it += NGW) transpose_item<0>(w_o, 1024, 32, wt_o, 1024, scr, it, lane);
            for (int it = gw; it < 4 * 32; it += NGW) transpose_item<0>(w_o, 1024, 32, wt_os, CSW, scr, it, lane);
            for (int it = gw; it < 4 * 32; it += NGW) transpose_item<0>(w_o + (size_t)768 * 1024, 1024, 32, wt_os + 2304, CSW, scr, it, lane);
            for (int it = gw; it < 16 * 176; it += NGW) transpose_item<0>(w_up, DFF2, 176, wt_up, 1024, scr, it, lane);
            for (int it = gw; it < 44 * 32; it += NGW) transpose_item<0>(w_dn, 1024, 32, wt_dn, DFF, scr, it, lane);
            for (size_t i = gtid; i < (size_t)(ZW - DIN) * 1024 / 8; i += NGT) *(h8*)(wt_in + (size_t)DIN * 1024 + i * 8) = (h8){0, 0, 0, 0, 0, 0, 0, 0};
            for (size_t i = gtid; i < (size_t)512 * 256; i += NGT) { const int n = (int)(i >> 8), k = (int)(i & 255); const int pn = n >> 8, jj = n & 127, isI = (n >> 7) & 1, ch = pn * 128 + jj;
                float v = 0.f; if ((k >> 6) == (ch >> 6)) v = (isI ? w_i : w_r)[((ch >> 6) * 64 + (k & 63)) * 64 + (ch & 63)];
                wt_g[i] = (h16)v; }
            for (size_t i = gtid; i < (size_t)2048 * 384; i += NGT) { const int n = (int)(i / 384), k = (int)(i % 384), hh = n >> 8, c = n & 255;
                const float* a = w_uq + (size_t)k * 768 + hh * 96; const float* b = w_uk + (size_t)c * 512 + hh * 64; float s = 0.f;
#pragma unroll 8
                for (int d = 0; d < 64; ++d) s += a[d] * b[d];
                wt_ql[i] = (h16)s; }
            for (size_t i = gtid; i < (size_t)2048 * 1024; i += NGT) { const int n = (int)(i & 1023), kk = (int)(i >> 10), hh = kk >> 8, c = kk & 255;
                const float* a = w_uv + (size_t)c * 512 + hh * 64; const float* b = w_o + (size_t)(256 + hh * 64) * 1024 + n; float s = 0.f;
#pragma unroll 8
                for (int d = 0; d < 64; ++d) s += a[d] * b[(size_t)d * 1024];
                wt_os[(size_t)n * CSW + 256 + kk] = (h16)s; }
        }
    }
    grid.sync();

    for (int l = 0; l < DEPTH; ++l) {
        if (PHM & (1u << 1)) { PH_BEGIN
          Gemm g{WSP(h16, W_XH), WSP(h16, W_WIN + lq * SZ_WIN), MT, ZW, 1024, 1024, 1024}; StaticOrder S; S.init(MT, ZW, G, bid); EpiZ E{WSP(h16, W_Z), out + O_SV + (size_t)lq * MS * 256}; gemm_phase(lds, g, S, E, tid); }
        grid.sync();

        if (PHM & (1u << 2)) { PH_BEGIN
            const float* qn_g = kp->in[15] + lq * 384; const float* kvn_g = kp->in[17] + lq * 256;
            const float* cw = kp->in[20] + (size_t)lq * 4 * 256; const float* cb = kp->in[21] + lq * 256; const float* stc = kp->in[5] + (size_t)lq * DBATCH * 3 * 256;
            const h16* z = WSP(h16, W_Z); h16* cqn = WSP(h16, W_CQN); h16* ckvn = WSP(h16, W_CKVN); h16* knew = WSP(h16, W_KNEW); h16* kb = WSP(h16, W_K); h16* xc = WSP(h16, W_XC);
            const float* ropec = WSP(float, W_ROPE); const float* ropes = ropec + NPOS * 16;
            for (int row = gw; row < MT; row += NGW) {
                const h16* zr = z + (size_t)row * ZW; const bool samp = row >= MP; const int rs = row - MP;
                const int t = samp ? (rs & 31) : (row & (SEQ - 1)), bb = samp ? (rs >> 5) : (row >> 11);
                { float v[6]; float ss = 0.f;
#pragma unroll
                    for (int i = 0; i < 3; ++i) { const h2 x = *(const h2*)(zr + 512 + 2 * lane + 128 * i); v[2 * i] = (float)x[0]; v[2 * i + 1] = (float)x[1]; ss += v[2 * i] * v[2 * i] + v[2 * i + 1] * v[2 * i + 1]; }
                    const float rr = rsqrtf(wave_sum(ss, lane) * (1.f / 384.f) + 1e-6f);
#pragma unroll
                    for (int i = 0; i < 3; ++i) { const int c = 2 * lane + 128 * i; h2 o; o[0] = (h16)(v[2 * i] * rr * qn_g[c]); o[1] = (h16)(v[2 * i + 1] * rr * qn_g[c + 1]); *(h2*)(cqn + (size_t)row * 384 + c) = o; } }
                { const h4 x = *(const h4*)(zr + 896 + 4 * lane); f4 v; float ss = 0.f;
#pragma unroll
                    for (int e = 0; e < 4; ++e) { v[e] = (float)x[e]; ss += v[e] * v[e]; }
                    const float rr = rsqrtf(wave_sum(ss, lane) * (1.f / 256.f) + 1e-6f); const f4 gg = *(const f4*)(kvn_g + 4 * lane); v = v * rr * gg;
                    if (!samp) { *(f4*)(out + O_PLAT + ((size_t)lq * MP + row) * 256 + 4 * lane) = v; *(h4*)(ckvn + (size_t)row * 256 + 4 * lane) = pack4(v); }
                    else { *(f4*)(out + O_SLAT + ((size_t)lq * MS + rs) * 256 + 4 * lane) = v; *(h4*)(knew + (size_t)rs * KNW + 4 * lane) = pack4(v); } }
                if (lane < 16) { const int pidx = samp ? SEQ + t : t; const float c = ropec[pidx * 16 + lane], s = ropes[pidx * 16 + lane];
                    const float x1 = (float)zr[1152 + lane], x2 = (float)zr[1168 + lane], o1 = x1 * c - x2 * s, o2 = x1 * s + x2 * c;
                    if (!samp) { float* o = out + O_PKR + ((size_t)lq * MP + row) * 32; o[lane] = o1; o[16 + lane] = o2;
                        h16* kr = kb + (size_t)row * KW + 64;
#pragma unroll
                        for (int hh = 0; hh < 8; ++hh) { kr[hh * 96 + lane] = (h16)o1; kr[hh * 96 + 16 + lane] = (h16)o2; } }
                    else { float* o = out + O_SKR + ((size_t)lq * MS + rs) * 32; o[lane] = o1; o[16 + lane] = o2; knew[(size_t)rs * KNW + 256 + lane] = (h16)o1; knew[(size_t)rs * KNW + 272 + lane] = (h16)o2; } }
                { const int c = 4 * lane; f4 accv = *(const f4*)(cb + c);
#pragma unroll
                    for (int j = 0; j < 4; ++j) { const int tau = t - 3 + j; f4 xv;
                        if (tau >= 0) { const h4 x = *(const h4*)(zr - (ptrdiff_t)(3 - j) * ZW + 1184 + c); xv = (f4){(float)x[0], (float)x[1], (float)x[2], (float)x[3]}; }
                        else if (samp) xv = *(const f4*)(stc + ((size_t)bb * 3 + (3 + tau)) * 256 + c);
                        else xv = (f4){0.f, 0.f, 0.f, 0.f};
                        accv += xv * *(const f4*)(cw + j * 256 + c);
                        if (j == 3) { const int T = samp ? DSEQ : SEQ; if (t >= T - 3) { float* o = samp ? out + O_SLC + (((size_t)lq * DBATCH + bb) * 3 + (t - (T - 3))) * 256 : out + O_PLC + (((size_t)lq * NB + bb) * 3 + (t - (T - 3))) * 256; *(f4*)(o + c) = xv; } } }
                    *(h4*)(xc + (size_t)row * 256 + c) = pack4(accv); }
            }
        }
        grid.sync();

        if (PHM & (1u << 3)) { PH_BEGIN
          Gemm g{WSP(h16, W_CQN), WSP(h16, W_WUQ + lq * SZ_WUQ), MT, 768, 384, 384, 384}; StaticOrder S; S.init(MT, 768, G, bid);
          EpiQ E{WSP(h16, W_Q), WSP(h16, W_QLAT), WSP(float, W_ROPE), WSP(float, W_ROPE) + NPOS * 16}; gemm_phase(lds, g, S, E, tid); }
        if (PHM & (1u << 4)) { PH_BEGIN
          Gemm g{WSP(h16, W_CKVN), WSP(h16, W_WKV + lq * SZ_WKV), MP, 1024, 256, 256, 256}; StaticOrder S; S.init(MP, 1024, G, (bid + G - (396 % G)) % G); EpiKV E{WSP(h16, W_K), WSP(h16, W_V)}; gemm_phase(lds, g, S, E, tid); }
        if (PHM & (1u << 5)) { PH_BEGIN
          Gemm g{WSP(h16, W_XC), WSP(h16, W_WG + lq * SZ_WG), MT, 512, 256, 256, 256}; StaticOrder S; S.init(MT, 512, G, (bid + G - (908 % G)) % G);
          EpiGate E{WSP(h16, W_XC), WSP(float, W_A), WSP(float, W_B), kp->in[23] + lq * 256, kp->in[25] + lq * 256, WSP(float, W_SP) + lq * 256}; gemm_phase(lds, g, S, E, tid); }
        if (PHM & (1u << 6)) { PH_BEGIN
          Gemm g{WSP(h16, W_CQN) + (size_t)MP * 384, WSP(h16, W_WQL + lq * SZ_WQL), MS, 2048, 384, 384, 384}; StaticOrder S; S.init(MS, 2048, G, (bid + G - (1172 % G)) % G); EpiQlat E{WSP(h16, W_QLAT)}; gemm_phase(lds, g, S, E, tid); }
        if (PHM & (1u << 7)) { PH_BEGIN
            const float* gw_s = kp->in[13] + (size_t)lq * 4 * 128 * 128; const float* gb_s = kp->in[14] + (size_t)lq * 4 * 128;
            const h16* z = WSP(h16, W_Z); h16* cat = WSP(h16, W_CAT); h16* cats = WSP(h16, W_CATS);
            const int fr = lane & 15, g4 = lane >> 4, q_ = fr >> 2, p_ = fr & 3;
            for (int item = (bid + G - (1204 % G)) % G; item < 1024 + 128; item += G) {
                const bool samp = item >= 1024; const int head = item & 3; const int ci = samp ? (item - 1024) >> 2 : item >> 2;
                const int R0 = samp ? MP + ci * 32 : ci * 128, L = samp ? 32 : 128;
                __syncthreads();
                for (int id = tid; id < L * 8; id += 512) { const int j = id >> 3, part = id & 7; *(LAS h8*)(lds + j * 144 + part * 16) = *(const h8*)(z + (size_t)(R0 + j) * ZW + 256 + head * 64 + part * 8); }
                __syncthreads();
                const int i0 = 16 * wave;
                if (i0 < L) {
                    f4 sacc[4];
#pragma unroll
                    for (int ct = 0; ct < 4; ++ct) sacc[ct] = (f4){0.f, 0.f, 0.f, 0.f};
                    const int i = i0 + fr;
#pragma unroll
                    for (int ks = 0; ks < 4; ++ks) if (32 * ks <= i0 + 15 && 32 * ks < L) {
                        const int j0 = 32 * ks + 8 * g4; const float* wp = gw_s + ((size_t)head * 128 + i) * 128 + j0; const f4 w0 = *(const f4*)wp, w1 = *(const f4*)(wp + 4);
                        h8 wf;
#pragma unroll
                        for (int e = 0; e < 4; ++e) { wf[e] = (h16)((j0 + e <= i) ? w0[e] : 0.f); wf[4 + e] = (h16)((j0 + 4 + e <= i) ? w1[e] : 0.f); }
#pragma unroll
                        for (int ct = 0; ct < 4; ++ct) { const h4 lo = trrd(lds + (32 * ks + 8 * g4 + q_) * 144 + (16 * ct + 4 * p_) * 2), hi = trrd(lds + (32 * ks + 8 * g4 + 4 + q_) * 144 + (16 * ct + 4 * p_) * 2);
                            sacc[ct] = __builtin_amdgcn_mfma_f32_16x16x32_f16(wf, cat44(lo, hi), sacc[ct], 0, 0, 0); } }
#pragma unroll
                    for (int jx = 0; jx < 4; ++jx) { const int ii = i0 + 4 * g4 + jx; const float bs = gb_s[head * 128 + ii]; const size_t r = (size_t)R0 + ii;
#pragma unroll
                        for (int ct = 0; ct < 4; ++ct) { const int d = head * 64 + 16 * ct + fr; const float uval = (float)z[r * ZW + d]; const h16 o = (h16)(uval * (sacc[ct][jx] + bs));
                            if (!samp) cat[r * 1024 + d] = o; else cats[(r - MP) * CSW + d] = o; } }
                }
            }
            __syncthreads();
        }
        grid.sync();

        if (PHM & (1u << 8)) { PH_BEGIN
            unsigned* counter = WSP(unsigned, W_CTR) + lq * 16;
            const int fr = lane & 15, g4 = lane >> 4;
            constexpr int N_SA = 64, N_PA = 1024, N_PS = 128, N_SS = 16, N_ALL = N_SA + N_PA + N_PS + N_SS;
            for (;;) {
                __syncthreads();
                if (tid == 0) s_item = (int)atomicAdd(counter, 1u);
                __syncthreads();
                const int item = s_item;
                if (item >= N_ALL) break;
                if (item < N_SA) {
                    constexpr int KS = 592;
                    const float* clat = kp->in[2] + (size_t)lq * DBATCH * PAST * 256; const float* ckr = kp->in[3] + (size_t)lq * DBATCH * PAST * 32;
                    const h16* qlat = WSP(h16, W_QLAT); const h16* knew = WSP(h16, W_KNEW); h16* cats = WSP(h16, W_CATS);
                    const int b = item >> 1, hg = item & 1, head = 4 * hg + (wave >> 1), tq = 16 * (wave & 1) + fr;
                    h8 qf[1][9];
#pragma unroll
                    for (int ks = 0; ks < 9; ++ks) qf[0][ks] = *(const h8*)(qlat + (size_t)(b * 32 + tq) * QLW + head * 288 + 32 * ks + 8 * g4);
                    f4 o[1][16]; float mrow[1] = {-1e30f}, lrow[1] = {0.f};
#pragma unroll
                    for (int ct = 0; ct < 16; ++ct) o[0][ct] = (f4){0.f, 0.f, 0.f, 0.f};
                    const float* lb = clat + (size_t)b * PAST * 256 + (size_t)(tid >> 6) * 256 + (tid & 63) * 4; const float* rb = ckr + (size_t)b * PAST * 32 + (size_t)(tid >> 3) * 32 + (tid & 7) * 4;
                    const int wl = (tid >> 6) * KS + (tid & 63) * 8, wr_ = (tid >> 3) * KS + 512 + (tid & 7) * 8;
                    f4 pl[4]; f4 pr;
#pragma unroll
                    for (int hf = 0; hf < 2; ++hf) {
#pragma unroll
                        for (int i = 0; i < 4; ++i) pl[i] = *(const f4*)(lb + (size_t)(hf * 4 + i) * 8 * 256);
#pragma unroll
                        for (int i = 0; i < 4; ++i) *(LAS h4*)(lds + wl + (hf * 4 + i) * 8 * KS) = pack4(pl[i]); }
                    pr = *(const f4*)rb;
                    *(LAS h4*)(lds + wr_) = pack4(pr);
                    __syncthreads();
                    for (int t = 0; t < 64; ++t) {
                        LAS unsigned char* cur = lds + (t & 1) * (64 * KS); LAS unsigned char* nxt = lds + ((t + 1) & 1) * (64 * KS);
                        const bool more = t + 1 < 64;
                        if (more) {
#pragma unroll
                            for (int i = 0; i < 4; ++i) pl[i] = *(const f4*)(lb + ((size_t)(t + 1) * 64 + i * 8) * 256);
                            pr = *(const f4*)(rb + (size_t)(t + 1) * 64 * 32);
                        }
                        h8 pf[1][2];
                        attn_qk<9, 16, 1, KS>(cur, qf, o, mrow, lrow, pf, 4, lane);
                        if (more) {
#pragma unroll
                            for (int i = 0; i < 4; ++i) *(LAS h4*)(nxt + wl + i * 8 * KS) = pack4(pl[i]);
                            *(LAS h4*)(nxt + wr_) = pack4(pr);
#pragma unroll
                            for (int i = 0; i < 4; ++i) pl[i] = *(const f4*)(lb + ((size_t)(t + 1) * 64 + (4 + i) * 8) * 256);
                        }
                        attn_pv<16, 1, KS>(cur, o, pf, 4, lane);
                        if (more) {
#pragma unroll
                            for (int i = 0; i < 4; ++i) *(LAS h4*)(nxt + wl + (4 + i) * 8 * KS) = pack4(pl[i]);
                        } else {
                            for (int id = tid; id < 32 * 36; id += 512) { const int key = id / 36, part = id % 36; *(LAS h8*)(nxt + key * KS + part * 16) = *(const h8*)(knew + (size_t)(b * 32 + key) * KNW + part * 8); }
                        }
                        __syncthreads();
                    }
                    attn_tile<9, 16, 1, KS, KS>(lds, lds, qf, o, mrow, lrow, 2, lane);
                    float lt = lrow[0]; lt += shx(lt, 16, lane); lt += shx(lt, 32, lane); const float inv = 1.f / lt;
                    h16* dst = cats + (size_t)(b * 32 + tq) * CSW + 256 + head * 256 + 4 * g4;
#pragma unroll
                    for (int ct = 0; ct < 16; ++ct) *(h4*)(dst + 16 * ct) = pack4(o[0][ct] * inv);
                } else if (item < N_SA + N_PA) {
                    constexpr int KS = 208, VS = 144, KBUF = 64 * KS, VBUF = 64 * VS;
                    const h16* qb = WSP(h16, W_Q); const h16* kb = WSP(h16, W_K); const h16* vb = WSP(h16, W_V); h16* cat = WSP(h16, W_CAT);
                    const int it = item - N_SA, qblk = 7 - (it >> 7), bh = it & 127, b = bh >> 3, head = bh & 7;
                    const int r0 = qblk * 256 + 32 * wave, ntw = (r0 >> 6) + 1, ntb = 4 * (qblk + 1);
                    h8 qf[2][3];
#pragma unroll
                    for (int qs = 0; qs < 2; ++qs)
#pragma unroll
                        for (int ks = 0; ks < 3; ++ks) qf[qs][ks] = *(const h8*)(qb + (size_t)(b * SEQ + r0 + 16 * qs + fr) * QW + head * 96 + 32 * ks + 8 * g4);
                    f4 o[2][4]; float mrow[2] = {-1e30f, -1e30f}, lrow[2] = {0.f, 0.f};
#pragma unroll
                    for (int qs = 0; qs < 2; ++qs)
#pragma unroll
                        for (int ct = 0; ct < 4; ++ct) o[qs][ct] = (f4){0.f, 0.f, 0.f, 0.f};
                    const int k0key = tid / 12, k0part = tid % 12, k1key = (tid + 512) / 12, k1part = (tid + 512) % 12, vkey = tid >> 3, vpart = tid & 7;
                    const h16* kg0 = kb + (size_t)b * SEQ * KW + head * 96 + (size_t)k0key * KW + k0part * 8; const h16* kg1 = kb + (size_t)b * SEQ * KW + head * 96 + (size_t)k1key * KW + k1part * 8;
                    const h16* vg = vb + (size_t)b * SEQ * VW + head * 64 + (size_t)vkey * VW + vpart * 8;
                    const int lk0 = k0key * KS + k0part * 16, lk1 = k1key * KS + k1part * 16, lv = 2 * KBUF + vkey * VS + vpart * 16;
                    h8 pk0, pk1 = (h8){0, 0, 0, 0, 0, 0, 0, 0}, pv;
                    pk0 = *(const h8*)kg0; if (tid < 256) pk1 = *(const h8*)kg1; pv = *(const h8*)vg;
                    *(LAS h8*)(lds + lk0) = pk0; if (tid < 256) *(LAS h8*)(lds + lk1) = pk1; *(LAS h8*)(lds + lv) = pv;
                    __syncthreads();
                    for (int t = 0; t < ntb; ++t) {
                        const int co = (t & 1), no = ((t + 1) & 1);
                        if (t + 1 < ntb) { const size_t ro = (size_t)(t + 1) * 64;
                            pk0 = *(const h8*)(kg0 + ro * KW); if (tid < 256) pk1 = *(const h8*)(kg1 + ro * KW); pv = *(const h8*)(vg + ro * VW); }
                        if (t < ntw) attn_tile<3, 4, 2, KS, VS>(lds + co * KBUF, lds + 2 * KBUF + co * VBUF, qf, o, mrow, lrow, 4, lane);
                        if (t + 1 < ntb) { *(LAS h8*)(lds + no * KBUF + lk0) = pk0; if (tid < 256) *(LAS h8*)(lds + no * KBUF + lk1) = pk1; *(LAS h8*)(lds + no * VBUF + lv) = pv; }
                        __syncthreads();
                    }
#pragma unroll
                    for (int qs = 0; qs < 2; ++qs) { float lt = lrow[qs]; lt += shx(lt, 16, lane); lt += shx(lt, 32, lane); const float inv = 1.f / lt;
                        h16* dst = cat + (size_t)(b * SEQ + r0 + 16 * qs + fr) * 1024 + 256 + head * 64 + 4 * g4;
#pragma unroll
                        for (int ct = 0; ct < 4; ++ct) *(h4*)(dst + 16 * ct) = pack4(o[qs][ct] * inv); }
                } else if (item < N_SA + N_PA + N_PS) {
                    const float* abuf = WSP(float, W_A); const float* bbuf = WSP(float, W_B); const h16* z = WSP(h16, W_Z); h16* cat = WSP(h16, W_CAT);
                    const int it = item - N_SA - N_PA, b = it >> 3, ch = (it & 7) * 32 + (tid & 31), seg = tid >> 5;
                    const size_t rbase = (size_t)b * SEQ + seg * 128;
                    float A = 1.f, B = 0.f;
#pragma unroll 4
                    for (int i = 0; i < 128; ++i) { const float a = abuf[(rbase + i) * 256 + ch], bb = bbuf[(rbase + i) * 256 + ch]; B = a * B + bb; A *= a; }
                    LAS float* sA = (LAS float*)lds; LAS float* sB = sA + 512;
                    sA[tid] = A; sB[tid] = B;
                    __syncthreads();
                    float h = 0.f;
                    for (int s2 = 0; s2 < seg; ++s2) h = sA[s2 * 32 + (tid & 31)] * h + sB[s2 * 32 + (tid & 31)];
#pragma unroll 4
                    for (int i = 0; i < 128; ++i) { const float a = abuf[(rbase + i) * 256 + ch], bb = bbuf[(rbase + i) * 256 + ch]; h = a * h + bb;
                        const float gt = (float)z[(rbase + i) * ZW + 1440 + ch]; cat[(rbase + i) * 1024 + 768 + ch] = (h16)(h * gt); }
                    if (seg == 15) out[O_PH + ((size_t)lq * NB + b) * 256 + ch] = h;
                } else {
                    const float* abuf = WSP(float, W_A); const float* bbuf = WSP(float, W_B); const h16* z = WSP(h16, W_Z); h16* cats = WSP(h16, W_CATS);
                    const int it = item - N_SA - N_PA - N_PS, idx = it * 512 + tid, b = idx >> 8, ch = idx & 255;
                    float h = kp->in[4][((size_t)lq * DBATCH + b) * 256 + ch];
                    for (int t = 0; t < DSEQ; ++t) { const size_t r = (size_t)MP + b * 32 + t; h = abuf[r * 256 + ch] * h + bbuf[r * 256 + ch];
                        const float gt = (float)z[r * ZW + 1440 + ch]; cats[(size_t)(b * 32 + t) * CSW + 2304 + ch] = (h16)(h * gt); }
                    out[O_SH + ((size_t)lq * DBATCH + b) * 256 + ch] = h;
                }
            }
        }
        grid.sync();

        if (PHM & (1u << 9)) { PH_BEGIN
          const float* xres_s = lq == 0 ? kp->in[1] : out + O_Y + (size_t)MP * DM;
          Gemm g{WSP(h16, W_CATS), WSP(h16, W_WOS + lq * SZ_WOS), MS, 1024, CSW, CSW, CSW}; StaticOrder S; S.init(MS, 1024, G, bid); EpiRes E{xres_s, WSP(float, W_PRE) + (size_t)MP * DM}; gemm_phase(lds, g, S, E, tid); }
        if (PHM & (1u << 10)) { PH_BEGIN
          const float* xres_p = lq == 0 ? kp->in[0] : out + O_Y;
          Gemm g{WSP(h16, W_CAT), WSP(h16, W_WO + lq * SZ_WO), MP, 1024, 1024, 1024, 1024}; StaticOrder S; S.init(MP, 1024, G - 16, bid - 16); EpiRes E{xres_p, WSP(float, W_PRE)}; gemm_phase(lds, g, S, E, tid); }
        grid.sync();

        if (PHM & (1u << 11)) { PH_BEGIN
            const float* gg = kp->in[7] + lq * DM; const float* bb = kp->in[8] + lq * DM; const float* pre = WSP(float, W_PRE); float* x1f = WSP(float, W_X1F); h16* xh = WSP(h16, W_XH);
            for (int row = gw; row < MT; row += NGW) { const float* pr = pre + (size_t)row * DM; f4 v[4]; float s = 0.f;
#pragma unroll
                for (int j = 0; j < 4; ++j) { v[j] = *(const f4*)(pr + 4 * lane + 256 * j); s += (v[j][0] + v[j][1]) + (v[j][2] + v[j][3]); }
                const float mean = wave_sum(s, lane) * (1.f / DM); float s2 = 0.f;
#pragma unroll
                for (int j = 0; j < 4; ++j) { v[j] = v[j] - mean; s2 += (v[j][0] * v[j][0] + v[j][1] * v[j][1]) + (v[j][2] * v[j][2] + v[j][3] * v[j][3]); }
                const float rstd = rsqrtf(wave_sum(s2, lane) * (1.f / DM) + 1e-5f);
#pragma unroll
                for (int j = 0; j < 4; ++j) { const int c = 4 * lane + 256 * j; const f4 y = v[j] * rstd * *(const f4*)(gg + c) + *(const f4*)(bb + c);
                    *(f4*)(x1f + (size_t)row * DM + c) = y; *(h4*)(xh + (size_t)row * DM + c) = pack4(y); } }
        }
        grid.sync();

        if (PHM & (1u << 12)) { PH_BEGIN
          Gemm g{WSP(h16, W_XH), WSP(h16, W_WUP + lq * SZ_WUP), MT, DFF2, 1024, 1024, 1024}; StaticOrder S; S.init(MT, DFF2, G, bid);
          EpiUp E{WSP(h16, W_UP), out + O_PFC + (size_t)lq * NB * 2 * DFF2, (O_SFC + (size_t)lq * DBATCH * 2 * DFF2) - (O_PFC + (size_t)lq * NB * 2 * DFF2)}; gemm_phase(lds, g, S, E, tid); }
        grid.sync();

        if (PHM & (1u << 13)) { PH_BEGIN
            const float* fw = kp->in[28] + (size_t)lq * 3 * DFF2; const float* fb = kp->in[29] + (size_t)lq * DFF2; const float* stf = kp->in[6] + (size_t)lq * DBATCH * 2 * DFF2;
            const h16* up = WSP(h16, W_UP); h16* act = WSP(h16, W_ACT);
            for (size_t i = gtid; i < (size_t)MT * (DFF / 8); i += NGT) { const int row = (int)(i / (DFF / 8)), j0 = (int)(i % (DFF / 8)) * 8;
                const bool samp = row >= MP; const int rs = row - MP, t = samp ? (rs & 31) : (row & (SEQ - 1)), bb = samp ? (rs >> 5) : 0;
                f4 g0 = *(const f4*)(fb + j0), g1 = *(const f4*)(fb + j0 + 4), v0 = *(const f4*)(fb + DFF + j0), v1 = *(const f4*)(fb + DFF + j0 + 4);
#pragma unroll
                for (int j = 0; j < 3; ++j) { const int tau = t - 2 + j; f4 xg0, xg1, xv0, xv1;
                    if (tau >= 0) { const h16* ur = up + (size_t)(row - (2 - j)) * DFF2; const h8 a = *(const h8*)(ur + j0), c = *(const h8*)(ur + DFF + j0);
                        xg0 = (f4){(float)a[0], (float)a[1], (float)a[2], (float)a[3]}; xg1 = (f4){(float)a[4], (float)a[5], (float)a[6], (float)a[7]};
                        xv0 = (f4){(float)c[0], (float)c[1], (float)c[2], (float)c[3]}; xv1 = (f4){(float)c[4], (float)c[5], (float)c[6], (float)c[7]}; }
                    else if (samp) { const float* sr = stf + ((size_t)bb * 2 + (2 + tau)) * DFF2; xg0 = *(const f4*)(sr + j0); xg1 = *(const f4*)(sr + j0 + 4); xv0 = *(const f4*)(sr + DFF + j0); xv1 = *(const f4*)(sr + DFF + j0 + 4); }
                    else { xg0 = xg1 = xv0 = xv1 = (f4){0.f, 0.f, 0.f, 0.f}; }
                    const float* wj = fw + (size_t)j * DFF2;
                    g0 += xg0 * *(const f4*)(wj + j0); g1 += xg1 * *(const f4*)(wj + j0 + 4); v0 += xv0 * *(const f4*)(wj + DFF + j0); v1 += xv1 * *(const f4*)(wj + DFF + j0 + 4); }
                h8 o;
#pragma unroll
                for (int e = 0; e < 4; ++e) { o[e] = (h16)(gelu_f(g0[e]) * v0[e]); o[4 + e] = (h16)(gelu_f(g1[e]) * v1[e]); }
                *(h8*)(act + (size_t)row * DFF + j0) = o; }
        }
        grid.sync();

        if (PHM & (1u << 14)) { PH_BEGIN
          Gemm g{WSP(h16, W_ACT), WSP(h16, W_WDN + lq * SZ_WDN), MT, 1024, DFF, DFF, DFF}; StaticOrder S; S.init(MT, 1024, G, bid); EpiRes E{WSP(float, W_X1F), WSP(float, W_PRE)}; gemm_phase(lds, g, S, E, tid); }
        grid.sync();

        if (PHM & (1u << 15)) { PH_BEGIN
            const float* gg = kp->in[9] + lq * DM; const float* bb = kp->in[10] + lq * DM; const float* pre = WSP(float, W_PRE); h16* xh = WSP(h16, W_XH);
            for (int row = gw; row < MT; row += NGW) { const float* pr = pre + (size_t)row * DM; f4 v[4]; float s = 0.f;
#pragma unroll
                for (int j = 0; j < 4; ++j) { v[j] = *(const f4*)(pr + 4 * lane + 256 * j); s += (v[j][0] + v[j][1]) + (v[j][2] + v[j][3]); }
                const float mean = wave_sum(s, lane) * (1.f / DM); float s2 = 0.f;
#pragma unroll
                for (int j = 0; j < 4; ++j) { v[j] = v[j] - mean; s2 += (v[j][0] * v[j][0] + v[j][1] * v[j][1]) + (v[j][2] * v[j][2] + v[j][3] * v[j][3]); }
                const float rstd = rsqrtf(wave_sum(s2, lane) * (1.f / DM) + 1e-5f);
#pragma unroll
                for (int j = 0; j < 4; ++j) { const int c = 4 * lane + 256 * j; const f4 y = v[j] * rstd * *(const f4*)(gg + c) + *(const f4*)(bb + c);
                    *(f4*)(out + O_Y + (size_t)row * DM + c) = y; *(h4*)(xh + (size_t)row * DM + c) = pack4(y); } }
        }
        grid.sync();
    }
}

extern "C" void kernel_launch(void* const* d_in, const int* in_sizes, int n_in, void* d_out, int out_size, void* d_ws, size_t ws_size, hipStream_t stream) {
    constexpr size_t kDynLds = STAGE_BYTES;
    static int grid_blocks = 0;
    if (!grid_blocks) {
        if (n_in != 31 || (size_t)out_size != O_END || ws_size < W_END) { fprintf(stderr, "kernel_launch: unexpected shapes n_in %d out %d ws %zu (need %zu)\n", n_in, out_size, ws_size, (size_t)W_END); grid_blocks = -1; return; }
        int dev = 0, cus = 0, per_cu = 0;
        hipGetDevice(&dev);
        hipDeviceGetAttribute(&cus, hipDeviceAttributeMultiprocessorCount, dev);
        hipFuncSetAttribute((const void*)trunk_fwd, hipFuncAttributeMaxDynamicSharedMemorySize, (int)kDynLds);
        hipOccupancyMaxActiveBlocksPerMultiprocessor(&per_cu, (const void*)trunk_fwd, 512, kDynLds);
        if (per_cu < 1) per_cu = 1;
        grid_blocks = cus * per_cu;
        if (grid_blocks > 256) grid_blocks = 256;
        if (grid_blocks < 32) { fprintf(stderr, "kernel_launch: grid %d too small\n", grid_blocks); grid_blocks = -1; return; }
    }
    if (grid_blocks < 0) return;
    hipMemsetAsync((char*)d_ws + W_CTR, 0, 4096, stream);
    Params p{};
    for (int i = 0; i < 31; ++i) p.in[i] = (const float*)d_in[i];
    p.out = (float*)d_out; p.ws = (unsigned char*)d_ws;
    void* args[] = {&p};
    hipError_t e = hipLaunchCooperativeKernel((const void*)trunk_fwd, dim3(grid_blocks), dim3(512), args, kDynLds, stream);
    if (e != hipSuccess) fprintf(stderr, "cooperative launch failed: %s (grid %d)\n", hipGetErrorString(e), grid_blocks);
}
```

```cpp
#include <hip/hip_runtime.h>
#include <hip/hip_cooperative_groups.h>
#include <cstdio>
#include <cstdint>
namespace cg = cooperative_groups;

typedef _Float16 h16;
typedef _Float16 h8 __attribute__((ext_vector_type(8)));
typedef _Float16 h4 __attribute__((ext_vector_type(4)));
typedef _Float16 h2 __attribute__((ext_vector_type(2)));
typedef float f4 __attribute__((ext_vector_type(4)));
typedef short s4v __attribute__((__vector_size__(8)));
#define LAS __attribute__((address_space(3)))
#define DEVI __device__ __forceinline__

constexpr int DM = 1024, NB = 16, SEQ = 2048, DEPTH = 4, DBATCH = 32, DSEQ = 32, PAST = 4096;
constexpr int MP = NB * SEQ, MS = DBATCH * DSEQ, MT = MP + MS;
constexpr int DIN = 1696, ZW = 1792, DFF = 2816, DFF2 = 5632;
constexpr int QW = 768, KW = 768, VW = 512, QLW = 2304, CSW = 2560, KNW = 288;
constexpr float ALPHA = 1.681792830507429f;
constexpr float QSCALE = 0.14724444f;
constexpr int NPOS = SEQ + DSEQ;

constexpr size_t O_Y = 0;
constexpr size_t O_PLAT = (size_t)MT * DM;
constexpr size_t O_PKR = O_PLAT + (size_t)DEPTH * MP * 256;
constexpr size_t O_PH = O_PKR + (size_t)DEPTH * MP * 32;
constexpr size_t O_PLC = O_PH + (size_t)DEPTH * NB * 256;
constexpr size_t O_PFC = O_PLC + (size_t)DEPTH * NB * 3 * 256;
constexpr size_t O_SLAT = O_PFC + (size_t)DEPTH * NB * 2 * DFF2;
constexpr size_t O_SKR = O_SLAT + (size_t)DEPTH * MS * 256;
constexpr size_t O_SV = O_SKR + (size_t)DEPTH * MS * 32;
constexpr size_t O_SH = O_SV + (size_t)DEPTH * MS * 256;
constexpr size_t O_SLC = O_SH + (size_t)DEPTH * DBATCH * 256;
constexpr size_t O_SFC = O_SLC + (size_t)DEPTH * DBATCH * 3 * 256;
constexpr size_t O_END = O_SFC + (size_t)DEPTH * DBATCH * 2 * DFF2;

constexpr size_t al(size_t x) { return (x + 255) & ~(size_t)255; }
constexpr size_t W_CTR = 0;
constexpr size_t W_PARAMS = 2048;
constexpr size_t W_ROPE = 4096;
constexpr size_t W_SP = al(W_ROPE + (size_t)NPOS * 16 * 2 * 4);
constexpr size_t W_WIN = al(W_SP + (size_t)DEPTH * 256 * 4);
constexpr size_t SZ_WIN = (size_t)ZW * 1024 * 2;
constexpr size_t W_WUQ = W_WIN + DEPTH * SZ_WIN;   constexpr size_t SZ_WUQ = (size_t)768 * 384 * 2;
constexpr size_t W_WQL = W_WUQ + DEPTH * SZ_WUQ;   constexpr size_t SZ_WQL = (size_t)2048 * 384 * 2;
constexpr size_t W_WKV = W_WQL + DEPTH * SZ_WQL;   constexpr size_t SZ_WKV = (size_t)1024 * 256 * 2;
constexpr size_t W_WG = W_WKV + DEPTH * SZ_WKV;    constexpr size_t SZ_WG = (size_t)512 * 256 * 2;
constexpr size_t W_WO = W_WG + DEPTH * SZ_WG;      constexpr size_t SZ_WO = (size_t)1024 * 1024 * 2;
constexpr size_t W_WOS = W_WO + DEPTH * SZ_WO;     constexpr size_t SZ_WOS = (size_t)1024 * CSW * 2;
constexpr size_t W_WUP = W_WOS + DEPTH * SZ_WOS;   constexpr size_t SZ_WUP = (size_t)DFF2 * 1024 * 2;
constexpr size_t W_WDN = W_WUP + DEPTH * SZ_WUP;   constexpr size_t SZ_WDN = (size_t)1024 * DFF * 2;
constexpr size_t W_XH = W_WDN + DEPTH * SZ_WDN;
constexpr size_t W_Z = W_XH + (size_t)MT * 1024 * 2;
constexpr size_t W_CQN = W_Z + (size_t)MT * ZW * 2;
constexpr size_t W_CKVN = W_CQN + (size_t)MT * 384 * 2;
constexpr size_t W_XC = W_CKVN + (size_t)MP * 256 * 2;
constexpr size_t W_Q = W_XC + (size_t)MT * 256 * 2;
constexpr size_t W_K = W_Q + (size_t)MP * QW * 2;
constexpr size_t W_V = W_K + (size_t)MP * KW * 2;
constexpr size_t W_A = W_V + (size_t)MP * VW * 2;
constexpr size_t W_B = W_A + (size_t)MT * 256 * 4;
constexpr size_t W_CAT = W_B + (size_t)MT * 256 * 4;
constexpr size_t W_CATS = W_CAT + (size_t)MP * 1024 * 2;
constexpr size_t W_QLAT = W_CATS + (size_t)MS * CSW * 2;
constexpr size_t W_KNEW = W_QLAT + (size_t)MS * QLW * 2;
constexpr size_t W_PRE = al(W_KNEW + (size_t)MS * KNW * 2);
constexpr size_t W_X1F = W_PRE + (size_t)MT * 1024 * 4;
constexpr size_t W_UP = W_X1F + (size_t)MT * 1024 * 4;
constexpr size_t W_ACT = W_UP + (size_t)MT * DFF2 * 2;
constexpr size_t W_END = W_ACT + (size_t)MT * DFF * 2;

struct Params { const float* in[31]; float* out; unsigned char* ws; };

DEVI float gelu_f(float x) { const float u = 1.5957691216057308f * (x + 0.044715f * x * x * x); return x / (1.f + __expf(-u)); }
DEVI float sigmoid_f(float x) { return 1.f / (1.f + __expf(-x)); }
DEVI h8 pack8(f4 a, f4 b) { h8 r; r[0] = (h16)a[0]; r[1] = (h16)a[1]; r[2] = (h16)a[2]; r[3] = (h16)a[3]; r[4] = (h16)b[0]; r[5] = (h16)b[1]; r[6] = (h16)b[2]; r[7] = (h16)b[3]; return r; }
DEVI h4 pack4(f4 a) { h4 r; r[0] = (h16)a[0]; r[1] = (h16)a[1]; r[2] = (h16)a[2]; r[3] = (h16)a[3]; return r; }
DEVI float shx(float v, int o, int lane) { return __builtin_bit_cast(float, __builtin_amdgcn_ds_bpermute((lane ^ o) << 2, __builtin_bit_cast(int, v))); }
DEVI float wave_sum(float v, int lane) {
#pragma unroll
    for (int o = 1; o < 64; o <<= 1) v += shx(v, o, lane);
    return v;
}
DEVI int opaque_lane() { unsigned ones = ~0u; asm volatile("" : "+s"(ones)); return (int)__builtin_amdgcn_mbcnt_hi(ones, __builtin_amdgcn_mbcnt_lo(ones, 0u)); }
DEVI h4 trrd(LAS unsigned char* p) { s4v r = __builtin_amdgcn_ds_read_tr16_b64_v4i16((LAS s4v*)p); return __builtin_bit_cast(h4, r); }
DEVI h8 cat44(h4 a, h4 b) { return __builtin_shufflevector(a, b, 0, 1, 2, 3, 4, 5, 6, 7); }

constexpr int BM = 256, BK = 64, HALF = 128, HTB = HALF * BK * 2, STAGE_BYTES = 8 * HTB, NXCD = 8, WGM = 8;
DEVI int lds_byte(int r, int c) { const int st = (r >> 4) * 2 + (c >> 5), rr = r & 15, cc = c & 31, ob = rr * 64 + cc * 2; return st * 1024 + (ob ^ (((ob >> 9) & 1) << 5)); }
DEVI void stage_rc(int b, int& R, int& C) { const int st = b / 1024, sb = b % 1024, swz = sb ^ (((sb >> 9) & 1) << 5); R = (st >> 1) * 16 + swz / 64; C = (st & 1) * 32 + (swz % 64) / 2; }
DEVI int perm32(int rho) { const int n = rho >> 4, i = rho & 15; return 8 * (i >> 2) + 4 * n + (i & 3); }
struct Unit { int pm, pn; };
struct Gemm { const h16* A; const h16* Bt; int M, N, K, lda, ldb; };
struct StaticOrder {
    int nM, nN, nwg, G, c;
    DEVI void init(int M, int N, int G_, int c_) { nM = M / BM; nN = N / BM; nwg = nM * nN; G = G_; c = c_; }
    DEVI bool next(int i, Unit& u) const {
        if (c < 0) return false;
        const long L = (long)i * G + c; if (L >= nwg) return false;
        int wgid = (int)L; { const int q = nwg / NXCD, r = nwg % NXCD, xcd = wgid % NXCD, off = wgid / NXCD; wgid = (xcd < r ? xcd * (q + 1) : r * (q + 1) + (xcd - r) * q) + off; }
        const int nig = WGM * nN, gid = wgid / nig, fm = gid * WGM, gsz = (nM - fm) < WGM ? (nM - fm) : WGM;
        u.pm = fm + ((wgid % nig) % gsz); u.pn = (wgid % nig) / gsz; return true;
    }
};
template <class Epi>
DEVI void gemm_phase(LAS unsigned char* lds, const Gemm g, const StaticOrder& S, const Epi& E, const int tid) {
    const int wid = __builtin_amdgcn_readfirstlane(tid >> 6), lane = tid & 63, wr = wid >> 2, wc = wid & 3, fr = lane & 15, fq = lane >> 4;
    const int K = g.K, nt = K / BK;
    unsigned voffA[2], voffB[2];
#pragma unroll
    for (int i = 0; i < 2; ++i) { int R, C; stage_rc(tid * 16 + i * 8192, R, C); const int Rb = Epi::PERM ? ((R & ~31) + perm32(R & 31)) : R;
        voffA[i] = (unsigned)(R * g.lda + C) * 2u; voffB[i] = (unsigned)(Rb * g.ldb + C) * 2u; }
    const size_t kstep = (size_t)(BK * 2);
    const size_t hstepA = (size_t)HALF * g.lda * 2, hstepB = (size_t)HALF * g.ldb * 2;
    const size_t tstepA = 2 * hstepA, tstepB = 2 * hstepB;
    const unsigned ldsw = (unsigned)wid * 1024u;
    const int aoff = lds_byte(wr * 64 + fr, fq * 8), boff = lds_byte(wc * 32 + fr, fq * 8);
#define PG8_SA(b, h) (((b) * 2 + (h)) * HTB)
#define PG8_SB(b, h) ((4 + (b) * 2 + (h)) * HTB)
#define PG8_STAGE(bufoff, gbase, voff) do { _Pragma("unroll") for (int _i = 0; _i < 2; ++_i) \
        __builtin_amdgcn_global_load_lds((const unsigned*)((const char*)(gbase) + (voff)[_i]), (LAS unsigned*)(lds + (bufoff) + ldsw + _i * 8192), 16, 0, 0); } while (0)
#define PG8_LDA(dst, b, h) do { _Pragma("unroll") for (int m = 0; m < 4; ++m) _Pragma("unroll") for (int k = 0; k < 2; ++k) dst[m][k] = *(const LAS h8*)(lds + PG8_SA(b, h) + aoff + m * 2048 + k * 1024); } while (0)
#define PG8_LDB(dst, b, h) do { _Pragma("unroll") for (int n = 0; n < 2; ++n) _Pragma("unroll") for (int k = 0; k < 2; ++k) dst[n][k] = *(const LAS h8*)(lds + PG8_SB(b, h) + boff + n * 2048 + k * 1024); } while (0)
#define PG8_MMA(ai, bj, At, Bt) do { __builtin_amdgcn_s_setprio(1); _Pragma("unroll") for (int m = 0; m < 4; ++m) _Pragma("unroll") for (int n = 0; n < 2; ++n) _Pragma("unroll") for (int k = 0; k < 2; ++k) \
        acc[ai][bj][m][n] = __builtin_amdgcn_mfma_f32_16x16x32_f16(Bt[n][k], At[m][k], acc[ai][bj][m][n], 0, 0, 0); __builtin_amdgcn_s_setprio(0); } while (0)
#define PG8_WAIT_V(n) asm volatile("s_waitcnt vmcnt(" #n ")" ::: "memory")
#define PG8_WAIT_L(n) asm volatile("s_waitcnt lgkmcnt(" #n ")" ::: "memory")
#define PG8_BAR __builtin_amdgcn_s_barrier()
#define PG8_SCHED __builtin_amdgcn_sched_barrier(0)
    Unit cur, nxt; int ui = 0;
    if (!S.next(0, cur)) return;
    f4 acc[2][2][4][2];
#pragma unroll
    for (int a = 0; a < 2; ++a)
#pragma unroll
        for (int b = 0; b < 2; ++b)
#pragma unroll
            for (int m = 0; m < 4; ++m)
#pragma unroll
                for (int n = 0; n < 2; ++n) acc[a][b][m][n] = (f4){0.f, 0.f, 0.f, 0.f};
    h8 At[4][2], B0[2][2], B1[2][2];
    const char* cA = (const char*)g.A + (size_t)cur.pm * tstepA; const char* cB = (const char*)g.Bt + (size_t)cur.pn * tstepB;
    PG8_STAGE(PG8_SB(0, 0), cB, voffB); PG8_STAGE(PG8_SA(0, 0), cA, voffA); PG8_STAGE(PG8_SB(0, 1), cB + hstepB, voffB); PG8_STAGE(PG8_SA(0, 1), cA + hstepA, voffA);
    if (wr == 1) PG8_BAR;
    PG8_WAIT_V(4); PG8_BAR;
    PG8_STAGE(PG8_SB(1, 0), cB + kstep, voffB); PG8_STAGE(PG8_SA(1, 0), cA + kstep, voffA); PG8_STAGE(PG8_SB(1, 1), cB + hstepB + kstep, voffB);
    PG8_WAIT_V(6); PG8_BAR;
    for (;;) {
        const bool has_next = S.next(ui + 1, nxt);
        const char* nA = has_next ? (const char*)g.A + (size_t)nxt.pm * tstepA : cA; const char* nB = has_next ? (const char*)g.Bt + (size_t)nxt.pn * tstepB : cB;
        for (int t = 0; t < nt; t += 2) {
            const bool last = (t == nt - 2);
            const char* a1 = cA + (size_t)(t + 1) * kstep;
            const char* a2 = last ? nA : cA + (size_t)(t + 2) * kstep; const char* b2 = last ? nB : cB + (size_t)(t + 2) * kstep;
            const char* a3 = a2 + kstep; const char* b3 = b2 + kstep;
            PG8_LDB(B0, 0, 0); PG8_SCHED; PG8_LDA(At, 0, 0); PG8_STAGE(PG8_SA(1, 1), a1 + hstepA, voffA);
            PG8_WAIT_L(8); PG8_BAR; PG8_WAIT_L(0); PG8_MMA(0, 0, At, B0); PG8_BAR; PG8_SCHED;
            PG8_LDB(B1, 0, 1); PG8_STAGE(PG8_SB(0, 0), b2, voffB);
            PG8_BAR; PG8_WAIT_L(0); PG8_MMA(0, 1, At, B1); PG8_BAR;
            PG8_LDA(At, 0, 1); PG8_STAGE(PG8_SA(0, 0), a2, voffA);
            PG8_BAR; PG8_WAIT_L(0); PG8_MMA(1, 0, At, B0); PG8_BAR; PG8_SCHED;
            PG8_STAGE(PG8_SB(0, 1), b2 + hstepB, voffB);
            PG8_WAIT_V(6); PG8_BAR; PG8_MMA(1, 1, At, B1); PG8_BAR;
            PG8_LDB(B0, 1, 0); PG8_SCHED; PG8_LDA(At, 1, 0); PG8_STAGE(PG8_SA(0, 1), a2 + hstepA, voffA);
            PG8_WAIT_L(8); PG8_BAR; PG8_WAIT_L(0); PG8_MMA(0, 0, At, B0); PG8_BAR; PG8_SCHED;
            PG8_LDB(B1, 1, 1); PG8_STAGE(PG8_SB(1, 0), b3, voffB);
            PG8_BAR; PG8_WAIT_L(0); PG8_MMA(0, 1, At, B1); PG8_BAR;
            PG8_LDA(At, 1, 1); PG8_STAGE(PG8_SA(1, 0), a3, voffA);
            PG8_BAR; PG8_WAIT_L(0); PG8_MMA(1, 0, At, B0); PG8_BAR; PG8_SCHED;
            PG8_STAGE(PG8_SB(1, 1), b3 + hstepB, voffB);
            PG8_WAIT_V(6); PG8_BAR; PG8_MMA(1, 1, At, B1); PG8_BAR;
        }
        { int t2 = tid; asm volatile("" : "+v"(t2)); const int l2 = t2 & 63; E(acc, cur, wr, wc, l2 & 15, l2 >> 4); }
        if (!has_next) break;
#pragma unroll
        for (int a = 0; a < 2; ++a)
#pragma unroll
            for (int b = 0; b < 2; ++b)
#pragma unroll
                for (int m = 0; m < 4; ++m)
#pragma unroll
                    for (int n = 0; n < 2; ++n) acc[a][b][m][n] = (f4){0.f, 0.f, 0.f, 0.f};
        cur = nxt; cA = nA; cB = nB; ++ui;
    }
    PG8_WAIT_V(0);
    if (wr == 0) PG8_BAR;
    PG8_BAR;
#undef PG8_SA
#undef PG8_SB
#undef PG8_STAGE
#undef PG8_LDA
#undef PG8_LDB
#undef PG8_MMA
#undef PG8_WAIT_V
#undef PG8_WAIT_L
#undef PG8_BAR
#undef PG8_SCHED
}

typedef f4 Acc[2][2][4][2];
#define EPI_ROWS for (int ai = 0; ai < 2; ++ai) _Pragma("unroll") for (int m = 0; m < 4; ++m)

struct EpiZ {
    static constexpr bool PERM = true;
    h16* z; float* sv;
    DEVI void operator()(const Acc& acc, const Unit& u, int wr, int wc, int fr, int fq) const {
#pragma unroll
        EPI_ROWS { const int row = u.pm * BM + ai * HALF + wr * 64 + m * 16 + fr;
#pragma unroll
            for (int bj = 0; bj < 2; ++bj) { const int col = u.pn * BM + bj * HALF + wc * 32 + fq * 8;
                f4 v0 = acc[ai][bj][m][0], v1 = acc[ai][bj][m][1];
                if (col < 512 || (col >= 1440 && col < 1696)) {
#pragma unroll
                    for (int e = 0; e < 4; ++e) { v0[e] = gelu_f(v0[e]); v1[e] = gelu_f(v1[e]); } }
                *(h8*)(z + (size_t)row * ZW + col) = pack8(v0, v1);
                if (row >= MP && col >= 256 && col < 512) { float* o = sv + (size_t)(row - MP) * 256 + (col - 256); *(f4*)o = v0; *(f4*)(o + 4) = v1; } } }
    }
};
struct EpiQ {
    static constexpr bool PERM = true;
    h16* q; h16* qlat; const float* ropec; const float* ropes;
    DEVI void operator()(const Acc& acc, const Unit& u, int wr, int wc, int fr, int fq) const {
        const bool samp = u.pm * BM >= MP;
        if (u.pn < 2) { if (samp) return;
#pragma unroll
            EPI_ROWS { const int row = u.pm * BM + ai * HALF + wr * 64 + m * 16 + fr;
#pragma unroll
                for (int bj = 0; bj < 2; ++bj) { const int col = u.pn * BM + bj * HALF + wc * 32 + fq * 8;
                    *(h8*)(q + (size_t)row * QW + (col >> 6) * 96 + (col & 63)) = pack8(acc[ai][bj][m][0] * QSCALE, acc[ai][bj][m][1] * QSCALE); } }
        } else {
            const int j = wc * 32 + fq * 8, head = j >> 4, i0 = j & 15;
#pragma unroll
            EPI_ROWS { const int row = u.pm * BM + ai * HALF + wr * 64 + m * 16 + fr;
                const int pidx = samp ? SEQ + ((row - MP) & 31) : (row & (SEQ - 1));
                const size_t po = samp ? (W_QLAT - W_Q) / 2 + (size_t)(row - MP) * QLW + head * 288 + 256 + i0 : (size_t)row * QW + head * 96 + 64 + i0;
#pragma unroll
                for (int n = 0; n < 2; ++n) { const f4 c0 = *(const f4*)(ropec + pidx * 16 + i0 + 4 * n), s0 = *(const f4*)(ropes + pidx * 16 + i0 + 4 * n);
                    const f4 a0 = acc[ai][0][m][n], b0 = acc[ai][1][m][n];
                    *(h4*)(q + po + 4 * n) = pack4((a0 * c0 - b0 * s0) * QSCALE); *(h4*)(q + po + 16 + 4 * n) = pack4((a0 * s0 + b0 * c0) * QSCALE); }
                asm volatile("" ::: "memory"); }
        }
    }
};
struct EpiKV {
    static constexpr bool PERM = true;
    h16* k; h16* v;
    DEVI void operator()(const Acc& acc, const Unit& u, int wr, int wc, int fr, int fq) const {
#pragma unroll
        EPI_ROWS { const int row = u.pm * BM + ai * HALF + wr * 64 + m * 16 + fr;
#pragma unroll
            for (int bj = 0; bj < 2; ++bj) { const int col = u.pn * BM + bj * HALF + wc * 32 + fq * 8; const h8 o = pack8(acc[ai][bj][m][0], acc[ai][bj][m][1]);
                if (u.pn < 2) *(h8*)(k + (size_t)row * KW + (col >> 6) * 96 + (col & 63)) = o; else *(h8*)(v + (size_t)row * VW + (col - 512)) = o; } }
    }
};
DEVI float one_minus_exp(float x) {
    const float pser = -x * (1.f + x * (0.5f + x * (0.16666667f + x * (0.041666668f + x * (0.0083333338f + x * 0.0013888889f)))));
    return x > -0.25f ? pser : 1.f - __expf(x);
}
struct EpiGate {
    static constexpr bool PERM = false;
    const h16* xc; float* a; float* b; const float* br; const float* bi; const float* sp;
    DEVI void operator()(const Acc& acc, const Unit& u, int wr, int wc, int fr, int fq) const {
#pragma unroll
        for (int n = 0; n < 2; ++n) { const int ch = u.pn * 128 + wc * 32 + n * 16 + fq * 4;
            const f4 vbr = *(const f4*)(br + ch), vbi = *(const f4*)(bi + ch), vsp = *(const f4*)(sp + ch) * -8.f;
#pragma unroll
            EPI_ROWS { const int row = u.pm * BM + ai * HALF + wr * 64 + m * 16 + fr;
                const h4 xv = *(const h4*)(xc + (size_t)row * 256 + ch); f4 oa, ob;
#pragma unroll
                for (int e = 0; e < 4; ++e) { const float r = sigmoid_f(acc[ai][0][m][n][e] + vbr[e]), ig = sigmoid_f(acc[ai][1][m][n][e] + vbi[e]);
                    const float la = r * vsp[e]; oa[e] = __expf(la); ob[e] = sqrtf(one_minus_exp(2.f * la)) * (ig * (float)xv[e]); }
                *(f4*)(a + (size_t)row * 256 + ch) = oa; *(f4*)(b + (size_t)row * 256 + ch) = ob;
                asm volatile("" ::: "memory"); } }
    }
};
struct EpiQlat {
    static constexpr bool PERM = true;
    h16* qlat;
    DEVI void operator()(const Acc& acc, const Unit& u, int wr, int wc, int fr, int fq) const {
#pragma unroll
        EPI_ROWS { const int row = u.pm * BM + ai * HALF + wr * 64 + m * 16 + fr;
#pragma unroll
            for (int bj = 0; bj < 2; ++bj) { const int c = bj * HALF + wc * 32 + fq * 8;
                *(h8*)(qlat + (size_t)row * QLW + u.pn * 288 + c) = pack8(acc[ai][bj][m][0] * QSCALE, acc[ai][bj][m][1] * QSCALE); } }
    }
};
struct EpiRes {
    static constexpr bool PERM = false;
    const float* xres; float* pre;
    DEVI void operator()(const Acc& acc, const Unit& u, int wr, int wc, int fr, int fq) const {
#pragma unroll
        EPI_ROWS { const int row = u.pm * BM + ai * HALF + wr * 64 + m * 16 + fr;
#pragma unroll
            for (int bj = 0; bj < 2; ++bj)
#pragma unroll
                for (int n = 0; n < 2; ++n) { const int col = u.pn * BM + bj * HALF + wc * 32 + n * 16 + fq * 4; const size_t o = (size_t)row * DM + col;
                    *(f4*)(pre + o) = *(const f4*)(xres + o) * ALPHA + acc[ai][bj][m][n]; } }
    }
};
struct EpiUp {
    static constexpr bool PERM = true;
    h16* up; float* pfc; size_t sdelta;
    DEVI void operator()(const Acc& acc, const Unit& u, int wr, int wc, int fr, int fq) const {
#pragma unroll
        EPI_ROWS { const int row = u.pm * BM + ai * HALF + wr * 64 + m * 16 + fr;
            bool has_st; size_t so;
            if (row < MP) { const int t = row & (SEQ - 1); has_st = t >= SEQ - 2; so = ((size_t)(row >> 11) * 2 + (t - (SEQ - 2))) * DFF2; }
            else { const int rs = row - MP, t = rs & 31; has_st = t >= DSEQ - 2; so = sdelta + ((size_t)(rs >> 5) * 2 + (t - (DSEQ - 2))) * DFF2; }
            float* st = pfc + so;
#pragma unroll
            for (int bj = 0; bj < 2; ++bj) { const int col = u.pn * BM + bj * HALF + wc * 32 + fq * 8;
                *(h8*)(up + (size_t)row * DFF2 + col) = pack8(acc[ai][bj][m][0], acc[ai][bj][m][1]);
                if (has_st) { *(f4*)(st + col) = acc[ai][bj][m][0]; *(f4*)(st + col + 4) = acc[ai][bj][m][1]; } } }
    }
};

template <int MODE>
DEVI void transpose_item(const float* W, int ldw, int nblk, h16* WT, int ldd, LAS float* scr, int item, int lane) {
    const int kb = item / nblk, nb = item % nblk, k0 = 64 * kb, n0 = 32 * nb;
    int nsrc = n0 + (lane & 31);
    if (MODE == 1) { const int n = nsrc; if (n < 512) nsrc = (n >> 6) * 96 + (n & 63); else if (n < 640) nsrc = ((n - 512) >> 4) * 96 + 64 + ((n - 512) & 15); else nsrc = ((n - 640) >> 4) * 96 + 80 + ((n - 640) & 15); }
#pragma unroll 8
    for (int i = 0; i < 32; ++i) { const int kk = 2 * i + (lane >> 5); scr[kk * 33 + (lane & 31)] = W[(size_t)(k0 + kk) * ldw + nsrc]; }
    __builtin_amdgcn_fence(__ATOMIC_RELEASE, "wavefront"); asm volatile("s_waitcnt lgkmcnt(0)" ::: "memory");
    const int c = lane & 7;
#pragma unroll
    for (int j = 0; j < 4; ++j) { const int n = (lane >> 3) + 8 * j; const LAS float* s = scr + (8 * c) * 33 + n;
        h8 o; o[0] = (h16)s[0 * 33]; o[1] = (h16)s[1 * 33]; o[2] = (h16)s[2 * 33]; o[3] = (h16)s[3 * 33]; o[4] = (h16)s[4 * 33]; o[5] = (h16)s[5 * 33]; o[6] = (h16)s[6 * 33]; o[7] = (h16)s[7 * 33];
        *(h8*)(WT + (size_t)(n0 + n) * ldd + k0 + 8 * c) = o; }
    asm volatile("s_waitcnt lgkmcnt(0)" ::: "memory");
}

template <int NKS, int NCT, int NQS, int KSTR>
DEVI void attn_qk(LAS unsigned char* kbase, const h8 (&qf)[NQS][NKS], f4 (&o)[NQS][NCT], float (&mrow)[NQS], float (&lrow)[NQS], h8 (&pf)[NQS][2], const int nkt, const int lane) {
    const int fr = lane & 15, g = lane >> 4;
    f4 s[NQS][4];
#pragma unroll
    for (int qs = 0; qs < NQS; ++qs)
#pragma unroll
        for (int kt = 0; kt < 4; ++kt) s[qs][kt] = (f4){-1e30f, -1e30f, -1e30f, -1e30f};
#pragma unroll
    for (int kt = 0; kt < 4; ++kt) if (kt < nkt) {
#pragma unroll
        for (int qs = 0; qs < NQS; ++qs) s[qs][kt] = (f4){0.f, 0.f, 0.f, 0.f};
#pragma unroll
        for (int ks = 0; ks < NKS; ++ks) { const h8 kf = *(const LAS h8*)(kbase + (kt * 16 + fr) * KSTR + ks * 64 + g * 16);
#pragma unroll
            for (int qs = 0; qs < NQS; ++qs) s[qs][kt] = __builtin_amdgcn_mfma_f32_16x16x32_f16(kf, qf[qs][ks], s[qs][kt], 0, 0, 0); } }
    __builtin_amdgcn_sched_barrier(0);
#pragma unroll
    for (int qs = 0; qs < NQS; ++qs) {
        float mx = -1e30f;
#pragma unroll
        for (int kt = 0; kt < 4; ++kt)
#pragma unroll
            for (int e = 0; e < 4; ++e) mx = fmaxf(mx, s[qs][kt][e]);
        mx = fmaxf(mx, shx(mx, 16, lane)); mx = fmaxf(mx, shx(mx, 32, lane));
        const float mnew = fmaxf(mrow[qs], mx), alpha = exp2f(mrow[qs] - mnew); mrow[qs] = mnew;
        float ps = 0.f;
#pragma unroll
        for (int kt = 0; kt < 4; ++kt)
#pragma unroll
            for (int e = 0; e < 4; ++e) { const float p = exp2f(s[qs][kt][e] - mnew); s[qs][kt][e] = p; ps += p; }
        lrow[qs] = lrow[qs] * alpha + ps;
#pragma unroll
        for (int ct = 0; ct < NCT; ++ct) o[qs][ct] *= alpha;
#pragma unroll
        for (int k2 = 0; k2 < 2; ++k2) pf[qs][k2] = pack8(s[qs][2 * k2], s[qs][2 * k2 + 1]);
    }
    __builtin_amdgcn_sched_barrier(0);
}
template <int NCT, int NQS, int VSTR>
DEVI void attn_pv(LAS unsigned char* vbase, f4 (&o)[NQS][NCT], const h8 (&pf)[NQS][2], const int nkt, const int lane) {
    const int fr = lane & 15, g = lane >> 4, q_ = fr >> 2, p_ = fr & 3;
#pragma unroll
    for (int k2 = 0; k2 < 2; ++k2) if (2 * k2 < nkt) {
#pragma unroll
        for (int ct = 0; ct < NCT; ++ct) {
            const h4 lo = trrd(vbase + (32 * k2 + 4 * g + q_) * VSTR + (16 * ct + 4 * p_) * 2);
            const h4 hi = trrd(vbase + (32 * k2 + 16 + 4 * g + q_) * VSTR + (16 * ct + 4 * p_) * 2);
            const h8 vf = cat44(lo, hi);
#pragma unroll
            for (int qs = 0; qs < NQS; ++qs) o[qs][ct] = __builtin_amdgcn_mfma_f32_16x16x32_f16(vf, pf[qs][k2], o[qs][ct], 0, 0, 0); } }
    __builtin_amdgcn_sched_barrier(0);
}
template <int NKS, int NCT, int NQS, int KSTR, int VSTR>
DEVI void attn_tile(LAS unsigned char* kbase, LAS unsigned char* vbase, const h8 (&qf)[NQS][NKS], f4 (&o)[NQS][NCT], float (&mrow)[NQS], float (&lrow)[NQS], const int nkt, const int lane) {
    h8 pf[NQS][2];
    attn_qk<NKS, NCT, NQS, KSTR>(kbase, qf, o, mrow, lrow, pf, nkt, lane);
    attn_pv<NCT, NQS, VSTR>(vbase, o, pf, nkt, lane);
}

#ifndef PHM
#define PHM 0xFFFFFFFFu
#endif
#ifndef DBL
#define DBL 0u
#endif
#define NREP(k) (((DBL >> (k)) & 1u) ? 2 : 1)
__global__ void __launch_bounds__(512, 2) trunk_fwd(Params p) {
    extern __shared__ __attribute__((aligned(16))) unsigned char shm_raw[];
    LAS unsigned char* lds = (LAS unsigned char*)shm_raw;
    __shared__ int s_item;
    cg::grid_group grid = cg::this_grid();
    const int wave_s = __builtin_amdgcn_readfirstlane((int)threadIdx.x >> 6);
#define PH_BEGIN \
    int tid = wave_s * 64 + opaque_lane(); asm volatile("" : "+v"(tid)); \
    int bid = blockIdx.x, G = gridDim.x, lq = l; asm volatile("" : "+s"(bid), "+s"(G), "+s"(lq)); \
    const int lane = tid & 63, wave = __builtin_amdgcn_readfirstlane(tid >> 6); \
    const int gw = bid * 8 + wave, NGW = G * 8; const size_t gtid = (size_t)bid * 512 + tid, NGT = (size_t)G * 512; \
    const __attribute__((address_space(4))) Params* kp = (const __attribute__((address_space(4))) Params*)__builtin_amdgcn_kernarg_segment_ptr(); asm volatile("" : "+s"(kp)); \
    unsigned char* ws = kp->ws; float* out = kp->out; \
    (void)lane; (void)wave; (void)gw; (void)NGW; (void)gtid; (void)NGT; (void)out; (void)lq;
#define WSP(T, off) ((T*)(ws + (off)))
    for (int rep = 0; rep < NREP(0); ++rep) if (PHM & 1u) {
        int tid = wave_s * 64 + opaque_lane(); asm volatile("" : "+v"(tid));
        const int bid = blockIdx.x, G = gridDim.x, lane = tid & 63, wave = __builtin_amdgcn_readfirstlane(tid >> 6);
        const int gw = bid * 8 + wave, NGW = G * 8; const size_t gtid = (size_t)bid * 512 + tid, NGT = (size_t)G * 512;
        unsigned char* ws = p.ws;
        h16* xh = WSP(h16, W_XH); float* ropec = WSP(float, W_ROPE); float* ropes = ropec + NPOS * 16;
        for (size_t i = gtid; i < (size_t)MT * DM / 8; i += NGT) { const size_t e = i * 8; const float* src = e < (size_t)MP * DM ? p.in[0] + e : p.in[1] + (e - (size_t)MP * DM);
            *(h8*)(xh + e) = pack8(*(const f4*)src, *(const f4*)(src + 4)); }
        for (size_t i = gtid; i < (size_t)NPOS * 16; i += NGT) { const int pi = (int)(i >> 4), fi = (int)(i & 15); const double pos = pi < SEQ ? (double)pi : (double)(PAST + pi - SEQ);
            const double ang = pos * exp(-(double)fi / 16.0 * 9.210340371976184); ropec[i] = (float)cos(ang); ropes[i] = (float)sin(ang); }
        for (size_t i = gtid; i < (size_t)DEPTH * 256; i += NGT) WSP(float, W_SP)[i] = log1pf(expf(-p.in[26][i]));
        LAS float* scr = (LAS float*)(lds + wave * 8448);
        for (int l = 0; l < DEPTH; ++l) {
            h16* wt_in = WSP(h16, W_WIN + l * SZ_WIN); h16* wt_uq = WSP(h16, W_WUQ + l * SZ_WUQ); h16* wt_kv = WSP(h16, W_WKV + l * SZ_WKV);
            h16* wt_o = WSP(h16, W_WO + l * SZ_WO); h16* wt_os = WSP(h16, W_WOS + l * SZ_WOS); h16* wt_up = WSP(h16, W_WUP + l * SZ_WUP); h16* wt_dn = WSP(h16, W_WDN + l * SZ_WDN);
            h16* wt_ql = WSP(h16, W_WQL + l * SZ_WQL); h16* wt_g = WSP(h16, W_WG + l * SZ_WG);
            const float* w_in = p.in[11] + (size_t)l * DM * DIN; const float* w_o = p.in[12] + (size_t)l * DM * DM; const float* w_uq = p.in[16] + (size_t)l * 384 * 768;
            const float* w_uk = p.in[18] + (size_t)l * 256 * 512; const float* w_uv = p.in[19] + (size_t)l * 256 * 512; const float* w_up = p.in[27] + (size_t)l * DM * DFF2; const float* w_dn = p.in[30] + (size_t)l * DFF * DM;
            const float* w_r = p.in[22] + (size_t)l * 4 * 64 * 64; const float* w_i = p.in[24] + (size_t)l * 4 * 64 * 64;
            for (int it = gw; it < 16 * 53; it += NGW) transpose_item<0>(w_in, DIN, 53, wt_in, 1024, scr, it, lane);
            for (int it = gw; it < 6 * 24; it += NGW) transpose_item<1>(w_uq, 768, 24, wt_uq, 384, scr, it, lane);
            for (int it = gw; it < 4 * 16; it += NGW) transpose_item<0>(w_uk, 512, 16, wt_kv, 256, scr, it, lane);
            for (int it = gw; it < 4 * 16; it += NGW) transpose_item<0>(w_uv, 512, 16, wt_kv + 512 * 256, 256, scr, it, lane);
            for (int it = gw; it < 16 * 32; it += NGW) transpose_item<0>(w_o, 1024, 32, wt_o, 1024, scr, it, lane);
            for (int it = gw; it < 4 * 32; it += NGW) transpose_item<0>(w_o, 1024, 32, wt_os, CSW, scr, it, lane);
            for (int it = gw; it < 4 * 32; it += NGW) transpose_item<0>(w_o + (size_t)768 * 1024, 1024, 32, wt_os + 2304, CSW, scr, it, lane);
            for (int it = gw; it < 16 * 176; it += NGW) transpose_item<0>(w_up, DFF2, 176, wt_up, 1024, scr, it, lane);
            for (int it = gw; it < 44 * 32; it += NGW) transpose_item<0>(w_dn, 1024, 32, wt_dn, DFF, scr, it, lane);
            for (size_t i = gtid; i < (size_t)(ZW - DIN) * 1024 / 8; i += NGT) *(h8*)(wt_in + (size_t)DIN * 1024 + i * 8) = (h8){0, 0, 0, 0, 0, 0, 0, 0};
            for (size_t i = gtid; i < (size_t)512 * 256; i += NGT) { const int n = (int)(i >> 8), k = (int)(i & 255); const int pn = n >> 8, jj = n & 127, isI = (n >> 7) & 1, ch = pn * 128 + jj;
                float v = 0.f; if ((k >> 6) == (ch >> 6)) v = (isI ? w_i : w_r)[((ch >> 6) * 64 + (k & 63)) * 64 + (ch & 63)];
                wt_g[i] = (h16)v; }
            for (size_t i = gtid; i < (size_t)2048 * 384; i += NGT) { const int n = (int)(i / 384), k = (int)(i % 384), hh = n >> 8, c = n & 255;
                const float* a = w_uq + (size_t)k * 768 + hh * 96; const float* b = w_uk + (size_t)c * 512 + hh * 64; float s = 0.f;
#pragma unroll 8
                for (int d = 0; d < 64; ++d) s += a[d] * b[d];
                wt_ql[i] = (h16)s; }
            for (size_t i = gtid; i < (size_t)2048 * 1024; i += NGT) { const int kk = (int)(i & 2047), n = (int)(i >> 11), hh = kk >> 8, c = kk & 255;
                const float* a = w_uv + (size_t)c * 512 + hh * 64; const float* b = w_o + (size_t)(256 + hh * 64) * 1024 + n; float s = 0.f;
#pragma unroll 8
                for (int d = 0; d < 64; ++d) s += a[d] * b[(size_t)d * 1024];
                wt_os[(size_t)n * CSW + 256 + kk] = (h16)s; }
        }
    }
    grid.sync();

    for (int l = 0; l < DEPTH; ++l) {
        for (int rep = 0; rep < NREP(1); ++rep) if (PHM & (1u << 1)) { PH_BEGIN
          Gemm g{WSP(h16, W_XH), WSP(h16, W_WIN + lq * SZ_WIN), MT, ZW, 1024, 1024, 1024}; StaticOrder S; S.init(MT, ZW, G, bid); EpiZ E{WSP(h16, W_Z), out + O_SV + (size_t)lq * MS * 256}; gemm_phase(lds, g, S, E, tid); }
        grid.sync();

        for (int rep = 0; rep < NREP(2); ++rep) if (PHM & (1u << 2)) { PH_BEGIN
            const float* qn_g = kp->in[15] + lq * 384; const float* kvn_g = kp->in[17] + lq * 256;
            const float* cw = kp->in[20] + (size_t)lq * 4 * 256; const float* cb = kp->in[21] + lq * 256; const float* stc = kp->in[5] + (size_t)lq * DBATCH * 3 * 256;
            const h16* z = WSP(h16, W_Z); h16* cqn = WSP(h16, W_CQN); h16* ckvn = WSP(h16, W_CKVN); h16* knew = WSP(h16, W_KNEW); h16* kb = WSP(h16, W_K); h16* xc = WSP(h16, W_XC);
            const float* ropec = WSP(float, W_ROPE); const float* ropes = ropec + NPOS * 16;
            for (int row = gw; row < MT; row += NGW) {
                const h16* zr = z + (size_t)row * ZW; const bool samp = row >= MP; const int rs = row - MP;
                const int t = samp ? (rs & 31) : (row & (SEQ - 1)), bb = samp ? (rs >> 5) : (row >> 11);
                { float v[6]; float ss = 0.f;
#pragma unroll
                    for (int i = 0; i < 3; ++i) { const h2 x = *(const h2*)(zr + 512 + 2 * lane + 128 * i); v[2 * i] = (float)x[0]; v[2 * i + 1] = (float)x[1]; ss += v[2 * i] * v[2 * i] + v[2 * i + 1] * v[2 * i + 1]; }
                    const float rr = rsqrtf(wave_sum(ss, lane) * (1.f / 384.f) + 1e-6f);
#pragma unroll
                    for (int i = 0; i < 3; ++i) { const int c = 2 * lane + 128 * i; h2 o; o[0] = (h16)(v[2 * i] * rr * qn_g[c]); o[1] = (h16)(v[2 * i + 1] * rr * qn_g[c + 1]); *(h2*)(cqn + (size_t)row * 384 + c) = o; } }
                { const h4 x = *(const h4*)(zr + 896 + 4 * lane); f4 v; float ss = 0.f;
#pragma unroll
                    for (int e = 0; e < 4; ++e) { v[e] = (float)x[e]; ss += v[e] * v[e]; }
                    const float rr = rsqrtf(wave_sum(ss, lane) * (1.f / 256.f) + 1e-6f); const f4 gg = *(const f4*)(kvn_g + 4 * lane); v = v * rr * gg;
                    if (!samp) { *(f4*)(out + O_PLAT + ((size_t)lq * MP + row) * 256 + 4 * lane) = v; *(h4*)(ckvn + (size_t)row * 256 + 4 * lane) = pack4(v); }
                    else { *(f4*)(out + O_SLAT + ((size_t)lq * MS + rs) * 256 + 4 * lane) = v; *(h4*)(knew + (size_t)rs * KNW + 4 * lane) = pack4(v); } }
                if (lane < 16) { const int pidx = samp ? SEQ + t : t; const float c = ropec[pidx * 16 + lane], s = ropes[pidx * 16 + lane];
                    const float x1 = (float)zr[1152 + lane], x2 = (float)zr[1168 + lane], o1 = x1 * c - x2 * s, o2 = x1 * s + x2 * c;
                    if (!samp) { float* o = out + O_PKR + ((size_t)lq * MP + row) * 32; o[lane] = o1; o[16 + lane] = o2;
                        h16* kr = kb + (size_t)row * KW + 64;
#pragma unroll
                        for (int hh = 0; hh < 8; ++hh) { kr[hh * 96 + lane] = (h16)o1; kr[hh * 96 + 16 + lane] = (h16)o2; } }
                    else { float* o = out + O_SKR + ((size_t)lq * MS + rs) * 32; o[lane] = o1; o[16 + lane] = o2; knew[(size_t)rs * KNW + 256 + lane] = (h16)o1; knew[(size_t)rs * KNW + 272 + lane] = (h16)o2; } }
                { const int c = 4 * lane; f4 accv = *(const f4*)(cb + c);
#pragma unroll
                    for (int j = 0; j < 4; ++j) { const int tau = t - 3 + j; f4 xv;
                        if (tau >= 0) { const h4 x = *(const h4*)(zr - (ptrdiff_t)(3 - j) * ZW + 1184 + c); xv = (f4){(float)x[0], (float)x[1], (float)x[2], (float)x[3]}; }
                        else if (samp) xv = *(const f4*)(stc + ((size_t)bb * 3 + (3 + tau)) * 256 + c);
                        else xv = (f4){0.f, 0.f, 0.f, 0.f};
                        accv += xv * *(const f4*)(cw + j * 256 + c);
                        if (j == 3) { const int T = samp ? DSEQ : SEQ; if (t >= T - 3) { float* o = samp ? out + O_SLC + (((size_t)lq * DBATCH + bb) * 3 + (t - (T - 3))) * 256 : out + O_PLC + (((size_t)lq * NB + bb) * 3 + (t - (T - 3))) * 256; *(f4*)(o + c) = xv; } } }
                    *(h4*)(xc + (size_t)row * 256 + c) = pack4(accv); }
            }
        }
        grid.sync();

        for (int rep = 0; rep < NREP(3); ++rep) if (PHM & (1u << 3)) { PH_BEGIN
          Gemm g{WSP(h16, W_CQN), WSP(h16, W_WUQ + lq * SZ_WUQ), MT, 768, 384, 384, 384}; StaticOrder S; S.init(MT, 768, G, bid);
          EpiQ E{WSP(h16, W_Q), WSP(h16, W_QLAT), WSP(float, W_ROPE), WSP(float, W_ROPE) + NPOS * 16}; gemm_phase(lds, g, S, E, tid); }
        for (int rep = 0; rep < NREP(4); ++rep) if (PHM & (1u << 4)) { PH_BEGIN
          Gemm g{WSP(h16, W_CKVN), WSP(h16, W_WKV + lq * SZ_WKV), MP, 1024, 256, 256, 256}; StaticOrder S; S.init(MP, 1024, G, (bid + G - (396 % G)) % G); EpiKV E{WSP(h16, W_K), WSP(h16, W_V)}; gemm_phase(lds, g, S, E, tid); }
        for (int rep = 0; rep < NREP(5); ++rep) if (PHM & (1u << 5)) { PH_BEGIN
          Gemm g{WSP(h16, W_XC), WSP(h16, W_WG + lq * SZ_WG), MT, 512, 256, 256, 256}; StaticOrder S; S.init(MT, 512, G, (bid + G - (908 % G)) % G);
          EpiGate E{WSP(h16, W_XC), WSP(float, W_A), WSP(float, W_B), kp->in[23] + lq * 256, kp->in[25] + lq * 256, WSP(float, W_SP) + lq * 256}; gemm_phase(lds, g, S, E, tid); }
        for (int rep = 0; rep < NREP(6); ++rep) if (PHM & (1u << 6)) { PH_BEGIN
          Gemm g{WSP(h16, W_CQN) + (size_t)MP * 384, WSP(h16, W_WQL + lq * SZ_WQL), MS, 2048, 384, 384, 384}; StaticOrder S; S.init(MS, 2048, G, (bid + G - (1172 % G)) % G); EpiQlat E{WSP(h16, W_QLAT)}; gemm_phase(lds, g, S, E, tid); }
        for (int rep = 0; rep < NREP(7); ++rep) if (PHM & (1u << 7)) { PH_BEGIN
            const float* gw_s = kp->in[13] + (size_t)lq * 4 * 128 * 128; const float* gb_s = kp->in[14] + (size_t)lq * 4 * 128;
            const h16* z = WSP(h16, W_Z); h16* cat = WSP(h16, W_CAT); h16* cats = WSP(h16, W_CATS);
            const int fr = lane & 15, g4 = lane >> 4, q_ = fr >> 2, p_ = fr & 3;
            for (int item = (bid + G - (1204 % G)) % G; item < 1024 + 128; item += G) {
                const bool samp = item >= 1024; const int head = item & 3; const int ci = samp ? (item - 1024) >> 2 : item >> 2;
                const int R0 = samp ? MP + ci * 32 : ci * 128, L = samp ? 32 : 128;
                __syncthreads();
                for (int id = tid; id < L * 8; id += 512) { const int j = id >> 3, part = id & 7; *(LAS h8*)(lds + j * 144 + part * 16) = *(const h8*)(z + (size_t)(R0 + j) * ZW + 256 + head * 64 + part * 8); }
                __syncthreads();
                const int i0 = 16 * wave;
                if (i0 < L) {
                    f4 sacc[4];
#pragma unroll
                    for (int ct = 0; ct < 4; ++ct) sacc[ct] = (f4){0.f, 0.f, 0.f, 0.f};
                    const int i = i0 + fr;
#pragma unroll
                    for (int ks = 0; ks < 4; ++ks) if (32 * ks <= i0 + 15 && 32 * ks < L) {
                        const int j0 = 32 * ks + 8 * g4; const float* wp = gw_s + ((size_t)head * 128 + i) * 128 + j0; const f4 w0 = *(const f4*)wp, w1 = *(const f4*)(wp + 4);
                        h8 wf;
#pragma unroll
                        for (int e = 0; e < 4; ++e) { wf[e] = (h16)((j0 + e <= i) ? w0[e] : 0.f); wf[4 + e] = (h16)((j0 + 4 + e <= i) ? w1[e] : 0.f); }
#pragma unroll
                        for (int ct = 0; ct < 4; ++ct) { const h4 lo = trrd(lds + (32 * ks + 8 * g4 + q_) * 144 + (16 * ct + 4 * p_) * 2), hi = trrd(lds + (32 * ks + 8 * g4 + 4 + q_) * 144 + (16 * ct + 4 * p_) * 2);
                            sacc[ct] = __builtin_amdgcn_mfma_f32_16x16x32_f16(wf, cat44(lo, hi), sacc[ct], 0, 0, 0); } }
#pragma unroll
                    for (int jx = 0; jx < 4; ++jx) { const int ii = i0 + 4 * g4 + jx; const float bs = gb_s[head * 128 + ii]; const size_t r = (size_t)R0 + ii;
#pragma unroll
                        for (int ct = 0; ct < 4; ++ct) { const int d = head * 64 + 16 * ct + fr; const float uval = (float)z[r * ZW + d]; const h16 o = (h16)(uval * (sacc[ct][jx] + bs));
                            if (!samp) cat[r * 1024 + d] = o; else cats[(r - MP) * CSW + d] = o; } }
                }
            }
            __syncthreads();
        }
        grid.sync();

        for (int rep = 0; rep < NREP(8); ++rep) if (PHM & (1u << 8)) { PH_BEGIN
            unsigned* counter = WSP(unsigned, W_CTR) + lq * 16 + rep * 8;
            const int fr = lane & 15, g4 = lane >> 4;
            constexpr int N_SA = 64, N_PA = 1024, N_PS = 128, N_SS = 16, N_ALL = N_SA + N_PA + N_PS + N_SS;
            for (;;) {
                __syncthreads();
                if (tid == 0) s_item = (int)atomicAdd(counter, 1u);
                __syncthreads();
                const int item = s_item;
                if (item >= N_ALL) break;
                if (item < N_SA) {
                    constexpr int KS = 592;
                    const float* clat = kp->in[2] + (size_t)lq * DBATCH * PAST * 256; const float* ckr = kp->in[3] + (size_t)lq * DBATCH * PAST * 32;
                    const h16* qlat = WSP(h16, W_QLAT); const h16* knew = WSP(h16, W_KNEW); h16* cats = WSP(h16, W_CATS);
                    const int b = item >> 1, hg = item & 1, head = 4 * hg + (wave >> 1), tq = 16 * (wave & 1) + fr;
                    h8 qf[1][9];
#pragma unroll
                    for (int ks = 0; ks < 9; ++ks) qf[0][ks] = *(const h8*)(qlat + (size_t)(b * 32 + tq) * QLW + head * 288 + 32 * ks + 8 * g4);
                    f4 o[1][16]; float mrow[1] = {-1e30f}, lrow[1] = {0.f};
#pragma unroll
                    for (int ct = 0; ct < 16; ++ct) o[0][ct] = (f4){0.f, 0.f, 0.f, 0.f};
                    const float* lb = clat + (size_t)b * PAST * 256 + (size_t)(tid >> 6) * 256 + (tid & 63) * 4; const float* rb = ckr + (size_t)b * PAST * 32 + (size_t)(tid >> 3) * 32 + (tid & 7) * 4;
                    const int wl = (tid >> 6) * KS + (tid & 63) * 8, wr_ = (tid >> 3) * KS + 512 + (tid & 7) * 8;
                    f4 pl[4]; f4 pr;
#pragma unroll
                    for (int hf = 0; hf < 2; ++hf) {
#pragma unroll
                        for (int i = 0; i < 4; ++i) pl[i] = *(const f4*)(lb + (size_t)(hf * 4 + i) * 8 * 256);
#pragma unroll
                        for (int i = 0; i < 4; ++i) *(LAS h4*)(lds + wl + (hf * 4 + i) * 8 * KS) = pack4(pl[i]); }
                    pr = *(const f4*)rb;
                    *(LAS h4*)(lds + wr_) = pack4(pr);
                    __syncthreads();
                    for (int t = 0; t < 64; ++t) {
                        LAS unsigned char* cur = lds + (t & 1) * (64 * KS); LAS unsigned char* nxt = lds + ((t + 1) & 1) * (64 * KS);
                        const bool more = t + 1 < 64;
                        if (more) {
#pragma unroll
                            for (int i = 0; i < 4; ++i) pl[i] = *(const f4*)(lb + ((size_t)(t + 1) * 64 + i * 8) * 256);
                            pr = *(const f4*)(rb + (size_t)(t + 1) * 64 * 32);
                        }
                        h8 pf[1][2];
                        attn_qk<9, 16, 1, KS>(cur, qf, o, mrow, lrow, pf, 4, lane);
                        if (more) {
#pragma unroll
                            for (int i = 0; i < 4; ++i) *(LAS h4*)(nxt + wl + i * 8 * KS) = pack4(pl[i]);
                            *(LAS h4*)(nxt + wr_) = pack4(pr);
#pragma unroll
                            for (int i = 0; i < 4; ++i) pl[i] = *(const f4*)(lb + ((size_t)(t + 1) * 64 + (4 + i) * 8) * 256);
                        }
                        attn_pv<16, 1, KS>(cur, o, pf, 4, lane);
                        if (more) {
#pragma unroll
                            for (int i = 0; i < 4; ++i) *(LAS h4*)(nxt + wl + (4 + i) * 8 * KS) = pack4(pl[i]);
                        } else {
                            for (int id = tid; id < 32 * 36; id += 512) { const int key = id / 36, part = id % 36; *(LAS h8*)(nxt + key * KS + part * 16) = *(const h8*)(knew + (size_t)(b * 32 + key) * KNW + part * 8); }
                        }
                        __syncthreads();
                    }
                    attn_tile<9, 16, 1, KS, KS>(lds, lds, qf, o, mrow, lrow, 2, lane);
                    float lt = lrow[0]; lt += shx(lt, 16, lane); lt += shx(lt, 32, lane); const float inv = 1.f / lt;
                    h16* dst = cats + (size_t)(b * 32 + tq) * CSW + 256 + head * 256 + 4 * g4;
#pragma unroll
                    for (int ct = 0; ct < 16; ++ct) *(h4*)(dst + 16 * ct) = pack4(o[0][ct] * inv);
                } else if (item < N_SA + N_PA) {
                    constexpr int KS = 208, VS = 144, KBUF = 64 * KS, VBUF = 64 * VS;
                    const h16* qb = WSP(h16, W_Q); const h16* kb = WSP(h16, W_K); const h16* vb = WSP(h16, W_V); h16* cat = WSP(h16, W_CAT);
                    const int it = item - N_SA, qblk = 7 - (it >> 7), bh = it & 127, b = bh >> 3, head = bh & 7;
                    const int r0 = qblk * 256 + 32 * wave, ntw = (r0 >> 6) + 1, ntb = 4 * (qblk + 1);
                    h8 qf[2][3];
#pragma unroll
                    for (int qs = 0; qs < 2; ++qs)
#pragma unroll
                        for (int ks = 0; ks < 3; ++ks) qf[qs][ks] = *(const h8*)(qb + (size_t)(b * SEQ + r0 + 16 * qs + fr) * QW + head * 96 + 32 * ks + 8 * g4);
                    f4 o[2][4]; float mrow[2] = {-1e30f, -1e30f}, lrow[2] = {0.f, 0.f};
#pragma unroll
                    for (int qs = 0; qs < 2; ++qs)
#pragma unroll
                        for (int ct = 0; ct < 4; ++ct) o[qs][ct] = (f4){0.f, 0.f, 0.f, 0.f};
                    const int k0key = tid / 12, k0part = tid % 12, k1key = (tid + 512) / 12, k1part = (tid + 512) % 12, vkey = tid >> 3, vpart = tid & 7;
                    const h16* kg0 = kb + (size_t)b * SEQ * KW + head * 96 + (size_t)k0key * KW + k0part * 8; const h16* kg1 = kb + (size_t)b * SEQ * KW + head * 96 + (size_t)k1key * KW + k1part * 8;
                    const h16* vg = vb + (size_t)b * SEQ * VW + head * 64 + (size_t)vkey * VW + vpart * 8;
                    const int lk0 = k0key * KS + k0part * 16, lk1 = k1key * KS + k1part * 16, lv = 2 * KBUF + vkey * VS + vpart * 16;
                    h8 pk0, pk1 = (h8){0, 0, 0, 0, 0, 0, 0, 0}, pv;
                    pk0 = *(const h8*)kg0; if (tid < 256) pk1 = *(const h8*)kg1; pv = *(const h8*)vg;
                    *(LAS h8*)(lds + lk0) = pk0; if (tid < 256) *(LAS h8*)(lds + lk1) = pk1; *(LAS h8*)(lds + lv) = pv;
                    __syncthreads();
                    for (int t = 0; t < ntb; ++t) {
                        const int co = (t & 1), no = ((t + 1) & 1);
                        if (t + 1 < ntb) { const size_t ro = (size_t)(t + 1) * 64;
                            pk0 = *(const h8*)(kg0 + ro * KW); if (tid < 256) pk1 = *(const h8*)(kg1 + ro * KW); pv = *(const h8*)(vg + ro * VW); }
                        if (t < ntw) attn_tile<3, 4, 2, KS, VS>(lds + co * KBUF, lds + 2 * KBUF + co * VBUF, qf, o, mrow, lrow, 4, lane);
                        if (t + 1 < ntb) { *(LAS h8*)(lds + no * KBUF + lk0) = pk0; if (tid < 256) *(LAS h8*)(lds + no * KBUF + lk1) = pk1; *(LAS h8*)(lds + no * VBUF + lv) = pv; }
                        __syncthreads();
                    }
#pragma unroll
                    for (int qs = 0; qs < 2; ++qs) { float lt = lrow[qs]; lt += shx(lt, 16, lane); lt += shx(lt, 32, lane); const float inv = 1.f / lt;
                        h16* dst = cat + (size_t)(b * SEQ + r0 + 16 * qs + fr) * 1024 + 256 + head * 64 + 4 * g4;
#pragma unroll
                        for (int ct = 0; ct < 4; ++ct) *(h4*)(dst + 16 * ct) = pack4(o[qs][ct] * inv); }
                } else if (item < N_SA + N_PA + N_PS) {
                    const float* abuf = WSP(float, W_A); const float* bbuf = WSP(float, W_B); const h16* z = WSP(h16, W_Z); h16* cat = WSP(h16, W_CAT);
                    const int it = item - N_SA - N_PA, b = it >> 3, ch = (it & 7) * 32 + (tid & 31), seg = tid >> 5;
                    const size_t rbase = (size_t)b * SEQ + seg * 128;
                    float A = 1.f, B = 0.f;
#pragma unroll 4
                    for (int i = 0; i < 128; ++i) { const float a = abuf[(rbase + i) * 256 + ch], bb = bbuf[(rbase + i) * 256 + ch]; B = a * B + bb; A *= a; }
                    LAS float* sA = (LAS float*)lds; LAS float* sB = sA + 512;
                    sA[tid] = A; sB[tid] = B;
                    __syncthreads();
                    float h = 0.f;
                    for (int s2 = 0; s2 < seg; ++s2) h = sA[s2 * 32 + (tid & 31)] * h + sB[s2 * 32 + (tid & 31)];
#pragma unroll 4
                    for (int i = 0; i < 128; ++i) { const float a = abuf[(rbase + i) * 256 + ch], bb = bbuf[(rbase + i) * 256 + ch]; h = a * h + bb;
                        const float gt = (float)z[(rbase + i) * ZW + 1440 + ch]; cat[(rbase + i) * 1024 + 768 + ch] = (h16)(h * gt); }
                    if (seg == 15) out[O_PH + ((size_t)lq * NB + b) * 256 + ch] = h;
                } else {
                    const float* abuf = WSP(float, W_A); const float* bbuf = WSP(float, W_B); const h16* z = WSP(h16, W_Z); h16* cats = WSP(h16, W_CATS);
                    const int it = item - N_SA - N_PA - N_PS, idx = it * 512 + tid, b = idx >> 8, ch = idx & 255;
                    float h = kp->in[4][((size_t)lq * DBATCH + b) * 256 + ch];
                    for (int t = 0; t < DSEQ; ++t) { const size_t r = (size_t)MP + b * 32 + t; h = abuf[r * 256 + ch] * h + bbuf[r * 256 + ch];
                        const float gt = (float)z[r * ZW + 1440 + ch]; cats[(size_t)(b * 32 + t) * CSW + 2304 + ch] = (h16)(h * gt); }
                    out[O_SH + ((size_t)lq * DBATCH + b) * 256 + ch] = h;
                }
            }
        }
        grid.sync();

        for (int rep = 0; rep < NREP(9); ++rep) if (PHM & (1u << 9)) { PH_BEGIN
          const float* xres_s = lq == 0 ? kp->in[1] : out + O_Y + (size_t)MP * DM;
          Gemm g{WSP(h16, W_CATS), WSP(h16, W_WOS + lq * SZ_WOS), MS, 1024, CSW, CSW, CSW}; StaticOrder S; S.init(MS, 1024, G, bid); EpiRes E{xres_s, WSP(float, W_PRE) + (size_t)MP * DM}; gemm_phase(lds, g, S, E, tid); }
        for (int rep = 0; rep < NREP(10); ++rep) if (PHM & (1u << 10)) { PH_BEGIN
          const float* xres_p = lq == 0 ? kp->in[0] : out + O_Y;
          Gemm g{WSP(h16, W_CAT), WSP(h16, W_WO + lq * SZ_WO), MP, 1024, 1024, 1024, 1024}; StaticOrder S; S.init(MP, 1024, G - 16, bid - 16); EpiRes E{xres_p, WSP(float, W_PRE)}; gemm_phase(lds, g, S, E, tid); }
        grid.sync();

        for (int rep = 0; rep < NREP(11); ++rep) if (PHM & (1u << 11)) { PH_BEGIN
            const float* gg = kp->in[7] + lq * DM; const float* bb = kp->in[8] + lq * DM; const float* pre = WSP(float, W_PRE); float* x1f = WSP(float, W_X1F); h16* xh = WSP(h16, W_XH);
            for (int row0 = gw; row0 < MT; row0 += 2 * NGW) { f4 v[2][4]; float s[2], s2[2]; const bool ok1 = row0 + NGW < MT;
#pragma unroll
                for (int u = 0; u < 2; ++u) { const int row = (u == 0 || ok1) ? row0 + u * NGW : row0; const float* pr = pre + (size_t)row * DM; s[u] = 0.f;
#pragma unroll
                    for (int j = 0; j < 4; ++j) { v[u][j] = *(const f4*)(pr + 4 * lane + 256 * j); s[u] += (v[u][j][0] + v[u][j][1]) + (v[u][j][2] + v[u][j][3]); } }
#pragma unroll
                for (int o = 1; o < 64; o <<= 1) { s[0] += shx(s[0], o, lane); s[1] += shx(s[1], o, lane); }
#pragma unroll
                for (int u = 0; u < 2; ++u) { const float mean = s[u] * (1.f / DM); s2[u] = 0.f;
#pragma unroll
                    for (int j = 0; j < 4; ++j) { v[u][j] = v[u][j] - mean; s2[u] += (v[u][j][0] * v[u][j][0] + v[u][j][1] * v[u][j][1]) + (v[u][j][2] * v[u][j][2] + v[u][j][3] * v[u][j][3]); } }
#pragma unroll
                for (int o = 1; o < 64; o <<= 1) { s2[0] += shx(s2[0], o, lane); s2[1] += shx(s2[1], o, lane); }
#pragma unroll
                for (int u = 0; u < 2; ++u) if (u == 0 || ok1) { const int row = row0 + u * NGW; const float rstd = rsqrtf(s2[u] * (1.f / DM) + 1e-5f);
#pragma unroll
                    for (int j = 0; j < 4; ++j) { const int c = 4 * lane + 256 * j; const f4 y = v[u][j] * rstd * *(const f4*)(gg + c) + *(const f4*)(bb + c);
                        *(f4*)(x1f + (size_t)row * DM + c) = y; *(h4*)(xh + (size_t)row * DM + c) = pack4(y); } } }
        }
        grid.sync();

        for (int rep = 0; rep < NREP(12); ++rep) if (PHM & (1u << 12)) { PH_BEGIN
          Gemm g{WSP(h16, W_XH), WSP(h16, W_WUP + lq * SZ_WUP), MT, DFF2, 1024, 1024, 1024}; StaticOrder S; S.init(MT, DFF2, G, bid);
          EpiUp E{WSP(h16, W_UP), out + O_PFC + (size_t)lq * NB * 2 * DFF2, (O_SFC + (size_t)lq * DBATCH * 2 * DFF2) - (O_PFC + (size_t)lq * NB * 2 * DFF2)}; gemm_phase(lds, g, S, E, tid); }
        grid.sync();

        for (int rep = 0; rep < NREP(13); ++rep) if (PHM & (1u << 13)) { PH_BEGIN
            const float* fw = kp->in[28] + (size_t)lq * 3 * DFF2; const float* fb = kp->in[29] + (size_t)lq * DFF2; const float* stf = kp->in[6] + (size_t)lq * DBATCH * 2 * DFF2;
            const h16* up = WSP(h16, W_UP); h16* act = WSP(h16, W_ACT);
            constexpr int RSEG = 32, NCG = DFF / 8;
            for (unsigned it = (unsigned)gtid; it < (unsigned)(NCG * (MT / RSEG)); it += (unsigned)NGT) { const int seg = (int)(it / (unsigned)NCG), cg = (int)(it - (unsigned)seg * NCG), j0 = cg * 8, row0 = seg * RSEG;
                const bool samp = row0 >= MP; const int t0 = samp ? 0 : (row0 & (SEQ - 1)), bb = (row0 - MP) >> 5;
                const f4 bg0 = *(const f4*)(fb + j0), bg1 = *(const f4*)(fb + j0 + 4), bv0 = *(const f4*)(fb + DFF + j0), bv1 = *(const f4*)(fb + DFF + j0 + 4);
                f4 wg0[3], wg1[3], wv0[3], wv1[3];
#pragma unroll
                for (int j = 0; j < 3; ++j) { const float* wj = fw + (size_t)j * DFF2; wg0[j] = *(const f4*)(wj + j0); wg1[j] = *(const f4*)(wj + j0 + 4); wv0[j] = *(const f4*)(wj + DFF + j0); wv1[j] = *(const f4*)(wj + DFF + j0 + 4); }
                f4 ag0, ag1, av0, av1, bg0_, bg1_, bv0_, bv1_;
                if (t0 > 0) { const h16* u2 = up + (size_t)(row0 - 2) * DFF2; const h16* u1 = u2 + DFF2;
                    const h8 a = *(const h8*)(u2 + j0), c = *(const h8*)(u2 + DFF + j0), d = *(const h8*)(u1 + j0), e = *(const h8*)(u1 + DFF + j0);
                    ag0 = (f4){(float)a[0], (float)a[1], (float)a[2], (float)a[3]}; ag1 = (f4){(float)a[4], (float)a[5], (float)a[6], (float)a[7]};
                    av0 = (f4){(float)c[0], (float)c[1], (float)c[2], (float)c[3]}; av1 = (f4){(float)c[4], (float)c[5], (float)c[6], (float)c[7]};
                    bg0_ = (f4){(float)d[0], (float)d[1], (float)d[2], (float)d[3]}; bg1_ = (f4){(float)d[4], (float)d[5], (float)d[6], (float)d[7]};
                    bv0_ = (f4){(float)e[0], (float)e[1], (float)e[2], (float)e[3]}; bv1_ = (f4){(float)e[4], (float)e[5], (float)e[6], (float)e[7]}; }
                else if (samp) { const float* s2 = stf + (size_t)bb * 2 * DFF2; const float* s1 = s2 + DFF2;
                    ag0 = *(const f4*)(s2 + j0); ag1 = *(const f4*)(s2 + j0 + 4); av0 = *(const f4*)(s2 + DFF + j0); av1 = *(const f4*)(s2 + DFF + j0 + 4);
                    bg0_ = *(const f4*)(s1 + j0); bg1_ = *(const f4*)(s1 + j0 + 4); bv0_ = *(const f4*)(s1 + DFF + j0); bv1_ = *(const f4*)(s1 + DFF + j0 + 4); }
                else { ag0 = ag1 = av0 = av1 = bg0_ = bg1_ = bv0_ = bv1_ = (f4){0.f, 0.f, 0.f, 0.f}; }
                const h16* ur = up + (size_t)row0 * DFF2 + j0; h16* ar = act + (size_t)row0 * DFF + j0;
#pragma unroll 4
                for (int r = 0; r < RSEG; ++r) { const h8 a = *(const h8*)(ur + (size_t)r * DFF2), c = *(const h8*)(ur + (size_t)r * DFF2 + DFF);
                    const f4 cg0 = (f4){(float)a[0], (float)a[1], (float)a[2], (float)a[3]}, cg1 = (f4){(float)a[4], (float)a[5], (float)a[6], (float)a[7]};
                    const f4 cv0 = (f4){(float)c[0], (float)c[1], (float)c[2], (float)c[3]}, cv1 = (f4){(float)c[4], (float)c[5], (float)c[6], (float)c[7]};
                    const f4 g0 = bg0 + ag0 * wg0[0] + bg0_ * wg0[1] + cg0 * wg0[2], g1 = bg1 + ag1 * wg1[0] + bg1_ * wg1[1] + cg1 * wg1[2];
                    const f4 v0 = bv0 + av0 * wv0[0] + bv0_ * wv0[1] + cv0 * wv0[2], v1 = bv1 + av1 * wv1[0] + bv1_ * wv1[1] + cv1 * wv1[2];
                    h8 o;
#pragma unroll
                    for (int e = 0; e < 4; ++e) { o[e] = (h16)(gelu_f(g0[e]) * v0[e]); o[4 + e] = (h16)(gelu_f(g1[e]) * v1[e]); }
                    *(h8*)(ar + (size_t)r * DFF) = o;
                    ag0 = bg0_; ag1 = bg1_; av0 = bv0_; av1 = bv1_; bg0_ = cg0; bg1_ = cg1; bv0_ = cv0; bv1_ = cv1; } }
        }
        grid.sync();

        for (int rep = 0; rep < NREP(14); ++rep) if (PHM & (1u << 14)) { PH_BEGIN
          Gemm g{WSP(h16, W_ACT), WSP(h16, W_WDN + lq * SZ_WDN), MT, 1024, DFF, DFF, DFF}; StaticOrder S; S.init(MT, 1024, G, bid); EpiRes E{WSP(float, W_X1F), WSP(float, W_PRE)}; gemm_phase(lds, g, S, E, tid); }
        grid.sync();

        for (int rep = 0; rep < NREP(15); ++rep) if (PHM & (1u << 15)) { PH_BEGIN
            const float* gg = kp->in[9] + lq * DM; const float* bb = kp->in[10] + lq * DM; const float* pre = WSP(float, W_PRE); h16* xh = WSP(h16, W_XH);
            for (int row0 = gw; row0 < MT; row0 += 2 * NGW) { f4 v[2][4]; float s[2], s2[2]; const bool ok1 = row0 + NGW < MT;
#pragma unroll
                for (int u = 0; u < 2; ++u) { const int row = (u == 0 || ok1) ? row0 + u * NGW : row0; const float* pr = pre + (size_t)row * DM; s[u] = 0.f;
#pragma unroll
                    for (int j = 0; j < 4; ++j) { v[u][j] = *(const f4*)(pr + 4 * lane + 256 * j); s[u] += (v[u][j][0] + v[u][j][1]) + (v[u][j][2] + v[u][j][3]); } }
#pragma unroll
                for (int o = 1; o < 64; o <<= 1) { s[0] += shx(s[0], o, lane); s[1] += shx(s[1], o, lane); }
#pragma unroll
                for (int u = 0; u < 2; ++u) { const float mean = s[u] * (1.f / DM); s2[u] = 0.f;
#pragma unroll
                    for (int j = 0; j < 4; ++j) { v[u][j] = v[u][j] - mean; s2[u] += (v[u][j][0] * v[u][j][0] + v[u][j][1] * v[u][j][1]) + (v[u][j][2] * v[u][j][2] + v[u][j][3] * v[u][j][3]); } }
#pragma unroll
                for (int o = 1; o < 64; o <<= 1) { s2[0] += shx(s2[0], o, lane); s2[1] += shx(s2[1], o, lane); }
#pragma unroll
                for (int u = 0; u < 2; ++u) if (u == 0 || ok1) { const int row = row0 + u * NGW; const float rstd = rsqrtf(s2[u] * (1.f / DM) + 1e-5f);
#pragma unroll
                    for (int j = 0; j < 4; ++j) { const int c = 4 * lane + 256 * j; const f4 y = v[u][j] * rstd * *(const f4*)(gg + c) + *(const f4*)(bb + c);
                        *(f4*)(out + O_Y + (size_t)row * DM + c) = y; *(h4*)(xh + (size_t)row * DM + c) = pack4(y); } } }
        }
        grid.sync();
    }
}

extern "C" void kernel_launch(void* const* d_in, const int* in_sizes, int n_in, void* d_out, int out_size, void* d_ws, size_t ws_size, hipStream_t stream) {
    constexpr size_t kDynLds = STAGE_BYTES;
    static int grid_blocks = 0;
    if (!grid_blocks) {
        if (n_in != 31 || (size_t)out_size != O_END || ws_size < W_END) { fprintf(stderr, "kernel_launch: unexpected shapes n_in %d out %d ws %zu (need %zu)\n", n_in, out_size, ws_size, (size_t)W_END); grid_blocks = -1; return; }
        int dev = 0, cus = 0, per_cu = 0;
        hipGetDevice(&dev);
        hipDeviceGetAttribute(&cus, hipDeviceAttributeMultiprocessorCount, dev);
        hipFuncSetAttribute((const void*)trunk_fwd, hipFuncAttributeMaxDynamicSharedMemorySize, (int)kDynLds);
        hipOccupancyMaxActiveBlocksPerMultiprocessor(&per_cu, (const void*)trunk_fwd, 512, kDynLds);
        if (per_cu < 1) per_cu = 1;
        grid_blocks = cus * per_cu;
        if (grid_blocks > 256) grid_blocks = 256;
        if (grid_blocks < 32) { fprintf(stderr, "kernel_launch: grid %d too small\n", grid_blocks); grid_blocks = -1; return; }
    }
    if (grid_blocks < 0) return;
    hipMemsetAsync((char*)d_ws + W_CTR, 0, 4096, stream);
    Params p{};
    for (int i = 0; i < 31; ++i) p.in[i] = (const float*)d_in[i];
    p.out = (float*)d_out; p.ws = (unsigned char*)d_ws;
    void* args[] = {&p};
    hipError_t e = hipLaunchCooperativeKernel((const void*)trunk_fwd, dim3(grid_blocks), dim3(512), args, kDynLds, stream);
    if (e != hipSuccess) fprintf(stderr, "cooperative launch failed: %s (grid %d)\n", hipGetErrorString(e), grid_blocks);
}
```

```cpp
#include <hip/hip_runtime.h>
#include <hip/hip_cooperative_groups.h>
#include <cstdio>
#include <cstdint>
namespace cg = cooperative_groups;

typedef _Float16 h16;
typedef _Float16 h8 __attribute__((ext_vector_type(8)));
typedef _Float16 h4 __attribute__((ext_vector_type(4)));
typedef _Float16 h2 __attribute__((ext_vector_type(2)));
typedef float f4 __attribute__((ext_vector_type(4)));
typedef short s4v __attribute__((__vector_size__(8)));
#define LAS __attribute__((address_space(3)))
#define DEVI __device__ __forceinline__

constexpr int DM = 1024, NB = 16, SEQ = 2048, DEPTH = 4, DBATCH = 32, DSEQ = 32, PAST = 4096;
constexpr int MP = NB * SEQ, MS = DBATCH * DSEQ, MT = MP + MS;
constexpr int DIN = 1696, ZW = 1792, DFF = 2816, DFF2 = 5632;
constexpr int QW = 768, KW = 768, VW = 512, QLW = 2304, CSW = 2560, KNW = 288;
constexpr float ALPHA = 1.681792830507429f;
constexpr float QSCALE = 0.14724444f;
constexpr int NPOS = SEQ + DSEQ;

constexpr size_t O_Y = 0;
constexpr size_t O_PLAT = (size_t)MT * DM;
constexpr size_t O_PKR = O_PLAT + (size_t)DEPTH * MP * 256;
constexpr size_t O_PH = O_PKR + (size_t)DEPTH * MP * 32;
constexpr size_t O_PLC = O_PH + (size_t)DEPTH * NB * 256;
constexpr size_t O_PFC = O_PLC + (size_t)DEPTH * NB * 3 * 256;
constexpr size_t O_SLAT = O_PFC + (size_t)DEPTH * NB * 2 * DFF2;
constexpr size_t O_SKR = O_SLAT + (size_t)DEPTH * MS * 256;
constexpr size_t O_SV = O_SKR + (size_t)DEPTH * MS * 32;
constexpr size_t O_SH = O_SV + (size_t)DEPTH * MS * 256;
constexpr size_t O_SLC = O_SH + (size_t)DEPTH * DBATCH * 256;
constexpr size_t O_SFC = O_SLC + (size_t)DEPTH * DBATCH * 3 * 256;
constexpr size_t O_END = O_SFC + (size_t)DEPTH * DBATCH * 2 * DFF2;

constexpr size_t al(size_t x) { return (x + 255) & ~(size_t)255; }
constexpr size_t W_CTR = 0;
constexpr size_t W_PARAMS = 2048;
constexpr size_t W_BAR = 4096;
constexpr size_t W_ROPE = 4096 + 16384;
constexpr size_t W_SP = al(W_ROPE + (size_t)NPOS * 16 * 2 * 4);
constexpr size_t W_WIN = al(W_SP + (size_t)DEPTH * 256 * 4);
constexpr size_t SZ_WIN = (size_t)ZW * 1024 * 2;
constexpr size_t W_WUQ = W_WIN + DEPTH * SZ_WIN;   constexpr size_t SZ_WUQ = (size_t)768 * 384 * 2;
constexpr size_t W_WQL = W_WUQ + DEPTH * SZ_WUQ;   constexpr size_t SZ_WQL = (size_t)2048 * 384 * 2;
constexpr size_t W_WKV = W_WQL + DEPTH * SZ_WQL;   constexpr size_t SZ_WKV = (size_t)1024 * 256 * 2;
constexpr size_t W_WG = W_WKV + DEPTH * SZ_WKV;    constexpr size_t SZ_WG = (size_t)512 * 256 * 2;
constexpr size_t W_WO = W_WG + DEPTH * SZ_WG;      constexpr size_t SZ_WO = (size_t)1024 * 1024 * 2;
constexpr size_t W_WOS = W_WO + DEPTH * SZ_WO;     constexpr size_t SZ_WOS = (size_t)1024 * CSW * 2;
constexpr size_t W_WUP = W_WOS + DEPTH * SZ_WOS;   constexpr size_t SZ_WUP = (size_t)DFF2 * 1024 * 2;
constexpr size_t W_WDN = W_WUP + DEPTH * SZ_WUP;   constexpr size_t SZ_WDN = (size_t)1024 * DFF * 2;
constexpr size_t W_XH = W_WDN + DEPTH * SZ_WDN;
constexpr size_t W_Z = W_XH + (size_t)MT * 1024 * 2;
constexpr size_t W_CQN = W_Z + (size_t)MT * ZW * 2;
constexpr size_t W_CKVN = W_CQN + (size_t)MT * 384 * 2;
constexpr size_t W_XC = W_CKVN + (size_t)MP * 256 * 2;
constexpr size_t W_Q = W_XC + (size_t)MT * 256 * 2;
constexpr size_t W_K = W_Q + (size_t)MP * QW * 2;
constexpr size_t W_V = W_K + (size_t)MP * KW * 2;
constexpr size_t W_A = W_V + (size_t)MP * VW * 2;
constexpr size_t W_B = W_A + (size_t)MT * 256 * 4;
constexpr size_t W_CAT = W_B + (size_t)MT * 256 * 4;
constexpr size_t W_CATS = W_CAT + (size_t)MP * 1024 * 2;
constexpr size_t W_QLAT = W_CATS + (size_t)MS * CSW * 2;
constexpr size_t W_KNEW = W_QLAT + (size_t)MS * QLW * 2;
constexpr size_t W_PRE = al(W_KNEW + (size_t)MS * KNW * 2);
constexpr size_t W_X1F = W_PRE + (size_t)MT * 1024 * 4;
constexpr size_t W_UP = W_X1F + (size_t)MT * 1024 * 4;
constexpr size_t W_ACT = W_UP + (size_t)MT * DFF2 * 2;
constexpr size_t W_END = W_ACT + (size_t)MT * DFF * 2;

struct Params { const float* in[31]; float* out; unsigned char* ws; };

DEVI float gelu_f(float x) { const float u = 1.5957691216057308f * (x + 0.044715f * x * x * x); return x / (1.f + __expf(-u)); }
DEVI float sigmoid_f(float x) { return 1.f / (1.f + __expf(-x)); }
DEVI h8 pack8(f4 a, f4 b) { h8 r; r[0] = (h16)a[0]; r[1] = (h16)a[1]; r[2] = (h16)a[2]; r[3] = (h16)a[3]; r[4] = (h16)b[0]; r[5] = (h16)b[1]; r[6] = (h16)b[2]; r[7] = (h16)b[3]; return r; }
DEVI h4 pack4(f4 a) { h4 r; r[0] = (h16)a[0]; r[1] = (h16)a[1]; r[2] = (h16)a[2]; r[3] = (h16)a[3]; return r; }
DEVI float shx(float v, int o, int lane) { return __builtin_bit_cast(float, __builtin_amdgcn_ds_bpermute((lane ^ o) << 2, __builtin_bit_cast(int, v))); }
DEVI float wave_sum(float v, int lane) {
#pragma unroll
    for (int o = 1; o < 64; o <<= 1) v += shx(v, o, lane);
    return v;
}
DEVI int opaque_lane() { unsigned ones = ~0u; asm volatile("" : "+s"(ones)); return (int)__builtin_amdgcn_mbcnt_hi(ones, __builtin_amdgcn_mbcnt_lo(ones, 0u)); }
DEVI h4 trrd(LAS unsigned char* p) { s4v r = __builtin_amdgcn_ds_read_tr16_b64_v4i16((LAS s4v*)p); return __builtin_bit_cast(h4, r); }
DEVI h8 cat44(h4 a, h4 b) { return __builtin_shufflevector(a, b, 0, 1, 2, 3, 4, 5, 6, 7); }

constexpr int BM = 256, BK = 64, HALF = 128, HTB = HALF * BK * 2, STAGE_BYTES = 8 * HTB, NXCD = 8, WGM = 8;
DEVI int lds_byte(int r, int c) { const int st = (r >> 4) * 2 + (c >> 5), rr = r & 15, cc = c & 31, ob = rr * 64 + cc * 2; return st * 1024 + (ob ^ (((ob >> 9) & 1) << 5)); }
DEVI void stage_rc(int b, int& R, int& C) { const int st = b / 1024, sb = b % 1024, swz = sb ^ (((sb >> 9) & 1) << 5); R = (st >> 1) * 16 + swz / 64; C = (st & 1) * 32 + (swz % 64) / 2; }
DEVI int perm32(int rho) { const int n = rho >> 4, i = rho & 15; return 8 * (i >> 2) + 4 * n + (i & 3); }
struct Unit { int pm, pn; };
struct Gemm { const h16* A; const h16* Bt; int M, N, K, lda, ldb; };
struct StaticOrder {
    int nM, nN, nwg, G, c;
    DEVI void init(int M, int N, int G_, int c_) { nM = M / BM; nN = N / BM; nwg = nM * nN; G = G_; c = c_; }
    DEVI bool next(int i, Unit& u) const {
        if (c < 0) return false;
        const long L = (long)i * G + c; if (L >= nwg) return false;
        int wgid = (int)L; { const int q = nwg / NXCD, r = nwg % NXCD, xcd = wgid % NXCD, off = wgid / NXCD; wgid = (xcd < r ? xcd * (q + 1) : r * (q + 1) + (xcd - r) * q) + off; }
        const int nig = WGM * nN, gid = wgid / nig, fm = gid * WGM, gsz = (nM - fm) < WGM ? (nM - fm) : WGM;
        u.pm = fm + ((wgid % nig) % gsz); u.pn = (wgid % nig) / gsz; return true;
    }
};
template <class Epi>
DEVI void gemm_phase(LAS unsigned char* lds, const Gemm g, const StaticOrder& S, const Epi& E, const int tid) {
    const int wid = __builtin_amdgcn_readfirstlane(tid >> 6), lane = tid & 63, wr = wid >> 2, wc = wid & 3, fr = lane & 15, fq = lane >> 4;
    const int K = g.K, nt = K / BK;
    unsigned voffA[2], voffB[2];
#pragma unroll
    for (int i = 0; i < 2; ++i) { int R, C; stage_rc(tid * 16 + i * 8192, R, C); const int Rb = Epi::PERM ? ((R & ~31) + perm32(R & 31)) : R;
        voffA[i] = (unsigned)(R * g.lda + C) * 2u; voffB[i] = (unsigned)(Rb * g.ldb + C) * 2u; }
    const size_t kstep = (size_t)(BK * 2);
    const size_t hstepA = (size_t)HALF * g.lda * 2, hstepB = (size_t)HALF * g.ldb * 2;
    const size_t tstepA = 2 * hstepA, tstepB = 2 * hstepB;
    const unsigned ldsw = (unsigned)wid * 1024u;
    const int aoff = lds_byte(wr * 64 + fr, fq * 8), boff = lds_byte(wc * 32 + fr, fq * 8);
#define PG8_SA(b, h) (((b) * 2 + (h)) * HTB)
#define PG8_SB(b, h) ((4 + (b) * 2 + (h)) * HTB)
#define PG8_STAGE(bufoff, gbase, voff) do { _Pragma("unroll") for (int _i = 0; _i < 2; ++_i) \
        __builtin_amdgcn_global_load_lds((const unsigned*)((const char*)(gbase) + (voff)[_i]), (LAS unsigned*)(lds + (bufoff) + ldsw + _i * 8192), 16, 0, 0); } while (0)
#define PG8_LDA(dst, b, h) do { _Pragma("unroll") for (int m = 0; m < 4; ++m) _Pragma("unroll") for (int k = 0; k < 2; ++k) dst[m][k] = *(const LAS h8*)(lds + PG8_SA(b, h) + aoff + m * 2048 + k * 1024); } while (0)
#define PG8_LDB(dst, b, h) do { _Pragma("unroll") for (int n = 0; n < 2; ++n) _Pragma("unroll") for (int k = 0; k < 2; ++k) dst[n][k] = *(const LAS h8*)(lds + PG8_SB(b, h) + boff + n * 2048 + k * 1024); } while (0)
#define PG8_MMA(ai, bj, At, Bt) do { __builtin_amdgcn_s_setprio(1); _Pragma("unroll") for (int m = 0; m < 4; ++m) _Pragma("unroll") for (int n = 0; n < 2; ++n) _Pragma("unroll") for (int k = 0; k < 2; ++k) \
        acc[ai][bj][m][n] = __builtin_amdgcn_mfma_f32_16x16x32_f16(Bt[n][k], At[m][k], acc[ai][bj][m][n], 0, 0, 0); __builtin_amdgcn_s_setprio(0); } while (0)
#define PG8_WAIT_V(n) asm volatile("s_waitcnt vmcnt(" #n ")" ::: "memory")
#define PG8_WAIT_L(n) asm volatile("s_waitcnt lgkmcnt(" #n ")" ::: "memory")
#define PG8_BAR __builtin_amdgcn_s_barrier()
#define PG8_SCHED __builtin_amdgcn_sched_barrier(0)
    Unit cur, nxt; int ui = 0;
    if (!S.next(0, cur)) return;
    f4 acc[2][2][4][2];
#pragma unroll
    for (int a = 0; a < 2; ++a)
#pragma unroll
        for (int b = 0; b < 2; ++b)
#pragma unroll
            for (int m = 0; m < 4; ++m)
#pragma unroll
                for (int n = 0; n < 2; ++n) acc[a][b][m][n] = (f4){0.f, 0.f, 0.f, 0.f};
    h8 At[4][2], B0[2][2], B1[2][2];
    const char* cA = (const char*)g.A + (size_t)cur.pm * tstepA; const char* cB = (const char*)g.Bt + (size_t)cur.pn * tstepB;
    PG8_STAGE(PG8_SB(0, 0), cB, voffB); PG8_STAGE(PG8_SA(0, 0), cA, voffA); PG8_STAGE(PG8_SB(0, 1), cB + hstepB, voffB); PG8_STAGE(PG8_SA(0, 1), cA + hstepA, voffA);
    if (wr == 1) PG8_BAR;
    PG8_WAIT_V(4); PG8_BAR;
    PG8_STAGE(PG8_SB(1, 0), cB + kstep, voffB); PG8_STAGE(PG8_SA(1, 0), cA + kstep, voffA); PG8_STAGE(PG8_SB(1, 1), cB + hstepB + kstep, voffB);
    PG8_WAIT_V(6); PG8_BAR;
    for (;;) {
        const bool has_next = S.next(ui + 1, nxt);
        const char* nA = has_next ? (const char*)g.A + (size_t)nxt.pm * tstepA : cA; const char* nB = has_next ? (const char*)g.Bt + (size_t)nxt.pn * tstepB : cB;
        for (int t = 0; t < nt; t += 2) {
            const bool last = (t == nt - 2);
            const char* a1 = cA + (size_t)(t + 1) * kstep;
            const char* a2 = last ? nA : cA + (size_t)(t + 2) * kstep; const char* b2 = last ? nB : cB + (size_t)(t + 2) * kstep;
            const char* a3 = a2 + kstep; const char* b3 = b2 + kstep;
            PG8_LDB(B0, 0, 0); PG8_SCHED; PG8_LDA(At, 0, 0); PG8_STAGE(PG8_SA(1, 1), a1 + hstepA, voffA);
            PG8_WAIT_L(8); PG8_BAR; PG8_WAIT_L(0); PG8_MMA(0, 0, At, B0); PG8_BAR; PG8_SCHED;
            PG8_LDB(B1, 0, 1); PG8_STAGE(PG8_SB(0, 0), b2, voffB);
            PG8_BAR; PG8_WAIT_L(0); PG8_MMA(0, 1, At, B1); PG8_BAR;
            PG8_LDA(At, 0, 1); PG8_STAGE(PG8_SA(0, 0), a2, voffA);
            PG8_BAR; PG8_WAIT_L(0); PG8_MMA(1, 0, At, B0); PG8_BAR; PG8_SCHED;
            PG8_STAGE(PG8_SB(0, 1), b2 + hstepB, voffB);
            PG8_WAIT_V(6); PG8_BAR; PG8_MMA(1, 1, At, B1); PG8_BAR;
            PG8_LDB(B0, 1, 0); PG8_SCHED; PG8_LDA(At, 1, 0); PG8_STAGE(PG8_SA(0, 1), a2 + hstepA, voffA);
            PG8_WAIT_L(8); PG8_BAR; PG8_WAIT_L(0); PG8_MMA(0, 0, At, B0); PG8_BAR; PG8_SCHED;
            PG8_LDB(B1, 1, 1); PG8_STAGE(PG8_SB(1, 0), b3, voffB);
            PG8_BAR; PG8_WAIT_L(0); PG8_MMA(0, 1, At, B1); PG8_BAR;
            PG8_LDA(At, 1, 1); PG8_STAGE(PG8_SA(1, 0), a3, voffA);
            PG8_BAR; PG8_WAIT_L(0); PG8_MMA(1, 0, At, B0); PG8_BAR; PG8_SCHED;
            PG8_STAGE(PG8_SB(1, 1), b3 + hstepB, voffB);
            PG8_WAIT_V(6); PG8_BAR; PG8_MMA(1, 1, At, B1); PG8_BAR;
        }
        { int t2 = tid; asm volatile("" : "+v"(t2)); const int l2 = t2 & 63; E(acc, cur, wr, wc, l2 & 15, l2 >> 4); }
        if (!has_next) break;
#pragma unroll
        for (int a = 0; a < 2; ++a)
#pragma unroll
            for (int b = 0; b < 2; ++b)
#pragma unroll
                for (int m = 0; m < 4; ++m)
#pragma unroll
                    for (int n = 0; n < 2; ++n) acc[a][b][m][n] = (f4){0.f, 0.f, 0.f, 0.f};
        cur = nxt; cA = nA; cB = nB; ++ui;
    }
    PG8_WAIT_V(0);
    if (wr == 0) PG8_BAR;
    PG8_BAR;
#undef PG8_SA
#undef PG8_SB
#undef PG8_STAGE
#undef PG8_LDA
#undef PG8_LDB
#undef PG8_MMA
#undef PG8_WAIT_V
#undef PG8_WAIT_L
#undef PG8_BAR
#undef PG8_SCHED
}

typedef f4 Acc[2][2][4][2];
#define EPI_ROWS for (int ai = 0; ai < 2; ++ai) _Pragma("unroll") for (int m = 0; m < 4; ++m)

struct EpiZ {
    static constexpr bool PERM = true;
    h16* z; float* sv;
    DEVI void operator()(const Acc& acc, const Unit& u, int wr, int wc, int fr, int fq) const {
#pragma unroll
        EPI_ROWS { const int row = u.pm * BM + ai * HALF + wr * 64 + m * 16 + fr;
#pragma unroll
            for (int bj = 0; bj < 2; ++bj) { const int col = u.pn * BM + bj * HALF + wc * 32 + fq * 8;
                f4 v0 = acc[ai][bj][m][0], v1 = acc[ai][bj][m][1];
                if (col < 512 || (col >= 1440 && col < 1696)) {
#pragma unroll
                    for (int e = 0; e < 4; ++e) { v0[e] = gelu_f(v0[e]); v1[e] = gelu_f(v1[e]); } }
                *(h8*)(z + (size_t)row * ZW + col) = pack8(v0, v1);
                if (row >= MP && col >= 256 && col < 512) { float* o = sv + (size_t)(row - MP) * 256 + (col - 256); *(f4*)o = v0; *(f4*)(o + 4) = v1; } } }
    }
};
struct EpiQ {
    static constexpr bool PERM = true;
    h16* q; h16* qlat; const float* ropec; const float* ropes;
    DEVI void operator()(const Acc& acc, const Unit& u, int wr, int wc, int fr, int fq) const {
        const bool samp = u.pm * BM >= MP;
        if (u.pn < 2) { if (samp) return;
#pragma unroll
            EPI_ROWS { const int row = u.pm * BM + ai * HALF + wr * 64 + m * 16 + fr;
#pragma unroll
                for (int bj = 0; bj < 2; ++bj) { const int col = u.pn * BM + bj * HALF + wc * 32 + fq * 8;
                    *(h8*)(q + (size_t)row * QW + (col >> 6) * 96 + (col & 63)) = pack8(acc[ai][bj][m][0] * QSCALE, acc[ai][bj][m][1] * QSCALE); } }
        } else {
            const int j = wc * 32 + fq * 8, head = j >> 4, i0 = j & 15;
#pragma unroll
            EPI_ROWS { const int row = u.pm * BM + ai * HALF + wr * 64 + m * 16 + fr;
                const int pidx = samp ? SEQ + ((row - MP) & 31) : (row & (SEQ - 1));
                const size_t po = samp ? (W_QLAT - W_Q) / 2 + (size_t)(row - MP) * QLW + head * 288 + 256 + i0 : (size_t)row * QW + head * 96 + 64 + i0;
#pragma unroll
                for (int n = 0; n < 2; ++n) { const f4 c0 = *(const f4*)(ropec + pidx * 16 + i0 + 4 * n), s0 = *(const f4*)(ropes + pidx * 16 + i0 + 4 * n);
                    const f4 a0 = acc[ai][0][m][n], b0 = acc[ai][1][m][n];
                    *(h4*)(q + po + 4 * n) = pack4((a0 * c0 - b0 * s0) * QSCALE); *(h4*)(q + po + 16 + 4 * n) = pack4((a0 * s0 + b0 * c0) * QSCALE); }
                asm volatile("" ::: "memory"); }
        }
    }
};
struct EpiKV {
    static constexpr bool PERM = true;
    h16* k; h16* v;
    DEVI void operator()(const Acc& acc, const Unit& u, int wr, int wc, int fr, int fq) const {
#pragma unroll
        EPI_ROWS { const int row = u.pm * BM + ai * HALF + wr * 64 + m * 16 + fr;
#pragma unroll
            for (int bj = 0; bj < 2; ++bj) { const int col = u.pn * BM + bj * HALF + wc * 32 + fq * 8; const h8 o = pack8(acc[ai][bj][m][0], acc[ai][bj][m][1]);
                if (u.pn < 2) *(h8*)(k + (size_t)row * KW + (col >> 6) * 96 + (col & 63)) = o; else *(h8*)(v + (size_t)row * VW + (col - 512)) = o; } }
    }
};
DEVI float one_minus_exp(float x) {
    const float pser = -x * (1.f + x * (0.5f + x * (0.16666667f + x * (0.041666668f + x * (0.0083333338f + x * 0.0013888889f)))));
    return x > -0.25f ? pser : 1.f - __expf(x);
}
struct EpiGate {
    static constexpr bool PERM = false;
    const h16* xc; float* a; float* b; const float* br; const float* bi; const float* sp;
    DEVI void operator()(const Acc& acc, const Unit& u, int wr, int wc, int fr, int fq) const {
#pragma unroll
        for (int n = 0; n < 2; ++n) { const int ch = u.pn * 128 + wc * 32 + n * 16 + fq * 4;
            const f4 vbr = *(const f4*)(br + ch), vbi = *(const f4*)(bi + ch), vsp = *(const f4*)(sp + ch) * -8.f;
#pragma unroll
            EPI_ROWS { const int row = u.pm * BM + ai * HALF + wr * 64 + m * 16 + fr;
                const h4 xv = *(const h4*)(xc + (size_t)row * 256 + ch); f4 oa, ob;
#pragma unroll
                for (int e = 0; e < 4; ++e) { const float r = sigmoid_f(acc[ai][0][m][n][e] + vbr[e]), ig = sigmoid_f(acc[ai][1][m][n][e] + vbi[e]);
                    const float la = r * vsp[e]; oa[e] = __expf(la); ob[e] = sqrtf(one_minus_exp(2.f * la)) * (ig * (float)xv[e]); }
                *(f4*)(a + (size_t)row * 256 + ch) = oa; *(f4*)(b + (size_t)row * 256 + ch) = ob;
                asm volatile("" ::: "memory"); } }
    }
};
struct EpiQlat {
    static constexpr bool PERM = true;
    h16* qlat;
    DEVI void operator()(const Acc& acc, const Unit& u, int wr, int wc, int fr, int fq) const {
#pragma unroll
        EPI_ROWS { const int row = u.pm * BM + ai * HALF + wr * 64 + m * 16 + fr;
#pragma unroll
            for (int bj = 0; bj < 2; ++bj) { const int c = bj * HALF + wc * 32 + fq * 8;
                *(h8*)(qlat + (size_t)row * QLW + u.pn * 288 + c) = pack8(acc[ai][bj][m][0] * QSCALE, acc[ai][bj][m][1] * QSCALE); } }
    }
};
struct EpiRes {
    static constexpr bool PERM = false;
    const float* xres; float* pre;
    DEVI void operator()(const Acc& acc, const Unit& u, int wr, int wc, int fr, int fq) const {
#pragma unroll
        EPI_ROWS { const int row = u.pm * BM + ai * HALF + wr * 64 + m * 16 + fr;
#pragma unroll
            for (int bj = 0; bj < 2; ++bj)
#pragma unroll
                for (int n = 0; n < 2; ++n) { const int col = u.pn * BM + bj * HALF + wc * 32 + n * 16 + fq * 4; const size_t o = (size_t)row * DM + col;
                    *(f4*)(pre + o) = *(const f4*)(xres + o) * ALPHA + acc[ai][bj][m][n]; } }
    }
};
struct EpiUp {
    static constexpr bool PERM = true;
    h16* up; float* pfc; size_t sdelta;
    DEVI void operator()(const Acc& acc, const Unit& u, int wr, int wc, int fr, int fq) const {
#pragma unroll
        EPI_ROWS { const int row = u.pm * BM + ai * HALF + wr * 64 + m * 16 + fr;
            bool has_st; size_t so;
            if (row < MP) { const int t = row & (SEQ - 1); has_st = t >= SEQ - 2; so = ((size_t)(row >> 11) * 2 + (t - (SEQ - 2))) * DFF2; }
            else { const int rs = row - MP, t = rs & 31; has_st = t >= DSEQ - 2; so = sdelta + ((size_t)(rs >> 5) * 2 + (t - (DSEQ - 2))) * DFF2; }
            float* st = pfc + so;
#pragma unroll
            for (int bj = 0; bj < 2; ++bj) { const int col = u.pn * BM + bj * HALF + wc * 32 + fq * 8;
                *(h8*)(up + (size_t)row * DFF2 + col) = pack8(acc[ai][bj][m][0], acc[ai][bj][m][1]);
                if (has_st) { *(f4*)(st + col) = acc[ai][bj][m][0]; *(f4*)(st + col + 4) = acc[ai][bj][m][1]; } } }
    }
};

template <int MODE>
DEVI void transpose_item(const float* W, int ldw, int nblk, h16* WT, int ldd, LAS float* scr, int item, int lane) {
    const int kb = item / nblk, nb = item % nblk, k0 = 64 * kb, n0 = 32 * nb;
    int nsrc = n0 + (lane & 31);
    if (MODE == 1) { const int n = nsrc; if (n < 512) nsrc = (n >> 6) * 96 + (n & 63); else if (n < 640) nsrc = ((n - 512) >> 4) * 96 + 64 + ((n - 512) & 15); else nsrc = ((n - 640) >> 4) * 96 + 80 + ((n - 640) & 15); }
#pragma unroll 8
    for (int i = 0; i < 32; ++i) { const int kk = 2 * i + (lane >> 5); scr[kk * 33 + (lane & 31)] = W[(size_t)(k0 + kk) * ldw + nsrc]; }
    __builtin_amdgcn_fence(__ATOMIC_RELEASE, "wavefront"); asm volatile("s_waitcnt lgkmcnt(0)" ::: "memory");
    const int c = lane & 7;
#pragma unroll
    for (int j = 0; j < 4; ++j) { const int n = (lane >> 3) + 8 * j; const LAS float* s = scr + (8 * c) * 33 + n;
        h8 o; o[0] = (h16)s[0 * 33]; o[1] = (h16)s[1 * 33]; o[2] = (h16)s[2 * 33]; o[3] = (h16)s[3 * 33]; o[4] = (h16)s[4 * 33]; o[5] = (h16)s[5 * 33]; o[6] = (h16)s[6 * 33]; o[7] = (h16)s[7 * 33];
        *(h8*)(WT + (size_t)(n0 + n) * ldd + k0 + 8 * c) = o; }
    asm volatile("s_waitcnt lgkmcnt(0)" ::: "memory");
}

template <int NKS, int NCT, int NQS, int KSTR>
DEVI void attn_qk(LAS unsigned char* kbase, const h8 (&qf)[NQS][NKS], f4 (&o)[NQS][NCT], float (&mrow)[NQS], float (&lrow)[NQS], h8 (&pf)[NQS][2], const int nkt, const int lane) {
    const int fr = lane & 15, g = lane >> 4;
    f4 s[NQS][4];
#pragma unroll
    for (int qs = 0; qs < NQS; ++qs)
#pragma unroll
        for (int kt = 0; kt < 4; ++kt) s[qs][kt] = (f4){-1e30f, -1e30f, -1e30f, -1e30f};
#pragma unroll
    for (int kt = 0; kt < 4; ++kt) if (kt < nkt) {
#pragma unroll
        for (int qs = 0; qs < NQS; ++qs) s[qs][kt] = (f4){0.f, 0.f, 0.f, 0.f};
#pragma unroll
        for (int ks = 0; ks < NKS; ++ks) { const h8 kf = *(const LAS h8*)(kbase + (kt * 16 + fr) * KSTR + ks * 64 + g * 16);
#pragma unroll
            for (int qs = 0; qs < NQS; ++qs) s[qs][kt] = __builtin_amdgcn_mfma_f32_16x16x32_f16(kf, qf[qs][ks], s[qs][kt], 0, 0, 0); } }
    __builtin_amdgcn_sched_barrier(0);
#pragma unroll
    for (int qs = 0; qs < NQS; ++qs) {
        float mx = -1e30f;
#pragma unroll
        for (int kt = 0; kt < 4; ++kt)
#pragma unroll
            for (int e = 0; e < 4; ++e) mx = fmaxf(mx, s[qs][kt][e]);
        mx = fmaxf(mx, shx(mx, 16, lane)); mx = fmaxf(mx, shx(mx, 32, lane));
        const float mnew = fmaxf(mrow[qs], mx), alpha = exp2f(mrow[qs] - mnew); mrow[qs] = mnew;
        float ps = 0.f;
#pragma unroll
        for (int kt = 0; kt < 4; ++kt)
#pragma unroll
            for (int e = 0; e < 4; ++e) { const float p = exp2f(s[qs][kt][e] - mnew); s[qs][kt][e] = p; ps += p; }
        lrow[qs] = lrow[qs] * alpha + ps;
#pragma unroll
        for (int ct = 0; ct < NCT; ++ct) o[qs][ct] *= alpha;
#pragma unroll
        for (int k2 = 0; k2 < 2; ++k2) pf[qs][k2] = pack8(s[qs][2 * k2], s[qs][2 * k2 + 1]);
    }
    __builtin_amdgcn_sched_barrier(0);
}
template <int NCT, int NQS, int VSTR>
DEVI void attn_pv(LAS unsigned char* vbase, f4 (&o)[NQS][NCT], const h8 (&pf)[NQS][2], const int nkt, const int lane) {
    const int fr = lane & 15, g = lane >> 4, q_ = fr >> 2, p_ = fr & 3;
#pragma unroll
    for (int k2 = 0; k2 < 2; ++k2) if (2 * k2 < nkt) {
#pragma unroll
        for (int ct = 0; ct < NCT; ++ct) {
            const h4 lo = trrd(vbase + (32 * k2 + 4 * g + q_) * VSTR + (16 * ct + 4 * p_) * 2);
            const h4 hi = trrd(vbase + (32 * k2 + 16 + 4 * g + q_) * VSTR + (16 * ct + 4 * p_) * 2);
            const h8 vf = cat44(lo, hi);
#pragma unroll
            for (int qs = 0; qs < NQS; ++qs) o[qs][ct] = __builtin_amdgcn_mfma_f32_16x16x32_f16(vf, pf[qs][k2], o[qs][ct], 0, 0, 0); } }
    __builtin_amdgcn_sched_barrier(0);
}
template <int NKS, int NCT, int NQS, int KSTR, int VSTR>
DEVI void attn_tile(LAS unsigned char* kbase, LAS unsigned char* vbase, const h8 (&qf)[NQS][NKS], f4 (&o)[NQS][NCT], float (&mrow)[NQS], float (&lrow)[NQS], const int nkt, const int lane) {
    h8 pf[NQS][2];
    attn_qk<NKS, NCT, NQS, KSTR>(kbase, qf, o, mrow, lrow, pf, nkt, lane);
    attn_pv<NCT, NQS, VSTR>(vbase, o, pf, nkt, lane);
}


#define XB_TMO      128
#define XB_XCNT(j)  (256  + 64 * (j))
#define XB_XSUB(j)  (1280 + 64 * (j))
#define XB_XGEN(j)  (2304 + 64 * (j))
#define XB_TOP      3328
#define XB_TOPGEN   3392
#define XCD_BAR_WORDS 3456
#define XB_SPIN_CAP (1u << 18)
DEVI unsigned xb_ld(unsigned* p)              { return __hip_atomic_load(p, __ATOMIC_RELAXED, __HIP_MEMORY_SCOPE_AGENT); }
DEVI unsigned xb_add(unsigned* p, unsigned v) { return __hip_atomic_fetch_add(p, v, __ATOMIC_RELAXED, __HIP_MEMORY_SCOPE_AGENT); }
DEVI unsigned xb_xcc_id() { return (unsigned)__builtin_amdgcn_s_getreg((3 << 11) | 20) & 0xFu; }
#define XB_SPIN(cond, bar) do { unsigned _sp = 0; while (cond) { __builtin_amdgcn_s_sleep(1); \
    if ((++_sp & 255u) == 0u) { if (xb_ld(&(bar)[XB_TMO])) break; if (_sp > XB_SPIN_CAP) { atomicAdd(&(bar)[XB_TMO], 1u); break; } } } } while (0)
DEVI void xb_complete(unsigned* bar, unsigned x, unsigned& nloc, unsigned& nx, unsigned G) {
    unsigned sum, cnt, mine, sp = 0u;
    for (;;) {
        sum = 0u; cnt = 0u; mine = 0u;
#pragma unroll
        for (unsigned j = 0; j < 16; ++j) { const unsigned c = xb_ld(&bar[XB_XCNT(j)]); sum += c; cnt += (c > 0u) ? 1u : 0u; mine = (j == x) ? c : mine; }
        if (sum == G) break;
        __builtin_amdgcn_s_sleep(1);
        if ((++sp & 255u) == 0u) { if (xb_ld(&bar[XB_TMO])) break; if (sp > XB_SPIN_CAP) { atomicAdd(&bar[XB_TMO], 1u); break; } }
    }
    nloc = mine > 0u ? mine : 1u; nx = cnt > 0u ? cnt : 1u;
}
DEVI void xbar(unsigned* bar, volatile LAS unsigned* st, int tid, unsigned G) {
    asm volatile("s_waitcnt vmcnt(0)" ::: "memory");
    __syncthreads();
    if (tid == 0) {
        const unsigned x = xb_xcc_id();
        __builtin_amdgcn_s_waitcnt(0);
        unsigned nloc = st[0], nx = st[1];
        if (nloc == 0u) { xb_complete(bar, x, nloc, nx, G); st[0] = nloc; st[1] = nx; }
        const unsigned old = xb_add(&bar[XB_XSUB(x)], 1u);
        const unsigned gen = old / nloc;
        if (old + 1u == (gen + 1u) * nloc) {
            __builtin_amdgcn_fence(__ATOMIC_RELEASE, "agent");
            asm volatile("s_waitcnt vmcnt(0)" ::: "memory");
            const unsigned og = xb_add(&bar[XB_TOP], 1u);
            const unsigned tg = og / nx;
            if (og + 1u == (tg + 1u) * nx) xb_add(&bar[XB_TOPGEN], 1u);
            else XB_SPIN(xb_ld(&bar[XB_TOPGEN]) == tg, bar);
            __builtin_amdgcn_fence(__ATOMIC_ACQUIRE, "agent");
            xb_add(&bar[XB_XGEN(x)], 1u);
            asm volatile("s_waitcnt vmcnt(0)" ::: "memory");
        } else {
            XB_SPIN(xb_ld(&bar[XB_XGEN(x)]) == gen, bar);
            __builtin_amdgcn_fence(__ATOMIC_ACQUIRE, "agent");
            asm volatile("s_waitcnt vmcnt(0)" ::: "memory");
        }
    }
    __syncthreads();
}
#ifndef PHM
#define PHM 0xFFFFFFFFu
#endif
#ifndef DBL
#define DBL 0u
#endif
#define NREP(k) (((DBL >> (k)) & 1u) ? 2 : 1)
__global__ void __launch_bounds__(512, 2) trunk_fwd(Params p) {
    extern __shared__ __attribute__((aligned(16))) unsigned char shm_raw[];
    LAS unsigned char* lds = (LAS unsigned char*)shm_raw;
    __shared__ uint4 s_ctl;
#define s_item (*(LAS int*)&s_ctl)
    cg::grid_group grid = cg::this_grid();
    const int wave_s = __builtin_amdgcn_readfirstlane((int)threadIdx.x >> 6);
    if (threadIdx.x == 0) { s_ctl = make_uint4(0u, 0u, 0u, 0u); (void)xb_add((unsigned*)(p.ws + W_BAR) + XB_XCNT(xb_xcc_id()), 1u); }
    __syncthreads();
#define GSYNC() do { const __attribute__((address_space(4))) Params* kq = (const __attribute__((address_space(4))) Params*)__builtin_amdgcn_kernarg_segment_ptr(); asm volatile("" : "+s"(kq)); \
        unsigned Gq = gridDim.x; asm volatile("" : "+s"(Gq)); xbar((unsigned*)(kq->ws + W_BAR), (volatile LAS unsigned*)&s_ctl + 1, wave_s * 64 + opaque_lane(), Gq); } while (0)
#define PH_BEGIN \
    int tid = wave_s * 64 + opaque_lane(); asm volatile("" : "+v"(tid)); \
    int bid = blockIdx.x, G = gridDim.x, lq = l; asm volatile("" : "+s"(bid), "+s"(G), "+s"(lq)); \
    const int lane = tid & 63, wave = __builtin_amdgcn_readfirstlane(tid >> 6); \
    const int gw = bid * 8 + wave, NGW = G * 8; const size_t gtid = (size_t)bid * 512 + tid, NGT = (size_t)G * 512; \
    const __attribute__((address_space(4))) Params* kp = (const __attribute__((address_space(4))) Params*)__builtin_amdgcn_kernarg_segment_ptr(); asm volatile("" : "+s"(kp)); \
    unsigned char* ws = kp->ws; float* out = kp->out; \
    (void)lane; (void)wave; (void)gw; (void)NGW; (void)gtid; (void)NGT; (void)out; (void)lq;
#define WSP(T, off) ((T*)(ws + (off)))
    for (int rep = 0; rep < NREP(0); ++rep) if (PHM & 1u) {
        int tid = wave_s * 64 + opaque_lane(); asm volatile("" : "+v"(tid));
        const int bid = blockIdx.x, G = gridDim.x, lane = tid & 63, wave = __builtin_amdgcn_readfirstlane(tid >> 6);
        const int gw = bid * 8 + wave, NGW = G * 8; const size_t gtid = (size_t)bid * 512 + tid, NGT = (size_t)G * 512;
        unsigned char* ws = p.ws;
        h16* xh = WSP(h16, W_XH); float* ropec = WSP(float, W_ROPE); float* ropes = ropec + NPOS * 16;
        for (size_t i = gtid; i < (size_t)MT * DM / 8; i += NGT) { const size_t e = i * 8; const float* src = e < (size_t)MP * DM ? p.in[0] + e : p.in[1] + (e - (size_t)MP * DM);
            *(h8*)(xh + e) = pack8(*(const f4*)src, *(const f4*)(src + 4)); }
        for (size_t i = gtid; i < (size_t)NPOS * 16; i += NGT) { const int pi = (int)(i >> 4), fi = (int)(i & 15); const double pos = pi < SEQ ? (double)pi : (double)(PAST + pi - SEQ);
            const double ang = pos * exp(-(double)fi / 16.0 * 9.210340371976184); ropec[i] = (float)cos(ang); ropes[i] = (float)sin(ang); }
        for (size_t i = gtid; i < (size_t)DEPTH * 256; i += NGT) WSP(float, W_SP)[i] = log1pf(expf(-p.in[26][i]));
        LAS float* scr = (LAS float*)(lds + wave * 8448);
        for (int l = 0; l < DEPTH; ++l) {
            h16* wt_in = WSP(h16, W_WIN + l * SZ_WIN); h16* wt_uq = WSP(h16, W_WUQ + l * SZ_WUQ); h16* wt_kv = WSP(h16, W_WKV + l * SZ_WKV);
            h16* wt_o = WSP(h16, W_WO + l * SZ_WO); h16* wt_os = WSP(h16, W_WOS + l * SZ_WOS); h16* wt_up = WSP(h16, W_WUP + l * SZ_WUP); h16* wt_dn = WSP(h16, W_WDN + l * SZ_WDN);
            h16* wt_ql = WSP(h16, W_WQL + l * SZ_WQL); h16* wt_g = WSP(h16, W_WG + l * SZ_WG);
            const float* w_in = p.in[11] + (size_t)l * DM * DIN; const float* w_o = p.in[12] + (size_t)l * DM * DM; const float* w_uq = p.in[16] + (size_t)l * 384 * 768;
            const float* w_uk = p.in[18] + (size_t)l * 256 * 512; const float* w_uv = p.in[19] + (size_t)l * 256 * 512; const float* w_up = p.in[27] + (size_t)l * DM * DFF2; const float* w_dn = p.in[30] + (size_t)l * DFF * DM;
            const float* w_r = p.in[22] + (size_t)l * 4 * 64 * 64; const float* w_i = p.in[24] + (size_t)l * 4 * 64 * 64;
            for (int it = gw; it < 16 * 53; it += NGW) transpose_item<0>(w_in, DIN, 53, wt_in, 1024, scr, it, lane);
            for (int it = gw; it < 6 * 24; it += NGW) transpose_item<1>(w_uq, 768, 24, wt_uq, 384, scr, it, lane);
            for (int it = gw; it < 4 * 16; it += NGW) transpose_item<0>(w_uk, 512, 16, wt_kv, 256, scr, it, lane);
            for (int it = gw; it < 4 * 16; it += NGW) transpose_item<0>(w_uv, 512, 16, wt_kv + 512 * 256, 256, scr, it, lane);
            for (int it = gw; it < 16 * 32; it += NGW) transpose_item<0>(w_o, 1024, 32, wt_o, 1024, scr, it, lane);
            for (int it = gw; it < 4 * 32; it += NGW) transpose_item<0>(w_o, 1024, 32, wt_os, CSW, scr, it, lane);
            for (int it = gw; it < 4 * 32; it += NGW) transpose_item<0>(w_o + (size_t)768 * 1024, 1024, 32, wt_os + 2304, CSW, scr, it, lane);
            for (int it = gw; it < 16 * 176; it += NGW) transpose_item<0>(w_up, DFF2, 176, wt_up, 1024, scr, it, lane);
            for (int it = gw; it < 44 * 32; it += NGW) transpose_item<0>(w_dn, 1024, 32, wt_dn, DFF, scr, it, lane);
            for (size_t i = gtid; i < (size_t)(ZW - DIN) * 1024 / 8; i += NGT) *(h8*)(wt_in + (size_t)DIN * 1024 + i * 8) = (h8){0, 0, 0, 0, 0, 0, 0, 0};
            for (size_t i = gtid; i < (size_t)512 * 256; i += NGT) { const int n = (int)(i >> 8), k = (int)(i & 255); const int pn = n >> 8, jj = n & 127, isI = (n >> 7) & 1, ch = pn * 128 + jj;
                float v = 0.f; if ((k >> 6) == (ch >> 6)) v = (isI ? w_i : w_r)[((ch >> 6) * 64 + (k & 63)) * 64 + (ch & 63)];
                wt_g[i] = (h16)v; }
            for (size_t i = gtid; i < (size_t)2048 * 384; i += NGT) { const int n = (int)(i / 384), k = (int)(i % 384), hh = n >> 8, c = n & 255;
                const float* a = w_uq + (size_t)k * 768 + hh * 96; const float* b = w_uk + (size_t)c * 512 + hh * 64; float s = 0.f;
#pragma unroll 8
                for (int d = 0; d < 64; ++d) s += a[d] * b[d];
                wt_ql[i] = (h16)s; }
            for (size_t i = gtid; i < (size_t)2048 * 1024; i += NGT) { const int kk = (int)(i & 2047), n = (int)(i >> 11), hh = kk >> 8, c = kk & 255;
                const float* a = w_uv + (size_t)c * 512 + hh * 64; const float* b = w_o + (size_t)(256 + hh * 64) * 1024 + n; float s = 0.f;
#pragma unroll 8
                for (int d = 0; d < 64; ++d) s += a[d] * b[(size_t)d * 1024];
                wt_os[(size_t)n * CSW + 256 + kk] = (h16)s; }
        }
    }
    grid.sync();

    for (int l = 0; l < DEPTH; ++l) {
        for (int rep = 0; rep < NREP(1); ++rep) if (PHM & (1u << 1)) { PH_BEGIN
          Gemm g{WSP(h16, W_XH), WSP(h16, W_WIN + lq * SZ_WIN), MT, ZW, 1024, 1024, 1024}; StaticOrder S; S.init(MT, ZW, G, bid); EpiZ E{WSP(h16, W_Z), out + O_SV + (size_t)lq * MS * 256}; gemm_phase(lds, g, S, E, tid); }
        GSYNC();

        for (int rep = 0; rep < NREP(2); ++rep) if (PHM & (1u << 2)) { PH_BEGIN
            const float* qn_g = kp->in[15] + lq * 384; const float* kvn_g = kp->in[17] + lq * 256;
            const float* cw = kp->in[20] + (size_t)lq * 4 * 256; const float* cb = kp->in[21] + lq * 256; const float* stc = kp->in[5] + (size_t)lq * DBATCH * 3 * 256;
            const h16* z = WSP(h16, W_Z); h16* cqn = WSP(h16, W_CQN); h16* ckvn = WSP(h16, W_CKVN); h16* knew = WSP(h16, W_KNEW); h16* kb = WSP(h16, W_K); h16* xc = WSP(h16, W_XC);
            const float* ropec = WSP(float, W_ROPE); const float* ropes = ropec + NPOS * 16;
            for (int row = gw; row < MT; row += NGW) {
                const h16* zr = z + (size_t)row * ZW; const bool samp = row >= MP; const int rs = row - MP;
                const int t = samp ? (rs & 31) : (row & (SEQ - 1)), bb = samp ? (rs >> 5) : (row >> 11);
                { float v[6]; float ss = 0.f;
#pragma unroll
                    for (int i = 0; i < 3; ++i) { const h2 x = *(const h2*)(zr + 512 + 2 * lane + 128 * i); v[2 * i] = (float)x[0]; v[2 * i + 1] = (float)x[1]; ss += v[2 * i] * v[2 * i] + v[2 * i + 1] * v[2 * i + 1]; }
                    const float rr = rsqrtf(wave_sum(ss, lane) * (1.f / 384.f) + 1e-6f);
#pragma unroll
                    for (int i = 0; i < 3; ++i) { const int c = 2 * lane + 128 * i; h2 o; o[0] = (h16)(v[2 * i] * rr * qn_g[c]); o[1] = (h16)(v[2 * i + 1] * rr * qn_g[c + 1]); *(h2*)(cqn + (size_t)row * 384 + c) = o; } }
                { const h4 x = *(const h4*)(zr + 896 + 4 * lane); f4 v; float ss = 0.f;
#pragma unroll
                    for (int e = 0; e < 4; ++e) { v[e] = (float)x[e]; ss += v[e] * v[e]; }
                    const float rr = rsqrtf(wave_sum(ss, lane) * (1.f / 256.f) + 1e-6f); const f4 gg = *(const f4*)(kvn_g + 4 * lane); v = v * rr * gg;
                    if (!samp) { *(f4*)(out + O_PLAT + ((size_t)lq * MP + row) * 256 + 4 * lane) = v; *(h4*)(ckvn + (size_t)row * 256 + 4 * lane) = pack4(v); }
                    else { *(f4*)(out + O_SLAT + ((size_t)lq * MS + rs) * 256 + 4 * lane) = v; *(h4*)(knew + (size_t)rs * KNW + 4 * lane) = pack4(v); } }
                if (lane < 16) { const int pidx = samp ? SEQ + t : t; const float c = ropec[pidx * 16 + lane], s = ropes[pidx * 16 + lane];
                    const float x1 = (float)zr[1152 + lane], x2 = (float)zr[1168 + lane], o1 = x1 * c - x2 * s, o2 = x1 * s + x2 * c;
                    if (!samp) { float* o = out + O_PKR + ((size_t)lq * MP + row) * 32; o[lane] = o1; o[16 + lane] = o2;
                        h16* kr = kb + (size_t)row * KW + 64;
#pragma unroll
                        for (int hh = 0; hh < 8; ++hh) { kr[hh * 96 + lane] = (h16)o1; kr[hh * 96 + 16 + lane] = (h16)o2; } }
                    else { float* o = out + O_SKR + ((size_t)lq * MS + rs) * 32; o[lane] = o1; o[16 + lane] = o2; knew[(size_t)rs * KNW + 256 + lane] = (h16)o1; knew[(size_t)rs * KNW + 272 + lane] = (h16)o2; } }
                { const int c = 4 * lane; f4 accv = *(const f4*)(cb + c);
#pragma unroll
                    for (int j = 0; j < 4; ++j) { const int tau = t - 3 + j; f4 xv;
                        if (tau >= 0) { const h4 x = *(const h4*)(zr - (ptrdiff_t)(3 - j) * ZW + 1184 + c); xv = (f4){(float)x[0], (float)x[1], (float)x[2], (float)x[3]}; }
                        else if (samp) xv = *(const f4*)(stc + ((size_t)bb * 3 + (3 + tau)) * 256 + c);
                        else xv = (f4){0.f, 0.f, 0.f, 0.f};
                        accv += xv * *(const f4*)(cw + j * 256 + c);
                        if (j == 3) { const int T = samp ? DSEQ : SEQ; if (t >= T - 3) { float* o = samp ? out + O_SLC + (((size_t)lq * DBATCH + bb) * 3 + (t - (T - 3))) * 256 : out + O_PLC + (((size_t)lq * NB + bb) * 3 + (t - (T - 3))) * 256; *(f4*)(o + c) = xv; } } }
                    *(h4*)(xc + (size_t)row * 256 + c) = pack4(accv); }
            }
        }
        GSYNC();

        for (int rep = 0; rep < NREP(3); ++rep) if (PHM & (1u << 3)) { PH_BEGIN
          Gemm g{WSP(h16, W_CQN), WSP(h16, W_WUQ + lq * SZ_WUQ), MT, 768, 384, 384, 384}; StaticOrder S; S.init(MT, 768, G, bid);
          EpiQ E{WSP(h16, W_Q), WSP(h16, W_QLAT), WSP(float, W_ROPE), WSP(float, W_ROPE) + NPOS * 16}; gemm_phase(lds, g, S, E, tid); }
        for (int rep = 0; rep < NREP(4); ++rep) if (PHM & (1u << 4)) { PH_BEGIN
          Gemm g{WSP(h16, W_CKVN), WSP(h16, W_WKV + lq * SZ_WKV), MP, 1024, 256, 256, 256}; StaticOrder S; S.init(MP, 1024, G, (bid + G - (396 % G)) % G); EpiKV E{WSP(h16, W_K), WSP(h16, W_V)}; gemm_phase(lds, g, S, E, tid); }
        for (int rep = 0; rep < NREP(5); ++rep) if (PHM & (1u << 5)) { PH_BEGIN
          Gemm g{WSP(h16, W_XC), WSP(h16, W_WG + lq * SZ_WG), MT, 512, 256, 256, 256}; StaticOrder S; S.init(MT, 512, G, (bid + G - (908 % G)) % G);
          EpiGate E{WSP(h16, W_XC), WSP(float, W_A), WSP(float, W_B), kp->in[23] + lq * 256, kp->in[25] + lq * 256, WSP(float, W_SP) + lq * 256}; gemm_phase(lds, g, S, E, tid); }
        for (int rep = 0; rep < NREP(6); ++rep) if (PHM & (1u << 6)) { PH_BEGIN
          Gemm g{WSP(h16, W_CQN) + (size_t)MP * 384, WSP(h16, W_WQL + lq * SZ_WQL), MS, 2048, 384, 384, 384}; StaticOrder S; S.init(MS, 2048, G, (bid + G - (1172 % G)) % G); EpiQlat E{WSP(h16, W_QLAT)}; gemm_phase(lds, g, S, E, tid); }
        for (int rep = 0; rep < NREP(7); ++rep) if (PHM & (1u << 7)) { PH_BEGIN
            const float* gw_s = kp->in[13] + (size_t)lq * 4 * 128 * 128; const float* gb_s = kp->in[14] + (size_t)lq * 4 * 128;
            const h16* z = WSP(h16, W_Z); h16* cat = WSP(h16, W_CAT); h16* cats = WSP(h16, W_CATS);
            const int fr = lane & 15, g4 = lane >> 4, q_ = fr >> 2, p_ = fr & 3;
            for (int item = (bid + G - (1204 % G)) % G; item < 1024 + 128; item += G) {
                const bool samp = item >= 1024; const int head = item & 3; const int ci = samp ? (item - 1024) >> 2 : item >> 2;
                const int R0 = samp ? MP + ci * 32 : ci * 128, L = samp ? 32 : 128;
                __syncthreads();
                for (int id = tid; id < L * 8; id += 512) { const int j = id >> 3, part = id & 7; *(LAS h8*)(lds + j * 144 + part * 16) = *(const h8*)(z + (size_t)(R0 + j) * ZW + 256 + head * 64 + part * 8); }
                __syncthreads();
                const int i0 = 16 * wave;
                if (i0 < L) {
                    f4 sacc[4];
#pragma unroll
                    for (int ct = 0; ct < 4; ++ct) sacc[ct] = (f4){0.f, 0.f, 0.f, 0.f};
                    const int i = i0 + fr;
#pragma unroll
                    for (int ks = 0; ks < 4; ++ks) if (32 * ks <= i0 + 15 && 32 * ks < L) {
                        const int j0 = 32 * ks + 8 * g4; const float* wp = gw_s + ((size_t)head * 128 + i) * 128 + j0; const f4 w0 = *(const f4*)wp, w1 = *(const f4*)(wp + 4);
                        h8 wf;
#pragma unroll
                        for (int e = 0; e < 4; ++e) { wf[e] = (h16)((j0 + e <= i) ? w0[e] : 0.f); wf[4 + e] = (h16)((j0 + 4 + e <= i) ? w1[e] : 0.f); }
#pragma unroll
                        for (int ct = 0; ct < 4; ++ct) { const h4 lo = trrd(lds + (32 * ks + 8 * g4 + q_) * 144 + (16 * ct + 4 * p_) * 2), hi = trrd(lds + (32 * ks + 8 * g4 + 4 + q_) * 144 + (16 * ct + 4 * p_) * 2);
                            sacc[ct] = __builtin_amdgcn_mfma_f32_16x16x32_f16(wf, cat44(lo, hi), sacc[ct], 0, 0, 0); } }
#pragma unroll
                    for (int jx = 0; jx < 4; ++jx) { const int ii = i0 + 4 * g4 + jx; const float bs = gb_s[head * 128 + ii]; const size_t r = (size_t)R0 + ii;
#pragma unroll
                        for (int ct = 0; ct < 4; ++ct) { const int d = head * 64 + 16 * ct + fr; const float uval = (float)z[r * ZW + d]; const h16 o = (h16)(uval * (sacc[ct][jx] + bs));
                            if (!samp) cat[r * 1024 + d] = o; else cats[(r - MP) * CSW + d] = o; } }
                }
            }
            __syncthreads();
        }
        GSYNC();

        for (int rep = 0; rep < NREP(8); ++rep) if (PHM & (1u << 8)) { PH_BEGIN
            unsigned* counter = WSP(unsigned, W_CTR) + lq * 16 + rep * 8;
            const int fr = lane & 15, g4 = lane >> 4;
            constexpr int N_SA = 64, N_PA = 1024, N_PS = 128, N_SS = 16, N_ALL = N_SA + N_PA + N_PS + N_SS;
            for (;;) {
                __syncthreads();
                if (tid == 0) s_item = (int)atomicAdd(counter, 1u);
                __syncthreads();
                const int item = s_item;
                if (item >= N_ALL) break;
                if (item < N_SA) {
                    constexpr int KS = 592;
                    const float* clat = kp->in[2] + (size_t)lq * DBATCH * PAST * 256; const float* ckr = kp->in[3] + (size_t)lq * DBATCH * PAST * 32;
                    const h16* qlat = WSP(h16, W_QLAT); const h16* knew = WSP(h16, W_KNEW); h16* cats = WSP(h16, W_CATS);
                    const int b = item >> 1, hg = item & 1, head = 4 * hg + (wave >> 1), tq = 16 * (wave & 1) + fr;
                    h8 qf[1][9];
#pragma unroll
                    for (int ks = 0; ks < 9; ++ks) qf[0][ks] = *(const h8*)(qlat + (size_t)(b * 32 + tq) * QLW + head * 288 + 32 * ks + 8 * g4);
                    f4 o[1][16]; float mrow[1] = {-1e30f}, lrow[1] = {0.f};
#pragma unroll
                    for (int ct = 0; ct < 16; ++ct) o[0][ct] = (f4){0.f, 0.f, 0.f, 0.f};
                    const float* lb = clat + (size_t)b * PAST * 256 + (size_t)(tid >> 6) * 256 + (tid & 63) * 4; const float* rb = ckr + (size_t)b * PAST * 32 + (size_t)(tid >> 3) * 32 + (tid & 7) * 4;
                    const int wl = (tid >> 6) * KS + (tid & 63) * 8, wr_ = (tid >> 3) * KS + 512 + (tid & 7) * 8;
                    f4 pl[4]; f4 pr;
#pragma unroll
                    for (int hf = 0; hf < 2; ++hf) {
#pragma unroll
                        for (int i = 0; i < 4; ++i) pl[i] = *(const f4*)(lb + (size_t)(hf * 4 + i) * 8 * 256);
#pragma unroll
                        for (int i = 0; i < 4; ++i) *(LAS h4*)(lds + wl + (hf * 4 + i) * 8 * KS) = pack4(pl[i]); }
                    pr = *(const f4*)rb;
                    *(LAS h4*)(lds + wr_) = pack4(pr);
                    __syncthreads();
                    for (int t = 0; t < 64; ++t) {
                        LAS unsigned char* cur = lds + (t & 1) * (64 * KS); LAS unsigned char* nxt = lds + ((t + 1) & 1) * (64 * KS);
                        const bool more = t + 1 < 64;
                        if (more) {
#pragma unroll
                            for (int i = 0; i < 4; ++i) pl[i] = *(const f4*)(lb + ((size_t)(t + 1) * 64 + i * 8) * 256);
                            pr = *(const f4*)(rb + (size_t)(t + 1) * 64 * 32);
                        }
                        h8 pf[1][2];
                        attn_qk<9, 16, 1, KS>(cur, qf, o, mrow, lrow, pf, 4, lane);
                        if (more) {
#pragma unroll
                            for (int i = 0; i < 4; ++i) *(LAS h4*)(nxt + wl + i * 8 * KS) = pack4(pl[i]);
                            *(LAS h4*)(nxt + wr_) = pack4(pr);
#pragma unroll
                            for (int i = 0; i < 4; ++i) pl[i] = *(const f4*)(lb + ((size_t)(t + 1) * 64 + (4 + i) * 8) * 256);
                        }
                        attn_pv<16, 1, KS>(cur, o, pf, 4, lane);
                        if (more) {
#pragma unroll
                            for (int i = 0; i < 4; ++i) *(LAS h4*)(nxt + wl + (4 + i) * 8 * KS) = pack4(pl[i]);
                        } else {
                            for (int id = tid; id < 32 * 36; id += 512) { const int key = id / 36, part = id % 36; *(LAS h8*)(nxt + key * KS + part * 16) = *(const h8*)(knew + (size_t)(b * 32 + key) * KNW + part * 8); }
                        }
                        __syncthreads();
                    }
                    attn_tile<9, 16, 1, KS, KS>(lds, lds, qf, o, mrow, lrow, 2, lane);
                    float lt = lrow[0]; lt += shx(lt, 16, lane); lt += shx(lt, 32, lane); const float inv = 1.f / lt;
                    h16* dst = cats + (size_t)(b * 32 + tq) * CSW + 256 + head * 256 + 4 * g4;
#pragma unroll
                    for (int ct = 0; ct < 16; ++ct) *(h4*)(dst + 16 * ct) = pack4(o[0][ct] * inv);
                } else if (item < N_SA + N_PA) {
                    constexpr int KS = 208, VS = 144, KBUF = 64 * KS, VBUF = 64 * VS;
                    const h16* qb = WSP(h16, W_Q); const h16* kb = WSP(h16, W_K); const h16* vb = WSP(h16, W_V); h16* cat = WSP(h16, W_CAT);
                    const int it = item - N_SA, qblk = 7 - (it >> 7), bh = it & 127, b = bh >> 3, head = bh & 7;
                    const int r0 = qblk * 256 + 32 * wave, ntw = (r0 >> 6) + 1, ntb = 4 * (qblk + 1);
                    h8 qf[2][3];
#pragma unroll
                    for (int qs = 0; qs < 2; ++qs)
#pragma unroll
                        for (int ks = 0; ks < 3; ++ks) qf[qs][ks] = *(const h8*)(qb + (size_t)(b * SEQ + r0 + 16 * qs + fr) * QW + head * 96 + 32 * ks + 8 * g4);
                    f4 o[2][4]; float mrow[2] = {-1e30f, -1e30f}, lrow[2] = {0.f, 0.f};
#pragma unroll
                    for (int qs = 0; qs < 2; ++qs)
#pragma unroll
                        for (int ct = 0; ct < 4; ++ct) o[qs][ct] = (f4){0.f, 0.f, 0.f, 0.f};
                    const int k0key = tid / 12, k0part = tid % 12, k1key = (tid + 512) / 12, k1part = (tid + 512) % 12, vkey = tid >> 3, vpart = tid & 7;
                    const h16* kg0 = kb + (size_t)b * SEQ * KW + head * 96 + (size_t)k0key * KW + k0part * 8; const h16* kg1 = kb + (size_t)b * SEQ * KW + head * 96 + (size_t)k1key * KW + k1part * 8;
                    const h16* vg = vb + (size_t)b * SEQ * VW + head * 64 + (size_t)vkey * VW + vpart * 8;
                    const int lk0 = k0key * KS + k0part * 16, lk1 = k1key * KS + k1part * 16, lv = 2 * KBUF + vkey * VS + vpart * 16;
                    h8 pk0, pk1 = (h8){0, 0, 0, 0, 0, 0, 0, 0}, pv;
                    pk0 = *(const h8*)kg0; if (tid < 256) pk1 = *(const h8*)kg1; pv = *(const h8*)vg;
                    *(LAS h8*)(lds + lk0) = pk0; if (tid < 256) *(LAS h8*)(lds + lk1) = pk1; *(LAS h8*)(lds + lv) = pv;
                    __syncthreads();
                    for (int t = 0; t < ntb; ++t) {
                        const int co = (t & 1), no = ((t + 1) & 1);
                        if (t + 1 < ntb) { const size_t ro = (size_t)(t + 1) * 64;
                            pk0 = *(const h8*)(kg0 + ro * KW); if (tid < 256) pk1 = *(const h8*)(kg1 + ro * KW); pv = *(const h8*)(vg + ro * VW); }
                        if (t < ntw) attn_tile<3, 4, 2, KS, VS>(lds + co * KBUF, lds + 2 * KBUF + co * VBUF, qf, o, mrow, lrow, 4, lane);
                        if (t + 1 < ntb) { *(LAS h8*)(lds + no * KBUF + lk0) = pk0; if (tid < 256) *(LAS h8*)(lds + no * KBUF + lk1) = pk1; *(LAS h8*)(lds + no * VBUF + lv) = pv; }
                        __syncthreads();
                    }
#pragma unroll
                    for (int qs = 0; qs < 2; ++qs) { float lt = lrow[qs]; lt += shx(lt, 16, lane); lt += shx(lt, 32, lane); const float inv = 1.f / lt;
                        h16* dst = cat + (size_t)(b * SEQ + r0 + 16 * qs + fr) * 1024 + 256 + head * 64 + 4 * g4;
#pragma unroll
                        for (int ct = 0; ct < 4; ++ct) *(h4*)(dst + 16 * ct) = pack4(o[qs][ct] * inv); }
                } else if (item < N_SA + N_PA + N_PS) {
                    const float* abuf = WSP(float, W_A); const float* bbuf = WSP(float, W_B); const h16* z = WSP(h16, W_Z); h16* cat = WSP(h16, W_CAT);
                    const int it = item - N_SA - N_PA, b = it >> 3, ch = (it & 7) * 32 + (tid & 31), seg = tid >> 5;
                    const size_t rbase = (size_t)b * SEQ + seg * 128;
                    float A = 1.f, B = 0.f;
#pragma unroll 4
                    for (int i = 0; i < 128; ++i) { const float a = abuf[(rbase + i) * 256 + ch], bb = bbuf[(rbase + i) * 256 + ch]; B = a * B + bb; A *= a; }
                    LAS float* sA = (LAS float*)lds; LAS float* sB = sA + 512;
                    sA[tid] = A; sB[tid] = B;
                    __syncthreads();
                    float h = 0.f;
                    for (int s2 = 0; s2 < seg; ++s2) h = sA[s2 * 32 + (tid & 31)] * h + sB[s2 * 32 + (tid & 31)];
#pragma unroll 4
                    for (int i = 0; i < 128; ++i) { const float a = abuf[(rbase + i) * 256 + ch], bb = bbuf[(rbase + i) * 256 + ch]; h = a * h + bb;
                        const float gt = (float)z[(rbase + i) * ZW + 1440 + ch]; cat[(rbase + i) * 1024 + 768 + ch] = (h16)(h * gt); }
                    if (seg == 15) out[O_PH + ((size_t)lq * NB + b) * 256 + ch] = h;
                } else {
                    const float* abuf = WSP(float, W_A); const float* bbuf = WSP(float, W_B); const h16* z = WSP(h16, W_Z); h16* cats = WSP(h16, W_CATS);
                    const int it = item - N_SA - N_PA - N_PS, idx = it * 512 + tid, b = idx >> 8, ch = idx & 255;
                    float h = kp->in[4][((size_t)lq * DBATCH + b) * 256 + ch];
                    for (int t = 0; t < DSEQ; ++t) { const size_t r = (size_t)MP + b * 32 + t; h = abuf[r * 256 + ch] * h + bbuf[r * 256 + ch];
                        const float gt = (float)z[r * ZW + 1440 + ch]; cats[(size_t)(b * 32 + t) * CSW + 2304 + ch] = (h16)(h * gt); }
                    out[O_SH + ((size_t)lq * DBATCH + b) * 256 + ch] = h;
                }
            }
        }
        GSYNC();

        for (int rep = 0; rep < NREP(9); ++rep) if (PHM & (1u << 9)) { PH_BEGIN
          const float* xres_s = lq == 0 ? kp->in[1] : out + O_Y + (size_t)MP * DM;
          Gemm g{WSP(h16, W_CATS), WSP(h16, W_WOS + lq * SZ_WOS), MS, 1024, CSW, CSW, CSW}; StaticOrder S; S.init(MS, 1024, G, bid); EpiRes E{xres_s, WSP(float, W_PRE) + (size_t)MP * DM}; gemm_phase(lds, g, S, E, tid); }
        for (int rep = 0; rep < NREP(10); ++rep) if (PHM & (1u << 10)) { PH_BEGIN
          const float* xres_p = lq == 0 ? kp->in[0] : out + O_Y;
          Gemm g{WSP(h16, W_CAT), WSP(h16, W_WO + lq * SZ_WO), MP, 1024, 1024, 1024, 1024}; StaticOrder S; S.init(MP, 1024, G - 16, bid - 16); EpiRes E{xres_p, WSP(float, W_PRE)}; gemm_phase(lds, g, S, E, tid); }
        GSYNC();

        for (int rep = 0; rep < NREP(11); ++rep) if (PHM & (1u << 11)) { PH_BEGIN
            const float* gg = kp->in[7] + lq * DM; const float* bb = kp->in[8] + lq * DM; const float* pre = WSP(float, W_PRE); float* x1f = WSP(float, W_X1F); h16* xh = WSP(h16, W_XH);
            for (int row0 = gw; row0 < MT; row0 += 2 * NGW) { f4 v[2][4]; float s[2], s2[2]; const bool ok1 = row0 + NGW < MT;
#pragma unroll
                for (int u = 0; u < 2; ++u) { const int row = (u == 0 || ok1) ? row0 + u * NGW : row0; const float* pr = pre + (size_t)row * DM; s[u] = 0.f;
#pragma unroll
                    for (int j = 0; j < 4; ++j) { v[u][j] = *(const f4*)(pr + 4 * lane + 256 * j); s[u] += (v[u][j][0] + v[u][j][1]) + (v[u][j][2] + v[u][j][3]); } }
#pragma unroll
                for (int o = 1; o < 64; o <<= 1) { s[0] += shx(s[0], o, lane); s[1] += shx(s[1], o, lane); }
#pragma unroll
                for (int u = 0; u < 2; ++u) { const float mean = s[u] * (1.f / DM); s2[u] = 0.f;
#pragma unroll
                    for (int j = 0; j < 4; ++j) { v[u][j] = v[u][j] - mean; s2[u] += (v[u][j][0] * v[u][j][0] + v[u][j][1] * v[u][j][1]) + (v[u][j][2] * v[u][j][2] + v[u][j][3] * v[u][j][3]); } }
#pragma unroll
                for (int o = 1; o < 64; o <<= 1) { s2[0] += shx(s2[0], o, lane); s2[1] += shx(s2[1], o, lane); }
#pragma unroll
                for (int u = 0; u < 2; ++u) if (u == 0 || ok1) { const int row = row0 + u * NGW; const float rstd = rsqrtf(s2[u] * (1.f / DM) + 1e-5f);
#pragma unroll
                    for (int j = 0; j < 4; ++j) { const int c = 4 * lane + 256 * j; const f4 y = v[u][j] * rstd * *(const f4*)(gg + c) + *(const f4*)(bb + c);
                        *(f4*)(x1f + (size_t)row * DM + c) = y; *(h4*)(xh + (size_t)row * DM + c) = pack4(y); } } }
        }
        GSYNC();

        for (int rep = 0; rep < NREP(12); ++rep) if (PHM & (1u << 12)) { PH_BEGIN
          Gemm g{WSP(h16, W_XH), WSP(h16, W_WUP + lq * SZ_WUP), MT, DFF2, 1024, 1024, 1024}; StaticOrder S; S.init(MT, DFF2, G, bid);
          EpiUp E{WSP(h16, W_UP), out + O_PFC + (size_t)lq * NB * 2 * DFF2, (O_SFC + (size_t)lq * DBATCH * 2 * DFF2) - (O_PFC + (size_t)lq * NB * 2 * DFF2)}; gemm_phase(lds, g, S, E, tid); }
        GSYNC();

        for (int rep = 0; rep < NREP(13); ++rep) if (PHM & (1u << 13)) { PH_BEGIN
            const float* fw = kp->in[28] + (size_t)lq * 3 * DFF2; const float* fb = kp->in[29] + (size_t)lq * DFF2; const float* stf = kp->in[6] + (size_t)lq * DBATCH * 2 * DFF2;
            const h16* up = WSP(h16, W_UP); h16* act = WSP(h16, W_ACT);
            constexpr int RSEG = 32, NCG = DFF / 8;
            for (unsigned it = (unsigned)gtid; it < (unsigned)(NCG * (MT / RSEG)); it += (unsigned)NGT) { const int seg = (int)(it / (unsigned)NCG), cg = (int)(it - (unsigned)seg * NCG), j0 = cg * 8, row0 = seg * RSEG;
                const bool samp = row0 >= MP; const int t0 = samp ? 0 : (row0 & (SEQ - 1)), bb = (row0 - MP) >> 5;
                const f4 bg0 = *(const f4*)(fb + j0), bg1 = *(const f4*)(fb + j0 + 4), bv0 = *(const f4*)(fb + DFF + j0), bv1 = *(const f4*)(fb + DFF + j0 + 4);
                f4 wg0[3], wg1[3], wv0[3], wv1[3];
#pragma unroll
                for (int j = 0; j < 3; ++j) { const float* wj = fw + (size_t)j * DFF2; wg0[j] = *(const f4*)(wj + j0); wg1[j] = *(const f4*)(wj + j0 + 4); wv0[j] = *(const f4*)(wj + DFF + j0); wv1[j] = *(const f4*)(wj + DFF + j0 + 4); }
                f4 ag0, ag1, av0, av1, bg0_, bg1_, bv0_, bv1_;
                if (t0 > 0) { const h16* u2 = up + (size_t)(row0 - 2) * DFF2; const h16* u1 = u2 + DFF2;
                    const h8 a = *(const h8*)(u2 + j0), c = *(const h8*)(u2 + DFF + j0), d = *(const h8*)(u1 + j0), e = *(const h8*)(u1 + DFF + j0);
                    ag0 = (f4){(float)a[0], (float)a[1], (float)a[2], (float)a[3]}; ag1 = (f4){(float)a[4], (float)a[5], (float)a[6], (float)a[7]};
                    av0 = (f4){(float)c[0], (float)c[1], (float)c[2], (float)c[3]}; av1 = (f4){(float)c[4], (float)c[5], (float)c[6], (float)c[7]};
                    bg0_ = (f4){(float)d[0], (float)d[1], (float)d[2], (float)d[3]}; bg1_ = (f4){(float)d[4], (float)d[5], (float)d[6], (float)d[7]};
                    bv0_ = (f4){(float)e[0], (float)e[1], (float)e[2], (float)e[3]}; bv1_ = (f4){(float)e[4], (float)e[5], (float)e[6], (float)e[7]}; }
                else if (samp) { const float* s2 = stf + (size_t)bb * 2 * DFF2; const float* s1 = s2 + DFF2;
                    ag0 = *(const f4*)(s2 + j0); ag1 = *(const f4*)(s2 + j0 + 4); av0 = *(const f4*)(s2 + DFF + j0); av1 = *(const f4*)(s2 + DFF + j0 + 4);
                    bg0_ = *(const f4*)(s1 + j0); bg1_ = *(const f4*)(s1 + j0 + 4); bv0_ = *(const f4*)(s1 + DFF + j0); bv1_ = *(const f4*)(s1 + DFF + j0 + 4); }
                else { ag0 = ag1 = av0 = av1 = bg0_ = bg1_ = bv0_ = bv1_ = (f4){0.f, 0.f, 0.f, 0.f}; }
                const h16* ur = up + (size_t)row0 * DFF2 + j0; h16* ar = act + (size_t)row0 * DFF + j0;
#pragma unroll 4
                for (int r = 0; r < RSEG; ++r) { const h8 a = *(const h8*)(ur + (size_t)r * DFF2), c = *(const h8*)(ur + (size_t)r * DFF2 + DFF);
                    const f4 cg0 = (f4){(float)a[0], (float)a[1], (float)a[2], (float)a[3]}, cg1 = (f4){(float)a[4], (float)a[5], (float)a[6], (float)a[7]};
                    const f4 cv0 = (f4){(float)c[0], (float)c[1], (float)c[2], (float)c[3]}, cv1 = (f4){(float)c[4], (float)c[5], (float)c[6], (float)c[7]};
                    const f4 g0 = bg0 + ag0 * wg0[0] + bg0_ * wg0[1] + cg0 * wg0[2], g1 = bg1 + ag1 * wg1[0] + bg1_ * wg1[1] + cg1 * wg1[2];
                    const f4 v0 = bv0 + av0 * wv0[0] + bv0_ * wv0[1] + cv0 * wv0[2], v1 = bv1 + av1 * wv1[0] + bv1_ * wv1[1] + cv1 * wv1[2];
                    h8 o;
#pragma unroll
                    for (int e = 0; e < 4; ++e) { o[e] = (h16)(gelu_f(g0[e]) * v0[e]); o[4 + e] = (h16)(gelu_f(g1[e]) * v1[e]); }
                    *(h8*)(ar + (size_t)r * DFF) = o;
                    ag0 = bg0_; ag1 = bg1_; av0 = bv0_; av1 = bv1_; bg0_ = cg0; bg1_ = cg1; bv0_ = cv0; bv1_ = cv1; } }
        }
        GSYNC();

        for (int rep = 0; rep < NREP(14); ++rep) if (PHM & (1u << 14)) { PH_BEGIN
          Gemm g{WSP(h16, W_ACT), WSP(h16, W_WDN + lq * SZ_WDN), MT, 1024, DFF, DFF, DFF}; StaticOrder S; S.init(MT, 1024, G, bid); EpiRes E{WSP(float, W_X1F), WSP(float, W_PRE)}; gemm_phase(lds, g, S, E, tid); }
        GSYNC();

        for (int rep = 0; rep < NREP(15); ++rep) if (PHM & (1u << 15)) { PH_BEGIN
            const float* gg = kp->in[9] + lq * DM; const float* bb = kp->in[10] + lq * DM; const float* pre = WSP(float, W_PRE); h16* xh = WSP(h16, W_XH);
            for (int row0 = gw; row0 < MT; row0 += 2 * NGW) { f4 v[2][4]; float s[2], s2[2]; const bool ok1 = row0 + NGW < MT;
#pragma unroll
                for (int u = 0; u < 2; ++u) { const int row = (u == 0 || ok1) ? row0 + u * NGW : row0; const float* pr = pre + (size_t)row * DM; s[u] = 0.f;
#pragma unroll
                    for (int j = 0; j < 4; ++j) { v[u][j] = *(const f4*)(pr + 4 * lane + 256 * j); s[u] += (v[u][j][0] + v[u][j][1]) + (v[u][j][2] + v[u][j][3]); } }
#pragma unroll
                for (int o = 1; o < 64; o <<= 1) { s[0] += shx(s[0], o, lane); s[1] += shx(s[1], o, lane); }
#pragma unroll
                for (int u = 0; u < 2; ++u) { const float mean = s[u] * (1.f / DM); s2[u] = 0.f;
#pragma unroll
                    for (int j = 0; j < 4; ++j) { v[u][j] = v[u][j] - mean; s2[u] += (v[u][j][0] * v[u][j][0] + v[u][j][1] * v[u][j][1]) + (v[u][j][2] * v[u][j][2] + v[u][j][3] * v[u][j][3]); } }
#pragma unroll
                for (int o = 1; o < 64; o <<= 1) { s2[0] += shx(s2[0], o, lane); s2[1] += shx(s2[1], o, lane); }
#pragma unroll
                for (int u = 0; u < 2; ++u) if (u == 0 || ok1) { const int row = row0 + u * NGW; const float rstd = rsqrtf(s2[u] * (1.f / DM) + 1e-5f);
#pragma unroll
                    for (int j = 0; j < 4; ++j) { const int c = 4 * lane + 256 * j; const f4 y = v[u][j] * rstd * *(const f4*)(gg + c) + *(const f4*)(bb + c);
                        *(f4*)(out + O_Y + (size_t)row * DM + c) = y; *(h4*)(xh + (size_t)row * DM + c) = pack4(y); } } }
        }
        GSYNC();
    }
}

extern "C" void kernel_launch(void* const* d_in, const int* in_sizes, int n_in, void* d_out, int out_size, void* d_ws, size_t ws_size, hipStream_t stream) {
    constexpr size_t kDynLds = STAGE_BYTES;
    static int grid_blocks = 0;
    if (!grid_blocks) {
        if (n_in != 31 || (size_t)out_size != O_END || ws_size < W_END) { fprintf(stderr, "kernel_launch: unexpected shapes n_in %d out %d ws %zu (need %zu)\n", n_in, out_size, ws_size, (size_t)W_END); grid_blocks = -1; return; }
        int dev = 0, cus = 0, per_cu = 0;
        hipGetDevice(&dev);
        hipDeviceGetAttribute(&cus, hipDeviceAttributeMultiprocessorCount, dev);
        hipFuncSetAttribute((const void*)trunk_fwd, hipFuncAttributeMaxDynamicSharedMemorySize, (int)kDynLds);
        hipOccupancyMaxActiveBlocksPerMultiprocessor(&per_cu, (const void*)trunk_fwd, 512, kDynLds);
        if (per_cu < 1) per_cu = 1;
        grid_blocks = cus * per_cu;
        if (grid_blocks > 256) grid_blocks = 256;
        if (grid_blocks < 32) { fprintf(stderr, "kernel_launch: grid %d too small\n", grid_blocks); grid_blocks = -1; return; }
    }
    if (grid_blocks < 0) return;
    hipMemsetAsync((char*)d_ws + W_CTR, 0, 4096 + 16384, stream);
    Params p{};
    for (int i = 0; i < 31; ++i) p.in[i] = (const float*)d_in[i];
    p.out = (float*)d_out; p.ws = (unsigned char*)d_ws;
    void* args[] = {&p};
    hipError_t e = hipLaunchCooperativeKernel((const void*)trunk_fwd, dim3(grid_blocks), dim3(512), args, kDynLds, stream);
    if (e != hipSuccess) fprintf(stderr, "cooperative launch failed: %s (grid %d)\n", hipGetErrorString(e), grid_blocks);
}
```

```cpp
#include <hip/hip_runtime.h>
#include <hip/hip_cooperative_groups.h>
#include <cstdio>
#include <cstdint>
namespace cg = cooperative_groups;

typedef _Float16 h16;
typedef _Float16 h8 __attribute__((ext_vector_type(8)));
typedef _Float16 h4 __attribute__((ext_vector_type(4)));
typedef _Float16 h2 __attribute__((ext_vector_type(2)));
typedef float f4 __attribute__((ext_vector_type(4)));
typedef short s4v __attribute__((__vector_size__(8)));
#define LAS __attribute__((address_space(3)))
#define DEVI __device__ __forceinline__

constexpr int DM = 1024, NB = 16, SEQ = 2048, DEPTH = 4, DBATCH = 32, DSEQ = 32, PAST = 4096;
constexpr int MP = NB * SEQ, MS = DBATCH * DSEQ, MT = MP + MS;
constexpr int DIN = 1696, ZW = 1792, DFF = 2816, DFF2 = 5632;
constexpr int QW = 768, KW = 768, VW = 512, QLW = 2304, CSW = 2560, KNW = 288;
constexpr float ALPHA = 1.681792830507429f;
constexpr float QSCALE = 0.14724444f;
constexpr int NPOS = SEQ + DSEQ;

constexpr size_t O_Y = 0;
constexpr size_t O_PLAT = (size_t)MT * DM;
constexpr size_t O_PKR = O_PLAT + (size_t)DEPTH * MP * 256;
constexpr size_t O_PH = O_PKR + (size_t)DEPTH * MP * 32;
constexpr size_t O_PLC = O_PH + (size_t)DEPTH * NB * 256;
constexpr size_t O_PFC = O_PLC + (size_t)DEPTH * NB * 3 * 256;
constexpr size_t O_SLAT = O_PFC + (size_t)DEPTH * NB * 2 * DFF2;
constexpr size_t O_SKR = O_SLAT + (size_t)DEPTH * MS * 256;
constexpr size_t O_SV = O_SKR + (size_t)DEPTH * MS * 32;
constexpr size_t O_SH = O_SV + (size_t)DEPTH * MS * 256;
constexpr size_t O_SLC = O_SH + (size_t)DEPTH * DBATCH * 256;
constexpr size_t O_SFC = O_SLC + (size_t)DEPTH * DBATCH * 3 * 256;
constexpr size_t O_END = O_SFC + (size_t)DEPTH * DBATCH * 2 * DFF2;

constexpr size_t al(size_t x) { return (x + 255) & ~(size_t)255; }
constexpr size_t W_CTR = 0;
constexpr size_t W_PARAMS = 2048;
constexpr size_t W_BAR = 4096;
constexpr size_t W_CD = 4096 + 16384;
constexpr size_t SZ_CD = (size_t)(2 * ZW + 2 * DFF2) * 4;
constexpr size_t W_STATS = W_CD + DEPTH * SZ_CD;
constexpr size_t SZ_STATS = (size_t)MT * 2 * 4;
constexpr size_t W_ZERO_END = W_STATS + (size_t)DEPTH * 2 * SZ_STATS;
constexpr size_t W_ROPE = al(W_ZERO_END);
constexpr size_t W_SP = al(W_ROPE + (size_t)NPOS * 16 * 2 * 4);
constexpr size_t W_WIN = al(W_SP + (size_t)DEPTH * 256 * 4);
constexpr size_t SZ_WIN = (size_t)ZW * 1024 * 2;
constexpr size_t W_WUQ = W_WIN + DEPTH * SZ_WIN;   constexpr size_t SZ_WUQ = (size_t)768 * 384 * 2;
constexpr size_t W_WQL = W_WUQ + DEPTH * SZ_WUQ;   constexpr size_t SZ_WQL = (size_t)2048 * 384 * 2;
constexpr size_t W_WKV = W_WQL + DEPTH * SZ_WQL;   constexpr size_t SZ_WKV = (size_t)1024 * 256 * 2;
constexpr size_t W_WG = W_WKV + DEPTH * SZ_WKV;    constexpr size_t SZ_WG = (size_t)512 * 256 * 2;
constexpr size_t W_WO = W_WG + DEPTH * SZ_WG;      constexpr size_t SZ_WO = (size_t)1024 * 1024 * 2;
constexpr size_t W_WOS = W_WO + DEPTH * SZ_WO;     constexpr size_t SZ_WOS = (size_t)1024 * CSW * 2;
constexpr size_t W_WUP = W_WOS + DEPTH * SZ_WOS;   constexpr size_t SZ_WUP = (size_t)DFF2 * 1024 * 2;
constexpr size_t W_WDN = W_WUP + DEPTH * SZ_WUP;   constexpr size_t SZ_WDN = (size_t)1024 * DFF * 2;
constexpr size_t W_XH = W_WDN + DEPTH * SZ_WDN;
constexpr size_t W_Z = W_XH + (size_t)MT * 1024 * 2;
constexpr size_t W_CQN = W_Z + (size_t)MT * ZW * 2;
constexpr size_t W_CKVN = W_CQN + (size_t)MT * 384 * 2;
constexpr size_t W_XC = W_CKVN + (size_t)MP * 256 * 2;
constexpr size_t W_Q = W_XC + (size_t)MT * 256 * 2;
constexpr size_t W_K = W_Q + (size_t)MP * QW * 2;
constexpr size_t W_V = W_K + (size_t)MP * KW * 2;
constexpr size_t W_A = W_V + (size_t)MP * VW * 2;
constexpr size_t W_B = W_A + (size_t)MT * 256 * 4;
constexpr size_t W_CAT = W_B + (size_t)MT * 256 * 4;
constexpr size_t W_CATS = W_CAT + (size_t)MP * 1024 * 2;
constexpr size_t W_QLAT = W_CATS + (size_t)MS * CSW * 2;
constexpr size_t W_KNEW = W_QLAT + (size_t)MS * QLW * 2;
constexpr size_t W_PRE = al(W_KNEW + (size_t)MS * KNW * 2);
constexpr size_t W_X1F = W_PRE + (size_t)MT * 1024 * 4;
constexpr size_t W_UP = W_X1F + (size_t)MT * 1024 * 4;
constexpr size_t W_ACT = W_UP + (size_t)MT * DFF2 * 2;
constexpr size_t W_PART = W_ACT + (size_t)MT * DFF * 2;
constexpr size_t SZ_PARTW = 16 * 1024 + 512;
constexpr size_t W_END = W_PART + (size_t)256 * 8 * SZ_PARTW;

struct Params { const float* in[31]; float* out; unsigned char* ws; };

DEVI float gelu_f(float x) { const float u = 1.5957691216057308f * (x + 0.044715f * x * x * x); return x / (1.f + __expf(-u)); }
DEVI float sigmoid_f(float x) { return 1.f / (1.f + __expf(-x)); }
DEVI h8 pack8(f4 a, f4 b) { h8 r; r[0] = (h16)a[0]; r[1] = (h16)a[1]; r[2] = (h16)a[2]; r[3] = (h16)a[3]; r[4] = (h16)b[0]; r[5] = (h16)b[1]; r[6] = (h16)b[2]; r[7] = (h16)b[3]; return r; }
DEVI h4 pack4(f4 a) { h4 r; r[0] = (h16)a[0]; r[1] = (h16)a[1]; r[2] = (h16)a[2]; r[3] = (h16)a[3]; return r; }
DEVI float shx(float v, int o, int lane) { return __builtin_bit_cast(float, __builtin_amdgcn_ds_bpermute((lane ^ o) << 2, __builtin_bit_cast(int, v))); }
DEVI float wave_sum(float v, int lane) {
#pragma unroll
    for (int o = 1; o < 64; o <<= 1) v += shx(v, o, lane);
    return v;
}
DEVI int opaque_lane() { unsigned ones = ~0u; asm volatile("" : "+s"(ones)); return (int)__builtin_amdgcn_mbcnt_hi(ones, __builtin_amdgcn_mbcnt_lo(ones, 0u)); }
DEVI h4 trrd(LAS unsigned char* p) { s4v r = __builtin_amdgcn_ds_read_tr16_b64_v4i16((LAS s4v*)p); return __builtin_bit_cast(h4, r); }
DEVI h8 cat44(h4 a, h4 b) { return __builtin_shufflevector(a, b, 0, 1, 2, 3, 4, 5, 6, 7); }

constexpr int BM = 256, BK = 64, HALF = 128, HTB = HALF * BK * 2, STAGE_BYTES = 8 * HTB, NXCD = 8, WGM = 8;
DEVI int lds_byte(int r, int c) { const int st = (r >> 4) * 2 + (c >> 5), rr = r & 15, cc = c & 31, ob = rr * 64 + cc * 2; return st * 1024 + (ob ^ (((ob >> 9) & 1) << 5)); }
DEVI void stage_rc(int b, int& R, int& C) { const int st = b / 1024, sb = b % 1024, swz = sb ^ (((sb >> 9) & 1) << 5); R = (st >> 1) * 16 + swz / 64; C = (st & 1) * 32 + (swz % 64) / 2; }
DEVI int perm32(int rho) { const int n = rho >> 4, i = rho & 15; return 8 * (i >> 2) + 4 * n + (i & 3); }
struct Unit { int pm, pn; };
struct Gemm { const h16* A; const h16* Bt; int M, N, K, lda, ldb; };
struct StaticOrder {
    int nM, nN, nwg, G, c;
    DEVI void init(int M, int N, int G_, int c_) { nM = M / BM; nN = N / BM; nwg = nM * nN; G = G_; c = c_; }
    DEVI bool next(int i, Unit& u) const {
        if (c < 0) return false;
        const long L = (long)i * G + c; if (L >= nwg) return false;
        int wgid = (int)L; { const int q = nwg / NXCD, r = nwg % NXCD, xcd = wgid % NXCD, off = wgid / NXCD; wgid = (xcd < r ? xcd * (q + 1) : r * (q + 1) + (xcd - r) * q) + off; }
        const int nig = WGM * nN, gid = wgid / nig, fm = gid * WGM, gsz = (nM - fm) < WGM ? (nM - fm) : WGM;
        u.pm = fm + ((wgid % nig) % gsz); u.pn = (wgid % nig) / gsz; return true;
    }
};
template <class Epi>
DEVI void gemm_phase(LAS unsigned char* lds, const Gemm g, const StaticOrder& S, const Epi& E, const int tid) {
    const int wid = __builtin_amdgcn_readfirstlane(tid >> 6), lane = tid & 63, wr = wid >> 2, wc = wid & 3, fr = lane & 15, fq = lane >> 4;
    const int K = g.K, nt = K / BK;
    unsigned voffA[2], voffB[2];
#pragma unroll
    for (int i = 0; i < 2; ++i) { int R, C; stage_rc(tid * 16 + i * 8192, R, C); const int Rb = Epi::PERM ? ((R & ~31) + perm32(R & 31)) : R;
        voffA[i] = (unsigned)(R * g.lda + C) * 2u; voffB[i] = (unsigned)(Rb * g.ldb + C) * 2u; }
    const size_t kstep = (size_t)(BK * 2);
    const size_t hstepA = (size_t)HALF * g.lda * 2, hstepB = (size_t)HALF * g.ldb * 2;
    const size_t tstepA = 2 * hstepA, tstepB = 2 * hstepB;
    const unsigned ldsw = (unsigned)wid * 1024u;
    const int aoff = lds_byte(wr * 64 + fr, fq * 8), boff = lds_byte(wc * 32 + fr, fq * 8);
#define PG8_SA(b, h) (((b) * 2 + (h)) * HTB)
#define PG8_SB(b, h) ((4 + (b) * 2 + (h)) * HTB)
#define PG8_STAGE(bufoff, gbase, voff) do { _Pragma("unroll") for (int _i = 0; _i < 2; ++_i) \
        __builtin_amdgcn_global_load_lds((const unsigned*)((const char*)(gbase) + (voff)[_i]), (LAS unsigned*)(lds + (bufoff) + ldsw + _i * 8192), 16, 0, 0); } while (0)
#define PG8_LDA(dst, b, h) do { _Pragma("unroll") for (int m = 0; m < 4; ++m) _Pragma("unroll") for (int k = 0; k < 2; ++k) dst[m][k] = *(const LAS h8*)(lds + PG8_SA(b, h) + aoff + m * 2048 + k * 1024); } while (0)
#define PG8_LDB(dst, b, h) do { _Pragma("unroll") for (int n = 0; n < 2; ++n) _Pragma("unroll") for (int k = 0; k < 2; ++k) dst[n][k] = *(const LAS h8*)(lds + PG8_SB(b, h) + boff + n * 2048 + k * 1024); } while (0)
#define PG8_MMA(ai, bj, At, Bt) do { __builtin_amdgcn_s_setprio(1); _Pragma("unroll") for (int m = 0; m < 4; ++m) _Pragma("unroll") for (int n = 0; n < 2; ++n) _Pragma("unroll") for (int k = 0; k < 2; ++k) \
        acc[ai][bj][m][n] = __builtin_amdgcn_mfma_f32_16x16x32_f16(Bt[n][k], At[m][k], acc[ai][bj][m][n], 0, 0, 0); __builtin_amdgcn_s_setprio(0); } while (0)
#define PG8_WAIT_V(n) asm volatile("s_waitcnt vmcnt(" #n ")" ::: "memory")
#define PG8_WAIT_L(n) asm volatile("s_waitcnt lgkmcnt(" #n ")" ::: "memory")
#define PG8_BAR __builtin_amdgcn_s_barrier()
#define PG8_SCHED __builtin_amdgcn_sched_barrier(0)
    Unit cur, nxt; int ui = 0;
    if (!S.next(0, cur)) return;
    f4 acc[2][2][4][2];
#pragma unroll
    for (int a = 0; a < 2; ++a)
#pragma unroll
        for (int b = 0; b < 2; ++b)
#pragma unroll
            for (int m = 0; m < 4; ++m)
#pragma unroll
                for (int n = 0; n < 2; ++n) acc[a][b][m][n] = (f4){0.f, 0.f, 0.f, 0.f};
    h8 At[4][2], B0[2][2], B1[2][2];
    const char* cA = (const char*)g.A + (size_t)cur.pm * tstepA; const char* cB = (const char*)g.Bt + (size_t)cur.pn * tstepB;
    PG8_STAGE(PG8_SB(0, 0), cB, voffB); PG8_STAGE(PG8_SA(0, 0), cA, voffA); PG8_STAGE(PG8_SB(0, 1), cB + hstepB, voffB); PG8_STAGE(PG8_SA(0, 1), cA + hstepA, voffA);
    if (wr == 1) PG8_BAR;
    PG8_WAIT_V(4); PG8_BAR;
    PG8_STAGE(PG8_SB(1, 0), cB + kstep, voffB); PG8_STAGE(PG8_SA(1, 0), cA + kstep, voffA); PG8_STAGE(PG8_SB(1, 1), cB + hstepB + kstep, voffB);
    PG8_WAIT_V(6); PG8_BAR;
    for (;;) {
        const bool has_next = S.next(ui + 1, nxt);
        const char* nA = has_next ? (const char*)g.A + (size_t)nxt.pm * tstepA : cA; const char* nB = has_next ? (const char*)g.Bt + (size_t)nxt.pn * tstepB : cB;
        for (int t = 0; t < nt; t += 2) {
            const bool last = (t == nt - 2);
            const char* a1 = cA + (size_t)(t + 1) * kstep;
            const char* a2 = last ? nA : cA + (size_t)(t + 2) * kstep; const char* b2 = last ? nB : cB + (size_t)(t + 2) * kstep;
            const char* a3 = a2 + kstep; const char* b3 = b2 + kstep;
            PG8_LDB(B0, 0, 0); PG8_SCHED; PG8_LDA(At, 0, 0); PG8_STAGE(PG8_SA(1, 1), a1 + hstepA, voffA);
            PG8_WAIT_L(8); PG8_BAR; PG8_WAIT_L(0); PG8_MMA(0, 0, At, B0); PG8_BAR; PG8_SCHED;
            PG8_LDB(B1, 0, 1); PG8_STAGE(PG8_SB(0, 0), b2, voffB);
            PG8_BAR; PG8_WAIT_L(0); PG8_MMA(0, 1, At, B1); PG8_BAR;
            PG8_LDA(At, 0, 1); PG8_STAGE(PG8_SA(0, 0), a2, voffA);
            PG8_BAR; PG8_WAIT_L(0); PG8_MMA(1, 0, At, B0); PG8_BAR; PG8_SCHED;
            PG8_STAGE(PG8_SB(0, 1), b2 + hstepB, voffB);
            PG8_WAIT_V(6); PG8_BAR; PG8_MMA(1, 1, At, B1); PG8_BAR;
            PG8_LDB(B0, 1, 0); PG8_SCHED; PG8_LDA(At, 1, 0); PG8_STAGE(PG8_SA(0, 1), a2 + hstepA, voffA);
            PG8_WAIT_L(8); PG8_BAR; PG8_WAIT_L(0); PG8_MMA(0, 0, At, B0); PG8_BAR; PG8_SCHED;
            PG8_LDB(B1, 1, 1); PG8_STAGE(PG8_SB(1, 0), b3, voffB);
            PG8_BAR; PG8_WAIT_L(0); PG8_MMA(0, 1, At, B1); PG8_BAR;
            PG8_LDA(At, 1, 1); PG8_STAGE(PG8_SA(1, 0), a3, voffA);
            PG8_BAR; PG8_WAIT_L(0); PG8_MMA(1, 0, At, B0); PG8_BAR; PG8_SCHED;
            PG8_STAGE(PG8_SB(1, 1), b3 + hstepB, voffB);
            PG8_WAIT_V(6); PG8_BAR; PG8_MMA(1, 1, At, B1); PG8_BAR;
        }
        { int t2 = tid; asm volatile("" : "+v"(t2)); const int l2 = t2 & 63; E(acc, cur, wr, wc, l2 & 15, l2 >> 4); }
        if (!has_next) break;
#pragma unroll
        for (int a = 0; a < 2; ++a)
#pragma unroll
            for (int b = 0; b < 2; ++b)
#pragma unroll
                for (int m = 0; m < 4; ++m)
#pragma unroll
                    for (int n = 0; n < 2; ++n) acc[a][b][m][n] = (f4){0.f, 0.f, 0.f, 0.f};
        cur = nxt; cA = nA; cB = nB; ++ui;
    }
    PG8_WAIT_V(0);
    if (wr == 0) PG8_BAR;
    PG8_BAR;
#undef PG8_SA
#undef PG8_SB
#undef PG8_STAGE
#undef PG8_LDA
#undef PG8_LDB
#undef PG8_MMA
#undef PG8_WAIT_V
#undef PG8_WAIT_L
#undef PG8_BAR
#undef PG8_SCHED
}

typedef f4 Acc[2][2][4][2];
#define EPI_ROWS for (int ai = 0; ai < 2; ++ai) _Pragma("unroll") for (int m = 0; m < 4; ++m)

#define ROW_OF(r) (rowb + ((r) >> 2) * HALF + ((r) & 3) * 16)
struct EpiZ {
    static constexpr bool PERM = true;
    h16* z; float* sv; const float* st; const float* cv; const float* dv; bool fold;
    DEVI void operator()(const Acc& acc, const Unit& u, int wr, int wc, int fr, int fq) const {
        const int rowb = u.pm * BM + wr * 64 + fr, colb = u.pn * BM + wc * 32 + fq * 8;
        float mean[8], rstd[8]; f4 c[2][2], d[2][2];
#pragma unroll
        for (int r = 0; r < 8; ++r) { mean[r] = 0.f; rstd[r] = 1.f; }
#pragma unroll
        for (int bj = 0; bj < 2; ++bj)
#pragma unroll
            for (int n = 0; n < 2; ++n) { c[bj][n] = (f4){0.f, 0.f, 0.f, 0.f}; d[bj][n] = c[bj][n]; }
        if (fold) {
#pragma unroll
            for (int r = 0; r < 8; ++r) { const int row = ROW_OF(r); const float sm = st[2 * row], sq = st[2 * row + 1]; mean[r] = sm * (1.f / DM); rstd[r] = rsqrtf(sq * (1.f / DM) - mean[r] * mean[r] + 1e-5f); }
#pragma unroll
            for (int bj = 0; bj < 2; ++bj)
#pragma unroll
                for (int n = 0; n < 2; ++n) { c[bj][n] = *(const f4*)(cv + colb + bj * HALF + 4 * n); d[bj][n] = *(const f4*)(dv + colb + bj * HALF + 4 * n); } }
#pragma unroll
        for (int bj = 0; bj < 2; ++bj) { const int col = colb + bj * HALF; const bool act = col < 512 || (col >= 1440 && col < 1696);
#pragma unroll
            for (int r = 0; r < 8; ++r) { const int row = ROW_OF(r);
                f4 v0 = (acc[r >> 2][bj][r & 3][0] - c[bj][0] * mean[r]) * rstd[r] + d[bj][0], v1 = (acc[r >> 2][bj][r & 3][1] - c[bj][1] * mean[r]) * rstd[r] + d[bj][1];
                if (act) {
#pragma unroll
                    for (int e = 0; e < 4; ++e) { v0[e] = gelu_f(v0[e]); v1[e] = gelu_f(v1[e]); } }
                *(h8*)(z + (size_t)row * ZW + col) = pack8(v0, v1);
                if (row >= MP && col >= 256 && col < 512) { float* o = sv + (size_t)(row - MP) * 256 + (col - 256); *(f4*)o = v0; *(f4*)(o + 4) = v1; } } }
    }
};
struct EpiQ {
    static constexpr bool PERM = true;
    h16* q; h16* qlat; const float* ropec; const float* ropes;
    DEVI void operator()(const Acc& acc, const Unit& u, int wr, int wc, int fr, int fq) const {
        const bool samp = u.pm * BM >= MP;
        if (u.pn < 2) { if (samp) return;
#pragma unroll
            EPI_ROWS { const int row = u.pm * BM + ai * HALF + wr * 64 + m * 16 + fr;
#pragma unroll
                for (int bj = 0; bj < 2; ++bj) { const int col = u.pn * BM + bj * HALF + wc * 32 + fq * 8;
                    *(h8*)(q + (size_t)row * QW + (col >> 6) * 96 + (col & 63)) = pack8(acc[ai][bj][m][0] * QSCALE, acc[ai][bj][m][1] * QSCALE); } }
        } else {
            const int j = wc * 32 + fq * 8, head = j >> 4, i0 = j & 15; const int rowb = u.pm * BM + wr * 64 + fr;
            f4 cc[2], ss[2], cn[2], sn[2];
            { const int row = ROW_OF(0); const int pidx = samp ? SEQ + ((row - MP) & 31) : (row & (SEQ - 1));
#pragma unroll
              for (int n = 0; n < 2; ++n) { cc[n] = *(const f4*)(ropec + pidx * 16 + i0 + 4 * n); ss[n] = *(const f4*)(ropes + pidx * 16 + i0 + 4 * n); } }
#pragma unroll
            for (int r = 0; r < 8; ++r) { const int row = ROW_OF(r);
                if (r < 7) { const int rown = ROW_OF(r + 1); const int pidx = samp ? SEQ + ((rown - MP) & 31) : (rown & (SEQ - 1));
#pragma unroll
                    for (int n = 0; n < 2; ++n) { cn[n] = *(const f4*)(ropec + pidx * 16 + i0 + 4 * n); sn[n] = *(const f4*)(ropes + pidx * 16 + i0 + 4 * n); } }
                const size_t po = samp ? (W_QLAT - W_Q) / 2 + (size_t)(row - MP) * QLW + head * 288 + 256 + i0 : (size_t)row * QW + head * 96 + 64 + i0;
#pragma unroll
                for (int n = 0; n < 2; ++n) { const f4 a0 = acc[r >> 2][0][r & 3][n], b0 = acc[r >> 2][1][r & 3][n];
                    *(h4*)(q + po + 4 * n) = pack4((a0 * cc[n] - b0 * ss[n]) * QSCALE); *(h4*)(q + po + 16 + 4 * n) = pack4((a0 * ss[n] + b0 * cc[n]) * QSCALE); }
#pragma unroll
                for (int n = 0; n < 2; ++n) { cc[n] = cn[n]; ss[n] = sn[n]; } }
        }
    }
};
struct EpiKV {
    static constexpr bool PERM = true;
    h16* k; h16* v;
    DEVI void operator()(const Acc& acc, const Unit& u, int wr, int wc, int fr, int fq) const {
#pragma unroll
        EPI_ROWS { const int row = u.pm * BM + ai * HALF + wr * 64 + m * 16 + fr;
#pragma unroll
            for (int bj = 0; bj < 2; ++bj) { const int col = u.pn * BM + bj * HALF + wc * 32 + fq * 8; const h8 o = pack8(acc[ai][bj][m][0], acc[ai][bj][m][1]);
                if (u.pn < 2) *(h8*)(k + (size_t)row * KW + (col >> 6) * 96 + (col & 63)) = o; else *(h8*)(v + (size_t)row * VW + (col - 512)) = o; } }
    }
};
DEVI float one_minus_exp(float x) {
    const float pser = -x * (1.f + x * (0.5f + x * (0.16666667f + x * (0.041666668f + x * (0.0083333338f + x * 0.0013888889f)))));
    return x > -0.25f ? pser : 1.f - __expf(x);
}
struct EpiGate {
    static constexpr bool PERM = false;
    const h16* xc; float* a; float* b; const float* br; const float* bi; const float* sp;
    DEVI void operator()(const Acc& acc, const Unit& u, int wr, int wc, int fr, int fq) const {
        const int rowb = u.pm * BM + wr * 64 + fr, chb = u.pn * 128 + wc * 32 + fq * 4;
        f4 vbr[2], vbi[2], vsp[2]; h4 xv[2][8];
#pragma unroll
        for (int n = 0; n < 2; ++n) { const int ch = chb + n * 16; vbr[n] = *(const f4*)(br + ch); vbi[n] = *(const f4*)(bi + ch); vsp[n] = *(const f4*)(sp + ch) * -8.f;
#pragma unroll
            for (int r = 0; r < 8; ++r) xv[n][r] = *(const h4*)(xc + (size_t)ROW_OF(r) * 256 + ch); }
#pragma unroll
        for (int n = 0; n < 2; ++n) { const int ch = chb + n * 16;
#pragma unroll
            for (int r = 0; r < 8; ++r) { const int row = ROW_OF(r); f4 oa, ob;
#pragma unroll
                for (int e = 0; e < 4; ++e) { const float rg = sigmoid_f(acc[r >> 2][0][r & 3][n][e] + vbr[n][e]), ig = sigmoid_f(acc[r >> 2][1][r & 3][n][e] + vbi[n][e]);
                    const float la = rg * vsp[n][e]; oa[e] = __expf(la); ob[e] = sqrtf(one_minus_exp(2.f * la)) * (ig * (float)xv[n][r][e]); }
                *(f4*)(a + (size_t)row * 256 + ch) = oa; *(f4*)(b + (size_t)row * 256 + ch) = ob; } }
    }
};
struct EpiQlat {
    static constexpr bool PERM = true;
    h16* qlat;
    DEVI void operator()(const Acc& acc, const Unit& u, int wr, int wc, int fr, int fq) const {
#pragma unroll
        EPI_ROWS { const int row = u.pm * BM + ai * HALF + wr * 64 + m * 16 + fr;
#pragma unroll
            for (int bj = 0; bj < 2; ++bj) { const int c = bj * HALF + wc * 32 + fq * 8;
                *(h8*)(qlat + (size_t)row * QLW + u.pn * 288 + c) = pack8(acc[ai][bj][m][0] * QSCALE, acc[ai][bj][m][1] * QSCALE); } }
    }
};
struct EpiRes {
    static constexpr bool PERM = false;
    const float* src; const float* pst; const float* g; const float* b; bool ln; float* pre; h16* xh; float* ost;
    DEVI void operator()(const Acc& acc, const Unit& u, int wr, int wc, int fr, int fq) const {
        const int rowb = u.pm * BM + wr * 64 + fr, colb = u.pn * BM + wc * 32 + fq * 4, lane = fq * 16 + fr;
        f4 gv[4], bv[4]; float mean[8], rstd[8];
#pragma unroll
        for (int k = 0; k < 4; ++k) { const int col = colb + (k >> 1) * HALF + (k & 1) * 16; gv[k] = ln ? *(const f4*)(g + col) : (f4){1.f, 1.f, 1.f, 1.f}; bv[k] = ln ? *(const f4*)(b + col) : (f4){0.f, 0.f, 0.f, 0.f}; }
#pragma unroll
        for (int r = 0; r < 8; ++r) { mean[r] = 0.f; rstd[r] = 1.f;
            if (ln) { const int row = ROW_OF(r); const float sm = pst[2 * row], sq = pst[2 * row + 1]; mean[r] = sm * (1.f / DM); rstd[r] = rsqrtf(sq * (1.f / DM) - mean[r] * mean[r] + 1e-5f); } }
        f4 cur[4], nxt[4];
#pragma unroll
        for (int k = 0; k < 4; ++k) cur[k] = *(const f4*)(src + (size_t)ROW_OF(0) * DM + colb + (k >> 1) * HALF + (k & 1) * 16);
#pragma unroll
        for (int r = 0; r < 8; ++r) { const int row = ROW_OF(r);
            if (r < 7) {
#pragma unroll
                for (int k = 0; k < 4; ++k) nxt[k] = *(const f4*)(src + (size_t)ROW_OF(r + 1) * DM + colb + (k >> 1) * HALF + (k & 1) * 16); }
            float s1 = 0.f, s2 = 0.f;
#pragma unroll
            for (int k = 0; k < 4; ++k) { const size_t o = (size_t)row * DM + colb + (k >> 1) * HALF + (k & 1) * 16;
                const f4 xr = (cur[k] - mean[r]) * rstd[r] * gv[k] + bv[k];
                const f4 y = xr * ALPHA + acc[r >> 2][k >> 1][r & 3][k & 1];
                *(f4*)(pre + o) = y; *(h4*)(xh + o) = pack4(y);
                s1 += (y[0] + y[1]) + (y[2] + y[3]); s2 += (y[0] * y[0] + y[1] * y[1]) + (y[2] * y[2] + y[3] * y[3]); }
            s1 += shx(s1, 16, lane); s2 += shx(s2, 16, lane); s1 += shx(s1, 32, lane); s2 += shx(s2, 32, lane);
            if (fq == 0) { atomicAdd(ost + 2 * row, s1); atomicAdd(ost + 2 * row + 1, s2); }
#pragma unroll
            for (int k = 0; k < 4; ++k) cur[k] = nxt[k]; }
    }
};
struct EpiUp {
    static constexpr bool PERM = true;
    h16* up; float* pfc; size_t sdelta; const float* st; const float* cv; const float* dv;
    DEVI void operator()(const Acc& acc, const Unit& u, int wr, int wc, int fr, int fq) const {
        const int rowb = u.pm * BM + wr * 64 + fr, colb = u.pn * BM + wc * 32 + fq * 8;
        float mean[8], rstd[8]; f4 c[2][2], d[2][2];
#pragma unroll
        for (int r = 0; r < 8; ++r) { const int row = ROW_OF(r); const float sm = st[2 * row], sq = st[2 * row + 1]; mean[r] = sm * (1.f / DM); rstd[r] = rsqrtf(sq * (1.f / DM) - mean[r] * mean[r] + 1e-5f); }
#pragma unroll
        for (int bj = 0; bj < 2; ++bj)
#pragma unroll
            for (int n = 0; n < 2; ++n) { c[bj][n] = *(const f4*)(cv + colb + bj * HALF + 4 * n); d[bj][n] = *(const f4*)(dv + colb + bj * HALF + 4 * n); }
#pragma unroll
        for (int r = 0; r < 8; ++r) { const int row = ROW_OF(r);
            bool has_st; size_t so;
            if (row < MP) { const int t = row & (SEQ - 1); has_st = t >= SEQ - 2; so = ((size_t)(row >> 11) * 2 + (t - (SEQ - 2))) * DFF2; }
            else { const int rs = row - MP, t = rs & 31; has_st = t >= DSEQ - 2; so = sdelta + ((size_t)(rs >> 5) * 2 + (t - (DSEQ - 2))) * DFF2; }
#pragma unroll
            for (int bj = 0; bj < 2; ++bj) { const int col = colb + bj * HALF;
                const f4 v0 = (acc[r >> 2][bj][r & 3][0] - c[bj][0] * mean[r]) * rstd[r] + d[bj][0], v1 = (acc[r >> 2][bj][r & 3][1] - c[bj][1] * mean[r]) * rstd[r] + d[bj][1];
                *(h8*)(up + (size_t)row * DFF2 + col) = pack8(v0, v1);
                if (has_st) { float* sp = pfc + so + col; *(f4*)sp = v0; *(f4*)(sp + 4) = v1; } } }
    }
};

template <int MODE>
DEVI void transpose_item(const float* W, int ldw, int nblk, h16* WT, int ldd, LAS float* scr, int item, int lane, const float* gs = nullptr) {
    const int kb = item / nblk, nb = item % nblk, k0 = 64 * kb, n0 = 32 * nb;
    int nsrc = n0 + (lane & 31);
    if (MODE == 1) { const int n = nsrc; if (n < 512) nsrc = (n >> 6) * 96 + (n & 63); else if (n < 640) nsrc = ((n - 512) >> 4) * 96 + 64 + ((n - 512) & 15); else nsrc = ((n - 640) >> 4) * 96 + 80 + ((n - 640) & 15); }
#pragma unroll 8
    for (int i = 0; i < 32; ++i) { const int kk = 2 * i + (lane >> 5); float w = W[(size_t)(k0 + kk) * ldw + nsrc]; if (gs) w *= gs[k0 + kk]; scr[kk * 33 + (lane & 31)] = w; }
    __builtin_amdgcn_fence(__ATOMIC_RELEASE, "wavefront"); asm volatile("s_waitcnt lgkmcnt(0)" ::: "memory");
    const int c = lane & 7;
#pragma unroll
    for (int j = 0; j < 4; ++j) { const int n = (lane >> 3) + 8 * j; const LAS float* s = scr + (8 * c) * 33 + n;
        h8 o; o[0] = (h16)s[0 * 33]; o[1] = (h16)s[1 * 33]; o[2] = (h16)s[2 * 33]; o[3] = (h16)s[3 * 33]; o[4] = (h16)s[4 * 33]; o[5] = (h16)s[5 * 33]; o[6] = (h16)s[6 * 33]; o[7] = (h16)s[7 * 33];
        *(h8*)(WT + (size_t)(n0 + n) * ldd + k0 + 8 * c) = o; }
    asm volatile("s_waitcnt lgkmcnt(0)" ::: "memory");
}

template <int NKS, int NCT, int NQS, int KSTR>
DEVI void attn_qk(LAS unsigned char* kbase, const h8 (&qf)[NQS][NKS], f4 (&o)[NQS][NCT], float (&mrow)[NQS], float (&lrow)[NQS], h8 (&pf)[NQS][2], const int nkt, const int lane) {
    const int fr = lane & 15, g = lane >> 4;
    f4 s[NQS][4];
#pragma unroll
    for (int qs = 0; qs < NQS; ++qs)
#pragma unroll
        for (int kt = 0; kt < 4; ++kt) s[qs][kt] = (f4){-1e30f, -1e30f, -1e30f, -1e30f};
#pragma unroll
    for (int kt = 0; kt < 4; ++kt) if (kt < nkt) {
#pragma unroll
        for (int qs = 0; qs < NQS; ++qs) s[qs][kt] = (f4){0.f, 0.f, 0.f, 0.f};
#pragma unroll
        for (int ks = 0; ks < NKS; ++ks) { const h8 kf = *(const LAS h8*)(kbase + (kt * 16 + fr) * KSTR + ks * 64 + g * 16);
#pragma unroll
            for (int qs = 0; qs < NQS; ++qs) s[qs][kt] = __builtin_amdgcn_mfma_f32_16x16x32_f16(kf, qf[qs][ks], s[qs][kt], 0, 0, 0); } }
    __builtin_amdgcn_sched_barrier(0);
#pragma unroll
    for (int qs = 0; qs < NQS; ++qs) {
        float mx = -1e30f;
#pragma unroll
        for (int kt = 0; kt < 4; ++kt)
#pragma unroll
            for (int e = 0; e < 4; ++e) mx = fmaxf(mx, s[qs][kt][e]);
        mx = fmaxf(mx, shx(mx, 16, lane)); mx = fmaxf(mx, shx(mx, 32, lane));
        const float mnew = fmaxf(mrow[qs], mx), alpha = exp2f(mrow[qs] - mnew); mrow[qs] = mnew;
        float ps = 0.f;
#pragma unroll
        for (int kt = 0; kt < 4; ++kt)
#pragma unroll
            for (int e = 0; e < 4; ++e) { const float p = exp2f(s[qs][kt][e] - mnew); s[qs][kt][e] = p; ps += p; }
        lrow[qs] = lrow[qs] * alpha + ps;
#pragma unroll
        for (int ct = 0; ct < NCT; ++ct) o[qs][ct] *= alpha;
#pragma unroll
        for (int k2 = 0; k2 < 2; ++k2) pf[qs][k2] = pack8(s[qs][2 * k2], s[qs][2 * k2 + 1]);
    }
    __builtin_amdgcn_sched_barrier(0);
}
template <int NCT, int NQS, int VSTR>
DEVI void attn_pv(LAS unsigned char* vbase, f4 (&o)[NQS][NCT], const h8 (&pf)[NQS][2], const int nkt, const int lane) {
    const int fr = lane & 15, g = lane >> 4, q_ = fr >> 2, p_ = fr & 3;
#pragma unroll
    for (int k2 = 0; k2 < 2; ++k2) if (2 * k2 < nkt) {
#pragma unroll
        for (int ct = 0; ct < NCT; ++ct) {
            const h4 lo = trrd(vbase + (32 * k2 + 4 * g + q_) * VSTR + (16 * ct + 4 * p_) * 2);
            const h4 hi = trrd(vbase + (32 * k2 + 16 + 4 * g + q_) * VSTR + (16 * ct + 4 * p_) * 2);
            const h8 vf = cat44(lo, hi);
#pragma unroll
            for (int qs = 0; qs < NQS; ++qs) o[qs][ct] = __builtin_amdgcn_mfma_f32_16x16x32_f16(vf, pf[qs][k2], o[qs][ct], 0, 0, 0); } }
    __builtin_amdgcn_sched_barrier(0);
}
template <int NKS, int NCT, int NQS, int KSTR, int VSTR>
DEVI void attn_tile(LAS unsigned char* kbase, LAS unsigned char* vbase, const h8 (&qf)[NQS][NKS], f4 (&o)[NQS][NCT], float (&mrow)[NQS], float (&lrow)[NQS], const int nkt, const int lane) {
    h8 pf[NQS][2];
    attn_qk<NKS, NCT, NQS, KSTR>(kbase, qf, o, mrow, lrow, pf, nkt, lane);
    attn_pv<NCT, NQS, VSTR>(vbase, o, pf, nkt, lane);
}


#define XB_TMO      128
#define XB_XCNT(j)  (256  + 64 * (j))
#define XB_XSUB(j)  (1280 + 64 * (j))
#define XB_XGEN(j)  (2304 + 64 * (j))
#define XB_TOP      3328
#define XB_TOPGEN   3392
#define XCD_BAR_WORDS 3456
#define XB_SPIN_CAP (1u << 18)
DEVI unsigned xb_ld(unsigned* p)              { return __hip_atomic_load(p, __ATOMIC_RELAXED, __HIP_MEMORY_SCOPE_AGENT); }
DEVI unsigned xb_add(unsigned* p, unsigned v) { return __hip_atomic_fetch_add(p, v, __ATOMIC_RELAXED, __HIP_MEMORY_SCOPE_AGENT); }
DEVI unsigned xb_xcc_id() { return (unsigned)__builtin_amdgcn_s_getreg((3 << 11) | 20) & 0xFu; }
#define XB_SPIN(cond, bar) do { unsigned _sp = 0; while (cond) { __builtin_amdgcn_s_sleep(1); \
    if ((++_sp & 255u) == 0u) { if (xb_ld(&(bar)[XB_TMO])) break; if (_sp > XB_SPIN_CAP) { atomicAdd(&(bar)[XB_TMO], 1u); break; } } } } while (0)
DEVI void xb_complete(unsigned* bar, unsigned x, unsigned& nloc, unsigned& nx, unsigned G) {
    unsigned sum, cnt, mine, sp = 0u;
    for (;;) {
        sum = 0u; cnt = 0u; mine = 0u;
#pragma unroll
        for (unsigned j = 0; j < 16; ++j) { const unsigned c = xb_ld(&bar[XB_XCNT(j)]); sum += c; cnt += (c > 0u) ? 1u : 0u; mine = (j == x) ? c : mine; }
        if (sum == G) break;
        __builtin_amdgcn_s_sleep(1);
        if ((++sp & 255u) == 0u) { if (xb_ld(&bar[XB_TMO])) break; if (sp > XB_SPIN_CAP) { atomicAdd(&bar[XB_TMO], 1u); break; } }
    }
    nloc = mine > 0u ? mine : 1u; nx = cnt > 0u ? cnt : 1u;
}
DEVI void xbar(unsigned* bar, volatile LAS unsigned* st, int tid, unsigned G) {
    asm volatile("s_waitcnt vmcnt(0)" ::: "memory");
    __syncthreads();
    if (tid == 0) {
        const unsigned x = xb_xcc_id();
        __builtin_amdgcn_s_waitcnt(0);
        unsigned nloc = st[0], nx = st[1];
        if (nloc == 0u) { xb_complete(bar, x, nloc, nx, G); st[0] = nloc; st[1] = nx; }
        const unsigned old = xb_add(&bar[XB_XSUB(x)], 1u);
        const unsigned gen = old / nloc;
        if (old + 1u == (gen + 1u) * nloc) {
            __builtin_amdgcn_fence(__ATOMIC_RELEASE, "agent");
            asm volatile("s_waitcnt vmcnt(0)" ::: "memory");
            const unsigned og = xb_add(&bar[XB_TOP], 1u);
            const unsigned tg = og / nx;
            if (og + 1u == (tg + 1u) * nx) xb_add(&bar[XB_TOPGEN], 1u);
            else XB_SPIN(xb_ld(&bar[XB_TOPGEN]) == tg, bar);
            __builtin_amdgcn_fence(__ATOMIC_ACQUIRE, "agent");
            xb_add(&bar[XB_XGEN(x)], 1u);
            asm volatile("s_waitcnt vmcnt(0)" ::: "memory");
        } else {
            XB_SPIN(xb_ld(&bar[XB_XGEN(x)]) == gen, bar);
            __builtin_amdgcn_fence(__ATOMIC_ACQUIRE, "agent");
            asm volatile("s_waitcnt vmcnt(0)" ::: "memory");
        }
    }
    __syncthreads();
}
#ifndef PHM
#define PHM 0xFFFFFFFFu
#endif
#ifndef DBL
#define DBL 0u
#endif
#define NREP(k) (((DBL >> (k)) & 1u) ? 2 : 1)
__global__ void __launch_bounds__(512, 2) trunk_fwd(Params p) {
    extern __shared__ __attribute__((aligned(16))) unsigned char shm_raw[];
    LAS unsigned char* lds = (LAS unsigned char*)shm_raw;
    __shared__ uint4 s_ctl;
#define s_item (*(LAS int*)&s_ctl)
    cg::grid_group grid = cg::this_grid();
    const int wave_s = __builtin_amdgcn_readfirstlane((int)threadIdx.x >> 6);
    if (threadIdx.x == 0) { s_ctl = make_uint4(0u, 0u, 0u, 0u); (void)xb_add((unsigned*)(p.ws + W_BAR) + XB_XCNT(xb_xcc_id()), 1u); }
    __syncthreads();
#define GSYNC() do { const __attribute__((address_space(4))) Params* kq = (const __attribute__((address_space(4))) Params*)__builtin_amdgcn_kernarg_segment_ptr(); asm volatile("" : "+s"(kq)); \
        unsigned Gq = gridDim.x; asm volatile("" : "+s"(Gq)); xbar((unsigned*)(kq->ws + W_BAR), (volatile LAS unsigned*)&s_ctl + 1, wave_s * 64 + opaque_lane(), Gq); } while (0)
#define PH_BEGIN \
    int tid = wave_s * 64 + opaque_lane(); asm volatile("" : "+v"(tid)); \
    int bid = blockIdx.x, G = gridDim.x, lq = l; asm volatile("" : "+s"(bid), "+s"(G), "+s"(lq)); \
    const int lane = tid & 63, wave = __builtin_amdgcn_readfirstlane(tid >> 6); \
    const int gw = bid * 8 + wave, NGW = G * 8; const size_t gtid = (size_t)bid * 512 + tid, NGT = (size_t)G * 512; \
    const __attribute__((address_space(4))) Params* kp = (const __attribute__((address_space(4))) Params*)__builtin_amdgcn_kernarg_segment_ptr(); asm volatile("" : "+s"(kp)); \
    unsigned char* ws = kp->ws; float* out = kp->out; \
    (void)lane; (void)wave; (void)gw; (void)NGW; (void)gtid; (void)NGT; (void)out; (void)lq;
#define WSP(T, off) ((T*)(ws + (off)))
    for (int rep = 0; rep < NREP(0); ++rep) if (PHM & 1u) {
        int tid = wave_s * 64 + opaque_lane(); asm volatile("" : "+v"(tid));
        const int bid = blockIdx.x, G = gridDim.x, lane = tid & 63, wave = __builtin_amdgcn_readfirstlane(tid >> 6);
        const int gw = bid * 8 + wave, NGW = G * 8; const size_t gtid = (size_t)bid * 512 + tid, NGT = (size_t)G * 512;
        unsigned char* ws = p.ws;
        h16* xh = WSP(h16, W_XH); float* ropec = WSP(float, W_ROPE); float* ropes = ropec + NPOS * 16;
        for (size_t i = gtid; i < (size_t)MT * DM / 8; i += NGT) { const size_t e = i * 8; const float* src = e < (size_t)MP * DM ? p.in[0] + e : p.in[1] + (e - (size_t)MP * DM);
            *(h8*)(xh + e) = pack8(*(const f4*)src, *(const f4*)(src + 4)); }
        for (size_t i = gtid; i < (size_t)NPOS * 16; i += NGT) { const int pi = (int)(i >> 4), fi = (int)(i & 15); const double pos = pi < SEQ ? (double)pi : (double)(PAST + pi - SEQ);
            const double ang = pos * exp(-(double)fi / 16.0 * 9.210340371976184); ropec[i] = (float)cos(ang); ropes[i] = (float)sin(ang); }
        for (size_t i = gtid; i < (size_t)DEPTH * 256; i += NGT) WSP(float, W_SP)[i] = log1pf(expf(-p.in[26][i]));
        LAS float* scr = (LAS float*)(lds + wave * 8448);
        for (int l = 0; l < DEPTH; ++l) {
            h16* wt_in = WSP(h16, W_WIN + l * SZ_WIN); h16* wt_uq = WSP(h16, W_WUQ + l * SZ_WUQ); h16* wt_kv = WSP(h16, W_WKV + l * SZ_WKV);
            h16* wt_o = WSP(h16, W_WO + l * SZ_WO); h16* wt_os = WSP(h16, W_WOS + l * SZ_WOS); h16* wt_up = WSP(h16, W_WUP + l * SZ_WUP); h16* wt_dn = WSP(h16, W_WDN + l * SZ_WDN);
            h16* wt_ql = WSP(h16, W_WQL + l * SZ_WQL); h16* wt_g = WSP(h16, W_WG + l * SZ_WG);
            const float* w_in = p.in[11] + (size_t)l * DM * DIN; const float* w_o = p.in[12] + (size_t)l * DM * DM; const float* w_uq = p.in[16] + (size_t)l * 384 * 768;
            const float* w_uk = p.in[18] + (size_t)l * 256 * 512; const float* w_uv = p.in[19] + (size_t)l * 256 * 512; const float* w_up = p.in[27] + (size_t)l * DM * DFF2; const float* w_dn = p.in[30] + (size_t)l * DFF * DM;
            const float* w_r = p.in[22] + (size_t)l * 4 * 64 * 64; const float* w_i = p.in[24] + (size_t)l * 4 * 64 * 64;
            for (int it = gw; it < 16 * 53; it += NGW) transpose_item<0>(w_in, DIN, 53, wt_in, 1024, scr, it, lane, l > 0 ? p.in[9] + (l - 1) * DM : nullptr);
            for (int it = gw; it < 6 * 24; it += NGW) transpose_item<1>(w_uq, 768, 24, wt_uq, 384, scr, it, lane);
            for (int it = gw; it < 4 * 16; it += NGW) transpose_item<0>(w_uk, 512, 16, wt_kv, 256, scr, it, lane);
            for (int it = gw; it < 4 * 16; it += NGW) transpose_item<0>(w_uv, 512, 16, wt_kv + 512 * 256, 256, scr, it, lane);
            for (int it = gw; it < 16 * 32; it += NGW) transpose_item<0>(w_o, 1024, 32, wt_o, 1024, scr, it, lane);
            for (int it = gw; it < 4 * 32; it += NGW) transpose_item<0>(w_o, 1024, 32, wt_os, CSW, scr, it, lane);
            for (int it = gw; it < 4 * 32; it += NGW) transpose_item<0>(w_o + (size_t)768 * 1024, 1024, 32, wt_os + 2304, CSW, scr, it, lane);
            for (int it = gw; it < 16 * 176; it += NGW) transpose_item<0>(w_up, DFF2, 176, wt_up, 1024, scr, it, lane, p.in[7] + l * DM);
            for (int it = gw; it < 44 * 32; it += NGW) transpose_item<0>(w_dn, 1024, 32, wt_dn, DFF, scr, it, lane);
            for (size_t i = gtid; i < (size_t)(ZW - DIN) * 1024 / 8; i += NGT) *(h8*)(wt_in + (size_t)DIN * 1024 + i * 8) = (h8){0, 0, 0, 0, 0, 0, 0, 0};
            { float* cd = WSP(float, W_CD + l * SZ_CD);
              for (size_t i = gtid; i < (size_t)(DIN + DFF2) * 8; i += NGT) { const int kq = (int)(i / (DIN + DFF2)), nn = (int)(i % (DIN + DFF2)); const bool isup = nn >= DIN; const int n = isup ? nn - DIN : nn;
                  if (!isup && l == 0) continue;
                  const float* W = isup ? w_up : w_in; const int ldw = isup ? DFF2 : DIN; const float* gg = isup ? p.in[7] + l * DM : p.in[9] + (l - 1) * DM; const float* bb = isup ? p.in[8] + l * DM : p.in[10] + (l - 1) * DM;
                  float cs = 0.f, ds = 0.f;
#pragma unroll 8
                  for (int k = kq * 128; k < kq * 128 + 128; ++k) { const float w = W[(size_t)k * ldw + n]; cs += gg[k] * w; ds += bb[k] * w; }
                  float* dst = isup ? cd + 2 * ZW : cd; const int stride = isup ? DFF2 : ZW;
                  atomicAdd(dst + n, cs); atomicAdd(dst + stride + n, ds); } }
            for (size_t i = gtid; i < (size_t)512 * 256; i += NGT) { const int n = (int)(i >> 8), k = (int)(i & 255); const int pn = n >> 8, jj = n & 127, isI = (n >> 7) & 1, ch = pn * 128 + jj;
                float v = 0.f; if ((k >> 6) == (ch >> 6)) v = (isI ? w_i : w_r)[((ch >> 6) * 64 + (k & 63)) * 64 + (ch & 63)];
                wt_g[i] = (h16)v; }
            for (size_t i = gtid; i < (size_t)2048 * 384; i += NGT) { const int n = (int)(i / 384), k = (int)(i % 384), hh = n >> 8, c = n & 255;
                const float* a = w_uq + (size_t)k * 768 + hh * 96; const float* b = w_uk + (size_t)c * 512 + hh * 64; float s = 0.f;
#pragma unroll 8
                for (int d = 0; d < 64; ++d) s += a[d] * b[d];
                wt_ql[i] = (h16)s; }
            for (size_t i = gtid; i < (size_t)2048 * 1024; i += NGT) { const int kk = (int)(i & 2047), n = (int)(i >> 11), hh = kk >> 8, c = kk & 255;
                const float* a = w_uv + (size_t)c * 512 + hh * 64; const float* b = w_o + (size_t)(256 + hh * 64) * 1024 + n; float s = 0.f;
#pragma unroll 8
                for (int d = 0; d < 64; ++d) s += a[d] * b[(size_t)d * 1024];
                wt_os[(size_t)n * CSW + 256 + kk] = (h16)s; }
        }
    }
    grid.sync();

    for (int l = 0; l < DEPTH; ++l) {
        for (int rep = 0; rep < NREP(1); ++rep) if (PHM & (1u << 1)) { PH_BEGIN
          Gemm g{WSP(h16, W_XH), WSP(h16, W_WIN + lq * SZ_WIN), MT, ZW, 1024, 1024, 1024}; StaticOrder S; S.init(MT, ZW, G, bid); const int lp = lq > 0 ? lq - 1 : 0; EpiZ E{WSP(h16, W_Z), out + O_SV + (size_t)lq * MS * 256, WSP(float, W_STATS + (size_t)(lp * 2 + 1) * SZ_STATS), WSP(float, W_CD + lq * SZ_CD), WSP(float, W_CD + lq * SZ_CD) + ZW, lq > 0}; gemm_phase(lds, g, S, E, tid); }
        GSYNC();

        for (int rep = 0; rep < NREP(2); ++rep) if (PHM & (1u << 2)) { PH_BEGIN
            const float* qn_g = kp->in[15] + lq * 384; const float* kvn_g = kp->in[17] + lq * 256;
            const float* cw = kp->in[20] + (size_t)lq * 4 * 256; const float* cb = kp->in[21] + lq * 256; const float* stc = kp->in[5] + (size_t)lq * DBATCH * 3 * 256;
            const h16* z = WSP(h16, W_Z); h16* cqn = WSP(h16, W_CQN); h16* ckvn = WSP(h16, W_CKVN); h16* knew = WSP(h16, W_KNEW); h16* kb = WSP(h16, W_K); h16* xc = WSP(h16, W_XC);
            const float* ropec = WSP(float, W_ROPE); const float* ropes = ropec + NPOS * 16;
            for (int row = gw; row < MT; row += NGW) {
                const h16* zr = z + (size_t)row * ZW; const bool samp = row >= MP; const int rs = row - MP;
                const int t = samp ? (rs & 31) : (row & (SEQ - 1)), bb = samp ? (rs >> 5) : (row >> 11);
                { float v[6]; float ss = 0.f;
#pragma unroll
                    for (int i = 0; i < 3; ++i) { const h2 x = *(const h2*)(zr + 512 + 2 * lane + 128 * i); v[2 * i] = (float)x[0]; v[2 * i + 1] = (float)x[1]; ss += v[2 * i] * v[2 * i] + v[2 * i + 1] * v[2 * i + 1]; }
                    const float rr = rsqrtf(wave_sum(ss, lane) * (1.f / 384.f) + 1e-6f);
#pragma unroll
                    for (int i = 0; i < 3; ++i) { const int c = 2 * lane + 128 * i; h2 o; o[0] = (h16)(v[2 * i] * rr * qn_g[c]); o[1] = (h16)(v[2 * i + 1] * rr * qn_g[c + 1]); *(h2*)(cqn + (size_t)row * 384 + c) = o; } }
                { const h4 x = *(const h4*)(zr + 896 + 4 * lane); f4 v; float ss = 0.f;
#pragma unroll
                    for (int e = 0; e < 4; ++e) { v[e] = (float)x[e]; ss += v[e] * v[e]; }
                    const float rr = rsqrtf(wave_sum(ss, lane) * (1.f / 256.f) + 1e-6f); const f4 gg = *(const f4*)(kvn_g + 4 * lane); v = v * rr * gg;
                    if (!samp) { *(f4*)(out + O_PLAT + ((size_t)lq * MP + row) * 256 + 4 * lane) = v; *(h4*)(ckvn + (size_t)row * 256 + 4 * lane) = pack4(v); }
                    else { *(f4*)(out + O_SLAT + ((size_t)lq * MS + rs) * 256 + 4 * lane) = v; *(h4*)(knew + (size_t)rs * KNW + 4 * lane) = pack4(v); } }
                if (lane < 16) { const int pidx = samp ? SEQ + t : t; const float c = ropec[pidx * 16 + lane], s = ropes[pidx * 16 + lane];
                    const float x1 = (float)zr[1152 + lane], x2 = (float)zr[1168 + lane], o1 = x1 * c - x2 * s, o2 = x1 * s + x2 * c;
                    if (!samp) { float* o = out + O_PKR + ((size_t)lq * MP + row) * 32; o[lane] = o1; o[16 + lane] = o2;
                        h16* kr = kb + (size_t)row * KW + 64;
#pragma unroll
                        for (int hh = 0; hh < 8; ++hh) { kr[hh * 96 + lane] = (h16)o1; kr[hh * 96 + 16 + lane] = (h16)o2; } }
                    else { float* o = out + O_SKR + ((size_t)lq * MS + rs) * 32; o[lane] = o1; o[16 + lane] = o2; knew[(size_t)rs * KNW + 256 + lane] = (h16)o1; knew[(size_t)rs * KNW + 272 + lane] = (h16)o2; } }
                { const int c = 4 * lane; f4 accv = *(const f4*)(cb + c);
#pragma unroll
                    for (int j = 0; j < 4; ++j) { const int tau = t - 3 + j; f4 xv;
                        if (tau >= 0) { const h4 x = *(const h4*)(zr - (ptrdiff_t)(3 - j) * ZW + 1184 + c); xv = (f4){(float)x[0], (float)x[1], (float)x[2], (float)x[3]}; }
                        else if (samp) xv = *(const f4*)(stc + ((size_t)bb * 3 + (3 + tau)) * 256 + c);
                        else xv = (f4){0.f, 0.f, 0.f, 0.f};
                        accv += xv * *(const f4*)(cw + j * 256 + c);
                        if (j == 3) { const int T = samp ? DSEQ : SEQ; if (t >= T - 3) { float* o = samp ? out + O_SLC + (((size_t)lq * DBATCH + bb) * 3 + (t - (T - 3))) * 256 : out + O_PLC + (((size_t)lq * NB + bb) * 3 + (t - (T - 3))) * 256; *(f4*)(o + c) = xv; } } }
                    *(h4*)(xc + (size_t)row * 256 + c) = pack4(accv); }
            }
        }
        GSYNC();

        for (int rep = 0; rep < NREP(3); ++rep) if (PHM & (1u << 3)) { PH_BEGIN
          Gemm g{WSP(h16, W_CQN), WSP(h16, W_WUQ + lq * SZ_WUQ), MT, 768, 384, 384, 384}; StaticOrder S; S.init(MT, 768, G, bid);
          EpiQ E{WSP(h16, W_Q), WSP(h16, W_QLAT), WSP(float, W_ROPE), WSP(float, W_ROPE) + NPOS * 16}; gemm_phase(lds, g, S, E, tid); }
        for (int rep = 0; rep < NREP(4); ++rep) if (PHM & (1u << 4)) { PH_BEGIN
          Gemm g{WSP(h16, W_CKVN), WSP(h16, W_WKV + lq * SZ_WKV), MP, 1024, 256, 256, 256}; StaticOrder S; S.init(MP, 1024, G, (bid + G - (396 % G)) % G); EpiKV E{WSP(h16, W_K), WSP(h16, W_V)}; gemm_phase(lds, g, S, E, tid); }
        for (int rep = 0; rep < NREP(5); ++rep) if (PHM & (1u << 5)) { PH_BEGIN
          Gemm g{WSP(h16, W_XC), WSP(h16, W_WG + lq * SZ_WG), MT, 512, 256, 256, 256}; StaticOrder S; S.init(MT, 512, G, (bid + G - (908 % G)) % G);
          EpiGate E{WSP(h16, W_XC), WSP(float, W_A), WSP(float, W_B), kp->in[23] + lq * 256, kp->in[25] + lq * 256, WSP(float, W_SP) + lq * 256}; gemm_phase(lds, g, S, E, tid); }
        for (int rep = 0; rep < NREP(6); ++rep) if (PHM & (1u << 6)) { PH_BEGIN
          Gemm g{WSP(h16, W_CQN) + (size_t)MP * 384, WSP(h16, W_WQL + lq * SZ_WQL), MS, 2048, 384, 384, 384}; StaticOrder S; S.init(MS, 2048, G, (bid + G - (1172 % G)) % G); EpiQlat E{WSP(h16, W_QLAT)}; gemm_phase(lds, g, S, E, tid); }
        for (int rep = 0; rep < NREP(7); ++rep) if (PHM & (1u << 7)) { PH_BEGIN
            const float* gw_s = kp->in[13] + (size_t)lq * 4 * 128 * 128; const float* gb_s = kp->in[14] + (size_t)lq * 4 * 128;
            const h16* z = WSP(h16, W_Z); h16* cat = WSP(h16, W_CAT); h16* cats = WSP(h16, W_CATS);
            const int fr = lane & 15, g4 = lane >> 4, q_ = fr >> 2, p_ = fr & 3;
            for (int item = (bid + G - (1204 % G)) % G; item < 1024 + 128; item += G) {
                const bool samp = item >= 1024; const int head = item & 3; const int ci = samp ? (item - 1024) >> 2 : item >> 2;
                const int R0 = samp ? MP + ci * 32 : ci * 128, L = samp ? 32 : 128;
                __syncthreads();
                for (int id = tid; id < L * 8; id += 512) { const int j = id >> 3, part = id & 7; *(LAS h8*)(lds + j * 144 + part * 16) = *(const h8*)(z + (size_t)(R0 + j) * ZW + 256 + head * 64 + part * 8); }
                __syncthreads();
                const int i0 = 16 * wave;
                if (i0 < L) {
                    f4 sacc[4];
#pragma unroll
                    for (int ct = 0; ct < 4; ++ct) sacc[ct] = (f4){0.f, 0.f, 0.f, 0.f};
                    const int i = i0 + fr;
#pragma unroll
                    for (int ks = 0; ks < 4; ++ks) if (32 * ks <= i0 + 15 && 32 * ks < L) {
                        const int j0 = 32 * ks + 8 * g4; const float* wp = gw_s + ((size_t)head * 128 + i) * 128 + j0; const f4 w0 = *(const f4*)wp, w1 = *(const f4*)(wp + 4);
                        h8 wf;
#pragma unroll
                        for (int e = 0; e < 4; ++e) { wf[e] = (h16)((j0 + e <= i) ? w0[e] : 0.f); wf[4 + e] = (h16)((j0 + 4 + e <= i) ? w1[e] : 0.f); }
#pragma unroll
                        for (int ct = 0; ct < 4; ++ct) { const h4 lo = trrd(lds + (32 * ks + 8 * g4 + q_) * 144 + (16 * ct + 4 * p_) * 2), hi = trrd(lds + (32 * ks + 8 * g4 + 4 + q_) * 144 + (16 * ct + 4 * p_) * 2);
                            sacc[ct] = __builtin_amdgcn_mfma_f32_16x16x32_f16(wf, cat44(lo, hi), sacc[ct], 0, 0, 0); } }
#pragma unroll
                    for (int jx = 0; jx < 4; ++jx) { const int ii = i0 + 4 * g4 + jx; const float bs = gb_s[head * 128 + ii]; const size_t r = (size_t)R0 + ii;
#pragma unroll
                        for (int ct = 0; ct < 4; ++ct) { const int d = head * 64 + 16 * ct + fr; const float uval = (float)z[r * ZW + d]; const h16 o = (h16)(uval * (sacc[ct][jx] + bs));
                            if (!samp) cat[r * 1024 + d] = o; else cats[(r - MP) * CSW + d] = o; } }
                }
            }
            __syncthreads();
        }
        GSYNC();

        for (int rep = 0; rep < NREP(8); ++rep) if (PHM & (1u << 8)) { PH_BEGIN
            unsigned* counter = WSP(unsigned, W_CTR) + lq * 16 + rep * 8;
            const int fr = lane & 15, g4 = lane >> 4;
            constexpr int N_SA = 256, N_PA = 1024, N_PS = 128, N_SS = 16, N_ALL = N_SA + N_PA + N_PS + N_SS;
            for (;;) {
                __syncthreads();
                if (tid == 0) s_item = (int)atomicAdd(counter, 1u);
                __syncthreads();
                const int qi = s_item;
                if (qi >= N_ALL) break;
                const int item = qi < N_PS + N_SS ? qi + N_SA + N_PA : qi - (N_PS + N_SS);
                if (item < N_SA) {
                    constexpr int KS = 592;
                    const float* clat = kp->in[2] + (size_t)lq * DBATCH * PAST * 256; const float* ckr = kp->in[3] + (size_t)lq * DBATCH * PAST * 32;
                    const h16* qlat = WSP(h16, W_QLAT); const h16* knew = WSP(h16, W_KNEW); h16* cats = WSP(h16, W_CATS);
                    const int b = item >> 3, hg = (item >> 2) & 1, sp = item & 3, head = 4 * hg + (wave >> 1), tq = 16 * (wave & 1) + fr, t0 = sp * 16;
                    h8 qf[1][9];
#pragma unroll
                    for (int ks = 0; ks < 9; ++ks) qf[0][ks] = *(const h8*)(qlat + (size_t)(b * 32 + tq) * QLW + head * 288 + 32 * ks + 8 * g4);
                    f4 o[1][16]; float mrow[1] = {-1e30f}, lrow[1] = {0.f};
#pragma unroll
                    for (int ct = 0; ct < 16; ++ct) o[0][ct] = (f4){0.f, 0.f, 0.f, 0.f};
                    const float* lb = clat + (size_t)b * PAST * 256 + (size_t)(t0 * 64 + (tid >> 6)) * 256 + (tid & 63) * 4; const float* rb = ckr + (size_t)b * PAST * 32 + (size_t)(t0 * 64 + (tid >> 3)) * 32 + (tid & 7) * 4;
                    const int wl = (tid >> 6) * KS + (tid & 63) * 8, wr_ = (tid >> 3) * KS + 512 + (tid & 7) * 8;
                    f4 pl[4]; f4 pr;
#pragma unroll
                    for (int hf = 0; hf < 2; ++hf) {
#pragma unroll
                        for (int i = 0; i < 4; ++i) pl[i] = *(const f4*)(lb + (size_t)(hf * 4 + i) * 8 * 256);
#pragma unroll
                        for (int i = 0; i < 4; ++i) *(LAS h4*)(lds + wl + (hf * 4 + i) * 8 * KS) = pack4(pl[i]); }
                    pr = *(const f4*)rb;
                    *(LAS h4*)(lds + wr_) = pack4(pr);
                    __syncthreads();
                    for (int t = 0; t < 16; ++t) {
                        LAS unsigned char* cur = lds + (t & 1) * (64 * KS); LAS unsigned char* nxt = lds + ((t + 1) & 1) * (64 * KS);
                        const bool more = t + 1 < 16;
                        if (more) {
#pragma unroll
                            for (int i = 0; i < 4; ++i) pl[i] = *(const f4*)(lb + ((size_t)(t + 1) * 64 + i * 8) * 256);
                            pr = *(const f4*)(rb + (size_t)(t + 1) * 64 * 32);
                        }
                        h8 pf[1][2];
                        attn_qk<9, 16, 1, KS>(cur, qf, o, mrow, lrow, pf, 4, lane);
                        if (more) {
#pragma unroll
                            for (int i = 0; i < 4; ++i) *(LAS h4*)(nxt + wl + i * 8 * KS) = pack4(pl[i]);
                            *(LAS h4*)(nxt + wr_) = pack4(pr);
#pragma unroll
                            for (int i = 0; i < 4; ++i) pl[i] = *(const f4*)(lb + ((size_t)(t + 1) * 64 + (4 + i) * 8) * 256);
                        }
                        attn_pv<16, 1, KS>(cur, o, pf, 4, lane);
                        if (more) {
#pragma unroll
                            for (int i = 0; i < 4; ++i) *(LAS h4*)(nxt + wl + (4 + i) * 8 * KS) = pack4(pl[i]);
                        } else if (sp == 3) {
                            for (int id = tid; id < 32 * 36; id += 512) { const int key = id / 36, part = id % 36; *(LAS h8*)(nxt + key * KS + part * 16) = *(const h8*)(knew + (size_t)(b * 32 + key) * KNW + part * 8); }
                        }
                        __syncthreads();
                    }
                    if (sp == 3) attn_tile<9, 16, 1, KS, KS>(lds, lds, qf, o, mrow, lrow, 2, lane);
                    { unsigned char* pw = ws + W_PART + ((size_t)item * 8 + wave) * SZ_PARTW;
#pragma unroll
                      for (int ct = 0; ct < 16; ++ct) *(f4*)(pw + ct * 1024 + lane * 16) = o[0][ct];
                      *(float*)(pw + 16384 + lane * 4) = mrow[0]; *(float*)(pw + 16640 + lane * 4) = lrow[0]; }
                    asm volatile("s_waitcnt vmcnt(0)" ::: "memory");
                    __syncthreads();
                    if (tid == 0) { __builtin_amdgcn_fence(__ATOMIC_RELEASE, "agent"); asm volatile("s_waitcnt vmcnt(0)" ::: "memory");
                        const unsigned old = xb_add(WSP(unsigned, W_CTR) + 256 + lq * 64 + rep * 512 + (item >> 2), 1u);
                        if (old == 3u) { __builtin_amdgcn_fence(__ATOMIC_ACQUIRE, "agent"); asm volatile("s_waitcnt vmcnt(0)" ::: "memory"); }
                        *((LAS int*)&s_ctl + 3) = (int)old; }
                    __syncthreads();
                    if (*((LAS int*)&s_ctl + 3) == 3) {
                        const unsigned char* p0 = ws + W_PART + ((size_t)(item & ~3) * 8 + wave) * SZ_PARTW;
                        float mi[4], M = -1e30f;
#pragma unroll
                        for (int i = 0; i < 4; ++i) { mi[i] = *(const float*)(p0 + (size_t)i * 8 * SZ_PARTW + 16384 + lane * 4); M = fmaxf(M, mi[i]); }
                        float L = 0.f;
#pragma unroll
                        for (int i = 0; i < 4; ++i) { mi[i] = exp2f(mi[i] - M); L += mi[i] * *(const float*)(p0 + (size_t)i * 8 * SZ_PARTW + 16640 + lane * 4); }
                        L += shx(L, 16, lane); L += shx(L, 32, lane); const float inv = 1.f / L;
                        h16* dst = cats + (size_t)(b * 32 + tq) * CSW + 256 + head * 256 + 4 * g4;
#pragma unroll
                        for (int ct = 0; ct < 16; ++ct) { f4 acc4 = (f4){0.f, 0.f, 0.f, 0.f};
#pragma unroll
                            for (int i = 0; i < 4; ++i) acc4 += *(const f4*)(p0 + (size_t)i * 8 * SZ_PARTW + ct * 1024 + lane * 16) * mi[i];
                            *(h4*)(dst + 16 * ct) = pack4(acc4 * inv); }
                    }
                } else if (item < N_SA + N_PA) {
                    constexpr int KS = 208, VS = 144, KBUF = 64 * KS, VBUF = 64 * VS;
                    const h16* qb = WSP(h16, W_Q); const h16* kb = WSP(h16, W_K); const h16* vb = WSP(h16, W_V); h16* cat = WSP(h16, W_CAT);
                    const int it = item - N_SA, qblk = 7 - (it >> 7), bh = it & 127, b = bh >> 3, head = bh & 7;
                    const int r0 = qblk * 256 + 32 * wave, ntw = (r0 >> 6) + 1, ntb = 4 * (qblk + 1);
                    h8 qf[2][3];
#pragma unroll
                    for (int qs = 0; qs < 2; ++qs)
#pragma unroll
                        for (int ks = 0; ks < 3; ++ks) qf[qs][ks] = *(const h8*)(qb + (size_t)(b * SEQ + r0 + 16 * qs + fr) * QW + head * 96 + 32 * ks + 8 * g4);
                    f4 o[2][4]; float mrow[2] = {-1e30f, -1e30f}, lrow[2] = {0.f, 0.f};
#pragma unroll
                    for (int qs = 0; qs < 2; ++qs)
#pragma unroll
                        for (int ct = 0; ct < 4; ++ct) o[qs][ct] = (f4){0.f, 0.f, 0.f, 0.f};
                    const int k0key = tid / 12, k0part = tid % 12, k1key = (tid + 512) / 12, k1part = (tid + 512) % 12, vkey = tid >> 3, vpart = tid & 7;
                    const h16* kg0 = kb + (size_t)b * SEQ * KW + head * 96 + (size_t)k0key * KW + k0part * 8; const h16* kg1 = kb + (size_t)b * SEQ * KW + head * 96 + (size_t)k1key * KW + k1part * 8;
                    const h16* vg = vb + (size_t)b * SEQ * VW + head * 64 + (size_t)vkey * VW + vpart * 8;
                    const int lk0 = k0key * KS + k0part * 16, lk1 = k1key * KS + k1part * 16, lv = 2 * KBUF + vkey * VS + vpart * 16;
                    h8 pk0, pk1 = (h8){0, 0, 0, 0, 0, 0, 0, 0}, pv;
                    pk0 = *(const h8*)kg0; if (tid < 256) pk1 = *(const h8*)kg1; pv = *(const h8*)vg;
                    *(LAS h8*)(lds + lk0) = pk0; if (tid < 256) *(LAS h8*)(lds + lk1) = pk1; *(LAS h8*)(lds + lv) = pv;
                    __syncthreads();
                    for (int t = 0; t < ntb; ++t) {
                        const int co = (t & 1), no = ((t + 1) & 1);
                        if (t + 1 < ntb) { const size_t ro = (size_t)(t + 1) * 64;
                            pk0 = *(const h8*)(kg0 + ro * KW); if (tid < 256) pk1 = *(const h8*)(kg1 + ro * KW); pv = *(const h8*)(vg + ro * VW); }
                        if (t < ntw) attn_tile<3, 4, 2, KS, VS>(lds + co * KBUF, lds + 2 * KBUF + co * VBUF, qf, o, mrow, lrow, 4, lane);
                        if (t + 1 < ntb) { *(LAS h8*)(lds + no * KBUF + lk0) = pk0; if (tid < 256) *(LAS h8*)(lds + no * KBUF + lk1) = pk1; *(LAS h8*)(lds + no * VBUF + lv) = pv; }
                        __syncthreads();
                    }
#pragma unroll
                    for (int qs = 0; qs < 2; ++qs) { float lt = lrow[qs]; lt += shx(lt, 16, lane); lt += shx(lt, 32, lane); const float inv = 1.f / lt;
                        h16* dst = cat + (size_t)(b * SEQ + r0 + 16 * qs + fr) * 1024 + 256 + head * 64 + 4 * g4;
#pragma unroll
                        for (int ct = 0; ct < 4; ++ct) *(h4*)(dst + 16 * ct) = pack4(o[qs][ct] * inv); }
                } else if (item < N_SA + N_PA + N_PS) {
                    const float* abuf = WSP(float, W_A); const float* bbuf = WSP(float, W_B); const h16* z = WSP(h16, W_Z); h16* cat = WSP(h16, W_CAT);
                    const int it = item - N_SA - N_PA, b = it >> 3, ch = (it & 7) * 32 + (tid & 31), seg = tid >> 5;
                    const size_t rbase = (size_t)b * SEQ + seg * 128;
                    float A = 1.f, B = 0.f;
#pragma unroll 16
                    for (int i = 0; i < 128; ++i) { const float a = abuf[(rbase + i) * 256 + ch], bb = bbuf[(rbase + i) * 256 + ch]; B = a * B + bb; A *= a; }
                    LAS float* sA = (LAS float*)lds; LAS float* sB = sA + 512;
                    sA[tid] = A; sB[tid] = B;
                    __syncthreads();
                    float h = 0.f;
                    for (int s2 = 0; s2 < seg; ++s2) h = sA[s2 * 32 + (tid & 31)] * h + sB[s2 * 32 + (tid & 31)];
#pragma unroll 16
                    for (int i = 0; i < 128; ++i) { const float a = abuf[(rbase + i) * 256 + ch], bb = bbuf[(rbase + i) * 256 + ch]; h = a * h + bb;
                        const float gt = (float)z[(rbase + i) * ZW + 1440 + ch]; cat[(rbase + i) * 1024 + 768 + ch] = (h16)(h * gt); }
                    if (seg == 15) out[O_PH + ((size_t)lq * NB + b) * 256 + ch] = h;
                } else {
                    const float* abuf = WSP(float, W_A); const float* bbuf = WSP(float, W_B); const h16* z = WSP(h16, W_Z); h16* cats = WSP(h16, W_CATS);
                    const int it = item - N_SA - N_PA - N_PS, idx = it * 512 + tid, b = idx >> 8, ch = idx & 255;
                    float h = kp->in[4][((size_t)lq * DBATCH + b) * 256 + ch];
                    for (int t = 0; t < DSEQ; ++t) { const size_t r = (size_t)MP + b * 32 + t; h = abuf[r * 256 + ch] * h + bbuf[r * 256 + ch];
                        const float gt = (float)z[r * ZW + 1440 + ch]; cats[(size_t)(b * 32 + t) * CSW + 2304 + ch] = (h16)(h * gt); }
                    out[O_SH + ((size_t)lq * DBATCH + b) * 256 + ch] = h;
                }
            }
        }
        GSYNC();

        for (int rep = 0; rep < NREP(9); ++rep) if (PHM & (1u << 9)) { PH_BEGIN
          const int lp = lq > 0 ? lq - 1 : 0; const float* xres_s = lq == 0 ? kp->in[1] : WSP(float, W_X1F) + (size_t)MP * DM;
          Gemm g{WSP(h16, W_CATS), WSP(h16, W_WOS + lq * SZ_WOS), MS, 1024, CSW, CSW, CSW}; StaticOrder S; S.init(MS, 1024, G, bid); EpiRes E{xres_s, WSP(float, W_STATS + (size_t)(lp * 2 + 1) * SZ_STATS) + 2 * MP, kp->in[9] + lp * DM, kp->in[10] + lp * DM, lq > 0, WSP(float, W_PRE) + (size_t)MP * DM, WSP(h16, W_XH) + (size_t)MP * DM, WSP(float, W_STATS + (size_t)(lq * 2) * SZ_STATS) + 2 * MP}; gemm_phase(lds, g, S, E, tid); }
        for (int rep = 0; rep < NREP(10); ++rep) if (PHM & (1u << 10)) { PH_BEGIN
          const int lp = lq > 0 ? lq - 1 : 0; const float* xres_p = lq == 0 ? kp->in[0] : WSP(float, W_X1F);
          Gemm g{WSP(h16, W_CAT), WSP(h16, W_WO + lq * SZ_WO), MP, 1024, 1024, 1024, 1024}; StaticOrder S; S.init(MP, 1024, G - 16, bid - 16); EpiRes E{xres_p, WSP(float, W_STATS + (size_t)(lp * 2 + 1) * SZ_STATS), kp->in[9] + lp * DM, kp->in[10] + lp * DM, lq > 0, WSP(float, W_PRE), WSP(h16, W_XH), WSP(float, W_STATS + (size_t)(lq * 2) * SZ_STATS)}; gemm_phase(lds, g, S, E, tid); }
        GSYNC();

        for (int rep = 0; rep < NREP(12); ++rep) if (PHM & (1u << 12)) { PH_BEGIN
          Gemm g{WSP(h16, W_XH), WSP(h16, W_WUP + lq * SZ_WUP), MT, DFF2, 1024, 1024, 1024}; StaticOrder S; S.init(MT, DFF2, G, bid);
          EpiUp E{WSP(h16, W_UP), out + O_PFC + (size_t)lq * NB * 2 * DFF2, (O_SFC + (size_t)lq * DBATCH * 2 * DFF2) - (O_PFC + (size_t)lq * NB * 2 * DFF2), WSP(float, W_STATS + (size_t)(lq * 2) * SZ_STATS), WSP(float, W_CD + lq * SZ_CD) + 2 * ZW, WSP(float, W_CD + lq * SZ_CD) + 2 * ZW + DFF2}; gemm_phase(lds, g, S, E, tid); }
        GSYNC();

        for (int rep = 0; rep < NREP(13); ++rep) if (PHM & (1u << 13)) { PH_BEGIN
            const float* fw = kp->in[28] + (size_t)lq * 3 * DFF2; const float* fb = kp->in[29] + (size_t)lq * DFF2; const float* stf = kp->in[6] + (size_t)lq * DBATCH * 2 * DFF2;
            const h16* up = WSP(h16, W_UP); h16* act = WSP(h16, W_ACT);
            constexpr int RSEG = 32, NCG = DFF / 8;
            for (unsigned it = (unsigned)gtid; it < (unsigned)(NCG * (MT / RSEG)); it += (unsigned)NGT) { const int seg = (int)(it / (unsigned)NCG), cg = (int)(it - (unsigned)seg * NCG), j0 = cg * 8, row0 = seg * RSEG;
                const bool samp = row0 >= MP; const int t0 = samp ? 0 : (row0 & (SEQ - 1)), bb = (row0 - MP) >> 5;
                const f4 bg0 = *(const f4*)(fb + j0), bg1 = *(const f4*)(fb + j0 + 4), bv0 = *(const f4*)(fb + DFF + j0), bv1 = *(const f4*)(fb + DFF + j0 + 4);
                f4 wg0[3], wg1[3], wv0[3], wv1[3];
#pragma unroll
                for (int j = 0; j < 3; ++j) { const float* wj = fw + (size_t)j * DFF2; wg0[j] = *(const f4*)(wj + j0); wg1[j] = *(const f4*)(wj + j0 + 4); wv0[j] = *(const f4*)(wj + DFF + j0); wv1[j] = *(const f4*)(wj + DFF + j0 + 4); }
                f4 ag0, ag1, av0, av1, bg0_, bg1_, bv0_, bv1_;
                if (t0 > 0) { const h16* u2 = up + (size_t)(row0 - 2) * DFF2; const h16* u1 = u2 + DFF2;
                    const h8 a = *(const h8*)(u2 + j0), c = *(const h8*)(u2 + DFF + j0), d = *(const h8*)(u1 + j0), e = *(const h8*)(u1 + DFF + j0);
                    ag0 = (f4){(float)a[0], (float)a[1], (float)a[2], (float)a[3]}; ag1 = (f4){(float)a[4], (float)a[5], (float)a[6], (float)a[7]};
                    av0 = (f4){(float)c[0], (float)c[1], (float)c[2], (float)c[3]}; av1 = (f4){(float)c[4], (float)c[5], (float)c[6], (float)c[7]};
                    bg0_ = (f4){(float)d[0], (float)d[1], (float)d[2], (float)d[3]}; bg1_ = (f4){(float)d[4], (float)d[5], (float)d[6], (float)d[7]};
                    bv0_ = (f4){(float)e[0], (float)e[1], (float)e[2], (float)e[3]}; bv1_ = (f4){(float)e[4], (float)e[5], (float)e[6], (float)e[7]}; }
                else if (samp) { const float* s2 = stf + (size_t)bb * 2 * DFF2; const float* s1 = s2 + DFF2;
                    ag0 = *(const f4*)(s2 + j0); ag1 = *(const f4*)(s2 + j0 + 4); av0 = *(const f4*)(s2 + DFF + j0); av1 = *(const f4*)(s2 + DFF + j0 + 4);
                    bg0_ = *(const f4*)(s1 + j0); bg1_ = *(const f4*)(s1 + j0 + 4); bv0_ = *(const f4*)(s1 + DFF + j0); bv1_ = *(const f4*)(s1 + DFF + j0 + 4); }
                else { ag0 = ag1 = av0 = av1 = bg0_ = bg1_ = bv0_ = bv1_ = (f4){0.f, 0.f, 0.f, 0.f}; }
                const h16* ur = up + (size_t)row0 * DFF2 + j0; h16* ar = act + (size_t)row0 * DFF + j0;
#pragma unroll 4
                for (int r = 0; r < RSEG; ++r) { const h8 a = *(const h8*)(ur + (size_t)r * DFF2), c = *(const h8*)(ur + (size_t)r * DFF2 + DFF);
                    const f4 cg0 = (f4){(float)a[0], (float)a[1], (float)a[2], (float)a[3]}, cg1 = (f4){(float)a[4], (float)a[5], (float)a[6], (float)a[7]};
                    const f4 cv0 = (f4){(float)c[0], (float)c[1], (float)c[2], (float)c[3]}, cv1 = (f4){(float)c[4], (float)c[5], (float)c[6], (float)c[7]};
                    const f4 g0 = bg0 + ag0 * wg0[0] + bg0_ * wg0[1] + cg0 * wg0[2], g1 = bg1 + ag1 * wg1[0] + bg1_ * wg1[1] + cg1 * wg1[2];
                    const f4 v0 = bv0 + av0 * wv0[0] + bv0_ * wv0[1] + cv0 * wv0[2], v1 = bv1 + av1 * wv1[0] + bv1_ * wv1[1] + cv1 * wv1[2];
                    h8 o;
#pragma unroll
                    for (int e = 0; e < 4; ++e) { o[e] = (h16)(gelu_f(g0[e]) * v0[e]); o[4 + e] = (h16)(gelu_f(g1[e]) * v1[e]); }
                    *(h8*)(ar + (size_t)r * DFF) = o;
                    ag0 = bg0_; ag1 = bg1_; av0 = bv0_; av1 = bv1_; bg0_ = cg0; bg1_ = cg1; bv0_ = cv0; bv1_ = cv1; } }
        }
        GSYNC();

        for (int rep = 0; rep < NREP(14); ++rep) if (PHM & (1u << 14)) { PH_BEGIN
          Gemm g{WSP(h16, W_ACT), WSP(h16, W_WDN + lq * SZ_WDN), MT, 1024, DFF, DFF, DFF}; StaticOrder S; S.init(MT, 1024, G, bid); EpiRes E{WSP(float, W_PRE), WSP(float, W_STATS + (size_t)(lq * 2) * SZ_STATS), kp->in[7] + lq * DM, kp->in[8] + lq * DM, true, WSP(float, W_X1F), WSP(h16, W_XH), WSP(float, W_STATS + (size_t)(lq * 2 + 1) * SZ_STATS)}; gemm_phase(lds, g, S, E, tid); }
        GSYNC();

    }
    { const int l = DEPTH - 1; PH_BEGIN
        const float* gg = kp->in[9] + lq * DM; const float* bb = kp->in[10] + lq * DM; const float* pre2 = WSP(float, W_X1F); const float* st = WSP(float, W_STATS + (size_t)(lq * 2 + 1) * SZ_STATS);
        for (size_t i = gtid; i < (size_t)MT * (DM / 4); i += NGT) { const int row = (int)(i >> 8), c = (int)(i & 255) * 4;
            const float sm = st[2 * row], sq = st[2 * row + 1], mean = sm * (1.f / DM), rstd = rsqrtf(sq * (1.f / DM) - mean * mean + 1e-5f);
            *(f4*)(out + O_Y + (size_t)row * DM + c) = (*(const f4*)(pre2 + (size_t)row * DM + c) - mean) * rstd * *(const f4*)(gg + c) + *(const f4*)(bb + c); }
    }
}

extern "C" void kernel_launch(void* const* d_in, const int* in_sizes, int n_in, void* d_out, int out_size, void* d_ws, size_t ws_size, hipStream_t stream) {
    constexpr size_t kDynLds = STAGE_BYTES;
    static int grid_blocks = 0;
    if (!grid_blocks) {
        if (n_in != 31 || (size_t)out_size != O_END || ws_size < W_END) { fprintf(stderr, "kernel_launch: unexpected shapes n_in %d out %d ws %zu (need %zu)\n", n_in, out_size, ws_size, (size_t)W_END); grid_blocks = -1; return; }
        int dev = 0, cus = 0, per_cu = 0;
        hipGetDevice(&dev);
        hipDeviceGetAttribute(&cus, hipDeviceAttributeMultiprocessorCount, dev);
        hipFuncSetAttribute((const void*)trunk_fwd, hipFuncAttributeMaxDynamicSharedMemorySize, (int)kDynLds);
        hipOccupancyMaxActiveBlocksPerMultiprocessor(&per_cu, (const void*)trunk_fwd, 512, kDynLds);
        if (per_cu < 1) per_cu = 1;
        grid_blocks = cus * per_cu;
        if (grid_blocks > 256) grid_blocks = 256;
        if (grid_blocks < 32) { fprintf(stderr, "kernel_launch: grid %d too small\n", grid_blocks); grid_blocks = -1; return; }
    }
    if (grid_blocks < 0) return;
    hipMemsetAsync((char*)d_ws + W_CTR, 0, W_ZERO_END, stream);
    Params p{};
    for (int i = 0; i < 31; ++i) p.in[i] = (const float*)d_in[i];
    p.out = (float*)d_out; p.ws = (unsigned char*)d_ws;
    void* args[] = {&p};
    hipError_t e = hipLaunchCooperativeKernel((const void*)trunk_fwd, dim3(grid_blocks), dim3(512), args, kDynLds, stream);
    if (e != hipSuccess) fprintf(stderr, "cooperative launch failed: %s (grid %d)\n", hipGetErrorString(e), grid_blocks);
}
```

```cpp
#include <hip/hip_runtime.h>
#include <hip/hip_cooperative_groups.h>
#include <cstdio>
#include <cstdint>
namespace cg = cooperative_groups;

typedef _Float16 h16;
typedef _Float16 h8 __attribute__((ext_vector_type(8)));
typedef _Float16 h4 __attribute__((ext_vector_type(4)));
typedef _Float16 h2 __attribute__((ext_vector_type(2)));
typedef float f4 __attribute__((ext_vector_type(4)));
typedef short s4v __attribute__((__vector_size__(8)));
#define LAS __attribute__((address_space(3)))
#define DEVI __device__ __forceinline__

constexpr int DM = 1024, NB = 16, SEQ = 2048, DEPTH = 4, DBATCH = 32, DSEQ = 32, PAST = 4096;
constexpr int MP = NB * SEQ, MS = DBATCH * DSEQ, MT = MP + MS;
constexpr int DIN = 1696, ZW = 1792, DFF = 2816, DFF2 = 5632;
constexpr int QW = 768, KW = 768, VW = 512, QLW = 2304, CSW = 2560, KNW = 288;
constexpr float ALPHA = 1.681792830507429f;
constexpr float QSCALE = 0.14724444f;
constexpr int NPOS = SEQ + DSEQ;

constexpr size_t O_Y = 0;
constexpr size_t O_PLAT = (size_t)MT * DM;
constexpr size_t O_PKR = O_PLAT + (size_t)DEPTH * MP * 256;
constexpr size_t O_PH = O_PKR + (size_t)DEPTH * MP * 32;
constexpr size_t O_PLC = O_PH + (size_t)DEPTH * NB * 256;
constexpr size_t O_PFC = O_PLC + (size_t)DEPTH * NB * 3 * 256;
constexpr size_t O_SLAT = O_PFC + (size_t)DEPTH * NB * 2 * DFF2;
constexpr size_t O_SKR = O_SLAT + (size_t)DEPTH * MS * 256;
constexpr size_t O_SV = O_SKR + (size_t)DEPTH * MS * 32;
constexpr size_t O_SH = O_SV + (size_t)DEPTH * MS * 256;
constexpr size_t O_SLC = O_SH + (size_t)DEPTH * DBATCH * 256;
constexpr size_t O_SFC = O_SLC + (size_t)DEPTH * DBATCH * 3 * 256;
constexpr size_t O_END = O_SFC + (size_t)DEPTH * DBATCH * 2 * DFF2;

constexpr size_t al(size_t x) { return (x + 255) & ~(size_t)255; }
constexpr size_t W_CTR = 0;
constexpr size_t W_PARAMS = 2048;
constexpr size_t W_BAR = 4096;
constexpr size_t W_CD = 4096 + 16384;
constexpr size_t SZ_CD = (size_t)(2 * ZW + 2 * DFF2) * 4;
constexpr size_t W_STATS = W_CD + DEPTH * SZ_CD;
constexpr size_t SZ_STATS = (size_t)MT * 2 * 4;
constexpr size_t W_ZERO_END = W_STATS + (size_t)DEPTH * 2 * SZ_STATS;
constexpr size_t W_ROPE = al(W_ZERO_END);
constexpr size_t W_SP = al(W_ROPE + (size_t)NPOS * 16 * 2 * 4);
constexpr size_t W_WIN = al(W_SP + (size_t)DEPTH * 256 * 4);
constexpr size_t SZ_WIN = (size_t)ZW * 1024 * 2;
constexpr size_t W_WUQ = W_WIN + DEPTH * SZ_WIN;   constexpr size_t SZ_WUQ = (size_t)768 * 384 * 2;
constexpr size_t W_WQL = W_WUQ + DEPTH * SZ_WUQ;   constexpr size_t SZ_WQL = (size_t)2048 * 384 * 2;
constexpr size_t W_WKV = W_WQL + DEPTH * SZ_WQL;   constexpr size_t SZ_WKV = (size_t)1024 * 256 * 2;
constexpr size_t W_WG = W_WKV + DEPTH * SZ_WKV;    constexpr size_t SZ_WG = (size_t)512 * 256 * 2;
constexpr size_t W_WO = W_WG + DEPTH * SZ_WG;      constexpr size_t SZ_WO = (size_t)1024 * 1024 * 2;
constexpr size_t W_WOS = W_WO + DEPTH * SZ_WO;     constexpr size_t SZ_WOS = (size_t)1024 * CSW * 2;
constexpr size_t W_WUP = W_WOS + DEPTH * SZ_WOS;   constexpr size_t SZ_WUP = (size_t)DFF2 * 1024 * 2;
constexpr size_t W_WDN = W_WUP + DEPTH * SZ_WUP;   constexpr size_t SZ_WDN = (size_t)1024 * DFF * 2;
constexpr size_t W_XH = W_WDN + DEPTH * SZ_WDN;
constexpr size_t W_Z = W_XH + (size_t)MT * 1024 * 2;
constexpr size_t W_CQN = W_Z + (size_t)MT * ZW * 2;
constexpr size_t W_CKVN = W_CQN + (size_t)MT * 384 * 2;
constexpr size_t W_XC = W_CKVN + (size_t)MP * 256 * 2;
constexpr size_t W_Q = W_XC + (size_t)MT * 256 * 2;
constexpr size_t W_K = W_Q + (size_t)MP * QW * 2;
constexpr size_t W_V = W_K + (size_t)MP * KW * 2;
constexpr size_t W_A = W_V + (size_t)MP * VW * 2;
constexpr size_t W_B = W_A + (size_t)MT * 256 * 4;
constexpr size_t W_CAT = W_B + (size_t)MT * 256 * 4;
constexpr size_t W_CATS = W_CAT + (size_t)MP * 1024 * 2;
constexpr size_t W_QLAT = W_CATS + (size_t)MS * CSW * 2;
constexpr size_t W_KNEW = W_QLAT + (size_t)MS * QLW * 2;
constexpr size_t W_PRE = al(W_KNEW + (size_t)MS * KNW * 2);
constexpr size_t W_X1F = W_PRE + (size_t)MT * 1024 * 4;
constexpr size_t W_UP = W_X1F + (size_t)MT * 1024 * 4;
constexpr size_t W_ACT = W_UP + (size_t)MT * DFF2 * 2;
constexpr size_t W_PART = W_ACT + (size_t)MT * DFF * 2;
constexpr size_t SZ_PARTW = 16 * 1024 + 512;
constexpr size_t W_END = W_PART + (size_t)256 * 8 * SZ_PARTW;

struct Params { const float* in[31]; float* out; unsigned char* ws; };

DEVI float gelu_f(float x) { const float u = -2.302208198f * (x + 0.044715f * x * x * x); return x * __builtin_amdgcn_rcpf(1.f + __builtin_amdgcn_exp2f(u)); }
DEVI float sigmoid_f(float x) { return __builtin_amdgcn_rcpf(1.f + __builtin_amdgcn_exp2f(-1.4426950408889634f * x)); }
DEVI h8 pack8(f4 a, f4 b) { h8 r; r[0] = (h16)a[0]; r[1] = (h16)a[1]; r[2] = (h16)a[2]; r[3] = (h16)a[3]; r[4] = (h16)b[0]; r[5] = (h16)b[1]; r[6] = (h16)b[2]; r[7] = (h16)b[3]; return r; }
DEVI h4 pack4(f4 a) { h4 r; r[0] = (h16)a[0]; r[1] = (h16)a[1]; r[2] = (h16)a[2]; r[3] = (h16)a[3]; return r; }
DEVI float shx(float v, int o, int lane) { return __builtin_bit_cast(float, __builtin_amdgcn_ds_bpermute((lane ^ o) << 2, __builtin_bit_cast(int, v))); }
DEVI float wave_sum(float v, int lane) {
#pragma unroll
    for (int o = 1; o < 64; o <<= 1) v += shx(v, o, lane);
    return v;
}
DEVI int opaque_lane() { unsigned ones = ~0u; asm volatile("" : "+s"(ones)); return (int)__builtin_amdgcn_mbcnt_hi(ones, __builtin_amdgcn_mbcnt_lo(ones, 0u)); }
DEVI h4 trrd(LAS unsigned char* p) { s4v r = __builtin_amdgcn_ds_read_tr16_b64_v4i16((LAS s4v*)p); return __builtin_bit_cast(h4, r); }
DEVI h8 cat44(h4 a, h4 b) { return __builtin_shufflevector(a, b, 0, 1, 2, 3, 4, 5, 6, 7); }

constexpr int BM = 256, BK = 64, HALF = 128, HTB = HALF * BK * 2, STAGE_BYTES = 8 * HTB, NXCD = 8, WGM = 8;
DEVI int lds_byte(int r, int c) { const int st = (r >> 4) * 2 + (c >> 5), rr = r & 15, cc = c & 31, ob = rr * 64 + cc * 2; return st * 1024 + (ob ^ (((ob >> 9) & 1) << 5)); }
DEVI void stage_rc(int b, int& R, int& C) { const int st = b / 1024, sb = b % 1024, swz = sb ^ (((sb >> 9) & 1) << 5); R = (st >> 1) * 16 + swz / 64; C = (st & 1) * 32 + (swz % 64) / 2; }
DEVI int perm32(int rho) { const int n = rho >> 4, i = rho & 15; return 8 * (i >> 2) + 4 * n + (i & 3); }
struct Unit { int pm, pn; };
struct Gemm { const h16* A; const h16* Bt; int M, N, K, lda, ldb; };
struct StaticOrder {
    int nM, nN, nwg, G, c;
    DEVI void init(int M, int N, int G_, int c_) { nM = M / BM; nN = N / BM; nwg = nM * nN; G = G_; c = c_; }
    DEVI bool next(int i, Unit& u) const {
        if (c < 0) return false;
        const long L = (long)i * G + c; if (L >= nwg) return false;
        int wgid = (int)L; { const int q = nwg / NXCD, r = nwg % NXCD, xcd = wgid % NXCD, off = wgid / NXCD; wgid = (xcd < r ? xcd * (q + 1) : r * (q + 1) + (xcd - r) * q) + off; }
        const int nig = WGM * nN, gid = wgid / nig, fm = gid * WGM, gsz = (nM - fm) < WGM ? (nM - fm) : WGM;
        u.pm = fm + ((wgid % nig) % gsz); u.pn = (wgid % nig) / gsz; return true;
    }
};
template <class Epi>
DEVI void gemm_phase(LAS unsigned char* lds, const Gemm g, const StaticOrder& S, const Epi& E, const int tid) {
    const int wid = __builtin_amdgcn_readfirstlane(tid >> 6), lane = tid & 63, wr = wid >> 2, wc = wid & 3, fr = lane & 15, fq = lane >> 4;
    const int K = g.K, nt = K / BK;
    unsigned voffA[2], voffB[2];
#pragma unroll
    for (int i = 0; i < 2; ++i) { int R, C; stage_rc(tid * 16 + i * 8192, R, C); const int Rb = Epi::PERM ? ((R & ~31) + perm32(R & 31)) : R;
        voffA[i] = (unsigned)(R * g.lda + C) * 2u; voffB[i] = (unsigned)(Rb * g.ldb + C) * 2u; }
    const size_t kstep = (size_t)(BK * 2);
    const size_t hstepA = (size_t)HALF * g.lda * 2, hstepB = (size_t)HALF * g.ldb * 2;
    const size_t tstepA = 2 * hstepA, tstepB = 2 * hstepB;
    const unsigned ldsw = (unsigned)wid * 1024u;
    const int aoff = lds_byte(wr * 64 + fr, fq * 8), boff = lds_byte(wc * 32 + fr, fq * 8);
#define PG8_SA(b, h) (((b) * 2 + (h)) * HTB)
#define PG8_SB(b, h) ((4 + (b) * 2 + (h)) * HTB)
#define PG8_STAGE(bufoff, gbase, voff) do { _Pragma("unroll") for (int _i = 0; _i < 2; ++_i) \
        __builtin_amdgcn_global_load_lds((const unsigned*)((const char*)(gbase) + (voff)[_i]), (LAS unsigned*)(lds + (bufoff) + ldsw + _i * 8192), 16, 0, 0); } while (0)
#define PG8_LDA(dst, b, h) do { _Pragma("unroll") for (int m = 0; m < 4; ++m) _Pragma("unroll") for (int k = 0; k < 2; ++k) dst[m][k] = *(const LAS h8*)(lds + PG8_SA(b, h) + aoff + m * 2048 + k * 1024); } while (0)
#define PG8_LDB(dst, b, h) do { _Pragma("unroll") for (int n = 0; n < 2; ++n) _Pragma("unroll") for (int k = 0; k < 2; ++k) dst[n][k] = *(const LAS h8*)(lds + PG8_SB(b, h) + boff + n * 2048 + k * 1024); } while (0)
#define PG8_MMA(ai, bj, At, Bt) do { __builtin_amdgcn_s_setprio(1); _Pragma("unroll") for (int m = 0; m < 4; ++m) _Pragma("unroll") for (int n = 0; n < 2; ++n) _Pragma("unroll") for (int k = 0; k < 2; ++k) \
        acc[ai][bj][m][n] = __builtin_amdgcn_mfma_f32_16x16x32_f16(Bt[n][k], At[m][k], acc[ai][bj][m][n], 0, 0, 0); __builtin_amdgcn_s_setprio(0); } while (0)
#define PG8_WAIT_V(n) asm volatile("s_waitcnt vmcnt(" #n ")" ::: "memory")
#define PG8_WAIT_L(n) asm volatile("s_waitcnt lgkmcnt(" #n ")" ::: "memory")
#define PG8_BAR __builtin_amdgcn_s_barrier()
#define PG8_SCHED __builtin_amdgcn_sched_barrier(0)
    Unit cur, nxt; int ui = 0;
    if (!S.next(0, cur)) return;
    f4 acc[2][2][4][2];
#pragma unroll
    for (int a = 0; a < 2; ++a)
#pragma unroll
        for (int b = 0; b < 2; ++b)
#pragma unroll
            for (int m = 0; m < 4; ++m)
#pragma unroll
                for (int n = 0; n < 2; ++n) acc[a][b][m][n] = (f4){0.f, 0.f, 0.f, 0.f};
    h8 At[4][2], B0[2][2], B1[2][2];
    const char* cA = (const char*)g.A + (size_t)cur.pm * tstepA; const char* cB = (const char*)g.Bt + (size_t)cur.pn * tstepB;
    PG8_STAGE(PG8_SB(0, 0), cB, voffB); PG8_STAGE(PG8_SA(0, 0), cA, voffA); PG8_STAGE(PG8_SB(0, 1), cB + hstepB, voffB); PG8_STAGE(PG8_SA(0, 1), cA + hstepA, voffA);
    if (wr == 1) PG8_BAR;
    PG8_WAIT_V(4); PG8_BAR;
    PG8_STAGE(PG8_SB(1, 0), cB + kstep, voffB); PG8_STAGE(PG8_SA(1, 0), cA + kstep, voffA); PG8_STAGE(PG8_SB(1, 1), cB + hstepB + kstep, voffB);
    PG8_WAIT_V(6); PG8_BAR;
    for (;;) {
        const bool has_next = S.next(ui + 1, nxt);
        const char* nA = has_next ? (const char*)g.A + (size_t)nxt.pm * tstepA : cA; const char* nB = has_next ? (const char*)g.Bt + (size_t)nxt.pn * tstepB : cB;
        for (int t = 0; t < nt; t += 2) {
            const bool last = (t == nt - 2);
            const char* a1 = cA + (size_t)(t + 1) * kstep;
            const char* a2 = last ? nA : cA + (size_t)(t + 2) * kstep; const char* b2 = last ? nB : cB + (size_t)(t + 2) * kstep;
            const char* a3 = a2 + kstep; const char* b3 = b2 + kstep;
            PG8_LDB(B0, 0, 0); PG8_SCHED; PG8_LDA(At, 0, 0); PG8_STAGE(PG8_SA(1, 1), a1 + hstepA, voffA);
            PG8_WAIT_L(8); PG8_BAR; PG8_WAIT_L(0); PG8_MMA(0, 0, At, B0); PG8_BAR; PG8_SCHED;
            PG8_LDB(B1, 0, 1); PG8_STAGE(PG8_SB(0, 0), b2, voffB);
            PG8_BAR; PG8_WAIT_L(0); PG8_MMA(0, 1, At, B1); PG8_BAR;
            PG8_LDA(At, 0, 1); PG8_STAGE(PG8_SA(0, 0), a2, voffA);
            PG8_BAR; PG8_WAIT_L(0); PG8_MMA(1, 0, At, B0); PG8_BAR; PG8_SCHED;
            PG8_STAGE(PG8_SB(0, 1), b2 + hstepB, voffB);
            PG8_WAIT_V(6); PG8_BAR; PG8_MMA(1, 1, At, B1); PG8_BAR;
            PG8_LDB(B0, 1, 0); PG8_SCHED; PG8_LDA(At, 1, 0); PG8_STAGE(PG8_SA(0, 1), a2 + hstepA, voffA);
            PG8_WAIT_L(8); PG8_BAR; PG8_WAIT_L(0); PG8_MMA(0, 0, At, B0); PG8_BAR; PG8_SCHED;
            PG8_LDB(B1, 1, 1); PG8_STAGE(PG8_SB(1, 0), b3, voffB);
            PG8_BAR; PG8_WAIT_L(0); PG8_MMA(0, 1, At, B1); PG8_BAR;
            PG8_LDA(At, 1, 1); PG8_STAGE(PG8_SA(1, 0), a3, voffA);
            PG8_BAR; PG8_WAIT_L(0); PG8_MMA(1, 0, At, B0); PG8_BAR; PG8_SCHED;
            PG8_STAGE(PG8_SB(1, 1), b3 + hstepB, voffB);
            PG8_WAIT_V(6); PG8_BAR; PG8_MMA(1, 1, At, B1); PG8_BAR;
        }
        { int t2 = tid; asm volatile("" : "+v"(t2)); const int l2 = t2 & 63; E(acc, cur, wr, wc, l2 & 15, l2 >> 4); }
        if (!has_next) break;
#pragma unroll
        for (int a = 0; a < 2; ++a)
#pragma unroll
            for (int b = 0; b < 2; ++b)
#pragma unroll
                for (int m = 0; m < 4; ++m)
#pragma unroll
                    for (int n = 0; n < 2; ++n) acc[a][b][m][n] = (f4){0.f, 0.f, 0.f, 0.f};
        cur = nxt; cA = nA; cB = nB; ++ui;
    }
    PG8_WAIT_V(0);
    if (wr == 0) PG8_BAR;
    PG8_BAR;
#undef PG8_SA
#undef PG8_SB
#undef PG8_STAGE
#undef PG8_LDA
#undef PG8_LDB
#undef PG8_MMA
#undef PG8_WAIT_V
#undef PG8_WAIT_L
#undef PG8_BAR
#undef PG8_SCHED
}

typedef f4 Acc[2][2][4][2];
#define EPI_ROWS for (int ai = 0; ai < 2; ++ai) _Pragma("unroll") for (int m = 0; m < 4; ++m)

#define ROW_OF(r) (rowb + ((r) >> 2) * HALF + ((r) & 3) * 16)
struct EpiZ {
    static constexpr bool PERM = true;
    h16* z; float* sv; const float* st; const float* cv; const float* dv; bool fold;
    DEVI void operator()(const Acc& acc, const Unit& u, int wr, int wc, int fr, int fq) const {
        const int rowb = u.pm * BM + wr * 64 + fr, colb = u.pn * BM + wc * 32 + fq * 8;
        float mean[8], rstd[8]; f4 c[2][2], d[2][2];
#pragma unroll
        for (int r = 0; r < 8; ++r) { mean[r] = 0.f; rstd[r] = 1.f; }
#pragma unroll
        for (int bj = 0; bj < 2; ++bj)
#pragma unroll
            for (int n = 0; n < 2; ++n) { c[bj][n] = (f4){0.f, 0.f, 0.f, 0.f}; d[bj][n] = c[bj][n]; }
        if (fold) {
#pragma unroll
            for (int r = 0; r < 8; ++r) { const int row = ROW_OF(r); const float sm = st[2 * row], sq = st[2 * row + 1]; mean[r] = sm * (1.f / DM); rstd[r] = rsqrtf(sq * (1.f / DM) - mean[r] * mean[r] + 1e-5f); }
#pragma unroll
            for (int bj = 0; bj < 2; ++bj)
#pragma unroll
                for (int n = 0; n < 2; ++n) { c[bj][n] = *(const f4*)(cv + colb + bj * HALF + 4 * n); d[bj][n] = *(const f4*)(dv + colb + bj * HALF + 4 * n); } }
#pragma unroll
        for (int bj = 0; bj < 2; ++bj) { const int col = colb + bj * HALF; const bool act = col < 512 || (col >= 1440 && col < 1696);
#pragma unroll
            for (int r = 0; r < 8; ++r) { const int row = ROW_OF(r);
                f4 v0 = (acc[r >> 2][bj][r & 3][0] - c[bj][0] * mean[r]) * rstd[r] + d[bj][0], v1 = (acc[r >> 2][bj][r & 3][1] - c[bj][1] * mean[r]) * rstd[r] + d[bj][1];
                if (act) {
#pragma unroll
                    for (int e = 0; e < 4; ++e) { v0[e] = gelu_f(v0[e]); v1[e] = gelu_f(v1[e]); } }
                *(h8*)(z + (size_t)row * ZW + col) = pack8(v0, v1);
                if (row >= MP && col >= 256 && col < 512) { float* o = sv + (size_t)(row - MP) * 256 + (col - 256); *(f4*)o = v0; *(f4*)(o + 4) = v1; } } }
    }
};
struct EpiQ {
    static constexpr bool PERM = true;
    h16* q; h16* qlat; const float* ropec; const float* ropes;
    DEVI void operator()(const Acc& acc, const Unit& u, int wr, int wc, int fr, int fq) const {
        const bool samp = u.pm * BM >= MP;
        if (u.pn < 2) { if (samp) return;
#pragma unroll
            EPI_ROWS { const int row = u.pm * BM + ai * HALF + wr * 64 + m * 16 + fr;
#pragma unroll
                for (int bj = 0; bj < 2; ++bj) { const int col = u.pn * BM + bj * HALF + wc * 32 + fq * 8;
                    *(h8*)(q + (size_t)row * QW + (col >> 6) * 96 + (col & 63)) = pack8(acc[ai][bj][m][0] * QSCALE, acc[ai][bj][m][1] * QSCALE); } }
        } else {
            const int j = wc * 32 + fq * 8, head = j >> 4, i0 = j & 15; const int rowb = u.pm * BM + wr * 64 + fr;
            f4 cc[2], ss[2], cn[2], sn[2];
            { const int row = ROW_OF(0); const int pidx = samp ? SEQ + ((row - MP) & 31) : (row & (SEQ - 1));
#pragma unroll
              for (int n = 0; n < 2; ++n) { cc[n] = *(const f4*)(ropec + pidx * 16 + i0 + 4 * n); ss[n] = *(const f4*)(ropes + pidx * 16 + i0 + 4 * n); } }
#pragma unroll
            for (int r = 0; r < 8; ++r) { const int row = ROW_OF(r);
                if (r < 7) { const int rown = ROW_OF(r + 1); const int pidx = samp ? SEQ + ((rown - MP) & 31) : (rown & (SEQ - 1));
#pragma unroll
                    for (int n = 0; n < 2; ++n) { cn[n] = *(const f4*)(ropec + pidx * 16 + i0 + 4 * n); sn[n] = *(const f4*)(ropes + pidx * 16 + i0 + 4 * n); } }
                const size_t po = samp ? (W_QLAT - W_Q) / 2 + (size_t)(row - MP) * QLW + head * 288 + 256 + i0 : (size_t)row * QW + head * 96 + 64 + i0;
#pragma unroll
                for (int n = 0; n < 2; ++n) { const f4 a0 = acc[r >> 2][0][r & 3][n], b0 = acc[r >> 2][1][r & 3][n];
                    *(h4*)(q + po + 4 * n) = pack4((a0 * cc[n] - b0 * ss[n]) * QSCALE); *(h4*)(q + po + 16 + 4 * n) = pack4((a0 * ss[n] + b0 * cc[n]) * QSCALE); }
#pragma unroll
                for (int n = 0; n < 2; ++n) { cc[n] = cn[n]; ss[n] = sn[n]; } }
        }
    }
};
struct EpiKV {
    static constexpr bool PERM = true;
    h16* k; h16* v;
    DEVI void operator()(const Acc& acc, const Unit& u, int wr, int wc, int fr, int fq) const {
#pragma unroll
        EPI_ROWS { const int row = u.pm * BM + ai * HALF + wr * 64 + m * 16 + fr;
#pragma unroll
            for (int bj = 0; bj < 2; ++bj) { const int col = u.pn * BM + bj * HALF + wc * 32 + fq * 8; const h8 o = pack8(acc[ai][bj][m][0], acc[ai][bj][m][1]);
                if (u.pn < 2) *(h8*)(k + (size_t)row * KW + (col >> 6) * 96 + (col & 63)) = o; else *(h8*)(v + (size_t)row * VW + (col - 512)) = o; } }
    }
};
DEVI float one_minus_exp(float x) {
    const float pser = -x * (1.f + x * (0.5f + x * (0.16666667f + x * (0.041666668f + x * (0.0083333338f + x * 0.0013888889f)))));
    return x > -0.25f ? pser : 1.f - __builtin_amdgcn_exp2f(1.4426950408889634f * x);
}
struct EpiGate {
    static constexpr bool PERM = false;
    const h16* xc; float* a; float* b; const float* br; const float* bi; const float* sp;
    DEVI void operator()(const Acc& acc, const Unit& u, int wr, int wc, int fr, int fq) const {
        const int rowb = u.pm * BM + wr * 64 + fr, chb = u.pn * 128 + wc * 32 + fq * 4;
        f4 vbr[2], vbi[2], vsp[2]; h4 xv[2][8];
#pragma unroll
        for (int n = 0; n < 2; ++n) { const int ch = chb + n * 16; vbr[n] = *(const f4*)(br + ch); vbi[n] = *(const f4*)(bi + ch); vsp[n] = *(const f4*)(sp + ch) * -8.f;
#pragma unroll
            for (int r = 0; r < 8; ++r) xv[n][r] = *(const h4*)(xc + (size_t)ROW_OF(r) * 256 + ch); }
#pragma unroll
        for (int n = 0; n < 2; ++n) { const int ch = chb + n * 16;
#pragma unroll
            for (int r = 0; r < 8; ++r) { const int row = ROW_OF(r); f4 oa, ob;
#pragma unroll
                for (int e = 0; e < 4; ++e) { const float rg = sigmoid_f(acc[r >> 2][0][r & 3][n][e] + vbr[n][e]), ig = sigmoid_f(acc[r >> 2][1][r & 3][n][e] + vbi[n][e]);
                    const float la = rg * vsp[n][e]; oa[e] = __builtin_amdgcn_exp2f(1.4426950408889634f * la); ob[e] = __builtin_amdgcn_sqrtf(one_minus_exp(2.f * la)) * (ig * (float)xv[n][r][e]); }
                *(f4*)(a + (size_t)row * 256 + ch) = oa; *(f4*)(b + (size_t)row * 256 + ch) = ob; } }
    }
};
struct EpiQlat {
    static constexpr bool PERM = true;
    h16* qlat;
    DEVI void operator()(const Acc& acc, const Unit& u, int wr, int wc, int fr, int fq) const {
#pragma unroll
        EPI_ROWS { const int row = u.pm * BM + ai * HALF + wr * 64 + m * 16 + fr;
#pragma unroll
            for (int bj = 0; bj < 2; ++bj) { const int c = bj * HALF + wc * 32 + fq * 8;
                *(h8*)(qlat + (size_t)row * QLW + u.pn * 288 + c) = pack8(acc[ai][bj][m][0] * QSCALE, acc[ai][bj][m][1] * QSCALE); } }
    }
};
struct EpiRes {
    static constexpr bool PERM = false;
    h16* xh; const float* pst; const float* g; const float* b; bool ln; float* ost;
    DEVI void operator()(const Acc& acc, const Unit& u, int wr, int wc, int fr, int fq) const {
        const int rowb = u.pm * BM + wr * 64 + fr, colb = u.pn * BM + wc * 32 + fq * 4, lane = fq * 16 + fr;
        f4 gv[4], bv[4]; float mean[8], rstd[8];
#pragma unroll
        for (int k = 0; k < 4; ++k) { const int col = colb + (k >> 1) * HALF + (k & 1) * 16; gv[k] = ln ? *(const f4*)(g + col) : (f4){1.f, 1.f, 1.f, 1.f}; bv[k] = ln ? *(const f4*)(b + col) : (f4){0.f, 0.f, 0.f, 0.f}; }
#pragma unroll
        for (int r = 0; r < 8; ++r) { mean[r] = 0.f; rstd[r] = 1.f;
            if (ln) { const int row = ROW_OF(r); const float sm = pst[2 * row], sq = pst[2 * row + 1]; mean[r] = sm * (1.f / DM); rstd[r] = rsqrtf(sq * (1.f / DM) - mean[r] * mean[r] + 1e-5f); } }
        h4 cur[4], nxt[4];
#pragma unroll
        for (int k = 0; k < 4; ++k) cur[k] = *(const h4*)(xh + (size_t)ROW_OF(0) * DM + colb + (k >> 1) * HALF + (k & 1) * 16);
#pragma unroll
        for (int r = 0; r < 8; ++r) { const int row = ROW_OF(r);
            if (r < 7) {
#pragma unroll
                for (int k = 0; k < 4; ++k) nxt[k] = *(const h4*)(xh + (size_t)ROW_OF(r + 1) * DM + colb + (k >> 1) * HALF + (k & 1) * 16); }
            float s1 = 0.f, s2 = 0.f;
#pragma unroll
            for (int k = 0; k < 4; ++k) { const size_t o = (size_t)row * DM + colb + (k >> 1) * HALF + (k & 1) * 16;
                const f4 xv = (f4){(float)cur[k][0], (float)cur[k][1], (float)cur[k][2], (float)cur[k][3]};
                const f4 xr = (xv - mean[r]) * rstd[r] * gv[k] + bv[k];
                const f4 y = xr * ALPHA + acc[r >> 2][k >> 1][r & 3][k & 1];
                *(h4*)(xh + o) = pack4(y);
                s1 += (y[0] + y[1]) + (y[2] + y[3]); s2 += (y[0] * y[0] + y[1] * y[1]) + (y[2] * y[2] + y[3] * y[3]); }
            s1 += shx(s1, 16, lane); s2 += shx(s2, 16, lane); s1 += shx(s1, 32, lane); s2 += shx(s2, 32, lane);
            if (fq == 0) { atomicAdd(ost + 2 * row, s1); atomicAdd(ost + 2 * row + 1, s2); }
#pragma unroll
            for (int k = 0; k < 4; ++k) cur[k] = nxt[k]; }
    }
};
struct EpiUp {
    static constexpr bool PERM = true;
    h16* up; float* pfc; size_t sdelta; const float* st; const float* cv; const float* dv;
    DEVI void operator()(const Acc& acc, const Unit& u, int wr, int wc, int fr, int fq) const {
        const int rowb = u.pm * BM + wr * 64 + fr, colb = u.pn * BM + wc * 32 + fq * 8;
        float mean[8], rstd[8]; f4 c[2][2], d[2][2];
#pragma unroll
        for (int r = 0; r < 8; ++r) { const int row = ROW_OF(r); const float sm = st[2 * row], sq = st[2 * row + 1]; mean[r] = sm * (1.f / DM); rstd[r] = rsqrtf(sq * (1.f / DM) - mean[r] * mean[r] + 1e-5f); }
#pragma unroll
        for (int bj = 0; bj < 2; ++bj)
#pragma unroll
            for (int n = 0; n < 2; ++n) { c[bj][n] = *(const f4*)(cv + colb + bj * HALF + 4 * n); d[bj][n] = *(const f4*)(dv + colb + bj * HALF + 4 * n); }
#pragma unroll
        for (int r = 0; r < 8; ++r) { const int row = ROW_OF(r);
            bool has_st; size_t so;
            if (row < MP) { const int t = row & (SEQ - 1); has_st = t >= SEQ - 2; so = ((size_t)(row >> 11) * 2 + (t - (SEQ - 2))) * DFF2; }
            else { const int rs = row - MP, t = rs & 31; has_st = t >= DSEQ - 2; so = sdelta + ((size_t)(rs >> 5) * 2 + (t - (DSEQ - 2))) * DFF2; }
#pragma unroll
            for (int bj = 0; bj < 2; ++bj) { const int col = colb + bj * HALF;
                const f4 v0 = (acc[r >> 2][bj][r & 3][0] - c[bj][0] * mean[r]) * rstd[r] + d[bj][0], v1 = (acc[r >> 2][bj][r & 3][1] - c[bj][1] * mean[r]) * rstd[r] + d[bj][1];
                *(h8*)(up + (size_t)row * DFF2 + col) = pack8(v0, v1);
                if (has_st) { float* sp = pfc + so + col; *(f4*)sp = v0; *(f4*)(sp + 4) = v1; } } }
    }
};

template <int MODE>
DEVI void transpose_item(const float* W, int ldw, int nblk, h16* WT, int ldd, LAS float* scr, int item, int lane, const float* gs = nullptr) {
    const int kb = item / nblk, nb = item % nblk, k0 = 64 * kb, n0 = 32 * nb;
    int nsrc = n0 + (lane & 31);
    if (MODE == 1) { const int n = nsrc; if (n < 512) nsrc = (n >> 6) * 96 + (n & 63); else if (n < 640) nsrc = ((n - 512) >> 4) * 96 + 64 + ((n - 512) & 15); else nsrc = ((n - 640) >> 4) * 96 + 80 + ((n - 640) & 15); }
#pragma unroll 8
    for (int i = 0; i < 32; ++i) { const int kk = 2 * i + (lane >> 5); float w = W[(size_t)(k0 + kk) * ldw + nsrc]; if (gs) w *= gs[k0 + kk]; scr[kk * 33 + (lane & 31)] = w; }
    __builtin_amdgcn_fence(__ATOMIC_RELEASE, "wavefront"); asm volatile("s_waitcnt lgkmcnt(0)" ::: "memory");
    const int c = lane & 7;
#pragma unroll
    for (int j = 0; j < 4; ++j) { const int n = (lane >> 3) + 8 * j; const LAS float* s = scr + (8 * c) * 33 + n;
        h8 o; o[0] = (h16)s[0 * 33]; o[1] = (h16)s[1 * 33]; o[2] = (h16)s[2 * 33]; o[3] = (h16)s[3 * 33]; o[4] = (h16)s[4 * 33]; o[5] = (h16)s[5 * 33]; o[6] = (h16)s[6 * 33]; o[7] = (h16)s[7 * 33];
        *(h8*)(WT + (size_t)(n0 + n) * ldd + k0 + 8 * c) = o; }
    asm volatile("s_waitcnt lgkmcnt(0)" ::: "memory");
}

template <int NKS, int NCT, int NQS, int KSTR>
DEVI void attn_qk(LAS unsigned char* kbase, const h8 (&qf)[NQS][NKS], f4 (&o)[NQS][NCT], float (&mrow)[NQS], float (&lrow)[NQS], h8 (&pf)[NQS][2], const int nkt, const int lane) {
    const int fr = lane & 15, g = lane >> 4;
    f4 s[NQS][4];
#pragma unroll
    for (int qs = 0; qs < NQS; ++qs)
#pragma unroll
        for (int kt = 0; kt < 4; ++kt) s[qs][kt] = (f4){-1e30f, -1e30f, -1e30f, -1e30f};
#pragma unroll
    for (int kt = 0; kt < 4; ++kt) if (kt < nkt) {
#pragma unroll
        for (int qs = 0; qs < NQS; ++qs) s[qs][kt] = (f4){0.f, 0.f, 0.f, 0.f};
#pragma unroll
        for (int ks = 0; ks < NKS; ++ks) { const h8 kf = *(const LAS h8*)(kbase + (kt * 16 + fr) * KSTR + ks * 64 + g * 16);
#pragma unroll
            for (int qs = 0; qs < NQS; ++qs) s[qs][kt] = __builtin_amdgcn_mfma_f32_16x16x32_f16(kf, qf[qs][ks], s[qs][kt], 0, 0, 0); } }
    __builtin_amdgcn_sched_barrier(0);
#pragma unroll
    for (int qs = 0; qs < NQS; ++qs) {
        float mx = -1e30f;
#pragma unroll
        for (int kt = 0; kt < 4; ++kt)
#pragma unroll
            for (int e = 0; e < 4; ++e) mx = fmaxf(mx, s[qs][kt][e]);
        mx = fmaxf(mx, shx(mx, 16, lane)); mx = fmaxf(mx, shx(mx, 32, lane));
        const float mnew = fmaxf(mrow[qs], mx), alpha = __builtin_amdgcn_exp2f(mrow[qs] - mnew); mrow[qs] = mnew;
        float ps = 0.f;
#pragma unroll
        for (int kt = 0; kt < 4; ++kt)
#pragma unroll
            for (int e = 0; e < 4; ++e) { const float p = __builtin_amdgcn_exp2f(s[qs][kt][e] - mnew); s[qs][kt][e] = p; ps += p; }
        lrow[qs] = lrow[qs] * alpha + ps;
#pragma unroll
        for (int ct = 0; ct < NCT; ++ct) o[qs][ct] *= alpha;
#pragma unroll
        for (int k2 = 0; k2 < 2; ++k2) pf[qs][k2] = pack8(s[qs][2 * k2], s[qs][2 * k2 + 1]);
    }
    __builtin_amdgcn_sched_barrier(0);
}
template <int NCT, int NQS, int VSTR>
DEVI void attn_pv(LAS unsigned char* vbase, f4 (&o)[NQS][NCT], const h8 (&pf)[NQS][2], const int nkt, const int lane) {
    const int fr = lane & 15, g = lane >> 4, q_ = fr >> 2, p_ = fr & 3;
#pragma unroll
    for (int k2 = 0; k2 < 2; ++k2) if (2 * k2 < nkt) {
#pragma unroll
        for (int ct = 0; ct < NCT; ++ct) {
            const h4 lo = trrd(vbase + (32 * k2 + 4 * g + q_) * VSTR + (16 * ct + 4 * p_) * 2);
            const h4 hi = trrd(vbase + (32 * k2 + 16 + 4 * g + q_) * VSTR + (16 * ct + 4 * p_) * 2);
            const h8 vf = cat44(lo, hi);
#pragma unroll
            for (int qs = 0; qs < NQS; ++qs) o[qs][ct] = __builtin_amdgcn_mfma_f32_16x16x32_f16(vf, pf[qs][k2], o[qs][ct], 0, 0, 0); } }
    __builtin_amdgcn_sched_barrier(0);
}
template <int NKS, int NCT, int NQS, int KSTR, int VSTR>
DEVI void attn_tile(LAS unsigned char* kbase, LAS unsigned char* vbase, const h8 (&qf)[NQS][NKS], f4 (&o)[NQS][NCT], float (&mrow)[NQS], float (&lrow)[NQS], const int nkt, const int lane) {
    h8 pf[NQS][2];
    attn_qk<NKS, NCT, NQS, KSTR>(kbase, qf, o, mrow, lrow, pf, nkt, lane);
    attn_pv<NCT, NQS, VSTR>(vbase, o, pf, nkt, lane);
}


#define XB_TMO      128
#define XB_XCNT(j)  (256  + 64 * (j))
#define XB_XSUB(j)  (1280 + 64 * (j))
#define XB_XGEN(j)  (2304 + 64 * (j))
#define XB_TOP      3328
#define XB_TOPGEN   3392
#define XCD_BAR_WORDS 3456
#define XB_SPIN_CAP (1u << 18)
DEVI unsigned xb_ld(unsigned* p)              { return __hip_atomic_load(p, __ATOMIC_RELAXED, __HIP_MEMORY_SCOPE_AGENT); }
DEVI unsigned xb_add(unsigned* p, unsigned v) { return __hip_atomic_fetch_add(p, v, __ATOMIC_RELAXED, __HIP_MEMORY_SCOPE_AGENT); }
DEVI unsigned xb_xcc_id() { return (unsigned)__builtin_amdgcn_s_getreg((3 << 11) | 20) & 0xFu; }
#define XB_SPIN(cond, bar) do { unsigned _sp = 0; while (cond) { __builtin_amdgcn_s_sleep(1); \
    if ((++_sp & 255u) == 0u) { if (xb_ld(&(bar)[XB_TMO])) break; if (_sp > XB_SPIN_CAP) { atomicAdd(&(bar)[XB_TMO], 1u); break; } } } } while (0)
DEVI void xb_complete(unsigned* bar, unsigned x, unsigned& nloc, unsigned& nx, unsigned G) {
    unsigned sum, cnt, mine, sp = 0u;
    for (;;) {
        sum = 0u; cnt = 0u; mine = 0u;
#pragma unroll
        for (unsigned j = 0; j < 16; ++j) { const unsigned c = xb_ld(&bar[XB_XCNT(j)]); sum += c; cnt += (c > 0u) ? 1u : 0u; mine = (j == x) ? c : mine; }
        if (sum == G) break;
        __builtin_amdgcn_s_sleep(1);
        if ((++sp & 255u) == 0u) { if (xb_ld(&bar[XB_TMO])) break; if (sp > XB_SPIN_CAP) { atomicAdd(&bar[XB_TMO], 1u); break; } }
    }
    nloc = mine > 0u ? mine : 1u; nx = cnt > 0u ? cnt : 1u;
}
DEVI void xbar(unsigned* bar, volatile LAS unsigned* st, int tid, unsigned G) {
    asm volatile("s_waitcnt vmcnt(0)" ::: "memory");
    __syncthreads();
    if (tid == 0) {
        const unsigned x = xb_xcc_id();
        __builtin_amdgcn_s_waitcnt(0);
        unsigned nloc = st[0], nx = st[1];
        if (nloc == 0u) { xb_complete(bar, x, nloc, nx, G); st[0] = nloc; st[1] = nx; }
        const unsigned old = xb_add(&bar[XB_XSUB(x)], 1u);
        const unsigned gen = old / nloc;
        if (old + 1u == (gen + 1u) * nloc) {
            __builtin_amdgcn_fence(__ATOMIC_RELEASE, "agent");
            asm volatile("s_waitcnt vmcnt(0)" ::: "memory");
            const unsigned og = xb_add(&bar[XB_TOP], 1u);
            const unsigned tg = og / nx;
            if (og + 1u == (tg + 1u) * nx) xb_add(&bar[XB_TOPGEN], 1u);
            else XB_SPIN(xb_ld(&bar[XB_TOPGEN]) == tg, bar);
            __builtin_amdgcn_fence(__ATOMIC_ACQUIRE, "agent");
            xb_add(&bar[XB_XGEN(x)], 1u);
            asm volatile("s_waitcnt vmcnt(0)" ::: "memory");
        } else {
            XB_SPIN(xb_ld(&bar[XB_XGEN(x)]) == gen, bar);
            __builtin_amdgcn_fence(__ATOMIC_ACQUIRE, "agent");
            asm volatile("s_waitcnt vmcnt(0)" ::: "memory");
        }
    }
    __syncthreads();
}
#ifndef PHM
#define PHM 0xFFFFFFFFu
#endif
#ifndef DBL
#define DBL 0u
#endif
#define NREP(k) (((DBL >> (k)) & 1u) ? 2 : 1)
__global__ void __launch_bounds__(512, 2) trunk_fwd(Params p) {
    extern __shared__ __attribute__((aligned(16))) unsigned char shm_raw[];
    LAS unsigned char* lds = (LAS unsigned char*)shm_raw;
    __shared__ uint4 s_ctl;
#define s_item (*(LAS int*)&s_ctl)
    cg::grid_group grid = cg::this_grid();
    const int wave_s = __builtin_amdgcn_readfirstlane((int)threadIdx.x >> 6);
    if (threadIdx.x == 0) { s_ctl = make_uint4(0u, 0u, 0u, 0u); (void)xb_add((unsigned*)(p.ws + W_BAR) + XB_XCNT(xb_xcc_id()), 1u); }
    __syncthreads();
#define GSYNC() do { const __attribute__((address_space(4))) Params* kq = (const __attribute__((address_space(4))) Params*)__builtin_amdgcn_kernarg_segment_ptr(); asm volatile("" : "+s"(kq)); \
        unsigned Gq = gridDim.x; asm volatile("" : "+s"(Gq)); xbar((unsigned*)(kq->ws + W_BAR), (volatile LAS unsigned*)&s_ctl + 1, wave_s * 64 + opaque_lane(), Gq); } while (0)
#define PH_BEGIN \
    int tid = wave_s * 64 + opaque_lane(); asm volatile("" : "+v"(tid)); \
    int bid = blockIdx.x, G = gridDim.x, lq = l; asm volatile("" : "+s"(bid), "+s"(G), "+s"(lq)); \
    const int lane = tid & 63, wave = __builtin_amdgcn_readfirstlane(tid >> 6); \
    const int gw = bid * 8 + wave, NGW = G * 8; const size_t gtid = (size_t)bid * 512 + tid, NGT = (size_t)G * 512; \
    const __attribute__((address_space(4))) Params* kp = (const __attribute__((address_space(4))) Params*)__builtin_amdgcn_kernarg_segment_ptr(); asm volatile("" : "+s"(kp)); \
    unsigned char* ws = kp->ws; float* out = kp->out; \
    (void)lane; (void)wave; (void)gw; (void)NGW; (void)gtid; (void)NGT; (void)out; (void)lq;
#define WSP(T, off) ((T*)(ws + (off)))
    for (int rep = 0; rep < NREP(0); ++rep) if (PHM & 1u) {
        int tid = wave_s * 64 + opaque_lane(); asm volatile("" : "+v"(tid));
        const int bid = blockIdx.x, G = gridDim.x, lane = tid & 63, wave = __builtin_amdgcn_readfirstlane(tid >> 6);
        const int gw = bid * 8 + wave, NGW = G * 8; const size_t gtid = (size_t)bid * 512 + tid, NGT = (size_t)G * 512;
        unsigned char* ws = p.ws;
        h16* xh = WSP(h16, W_XH); float* ropec = WSP(float, W_ROPE); float* ropes = ropec + NPOS * 16;
        for (size_t i = gtid; i < (size_t)MT * DM / 8; i += NGT) { const size_t e = i * 8; const float* src = e < (size_t)MP * DM ? p.in[0] + e : p.in[1] + (e - (size_t)MP * DM);
            *(h8*)(xh + e) = pack8(*(const f4*)src, *(const f4*)(src + 4)); }
        for (size_t i = gtid; i < (size_t)NPOS * 16; i += NGT) { const int pi = (int)(i >> 4), fi = (int)(i & 15); const double pos = pi < SEQ ? (double)pi : (double)(PAST + pi - SEQ);
            const double ang = pos * exp(-(double)fi / 16.0 * 9.210340371976184); ropec[i] = (float)cos(ang); ropes[i] = (float)sin(ang); }
        for (size_t i = gtid; i < (size_t)DEPTH * 256; i += NGT) WSP(float, W_SP)[i] = log1pf(expf(-p.in[26][i]));
        LAS float* scr = (LAS float*)(lds + wave * 8448);
        for (int l = 0; l < DEPTH; ++l) {
            h16* wt_in = WSP(h16, W_WIN + l * SZ_WIN); h16* wt_uq = WSP(h16, W_WUQ + l * SZ_WUQ); h16* wt_kv = WSP(h16, W_WKV + l * SZ_WKV);
            h16* wt_o = WSP(h16, W_WO + l * SZ_WO); h16* wt_os = WSP(h16, W_WOS + l * SZ_WOS); h16* wt_up = WSP(h16, W_WUP + l * SZ_WUP); h16* wt_dn = WSP(h16, W_WDN + l * SZ_WDN);
            h16* wt_ql = WSP(h16, W_WQL + l * SZ_WQL); h16* wt_g = WSP(h16, W_WG + l * SZ_WG);
            const float* w_in = p.in[11] + (size_t)l * DM * DIN; const float* w_o = p.in[12] + (size_t)l * DM * DM; const float* w_uq = p.in[16] + (size_t)l * 384 * 768;
            const float* w_uk = p.in[18] + (size_t)l * 256 * 512; const float* w_uv = p.in[19] + (size_t)l * 256 * 512; const float* w_up = p.in[27] + (size_t)l * DM * DFF2; const float* w_dn = p.in[30] + (size_t)l * DFF * DM;
            const float* w_r = p.in[22] + (size_t)l * 4 * 64 * 64; const float* w_i = p.in[24] + (size_t)l * 4 * 64 * 64;
            for (int it = gw; it < 16 * 53; it += NGW) transpose_item<0>(w_in, DIN, 53, wt_in, 1024, scr, it, lane, l > 0 ? p.in[9] + (l - 1) * DM : nullptr);
            for (int it = gw; it < 6 * 24; it += NGW) transpose_item<1>(w_uq, 768, 24, wt_uq, 384, scr, it, lane);
            for (int it = gw; it < 4 * 16; it += NGW) transpose_item<0>(w_uk, 512, 16, wt_kv, 256, scr, it, lane);
            for (int it = gw; it < 4 * 16; it += NGW) transpose_item<0>(w_uv, 512, 16, wt_kv + 512 * 256, 256, scr, it, lane);
            for (int it = gw; it < 16 * 32; it += NGW) transpose_item<0>(w_o, 1024, 32, wt_o, 1024, scr, it, lane);
            for (int it = gw; it < 4 * 32; it += NGW) transpose_item<0>(w_o, 1024, 32, wt_os, CSW, scr, it, lane);
            for (int it = gw; it < 4 * 32; it += NGW) transpose_item<0>(w_o + (size_t)768 * 1024, 1024, 32, wt_os + 2304, CSW, scr, it, lane);
            for (int it = gw; it < 16 * 176; it += NGW) transpose_item<0>(w_up, DFF2, 176, wt_up, 1024, scr, it, lane, p.in[7] + l * DM);
            for (int it = gw; it < 44 * 32; it += NGW) transpose_item<0>(w_dn, 1024, 32, wt_dn, DFF, scr, it, lane);
            for (size_t i = gtid; i < (size_t)(ZW - DIN) * 1024 / 8; i += NGT) *(h8*)(wt_in + (size_t)DIN * 1024 + i * 8) = (h8){0, 0, 0, 0, 0, 0, 0, 0};
            { float* cd = WSP(float, W_CD + l * SZ_CD);
              for (size_t i = gtid; i < (size_t)(DIN + DFF2) * 8; i += NGT) { const int kq = (int)(i / (DIN + DFF2)), nn = (int)(i % (DIN + DFF2)); const bool isup = nn >= DIN; const int n = isup ? nn - DIN : nn;
                  if (!isup && l == 0) continue;
                  const float* W = isup ? w_up : w_in; const int ldw = isup ? DFF2 : DIN; const float* gg = isup ? p.in[7] + l * DM : p.in[9] + (l - 1) * DM; const float* bb = isup ? p.in[8] + l * DM : p.in[10] + (l - 1) * DM;
                  float cs = 0.f, ds = 0.f;
#pragma unroll 8
                  for (int k = kq * 128; k < kq * 128 + 128; ++k) { const float w = W[(size_t)k * ldw + n]; cs += gg[k] * w; ds += bb[k] * w; }
                  float* dst = isup ? cd + 2 * ZW : cd; const int stride = isup ? DFF2 : ZW;
                  atomicAdd(dst + n, cs); atomicAdd(dst + stride + n, ds); } }
            for (size_t i = gtid; i < (size_t)512 * 256; i += NGT) { const int n = (int)(i >> 8), k = (int)(i & 255); const int pn = n >> 8, jj = n & 127, isI = (n >> 7) & 1, ch = pn * 128 + jj;
                float v = 0.f; if ((k >> 6) == (ch >> 6)) v = (isI ? w_i : w_r)[((ch >> 6) * 64 + (k & 63)) * 64 + (ch & 63)];
                wt_g[i] = (h16)v; }
            for (size_t i = gtid; i < (size_t)2048 * 384; i += NGT) { const int n = (int)(i / 384), k = (int)(i % 384), hh = n >> 8, c = n & 255;
                const float* a = w_uq + (size_t)k * 768 + hh * 96; const float* b = w_uk + (size_t)c * 512 + hh * 64; float s = 0.f;
#pragma unroll 8
                for (int d = 0; d < 64; ++d) s += a[d] * b[d];
                wt_ql[i] = (h16)s; }
            for (size_t i = gtid; i < (size_t)2048 * 1024; i += NGT) { const int kk = (int)(i & 2047), n = (int)(i >> 11), hh = kk >> 8, c = kk & 255;
                const float* a = w_uv + (size_t)c * 512 + hh * 64; const float* b = w_o + (size_t)(256 + hh * 64) * 1024 + n; float s = 0.f;
#pragma unroll 8
                for (int d = 0; d < 64; ++d) s += a[d] * b[(size_t)d * 1024];
                wt_os[(size_t)n * CSW + 256 + kk] = (h16)s; }
        }
    }
    grid.sync();

    for (int l = 0; l < DEPTH; ++l) {
        for (int rep = 0; rep < NREP(1); ++rep) if (PHM & (1u << 1)) { PH_BEGIN
          Gemm g{WSP(h16, W_XH), WSP(h16, W_WIN + lq * SZ_WIN), MT, ZW, 1024, 1024, 1024}; StaticOrder S; S.init(MT, ZW, G, bid); const int lp = lq > 0 ? lq - 1 : 0; EpiZ E{WSP(h16, W_Z), out + O_SV + (size_t)lq * MS * 256, WSP(float, W_STATS + (size_t)(lp * 2 + 1) * SZ_STATS), WSP(float, W_CD + lq * SZ_CD), WSP(float, W_CD + lq * SZ_CD) + ZW, lq > 0}; gemm_phase(lds, g, S, E, tid); }
        GSYNC();

        for (int rep = 0; rep < NREP(2); ++rep) if (PHM & (1u << 2)) { PH_BEGIN
            const float* qn_g = kp->in[15] + lq * 384; const float* kvn_g = kp->in[17] + lq * 256;
            const float* cw = kp->in[20] + (size_t)lq * 4 * 256; const float* cb = kp->in[21] + lq * 256; const float* stc = kp->in[5] + (size_t)lq * DBATCH * 3 * 256;
            const h16* z = WSP(h16, W_Z); h16* cqn = WSP(h16, W_CQN); h16* ckvn = WSP(h16, W_CKVN); h16* knew = WSP(h16, W_KNEW); h16* kb = WSP(h16, W_K); h16* xc = WSP(h16, W_XC);
            const float* ropec = WSP(float, W_ROPE); const float* ropes = ropec + NPOS * 16;
            for (int row = gw; row < MT; row += NGW) {
                const h16* zr = z + (size_t)row * ZW; const bool samp = row >= MP; const int rs = row - MP;
                const int t = samp ? (rs & 31) : (row & (SEQ - 1)), bb = samp ? (rs >> 5) : (row >> 11);
                { float v[6]; float ss = 0.f;
#pragma unroll
                    for (int i = 0; i < 3; ++i) { const h2 x = *(const h2*)(zr + 512 + 2 * lane + 128 * i); v[2 * i] = (float)x[0]; v[2 * i + 1] = (float)x[1]; ss += v[2 * i] * v[2 * i] + v[2 * i + 1] * v[2 * i + 1]; }
                    const float rr = rsqrtf(wave_sum(ss, lane) * (1.f / 384.f) + 1e-6f);
#pragma unroll
                    for (int i = 0; i < 3; ++i) { const int c = 2 * lane + 128 * i; h2 o; o[0] = (h16)(v[2 * i] * rr * qn_g[c]); o[1] = (h16)(v[2 * i + 1] * rr * qn_g[c + 1]); *(h2*)(cqn + (size_t)row * 384 + c) = o; } }
                { const h4 x = *(const h4*)(zr + 896 + 4 * lane); f4 v; float ss = 0.f;
#pragma unroll
                    for (int e = 0; e < 4; ++e) { v[e] = (float)x[e]; ss += v[e] * v[e]; }
                    const float rr = rsqrtf(wave_sum(ss, lane) * (1.f / 256.f) + 1e-6f); const f4 gg = *(const f4*)(kvn_g + 4 * lane); v = v * rr * gg;
                    if (!samp) { *(f4*)(out + O_PLAT + ((size_t)lq * MP + row) * 256 + 4 * lane) = v; *(h4*)(ckvn + (size_t)row * 256 + 4 * lane) = pack4(v); }
                    else { *(f4*)(out + O_SLAT + ((size_t)lq * MS + rs) * 256 + 4 * lane) = v; *(h4*)(knew + (size_t)rs * KNW + 4 * lane) = pack4(v); } }
                if (lane < 16) { const int pidx = samp ? SEQ + t : t; const float c = ropec[pidx * 16 + lane], s = ropes[pidx * 16 + lane];
                    const float x1 = (float)zr[1152 + lane], x2 = (float)zr[1168 + lane], o1 = x1 * c - x2 * s, o2 = x1 * s + x2 * c;
                    if (!samp) { float* o = out + O_PKR + ((size_t)lq * MP + row) * 32; o[lane] = o1; o[16 + lane] = o2;
                        h16* kr = kb + (size_t)row * KW + 64;
#pragma unroll
                        for (int hh = 0; hh < 8; ++hh) { kr[hh * 96 + lane] = (h16)o1; kr[hh * 96 + 16 + lane] = (h16)o2; } }
                    else { float* o = out + O_SKR + ((size_t)lq * MS + rs) * 32; o[lane] = o1; o[16 + lane] = o2; knew[(size_t)rs * KNW + 256 + lane] = (h16)o1; knew[(size_t)rs * KNW + 272 + lane] = (h16)o2; } }
                { const int c = 4 * lane; f4 accv = *(const f4*)(cb + c);
#pragma unroll
                    for (int j = 0; j < 4; ++j) { const int tau = t - 3 + j; f4 xv;
                        if (tau >= 0) { const h4 x = *(const h4*)(zr - (ptrdiff_t)(3 - j) * ZW + 1184 + c); xv = (f4){(float)x[0], (float)x[1], (float)x[2], (float)x[3]}; }
                        else if (samp) xv = *(const f4*)(stc + ((size_t)bb * 3 + (3 + tau)) * 256 + c);
                        else xv = (f4){0.f, 0.f, 0.f, 0.f};
                        accv += xv * *(const f4*)(cw + j * 256 + c);
                        if (j == 3) { const int T = samp ? DSEQ : SEQ; if (t >= T - 3) { float* o = samp ? out + O_SLC + (((size_t)lq * DBATCH + bb) * 3 + (t - (T - 3))) * 256 : out + O_PLC + (((size_t)lq * NB + bb) * 3 + (t - (T - 3))) * 256; *(f4*)(o + c) = xv; } } }
                    *(h4*)(xc + (size_t)row * 256 + c) = pack4(accv); }
            }
        }
        GSYNC();

        for (int rep = 0; rep < NREP(3); ++rep) if (PHM & (1u << 3)) { PH_BEGIN
          Gemm g{WSP(h16, W_CQN), WSP(h16, W_WUQ + lq * SZ_WUQ), MT, 768, 384, 384, 384}; StaticOrder S; S.init(MT, 768, G, bid);
          EpiQ E{WSP(h16, W_Q), WSP(h16, W_QLAT), WSP(float, W_ROPE), WSP(float, W_ROPE) + NPOS * 16}; gemm_phase(lds, g, S, E, tid); }
        for (int rep = 0; rep < NREP(4); ++rep) if (PHM & (1u << 4)) { PH_BEGIN
          Gemm g{WSP(h16, W_CKVN), WSP(h16, W_WKV + lq * SZ_WKV), MP, 1024, 256, 256, 256}; StaticOrder S; S.init(MP, 1024, G, (bid + G - (396 % G)) % G); EpiKV E{WSP(h16, W_K), WSP(h16, W_V)}; gemm_phase(lds, g, S, E, tid); }
        for (int rep = 0; rep < NREP(5); ++rep) if (PHM & (1u << 5)) { PH_BEGIN
          Gemm g{WSP(h16, W_XC), WSP(h16, W_WG + lq * SZ_WG), MT, 512, 256, 256, 256}; StaticOrder S; S.init(MT, 512, G, (bid + G - (908 % G)) % G);
          EpiGate E{WSP(h16, W_XC), WSP(float, W_A), WSP(float, W_B), kp->in[23] + lq * 256, kp->in[25] + lq * 256, WSP(float, W_SP) + lq * 256}; gemm_phase(lds, g, S, E, tid); }
        for (int rep = 0; rep < NREP(6); ++rep) if (PHM & (1u << 6)) { PH_BEGIN
          Gemm g{WSP(h16, W_CQN) + (size_t)MP * 384, WSP(h16, W_WQL + lq * SZ_WQL), MS, 2048, 384, 384, 384}; StaticOrder S; S.init(MS, 2048, G, (bid + G - (1172 % G)) % G); EpiQlat E{WSP(h16, W_QLAT)}; gemm_phase(lds, g, S, E, tid); }
        for (int rep = 0; rep < NREP(7); ++rep) if (PHM & (1u << 7)) { PH_BEGIN
            const float* gw_s = kp->in[13] + (size_t)lq * 4 * 128 * 128; const float* gb_s = kp->in[14] + (size_t)lq * 4 * 128;
            const h16* z = WSP(h16, W_Z); h16* cat = WSP(h16, W_CAT); h16* cats = WSP(h16, W_CATS);
            const int fr = lane & 15, g4 = lane >> 4, q_ = fr >> 2, p_ = fr & 3;
            for (int item = (bid + G - (1204 % G)) % G; item < 1024 + 128; item += G) {
                const bool samp = item >= 1024; const int head = item & 3; const int ci = samp ? (item - 1024) >> 2 : item >> 2;
                const int R0 = samp ? MP + ci * 32 : ci * 128, L = samp ? 32 : 128;
                __syncthreads();
                for (int id = tid; id < L * 8; id += 512) { const int j = id >> 3, part = id & 7; *(LAS h8*)(lds + j * 144 + part * 16) = *(const h8*)(z + (size_t)(R0 + j) * ZW + 256 + head * 64 + part * 8); }
                __syncthreads();
                const int i0 = 16 * wave;
                if (i0 < L) {
                    f4 sacc[4];
#pragma unroll
                    for (int ct = 0; ct < 4; ++ct) sacc[ct] = (f4){0.f, 0.f, 0.f, 0.f};
                    const int i = i0 + fr;
#pragma unroll
                    for (int ks = 0; ks < 4; ++ks) if (32 * ks <= i0 + 15 && 32 * ks < L) {
                        const int j0 = 32 * ks + 8 * g4; const float* wp = gw_s + ((size_t)head * 128 + i) * 128 + j0; const f4 w0 = *(const f4*)wp, w1 = *(const f4*)(wp + 4);
                        h8 wf;
#pragma unroll
                        for (int e = 0; e < 4; ++e) { wf[e] = (h16)((j0 + e <= i) ? w0[e] : 0.f); wf[4 + e] = (h16)((j0 + 4 + e <= i) ? w1[e] : 0.f); }
#pragma unroll
                        for (int ct = 0; ct < 4; ++ct) { const h4 lo = trrd(lds + (32 * ks + 8 * g4 + q_) * 144 + (16 * ct + 4 * p_) * 2), hi = trrd(lds + (32 * ks + 8 * g4 + 4 + q_) * 144 + (16 * ct + 4 * p_) * 2);
                            sacc[ct] = __builtin_amdgcn_mfma_f32_16x16x32_f16(wf, cat44(lo, hi), sacc[ct], 0, 0, 0); } }
#pragma unroll
                    for (int jx = 0; jx < 4; ++jx) { const int ii = i0 + 4 * g4 + jx; const float bs = gb_s[head * 128 + ii]; const size_t r = (size_t)R0 + ii;
#pragma unroll
                        for (int ct = 0; ct < 4; ++ct) { const int d = head * 64 + 16 * ct + fr; const float uval = (float)z[r * ZW + d]; const h16 o = (h16)(uval * (sacc[ct][jx] + bs));
                            if (!samp) cat[r * 1024 + d] = o; else cats[(r - MP) * CSW + d] = o; } }
                }
            }
            __syncthreads();
        }
        GSYNC();

        for (int rep = 0; rep < NREP(8); ++rep) if (PHM & (1u << 8)) { PH_BEGIN
            unsigned* counter = WSP(unsigned, W_CTR) + lq * 16 + rep * 8;
            const int fr = lane & 15, g4 = lane >> 4;
            constexpr int N_SA = 256, N_PA = 1024, N_PS = 128, N_SS = 16, N_ALL = N_SA + N_PA + N_PS + N_SS;
            for (;;) {
                __syncthreads();
                if (tid == 0) s_item = (int)atomicAdd(counter, 1u);
                __syncthreads();
                const int qi = s_item;
                if (qi >= N_ALL) break;
                const int item = qi < N_PS + N_SS ? qi + N_SA + N_PA : qi - (N_PS + N_SS);
                if (item < N_SA) {
                    constexpr int KS = 592;
                    const float* clat = kp->in[2] + (size_t)lq * DBATCH * PAST * 256; const float* ckr = kp->in[3] + (size_t)lq * DBATCH * PAST * 32;
                    const h16* qlat = WSP(h16, W_QLAT); const h16* knew = WSP(h16, W_KNEW); h16* cats = WSP(h16, W_CATS);
                    const int b = item >> 3, hg = (item >> 2) & 1, sp = item & 3, head = 4 * hg + (wave >> 1), tq = 16 * (wave & 1) + fr, t0 = sp * 16;
                    h8 qf[1][9];
#pragma unroll
                    for (int ks = 0; ks < 9; ++ks) qf[0][ks] = *(const h8*)(qlat + (size_t)(b * 32 + tq) * QLW + head * 288 + 32 * ks + 8 * g4);
                    f4 o[1][16]; float mrow[1] = {-1e30f}, lrow[1] = {0.f};
#pragma unroll
                    for (int ct = 0; ct < 16; ++ct) o[0][ct] = (f4){0.f, 0.f, 0.f, 0.f};
                    const float* lb = clat + (size_t)b * PAST * 256 + (size_t)(t0 * 64 + (tid >> 6)) * 256 + (tid & 63) * 4; const float* rb = ckr + (size_t)b * PAST * 32 + (size_t)(t0 * 64 + (tid >> 3)) * 32 + (tid & 7) * 4;
                    const int wl = (tid >> 6) * KS + (tid & 63) * 8, wr_ = (tid >> 3) * KS + 512 + (tid & 7) * 8;
                    f4 pl[4]; f4 pr;
#pragma unroll
                    for (int hf = 0; hf < 2; ++hf) {
#pragma unroll
                        for (int i = 0; i < 4; ++i) pl[i] = *(const f4*)(lb + (size_t)(hf * 4 + i) * 8 * 256);
#pragma unroll
                        for (int i = 0; i < 4; ++i) *(LAS h4*)(lds + wl + (hf * 4 + i) * 8 * KS) = pack4(pl[i]); }
                    pr = *(const f4*)rb;
                    *(LAS h4*)(lds + wr_) = pack4(pr);
                    __syncthreads();
                    for (int t = 0; t < 16; ++t) {
                        LAS unsigned char* cur = lds + (t & 1) * (64 * KS); LAS unsigned char* nxt = lds + ((t + 1) & 1) * (64 * KS);
                        const bool more = t + 1 < 16;
                        if (more) {
#pragma unroll
                            for (int i = 0; i < 4; ++i) pl[i] = *(const f4*)(lb + ((size_t)(t + 1) * 64 + i * 8) * 256);
                            pr = *(const f4*)(rb + (size_t)(t + 1) * 64 * 32);
                        }
                        h8 pf[1][2];
                        attn_qk<9, 16, 1, KS>(cur, qf, o, mrow, lrow, pf, 4, lane);
                        if (more) {
#pragma unroll
                            for (int i = 0; i < 4; ++i) *(LAS h4*)(nxt + wl + i * 8 * KS) = pack4(pl[i]);
                            *(LAS h4*)(nxt + wr_) = pack4(pr);
#pragma unroll
                            for (int i = 0; i < 4; ++i) pl[i] = *(const f4*)(lb + ((size_t)(t + 1) * 64 + (4 + i) * 8) * 256);
                        }
                        attn_pv<16, 1, KS>(cur, o, pf, 4, lane);
                        if (more) {
#pragma unroll
                            for (int i = 0; i < 4; ++i) *(LAS h4*)(nxt + wl + (4 + i) * 8 * KS) = pack4(pl[i]);
                        } else if (sp == 3) {
                            for (int id = tid; id < 32 * 36; id += 512) { const int key = id / 36, part = id % 36; *(LAS h8*)(nxt + key * KS + part * 16) = *(const h8*)(knew + (size_t)(b * 32 + key) * KNW + part * 8); }
                        }
                        __syncthreads();
                    }
                    if (sp == 3) attn_tile<9, 16, 1, KS, KS>(lds, lds, qf, o, mrow, lrow, 2, lane);
                    { unsigned char* pw = ws + W_PART + ((size_t)item * 8 + wave) * SZ_PARTW;
#pragma unroll
                      for (int ct = 0; ct < 16; ++ct) *(f4*)(pw + ct * 1024 + lane * 16) = o[0][ct];
                      *(float*)(pw + 16384 + lane * 4) = mrow[0]; *(float*)(pw + 16640 + lane * 4) = lrow[0]; }
                    asm volatile("s_waitcnt vmcnt(0)" ::: "memory");
                    __syncthreads();
                    if (tid == 0) { __builtin_amdgcn_fence(__ATOMIC_RELEASE, "agent"); asm volatile("s_waitcnt vmcnt(0)" ::: "memory");
                        const unsigned old = xb_add(WSP(unsigned, W_CTR) + 256 + lq * 64 + rep * 512 + (item >> 2), 1u);
                        if (old == 3u) { __builtin_amdgcn_fence(__ATOMIC_ACQUIRE, "agent"); asm volatile("s_waitcnt vmcnt(0)" ::: "memory"); }
                        *((LAS int*)&s_ctl + 3) = (int)old; }
                    __syncthreads();
                    if (*((LAS int*)&s_ctl + 3) == 3) {
                        const unsigned char* p0 = ws + W_PART + ((size_t)(item & ~3) * 8 + wave) * SZ_PARTW;
                        float mi[4], M = -1e30f;
#pragma unroll
                        for (int i = 0; i < 4; ++i) { mi[i] = *(const float*)(p0 + (size_t)i * 8 * SZ_PARTW + 16384 + lane * 4); M = fmaxf(M, mi[i]); }
                        float L = 0.f;
#pragma unroll
                        for (int i = 0; i < 4; ++i) { mi[i] = __builtin_amdgcn_exp2f(mi[i] - M); L += mi[i] * *(const float*)(p0 + (size_t)i * 8 * SZ_PARTW + 16640 + lane * 4); }
                        L += shx(L, 16, lane); L += shx(L, 32, lane); const float inv = 1.f / L;
                        h16* dst = cats + (size_t)(b * 32 + tq) * CSW + 256 + head * 256 + 4 * g4;
#pragma unroll
                        for (int ct = 0; ct < 16; ++ct) { f4 acc4 = (f4){0.f, 0.f, 0.f, 0.f};
#pragma unroll
                            for (int i = 0; i < 4; ++i) acc4 += *(const f4*)(p0 + (size_t)i * 8 * SZ_PARTW + ct * 1024 + lane * 16) * mi[i];
                            *(h4*)(dst + 16 * ct) = pack4(acc4 * inv); }
                    }
                } else if (item < N_SA + N_PA) {
                    constexpr int KS = 208, VS = 144, KBUF = 64 * KS, VBUF = 64 * VS;
                    const h16* qb = WSP(h16, W_Q); const h16* kb = WSP(h16, W_K); const h16* vb = WSP(h16, W_V); h16* cat = WSP(h16, W_CAT);
                    const int it = item - N_SA, qblk = 7 - (it >> 7), bh = it & 127, b = bh >> 3, head = bh & 7;
                    const int r0 = qblk * 256 + 32 * wave, ntw = (r0 >> 6) + 1, ntb = 4 * (qblk + 1);
                    h8 qf[2][3];
#pragma unroll
                    for (int qs = 0; qs < 2; ++qs)
#pragma unroll
                        for (int ks = 0; ks < 3; ++ks) qf[qs][ks] = *(const h8*)(qb + (size_t)(b * SEQ + r0 + 16 * qs + fr) * QW + head * 96 + 32 * ks + 8 * g4);
                    f4 o[2][4]; float mrow[2] = {-1e30f, -1e30f}, lrow[2] = {0.f, 0.f};
#pragma unroll
                    for (int qs = 0; qs < 2; ++qs)
#pragma unroll
                        for (int ct = 0; ct < 4; ++ct) o[qs][ct] = (f4){0.f, 0.f, 0.f, 0.f};
                    const int k0key = tid / 12, k0part = tid % 12, k1key = (tid + 512) / 12, k1part = (tid + 512) % 12, vkey = tid >> 3, vpart = tid & 7;
                    const h16* kg0 = kb + (size_t)b * SEQ * KW + head * 96 + (size_t)k0key * KW + k0part * 8; const h16* kg1 = kb + (size_t)b * SEQ * KW + head * 96 + (size_t)k1key * KW + k1part * 8;
                    const h16* vg = vb + (size_t)b * SEQ * VW + head * 64 + (size_t)vkey * VW + vpart * 8;
                    const int lk0 = k0key * KS + k0part * 16, lk1 = k1key * KS + k1part * 16, lv = 2 * KBUF + vkey * VS + vpart * 16;
                    h8 pk0, pk1 = (h8){0, 0, 0, 0, 0, 0, 0, 0}, pv;
                    pk0 = *(const h8*)kg0; if (tid < 256) pk1 = *(const h8*)kg1; pv = *(const h8*)vg;
                    *(LAS h8*)(lds + lk0) = pk0; if (tid < 256) *(LAS h8*)(lds + lk1) = pk1; *(LAS h8*)(lds + lv) = pv;
                    __syncthreads();
                    for (int t = 0; t < ntb; ++t) {
                        const int co = (t & 1), no = ((t + 1) & 1);
                        if (t + 1 < ntb) { const size_t ro = (size_t)(t + 1) * 64;
                            pk0 = *(const h8*)(kg0 + ro * KW); if (tid < 256) pk1 = *(const h8*)(kg1 + ro * KW); pv = *(const h8*)(vg + ro * VW); }
                        if (t < ntw) attn_tile<3, 4, 2, KS, VS>(lds + co * KBUF, lds + 2 * KBUF + co * VBUF, qf, o, mrow, lrow, 4, lane);
                        if (t + 1 < ntb) { *(LAS h8*)(lds + no * KBUF + lk0) = pk0; if (tid < 256) *(LAS h8*)(lds + no * KBUF + lk1) = pk1; *(LAS h8*)(lds + no * VBUF + lv) = pv; }
                        __syncthreads();
                    }
#pragma unroll
                    for (int qs = 0; qs < 2; ++qs) { float lt = lrow[qs]; lt += shx(lt, 16, lane); lt += shx(lt, 32, lane); const float inv = 1.f / lt;
                        h16* dst = cat + (size_t)(b * SEQ + r0 + 16 * qs + fr) * 1024 + 256 + head * 64 + 4 * g4;
#pragma unroll
                        for (int ct = 0; ct < 4; ++ct) *(h4*)(dst + 16 * ct) = pack4(o[qs][ct] * inv); }
                } else if (item < N_SA + N_PA + N_PS) {
                    const float* abuf = WSP(float, W_A); const float* bbuf = WSP(float, W_B); const h16* z = WSP(h16, W_Z); h16* cat = WSP(h16, W_CAT);
                    const int it = item - N_SA - N_PA, b = it >> 3, ch = (it & 7) * 32 + (tid & 31), seg = tid >> 5;
                    const size_t rbase = (size_t)b * SEQ + seg * 128;
                    float A = 1.f, B = 0.f;
#pragma unroll 16
                    for (int i = 0; i < 128; ++i) { const float a = abuf[(rbase + i) * 256 + ch], bb = bbuf[(rbase + i) * 256 + ch]; B = a * B + bb; A *= a; }
                    LAS float* sA = (LAS float*)lds; LAS float* sB = sA + 512;
                    sA[tid] = A; sB[tid] = B;
                    __syncthreads();
                    float h = 0.f;
                    for (int s2 = 0; s2 < seg; ++s2) h = sA[s2 * 32 + (tid & 31)] * h + sB[s2 * 32 + (tid & 31)];
#pragma unroll 16
                    for (int i = 0; i < 128; ++i) { const float a = abuf[(rbase + i) * 256 + ch], bb = bbuf[(rbase + i) * 256 + ch]; h = a * h + bb;
                        const float gt = (float)z[(rbase + i) * ZW + 1440 + ch]; cat[(rbase + i) * 1024 + 768 + ch] = (h16)(h * gt); }
                    if (seg == 15) out[O_PH + ((size_t)lq * NB + b) * 256 + ch] = h;
                } else {
                    const float* abuf = WSP(float, W_A); const float* bbuf = WSP(float, W_B); const h16* z = WSP(h16, W_Z); h16* cats = WSP(h16, W_CATS);
                    const int it = item - N_SA - N_PA - N_PS, idx = it * 512 + tid, b = idx >> 8, ch = idx & 255;
                    float h = kp->in[4][((size_t)lq * DBATCH + b) * 256 + ch];
                    for (int t = 0; t < DSEQ; ++t) { const size_t r = (size_t)MP + b * 32 + t; h = abuf[r * 256 + ch] * h + bbuf[r * 256 + ch];
                        const float gt = (float)z[r * ZW + 1440 + ch]; cats[(size_t)(b * 32 + t) * CSW + 2304 + ch] = (h16)(h * gt); }
                    out[O_SH + ((size_t)lq * DBATCH + b) * 256 + ch] = h;
                }
            }
        }
        GSYNC();

        for (int rep = 0; rep < NREP(9); ++rep) if (PHM & (1u << 9)) { PH_BEGIN
          const int lp = lq > 0 ? lq - 1 : 0;
          Gemm g{WSP(h16, W_CATS), WSP(h16, W_WOS + lq * SZ_WOS), MS, 1024, CSW, CSW, CSW}; StaticOrder S; S.init(MS, 1024, G, bid);
          EpiRes E{WSP(h16, W_XH) + (size_t)MP * DM, WSP(float, W_STATS + (size_t)(lp * 2 + 1) * SZ_STATS) + 2 * MP, kp->in[9] + lp * DM, kp->in[10] + lp * DM, lq > 0, WSP(float, W_STATS + (size_t)(lq * 2) * SZ_STATS) + 2 * MP}; gemm_phase(lds, g, S, E, tid); }
        for (int rep = 0; rep < NREP(10); ++rep) if (PHM & (1u << 10)) { PH_BEGIN
          const int lp = lq > 0 ? lq - 1 : 0;
          Gemm g{WSP(h16, W_CAT), WSP(h16, W_WO + lq * SZ_WO), MP, 1024, 1024, 1024, 1024}; StaticOrder S; S.init(MP, 1024, G - 16, bid - 16);
          EpiRes E{WSP(h16, W_XH), WSP(float, W_STATS + (size_t)(lp * 2 + 1) * SZ_STATS), kp->in[9] + lp * DM, kp->in[10] + lp * DM, lq > 0, WSP(float, W_STATS + (size_t)(lq * 2) * SZ_STATS)}; gemm_phase(lds, g, S, E, tid); }
        GSYNC();

        for (int rep = 0; rep < NREP(12); ++rep) if (PHM & (1u << 12)) { PH_BEGIN
          Gemm g{WSP(h16, W_XH), WSP(h16, W_WUP + lq * SZ_WUP), MT, DFF2, 1024, 1024, 1024}; StaticOrder S; S.init(MT, DFF2, G, bid);
          EpiUp E{WSP(h16, W_UP), out + O_PFC + (size_t)lq * NB * 2 * DFF2, (O_SFC + (size_t)lq * DBATCH * 2 * DFF2) - (O_PFC + (size_t)lq * NB * 2 * DFF2), WSP(float, W_STATS + (size_t)(lq * 2) * SZ_STATS), WSP(float, W_CD + lq * SZ_CD) + 2 * ZW, WSP(float, W_CD + lq * SZ_CD) + 2 * ZW + DFF2}; gemm_phase(lds, g, S, E, tid); }
        GSYNC();

        for (int rep = 0; rep < NREP(13); ++rep) if (PHM & (1u << 13)) { PH_BEGIN
            const float* fw = kp->in[28] + (size_t)lq * 3 * DFF2; const float* fb = kp->in[29] + (size_t)lq * DFF2; const float* stf = kp->in[6] + (size_t)lq * DBATCH * 2 * DFF2;
            const h16* up = WSP(h16, W_UP); h16* act = WSP(h16, W_ACT);
            constexpr int RSEG = 32, NCG = DFF / 8;
            for (unsigned it = (unsigned)gtid; it < (unsigned)(NCG * (MT / RSEG)); it += (unsigned)NGT) { const int seg = (int)(it / (unsigned)NCG), cg = (int)(it - (unsigned)seg * NCG), j0 = cg * 8, row0 = seg * RSEG;
                const bool samp = row0 >= MP; const int t0 = samp ? 0 : (row0 & (SEQ - 1)), bb = (row0 - MP) >> 5;
                const f4 bg0 = *(const f4*)(fb + j0), bg1 = *(const f4*)(fb + j0 + 4), bv0 = *(const f4*)(fb + DFF + j0), bv1 = *(const f4*)(fb + DFF + j0 + 4);
                f4 wg0[3], wg1[3], wv0[3], wv1[3];
#pragma unroll
                for (int j = 0; j < 3; ++j) { const float* wj = fw + (size_t)j * DFF2; wg0[j] = *(const f4*)(wj + j0); wg1[j] = *(const f4*)(wj + j0 + 4); wv0[j] = *(const f4*)(wj + DFF + j0); wv1[j] = *(const f4*)(wj + DFF + j0 + 4); }
                f4 ag0, ag1, av0, av1, bg0_, bg1_, bv0_, bv1_;
                if (t0 > 0) { const h16* u2 = up + (size_t)(row0 - 2) * DFF2; const h16* u1 = u2 + DFF2;
                    const h8 a = *(const h8*)(u2 + j0), c = *(const h8*)(u2 + DFF + j0), d = *(const h8*)(u1 + j0), e = *(const h8*)(u1 + DFF + j0);
                    ag0 = (f4){(float)a[0], (float)a[1], (float)a[2], (float)a[3]}; ag1 = (f4){(float)a[4], (float)a[5], (float)a[6], (float)a[7]};
                    av0 = (f4){(float)c[0], (float)c[1], (float)c[2], (float)c[3]}; av1 = (f4){(float)c[4], (float)c[5], (float)c[6], (float)c[7]};
                    bg0_ = (f4){(float)d[0], (float)d[1], (float)d[2], (float)d[3]}; bg1_ = (f4){(float)d[4], (float)d[5], (float)d[6], (float)d[7]};
                    bv0_ = (f4){(float)e[0], (float)e[1], (float)e[2], (float)e[3]}; bv1_ = (f4){(float)e[4], (float)e[5], (float)e[6], (float)e[7]}; }
                else if (samp) { const float* s2 = stf + (size_t)bb * 2 * DFF2; const float* s1 = s2 + DFF2;
                    ag0 = *(const f4*)(s2 + j0); ag1 = *(const f4*)(s2 + j0 + 4); av0 = *(const f4*)(s2 + DFF + j0); av1 = *(const f4*)(s2 + DFF + j0 + 4);
                    bg0_ = *(const f4*)(s1 + j0); bg1_ = *(const f4*)(s1 + j0 + 4); bv0_ = *(const f4*)(s1 + DFF + j0); bv1_ = *(const f4*)(s1 + DFF + j0 + 4); }
                else { ag0 = ag1 = av0 = av1 = bg0_ = bg1_ = bv0_ = bv1_ = (f4){0.f, 0.f, 0.f, 0.f}; }
                const h16* ur = up + (size_t)row0 * DFF2 + j0; h16* ar = act + (size_t)row0 * DFF + j0;
#pragma unroll 4
                for (int r = 0; r < RSEG; ++r) { const h8 a = *(const h8*)(ur + (size_t)r * DFF2), c = *(const h8*)(ur + (size_t)r * DFF2 + DFF);
                    const f4 cg0 = (f4){(float)a[0], (float)a[1], (float)a[2], (float)a[3]}, cg1 = (f4){(float)a[4], (float)a[5], (float)a[6], (float)a[7]};
                    const f4 cv0 = (f4){(float)c[0], (float)c[1], (float)c[2], (float)c[3]}, cv1 = (f4){(float)c[4], (float)c[5], (float)c[6], (float)c[7]};
                    const f4 g0 = bg0 + ag0 * wg0[0] + bg0_ * wg0[1] + cg0 * wg0[2], g1 = bg1 + ag1 * wg1[0] + bg1_ * wg1[1] + cg1 * wg1[2];
                    const f4 v0 = bv0 + av0 * wv0[0] + bv0_ * wv0[1] + cv0 * wv0[2], v1 = bv1 + av1 * wv1[0] + bv1_ * wv1[1] + cv1 * wv1[2];
                    h8 o;
#pragma unroll
                    for (int e = 0; e < 4; ++e) { o[e] = (h16)(gelu_f(g0[e]) * v0[e]); o[4 + e] = (h16)(gelu_f(g1[e]) * v1[e]); }
                    *(h8*)(ar + (size_t)r * DFF) = o;
                    ag0 = bg0_; ag1 = bg1_; av0 = bv0_; av1 = bv1_; bg0_ = cg0; bg1_ = cg1; bv0_ = cv0; bv1_ = cv1; } }
        }
        GSYNC();

        for (int rep = 0; rep < NREP(14); ++rep) if (PHM & (1u << 14)) { PH_BEGIN
          Gemm g{WSP(h16, W_ACT), WSP(h16, W_WDN + lq * SZ_WDN), MT, 1024, DFF, DFF, DFF}; StaticOrder S; S.init(MT, 1024, G, bid); EpiRes E{WSP(h16, W_XH), WSP(float, W_STATS + (size_t)(lq * 2) * SZ_STATS), kp->in[7] + lq * DM, kp->in[8] + lq * DM, true, WSP(float, W_STATS + (size_t)(lq * 2 + 1) * SZ_STATS)}; gemm_phase(lds, g, S, E, tid); }
        GSYNC();

    }
    { const int l = DEPTH - 1; PH_BEGIN
        const float* gg = kp->in[9] + lq * DM; const float* bb = kp->in[10] + lq * DM; const h16* pre2 = WSP(h16, W_XH); const float* st = WSP(float, W_STATS + (size_t)(lq * 2 + 1) * SZ_STATS);
        for (size_t i = gtid; i < (size_t)MT * (DM / 4); i += NGT) { const int row = (int)(i >> 8), c = (int)(i & 255) * 4;
            const float sm = st[2 * row], sq = st[2 * row + 1], mean = sm * (1.f / DM), rstd = rsqrtf(sq * (1.f / DM) - mean * mean + 1e-5f);
            const h4 xv = *(const h4*)(pre2 + (size_t)row * DM + c);
            *(f4*)(out + O_Y + (size_t)row * DM + c) = ((f4){(float)xv[0], (float)xv[1], (float)xv[2], (float)xv[3]} - mean) * rstd * *(const f4*)(gg + c) + *(const f4*)(bb + c); }
    }
}

extern "C" void kernel_launch(void* const* d_in, const int* in_sizes, int n_in, void* d_out, int out_size, void* d_ws, size_t ws_size, hipStream_t stream) {
    constexpr size_t kDynLds = STAGE_BYTES;
    static int grid_blocks = 0;
    if (!grid_blocks) {
        if (n_in != 31 || (size_t)out_size != O_END || ws_size < W_END) { fprintf(stderr, "kernel_launch: unexpected shapes n_in %d out %d ws %zu (need %zu)\n", n_in, out_size, ws_size, (size_t)W_END); grid_blocks = -1; return; }
        int dev = 0, cus = 0, per_cu = 0;
        hipGetDevice(&dev);
        hipDeviceGetAttribute(&cus, hipDeviceAttributeMultiprocessorCount, dev);
        hipFuncSetAttribute((const void*)trunk_fwd, hipFuncAttributeMaxDynamicSharedMemorySize, (int)kDynLds);
        hipOccupancyMaxActiveBlocksPerMultiprocessor(&per_cu, (const void*)trunk_fwd, 512, kDynLds);
        if (per_cu < 1) per_cu = 1;
        grid_blocks = cus * per_cu;
        if (grid_blocks > 256) grid_blocks = 256;
        if (grid_blocks < 32) { fprintf(stderr, "kernel_launch: grid %d too small\n", grid_blocks); grid_blocks = -1; return; }
    }
    if (grid_blocks < 0) return;
    hipMemsetAsync((char*)d_ws + W_CTR, 0, W_ZERO_END, stream);
    Params p{};
    for (int i = 0; i < 31; ++i) p.in[i] = (const float*)d_in[i];
    p.out = (float*)d_out; p.ws = (unsigned char*)d_ws;
    void* args[] = {&p};
    hipError_t e = hipLaunchCooperativeKernel((const void*)trunk_fwd, dim3(grid_blocks), dim3(512), args, kDynLds, stream);
    if (e != hipSuccess) fprintf(stderr, "cooperative launch failed: %s (grid %d)\n", hipGetErrorString(e), grid_blocks);
}
```

```cpp
#include <hip/hip_runtime.h>
#include <hip/hip_cooperative_groups.h>
#include <cstdio>
#include <cstdint>
namespace cg = cooperative_groups;

typedef _Float16 h16;
typedef _Float16 h8 __attribute__((ext_vector_type(8)));
typedef _Float16 h4 __attribute__((ext_vector_type(4)));
typedef _Float16 h2 __attribute__((ext_vector_type(2)));
typedef float f4 __attribute__((ext_vector_type(4)));
typedef short s4v __attribute__((__vector_size__(8)));
#define LAS __attribute__((address_space(3)))
#define DEVI __device__ __forceinline__

constexpr int DM = 1024, NB = 16, SEQ = 2048, DEPTH = 4, DBATCH = 32, DSEQ = 32, PAST = 4096;
constexpr int MP = NB * SEQ, MS = DBATCH * DSEQ, MT = MP + MS;
constexpr int DIN = 1696, ZW = 1792, DFF = 2816, DFF2 = 5632;
constexpr int QW = 768, KW = 768, VW = 512, QLW = 2304, CSW = 2560, KNW = 288;
constexpr float ALPHA = 1.681792830507429f;
constexpr float QSCALE = 0.14724444f;
constexpr int NPOS = SEQ + DSEQ;

constexpr size_t O_Y = 0;
constexpr size_t O_PLAT = (size_t)MT * DM;
constexpr size_t O_PKR = O_PLAT + (size_t)DEPTH * MP * 256;
constexpr size_t O_PH = O_PKR + (size_t)DEPTH * MP * 32;
constexpr size_t O_PLC = O_PH + (size_t)DEPTH * NB * 256;
constexpr size_t O_PFC = O_PLC + (size_t)DEPTH * NB * 3 * 256;
constexpr size_t O_SLAT = O_PFC + (size_t)DEPTH * NB * 2 * DFF2;
constexpr size_t O_SKR = O_SLAT + (size_t)DEPTH * MS * 256;
constexpr size_t O_SV = O_SKR + (size_t)DEPTH * MS * 32;
constexpr size_t O_SH = O_SV + (size_t)DEPTH * MS * 256;
constexpr size_t O_SLC = O_SH + (size_t)DEPTH * DBATCH * 256;
constexpr size_t O_SFC = O_SLC + (size_t)DEPTH * DBATCH * 3 * 256;
constexpr size_t O_END = O_SFC + (size_t)DEPTH * DBATCH * 2 * DFF2;

constexpr size_t al(size_t x) { return (x + 255) & ~(size_t)255; }
constexpr size_t W_CTR = 0;
constexpr size_t W_PARAMS = 2048;
constexpr size_t W_BAR = 4096;
constexpr size_t W_CD = 4096 + 16384;
constexpr size_t SZ_CD = (size_t)(2 * ZW + 2 * DFF2) * 4;
constexpr size_t W_STATS = W_CD + DEPTH * SZ_CD;
constexpr size_t SZ_STATS = (size_t)MT * 2 * 4;
constexpr size_t W_ZERO_END = W_STATS + (size_t)DEPTH * 2 * SZ_STATS;
constexpr size_t W_ROPE = al(W_ZERO_END);
constexpr size_t W_SP = al(W_ROPE + (size_t)NPOS * 16 * 2 * 4);
constexpr size_t W_WIN = al(W_SP + (size_t)DEPTH * 256 * 4);
constexpr size_t SZ_WIN = (size_t)ZW * 1024 * 2;
constexpr size_t W_WUQ = W_WIN + DEPTH * SZ_WIN;   constexpr size_t SZ_WUQ = (size_t)768 * 384 * 2;
constexpr size_t W_WQL = W_WUQ + DEPTH * SZ_WUQ;   constexpr size_t SZ_WQL = (size_t)2048 * 384 * 2;
constexpr size_t W_WKV = W_WQL + DEPTH * SZ_WQL;   constexpr size_t SZ_WKV = (size_t)1024 * 256 * 2;
constexpr size_t W_WG = W_WKV + DEPTH * SZ_WKV;    constexpr size_t SZ_WG = (size_t)512 * 256 * 2;
constexpr size_t W_WO = W_WG + DEPTH * SZ_WG;      constexpr size_t SZ_WO = (size_t)1024 * 1024 * 2;
constexpr size_t W_WOS = W_WO + DEPTH * SZ_WO;     constexpr size_t SZ_WOS = (size_t)8 * 64 * 256 * 2;
constexpr size_t W_WUP = W_WOS + DEPTH * SZ_WOS;   constexpr size_t SZ_WUP = (size_t)DFF2 * 1024 * 2;
constexpr size_t W_WDN = W_WUP + DEPTH * SZ_WUP;   constexpr size_t SZ_WDN = (size_t)1024 * DFF * 2;
constexpr size_t W_XH = W_WDN + DEPTH * SZ_WDN;
constexpr size_t W_Z = W_XH + (size_t)MT * 1024 * 2;
constexpr size_t W_CQN = W_Z + (size_t)MT * ZW * 2;
constexpr size_t W_CKVN = W_CQN + (size_t)MT * 384 * 2;
constexpr size_t W_XC = W_CKVN + (size_t)MP * 256 * 2;
constexpr size_t W_Q = W_XC + (size_t)MT * 256 * 2;
constexpr size_t W_K = W_Q + (size_t)MP * QW * 2;
constexpr size_t W_V = W_K + (size_t)MP * KW * 2;
constexpr size_t W_A = W_V + (size_t)MP * VW * 2;
constexpr size_t W_B = W_A + (size_t)MT * 256 * 4;
constexpr size_t W_CAT = W_B + (size_t)MT * 256 * 4;
constexpr size_t W_CATS = W_CAT + (size_t)MP * 1024 * 2;
constexpr size_t W_QLAT = W_CATS + (size_t)MS * 1024 * 2;
constexpr size_t W_KNEW = W_QLAT + (size_t)MS * QLW * 2;
constexpr size_t W_PRE = al(W_KNEW + (size_t)MS * KNW * 2);
constexpr size_t W_X1F = W_PRE + (size_t)MT * 1024 * 4;
constexpr size_t W_UP = W_X1F + (size_t)MT * 1024 * 4;
constexpr size_t W_ACT = W_UP + (size_t)MT * DFF2 * 2;
constexpr size_t W_PART = W_ACT + (size_t)MT * DFF * 2;
constexpr size_t SZ_PARTW = 16 * 1024 + 512;
constexpr size_t W_END = W_PART + (size_t)256 * 8 * SZ_PARTW;

struct Params { const float* in[31]; float* out; unsigned char* ws; };

DEVI float gelu_f(float x) { const float u = -2.302208198f * (x + 0.044715f * x * x * x); return x * __builtin_amdgcn_rcpf(1.f + __builtin_amdgcn_exp2f(u)); }
DEVI float sigmoid_f(float x) { return __builtin_amdgcn_rcpf(1.f + __builtin_amdgcn_exp2f(-1.4426950408889634f * x)); }
DEVI h8 pack8(f4 a, f4 b) { h8 r; r[0] = (h16)a[0]; r[1] = (h16)a[1]; r[2] = (h16)a[2]; r[3] = (h16)a[3]; r[4] = (h16)b[0]; r[5] = (h16)b[1]; r[6] = (h16)b[2]; r[7] = (h16)b[3]; return r; }
DEVI h4 pack4(f4 a) { h4 r; r[0] = (h16)a[0]; r[1] = (h16)a[1]; r[2] = (h16)a[2]; r[3] = (h16)a[3]; return r; }
DEVI float shx(float v, int o, int lane) { return __builtin_bit_cast(float, __builtin_amdgcn_ds_bpermute((lane ^ o) << 2, __builtin_bit_cast(int, v))); }
DEVI float wave_sum(float v, int lane) {
#pragma unroll
    for (int o = 1; o < 64; o <<= 1) v += shx(v, o, lane);
    return v;
}
DEVI int opaque_lane() { unsigned ones = ~0u; asm volatile("" : "+s"(ones)); return (int)__builtin_amdgcn_mbcnt_hi(ones, __builtin_amdgcn_mbcnt_lo(ones, 0u)); }
DEVI h4 trrd(LAS unsigned char* p) { s4v r = __builtin_amdgcn_ds_read_tr16_b64_v4i16((LAS s4v*)p); return __builtin_bit_cast(h4, r); }
DEVI h8 cat44(h4 a, h4 b) { return __builtin_shufflevector(a, b, 0, 1, 2, 3, 4, 5, 6, 7); }

constexpr int BM = 256, BK = 64, HALF = 128, HTB = HALF * BK * 2, STAGE_BYTES = 8 * HTB, NXCD = 8, WGM = 8;
DEVI int lds_byte(int r, int c) { const int st = (r >> 4) * 2 + (c >> 5), rr = r & 15, cc = c & 31, ob = rr * 64 + cc * 2; return st * 1024 + (ob ^ (((ob >> 9) & 1) << 5)); }
DEVI void stage_rc(int b, int& R, int& C) { const int st = b / 1024, sb = b % 1024, swz = sb ^ (((sb >> 9) & 1) << 5); R = (st >> 1) * 16 + swz / 64; C = (st & 1) * 32 + (swz % 64) / 2; }
DEVI int perm32(int rho) { const int n = rho >> 4, i = rho & 15; return 8 * (i >> 2) + 4 * n + (i & 3); }
struct Unit { int pm, pn; };
struct Gemm { const h16* A; const h16* Bt; int M, N, K, lda, ldb; };
struct StaticOrder {
    int nM, nN, nwg, G, c;
    DEVI void init(int M, int N, int G_, int c_) { nM = M / BM; nN = N / BM; nwg = nM * nN; G = G_; c = c_; }
    DEVI bool next(int i, Unit& u) const {
        if (c < 0) return false;
        const long L = (long)i * G + c; if (L >= nwg) return false;
        int wgid = (int)L; { const int q = nwg / NXCD, r = nwg % NXCD, xcd = wgid % NXCD, off = wgid / NXCD; wgid = (xcd < r ? xcd * (q + 1) : r * (q + 1) + (xcd - r) * q) + off; }
        const int nig = WGM * nN, gid = wgid / nig, fm = gid * WGM, gsz = (nM - fm) < WGM ? (nM - fm) : WGM;
        u.pm = fm + ((wgid % nig) % gsz); u.pn = (wgid % nig) / gsz; return true;
    }
};
template <class Epi>
DEVI void gemm_phase(LAS unsigned char* lds, const Gemm g, const StaticOrder& S, const Epi& E, const int tid) {
    const int wid = __builtin_amdgcn_readfirstlane(tid >> 6), lane = tid & 63, wr = wid >> 2, wc = wid & 3, fr = lane & 15, fq = lane >> 4;
    const int K = g.K, nt = K / BK;
    unsigned voffA[2], voffB[2];
#pragma unroll
    for (int i = 0; i < 2; ++i) { int R, C; stage_rc(tid * 16 + i * 8192, R, C); const int Rb = Epi::PERM ? ((R & ~31) + perm32(R & 31)) : R;
        voffA[i] = (unsigned)(R * g.lda + C) * 2u; voffB[i] = (unsigned)(Rb * g.ldb + C) * 2u; }
    const size_t kstep = (size_t)(BK * 2);
    const size_t hstepA = (size_t)HALF * g.lda * 2, hstepB = (size_t)HALF * g.ldb * 2;
    const size_t tstepA = 2 * hstepA, tstepB = 2 * hstepB;
    const unsigned ldsw = (unsigned)wid * 1024u;
    const int aoff = lds_byte(wr * 64 + fr, fq * 8), boff = lds_byte(wc * 32 + fr, fq * 8);
#define PG8_SA(b, h) (((b) * 2 + (h)) * HTB)
#define PG8_SB(b, h) ((4 + (b) * 2 + (h)) * HTB)
#define PG8_STAGE(bufoff, gbase, voff) do { _Pragma("unroll") for (int _i = 0; _i < 2; ++_i) \
        __builtin_amdgcn_global_load_lds((const unsigned*)((const char*)(gbase) + (voff)[_i]), (LAS unsigned*)(lds + (bufoff) + ldsw + _i * 8192), 16, 0, 0); } while (0)
#define PG8_LDA(dst, b, h) do { _Pragma("unroll") for (int m = 0; m < 4; ++m) _Pragma("unroll") for (int k = 0; k < 2; ++k) dst[m][k] = *(const LAS h8*)(lds + PG8_SA(b, h) + aoff + m * 2048 + k * 1024); } while (0)
#define PG8_LDB(dst, b, h) do { _Pragma("unroll") for (int n = 0; n < 2; ++n) _Pragma("unroll") for (int k = 0; k < 2; ++k) dst[n][k] = *(const LAS h8*)(lds + PG8_SB(b, h) + boff + n * 2048 + k * 1024); } while (0)
#define PG8_MMA(ai, bj, At, Bt) do { __builtin_amdgcn_s_setprio(1); _Pragma("unroll") for (int m = 0; m < 4; ++m) _Pragma("unroll") for (int n = 0; n < 2; ++n) _Pragma("unroll") for (int k = 0; k < 2; ++k) \
        acc[ai][bj][m][n] = __builtin_amdgcn_mfma_f32_16x16x32_f16(Bt[n][k], At[m][k], acc[ai][bj][m][n], 0, 0, 0); __builtin_amdgcn_s_setprio(0); } while (0)
#define PG8_WAIT_V(n) asm volatile("s_waitcnt vmcnt(" #n ")" ::: "memory")
#define PG8_WAIT_L(n) asm volatile("s_waitcnt lgkmcnt(" #n ")" ::: "memory")
#define PG8_BAR __builtin_amdgcn_s_barrier()
#define PG8_SCHED __builtin_amdgcn_sched_barrier(0)
    Unit cur, nxt; int ui = 0;
    if (!S.next(0, cur)) return;
    f4 acc[2][2][4][2];
#pragma unroll
    for (int a = 0; a < 2; ++a)
#pragma unroll
        for (int b = 0; b < 2; ++b)
#pragma unroll
            for (int m = 0; m < 4; ++m)
#pragma unroll
                for (int n = 0; n < 2; ++n) acc[a][b][m][n] = (f4){0.f, 0.f, 0.f, 0.f};
    h8 At[4][2], B0[2][2], B1[2][2];
    const char* cA = (const char*)g.A + (size_t)cur.pm * tstepA; const char* cB = (const char*)g.Bt + (size_t)cur.pn * tstepB;
    PG8_STAGE(PG8_SB(0, 0), cB, voffB); PG8_STAGE(PG8_SA(0, 0), cA, voffA); PG8_STAGE(PG8_SB(0, 1), cB + hstepB, voffB); PG8_STAGE(PG8_SA(0, 1), cA + hstepA, voffA);
    if (wr == 1) PG8_BAR;
    PG8_WAIT_V(4); PG8_BAR;
    PG8_STAGE(PG8_SB(1, 0), cB + kstep, voffB); PG8_STAGE(PG8_SA(1, 0), cA + kstep, voffA); PG8_STAGE(PG8_SB(1, 1), cB + hstepB + kstep, voffB);
    PG8_WAIT_V(6); PG8_BAR;
    for (;;) {
        const bool has_next = S.next(ui + 1, nxt);
        const char* nA = has_next ? (const char*)g.A + (size_t)nxt.pm * tstepA : cA; const char* nB = has_next ? (const char*)g.Bt + (size_t)nxt.pn * tstepB : cB;
        for (int t = 0; t < nt; t += 2) {
            const bool last = (t == nt - 2);
            const char* a1 = cA + (size_t)(t + 1) * kstep;
            const char* a2 = last ? nA : cA + (size_t)(t + 2) * kstep; const char* b2 = last ? nB : cB + (size_t)(t + 2) * kstep;
            const char* a3 = a2 + kstep; const char* b3 = b2 + kstep;
            PG8_LDB(B0, 0, 0); PG8_SCHED; PG8_LDA(At, 0, 0); PG8_STAGE(PG8_SA(1, 1), a1 + hstepA, voffA);
            PG8_WAIT_L(8); PG8_BAR; PG8_WAIT_L(0); PG8_MMA(0, 0, At, B0); PG8_BAR; PG8_SCHED;
            PG8_LDB(B1, 0, 1); PG8_STAGE(PG8_SB(0, 0), b2, voffB);
            PG8_BAR; PG8_WAIT_L(0); PG8_MMA(0, 1, At, B1); PG8_BAR;
            PG8_LDA(At, 0, 1); PG8_STAGE(PG8_SA(0, 0), a2, voffA);
            PG8_BAR; PG8_WAIT_L(0); PG8_MMA(1, 0, At, B0); PG8_BAR; PG8_SCHED;
            PG8_STAGE(PG8_SB(0, 1), b2 + hstepB, voffB);
            PG8_WAIT_V(6); PG8_BAR; PG8_MMA(1, 1, At, B1); PG8_BAR;
            PG8_LDB(B0, 1, 0); PG8_SCHED; PG8_LDA(At, 1, 0); PG8_STAGE(PG8_SA(0, 1), a2 + hstepA, voffA);
            PG8_WAIT_L(8); PG8_BAR; PG8_WAIT_L(0); PG8_MMA(0, 0, At, B0); PG8_BAR; PG8_SCHED;
            PG8_LDB(B1, 1, 1); PG8_STAGE(PG8_SB(1, 0), b3, voffB);
            PG8_BAR; PG8_WAIT_L(0); PG8_MMA(0, 1, At, B1); PG8_BAR;
            PG8_LDA(At, 1, 1); PG8_STAGE(PG8_SA(1, 0), a3, voffA);
            PG8_BAR; PG8_WAIT_L(0); PG8_MMA(1, 0, At, B0); PG8_BAR; PG8_SCHED;
            PG8_STAGE(PG8_SB(1, 1), b3 + hstepB, voffB);
            PG8_WAIT_V(6); PG8_BAR; PG8_MMA(1, 1, At, B1); PG8_BAR;
        }
        { int t2 = tid; asm volatile("" : "+v"(t2)); const int l2 = t2 & 63; E(acc, cur, wr, wc, l2 & 15, l2 >> 4); }
        if (!has_next) break;
#pragma unroll
        for (int a = 0; a < 2; ++a)
#pragma unroll
            for (int b = 0; b < 2; ++b)
#pragma unroll
                for (int m = 0; m < 4; ++m)
#pragma unroll
                    for (int n = 0; n < 2; ++n) acc[a][b][m][n] = (f4){0.f, 0.f, 0.f, 0.f};
        cur = nxt; cA = nA; cB = nB; ++ui;
    }
    PG8_WAIT_V(0);
    if (wr == 0) PG8_BAR;
    PG8_BAR;
#undef PG8_SA
#undef PG8_SB
#undef PG8_STAGE
#undef PG8_LDA
#undef PG8_LDB
#undef PG8_MMA
#undef PG8_WAIT_V
#undef PG8_WAIT_L
#undef PG8_BAR
#undef PG8_SCHED
}

typedef f4 Acc[2][2][4][2];
#define EPI_ROWS for (int ai = 0; ai < 2; ++ai) _Pragma("unroll") for (int m = 0; m < 4; ++m)

#define ROW_OF(r) (rowb + ((r) >> 2) * HALF + ((r) & 3) * 16)
struct EpiZ {
    static constexpr bool PERM = true;
    h16* z; float* sv; const float* st; const float* cv; const float* dv; bool fold;
    DEVI void operator()(const Acc& acc, const Unit& u, int wr, int wc, int fr, int fq) const {
        const int rowb = u.pm * BM + wr * 64 + fr, colb = u.pn * BM + wc * 32 + fq * 8;
        float mean[8], rstd[8]; f4 c[2][2], d[2][2];
#pragma unroll
        for (int r = 0; r < 8; ++r) { mean[r] = 0.f; rstd[r] = 1.f; }
#pragma unroll
        for (int bj = 0; bj < 2; ++bj)
#pragma unroll
            for (int n = 0; n < 2; ++n) { c[bj][n] = (f4){0.f, 0.f, 0.f, 0.f}; d[bj][n] = c[bj][n]; }
        if (fold) {
#pragma unroll
            for (int r = 0; r < 8; ++r) { const int row = ROW_OF(r); const float sm = st[2 * row], sq = st[2 * row + 1]; mean[r] = sm * (1.f / DM); rstd[r] = rsqrtf(sq * (1.f / DM) - mean[r] * mean[r] + 1e-5f); }
#pragma unroll
            for (int bj = 0; bj < 2; ++bj)
#pragma unroll
                for (int n = 0; n < 2; ++n) { c[bj][n] = *(const f4*)(cv + colb + bj * HALF + 4 * n); d[bj][n] = *(const f4*)(dv + colb + bj * HALF + 4 * n); } }
#pragma unroll
        for (int bj = 0; bj < 2; ++bj) { const int col = colb + bj * HALF; const bool act = col < 512 || (col >= 1440 && col < 1696);
#pragma unroll
            for (int r = 0; r < 8; ++r) { const int row = ROW_OF(r);
                f4 v0 = (acc[r >> 2][bj][r & 3][0] - c[bj][0] * mean[r]) * rstd[r] + d[bj][0], v1 = (acc[r >> 2][bj][r & 3][1] - c[bj][1] * mean[r]) * rstd[r] + d[bj][1];
                if (act) {
#pragma unroll
                    for (int e = 0; e < 4; ++e) { v0[e] = gelu_f(v0[e]); v1[e] = gelu_f(v1[e]); } }
                *(h8*)(z + (size_t)row * ZW + col) = pack8(v0, v1);
                if (row >= MP && col >= 256 && col < 512) { float* o = sv + (size_t)(row - MP) * 256 + (col - 256); *(f4*)o = v0; *(f4*)(o + 4) = v1; } } }
    }
};
struct EpiQ {
    static constexpr bool PERM = true;
    h16* q; h16* qlat; const float* ropec; const float* ropes;
    DEVI void operator()(const Acc& acc, const Unit& u, int wr, int wc, int fr, int fq) const {
        const bool samp = u.pm * BM >= MP;
        if (u.pn < 2) { if (samp) return;
#pragma unroll
            EPI_ROWS { const int row = u.pm * BM + ai * HALF + wr * 64 + m * 16 + fr;
#pragma unroll
                for (int bj = 0; bj < 2; ++bj) { const int col = u.pn * BM + bj * HALF + wc * 32 + fq * 8;
                    *(h8*)(q + (size_t)row * QW + (col >> 6) * 96 + (col & 63)) = pack8(acc[ai][bj][m][0] * QSCALE, acc[ai][bj][m][1] * QSCALE); } }
        } else {
            const int j = wc * 32 + fq * 8, head = j >> 4, i0 = j & 15; const int rowb = u.pm * BM + wr * 64 + fr;
#pragma unroll
            for (int r = 0; r < 8; ++r) { const int row = ROW_OF(r); const int pidx = samp ? SEQ + ((row - MP) & 31) : (row & (SEQ - 1));
                const size_t po = samp ? (W_QLAT - W_Q) / 2 + (size_t)(row - MP) * QLW + head * 288 + 256 + i0 : (size_t)row * QW + head * 96 + 64 + i0;
#pragma unroll
                for (int n = 0; n < 2; ++n) { const f4 cc = *(const f4*)(ropec + pidx * 16 + i0 + 4 * n), ss = *(const f4*)(ropes + pidx * 16 + i0 + 4 * n);
                    const f4 a0 = acc[r >> 2][0][r & 3][n], b0 = acc[r >> 2][1][r & 3][n];
                    *(h4*)(q + po + 4 * n) = pack4((a0 * cc - b0 * ss) * QSCALE); *(h4*)(q + po + 16 + 4 * n) = pack4((a0 * ss + b0 * cc) * QSCALE); } }
        }
    }
};
struct EpiKV {
    static constexpr bool PERM = true;
    h16* k; h16* v;
    DEVI void operator()(const Acc& acc, const Unit& u, int wr, int wc, int fr, int fq) const {
#pragma unroll
        EPI_ROWS { const int row = u.pm * BM + ai * HALF + wr * 64 + m * 16 + fr;
#pragma unroll
            for (int bj = 0; bj < 2; ++bj) { const int col = u.pn * BM + bj * HALF + wc * 32 + fq * 8; const h8 o = pack8(acc[ai][bj][m][0], acc[ai][bj][m][1]);
                if (u.pn < 2) *(h8*)(k + (size_t)row * KW + (col >> 6) * 96 + (col & 63)) = o; else *(h8*)(v + (size_t)row * VW + (col - 512)) = o; } }
    }
};
DEVI float one_minus_exp(float x) {
    const float pser = -x * (1.f + x * (0.5f + x * (0.16666667f + x * (0.041666668f + x * (0.0083333338f + x * 0.0013888889f)))));
    return x > -0.25f ? pser : 1.f - __builtin_amdgcn_exp2f(1.4426950408889634f * x);
}
struct EpiGate {
    static constexpr bool PERM = false;
    const h16* xc; float* a; float* b; const float* br; const float* bi; const float* sp;
    DEVI void operator()(const Acc& acc, const Unit& u, int wr, int wc, int fr, int fq) const {
        const int rowb = u.pm * BM + wr * 64 + fr, chb = u.pn * 128 + wc * 32 + fq * 4;
        f4 vbr[2], vbi[2], vsp[2]; h4 xv[2][8];
#pragma unroll
        for (int n = 0; n < 2; ++n) { const int ch = chb + n * 16; vbr[n] = *(const f4*)(br + ch); vbi[n] = *(const f4*)(bi + ch); vsp[n] = *(const f4*)(sp + ch) * -8.f;
#pragma unroll
            for (int r = 0; r < 8; ++r) xv[n][r] = *(const h4*)(xc + (size_t)ROW_OF(r) * 256 + ch); }
#pragma unroll
        for (int n = 0; n < 2; ++n) { const int ch = chb + n * 16;
#pragma unroll
            for (int r = 0; r < 8; ++r) { const int row = ROW_OF(r); f4 oa, ob;
#pragma unroll
                for (int e = 0; e < 4; ++e) { const float rg = sigmoid_f(acc[r >> 2][0][r & 3][n][e] + vbr[n][e]), ig = sigmoid_f(acc[r >> 2][1][r & 3][n][e] + vbi[n][e]);
                    const float la = rg * vsp[n][e]; oa[e] = __builtin_amdgcn_exp2f(1.4426950408889634f * la); ob[e] = __builtin_amdgcn_sqrtf(one_minus_exp(2.f * la)) * (ig * (float)xv[n][r][e]); }
                *(f4*)(a + (size_t)row * 256 + ch) = oa; *(f4*)(b + (size_t)row * 256 + ch) = ob; } }
    }
};
struct EpiQlat {
    static constexpr bool PERM = true;
    h16* qlat;
    DEVI void operator()(const Acc& acc, const Unit& u, int wr, int wc, int fr, int fq) const {
#pragma unroll
        EPI_ROWS { const int row = u.pm * BM + ai * HALF + wr * 64 + m * 16 + fr;
#pragma unroll
            for (int bj = 0; bj < 2; ++bj) { const int c = bj * HALF + wc * 32 + fq * 8;
                *(h8*)(qlat + (size_t)row * QLW + u.pn * 288 + c) = pack8(acc[ai][bj][m][0] * QSCALE, acc[ai][bj][m][1] * QSCALE); } }
    }
};
struct EpiRes {
    static constexpr bool PERM = false;
    h16* xh; const float* pst; const float* g; const float* b; bool ln; float* ost;
    DEVI void operator()(const Acc& acc, const Unit& u, int wr, int wc, int fr, int fq) const {
        const int rowb = u.pm * BM + wr * 64 + fr, colb = u.pn * BM + wc * 32 + fq * 4, lane = fq * 16 + fr;
        f4 gv[4], bv[4]; float mean[8], rstd[8];
#pragma unroll
        for (int k = 0; k < 4; ++k) { const int col = colb + (k >> 1) * HALF + (k & 1) * 16; gv[k] = ln ? *(const f4*)(g + col) : (f4){1.f, 1.f, 1.f, 1.f}; bv[k] = ln ? *(const f4*)(b + col) : (f4){0.f, 0.f, 0.f, 0.f}; }
#pragma unroll
        for (int r = 0; r < 8; ++r) { mean[r] = 0.f; rstd[r] = 1.f;
            if (ln) { const int row = ROW_OF(r); const float sm = pst[2 * row], sq = pst[2 * row + 1]; mean[r] = sm * (1.f / DM); rstd[r] = rsqrtf(sq * (1.f / DM) - mean[r] * mean[r] + 1e-5f); } }
        h4 cur[4], nxt[4];
#pragma unroll
        for (int k = 0; k < 4; ++k) cur[k] = *(const h4*)(xh + (size_t)ROW_OF(0) * DM + colb + (k >> 1) * HALF + (k & 1) * 16);
#pragma unroll
        for (int r = 0; r < 8; ++r) { const int row = ROW_OF(r);
            if (r < 7) {
#pragma unroll
                for (int k = 0; k < 4; ++k) nxt[k] = *(const h4*)(xh + (size_t)ROW_OF(r + 1) * DM + colb + (k >> 1) * HALF + (k & 1) * 16); }
            float s1 = 0.f, s2 = 0.f;
#pragma unroll
            for (int k = 0; k < 4; ++k) { const size_t o = (size_t)row * DM + colb + (k >> 1) * HALF + (k & 1) * 16;
                const f4 xv = (f4){(float)cur[k][0], (float)cur[k][1], (float)cur[k][2], (float)cur[k][3]};
                const f4 xr = (xv - mean[r]) * rstd[r] * gv[k] + bv[k];
                const f4 y = xr * ALPHA + acc[r >> 2][k >> 1][r & 3][k & 1];
                *(h4*)(xh + o) = pack4(y);
                s1 += (y[0] + y[1]) + (y[2] + y[3]); s2 += (y[0] * y[0] + y[1] * y[1]) + (y[2] * y[2] + y[3] * y[3]); }
            s1 += shx(s1, 16, lane); s2 += shx(s2, 16, lane); s1 += shx(s1, 32, lane); s2 += shx(s2, 32, lane);
            if (fq == 0) { atomicAdd(ost + 2 * row, s1); atomicAdd(ost + 2 * row + 1, s2); }
#pragma unroll
            for (int k = 0; k < 4; ++k) cur[k] = nxt[k]; }
    }
};
struct EpiUp {
    static constexpr bool PERM = true;
    h16* up; float* pfc; size_t sdelta; const float* st; const float* cv; const float* dv;
    DEVI void operator()(const Acc& acc, const Unit& u, int wr, int wc, int fr, int fq) const {
        const int rowb = u.pm * BM + wr * 64 + fr, colb = u.pn * BM + wc * 32 + fq * 8;
        float mean[8], rstd[8]; f4 c[2][2], d[2][2];
#pragma unroll
        for (int r = 0; r < 8; ++r) { const int row = ROW_OF(r); const float sm = st[2 * row], sq = st[2 * row + 1]; mean[r] = sm * (1.f / DM); rstd[r] = rsqrtf(sq * (1.f / DM) - mean[r] * mean[r] + 1e-5f); }
#pragma unroll
        for (int bj = 0; bj < 2; ++bj)
#pragma unroll
            for (int n = 0; n < 2; ++n) { c[bj][n] = *(const f4*)(cv + colb + bj * HALF + 4 * n); d[bj][n] = *(const f4*)(dv + colb + bj * HALF + 4 * n); }
#pragma unroll
        for (int r = 0; r < 8; ++r) { const int row = ROW_OF(r);
            bool has_st; size_t so;
            if (row < MP) { const int t = row & (SEQ - 1); has_st = t >= SEQ - 2; so = ((size_t)(row >> 11) * 2 + (t - (SEQ - 2))) * DFF2; }
            else { const int rs = row - MP, t = rs & 31; has_st = t >= DSEQ - 2; so = sdelta + ((size_t)(rs >> 5) * 2 + (t - (DSEQ - 2))) * DFF2; }
#pragma unroll
            for (int bj = 0; bj < 2; ++bj) { const int col = colb + bj * HALF;
                const f4 v0 = (acc[r >> 2][bj][r & 3][0] - c[bj][0] * mean[r]) * rstd[r] + d[bj][0], v1 = (acc[r >> 2][bj][r & 3][1] - c[bj][1] * mean[r]) * rstd[r] + d[bj][1];
                *(h8*)(up + (size_t)row * DFF2 + col) = pack8(v0, v1);
                if (has_st) { float* sp = pfc + so + col; *(f4*)sp = v0; *(f4*)(sp + 4) = v1; } } }
    }
};

template <int MODE>
DEVI void transpose_item(const float* W, int ldw, int nblk, h16* WT, int ldd, LAS float* scr, int item, int lane, const float* gs = nullptr, const float* bs = nullptr, float* csum = nullptr, float* dsum = nullptr) {
    const int kb = item / nblk, nb = item % nblk, k0 = 64 * kb, n0 = 32 * nb;
    int nsrc = n0 + (lane & 31);
    if (MODE == 1) { const int n = nsrc; if (n < 512) nsrc = (n >> 6) * 96 + (n & 63); else if (n < 640) nsrc = ((n - 512) >> 4) * 96 + 64 + ((n - 512) & 15); else nsrc = ((n - 640) >> 4) * 96 + 80 + ((n - 640) & 15); }
    float cs = 0.f, ds = 0.f;
#pragma unroll 8
    for (int i = 0; i < 32; ++i) { const int kk = 2 * i + (lane >> 5); float w = W[(size_t)(k0 + kk) * ldw + nsrc]; if (gs) { ds += bs[k0 + kk] * w; w *= gs[k0 + kk]; cs += w; } scr[kk * 33 + (lane & 31)] = w; }
    if (gs) { atomicAdd(csum + nsrc, cs); atomicAdd(dsum + nsrc, ds); }
    __builtin_amdgcn_fence(__ATOMIC_RELEASE, "wavefront"); asm volatile("s_waitcnt lgkmcnt(0)" ::: "memory");
    const int c = lane & 7;
#pragma unroll
    for (int j = 0; j < 4; ++j) { const int n = (lane >> 3) + 8 * j; const LAS float* s = scr + (8 * c) * 33 + n;
        h8 o; o[0] = (h16)s[0 * 33]; o[1] = (h16)s[1 * 33]; o[2] = (h16)s[2 * 33]; o[3] = (h16)s[3 * 33]; o[4] = (h16)s[4 * 33]; o[5] = (h16)s[5 * 33]; o[6] = (h16)s[6 * 33]; o[7] = (h16)s[7 * 33];
        *(h8*)(WT + (size_t)(n0 + n) * ldd + k0 + 8 * c) = o; }
    asm volatile("s_waitcnt lgkmcnt(0)" ::: "memory");
}

template <int NKS, int NCT, int NQS, int KSTR>
DEVI void attn_qk(LAS unsigned char* kbase, const h8 (&qf)[NQS][NKS], f4 (&o)[NQS][NCT], float (&mrow)[NQS], float (&lrow)[NQS], h8 (&pf)[NQS][2], const int nkt, const int lane) {
    const int fr = lane & 15, g = lane >> 4;
    f4 s[NQS][4];
#pragma unroll
    for (int qs = 0; qs < NQS; ++qs)
#pragma unroll
        for (int kt = 0; kt < 4; ++kt) s[qs][kt] = (f4){-1e30f, -1e30f, -1e30f, -1e30f};
#pragma unroll
    for (int kt = 0; kt < 4; ++kt) if (kt < nkt) {
#pragma unroll
        for (int qs = 0; qs < NQS; ++qs) s[qs][kt] = (f4){0.f, 0.f, 0.f, 0.f};
#pragma unroll
        for (int ks = 0; ks < NKS; ++ks) { const h8 kf = *(const LAS h8*)(kbase + (kt * 16 + fr) * KSTR + ks * 64 + g * 16);
#pragma unroll
            for (int qs = 0; qs < NQS; ++qs) s[qs][kt] = __builtin_amdgcn_mfma_f32_16x16x32_f16(kf, qf[qs][ks], s[qs][kt], 0, 0, 0); } }
    __builtin_amdgcn_sched_barrier(0);
#pragma unroll
    for (int qs = 0; qs < NQS; ++qs) {
        float mx = -1e30f;
#pragma unroll
        for (int kt = 0; kt < 4; ++kt)
#pragma unroll
            for (int e = 0; e < 4; ++e) mx = fmaxf(mx, s[qs][kt][e]);
        mx = fmaxf(mx, shx(mx, 16, lane)); mx = fmaxf(mx, shx(mx, 32, lane));
        const float mnew = fmaxf(mrow[qs], mx), alpha = __builtin_amdgcn_exp2f(mrow[qs] - mnew); mrow[qs] = mnew;
        float ps = 0.f;
#pragma unroll
        for (int kt = 0; kt < 4; ++kt)
#pragma unroll
            for (int e = 0; e < 4; ++e) { const float p = __builtin_amdgcn_exp2f(s[qs][kt][e] - mnew); s[qs][kt][e] = p; ps += p; }
        lrow[qs] = lrow[qs] * alpha + ps;
#pragma unroll
        for (int ct = 0; ct < NCT; ++ct) o[qs][ct] *= alpha;
#pragma unroll
        for (int k2 = 0; k2 < 2; ++k2) pf[qs][k2] = pack8(s[qs][2 * k2], s[qs][2 * k2 + 1]);
    }
    __builtin_amdgcn_sched_barrier(0);
}
template <int NCT, int NQS, int VSTR>
DEVI void attn_pv(LAS unsigned char* vbase, f4 (&o)[NQS][NCT], const h8 (&pf)[NQS][2], const int nkt, const int lane) {
    const int fr = lane & 15, g = lane >> 4, q_ = fr >> 2, p_ = fr & 3;
#pragma unroll
    for (int k2 = 0; k2 < 2; ++k2) if (2 * k2 < nkt) {
#pragma unroll
        for (int ct = 0; ct < NCT; ++ct) {
            const h4 lo = trrd(vbase + (32 * k2 + 4 * g + q_) * VSTR + (16 * ct + 4 * p_) * 2);
            const h4 hi = trrd(vbase + (32 * k2 + 16 + 4 * g + q_) * VSTR + (16 * ct + 4 * p_) * 2);
            const h8 vf = cat44(lo, hi);
#pragma unroll
            for (int qs = 0; qs < NQS; ++qs) o[qs][ct] = __builtin_amdgcn_mfma_f32_16x16x32_f16(vf, pf[qs][k2], o[qs][ct], 0, 0, 0); } }
    __builtin_amdgcn_sched_barrier(0);
}
template <int NKS, int NCT, int NQS, int KSTR, int VSTR>
DEVI void attn_tile(LAS unsigned char* kbase, LAS unsigned char* vbase, const h8 (&qf)[NQS][NKS], f4 (&o)[NQS][NCT], float (&mrow)[NQS], float (&lrow)[NQS], const int nkt, const int lane) {
    h8 pf[NQS][2];
    attn_qk<NKS, NCT, NQS, KSTR>(kbase, qf, o, mrow, lrow, pf, nkt, lane);
    attn_pv<NCT, NQS, VSTR>(vbase, o, pf, nkt, lane);
}


#define XB_TMO      128
#define XB_XCNT(j)  (256  + 64 * (j))
#define XB_XSUB(j)  (1280 + 64 * (j))
#define XB_XGEN(j)  (2304 + 64 * (j))
#define XB_TOP      3328
#define XB_TOPGEN   3392
#define XCD_BAR_WORDS 3456
#define XB_SPIN_CAP (1u << 18)
DEVI unsigned xb_ld(unsigned* p)              { return __hip_atomic_load(p, __ATOMIC_RELAXED, __HIP_MEMORY_SCOPE_AGENT); }
DEVI unsigned xb_add(unsigned* p, unsigned v) { return __hip_atomic_fetch_add(p, v, __ATOMIC_RELAXED, __HIP_MEMORY_SCOPE_AGENT); }
DEVI unsigned xb_xcc_id() { return (unsigned)__builtin_amdgcn_s_getreg((3 << 11) | 20) & 0xFu; }
#define XB_SPIN(cond, bar) do { unsigned _sp = 0; while (cond) { __builtin_amdgcn_s_sleep(1); \
    if ((++_sp & 255u) == 0u) { if (xb_ld(&(bar)[XB_TMO])) break; if (_sp > XB_SPIN_CAP) { atomicAdd(&(bar)[XB_TMO], 1u); break; } } } } while (0)
DEVI void xb_complete(unsigned* bar, unsigned x, unsigned& nloc, unsigned& nx, unsigned G) {
    unsigned sum, cnt, mine, sp = 0u;
    for (;;) {
        sum = 0u; cnt = 0u; mine = 0u;
#pragma unroll
        for (unsigned j = 0; j < 16; ++j) { const unsigned c = xb_ld(&bar[XB_XCNT(j)]); sum += c; cnt += (c > 0u) ? 1u : 0u; mine = (j == x) ? c : mine; }
        if (sum == G) break;
        __builtin_amdgcn_s_sleep(1);
        if ((++sp & 255u) == 0u) { if (xb_ld(&bar[XB_TMO])) break; if (sp > XB_SPIN_CAP) { atomicAdd(&bar[XB_TMO], 1u); break; } }
    }
    nloc = mine > 0u ? mine : 1u; nx = cnt > 0u ? cnt : 1u;
}
DEVI void xbar(unsigned* bar, volatile LAS unsigned* st, int tid, unsigned G) {
    asm volatile("s_waitcnt vmcnt(0)" ::: "memory");
    __syncthreads();
    if (tid == 0) {
        const unsigned x = xb_xcc_id();
        __builtin_amdgcn_s_waitcnt(0);
        unsigned nloc = st[0], nx = st[1];
        if (nloc == 0u) { xb_complete(bar, x, nloc, nx, G); st[0] = nloc; st[1] = nx; }
        const unsigned old = xb_add(&bar[XB_XSUB(x)], 1u);
        const unsigned gen = old / nloc;
        if (old + 1u == (gen + 1u) * nloc) {
            __builtin_amdgcn_fence(__ATOMIC_RELEASE, "agent");
            asm volatile("s_waitcnt vmcnt(0)" ::: "memory");
            const unsigned og = xb_add(&bar[XB_TOP], 1u);
            const unsigned tg = og / nx;
            if (og + 1u == (tg + 1u) * nx) xb_add(&bar[XB_TOPGEN], 1u);
            else XB_SPIN(xb_ld(&bar[XB_TOPGEN]) == tg, bar);
            __builtin_amdgcn_fence(__ATOMIC_ACQUIRE, "agent");
            xb_add(&bar[XB_XGEN(x)], 1u);
            asm volatile("s_waitcnt vmcnt(0)" ::: "memory");
        } else {
            XB_SPIN(xb_ld(&bar[XB_XGEN(x)]) == gen, bar);
            __builtin_amdgcn_fence(__ATOMIC_ACQUIRE, "agent");
            asm volatile("s_waitcnt vmcnt(0)" ::: "memory");
        }
    }
    __syncthreads();
}
#ifndef PHM
#define PHM 0xFFFFFFFFu
#endif
#ifndef DBL
#define DBL 0u
#endif
#define NREP(k) (((DBL >> (k)) & 1u) ? 2 : 1)
__global__ void __launch_bounds__(512, 2) trunk_fwd(Params p) {
    extern __shared__ __attribute__((aligned(16))) unsigned char shm_raw[];
    LAS unsigned char* lds = (LAS unsigned char*)shm_raw;
    __shared__ uint4 s_ctl;
#define s_item (*(LAS int*)&s_ctl)
    cg::grid_group grid = cg::this_grid();
    const int wave_s = __builtin_amdgcn_readfirstlane((int)threadIdx.x >> 6);
    if (threadIdx.x == 0) { s_ctl = make_uint4(0u, 0u, 0u, 0u); (void)xb_add((unsigned*)(p.ws + W_BAR) + XB_XCNT(xb_xcc_id()), 1u); }
    __syncthreads();
#define GSYNC() do { const __attribute__((address_space(4))) Params* kq = (const __attribute__((address_space(4))) Params*)__builtin_amdgcn_kernarg_segment_ptr(); asm volatile("" : "+s"(kq)); \
        unsigned Gq = gridDim.x; asm volatile("" : "+s"(Gq)); xbar((unsigned*)(kq->ws + W_BAR), (volatile LAS unsigned*)&s_ctl + 1, wave_s * 64 + opaque_lane(), Gq); } while (0)
#define PH_BEGIN \
    int tid = wave_s * 64 + opaque_lane(); asm volatile("" : "+v"(tid)); \
    int bid = blockIdx.x, G = gridDim.x, lq = l; asm volatile("" : "+s"(bid), "+s"(G), "+s"(lq)); \
    const int lane = tid & 63, wave = __builtin_amdgcn_readfirstlane(tid >> 6); \
    const int gw = bid * 8 + wave, NGW = G * 8; const size_t gtid = (size_t)bid * 512 + tid, NGT = (size_t)G * 512; \
    const __attribute__((address_space(4))) Params* kp = (const __attribute__((address_space(4))) Params*)__builtin_amdgcn_kernarg_segment_ptr(); asm volatile("" : "+s"(kp)); \
    unsigned char* ws = kp->ws; float* out = kp->out; \
    (void)lane; (void)wave; (void)gw; (void)NGW; (void)gtid; (void)NGT; (void)out; (void)lq;
#define WSP(T, off) ((T*)(ws + (off)))
    for (int rep = 0; rep < NREP(0); ++rep) if (PHM & 1u) {
        int tid = wave_s * 64 + opaque_lane(); asm volatile("" : "+v"(tid));
        const int bid = blockIdx.x, G = gridDim.x, lane = tid & 63, wave = __builtin_amdgcn_readfirstlane(tid >> 6);
        const int gw = bid * 8 + wave, NGW = G * 8; const size_t gtid = (size_t)bid * 512 + tid, NGT = (size_t)G * 512;
        unsigned char* ws = p.ws;
        h16* xh = WSP(h16, W_XH); float* ropec = WSP(float, W_ROPE); float* ropes = ropec + NPOS * 16;
        for (size_t i = gtid; i < (size_t)MT * DM / 8; i += NGT) { const size_t e = i * 8; const float* src = e < (size_t)MP * DM ? p.in[0] + e : p.in[1] + (e - (size_t)MP * DM);
            *(h8*)(xh + e) = pack8(*(const f4*)src, *(const f4*)(src + 4)); }
        for (size_t i = gtid; i < (size_t)NPOS * 16; i += NGT) { const int pi = (int)(i >> 4), fi = (int)(i & 15); const double pos = pi < SEQ ? (double)pi : (double)(PAST + pi - SEQ);
            const double ang = pos * exp(-(double)fi / 16.0 * 9.210340371976184); ropec[i] = (float)cos(ang); ropes[i] = (float)sin(ang); }
        for (size_t i = gtid; i < (size_t)DEPTH * 256; i += NGT) WSP(float, W_SP)[i] = log1pf(expf(-p.in[26][i]));
        LAS float* scr = (LAS float*)(lds + wave * 8448);
        for (int l = 0; l < DEPTH; ++l) {
            h16* wt_in = WSP(h16, W_WIN + l * SZ_WIN); h16* wt_uq = WSP(h16, W_WUQ + l * SZ_WUQ); h16* wt_kv = WSP(h16, W_WKV + l * SZ_WKV);
            h16* wt_o = WSP(h16, W_WO + l * SZ_WO); h16* wt_os = WSP(h16, W_WOS + l * SZ_WOS); h16* wt_up = WSP(h16, W_WUP + l * SZ_WUP); h16* wt_dn = WSP(h16, W_WDN + l * SZ_WDN);
            h16* wt_ql = WSP(h16, W_WQL + l * SZ_WQL); h16* wt_g = WSP(h16, W_WG + l * SZ_WG);
            const float* w_in = p.in[11] + (size_t)l * DM * DIN; const float* w_o = p.in[12] + (size_t)l * DM * DM; const float* w_uq = p.in[16] + (size_t)l * 384 * 768;
            const float* w_uk = p.in[18] + (size_t)l * 256 * 512; const float* w_uv = p.in[19] + (size_t)l * 256 * 512; const float* w_up = p.in[27] + (size_t)l * DM * DFF2; const float* w_dn = p.in[30] + (size_t)l * DFF * DM;
            const float* w_r = p.in[22] + (size_t)l * 4 * 64 * 64; const float* w_i = p.in[24] + (size_t)l * 4 * 64 * 64;
            for (int it = gw; it < 16 * 53; it += NGW) transpose_item<0>(w_in, DIN, 53, wt_in, 1024, scr, it, lane, l > 0 ? p.in[9] + (l - 1) * DM : nullptr, l > 0 ? p.in[10] + (l - 1) * DM : nullptr, WSP(float, W_CD + l * SZ_CD), WSP(float, W_CD + l * SZ_CD) + ZW);
            for (int it = gw; it < 6 * 24; it += NGW) transpose_item<1>(w_uq, 768, 24, wt_uq, 384, scr, it, lane);
            for (int it = gw; it < 4 * 16; it += NGW) transpose_item<0>(w_uk, 512, 16, wt_kv, 256, scr, it, lane);
            for (int it = gw; it < 4 * 16; it += NGW) transpose_item<0>(w_uv, 512, 16, wt_kv + 512 * 256, 256, scr, it, lane);
            for (int it = gw; it < 16 * 32; it += NGW) transpose_item<0>(w_o, 1024, 32, wt_o, 1024, scr, it, lane);
            for (int it = gw; it < 16 * 176; it += NGW) transpose_item<0>(w_up, DFF2, 176, wt_up, 1024, scr, it, lane, p.in[7] + l * DM, p.in[8] + l * DM, WSP(float, W_CD + l * SZ_CD) + 2 * ZW, WSP(float, W_CD + l * SZ_CD) + 2 * ZW + DFF2);
            for (int it = gw; it < 44 * 32; it += NGW) transpose_item<0>(w_dn, 1024, 32, wt_dn, DFF, scr, it, lane);
            for (size_t i = gtid; i < (size_t)(ZW - DIN) * 1024 / 8; i += NGT) *(h8*)(wt_in + (size_t)DIN * 1024 + i * 8) = (h8){0, 0, 0, 0, 0, 0, 0, 0};
            for (size_t i = gtid; i < (size_t)512 * 256; i += NGT) { const int n = (int)(i >> 8), k = (int)(i & 255); const int pn = n >> 8, jj = n & 127, isI = (n >> 7) & 1, ch = pn * 128 + jj;
                float v = 0.f; if ((k >> 6) == (ch >> 6)) v = (isI ? w_i : w_r)[((ch >> 6) * 64 + (k & 63)) * 64 + (ch & 63)];
                wt_g[i] = (h16)v; }
            for (size_t i = gtid; i < (size_t)2048 * 384; i += NGT) { const int n = (int)(i / 384), k = (int)(i % 384), hh = n >> 8, c = n & 255;
                const float* a = w_uq + (size_t)k * 768 + hh * 96; const float* b = w_uk + (size_t)c * 512 + hh * 64; float s = 0.f;
#pragma unroll 8
                for (int d = 0; d < 64; ++d) s += a[d] * b[d];
                wt_ql[i] = (h16)s; }
            for (size_t i = gtid; i < (size_t)8 * 64 * 256; i += NGT) { const int c = (int)(i & 255), hd = (int)(i >> 8); wt_os[i] = (h16)w_uv[(size_t)c * 512 + hd]; }
        }
    }
    grid.sync();

    for (int l = 0; l < DEPTH; ++l) {
        for (int rep = 0; rep < NREP(1); ++rep) if (PHM & (1u << 1)) { PH_BEGIN
          Gemm g{WSP(h16, W_XH), WSP(h16, W_WIN + lq * SZ_WIN), MT, ZW, 1024, 1024, 1024}; StaticOrder S; S.init(MT, ZW, G, bid); const int lp = lq > 0 ? lq - 1 : 0; EpiZ E{WSP(h16, W_Z), out + O_SV + (size_t)lq * MS * 256, WSP(float, W_STATS + (size_t)(lp * 2 + 1) * SZ_STATS), WSP(float, W_CD + lq * SZ_CD), WSP(float, W_CD + lq * SZ_CD) + ZW, lq > 0}; gemm_phase(lds, g, S, E, tid); }
        GSYNC();

        for (int rep = 0; rep < NREP(2); ++rep) if (PHM & (1u << 2)) { PH_BEGIN
            const float* qn_g = kp->in[15] + lq * 384; const float* kvn_g = kp->in[17] + lq * 256;
            const float* cw = kp->in[20] + (size_t)lq * 4 * 256; const float* cb = kp->in[21] + lq * 256; const float* stc = kp->in[5] + (size_t)lq * DBATCH * 3 * 256;
            const h16* z = WSP(h16, W_Z); h16* cqn = WSP(h16, W_CQN); h16* ckvn = WSP(h16, W_CKVN); h16* knew = WSP(h16, W_KNEW); h16* kb = WSP(h16, W_K); h16* xc = WSP(h16, W_XC);
            const float* ropec = WSP(float, W_ROPE); const float* ropes = ropec + NPOS * 16;
            for (int row = gw; row < MT; row += NGW) {
                const h16* zr = z + (size_t)row * ZW; const bool samp = row >= MP; const int rs = row - MP;
                const int t = samp ? (rs & 31) : (row & (SEQ - 1)), bb = samp ? (rs >> 5) : (row >> 11);
                { float v[6]; float ss = 0.f;
#pragma unroll
                    for (int i = 0; i < 3; ++i) { const h2 x = *(const h2*)(zr + 512 + 2 * lane + 128 * i); v[2 * i] = (float)x[0]; v[2 * i + 1] = (float)x[1]; ss += v[2 * i] * v[2 * i] + v[2 * i + 1] * v[2 * i + 1]; }
                    const float rr = rsqrtf(wave_sum(ss, lane) * (1.f / 384.f) + 1e-6f);
#pragma unroll
                    for (int i = 0; i < 3; ++i) { const int c = 2 * lane + 128 * i; h2 o; o[0] = (h16)(v[2 * i] * rr * qn_g[c]); o[1] = (h16)(v[2 * i + 1] * rr * qn_g[c + 1]); *(h2*)(cqn + (size_t)row * 384 + c) = o; } }
                { const h4 x = *(const h4*)(zr + 896 + 4 * lane); f4 v; float ss = 0.f;
#pragma unroll
                    for (int e = 0; e < 4; ++e) { v[e] = (float)x[e]; ss += v[e] * v[e]; }
                    const float rr = rsqrtf(wave_sum(ss, lane) * (1.f / 256.f) + 1e-6f); const f4 gg = *(const f4*)(kvn_g + 4 * lane); v = v * rr * gg;
                    if (!samp) { *(f4*)(out + O_PLAT + ((size_t)lq * MP + row) * 256 + 4 * lane) = v; *(h4*)(ckvn + (size_t)row * 256 + 4 * lane) = pack4(v); }
                    else { *(f4*)(out + O_SLAT + ((size_t)lq * MS + rs) * 256 + 4 * lane) = v; *(h4*)(knew + (size_t)rs * KNW + 4 * lane) = pack4(v); } }
                if (lane < 16) { const int pidx = samp ? SEQ + t : t; const float c = ropec[pidx * 16 + lane], s = ropes[pidx * 16 + lane];
                    const float x1 = (float)zr[1152 + lane], x2 = (float)zr[1168 + lane], o1 = x1 * c - x2 * s, o2 = x1 * s + x2 * c;
                    if (!samp) { float* o = out + O_PKR + ((size_t)lq * MP + row) * 32; o[lane] = o1; o[16 + lane] = o2;
                        h16* kr = kb + (size_t)row * KW + 64;
#pragma unroll
                        for (int hh = 0; hh < 8; ++hh) { kr[hh * 96 + lane] = (h16)o1; kr[hh * 96 + 16 + lane] = (h16)o2; } }
                    else { float* o = out + O_SKR + ((size_t)lq * MS + rs) * 32; o[lane] = o1; o[16 + lane] = o2; knew[(size_t)rs * KNW + 256 + lane] = (h16)o1; knew[(size_t)rs * KNW + 272 + lane] = (h16)o2; } }
                { const int c = 4 * lane; f4 accv = *(const f4*)(cb + c);
#pragma unroll
                    for (int j = 0; j < 4; ++j) { const int tau = t - 3 + j; f4 xv;
                        if (tau >= 0) { const h4 x = *(const h4*)(zr - (ptrdiff_t)(3 - j) * ZW + 1184 + c); xv = (f4){(float)x[0], (float)x[1], (float)x[2], (float)x[3]}; }
                        else if (samp) xv = *(const f4*)(stc + ((size_t)bb * 3 + (3 + tau)) * 256 + c);
                        else xv = (f4){0.f, 0.f, 0.f, 0.f};
                        accv += xv * *(const f4*)(cw + j * 256 + c);
                        if (j == 3) { const int T = samp ? DSEQ : SEQ; if (t >= T - 3) { float* o = samp ? out + O_SLC + (((size_t)lq * DBATCH + bb) * 3 + (t - (T - 3))) * 256 : out + O_PLC + (((size_t)lq * NB + bb) * 3 + (t - (T - 3))) * 256; *(f4*)(o + c) = xv; } } }
                    *(h4*)(xc + (size_t)row * 256 + c) = pack4(accv); }
            }
        }
        GSYNC();

        for (int rep = 0; rep < NREP(3); ++rep) if (PHM & (1u << 3)) { PH_BEGIN
          Gemm g{WSP(h16, W_CQN), WSP(h16, W_WUQ + lq * SZ_WUQ), MT, 768, 384, 384, 384}; StaticOrder S; S.init(MT, 768, G, bid);
          EpiQ E{WSP(h16, W_Q), WSP(h16, W_QLAT), WSP(float, W_ROPE), WSP(float, W_ROPE) + NPOS * 16}; gemm_phase(lds, g, S, E, tid); }
        for (int rep = 0; rep < NREP(4); ++rep) if (PHM & (1u << 4)) { PH_BEGIN
          Gemm g{WSP(h16, W_CKVN), WSP(h16, W_WKV + lq * SZ_WKV), MP, 1024, 256, 256, 256}; StaticOrder S; S.init(MP, 1024, G, (bid + G - (396 % G)) % G); EpiKV E{WSP(h16, W_K), WSP(h16, W_V)}; gemm_phase(lds, g, S, E, tid); }
        for (int rep = 0; rep < NREP(5); ++rep) if (PHM & (1u << 5)) { PH_BEGIN
          Gemm g{WSP(h16, W_XC), WSP(h16, W_WG + lq * SZ_WG), MT, 512, 256, 256, 256}; StaticOrder S; S.init(MT, 512, G, (bid + G - (908 % G)) % G);
          EpiGate E{WSP(h16, W_XC), WSP(float, W_A), WSP(float, W_B), kp->in[23] + lq * 256, kp->in[25] + lq * 256, WSP(float, W_SP) + lq * 256}; gemm_phase(lds, g, S, E, tid); }
        for (int rep = 0; rep < NREP(6); ++rep) if (PHM & (1u << 6)) { PH_BEGIN
          Gemm g{WSP(h16, W_CQN) + (size_t)MP * 384, WSP(h16, W_WQL + lq * SZ_WQL), MS, 2048, 384, 384, 384}; StaticOrder S; S.init(MS, 2048, G, (bid + G - (1172 % G)) % G); EpiQlat E{WSP(h16, W_QLAT)}; gemm_phase(lds, g, S, E, tid); }
        for (int rep = 0; rep < NREP(7); ++rep) if (PHM & (1u << 7)) { PH_BEGIN
            const float* gw_s = kp->in[13] + (size_t)lq * 4 * 128 * 128; const float* gb_s = kp->in[14] + (size_t)lq * 4 * 128;
            const h16* z = WSP(h16, W_Z); h16* cat = WSP(h16, W_CAT); h16* cats = WSP(h16, W_CATS);
            const int fr = lane & 15, g4 = lane >> 4, q_ = fr >> 2, p_ = fr & 3;
            for (int item = (bid + G - (1204 % G)) % G; item < 1024 + 128; item += G) {
                const bool samp = item >= 1024; const int head = item & 3; const int ci = samp ? (item - 1024) >> 2 : item >> 2;
                const int R0 = samp ? MP + ci * 32 : ci * 128, L = samp ? 32 : 128;
                __syncthreads();
                for (int id = tid; id < L * 8; id += 512) { const int j = id >> 3, part = id & 7; *(LAS h8*)(lds + j * 144 + part * 16) = *(const h8*)(z + (size_t)(R0 + j) * ZW + 256 + head * 64 + part * 8); }
                __syncthreads();
                const int i0 = 16 * wave;
                if (i0 < L) {
                    f4 sacc[4];
#pragma unroll
                    for (int ct = 0; ct < 4; ++ct) sacc[ct] = (f4){0.f, 0.f, 0.f, 0.f};
                    const int i = i0 + fr;
#pragma unroll
                    for (int ks = 0; ks < 4; ++ks) if (32 * ks <= i0 + 15 && 32 * ks < L) {
                        const int j0 = 32 * ks + 8 * g4; const float* wp = gw_s + ((size_t)head * 128 + i) * 128 + j0; const f4 w0 = *(const f4*)wp, w1 = *(const f4*)(wp + 4);
                        h8 wf;
#pragma unroll
                        for (int e = 0; e < 4; ++e) { wf[e] = (h16)((j0 + e <= i) ? w0[e] : 0.f); wf[4 + e] = (h16)((j0 + 4 + e <= i) ? w1[e] : 0.f); }
#pragma unroll
                        for (int ct = 0; ct < 4; ++ct) { const h4 lo = trrd(lds + (32 * ks + 8 * g4 + q_) * 144 + (16 * ct + 4 * p_) * 2), hi = trrd(lds + (32 * ks + 8 * g4 + 4 + q_) * 144 + (16 * ct + 4 * p_) * 2);
                            sacc[ct] = __builtin_amdgcn_mfma_f32_16x16x32_f16(wf, cat44(lo, hi), sacc[ct], 0, 0, 0); } }
#pragma unroll
                    for (int jx = 0; jx < 4; ++jx) { const int ii = i0 + 4 * g4 + jx; const float bs = gb_s[head * 128 + ii]; const size_t r = (size_t)R0 + ii;
#pragma unroll
                        for (int ct = 0; ct < 4; ++ct) { const int d = head * 64 + 16 * ct + fr; const float uval = (float)z[r * ZW + d]; const h16 o = (h16)(uval * (sacc[ct][jx] + bs));
                            cat[r * 1024 + d] = o; } }
                }
            }
            __syncthreads();
        }
        GSYNC();

        for (int rep = 0; rep < NREP(8); ++rep) if (PHM & (1u << 8)) { PH_BEGIN
            unsigned* counter = WSP(unsigned, W_CTR) + lq * 16 + rep * 8;
            const int fr = lane & 15, g4 = lane >> 4;
            constexpr int N_SA = 256, N_PA = 1024, N_PS = 128, N_SS = 16, N_ALL = N_SA + N_PA + N_PS + N_SS;
            for (;;) {
                __syncthreads();
                if (tid == 0) s_item = (int)atomicAdd(counter, 1u);
                __syncthreads();
                const int qi = s_item;
                if (qi >= N_ALL) break;
                int tix = tid; asm volatile("" : "+v"(tix));
                const int item = qi < N_PS + N_SS ? qi + N_SA + N_PA : qi - (N_PS + N_SS);
                if (item < N_SA) {
                    constexpr int KS = 592;
                    const float* clat = kp->in[2] + (size_t)lq * DBATCH * PAST * 256; const float* ckr = kp->in[3] + (size_t)lq * DBATCH * PAST * 32;
                    const h16* qlat = WSP(h16, W_QLAT); const h16* knew = WSP(h16, W_KNEW); h16* cats = WSP(h16, W_CATS);
                    const int b = item >> 3, hg = (item >> 2) & 1, sp = item & 3, head = 4 * hg + (wave >> 1), tq = 16 * (wave & 1) + fr, t0 = sp * 16;
                    h8 qf[1][9];
#pragma unroll
                    for (int ks = 0; ks < 9; ++ks) qf[0][ks] = *(const h8*)(qlat + (size_t)(b * 32 + tq) * QLW + head * 288 + 32 * ks + 8 * g4);
                    f4 o[1][16]; float mrow[1] = {-1e30f}, lrow[1] = {0.f};
#pragma unroll
                    for (int ct = 0; ct < 16; ++ct) o[0][ct] = (f4){0.f, 0.f, 0.f, 0.f};
                    const float* lb = clat + (size_t)b * PAST * 256 + (size_t)(t0 * 64 + (tix >> 6)) * 256 + (tix & 63) * 4; const float* rb = ckr + (size_t)b * PAST * 32 + (size_t)(t0 * 64 + (tix >> 3)) * 32 + (tix & 7) * 4;
                    const int wl = (tix >> 6) * KS + (tix & 63) * 8, wr_ = (tix >> 3) * KS + 512 + (tix & 7) * 8;
                    f4 pl[4]; f4 pr;
#pragma unroll
                    for (int hf = 0; hf < 2; ++hf) {
#pragma unroll
                        for (int i = 0; i < 4; ++i) pl[i] = *(const f4*)(lb + (size_t)(hf * 4 + i) * 8 * 256);
#pragma unroll
                        for (int i = 0; i < 4; ++i) *(LAS h4*)(lds + wl + (hf * 4 + i) * 8 * KS) = pack4(pl[i]); }
                    pr = *(const f4*)rb;
                    *(LAS h4*)(lds + wr_) = pack4(pr);
                    __syncthreads();
                    for (int t = 0; t < 16; ++t) {
                        LAS unsigned char* cur = lds + (t & 1) * (64 * KS); LAS unsigned char* nxt = lds + ((t + 1) & 1) * (64 * KS);
                        const bool more = t + 1 < 16;
                        if (more) {
#pragma unroll
                            for (int i = 0; i < 4; ++i) pl[i] = *(const f4*)(lb + ((size_t)(t + 1) * 64 + i * 8) * 256);
                            pr = *(const f4*)(rb + (size_t)(t + 1) * 64 * 32);
                        }
                        h8 pf[1][2];
                        attn_qk<9, 16, 1, KS>(cur, qf, o, mrow, lrow, pf, 4, lane);
                        if (more) {
#pragma unroll
                            for (int i = 0; i < 4; ++i) *(LAS h4*)(nxt + wl + i * 8 * KS) = pack4(pl[i]);
                            *(LAS h4*)(nxt + wr_) = pack4(pr);
#pragma unroll
                            for (int i = 0; i < 4; ++i) pl[i] = *(const f4*)(lb + ((size_t)(t + 1) * 64 + (4 + i) * 8) * 256);
                        }
                        attn_pv<16, 1, KS>(cur, o, pf, 4, lane);
                        if (more) {
#pragma unroll
                            for (int i = 0; i < 4; ++i) *(LAS h4*)(nxt + wl + (4 + i) * 8 * KS) = pack4(pl[i]);
                        } else if (sp == 3) {
                            for (int id = tix; id < 32 * 36; id += 512) { const int key = id / 36, part = id % 36; *(LAS h8*)(nxt + key * KS + part * 16) = *(const h8*)(knew + (size_t)(b * 32 + key) * KNW + part * 8); }
                        }
                        __syncthreads();
                    }
                    if (sp == 3) attn_tile<9, 16, 1, KS, KS>(lds, lds, qf, o, mrow, lrow, 2, lane);
                    { unsigned char* pw = ws + W_PART + ((size_t)item * 8 + wave) * SZ_PARTW;
#pragma unroll
                      for (int ct = 0; ct < 16; ++ct) *(f4*)(pw + ct * 1024 + lane * 16) = o[0][ct];
                      *(float*)(pw + 16384 + lane * 4) = mrow[0]; *(float*)(pw + 16640 + lane * 4) = lrow[0]; }
                    asm volatile("s_waitcnt vmcnt(0)" ::: "memory");
                    __syncthreads();
                    if (tix == 0) { __builtin_amdgcn_fence(__ATOMIC_RELEASE, "agent"); asm volatile("s_waitcnt vmcnt(0)" ::: "memory");
                        const unsigned old = xb_add(WSP(unsigned, W_CTR) + 256 + lq * 64 + rep * 512 + (item >> 2), 1u);
                        if (old == 3u) { __builtin_amdgcn_fence(__ATOMIC_ACQUIRE, "agent"); asm volatile("s_waitcnt vmcnt(0)" ::: "memory"); }
                        *((LAS int*)&s_ctl + 3) = (int)old; }
                    __syncthreads();
                    if (*((LAS int*)&s_ctl + 3) == 3) {
                        const unsigned char* p0 = ws + W_PART + ((size_t)(item & ~3) * 8 + wave) * SZ_PARTW;
                        float mi[4], M = -1e30f;
#pragma unroll
                        for (int i = 0; i < 4; ++i) { mi[i] = *(const float*)(p0 + (size_t)i * 8 * SZ_PARTW + 16384 + lane * 4); M = fmaxf(M, mi[i]); }
                        float L = 0.f;
#pragma unroll
                        for (int i = 0; i < 4; ++i) { mi[i] = __builtin_amdgcn_exp2f(mi[i] - M); L += mi[i] * *(const float*)(p0 + (size_t)i * 8 * SZ_PARTW + 16640 + lane * 4); }
                        L += shx(L, 16, lane); L += shx(L, 32, lane); const float inv = 1.f / L;
                        h8 bf[8];
#pragma unroll
                        for (int ks = 0; ks < 8; ++ks) { f4 u0 = (f4){0.f, 0.f, 0.f, 0.f}, u1 = u0;
#pragma unroll
                            for (int i = 0; i < 4; ++i) { u0 += *(const f4*)(p0 + (size_t)i * 8 * SZ_PARTW + (2 * ks) * 1024 + lane * 16) * mi[i]; u1 += *(const f4*)(p0 + (size_t)i * 8 * SZ_PARTW + (2 * ks + 1) * 1024 + lane * 16) * mi[i]; }
                            bf[ks] = pack8(u0 * inv, u1 * inv); }
                        const h16* wuvt = WSP(h16, W_WOS + lq * SZ_WOS) + (size_t)head * 64 * 256;
                        h16* dst = cats + (size_t)(b * 32 + tq) * 1024 + 256 + head * 64 + 4 * g4;
#pragma unroll
                        for (int dt = 0; dt < 4; ++dt) { f4 od = (f4){0.f, 0.f, 0.f, 0.f};
#pragma unroll
                            for (int ks = 0; ks < 8; ++ks) { const h16* wp = wuvt + (size_t)(16 * dt + fr) * 256 + 32 * ks + 4 * g4;
                                od = __builtin_amdgcn_mfma_f32_16x16x32_f16(cat44(*(const h4*)wp, *(const h4*)(wp + 16)), bf[ks], od, 0, 0, 0); }
                            *(h4*)(dst + 16 * dt) = pack4(od); }
                    }
                } else if (item < N_SA + N_PA) {
                    constexpr int KS = 208, VS = 144, KBUF = 64 * KS, VBUF = 64 * VS;
                    const h16* qb = WSP(h16, W_Q); const h16* kb = WSP(h16, W_K); const h16* vb = WSP(h16, W_V); h16* cat = WSP(h16, W_CAT);
                    const int it = item - N_SA, qblk = 7 - (it >> 7), bh = it & 127, b = bh >> 3, head = bh & 7;
                    const int r0 = qblk * 256 + 32 * wave, ntw = (r0 >> 6) + 1, ntb = 4 * (qblk + 1);
                    h8 qf[2][3];
#pragma unroll
                    for (int qs = 0; qs < 2; ++qs)
#pragma unroll
                        for (int ks = 0; ks < 3; ++ks) qf[qs][ks] = *(const h8*)(qb + (size_t)(b * SEQ + r0 + 16 * qs + fr) * QW + head * 96 + 32 * ks + 8 * g4);
                    f4 o[2][4]; float mrow[2] = {-1e30f, -1e30f}, lrow[2] = {0.f, 0.f};
#pragma unroll
                    for (int qs = 0; qs < 2; ++qs)
#pragma unroll
                        for (int ct = 0; ct < 4; ++ct) o[qs][ct] = (f4){0.f, 0.f, 0.f, 0.f};
                    const int k0key = tix / 12, k0part = tix % 12, k1key = (tix + 512) / 12, k1part = (tix + 512) % 12, vkey = tix >> 3, vpart = tix & 7;
                    const h16* kg0 = kb + (size_t)b * SEQ * KW + head * 96 + (size_t)k0key * KW + k0part * 8; const h16* kg1 = kb + (size_t)b * SEQ * KW + head * 96 + (size_t)k1key * KW + k1part * 8;
                    const h16* vg = vb + (size_t)b * SEQ * VW + head * 64 + (size_t)vkey * VW + vpart * 8;
                    const int lk0 = k0key * KS + k0part * 16, lk1 = k1key * KS + k1part * 16, lv = 2 * KBUF + vkey * VS + vpart * 16;
                    h8 pk0, pk1 = (h8){0, 0, 0, 0, 0, 0, 0, 0}, pv;
                    pk0 = *(const h8*)kg0; if (tix < 256) pk1 = *(const h8*)kg1; pv = *(const h8*)vg;
                    *(LAS h8*)(lds + lk0) = pk0; if (tix < 256) *(LAS h8*)(lds + lk1) = pk1; *(LAS h8*)(lds + lv) = pv;
                    __syncthreads();
                    for (int t = 0; t < ntb; ++t) {
                        const int co = (t & 1), no = ((t + 1) & 1);
                        if (t + 1 < ntb) { const size_t ro = (size_t)(t + 1) * 64;
                            pk0 = *(const h8*)(kg0 + ro * KW); if (tix < 256) pk1 = *(const h8*)(kg1 + ro * KW); pv = *(const h8*)(vg + ro * VW); }
                        if (t < ntw) attn_tile<3, 4, 2, KS, VS>(lds + co * KBUF, lds + 2 * KBUF + co * VBUF, qf, o, mrow, lrow, 4, lane);
                        if (t + 1 < ntb) { *(LAS h8*)(lds + no * KBUF + lk0) = pk0; if (tix < 256) *(LAS h8*)(lds + no * KBUF + lk1) = pk1; *(LAS h8*)(lds + no * VBUF + lv) = pv; }
                        __syncthreads();
                    }
#pragma unroll
                    for (int qs = 0; qs < 2; ++qs) { float lt = lrow[qs]; lt += shx(lt, 16, lane); lt += shx(lt, 32, lane); const float inv = 1.f / lt;
                        h16* dst = cat + (size_t)(b * SEQ + r0 + 16 * qs + fr) * 1024 + 256 + head * 64 + 4 * g4;
#pragma unroll
                        for (int ct = 0; ct < 4; ++ct) *(h4*)(dst + 16 * ct) = pack4(o[qs][ct] * inv); }
                } else if (item < N_SA + N_PA + N_PS) {
                    const float* abuf = WSP(float, W_A); const float* bbuf = WSP(float, W_B); const h16* z = WSP(h16, W_Z); h16* cat = WSP(h16, W_CAT);
                    const int it = item - N_SA - N_PA, b = it >> 3, ch = (it & 7) * 32 + (lane & 31), seg = wave * 2 + (lane >> 5), tl = seg * 32 + (lane & 31);
                    const size_t rbase = (size_t)b * SEQ + seg * 128;
                    float A = 1.f, B = 0.f;
#pragma unroll 16
                    for (int i = 0; i < 128; ++i) { const float a = abuf[(rbase + i) * 256 + ch], bb = bbuf[(rbase + i) * 256 + ch]; B = a * B + bb; A *= a; }
                    LAS float* sA = (LAS float*)lds; LAS float* sB = sA + 512;
                    sA[tl] = A; sB[tl] = B;
                    __syncthreads();
                    float h = 0.f;
                    for (int s2 = 0; s2 < seg; ++s2) h = sA[s2 * 32 + (lane & 31)] * h + sB[s2 * 32 + (lane & 31)];
#pragma unroll 16
                    for (int i = 0; i < 128; ++i) { const float a = abuf[(rbase + i) * 256 + ch], bb = bbuf[(rbase + i) * 256 + ch]; h = a * h + bb;
                        const float gt = (float)z[(rbase + i) * ZW + 1440 + ch]; cat[(rbase + i) * 1024 + 768 + ch] = (h16)(h * gt); }
                    if (seg == 15) out[O_PH + ((size_t)lq * NB + b) * 256 + ch] = h;
                } else {
                    const float* abuf = WSP(float, W_A); const float* bbuf = WSP(float, W_B); const h16* z = WSP(h16, W_Z); h16* cats = WSP(h16, W_CATS);
                    const int it = item - N_SA - N_PA - N_PS, idx = it * 512 + tix, b = idx >> 8, ch = idx & 255;
                    float h = kp->in[4][((size_t)lq * DBATCH + b) * 256 + ch];
                    for (int t = 0; t < DSEQ; ++t) { const size_t r = (size_t)MP + b * 32 + t; h = abuf[r * 256 + ch] * h + bbuf[r * 256 + ch];
                        const float gt = (float)z[r * ZW + 1440 + ch]; cats[(size_t)(b * 32 + t) * 1024 + 768 + ch] = (h16)(h * gt); }
                    out[O_SH + ((size_t)lq * DBATCH + b) * 256 + ch] = h;
                }
            }
        }
        GSYNC();

        for (int rep = 0; rep < NREP(9); ++rep) if (PHM & (1u << 9)) { PH_BEGIN
          const int lp = lq > 0 ? lq - 1 : 0;
          Gemm g{WSP(h16, W_CAT), WSP(h16, W_WO + lq * SZ_WO), MT, 1024, 1024, 1024, 1024}; StaticOrder S; S.init(MT, 1024, G, bid);
          EpiRes E{WSP(h16, W_XH), WSP(float, W_STATS + (size_t)(lp * 2 + 1) * SZ_STATS), kp->in[9] + lp * DM, kp->in[10] + lp * DM, lq > 0, WSP(float, W_STATS + (size_t)(lq * 2) * SZ_STATS)}; gemm_phase(lds, g, S, E, tid); }
        GSYNC();

        for (int rep = 0; rep < NREP(12); ++rep) if (PHM & (1u << 12)) { PH_BEGIN
          Gemm g{WSP(h16, W_XH), WSP(h16, W_WUP + lq * SZ_WUP), MT, DFF2, 1024, 1024, 1024}; StaticOrder S; S.init(MT, DFF2, G, bid);
          EpiUp E{WSP(h16, W_UP), out + O_PFC + (size_t)lq * NB * 2 * DFF2, (O_SFC + (size_t)lq * DBATCH * 2 * DFF2) - (O_PFC + (size_t)lq * NB * 2 * DFF2), WSP(float, W_STATS + (size_t)(lq * 2) * SZ_STATS), WSP(float, W_CD + lq * SZ_CD) + 2 * ZW, WSP(float, W_CD + lq * SZ_CD) + 2 * ZW + DFF2}; gemm_phase(lds, g, S, E, tid); }
        GSYNC();

        for (int rep = 0; rep < NREP(13); ++rep) if (PHM & (1u << 13)) { PH_BEGIN
            const float* fw = kp->in[28] + (size_t)lq * 3 * DFF2; const float* fb = kp->in[29] + (size_t)lq * DFF2; const float* stf = kp->in[6] + (size_t)lq * DBATCH * 2 * DFF2;
            const h16* up = WSP(h16, W_UP); h16* act = WSP(h16, W_ACT);
            constexpr int RSEG = 32, NCG = DFF / 8;
            for (unsigned it = (unsigned)gtid; it < (unsigned)(NCG * (MT / RSEG)); it += (unsigned)NGT) { const int seg = (int)(it / (unsigned)NCG), cg = (int)(it - (unsigned)seg * NCG), j0 = cg * 8, row0 = seg * RSEG;
                const bool samp = row0 >= MP; const int t0 = samp ? 0 : (row0 & (SEQ - 1)), bb = (row0 - MP) >> 5;
                const f4 bg0 = *(const f4*)(fb + j0), bg1 = *(const f4*)(fb + j0 + 4), bv0 = *(const f4*)(fb + DFF + j0), bv1 = *(const f4*)(fb + DFF + j0 + 4);
                f4 wg0[3], wg1[3], wv0[3], wv1[3];
#pragma unroll
                for (int j = 0; j < 3; ++j) { const float* wj = fw + (size_t)j * DFF2; wg0[j] = *(const f4*)(wj + j0); wg1[j] = *(const f4*)(wj + j0 + 4); wv0[j] = *(const f4*)(wj + DFF + j0); wv1[j] = *(const f4*)(wj + DFF + j0 + 4); }
                f4 ag0, ag1, av0, av1, bg0_, bg1_, bv0_, bv1_;
                if (t0 > 0) { const h16* u2 = up + (size_t)(row0 - 2) * DFF2; const h16* u1 = u2 + DFF2;
                    const h8 a = *(const h8*)(u2 + j0), c = *(const h8*)(u2 + DFF + j0), d = *(const h8*)(u1 + j0), e = *(const h8*)(u1 + DFF + j0);
                    ag0 = (f4){(float)a[0], (float)a[1], (float)a[2], (float)a[3]}; ag1 = (f4){(float)a[4], (float)a[5], (float)a[6], (float)a[7]};
                    av0 = (f4){(float)c[0], (float)c[1], (float)c[2], (float)c[3]}; av1 = (f4){(float)c[4], (float)c[5], (float)c[6], (float)c[7]};
                    bg0_ = (f4){(float)d[0], (float)d[1], (float)d[2], (float)d[3]}; bg1_ = (f4){(float)d[4], (float)d[5], (float)d[6], (float)d[7]};
                    bv0_ = (f4){(float)e[0], (float)e[1], (float)e[2], (float)e[3]}; bv1_ = (f4){(float)e[4], (float)e[5], (float)e[6], (float)e[7]}; }
                else if (samp) { const float* s2 = stf + (size_t)bb * 2 * DFF2; const float* s1 = s2 + DFF2;
                    ag0 = *(const f4*)(s2 + j0); ag1 = *(const f4*)(s2 + j0 + 4); av0 = *(const f4*)(s2 + DFF + j0); av1 = *(const f4*)(s2 + DFF + j0 + 4);
                    bg0_ = *(const f4*)(s1 + j0); bg1_ = *(const f4*)(s1 + j0 + 4); bv0_ = *(const f4*)(s1 + DFF + j0); bv1_ = *(const f4*)(s1 + DFF + j0 + 4); }
                else { ag0 = ag1 = av0 = av1 = bg0_ = bg1_ = bv0_ = bv1_ = (f4){0.f, 0.f, 0.f, 0.f}; }
                const h16* ur = up + (size_t)row0 * DFF2 + j0; h16* ar = act + (size_t)row0 * DFF + j0;
#pragma unroll 4
                for (int r = 0; r < RSEG; ++r) { const h8 a = *(const h8*)(ur + (size_t)r * DFF2), c = *(const h8*)(ur + (size_t)r * DFF2 + DFF);
                    const f4 cg0 = (f4){(float)a[0], (float)a[1], (float)a[2], (float)a[3]}, cg1 = (f4){(float)a[4], (float)a[5], (float)a[6], (float)a[7]};
                    const f4 cv0 = (f4){(float)c[0], (float)c[1], (float)c[2], (float)c[3]}, cv1 = (f4){(float)c[4], (float)c[5], (float)c[6], (float)c[7]};
                    const f4 g0 = bg0 + ag0 * wg0[0] + bg0_ * wg0[1] + cg0 * wg0[2], g1 = bg1 + ag1 * wg1[0] + bg1_ * wg1[1] + cg1 * wg1[2];
                    const f4 v0 = bv0 + av0 * wv0[0] + bv0_ * wv0[1] + cv0 * wv0[2], v1 = bv1 + av1 * wv1[0] + bv1_ * wv1[1] + cv1 * wv1[2];
                    h8 o;
#pragma unroll
                    for (int e = 0; e < 4; ++e) { o[e] = (h16)(gelu_f(g0[e]) * v0[e]); o[4 + e] = (h16)(gelu_f(g1[e]) * v1[e]); }
                    *(h8*)(ar + (size_t)r * DFF) = o;
                    ag0 = bg0_; ag1 = bg1_; av0 = bv0_; av1 = bv1_; bg0_ = cg0; bg1_ = cg1; bv0_ = cv0; bv1_ = cv1; } }
        }
        GSYNC();

        for (int rep = 0; rep < NREP(14); ++rep) if (PHM & (1u << 14)) { PH_BEGIN
          Gemm g{WSP(h16, W_ACT), WSP(h16, W_WDN + lq * SZ_WDN), MT, 1024, DFF, DFF, DFF}; StaticOrder S; S.init(MT, 1024, G, bid); EpiRes E{WSP(h16, W_XH), WSP(float, W_STATS + (size_t)(lq * 2) * SZ_STATS), kp->in[7] + lq * DM, kp->in[8] + lq * DM, true, WSP(float, W_STATS + (size_t)(lq * 2 + 1) * SZ_STATS)}; gemm_phase(lds, g, S, E, tid); }
        GSYNC();

    }
    { const int l = DEPTH - 1; PH_BEGIN
        const float* gg = kp->in[9] + lq * DM; const float* bb = kp->in[10] + lq * DM; const h16* pre2 = WSP(h16, W_XH); const float* st = WSP(float, W_STATS + (size_t)(lq * 2 + 1) * SZ_STATS);
        for (size_t i = gtid; i < (size_t)MT * (DM / 4); i += NGT) { const int row = (int)(i >> 8), c = (int)(i & 255) * 4;
            const float sm = st[2 * row], sq = st[2 * row + 1], mean = sm * (1.f / DM), rstd = rsqrtf(sq * (1.f / DM) - mean * mean + 1e-5f);
            const h4 xv = *(const h4*)(pre2 + (size_t)row * DM + c);
            *(f4*)(out + O_Y + (size_t)row * DM + c) = ((f4){(float)xv[0], (float)xv[1], (float)xv[2], (float)xv[3]} - mean) * rstd * *(const f4*)(gg + c) + *(const f4*)(bb + c); }
    }
}

extern "C" void kernel_launch(void* const* d_in, const int* in_sizes, int n_in, void* d_out, int out_size, void* d_ws, size_t ws_size, hipStream_t stream) {
    constexpr size_t kDynLds = STAGE_BYTES;
    static int grid_blocks = 0;
    if (!grid_blocks) {
        if (n_in != 31 || (size_t)out_size != O_END || ws_size < W_END) { fprintf(stderr, "kernel_launch: unexpected shapes n_in %d out %d ws %zu (need %zu)\n", n_in, out_size, ws_size, (size_t)W_END); grid_blocks = -1; return; }
        int dev = 0, cus = 0, per_cu = 0;
        hipGetDevice(&dev);
        hipDeviceGetAttribute(&cus, hipDeviceAttributeMultiprocessorCount, dev);
        hipFuncSetAttribute((const void*)trunk_fwd, hipFuncAttributeMaxDynamicSharedMemorySize, (int)kDynLds);
        hipOccupancyMaxActiveBlocksPerMultiprocessor(&per_cu, (const void*)trunk_fwd, 512, kDynLds);
        if (per_cu < 1) per_cu = 1;
        grid_blocks = cus * per_cu;
        if (grid_blocks > 256) grid_blocks = 256;
        if (grid_blocks < 32) { fprintf(stderr, "kernel_launch: grid %d too small\n", grid_blocks); grid_blocks = -1; return; }
    }
    if (grid_blocks < 0) return;
    hipMemsetAsync((char*)d_ws + W_CTR, 0, W_ZERO_END, stream);
    Params p{};
    for (int i = 0; i < 31; ++i) p.in[i] = (const float*)d_in[i];
    p.out = (float*)d_out; p.ws = (unsigned char*)d_ws;
    void* args[] = {&p};
    hipError_t e = hipLaunchCooperativeKernel((const void*)trunk_fwd, dim3(grid_blocks), dim3(512), args, kDynLds, stream);
    if (e != hipSuccess) fprintf(stderr, "cooperative launch failed: %s (grid %d)\n", hipGetErrorString(e), grid_blocks);
}
```

```cpp
#include <hip/hip_runtime.h>
#include <hip/hip_cooperative_groups.h>
#include <cstdio>
#include <cstdint>
namespace cg = cooperative_groups;

typedef _Float16 h16;
typedef _Float16 h8 __attribute__((ext_vector_type(8)));
typedef _Float16 h4 __attribute__((ext_vector_type(4)));
typedef _Float16 h2 __attribute__((ext_vector_type(2)));
typedef float f4 __attribute__((ext_vector_type(4)));
typedef short s4v __attribute__((__vector_size__(8)));
#define LAS __attribute__((address_space(3)))
#define DEVI __device__ __forceinline__

constexpr int DM = 1024, NB = 16, SEQ = 2048, DEPTH = 4, DBATCH = 32, DSEQ = 32, PAST = 4096;
constexpr int MP = NB * SEQ, MS = DBATCH * DSEQ, MT = MP + MS;
constexpr int DIN = 1696, ZW = 1792, DFF = 2816, DFF2 = 5632;
constexpr int QW = 768, KW = 768, VW = 512, QLW = 2304, CSW = 2560, KNW = 288;
constexpr float ALPHA = 1.681792830507429f;
constexpr float QSCALE = 0.14724444f;
constexpr int NPOS = SEQ + DSEQ;

constexpr size_t O_Y = 0;
constexpr size_t O_PLAT = (size_t)MT * DM;
constexpr size_t O_PKR = O_PLAT + (size_t)DEPTH * MP * 256;
constexpr size_t O_PH = O_PKR + (size_t)DEPTH * MP * 32;
constexpr size_t O_PLC = O_PH + (size_t)DEPTH * NB * 256;
constexpr size_t O_PFC = O_PLC + (size_t)DEPTH * NB * 3 * 256;
constexpr size_t O_SLAT = O_PFC + (size_t)DEPTH * NB * 2 * DFF2;
constexpr size_t O_SKR = O_SLAT + (size_t)DEPTH * MS * 256;
constexpr size_t O_SV = O_SKR + (size_t)DEPTH * MS * 32;
constexpr size_t O_SH = O_SV + (size_t)DEPTH * MS * 256;
constexpr size_t O_SLC = O_SH + (size_t)DEPTH * DBATCH * 256;
constexpr size_t O_SFC = O_SLC + (size_t)DEPTH * DBATCH * 3 * 256;
constexpr size_t O_END = O_SFC + (size_t)DEPTH * DBATCH * 2 * DFF2;

constexpr size_t al(size_t x) { return (x + 255) & ~(size_t)255; }
constexpr size_t W_CTR = 0;
constexpr size_t W_PARAMS = 2048;
constexpr size_t W_BAR = 4096;
constexpr size_t W_CD = 4096 + 16384;
constexpr size_t SZ_CD = (size_t)(2 * ZW + 2 * DFF2) * 4;
constexpr size_t W_STATS = W_CD + DEPTH * SZ_CD;
constexpr size_t SZ_STATS = (size_t)MT * 2 * 4;
constexpr size_t W_ZERO_END = W_STATS + (size_t)DEPTH * 2 * SZ_STATS;
constexpr size_t W_ROPE = al(W_ZERO_END);
constexpr size_t W_SP = al(W_ROPE + (size_t)NPOS * 16 * 2 * 4);
constexpr size_t W_WIN = al(W_SP + (size_t)DEPTH * 256 * 4);
constexpr size_t SZ_WIN = (size_t)ZW * 1024 * 2;
constexpr size_t W_WUQ = W_WIN + DEPTH * SZ_WIN;   constexpr size_t SZ_WUQ = (size_t)768 * 384 * 2;
constexpr size_t W_WQL = W_WUQ + DEPTH * SZ_WUQ;   constexpr size_t SZ_WQL = (size_t)2048 * 384 * 2;
constexpr size_t W_WKV = W_WQL + DEPTH * SZ_WQL;   constexpr size_t SZ_WKV = (size_t)1024 * 256 * 2;
constexpr size_t W_WG = W_WKV + DEPTH * SZ_WKV;    constexpr size_t SZ_WG = (size_t)512 * 256 * 2;
constexpr size_t W_WO = W_WG + DEPTH * SZ_WG;      constexpr size_t SZ_WO = (size_t)1024 * 1024 * 2;
constexpr size_t W_WOS = W_WO + DEPTH * SZ_WO;     constexpr size_t SZ_WOS = (size_t)8 * 64 * 256 * 2;
constexpr size_t W_WUP = W_WOS + DEPTH * SZ_WOS;   constexpr size_t SZ_WUP = (size_t)DFF2 * 1024 * 2;
constexpr size_t W_WDN = W_WUP + DEPTH * SZ_WUP;   constexpr size_t SZ_WDN = (size_t)1024 * DFF * 2;
constexpr size_t W_XH = W_WDN + DEPTH * SZ_WDN;
constexpr size_t W_Z = W_XH + (size_t)MT * 1024 * 2;
constexpr size_t W_CQN = W_Z + (size_t)MT * ZW * 2;
constexpr size_t W_CKVN = W_CQN + (size_t)MT * 384 * 2;
constexpr size_t W_XC = W_CKVN + (size_t)MP * 256 * 2;
constexpr size_t W_Q = W_XC + (size_t)MT * 256 * 2;
constexpr size_t W_K = W_Q + (size_t)MP * QW * 2;
constexpr size_t W_V = W_K + (size_t)MP * KW * 2;
constexpr size_t W_A = W_V + (size_t)MP * VW * 2;
constexpr size_t W_B = W_A + (size_t)MT * 256 * 4;
constexpr size_t W_CAT = W_B + (size_t)MT * 256 * 4;
constexpr size_t W_CATS = W_CAT + (size_t)MP * 1024 * 2;
constexpr size_t W_QLAT = W_CATS + (size_t)MS * 1024 * 2;
constexpr size_t W_KNEW = W_QLAT + (size_t)MS * QLW * 2;
constexpr size_t W_PRE = al(W_KNEW + (size_t)MS * KNW * 2);
constexpr size_t W_X1F = W_PRE + (size_t)MT * 1024 * 4;
constexpr size_t W_UP = W_X1F + (size_t)MT * 1024 * 4;
constexpr size_t W_ACT = W_UP + (size_t)MT * DFF2 * 2;
constexpr size_t W_PART = W_ACT + (size_t)MT * DFF * 2;
constexpr size_t SZ_PARTW = 16 * 1024 + 512;
constexpr size_t W_END = W_PART + (size_t)256 * 8 * SZ_PARTW;

struct Params { const float* in[31]; float* out; unsigned char* ws; };

DEVI float gelu_f(float x) { const float u = -2.302208198f * (x + 0.044715f * x * x * x); return x * __builtin_amdgcn_rcpf(1.f + __builtin_amdgcn_exp2f(u)); }
DEVI float sigmoid_f(float x) { return __builtin_amdgcn_rcpf(1.f + __builtin_amdgcn_exp2f(-1.4426950408889634f * x)); }
DEVI h8 pack8(f4 a, f4 b) { h8 r; r[0] = (h16)a[0]; r[1] = (h16)a[1]; r[2] = (h16)a[2]; r[3] = (h16)a[3]; r[4] = (h16)b[0]; r[5] = (h16)b[1]; r[6] = (h16)b[2]; r[7] = (h16)b[3]; return r; }
DEVI h4 pack4(f4 a) { h4 r; r[0] = (h16)a[0]; r[1] = (h16)a[1]; r[2] = (h16)a[2]; r[3] = (h16)a[3]; return r; }
DEVI float shx(float v, int o, int lane) { return __builtin_bit_cast(float, __builtin_amdgcn_ds_bpermute((lane ^ o) << 2, __builtin_bit_cast(int, v))); }
DEVI float wave_sum(float v, int lane) {
#pragma unroll
    for (int o = 1; o < 64; o <<= 1) v += shx(v, o, lane);
    return v;
}
DEVI int opaque_lane() { unsigned ones = ~0u; asm volatile("" : "+s"(ones)); return (int)__builtin_amdgcn_mbcnt_hi(ones, __builtin_amdgcn_mbcnt_lo(ones, 0u)); }
DEVI h4 trrd(LAS unsigned char* p) { s4v r = __builtin_amdgcn_ds_read_tr16_b64_v4i16((LAS s4v*)p); return __builtin_bit_cast(h4, r); }
DEVI h8 cat44(h4 a, h4 b) { return __builtin_shufflevector(a, b, 0, 1, 2, 3, 4, 5, 6, 7); }

constexpr int BM = 256, BK = 64, HALF = 128, HTB = HALF * BK * 2, STAGE_BYTES = 8 * HTB, NXCD = 8, WGM = 8;
DEVI int lds_byte(int r, int c) { const int st = (r >> 4) * 2 + (c >> 5), rr = r & 15, cc = c & 31, ob = rr * 64 + cc * 2; return st * 1024 + (ob ^ (((ob >> 9) & 1) << 5)); }
DEVI void stage_rc(int b, int& R, int& C) { const int st = b / 1024, sb = b % 1024, swz = sb ^ (((sb >> 9) & 1) << 5); R = (st >> 1) * 16 + swz / 64; C = (st & 1) * 32 + (swz % 64) / 2; }
DEVI int perm32(int rho) { const int n = rho >> 4, i = rho & 15; return 8 * (i >> 2) + 4 * n + (i & 3); }
struct Unit { int pm, pn; };
struct Gemm { const h16* A; const h16* Bt; int M, N, K, lda, ldb; };
struct StaticOrder {
    int nM, nN, nwg, G, c;
    DEVI void init(int M, int N, int G_, int c_) { nM = M / BM; nN = N / BM; nwg = nM * nN; G = G_; c = c_; }
    DEVI bool next(int i, Unit& u) const {
        if (c < 0) return false;
        const long L = (long)i * G + c; if (L >= nwg) return false;
        int wgid = (int)L; { const int q = nwg / NXCD, r = nwg % NXCD, xcd = wgid % NXCD, off = wgid / NXCD; wgid = (xcd < r ? xcd * (q + 1) : r * (q + 1) + (xcd - r) * q) + off; }
        const int nig = WGM * nN, gid = wgid / nig, fm = gid * WGM, gsz = (nM - fm) < WGM ? (nM - fm) : WGM;
        u.pm = fm + ((wgid % nig) % gsz); u.pn = (wgid % nig) / gsz; return true;
    }
};
template <class Epi>
DEVI void gemm_phase(LAS unsigned char* lds, const Gemm g, const StaticOrder& S, const Epi& E, const int tid) {
    const int wid = __builtin_amdgcn_readfirstlane(tid >> 6), lane = tid & 63, wr = wid >> 2, wc = wid & 3, fr = lane & 15, fq = lane >> 4;
    const int K = g.K, nt = K / BK;
    unsigned voffA[2], voffB[2];
#pragma unroll
    for (int i = 0; i < 2; ++i) { int R, C; stage_rc(tid * 16 + i * 8192, R, C); const int Rb = Epi::PERM ? ((R & ~31) + perm32(R & 31)) : R;
        voffA[i] = (unsigned)(R * g.lda + C) * 2u; voffB[i] = (unsigned)(Rb * g.ldb + C) * 2u; }
    const size_t kstep = (size_t)(BK * 2);
    const size_t hstepA = (size_t)HALF * g.lda * 2, hstepB = (size_t)HALF * g.ldb * 2;
    const size_t tstepA = 2 * hstepA, tstepB = 2 * hstepB;
    const unsigned ldsw = (unsigned)wid * 1024u;
    const int aoff = lds_byte(wr * 64 + fr, fq * 8), boff = lds_byte(wc * 32 + fr, fq * 8);
#define PG8_SA(b, h) (((b) * 2 + (h)) * HTB)
#define PG8_SB(b, h) ((4 + (b) * 2 + (h)) * HTB)
#define PG8_STAGE(bufoff, gbase, voff) do { _Pragma("unroll") for (int _i = 0; _i < 2; ++_i) \
        __builtin_amdgcn_global_load_lds((const unsigned*)((const char*)(gbase) + (voff)[_i]), (LAS unsigned*)(lds + (bufoff) + ldsw + _i * 8192), 16, 0, 0); } while (0)
#define PG8_LDA(dst, b, h) do { _Pragma("unroll") for (int m = 0; m < 4; ++m) _Pragma("unroll") for (int k = 0; k < 2; ++k) dst[m][k] = *(const LAS h8*)(lds + PG8_SA(b, h) + aoff + m * 2048 + k * 1024); } while (0)
#define PG8_LDB(dst, b, h) do { _Pragma("unroll") for (int n = 0; n < 2; ++n) _Pragma("unroll") for (int k = 0; k < 2; ++k) dst[n][k] = *(const LAS h8*)(lds + PG8_SB(b, h) + boff + n * 2048 + k * 1024); } while (0)
#define PG8_MMA(ai, bj, At, Bt) do { __builtin_amdgcn_s_setprio(1); _Pragma("unroll") for (int m = 0; m < 4; ++m) _Pragma("unroll") for (int n = 0; n < 2; ++n) _Pragma("unroll") for (int k = 0; k < 2; ++k) \
        acc[ai][bj][m][n] = __builtin_amdgcn_mfma_f32_16x16x32_f16(Bt[n][k], At[m][k], acc[ai][bj][m][n], 0, 0, 0); __builtin_amdgcn_s_setprio(0); } while (0)
#define PG8_WAIT_V(n) asm volatile("s_waitcnt vmcnt(" #n ")" ::: "memory")
#define PG8_WAIT_L(n) asm volatile("s_waitcnt lgkmcnt(" #n ")" ::: "memory")
#define PG8_BAR __builtin_amdgcn_s_barrier()
#define PG8_SCHED __builtin_amdgcn_sched_barrier(0)
    Unit cur, nxt; int ui = 0;
    if (!S.next(0, cur)) return;
    f4 acc[2][2][4][2];
#pragma unroll
    for (int a = 0; a < 2; ++a)
#pragma unroll
        for (int b = 0; b < 2; ++b)
#pragma unroll
            for (int m = 0; m < 4; ++m)
#pragma unroll
                for (int n = 0; n < 2; ++n) acc[a][b][m][n] = (f4){0.f, 0.f, 0.f, 0.f};
    h8 At[4][2], B0[2][2], B1[2][2];
    const char* cA = (const char*)g.A + (size_t)cur.pm * tstepA; const char* cB = (const char*)g.Bt + (size_t)cur.pn * tstepB;
    PG8_STAGE(PG8_SB(0, 0), cB, voffB); PG8_STAGE(PG8_SA(0, 0), cA, voffA); PG8_STAGE(PG8_SB(0, 1), cB + hstepB, voffB); PG8_STAGE(PG8_SA(0, 1), cA + hstepA, voffA);
    if (wr == 1) PG8_BAR;
    PG8_WAIT_V(4); PG8_BAR;
    PG8_STAGE(PG8_SB(1, 0), cB + kstep, voffB); PG8_STAGE(PG8_SA(1, 0), cA + kstep, voffA); PG8_STAGE(PG8_SB(1, 1), cB + hstepB + kstep, voffB);
    PG8_WAIT_V(6); PG8_BAR;
    for (;;) {
        const bool has_next = S.next(ui + 1, nxt);
        const char* nA = has_next ? (const char*)g.A + (size_t)nxt.pm * tstepA : cA; const char* nB = has_next ? (const char*)g.Bt + (size_t)nxt.pn * tstepB : cB;
        for (int t = 0; t < nt; t += 2) {
            const bool last = (t == nt - 2);
            const char* a1 = cA + (size_t)(t + 1) * kstep;
            const char* a2 = last ? nA : cA + (size_t)(t + 2) * kstep; const char* b2 = last ? nB : cB + (size_t)(t + 2) * kstep;
            const char* a3 = a2 + kstep; const char* b3 = b2 + kstep;
            PG8_LDB(B0, 0, 0); PG8_SCHED; PG8_LDA(At, 0, 0); PG8_STAGE(PG8_SA(1, 1), a1 + hstepA, voffA);
            PG8_WAIT_L(8); PG8_BAR; PG8_WAIT_L(0); PG8_MMA(0, 0, At, B0); PG8_BAR; PG8_SCHED;
            PG8_LDB(B1, 0, 1); PG8_STAGE(PG8_SB(0, 0), b2, voffB);
            PG8_BAR; PG8_WAIT_L(0); PG8_MMA(0, 1, At, B1); PG8_BAR;
            PG8_LDA(At, 0, 1); PG8_STAGE(PG8_SA(0, 0), a2, voffA);
            PG8_BAR; PG8_WAIT_L(0); PG8_MMA(1, 0, At, B0); PG8_BAR; PG8_SCHED;
            PG8_STAGE(PG8_SB(0, 1), b2 + hstepB, voffB);
            PG8_WAIT_V(6); PG8_BAR; PG8_MMA(1, 1, At, B1); PG8_BAR;
            PG8_LDB(B0, 1, 0); PG8_SCHED; PG8_LDA(At, 1, 0); PG8_STAGE(PG8_SA(0, 1), a2 + hstepA, voffA);
            PG8_WAIT_L(8); PG8_BAR; PG8_WAIT_L(0); PG8_MMA(0, 0, At, B0); PG8_BAR; PG8_SCHED;
            PG8_LDB(B1, 1, 1); PG8_STAGE(PG8_SB(1, 0), b3, voffB);
            PG8_BAR; PG8_WAIT_L(0); PG8_MMA(0, 1, At, B1); PG8_BAR;
            PG8_LDA(At, 1, 1); PG8_STAGE(PG8_SA(1, 0), a3, voffA);
            PG8_BAR; PG8_WAIT_L(0); PG8_MMA(1, 0, At, B0); PG8_BAR; PG8_SCHED;
            PG8_STAGE(PG8_SB(1, 1), b3 + hstepB, voffB);
            PG8_WAIT_V(6); PG8_BAR; PG8_MMA(1, 1, At, B1); PG8_BAR;
        }
        { int t2 = tid; asm volatile("" : "+v"(t2)); const int l2 = t2 & 63; E(acc, cur, wr, wc, l2 & 15, l2 >> 4); }
        if (!has_next) break;
#pragma unroll
        for (int a = 0; a < 2; ++a)
#pragma unroll
            for (int b = 0; b < 2; ++b)
#pragma unroll
                for (int m = 0; m < 4; ++m)
#pragma unroll
                    for (int n = 0; n < 2; ++n) acc[a][b][m][n] = (f4){0.f, 0.f, 0.f, 0.f};
        cur = nxt; cA = nA; cB = nB; ++ui;
    }
    PG8_WAIT_V(0);
    if (wr == 0) PG8_BAR;
    PG8_BAR;
#undef PG8_SA
#undef PG8_SB
#undef PG8_STAGE
#undef PG8_LDA
#undef PG8_LDB
#undef PG8_MMA
#undef PG8_WAIT_V
#undef PG8_WAIT_L
#undef PG8_BAR
#undef PG8_SCHED
}

typedef f4 Acc[2][2][4][2];
#define EPI_ROWS for (int ai = 0; ai < 2; ++ai) _Pragma("unroll") for (int m = 0; m < 4; ++m)

#define ROW_OF(r) (rowb + ((r) >> 2) * HALF + ((r) & 3) * 16)
struct EpiZ {
    static constexpr bool PERM = true;
    h16* z; float* sv; const float* st; const float* cv; const float* dv; bool fold;
    DEVI void operator()(const Acc& acc, const Unit& u, int wr, int wc, int fr, int fq) const {
        const int rowb = u.pm * BM + wr * 64 + fr, colb = u.pn * BM + wc * 32 + fq * 8;
        float mean[8], rstd[8]; f4 c[2][2], d[2][2];
#pragma unroll
        for (int r = 0; r < 8; ++r) { mean[r] = 0.f; rstd[r] = 1.f; }
#pragma unroll
        for (int bj = 0; bj < 2; ++bj)
#pragma unroll
            for (int n = 0; n < 2; ++n) { c[bj][n] = (f4){0.f, 0.f, 0.f, 0.f}; d[bj][n] = c[bj][n]; }
        if (fold) {
#pragma unroll
            for (int r = 0; r < 8; ++r) { const int row = ROW_OF(r); const float sm = st[2 * row], sq = st[2 * row + 1]; mean[r] = sm * (1.f / DM); rstd[r] = rsqrtf(sq * (1.f / DM) - mean[r] * mean[r] + 1e-5f); }
#pragma unroll
            for (int bj = 0; bj < 2; ++bj)
#pragma unroll
                for (int n = 0; n < 2; ++n) { c[bj][n] = *(const f4*)(cv + colb + bj * HALF + 4 * n); d[bj][n] = *(const f4*)(dv + colb + bj * HALF + 4 * n); } }
#pragma unroll
        for (int bj = 0; bj < 2; ++bj) { const int col = colb + bj * HALF; const bool act = col < 512 || (col >= 1440 && col < 1696);
#pragma unroll
            for (int r = 0; r < 8; ++r) { const int row = ROW_OF(r);
                f4 v0 = (acc[r >> 2][bj][r & 3][0] - c[bj][0] * mean[r]) * rstd[r] + d[bj][0], v1 = (acc[r >> 2][bj][r & 3][1] - c[bj][1] * mean[r]) * rstd[r] + d[bj][1];
                if (act) {
#pragma unroll
                    for (int e = 0; e < 4; ++e) { v0[e] = gelu_f(v0[e]); v1[e] = gelu_f(v1[e]); } }
                *(h8*)(z + (size_t)row * ZW + col) = pack8(v0, v1);
                if (row >= MP && col >= 256 && col < 512) { float* o = sv + (size_t)(row - MP) * 256 + (col - 256); *(f4*)o = v0; *(f4*)(o + 4) = v1; } } }
    }
};
struct EpiQ {
    static constexpr bool PERM = true;
    h16* q; h16* qlat; const float* ropec; const float* ropes;
    DEVI void operator()(const Acc& acc, const Unit& u, int wr, int wc, int fr, int fq) const {
        const bool samp = u.pm * BM >= MP;
        if (u.pn < 2) { if (samp) return;
#pragma unroll
            EPI_ROWS { const int row = u.pm * BM + ai * HALF + wr * 64 + m * 16 + fr;
#pragma unroll
                for (int bj = 0; bj < 2; ++bj) { const int col = u.pn * BM + bj * HALF + wc * 32 + fq * 8;
                    *(h8*)(q + (size_t)row * QW + (col >> 6) * 96 + (col & 63)) = pack8(acc[ai][bj][m][0] * QSCALE, acc[ai][bj][m][1] * QSCALE); } }
        } else {
            const int j = wc * 32 + fq * 8, head = j >> 4, i0 = j & 15; const int rowb = u.pm * BM + wr * 64 + fr;
#pragma unroll
            for (int r = 0; r < 8; ++r) { const int row = ROW_OF(r); const int pidx = samp ? SEQ + ((row - MP) & 31) : (row & (SEQ - 1));
                const size_t po = samp ? (W_QLAT - W_Q) / 2 + (size_t)(row - MP) * QLW + head * 288 + 256 + i0 : (size_t)row * QW + head * 96 + 64 + i0;
#pragma unroll
                for (int n = 0; n < 2; ++n) { const f4 cc = *(const f4*)(ropec + pidx * 16 + i0 + 4 * n), ss = *(const f4*)(ropes + pidx * 16 + i0 + 4 * n);
                    const f4 a0 = acc[r >> 2][0][r & 3][n], b0 = acc[r >> 2][1][r & 3][n];
                    *(h4*)(q + po + 4 * n) = pack4((a0 * cc - b0 * ss) * QSCALE); *(h4*)(q + po + 16 + 4 * n) = pack4((a0 * ss + b0 * cc) * QSCALE); } }
        }
    }
};
struct EpiKV {
    static constexpr bool PERM = true;
    h16* k; h16* v;
    DEVI void operator()(const Acc& acc, const Unit& u, int wr, int wc, int fr, int fq) const {
#pragma unroll
        EPI_ROWS { const int row = u.pm * BM + ai * HALF + wr * 64 + m * 16 + fr;
#pragma unroll
            for (int bj = 0; bj < 2; ++bj) { const int col = u.pn * BM + bj * HALF + wc * 32 + fq * 8; const h8 o = pack8(acc[ai][bj][m][0], acc[ai][bj][m][1]);
                if (u.pn < 2) *(h8*)(k + (size_t)row * KW + (col >> 6) * 96 + (col & 63)) = o; else *(h8*)(v + (size_t)row * VW + (col - 512)) = o; } }
    }
};
DEVI float one_minus_exp(float x) {
    const float pser = -x * (1.f + x * (0.5f + x * (0.16666667f + x * (0.041666668f + x * (0.0083333338f + x * 0.0013888889f)))));
    return x > -0.25f ? pser : 1.f - __builtin_amdgcn_exp2f(1.4426950408889634f * x);
}
struct EpiGate {
    static constexpr bool PERM = false;
    const h16* xc; float* a; float* b; const float* br; const float* bi; const float* sp;
    DEVI void operator()(const Acc& acc, const Unit& u, int wr, int wc, int fr, int fq) const {
        const int rowb = u.pm * BM + wr * 64 + fr, chb = u.pn * 128 + wc * 32 + fq * 4;
        f4 vbr[2], vbi[2], vsp[2]; h4 xv[2][8];
#pragma unroll
        for (int n = 0; n < 2; ++n) { const int ch = chb + n * 16; vbr[n] = *(const f4*)(br + ch); vbi[n] = *(const f4*)(bi + ch); vsp[n] = *(const f4*)(sp + ch) * -8.f;
#pragma unroll
            for (int r = 0; r < 8; ++r) xv[n][r] = *(const h4*)(xc + (size_t)ROW_OF(r) * 256 + ch); }
#pragma unroll
        for (int n = 0; n < 2; ++n) { const int ch = chb + n * 16;
#pragma unroll
            for (int r = 0; r < 8; ++r) { const int row = ROW_OF(r); f4 oa, ob;
#pragma unroll
                for (int e = 0; e < 4; ++e) { const float rg = sigmoid_f(acc[r >> 2][0][r & 3][n][e] + vbr[n][e]), ig = sigmoid_f(acc[r >> 2][1][r & 3][n][e] + vbi[n][e]);
                    const float la = rg * vsp[n][e]; oa[e] = __builtin_amdgcn_exp2f(1.4426950408889634f * la); ob[e] = __builtin_amdgcn_sqrtf(one_minus_exp(2.f * la)) * (ig * (float)xv[n][r][e]); }
                *(f4*)(a + (size_t)row * 256 + ch) = oa; *(f4*)(b + (size_t)row * 256 + ch) = ob; } }
    }
};
struct EpiQlat {
    static constexpr bool PERM = true;
    h16* qlat;
    DEVI void operator()(const Acc& acc, const Unit& u, int wr, int wc, int fr, int fq) const {
#pragma unroll
        EPI_ROWS { const int row = u.pm * BM + ai * HALF + wr * 64 + m * 16 + fr;
#pragma unroll
            for (int bj = 0; bj < 2; ++bj) { const int c = bj * HALF + wc * 32 + fq * 8;
                *(h8*)(qlat + (size_t)row * QLW + u.pn * 288 + c) = pack8(acc[ai][bj][m][0] * QSCALE, acc[ai][bj][m][1] * QSCALE); } }
    }
};
struct EpiRes {
    static constexpr bool PERM = false;
    h16* xh; const float* pst; const float* g; const float* b; bool ln; float* ost;
    DEVI void operator()(const Acc& acc, const Unit& u, int wr, int wc, int fr, int fq) const {
        const int rowb = u.pm * BM + wr * 64 + fr, colb = u.pn * BM + wc * 32 + fq * 4, lane = fq * 16 + fr;
        f4 gv[4], bv[4]; float mean[8], rstd[8];
#pragma unroll
        for (int k = 0; k < 4; ++k) { const int col = colb + (k >> 1) * HALF + (k & 1) * 16; gv[k] = ln ? *(const f4*)(g + col) : (f4){1.f, 1.f, 1.f, 1.f}; bv[k] = ln ? *(const f4*)(b + col) : (f4){0.f, 0.f, 0.f, 0.f}; }
#pragma unroll
        for (int r = 0; r < 8; ++r) { mean[r] = 0.f; rstd[r] = 1.f;
            if (ln) { const int row = ROW_OF(r); const float sm = pst[2 * row], sq = pst[2 * row + 1]; mean[r] = sm * (1.f / DM); rstd[r] = rsqrtf(sq * (1.f / DM) - mean[r] * mean[r] + 1e-5f); } }
        h4 cur[4], nxt[4];
#pragma unroll
        for (int k = 0; k < 4; ++k) cur[k] = *(const h4*)(xh + (size_t)ROW_OF(0) * DM + colb + (k >> 1) * HALF + (k & 1) * 16);
#pragma unroll
        for (int r = 0; r < 8; ++r) { const int row = ROW_OF(r);
            if (r < 7) {
#pragma unroll
                for (int k = 0; k < 4; ++k) nxt[k] = *(const h4*)(xh + (size_t)ROW_OF(r + 1) * DM + colb + (k >> 1) * HALF + (k & 1) * 16); }
            float s1 = 0.f, s2 = 0.f;
#pragma unroll
            for (int k = 0; k < 4; ++k) { const size_t o = (size_t)row * DM + colb + (k >> 1) * HALF + (k & 1) * 16;
                const f4 xv = (f4){(float)cur[k][0], (float)cur[k][1], (float)cur[k][2], (float)cur[k][3]};
                const f4 xr = (xv - mean[r]) * rstd[r] * gv[k] + bv[k];
                const f4 y = xr * ALPHA + acc[r >> 2][k >> 1][r & 3][k & 1];
                *(h4*)(xh + o) = pack4(y);
                s1 += (y[0] + y[1]) + (y[2] + y[3]); s2 += (y[0] * y[0] + y[1] * y[1]) + (y[2] * y[2] + y[3] * y[3]); }
            s1 += shx(s1, 16, lane); s2 += shx(s2, 16, lane); s1 += shx(s1, 32, lane); s2 += shx(s2, 32, lane);
            if (fq == 0) { atomicAdd(ost + 2 * row, s1); atomicAdd(ost + 2 * row + 1, s2); }
#pragma unroll
            for (int k = 0; k < 4; ++k) cur[k] = nxt[k]; }
    }
};
struct EpiUp {
    static constexpr bool PERM = true;
    h16* up; float* pfc; size_t sdelta; const float* st; const float* cv; const float* dv;
    DEVI void operator()(const Acc& acc, const Unit& u, int wr, int wc, int fr, int fq) const {
        const int rowb = u.pm * BM + wr * 64 + fr, colb = u.pn * BM + wc * 32 + fq * 8;
        float mean[8], rstd[8]; f4 c[2][2], d[2][2];
#pragma unroll
        for (int r = 0; r < 8; ++r) { const int row = ROW_OF(r); const float sm = st[2 * row], sq = st[2 * row + 1]; mean[r] = sm * (1.f / DM); rstd[r] = rsqrtf(sq * (1.f / DM) - mean[r] * mean[r] + 1e-5f); }
#pragma unroll
        for (int bj = 0; bj < 2; ++bj)
#pragma unroll
            for (int n = 0; n < 2; ++n) { c[bj][n] = *(const f4*)(cv + colb + bj * HALF + 4 * n); d[bj][n] = *(const f4*)(dv + colb + bj * HALF + 4 * n); }
#pragma unroll
        for (int r = 0; r < 8; ++r) { const int row = ROW_OF(r);
            bool has_st; size_t so;
            if (row < MP) { const int t = row & (SEQ - 1); has_st = t >= SEQ - 2; so = ((size_t)(row >> 11) * 2 + (t - (SEQ - 2))) * DFF2; }
            else { const int rs = row - MP, t = rs & 31; has_st = t >= DSEQ - 2; so = sdelta + ((size_t)(rs >> 5) * 2 + (t - (DSEQ - 2))) * DFF2; }
#pragma unroll
            for (int bj = 0; bj < 2; ++bj) { const int col = colb + bj * HALF;
                const f4 v0 = (acc[r >> 2][bj][r & 3][0] - c[bj][0] * mean[r]) * rstd[r] + d[bj][0], v1 = (acc[r >> 2][bj][r & 3][1] - c[bj][1] * mean[r]) * rstd[r] + d[bj][1];
                *(h8*)(up + (size_t)row * DFF2 + col) = pack8(v0, v1);
                if (has_st) { float* sp = pfc + so + col; *(f4*)sp = v0; *(f4*)(sp + 4) = v1; } } }
    }
};

template <int MODE>
DEVI void transpose_item(const float* W, int ldw, int nblk, h16* WT, int ldd, LAS float* scr, int item, int lane, const float* gs = nullptr, const float* bs = nullptr, float* csum = nullptr, float* dsum = nullptr) {
    const int kb = item / nblk, nb = item % nblk, k0 = 64 * kb, n0 = 32 * nb;
    int nsrc = n0 + (lane & 31);
    if (MODE == 1) { const int n = nsrc; if (n < 512) nsrc = (n >> 6) * 96 + (n & 63); else if (n < 640) nsrc = ((n - 512) >> 4) * 96 + 64 + ((n - 512) & 15); else nsrc = ((n - 640) >> 4) * 96 + 80 + ((n - 640) & 15); }
    float cs = 0.f, ds = 0.f;
#pragma unroll 8
    for (int i = 0; i < 32; ++i) { const int kk = 2 * i + (lane >> 5); float w = W[(size_t)(k0 + kk) * ldw + nsrc]; if (gs) { ds += bs[k0 + kk] * w; w *= gs[k0 + kk]; cs += w; } scr[kk * 33 + (lane & 31)] = w; }
    if (gs) { atomicAdd(csum + nsrc, cs); atomicAdd(dsum + nsrc, ds); }
    __builtin_amdgcn_fence(__ATOMIC_RELEASE, "wavefront"); asm volatile("s_waitcnt lgkmcnt(0)" ::: "memory");
    const int c = lane & 7;
#pragma unroll
    for (int j = 0; j < 4; ++j) { const int n = (lane >> 3) + 8 * j; const LAS float* s = scr + (8 * c) * 33 + n;
        h8 o; o[0] = (h16)s[0 * 33]; o[1] = (h16)s[1 * 33]; o[2] = (h16)s[2 * 33]; o[3] = (h16)s[3 * 33]; o[4] = (h16)s[4 * 33]; o[5] = (h16)s[5 * 33]; o[6] = (h16)s[6 * 33]; o[7] = (h16)s[7 * 33];
        *(h8*)(WT + (size_t)(n0 + n) * ldd + k0 + 8 * c) = o; }
    asm volatile("s_waitcnt lgkmcnt(0)" ::: "memory");
}

template <int NKS, int NCT, int NQS, int KSTR>
DEVI void attn_qk(LAS unsigned char* kbase, const h8 (&qf)[NQS][NKS], f4 (&o)[NQS][NCT], float (&mrow)[NQS], float (&lrow)[NQS], h8 (&pf)[NQS][2], const int nkt, const int lane) {
    const int fr = lane & 15, g = lane >> 4;
    f4 s[NQS][4];
#pragma unroll
    for (int qs = 0; qs < NQS; ++qs)
#pragma unroll
        for (int kt = 0; kt < 4; ++kt) s[qs][kt] = (f4){-1e30f, -1e30f, -1e30f, -1e30f};
#pragma unroll
    for (int kt = 0; kt < 4; ++kt) if (kt < nkt) {
#pragma unroll
        for (int qs = 0; qs < NQS; ++qs) s[qs][kt] = (f4){0.f, 0.f, 0.f, 0.f};
#pragma unroll
        for (int ks = 0; ks < NKS; ++ks) { const h8 kf = *(const LAS h8*)(kbase + (kt * 16 + fr) * KSTR + ks * 64 + g * 16);
#pragma unroll
            for (int qs = 0; qs < NQS; ++qs) s[qs][kt] = __builtin_amdgcn_mfma_f32_16x16x32_f16(kf, qf[qs][ks], s[qs][kt], 0, 0, 0); } }
    __builtin_amdgcn_sched_barrier(0);
#pragma unroll
    for (int qs = 0; qs < NQS; ++qs) {
        float mx = -1e30f;
#pragma unroll
        for (int kt = 0; kt < 4; ++kt)
#pragma unroll
            for (int e = 0; e < 4; ++e) mx = fmaxf(mx, s[qs][kt][e]);
        mx = fmaxf(mx, shx(mx, 16, lane)); mx = fmaxf(mx, shx(mx, 32, lane));
        const float mnew = fmaxf(mrow[qs], mx), alpha = __builtin_amdgcn_exp2f(mrow[qs] - mnew); mrow[qs] = mnew;
        float ps = 0.f;
#pragma unroll
        for (int kt = 0; kt < 4; ++kt)
#pragma unroll
            for (int e = 0; e < 4; ++e) { const float p = __builtin_amdgcn_exp2f(s[qs][kt][e] - mnew); s[qs][kt][e] = p; ps += p; }
        lrow[qs] = lrow[qs] * alpha + ps;
#pragma unroll
        for (int ct = 0; ct < NCT; ++ct) o[qs][ct] *= alpha;
#pragma unroll
        for (int k2 = 0; k2 < 2; ++k2) pf[qs][k2] = pack8(s[qs][2 * k2], s[qs][2 * k2 + 1]);
    }
    __builtin_amdgcn_sched_barrier(0);
}
template <int NCT, int NQS, int VSTR>
DEVI void attn_pv(LAS unsigned char* vbase, f4 (&o)[NQS][NCT], const h8 (&pf)[NQS][2], const int nkt, const int lane) {
    const int fr = lane & 15, g = lane >> 4, q_ = fr >> 2, p_ = fr & 3;
#pragma unroll
    for (int k2 = 0; k2 < 2; ++k2) if (2 * k2 < nkt) {
#pragma unroll
        for (int ct = 0; ct < NCT; ++ct) {
            const h4 lo = trrd(vbase + (32 * k2 + 4 * g + q_) * VSTR + (16 * ct + 4 * p_) * 2);
            const h4 hi = trrd(vbase + (32 * k2 + 16 + 4 * g + q_) * VSTR + (16 * ct + 4 * p_) * 2);
            const h8 vf = cat44(lo, hi);
#pragma unroll
            for (int qs = 0; qs < NQS; ++qs) o[qs][ct] = __builtin_amdgcn_mfma_f32_16x16x32_f16(vf, pf[qs][k2], o[qs][ct], 0, 0, 0); } }
    __builtin_amdgcn_sched_barrier(0);
}
template <int NKS, int NCT, int NQS, int KSTR, int VSTR>
DEVI void attn_tile(LAS unsigned char* kbase, LAS unsigned char* vbase, const h8 (&qf)[NQS][NKS], f4 (&o)[NQS][NCT], float (&mrow)[NQS], float (&lrow)[NQS], const int nkt, const int lane) {
    h8 pf[NQS][2];
    attn_qk<NKS, NCT, NQS, KSTR>(kbase, qf, o, mrow, lrow, pf, nkt, lane);
    attn_pv<NCT, NQS, VSTR>(vbase, o, pf, nkt, lane);
}


#define XB_TMO      128
#define XB_XCNT(j)  (256  + 64 * (j))
#define XB_XSUB(j)  (1280 + 64 * (j))
#define XB_XGEN(j)  (2304 + 64 * (j))
#define XB_TOP      3328
#define XB_TOPGEN   3392
#define XCD_BAR_WORDS 3456
#define XB_SPIN_CAP (1u << 18)
DEVI unsigned xb_ld(unsigned* p)              { return __hip_atomic_load(p, __ATOMIC_RELAXED, __HIP_MEMORY_SCOPE_AGENT); }
DEVI unsigned xb_add(unsigned* p, unsigned v) { return __hip_atomic_fetch_add(p, v, __ATOMIC_RELAXED, __HIP_MEMORY_SCOPE_AGENT); }
DEVI unsigned xb_xcc_id() { return (unsigned)__builtin_amdgcn_s_getreg((3 << 11) | 20) & 0xFu; }
#define XB_SPIN(cond, bar) do { unsigned _sp = 0; while (cond) { __builtin_amdgcn_s_sleep(1); \
    if ((++_sp & 255u) == 0u) { if (xb_ld(&(bar)[XB_TMO])) break; if (_sp > XB_SPIN_CAP) { atomicAdd(&(bar)[XB_TMO], 1u); break; } } } } while (0)
DEVI void xb_complete(unsigned* bar, unsigned x, unsigned& nloc, unsigned& nx, unsigned G) {
    unsigned sum, cnt, mine, sp = 0u;
    for (;;) {
        sum = 0u; cnt = 0u; mine = 0u;
#pragma unroll
        for (unsigned j = 0; j < 16; ++j) { const unsigned c = xb_ld(&bar[XB_XCNT(j)]); sum += c; cnt += (c > 0u) ? 1u : 0u; mine = (j == x) ? c : mine; }
        if (sum == G) break;
        __builtin_amdgcn_s_sleep(1);
        if ((++sp & 255u) == 0u) { if (xb_ld(&bar[XB_TMO])) break; if (sp > XB_SPIN_CAP) { atomicAdd(&bar[XB_TMO], 1u); break; } }
    }
    nloc = mine > 0u ? mine : 1u; nx = cnt > 0u ? cnt : 1u;
}
DEVI void xbar(unsigned* bar, volatile LAS unsigned* st, int tid, unsigned G) {
    asm volatile("s_waitcnt vmcnt(0)" ::: "memory");
    __syncthreads();
    if (tid == 0) {
        const unsigned x = xb_xcc_id();
        __builtin_amdgcn_s_waitcnt(0);
        unsigned nloc = st[0], nx = st[1];
        if (nloc == 0u) { xb_complete(bar, x, nloc, nx, G); st[0] = nloc; st[1] = nx; }
        const unsigned old = xb_add(&bar[XB_XSUB(x)], 1u);
        const unsigned gen = old / nloc;
        if (old + 1u == (gen + 1u) * nloc) {
            __builtin_amdgcn_fence(__ATOMIC_RELEASE, "agent");
            asm volatile("s_waitcnt vmcnt(0)" ::: "memory");
            const unsigned og = xb_add(&bar[XB_TOP], 1u);
            const unsigned tg = og / nx;
            if (og + 1u == (tg + 1u) * nx) xb_add(&bar[XB_TOPGEN], 1u);
            else XB_SPIN(xb_ld(&bar[XB_TOPGEN]) == tg, bar);
            __builtin_amdgcn_fence(__ATOMIC_ACQUIRE, "agent");
            xb_add(&bar[XB_XGEN(x)], 1u);
            asm volatile("s_waitcnt vmcnt(0)" ::: "memory");
        } else {
            XB_SPIN(xb_ld(&bar[XB_XGEN(x)]) == gen, bar);
            __builtin_amdgcn_fence(__ATOMIC_ACQUIRE, "agent");
            asm volatile("s_waitcnt vmcnt(0)" ::: "memory");
        }
    }
    __syncthreads();
}
#ifndef PHM
#define PHM 0xFFFFFFFFu
#endif
#ifndef DBL
#define DBL 0u
#endif
#define NREP(k) (((DBL >> (k)) & 1u) ? 2 : 1)
__global__ void __launch_bounds__(512, 2) trunk_fwd(Params p) {
    extern __shared__ __attribute__((aligned(16))) unsigned char shm_raw[];
    LAS unsigned char* lds = (LAS unsigned char*)shm_raw;
    __shared__ uint4 s_ctl;
#define s_item (*(LAS int*)&s_ctl)
    cg::grid_group grid = cg::this_grid();
    const int wave_s = __builtin_amdgcn_readfirstlane((int)threadIdx.x >> 6);
    if (threadIdx.x == 0) { s_ctl = make_uint4(0u, 0u, 0u, 0u); (void)xb_add((unsigned*)(p.ws + W_BAR) + XB_XCNT(xb_xcc_id()), 1u); }
    __syncthreads();
#define GSYNC() do { const __attribute__((address_space(4))) Params* kq = (const __attribute__((address_space(4))) Params*)__builtin_amdgcn_kernarg_segment_ptr(); asm volatile("" : "+s"(kq)); \
        unsigned Gq = gridDim.x; asm volatile("" : "+s"(Gq)); xbar((unsigned*)(kq->ws + W_BAR), (volatile LAS unsigned*)&s_ctl + 1, wave_s * 64 + opaque_lane(), Gq); } while (0)
#define PH_BEGIN \
    int tid = wave_s * 64 + opaque_lane(); asm volatile("" : "+v"(tid)); \
    int bid = blockIdx.x, G = gridDim.x, lq = l; asm volatile("" : "+s"(bid), "+s"(G), "+s"(lq)); \
    const int lane = tid & 63, wave = __builtin_amdgcn_readfirstlane(tid >> 6); \
    const int gw = bid * 8 + wave, NGW = G * 8; const size_t gtid = (size_t)bid * 512 + tid, NGT = (size_t)G * 512; \
    const __attribute__((address_space(4))) Params* kp = (const __attribute__((address_space(4))) Params*)__builtin_amdgcn_kernarg_segment_ptr(); asm volatile("" : "+s"(kp)); \
    unsigned char* ws = kp->ws; float* out = kp->out; \
    (void)lane; (void)wave; (void)gw; (void)NGW; (void)gtid; (void)NGT; (void)out; (void)lq;
#define WSP(T, off) ((T*)(ws + (off)))
    for (int rep = 0; rep < NREP(0); ++rep) if (PHM & 1u) {
        int tid = wave_s * 64 + opaque_lane(); asm volatile("" : "+v"(tid));
        const int bid = blockIdx.x, G = gridDim.x, lane = tid & 63, wave = __builtin_amdgcn_readfirstlane(tid >> 6);
        const int gw = bid * 8 + wave, NGW = G * 8; const size_t gtid = (size_t)bid * 512 + tid, NGT = (size_t)G * 512;
        unsigned char* ws = p.ws;
        h16* xh = WSP(h16, W_XH); float* ropec = WSP(float, W_ROPE); float* ropes = ropec + NPOS * 16;
        for (size_t i = gtid; i < (size_t)MT * DM / 8; i += NGT) { const size_t e = i * 8; const float* src = e < (size_t)MP * DM ? p.in[0] + e : p.in[1] + (e - (size_t)MP * DM);
            *(h8*)(xh + e) = pack8(*(const f4*)src, *(const f4*)(src + 4)); }
        for (size_t i = gtid; i < (size_t)NPOS * 16; i += NGT) { const int pi = (int)(i >> 4), fi = (int)(i & 15); const double pos = pi < SEQ ? (double)pi : (double)(PAST + pi - SEQ);
            const double ang = pos * exp(-(double)fi / 16.0 * 9.210340371976184); ropec[i] = (float)cos(ang); ropes[i] = (float)sin(ang); }
        for (size_t i = gtid; i < (size_t)DEPTH * 256; i += NGT) WSP(float, W_SP)[i] = log1pf(expf(-p.in[26][i]));
        LAS float* scr = (LAS float*)(lds + wave * 8448);
        for (int l = 0; l < DEPTH; ++l) {
            h16* wt_in = WSP(h16, W_WIN + l * SZ_WIN); h16* wt_uq = WSP(h16, W_WUQ + l * SZ_WUQ); h16* wt_kv = WSP(h16, W_WKV + l * SZ_WKV);
            h16* wt_o = WSP(h16, W_WO + l * SZ_WO); h16* wt_os = WSP(h16, W_WOS + l * SZ_WOS); h16* wt_up = WSP(h16, W_WUP + l * SZ_WUP); h16* wt_dn = WSP(h16, W_WDN + l * SZ_WDN);
            h16* wt_ql = WSP(h16, W_WQL + l * SZ_WQL); h16* wt_g = WSP(h16, W_WG + l * SZ_WG);
            const float* w_in = p.in[11] + (size_t)l * DM * DIN; const float* w_o = p.in[12] + (size_t)l * DM * DM; const float* w_uq = p.in[16] + (size_t)l * 384 * 768;
            const float* w_uk = p.in[18] + (size_t)l * 256 * 512; const float* w_uv = p.in[19] + (size_t)l * 256 * 512; const float* w_up = p.in[27] + (size_t)l * DM * DFF2; const float* w_dn = p.in[30] + (size_t)l * DFF * DM;
            const float* w_r = p.in[22] + (size_t)l * 4 * 64 * 64; const float* w_i = p.in[24] + (size_t)l * 4 * 64 * 64;
            for (int it = gw; it < 16 * 53; it += NGW) transpose_item<0>(w_in, DIN, 53, wt_in, 1024, scr, it, lane, l > 0 ? p.in[9] + (l - 1) * DM : nullptr, l > 0 ? p.in[10] + (l - 1) * DM : nullptr, WSP(float, W_CD + l * SZ_CD), WSP(float, W_CD + l * SZ_CD) + ZW);
            for (int it = gw; it < 6 * 24; it += NGW) transpose_item<1>(w_uq, 768, 24, wt_uq, 384, scr, it, lane);
            for (int it = gw; it < 4 * 16; it += NGW) transpose_item<0>(w_uk, 512, 16, wt_kv, 256, scr, it, lane);
            for (int it = gw; it < 4 * 16; it += NGW) transpose_item<0>(w_uv, 512, 16, wt_kv + 512 * 256, 256, scr, it, lane);
            for (int it = gw; it < 16 * 32; it += NGW) transpose_item<0>(w_o, 1024, 32, wt_o, 1024, scr, it, lane);
            for (int it = gw; it < 16 * 176; it += NGW) transpose_item<0>(w_up, DFF2, 176, wt_up, 1024, scr, it, lane, p.in[7] + l * DM, p.in[8] + l * DM, WSP(float, W_CD + l * SZ_CD) + 2 * ZW, WSP(float, W_CD + l * SZ_CD) + 2 * ZW + DFF2);
            for (int it = gw; it < 44 * 32; it += NGW) transpose_item<0>(w_dn, 1024, 32, wt_dn, DFF, scr, it, lane);
            for (size_t i = gtid; i < (size_t)(ZW - DIN) * 1024 / 8; i += NGT) *(h8*)(wt_in + (size_t)DIN * 1024 + i * 8) = (h8){0, 0, 0, 0, 0, 0, 0, 0};
            for (size_t i = gtid; i < (size_t)512 * 256; i += NGT) { const int n = (int)(i >> 8), k = (int)(i & 255); const int pn = n >> 8, jj = n & 127, isI = (n >> 7) & 1, ch = pn * 128 + jj;
                float v = 0.f; if ((k >> 6) == (ch >> 6)) v = (isI ? w_i : w_r)[((ch >> 6) * 64 + (k & 63)) * 64 + (ch & 63)];
                wt_g[i] = (h16)v; }
            for (int it = gw; it < 8 * 24 * 16; it += NGW) { const int hh = it / (24 * 16), kt = (it / 16) % 24, ct = it % 16, fr = lane & 15, g4 = lane >> 4;
                f4 accq = (f4){0.f, 0.f, 0.f, 0.f};
#pragma unroll
                for (int ks = 0; ks < 2; ++ks) { const float* ap = w_uq + (size_t)(16 * kt + fr) * 768 + hh * 96 + 32 * ks + 8 * g4; const float* bp = w_uk + (size_t)(16 * ct + fr) * 512 + hh * 64 + 32 * ks + 8 * g4;
                    accq = __builtin_amdgcn_mfma_f32_16x16x32_f16(pack8(*(const f4*)ap, *(const f4*)(ap + 4)), pack8(*(const f4*)bp, *(const f4*)(bp + 4)), accq, 0, 0, 0); }
                *(h4*)(wt_ql + (size_t)(hh * 256 + 16 * ct + fr) * 384 + 16 * kt + 4 * g4) = pack4(accq); }
            for (size_t i = gtid; i < (size_t)8 * 64 * 256; i += NGT) { const int c = (int)(i & 255), hd = (int)(i >> 8); wt_os[i] = (h16)w_uv[(size_t)c * 512 + hd]; }
        }
    }
    grid.sync();

    for (int l = 0; l < DEPTH; ++l) {
        for (int rep = 0; rep < NREP(1); ++rep) if (PHM & (1u << 1)) { PH_BEGIN
          Gemm g{WSP(h16, W_XH), WSP(h16, W_WIN + lq * SZ_WIN), MT, ZW, 1024, 1024, 1024}; StaticOrder S; S.init(MT, ZW, G, bid); const int lp = lq > 0 ? lq - 1 : 0; EpiZ E{WSP(h16, W_Z), out + O_SV + (size_t)lq * MS * 256, WSP(float, W_STATS + (size_t)(lp * 2 + 1) * SZ_STATS), WSP(float, W_CD + lq * SZ_CD), WSP(float, W_CD + lq * SZ_CD) + ZW, lq > 0}; gemm_phase(lds, g, S, E, tid); }
        GSYNC();

        for (int rep = 0; rep < NREP(2); ++rep) if (PHM & (1u << 2)) { PH_BEGIN
            const float* qn_g = kp->in[15] + lq * 384; const float* kvn_g = kp->in[17] + lq * 256;
            const float* cw = kp->in[20] + (size_t)lq * 4 * 256; const float* cb = kp->in[21] + lq * 256; const float* stc = kp->in[5] + (size_t)lq * DBATCH * 3 * 256;
            const h16* z = WSP(h16, W_Z); h16* cqn = WSP(h16, W_CQN); h16* ckvn = WSP(h16, W_CKVN); h16* knew = WSP(h16, W_KNEW); h16* kb = WSP(h16, W_K); h16* xc = WSP(h16, W_XC);
            const float* ropec = WSP(float, W_ROPE); const float* ropes = ropec + NPOS * 16;
            for (int row = gw; row < MT; row += NGW) {
                const h16* zr = z + (size_t)row * ZW; const bool samp = row >= MP; const int rs = row - MP;
                const int t = samp ? (rs & 31) : (row & (SEQ - 1)), bb = samp ? (rs >> 5) : (row >> 11);
                { float v[6]; float ss = 0.f;
#pragma unroll
                    for (int i = 0; i < 3; ++i) { const h2 x = *(const h2*)(zr + 512 + 2 * lane + 128 * i); v[2 * i] = (float)x[0]; v[2 * i + 1] = (float)x[1]; ss += v[2 * i] * v[2 * i] + v[2 * i + 1] * v[2 * i + 1]; }
                    const float rr = rsqrtf(wave_sum(ss, lane) * (1.f / 384.f) + 1e-6f);
#pragma unroll
                    for (int i = 0; i < 3; ++i) { const int c = 2 * lane + 128 * i; h2 o; o[0] = (h16)(v[2 * i] * rr * qn_g[c]); o[1] = (h16)(v[2 * i + 1] * rr * qn_g[c + 1]); *(h2*)(cqn + (size_t)row * 384 + c) = o; } }
                { const h4 x = *(const h4*)(zr + 896 + 4 * lane); f4 v; float ss = 0.f;
#pragma unroll
                    for (int e = 0; e < 4; ++e) { v[e] = (float)x[e]; ss += v[e] * v[e]; }
                    const float rr = rsqrtf(wave_sum(ss, lane) * (1.f / 256.f) + 1e-6f); const f4 gg = *(const f4*)(kvn_g + 4 * lane); v = v * rr * gg;
                    if (!samp) { *(f4*)(out + O_PLAT + ((size_t)lq * MP + row) * 256 + 4 * lane) = v; *(h4*)(ckvn + (size_t)row * 256 + 4 * lane) = pack4(v); }
                    else { *(f4*)(out + O_SLAT + ((size_t)lq * MS + rs) * 256 + 4 * lane) = v; *(h4*)(knew + (size_t)rs * KNW + 4 * lane) = pack4(v); } }
                if (lane < 16) { const int pidx = samp ? SEQ + t : t; const float c = ropec[pidx * 16 + lane], s = ropes[pidx * 16 + lane];
                    const float x1 = (float)zr[1152 + lane], x2 = (float)zr[1168 + lane], o1 = x1 * c - x2 * s, o2 = x1 * s + x2 * c;
                    if (!samp) { float* o = out + O_PKR + ((size_t)lq * MP + row) * 32; o[lane] = o1; o[16 + lane] = o2;
                        h16* kr = kb + (size_t)row * KW + 64;
#pragma unroll
                        for (int hh = 0; hh < 8; ++hh) { kr[hh * 96 + lane] = (h16)o1; kr[hh * 96 + 16 + lane] = (h16)o2; } }
                    else { float* o = out + O_SKR + ((size_t)lq * MS + rs) * 32; o[lane] = o1; o[16 + lane] = o2; knew[(size_t)rs * KNW + 256 + lane] = (h16)o1; knew[(size_t)rs * KNW + 272 + lane] = (h16)o2; } }
                { const int c = 4 * lane; f4 accv = *(const f4*)(cb + c);
#pragma unroll
                    for (int j = 0; j < 4; ++j) { const int tau = t - 3 + j; f4 xv;
                        if (tau >= 0) { const h4 x = *(const h4*)(zr - (ptrdiff_t)(3 - j) * ZW + 1184 + c); xv = (f4){(float)x[0], (float)x[1], (float)x[2], (float)x[3]}; }
                        else if (samp) xv = *(const f4*)(stc + ((size_t)bb * 3 + (3 + tau)) * 256 + c);
                        else xv = (f4){0.f, 0.f, 0.f, 0.f};
                        accv += xv * *(const f4*)(cw + j * 256 + c);
                        if (j == 3) { const int T = samp ? DSEQ : SEQ; if (t >= T - 3) { float* o = samp ? out + O_SLC + (((size_t)lq * DBATCH + bb) * 3 + (t - (T - 3))) * 256 : out + O_PLC + (((size_t)lq * NB + bb) * 3 + (t - (T - 3))) * 256; *(f4*)(o + c) = xv; } } }
                    *(h4*)(xc + (size_t)row * 256 + c) = pack4(accv); }
            }
        }
        GSYNC();

        for (int rep = 0; rep < NREP(3); ++rep) if (PHM & (1u << 3)) { PH_BEGIN
          Gemm g{WSP(h16, W_CQN), WSP(h16, W_WUQ + lq * SZ_WUQ), MT, 768, 384, 384, 384}; StaticOrder S; S.init(MT, 768, G, bid);
          EpiQ E{WSP(h16, W_Q), WSP(h16, W_QLAT), WSP(float, W_ROPE), WSP(float, W_ROPE) + NPOS * 16}; gemm_phase(lds, g, S, E, tid); }
        for (int rep = 0; rep < NREP(4); ++rep) if (PHM & (1u << 4)) { PH_BEGIN
          Gemm g{WSP(h16, W_CKVN), WSP(h16, W_WKV + lq * SZ_WKV), MP, 1024, 256, 256, 256}; StaticOrder S; S.init(MP, 1024, G, (bid + G - (396 % G)) % G); EpiKV E{WSP(h16, W_K), WSP(h16, W_V)}; gemm_phase(lds, g, S, E, tid); }
        for (int rep = 0; rep < NREP(5); ++rep) if (PHM & (1u << 5)) { PH_BEGIN
          Gemm g{WSP(h16, W_XC), WSP(h16, W_WG + lq * SZ_WG), MT, 512, 256, 256, 256}; StaticOrder S; S.init(MT, 512, G, (bid + G - (908 % G)) % G);
          EpiGate E{WSP(h16, W_XC), WSP(float, W_A), WSP(float, W_B), kp->in[23] + lq * 256, kp->in[25] + lq * 256, WSP(float, W_SP) + lq * 256}; gemm_phase(lds, g, S, E, tid); }
        for (int rep = 0; rep < NREP(6); ++rep) if (PHM & (1u << 6)) { PH_BEGIN
          Gemm g{WSP(h16, W_CQN) + (size_t)MP * 384, WSP(h16, W_WQL + lq * SZ_WQL), MS, 2048, 384, 384, 384}; StaticOrder S; S.init(MS, 2048, G, (bid + G - (1172 % G)) % G); EpiQlat E{WSP(h16, W_QLAT)}; gemm_phase(lds, g, S, E, tid); }
        for (int rep = 0; rep < NREP(7); ++rep) if (PHM & (1u << 7)) { PH_BEGIN
            const float* gw_s = kp->in[13] + (size_t)lq * 4 * 128 * 128; const float* gb_s = kp->in[14] + (size_t)lq * 4 * 128;
            const h16* z = WSP(h16, W_Z); h16* cat = WSP(h16, W_CAT); h16* cats = WSP(h16, W_CATS);
            const int fr = lane & 15, g4 = lane >> 4, q_ = fr >> 2, p_ = fr & 3;
            for (int item = (bid + G - (1204 % G)) % G; item < 1024 + 128; item += G) {
                const bool samp = item >= 1024; const int head = item & 3; const int ci = samp ? (item - 1024) >> 2 : item >> 2;
                const int R0 = samp ? MP + ci * 32 : ci * 128, L = samp ? 32 : 128;
                __syncthreads();
                for (int id = tid; id < L * 8; id += 512) { const int j = id >> 3, part = id & 7; *(LAS h8*)(lds + j * 144 + part * 16) = *(const h8*)(z + (size_t)(R0 + j) * ZW + 256 + head * 64 + part * 8); }
                __syncthreads();
                const int i0 = 16 * wave;
                if (i0 < L) {
                    f4 sacc[4];
#pragma unroll
                    for (int ct = 0; ct < 4; ++ct) sacc[ct] = (f4){0.f, 0.f, 0.f, 0.f};
                    const int i = i0 + fr;
#pragma unroll
                    for (int ks = 0; ks < 4; ++ks) if (32 * ks <= i0 + 15 && 32 * ks < L) {
                        const int j0 = 32 * ks + 8 * g4; const float* wp = gw_s + ((size_t)head * 128 + i) * 128 + j0; const f4 w0 = *(const f4*)wp, w1 = *(const f4*)(wp + 4);
                        h8 wf;
#pragma unroll
                        for (int e = 0; e < 4; ++e) { wf[e] = (h16)((j0 + e <= i) ? w0[e] : 0.f); wf[4 + e] = (h16)((j0 + 4 + e <= i) ? w1[e] : 0.f); }
#pragma unroll
                        for (int ct = 0; ct < 4; ++ct) { const h4 lo = trrd(lds + (32 * ks + 8 * g4 + q_) * 144 + (16 * ct + 4 * p_) * 2), hi = trrd(lds + (32 * ks + 8 * g4 + 4 + q_) * 144 + (16 * ct + 4 * p_) * 2);
                            sacc[ct] = __builtin_amdgcn_mfma_f32_16x16x32_f16(wf, cat44(lo, hi), sacc[ct], 0, 0, 0); } }
#pragma unroll
                    for (int jx = 0; jx < 4; ++jx) { const int ii = i0 + 4 * g4 + jx; const float bs = gb_s[head * 128 + ii]; const size_t r = (size_t)R0 + ii;
#pragma unroll
                        for (int ct = 0; ct < 4; ++ct) { const int d = head * 64 + 16 * ct + fr; const float uval = (float)z[r * ZW + d]; const h16 o = (h16)(uval * (sacc[ct][jx] + bs));
                            cat[r * 1024 + d] = o; } }
                }
            }
            __syncthreads();
        }
        GSYNC();

        for (int rep = 0; rep < NREP(8); ++rep) if (PHM & (1u << 8)) { PH_BEGIN
            unsigned* counter = WSP(unsigned, W_CTR) + lq * 16 + rep * 8;
            const int fr = lane & 15, g4 = lane >> 4;
            constexpr int N_SA = 256, N_PA = 1024, N_PS = 128, N_SS = 16, N_ALL = N_SA + N_PA + N_PS + N_SS;
            for (;;) {
                __syncthreads();
                if (tid == 0) s_item = (int)atomicAdd(counter, 1u);
                __syncthreads();
                const int qi = s_item;
                if (qi >= N_ALL) break;
                int tix = tid; asm volatile("" : "+v"(tix));
                const int item = qi < N_PS + N_SS ? qi + N_SA + N_PA : qi - (N_PS + N_SS);
                if (item < N_SA) {
                    constexpr int KS = 592;
                    const float* clat = kp->in[2] + (size_t)lq * DBATCH * PAST * 256; const float* ckr = kp->in[3] + (size_t)lq * DBATCH * PAST * 32;
                    const h16* qlat = WSP(h16, W_QLAT); const h16* knew = WSP(h16, W_KNEW); h16* cats = WSP(h16, W_CATS);
                    const int b = item >> 3, hg = (item >> 2) & 1, sp = item & 3, head = 4 * hg + (wave >> 1), tq = 16 * (wave & 1) + fr, t0 = sp * 16;
                    h8 qf[1][9];
#pragma unroll
                    for (int ks = 0; ks < 9; ++ks) qf[0][ks] = *(const h8*)(qlat + (size_t)(b * 32 + tq) * QLW + head * 288 + 32 * ks + 8 * g4);
                    f4 o[1][16]; float mrow[1] = {-1e30f}, lrow[1] = {0.f};
#pragma unroll
                    for (int ct = 0; ct < 16; ++ct) o[0][ct] = (f4){0.f, 0.f, 0.f, 0.f};
                    const float* lb = clat + (size_t)b * PAST * 256 + (size_t)(t0 * 64 + (tix >> 6)) * 256 + (tix & 63) * 4; const float* rb = ckr + (size_t)b * PAST * 32 + (size_t)(t0 * 64 + (tix >> 3)) * 32 + (tix & 7) * 4;
                    const int wl = (tix >> 6) * KS + (tix & 63) * 8, wr_ = (tix >> 3) * KS + 512 + (tix & 7) * 8;
                    f4 pl[4]; f4 pr;
#pragma unroll
                    for (int hf = 0; hf < 2; ++hf) {
#pragma unroll
                        for (int i = 0; i < 4; ++i) pl[i] = *(const f4*)(lb + (size_t)(hf * 4 + i) * 8 * 256);
#pragma unroll
                        for (int i = 0; i < 4; ++i) *(LAS h4*)(lds + wl + (hf * 4 + i) * 8 * KS) = pack4(pl[i]); }
                    pr = *(const f4*)rb;
                    *(LAS h4*)(lds + wr_) = pack4(pr);
                    __syncthreads();
                    for (int t = 0; t < 16; ++t) {
                        LAS unsigned char* cur = lds + (t & 1) * (64 * KS); LAS unsigned char* nxt = lds + ((t + 1) & 1) * (64 * KS);
                        const bool more = t + 1 < 16;
                        if (more) {
#pragma unroll
                            for (int i = 0; i < 4; ++i) pl[i] = *(const f4*)(lb + ((size_t)(t + 1) * 64 + i * 8) * 256);
                            pr = *(const f4*)(rb + (size_t)(t + 1) * 64 * 32);
                        }
                        h8 pf[1][2];
                        attn_qk<9, 16, 1, KS>(cur, qf, o, mrow, lrow, pf, 4, lane);
                        if (more) {
#pragma unroll
                            for (int i = 0; i < 4; ++i) *(LAS h4*)(nxt + wl + i * 8 * KS) = pack4(pl[i]);
                            *(LAS h4*)(nxt + wr_) = pack4(pr);
#pragma unroll
                            for (int i = 0; i < 4; ++i) pl[i] = *(const f4*)(lb + ((size_t)(t + 1) * 64 + (4 + i) * 8) * 256);
                        }
                        attn_pv<16, 1, KS>(cur, o, pf, 4, lane);
                        if (more) {
#pragma unroll
                            for (int i = 0; i < 4; ++i) *(LAS h4*)(nxt + wl + (4 + i) * 8 * KS) = pack4(pl[i]);
                        } else if (sp == 3) {
                            for (int id = tix; id < 32 * 36; id += 512) { const int key = id / 36, part = id % 36; *(LAS h8*)(nxt + key * KS + part * 16) = *(const h8*)(knew + (size_t)(b * 32 + key) * KNW + part * 8); }
                        }
                        __syncthreads();
                    }
                    if (sp == 3) attn_tile<9, 16, 1, KS, KS>(lds, lds, qf, o, mrow, lrow, 2, lane);
                    { unsigned char* pw = ws + W_PART + ((size_t)item * 8 + wave) * SZ_PARTW;
#pragma unroll
                      for (int ct = 0; ct < 16; ++ct) *(f4*)(pw + ct * 1024 + lane * 16) = o[0][ct];
                      *(float*)(pw + 16384 + lane * 4) = mrow[0]; *(float*)(pw + 16640 + lane * 4) = lrow[0]; }
                    asm volatile("s_waitcnt vmcnt(0)" ::: "memory");
                    __syncthreads();
                    if (tix == 0) { __builtin_amdgcn_fence(__ATOMIC_RELEASE, "agent"); asm volatile("s_waitcnt vmcnt(0)" ::: "memory");
                        const unsigned old = xb_add(WSP(unsigned, W_CTR) + 256 + lq * 64 + rep * 512 + (item >> 2), 1u);
                        if (old == 3u) { __builtin_amdgcn_fence(__ATOMIC_ACQUIRE, "agent"); asm volatile("s_waitcnt vmcnt(0)" ::: "memory"); }
                        *((LAS int*)&s_ctl + 3) = (int)old; }
                    __syncthreads();
                    if (*((LAS int*)&s_ctl + 3) == 3) {
                        const unsigned char* p0 = ws + W_PART + ((size_t)(item & ~3) * 8 + wave) * SZ_PARTW;
                        float mi[4], M = -1e30f;
#pragma unroll
                        for (int i = 0; i < 4; ++i) { mi[i] = *(const float*)(p0 + (size_t)i * 8 * SZ_PARTW + 16384 + lane * 4); M = fmaxf(M, mi[i]); }
                        float L = 0.f;
#pragma unroll
                        for (int i = 0; i < 4; ++i) { mi[i] = __builtin_amdgcn_exp2f(mi[i] - M); L += mi[i] * *(const float*)(p0 + (size_t)i * 8 * SZ_PARTW + 16640 + lane * 4); }
                        L += shx(L, 16, lane); L += shx(L, 32, lane); const float inv = 1.f / L;
                        h8 bf[8];
#pragma unroll
                        for (int ks = 0; ks < 8; ++ks) { f4 u0 = (f4){0.f, 0.f, 0.f, 0.f}, u1 = u0;
#pragma unroll
                            for (int i = 0; i < 4; ++i) { u0 += *(const f4*)(p0 + (size_t)i * 8 * SZ_PARTW + (2 * ks) * 1024 + lane * 16) * mi[i]; u1 += *(const f4*)(p0 + (size_t)i * 8 * SZ_PARTW + (2 * ks + 1) * 1024 + lane * 16) * mi[i]; }
                            bf[ks] = pack8(u0 * inv, u1 * inv); }
                        const h16* wuvt = WSP(h16, W_WOS + lq * SZ_WOS) + (size_t)head * 64 * 256;
                        h16* dst = cats + (size_t)(b * 32 + tq) * 1024 + 256 + head * 64 + 4 * g4;
#pragma unroll
                        for (int dt = 0; dt < 4; ++dt) { f4 od = (f4){0.f, 0.f, 0.f, 0.f};
#pragma unroll
                            for (int ks = 0; ks < 8; ++ks) { const h16* wp = wuvt + (size_t)(16 * dt + fr) * 256 + 32 * ks + 4 * g4;
                                od = __builtin_amdgcn_mfma_f32_16x16x32_f16(cat44(*(const h4*)wp, *(const h4*)(wp + 16)), bf[ks], od, 0, 0, 0); }
                            *(h4*)(dst + 16 * dt) = pack4(od); }
                    }
                } else if (item < N_SA + N_PA) {
                    constexpr int KS = 208, VS = 144, KBUF = 64 * KS, VBUF = 64 * VS;
                    const h16* qb = WSP(h16, W_Q); const h16* kb = WSP(h16, W_K); const h16* vb = WSP(h16, W_V); h16* cat = WSP(h16, W_CAT);
                    const int it = item - N_SA, qblk = 7 - (it >> 7), bh = it & 127, b = bh >> 3, head = bh & 7;
                    const int r0 = qblk * 256 + 32 * wave, ntw = (r0 >> 6) + 1, ntb = 4 * (qblk + 1);
                    h8 qf[2][3];
#pragma unroll
                    for (int qs = 0; qs < 2; ++qs)
#pragma unroll
                        for (int ks = 0; ks < 3; ++ks) qf[qs][ks] = *(const h8*)(qb + (size_t)(b * SEQ + r0 + 16 * qs + fr) * QW + head * 96 + 32 * ks + 8 * g4);
                    f4 o[2][4]; float mrow[2] = {-1e30f, -1e30f}, lrow[2] = {0.f, 0.f};
#pragma unroll
                    for (int qs = 0; qs < 2; ++qs)
#pragma unroll
                        for (int ct = 0; ct < 4; ++ct) o[qs][ct] = (f4){0.f, 0.f, 0.f, 0.f};
                    const int k0key = tix / 12, k0part = tix % 12, k1key = (tix + 512) / 12, k1part = (tix + 512) % 12, vkey = tix >> 3, vpart = tix & 7;
                    const h16* kg0 = kb + (size_t)b * SEQ * KW + head * 96 + (size_t)k0key * KW + k0part * 8; const h16* kg1 = kb + (size_t)b * SEQ * KW + head * 96 + (size_t)k1key * KW + k1part * 8;
                    const h16* vg = vb + (size_t)b * SEQ * VW + head * 64 + (size_t)vkey * VW + vpart * 8;
                    const int lk0 = k0key * KS + k0part * 16, lk1 = k1key * KS + k1part * 16, lv = 2 * KBUF + vkey * VS + vpart * 16;
                    h8 pk0, pk1 = (h8){0, 0, 0, 0, 0, 0, 0, 0}, pv;
                    pk0 = *(const h8*)kg0; if (tix < 256) pk1 = *(const h8*)kg1; pv = *(const h8*)vg;
                    *(LAS h8*)(lds + lk0) = pk0; if (tix < 256) *(LAS h8*)(lds + lk1) = pk1; *(LAS h8*)(lds + lv) = pv;
                    __syncthreads();
                    for (int t = 0; t < ntb; ++t) {
                        const int co = (t & 1), no = ((t + 1) & 1);
                        if (t + 1 < ntb) { const size_t ro = (size_t)(t + 1) * 64;
                            pk0 = *(const h8*)(kg0 + ro * KW); if (tix < 256) pk1 = *(const h8*)(kg1 + ro * KW); pv = *(const h8*)(vg + ro * VW); }
                        if (t < ntw) attn_tile<3, 4, 2, KS, VS>(lds + co * KBUF, lds + 2 * KBUF + co * VBUF, qf, o, mrow, lrow, 4, lane);
                        if (t + 1 < ntb) { *(LAS h8*)(lds + no * KBUF + lk0) = pk0; if (tix < 256) *(LAS h8*)(lds + no * KBUF + lk1) = pk1; *(LAS h8*)(lds + no * VBUF + lv) = pv; }
                        __syncthreads();
                    }
#pragma unroll
                    for (int qs = 0; qs < 2; ++qs) { float lt = lrow[qs]; lt += shx(lt, 16, lane); lt += shx(lt, 32, lane); const float inv = 1.f / lt;
                        h16* dst = cat + (size_t)(b * SEQ + r0 + 16 * qs + fr) * 1024 + 256 + head * 64 + 4 * g4;
#pragma unroll
                        for (int ct = 0; ct < 4; ++ct) *(h4*)(dst + 16 * ct) = pack4(o[qs][ct] * inv); }
                } else if (item < N_SA + N_PA + N_PS) {
                    const float* abuf = WSP(float, W_A); const float* bbuf = WSP(float, W_B); const h16* z = WSP(h16, W_Z); h16* cat = WSP(h16, W_CAT);
                    const int it = item - N_SA - N_PA, b = it >> 3, ch = (it & 7) * 32 + (lane & 31), seg = wave * 2 + (lane >> 5), tl = seg * 32 + (lane & 31);
                    const size_t rbase = (size_t)b * SEQ + seg * 128;
                    float A = 1.f, B = 0.f;
#pragma unroll 16
                    for (int i = 0; i < 128; ++i) { const float a = abuf[(rbase + i) * 256 + ch], bb = bbuf[(rbase + i) * 256 + ch]; B = a * B + bb; A *= a; }
                    LAS float* sA = (LAS float*)lds; LAS float* sB = sA + 512;
                    sA[tl] = A; sB[tl] = B;
                    __syncthreads();
                    float h = 0.f;
                    for (int s2 = 0; s2 < seg; ++s2) h = sA[s2 * 32 + (lane & 31)] * h + sB[s2 * 32 + (lane & 31)];
#pragma unroll 16
                    for (int i = 0; i < 128; ++i) { const float a = abuf[(rbase + i) * 256 + ch], bb = bbuf[(rbase + i) * 256 + ch]; h = a * h + bb;
                        const float gt = (float)z[(rbase + i) * ZW + 1440 + ch]; cat[(rbase + i) * 1024 + 768 + ch] = (h16)(h * gt); }
                    if (seg == 15) out[O_PH + ((size_t)lq * NB + b) * 256 + ch] = h;
                } else {
                    const float* abuf = WSP(float, W_A); const float* bbuf = WSP(float, W_B); const h16* z = WSP(h16, W_Z); h16* cats = WSP(h16, W_CATS);
                    const int it = item - N_SA - N_PA - N_PS, idx = it * 512 + tix, b = idx >> 8, ch = idx & 255;
                    float h = kp->in[4][((size_t)lq * DBATCH + b) * 256 + ch];
                    for (int t = 0; t < DSEQ; ++t) { const size_t r = (size_t)MP + b * 32 + t; h = abuf[r * 256 + ch] * h + bbuf[r * 256 + ch];
                        const float gt = (float)z[r * ZW + 1440 + ch]; cats[(size_t)(b * 32 + t) * 1024 + 768 + ch] = (h16)(h * gt); }
                    out[O_SH + ((size_t)lq * DBATCH + b) * 256 + ch] = h;
                }
            }
        }
        GSYNC();

        for (int rep = 0; rep < NREP(9); ++rep) if (PHM & (1u << 9)) { PH_BEGIN
          const int lp = lq > 0 ? lq - 1 : 0;
          Gemm g{WSP(h16, W_CAT), WSP(h16, W_WO + lq * SZ_WO), MT, 1024, 1024, 1024, 1024}; StaticOrder S; S.init(MT, 1024, G, bid);
          EpiRes E{WSP(h16, W_XH), WSP(float, W_STATS + (size_t)(lp * 2 + 1) * SZ_STATS), kp->in[9] + lp * DM, kp->in[10] + lp * DM, lq > 0, WSP(float, W_STATS + (size_t)(lq * 2) * SZ_STATS)}; gemm_phase(lds, g, S, E, tid); }
        GSYNC();

        for (int rep = 0; rep < NREP(12); ++rep) if (PHM & (1u << 12)) { PH_BEGIN
          Gemm g{WSP(h16, W_XH), WSP(h16, W_WUP + lq * SZ_WUP), MT, DFF2, 1024, 1024, 1024}; StaticOrder S; S.init(MT, DFF2, G, bid);
          EpiUp E{WSP(h16, W_UP), out + O_PFC + (size_t)lq * NB * 2 * DFF2, (O_SFC + (size_t)lq * DBATCH * 2 * DFF2) - (O_PFC + (size_t)lq * NB * 2 * DFF2), WSP(float, W_STATS + (size_t)(lq * 2) * SZ_STATS), WSP(float, W_CD + lq * SZ_CD) + 2 * ZW, WSP(float, W_CD + lq * SZ_CD) + 2 * ZW + DFF2}; gemm_phase(lds, g, S, E, tid); }
        GSYNC();

        for (int rep = 0; rep < NREP(13); ++rep) if (PHM & (1u << 13)) { PH_BEGIN
            const float* fw = kp->in[28] + (size_t)lq * 3 * DFF2; const float* fb = kp->in[29] + (size_t)lq * DFF2; const float* stf = kp->in[6] + (size_t)lq * DBATCH * 2 * DFF2;
            const h16* up = WSP(h16, W_UP); h16* act = WSP(h16, W_ACT);
            constexpr int RSEG = 32, NCG = DFF / 8;
            for (unsigned it = (unsigned)gtid; it < (unsigned)(NCG * (MT / RSEG)); it += (unsigned)NGT) { const int seg = (int)(it / (unsigned)NCG), cg = (int)(it - (unsigned)seg * NCG), j0 = cg * 8, row0 = seg * RSEG;
                const bool samp = row0 >= MP; const int t0 = samp ? 0 : (row0 & (SEQ - 1)), bb = (row0 - MP) >> 5;
                const f4 bg0 = *(const f4*)(fb + j0), bg1 = *(const f4*)(fb + j0 + 4), bv0 = *(const f4*)(fb + DFF + j0), bv1 = *(const f4*)(fb + DFF + j0 + 4);
                f4 wg0[3], wg1[3], wv0[3], wv1[3];
#pragma unroll
                for (int j = 0; j < 3; ++j) { const float* wj = fw + (size_t)j * DFF2; wg0[j] = *(const f4*)(wj + j0); wg1[j] = *(const f4*)(wj + j0 + 4); wv0[j] = *(const f4*)(wj + DFF + j0); wv1[j] = *(const f4*)(wj + DFF + j0 + 4); }
                f4 ag0, ag1, av0, av1, bg0_, bg1_, bv0_, bv1_;
                if (t0 > 0) { const h16* u2 = up + (size_t)(row0 - 2) * DFF2; const h16* u1 = u2 + DFF2;
                    const h8 a = *(const h8*)(u2 + j0), c = *(const h8*)(u2 + DFF + j0), d = *(const h8*)(u1 + j0), e = *(const h8*)(u1 + DFF + j0);
                    ag0 = (f4){(float)a[0], (float)a[1], (float)a[2], (float)a[3]}; ag1 = (f4){(float)a[4], (float)a[5], (float)a[6], (float)a[7]};
                    av0 = (f4){(float)c[0], (float)c[1], (float)c[2], (float)c[3]}; av1 = (f4){(float)c[4], (float)c[5], (float)c[6], (float)c[7]};
                    bg0_ = (f4){(float)d[0], (float)d[1], (float)d[2], (float)d[3]}; bg1_ = (f4){(float)d[4], (float)d[5], (float)d[6], (float)d[7]};
                    bv0_ = (f4){(float)e[0], (float)e[1], (float)e[2], (float)e[3]}; bv1_ = (f4){(float)e[4], (float)e[5], (float)e[6], (float)e[7]}; }
                else if (samp) { const float* s2 = stf + (size_t)bb * 2 * DFF2; const float* s1 = s2 + DFF2;
                    ag0 = *(const f4*)(s2 + j0); ag1 = *(const f4*)(s2 + j0 + 4); av0 = *(const f4*)(s2 + DFF + j0); av1 = *(const f4*)(s2 + DFF + j0 + 4);
                    bg0_ = *(const f4*)(s1 + j0); bg1_ = *(const f4*)(s1 + j0 + 4); bv0_ = *(const f4*)(s1 + DFF + j0); bv1_ = *(const f4*)(s1 + DFF + j0 + 4); }
                else { ag0 = ag1 = av0 = av1 = bg0_ = bg1_ = bv0_ = bv1_ = (f4){0.f, 0.f, 0.f, 0.f}; }
                const h16* ur = up + (size_t)row0 * DFF2 + j0; h16* ar = act + (size_t)row0 * DFF + j0;
#pragma unroll 4
                for (int r = 0; r < RSEG; ++r) { const h8 a = *(const h8*)(ur + (size_t)r * DFF2), c = *(const h8*)(ur + (size_t)r * DFF2 + DFF);
                    const f4 cg0 = (f4){(float)a[0], (float)a[1], (float)a[2], (float)a[3]}, cg1 = (f4){(float)a[4], (float)a[5], (float)a[6], (float)a[7]};
                    const f4 cv0 = (f4){(float)c[0], (float)c[1], (float)c[2], (float)c[3]}, cv1 = (f4){(float)c[4], (float)c[5], (float)c[6], (float)c[7]};
                    const f4 g0 = bg0 + ag0 * wg0[0] + bg0_ * wg0[1] + cg0 * wg0[2], g1 = bg1 + ag1 * wg1[0] + bg1_ * wg1[1] + cg1 * wg1[2];
                    const f4 v0 = bv0 + av0 * wv0[0] + bv0_ * wv0[1] + cv0 * wv0[2], v1 = bv1 + av1 * wv1[0] + bv1_ * wv1[1] + cv1 * wv1[2];
                    h8 o;
#pragma unroll
                    for (int e = 0; e < 4; ++e) { o[e] = (h16)(gelu_f(g0[e]) * v0[e]); o[4 + e] = (h16)(gelu_f(g1[e]) * v1[e]); }
                    *(h8*)(ar + (size_t)r * DFF) = o;
                    ag0 = bg0_; ag1 = bg1_; av0 = bv0_; av1 = bv1_; bg0_ = cg0; bg1_ = cg1; bv0_ = cv0; bv1_ = cv1; } }
        }
        GSYNC();

        for (int rep = 0; rep < NREP(14); ++rep) if (PHM & (1u << 14)) { PH_BEGIN
          Gemm g{WSP(h16, W_ACT), WSP(h16, W_WDN + lq * SZ_WDN), MT, 1024, DFF, DFF, DFF}; StaticOrder S; S.init(MT, 1024, G, bid); EpiRes E{WSP(h16, W_XH), WSP(float, W_STATS + (size_t)(lq * 2) * SZ_STATS), kp->in[7] + lq * DM, kp->in[8] + lq * DM, true, WSP(float, W_STATS + (size_t)(lq * 2 + 1) * SZ_STATS)}; gemm_phase(lds, g, S, E, tid); }
        GSYNC();

    }
    { const int l = DEPTH - 1; PH_BEGIN
        const float* gg = kp->in[9] + lq * DM; const float* bb = kp->in[10] + lq * DM; const h16* pre2 = WSP(h16, W_XH); const float* st = WSP(float, W_STATS + (size_t)(lq * 2 + 1) * SZ_STATS);
        for (size_t i = gtid; i < (size_t)MT * (DM / 4); i += NGT) { const int row = (int)(i >> 8), c = (int)(i & 255) * 4;
            const float sm = st[2 * row], sq = st[2 * row + 1], mean = sm * (1.f / DM), rstd = rsqrtf(sq * (1.f / DM) - mean * mean + 1e-5f);
            const h4 xv = *(const h4*)(pre2 + (size_t)row * DM + c);
            *(f4*)(out + O_Y + (size_t)row * DM + c) = ((f4){(float)xv[0], (float)xv[1], (float)xv[2], (float)xv[3]} - mean) * rstd * *(const f4*)(gg + c) + *(const f4*)(bb + c); }
    }
}

extern "C" void kernel_launch(void* const* d_in, const int* in_sizes, int n_in, void* d_out, int out_size, void* d_ws, size_t ws_size, hipStream_t stream) {
    constexpr size_t kDynLds = STAGE_BYTES;
    static int grid_blocks = 0;
    if (!grid_blocks) {
        if (n_in != 31 || (size_t)out_size != O_END || ws_size < W_END) { fprintf(stderr, "kernel_launch: unexpected shapes n_in %d out %d ws %zu (need %zu)\n", n_in, out_size, ws_size, (size_t)W_END); grid_blocks = -1; return; }
        int dev = 0, cus = 0, per_cu = 0;
        hipGetDevice(&dev);
        hipDeviceGetAttribute(&cus, hipDeviceAttributeMultiprocessorCount, dev);
        hipFuncSetAttribute((const void*)trunk_fwd, hipFuncAttributeMaxDynamicSharedMemorySize, (int)kDynLds);
        hipOccupancyMaxActiveBlocksPerMultiprocessor(&per_cu, (const void*)trunk_fwd, 512, kDynLds);
        if (per_cu < 1) per_cu = 1;
        grid_blocks = cus * per_cu;
        if (grid_blocks > 256) grid_blocks = 256;
        if (grid_blocks < 32) { fprintf(stderr, "kernel_launch: grid %d too small\n", grid_blocks); grid_blocks = -1; return; }
    }
    if (grid_blocks < 0) return;
    hipMemsetAsync((char*)d_ws + W_CTR, 0, W_ZERO_END, stream);
    Params p{};
    for (int i = 0; i < 31; ++i) p.in[i] = (const float*)d_in[i];
    p.out = (float*)d_out; p.ws = (unsigned char*)d_ws;
    void* args[] = {&p};
    hipError_t e = hipLaunchCooperativeKernel((const void*)trunk_fwd, dim3(grid_blocks), dim3(512), args, kDynLds, stream);
    if (e != hipSuccess) fprintf(stderr, "cooperative launch failed: %s (grid %d)\n", hipGetErrorString(e), grid_blocks);
}
```

```cpp
#include <hip/hip_runtime.h>
#include <hip/hip_cooperative_groups.h>
#include <cstdio>
#include <cstdint>
namespace cg = cooperative_groups;

typedef _Float16 h16;
typedef _Float16 h8 __attribute__((ext_vector_type(8)));
typedef _Float16 h4 __attribute__((ext_vector_type(4)));
typedef _Float16 h2 __attribute__((ext_vector_type(2)));
typedef float f4 __attribute__((ext_vector_type(4)));
typedef short s4v __attribute__((__vector_size__(8)));
#define LAS __attribute__((address_space(3)))
#define DEVI __device__ __forceinline__

constexpr int DM = 1024, NB = 16, SEQ = 2048, DEPTH = 4, DBATCH = 32, DSEQ = 32, PAST = 4096;
constexpr int MP = NB * SEQ, MS = DBATCH * DSEQ, MT = MP + MS;
constexpr int DIN = 1696, ZW = 1792, DFF = 2816, DFF2 = 5632;
constexpr int QW = 768, KW = 768, VW = 512, QLW = 2304, CSW = 2560, KNW = 288;
constexpr float ALPHA = 1.681792830507429f;
constexpr float QSCALE = 0.14724444f;
constexpr int NPOS = SEQ + DSEQ;

constexpr size_t O_Y = 0;
constexpr size_t O_PLAT = (size_t)MT * DM;
constexpr size_t O_PKR = O_PLAT + (size_t)DEPTH * MP * 256;
constexpr size_t O_PH = O_PKR + (size_t)DEPTH * MP * 32;
constexpr size_t O_PLC = O_PH + (size_t)DEPTH * NB * 256;
constexpr size_t O_PFC = O_PLC + (size_t)DEPTH * NB * 3 * 256;
constexpr size_t O_SLAT = O_PFC + (size_t)DEPTH * NB * 2 * DFF2;
constexpr size_t O_SKR = O_SLAT + (size_t)DEPTH * MS * 256;
constexpr size_t O_SV = O_SKR + (size_t)DEPTH * MS * 32;
constexpr size_t O_SH = O_SV + (size_t)DEPTH * MS * 256;
constexpr size_t O_SLC = O_SH + (size_t)DEPTH * DBATCH * 256;
constexpr size_t O_SFC = O_SLC + (size_t)DEPTH * DBATCH * 3 * 256;
constexpr size_t O_END = O_SFC + (size_t)DEPTH * DBATCH * 2 * DFF2;

constexpr size_t al(size_t x) { return (x + 255) & ~(size_t)255; }
constexpr size_t W_CTR = 0;
constexpr size_t W_PARAMS = 2048;
constexpr size_t W_BAR = 4096;
constexpr size_t W_CD = 4096 + 16384;
constexpr size_t SZ_CD = (size_t)(2 * ZW + 2 * DFF2) * 4;
constexpr size_t W_STATS = W_CD + DEPTH * SZ_CD;
constexpr size_t SZ_STATS = (size_t)MT * 2 * 4;
constexpr size_t W_ZERO_END = W_STATS + (size_t)DEPTH * 2 * SZ_STATS;
constexpr size_t W_ROPE = al(W_ZERO_END);
constexpr size_t W_SP = al(W_ROPE + (size_t)NPOS * 16 * 2 * 4);
constexpr size_t W_WIN = al(W_SP + (size_t)DEPTH * 256 * 4);
constexpr size_t SZ_WIN = (size_t)ZW * 1024 * 2;
constexpr size_t W_WUQ = W_WIN + DEPTH * SZ_WIN;   constexpr size_t SZ_WUQ = (size_t)768 * 384 * 2;
constexpr size_t W_WQL = W_WUQ + DEPTH * SZ_WUQ;   constexpr size_t SZ_WQL = (size_t)2048 * 384 * 2;
constexpr size_t W_WKV = W_WQL + DEPTH * SZ_WQL;   constexpr size_t SZ_WKV = (size_t)1024 * 256 * 2;
constexpr size_t W_WG = W_WKV + DEPTH * SZ_WKV;    constexpr size_t SZ_WG = (size_t)512 * 256 * 2;
constexpr size_t W_WO = W_WG + DEPTH * SZ_WG;      constexpr size_t SZ_WO = (size_t)1024 * 1024 * 2;
constexpr size_t W_WOS = W_WO + DEPTH * SZ_WO;     constexpr size_t SZ_WOS = (size_t)8 * 64 * 256 * 2;
constexpr size_t W_WUP = W_WOS + DEPTH * SZ_WOS;   constexpr size_t SZ_WUP = (size_t)DFF2 * 1024 * 2;
constexpr size_t W_WDN = W_WUP + DEPTH * SZ_WUP;   constexpr size_t SZ_WDN = (size_t)1024 * DFF * 2;
constexpr size_t W_XH = W_WDN + DEPTH * SZ_WDN;
constexpr size_t W_Z = W_XH + (size_t)MT * 1024 * 2;
constexpr size_t W_CQN = W_Z + (size_t)MT * ZW * 2;
constexpr size_t W_CKVN = W_CQN + (size_t)MT * 384 * 2;
constexpr size_t W_XC = W_CKVN + (size_t)MP * 256 * 2;
constexpr size_t W_Q = W_XC + (size_t)MT * 256 * 2;
constexpr size_t W_K = W_Q + (size_t)MP * QW * 2;
constexpr size_t W_V = W_K + (size_t)MP * KW * 2;
constexpr size_t W_A = W_V + (size_t)MP * VW * 2;
constexpr size_t W_B = W_A + (size_t)MT * 256 * 4;
constexpr size_t W_CAT = W_B + (size_t)MT * 256 * 4;
constexpr size_t W_CATS = W_CAT + (size_t)MP * 1024 * 2;
constexpr size_t W_QLAT = W_CATS + (size_t)MS * 1024 * 2;
constexpr size_t W_KNEW = W_QLAT + (size_t)MS * QLW * 2;
constexpr size_t W_PRE = al(W_KNEW + (size_t)MS * KNW * 2);
constexpr size_t W_X1F = W_PRE + (size_t)MT * 1024 * 4;
constexpr size_t W_UP = W_X1F + (size_t)MT * 1024 * 4;
constexpr size_t W_ACT = W_UP + (size_t)MT * DFF2 * 2;
constexpr size_t W_PART = W_ACT + (size_t)MT * DFF * 2;
constexpr size_t SZ_PARTW = 16 * 1024 + 512;
constexpr size_t W_END = W_PART + (size_t)256 * 8 * SZ_PARTW;

struct Params { const float* in[31]; float* out; unsigned char* ws; };

DEVI float gelu_f(float x) { const float u = -2.302208198f * (x + 0.044715f * x * x * x); return x * __builtin_amdgcn_rcpf(1.f + __builtin_amdgcn_exp2f(u)); }
DEVI float sigmoid_f(float x) { return __builtin_amdgcn_rcpf(1.f + __builtin_amdgcn_exp2f(-1.4426950408889634f * x)); }
DEVI h8 pack8(f4 a, f4 b) { h8 r; r[0] = (h16)a[0]; r[1] = (h16)a[1]; r[2] = (h16)a[2]; r[3] = (h16)a[3]; r[4] = (h16)b[0]; r[5] = (h16)b[1]; r[6] = (h16)b[2]; r[7] = (h16)b[3]; return r; }
DEVI h4 pack4(f4 a) { h4 r; r[0] = (h16)a[0]; r[1] = (h16)a[1]; r[2] = (h16)a[2]; r[3] = (h16)a[3]; return r; }
DEVI float shx(float v, int o, int lane) { return __builtin_bit_cast(float, __builtin_amdgcn_ds_bpermute((lane ^ o) << 2, __builtin_bit_cast(int, v))); }
DEVI float wave_sum(float v, int lane) {
#pragma unroll
    for (int o = 1; o < 64; o <<= 1) v += shx(v, o, lane);
    return v;
}
DEVI int opaque_lane() { unsigned ones = ~0u; asm volatile("" : "+s"(ones)); return (int)__builtin_amdgcn_mbcnt_hi(ones, __builtin_amdgcn_mbcnt_lo(ones, 0u)); }
DEVI h4 trrd(LAS unsigned char* p) { s4v r = __builtin_amdgcn_ds_read_tr16_b64_v4i16((LAS s4v*)p); return __builtin_bit_cast(h4, r); }
DEVI h8 cat44(h4 a, h4 b) { return __builtin_shufflevector(a, b, 0, 1, 2, 3, 4, 5, 6, 7); }

constexpr int BM = 256, BK = 64, HALF = 128, HTB = HALF * BK * 2, STAGE_BYTES = 8 * HTB, NXCD = 8, WGM = 8;
DEVI int lds_byte(int r, int c) { const int st = (r >> 4) * 2 + (c >> 5), rr = r & 15, cc = c & 31, ob = rr * 64 + cc * 2; return st * 1024 + (ob ^ (((ob >> 9) & 1) << 5)); }
DEVI void stage_rc(int b, int& R, int& C) { const int st = b / 1024, sb = b % 1024, swz = sb ^ (((sb >> 9) & 1) << 5); R = (st >> 1) * 16 + swz / 64; C = (st & 1) * 32 + (swz % 64) / 2; }
DEVI int perm32(int rho) { const int n = rho >> 4, i = rho & 15; return 8 * (i >> 2) + 4 * n + (i & 3); }
struct Unit { int pm, pn; };
struct Gemm { const h16* A; const h16* Bt; int M, N, K, lda, ldb; };
struct StaticOrder {
    int nM, nN, nwg, G, c;
    DEVI void init(int M, int N, int G_, int c_) { nM = M / BM; nN = N / BM; nwg = nM * nN; G = G_; c = c_; }
    DEVI bool next(int i, Unit& u) const {
        if (c < 0) return false;
        const long L = (long)i * G + c; if (L >= nwg) return false;
        int wgid = (int)L; { const int q = nwg / NXCD, r = nwg % NXCD, xcd = wgid % NXCD, off = wgid / NXCD; wgid = (xcd < r ? xcd * (q + 1) : r * (q + 1) + (xcd - r) * q) + off; }
        const int nig = WGM * nN, gid = wgid / nig, fm = gid * WGM, gsz = (nM - fm) < WGM ? (nM - fm) : WGM;
        u.pm = fm + ((wgid % nig) % gsz); u.pn = (wgid % nig) / gsz; return true;
    }
};
template <class Epi>
DEVI void gemm_phase(LAS unsigned char* lds, const Gemm g, const StaticOrder& S, const Epi& E, const int tid) {
    const int wid = __builtin_amdgcn_readfirstlane(tid >> 6), lane = tid & 63, wr = wid >> 2, wc = wid & 3, fr = lane & 15, fq = lane >> 4;
    const int K = g.K, nt = K / BK;
    unsigned voffA[2], voffB[2];
#pragma unroll
    for (int i = 0; i < 2; ++i) { int R, C; stage_rc(tid * 16 + i * 8192, R, C); const int Rb = Epi::PERM ? ((R & ~31) + perm32(R & 31)) : R;
        voffA[i] = (unsigned)(R * g.lda + C) * 2u; voffB[i] = (unsigned)(Rb * g.ldb + C) * 2u; }
    const size_t kstep = (size_t)(BK * 2);
    const size_t hstepA = (size_t)HALF * g.lda * 2, hstepB = (size_t)HALF * g.ldb * 2;
    const size_t tstepA = 2 * hstepA, tstepB = 2 * hstepB;
    const unsigned ldsw = (unsigned)wid * 1024u;
    const int aoff = lds_byte(wr * 64 + fr, fq * 8), boff = lds_byte(wc * 32 + fr, fq * 8);
#define PG8_SA(b, h) (((b) * 2 + (h)) * HTB)
#define PG8_SB(b, h) ((4 + (b) * 2 + (h)) * HTB)
#define PG8_STAGE(bufoff, gbase, voff) do { _Pragma("unroll") for (int _i = 0; _i < 2; ++_i) \
        __builtin_amdgcn_global_load_lds((const unsigned*)((const char*)(gbase) + (voff)[_i]), (LAS unsigned*)(lds + (bufoff) + ldsw + _i * 8192), 16, 0, 0); } while (0)
#define PG8_LDA(dst, b, h) do { _Pragma("unroll") for (int m = 0; m < 4; ++m) _Pragma("unroll") for (int k = 0; k < 2; ++k) dst[m][k] = *(const LAS h8*)(lds + PG8_SA(b, h) + aoff + m * 2048 + k * 1024); } while (0)
#define PG8_LDB(dst, b, h) do { _Pragma("unroll") for (int n = 0; n < 2; ++n) _Pragma("unroll") for (int k = 0; k < 2; ++k) dst[n][k] = *(const LAS h8*)(lds + PG8_SB(b, h) + boff + n * 2048 + k * 1024); } while (0)
#define PG8_MMA(ai, bj, At, Bt) do { __builtin_amdgcn_s_setprio(1); _Pragma("unroll") for (int m = 0; m < 4; ++m) _Pragma("unroll") for (int n = 0; n < 2; ++n) _Pragma("unroll") for (int k = 0; k < 2; ++k) \
        acc[ai][bj][m][n] = __builtin_amdgcn_mfma_f32_16x16x32_f16(Bt[n][k], At[m][k], acc[ai][bj][m][n], 0, 0, 0); __builtin_amdgcn_s_setprio(0); } while (0)
#define PG8_WAIT_V(n) asm volatile("s_waitcnt vmcnt(" #n ")" ::: "memory")
#define PG8_WAIT_L(n) asm volatile("s_waitcnt lgkmcnt(" #n ")" ::: "memory")
#define PG8_BAR __builtin_amdgcn_s_barrier()
#define PG8_SCHED __builtin_amdgcn_sched_barrier(0)
    Unit cur, nxt; int ui = 0;
    if (!S.next(0, cur)) return;
    f4 acc[2][2][4][2];
#pragma unroll
    for (int a = 0; a < 2; ++a)
#pragma unroll
        for (int b = 0; b < 2; ++b)
#pragma unroll
            for (int m = 0; m < 4; ++m)
#pragma unroll
                for (int n = 0; n < 2; ++n) acc[a][b][m][n] = (f4){0.f, 0.f, 0.f, 0.f};
    h8 At[4][2], B0[2][2], B1[2][2];
    const char* cA = (const char*)g.A + (size_t)cur.pm * tstepA; const char* cB = (const char*)g.Bt + (size_t)cur.pn * tstepB;
    PG8_STAGE(PG8_SB(0, 0), cB, voffB); PG8_STAGE(PG8_SA(0, 0), cA, voffA); PG8_STAGE(PG8_SB(0, 1), cB + hstepB, voffB); PG8_STAGE(PG8_SA(0, 1), cA + hstepA, voffA);
    if (wr == 1) PG8_BAR;
    PG8_WAIT_V(4); PG8_BAR;
    PG8_STAGE(PG8_SB(1, 0), cB + kstep, voffB); PG8_STAGE(PG8_SA(1, 0), cA + kstep, voffA); PG8_STAGE(PG8_SB(1, 1), cB + hstepB + kstep, voffB);
    PG8_WAIT_V(6); PG8_BAR;
    for (;;) {
        const bool has_next = S.next(ui + 1, nxt);
        const char* nA = has_next ? (const char*)g.A + (size_t)nxt.pm * tstepA : cA; const char* nB = has_next ? (const char*)g.Bt + (size_t)nxt.pn * tstepB : cB;
        for (int t = 0; t < nt; t += 2) {
            const bool last = (t == nt - 2);
            const char* a1 = cA + (size_t)(t + 1) * kstep;
            const char* a2 = last ? nA : cA + (size_t)(t + 2) * kstep; const char* b2 = last ? nB : cB + (size_t)(t + 2) * kstep;
            const char* a3 = a2 + kstep; const char* b3 = b2 + kstep;
            PG8_LDB(B0, 0, 0); PG8_SCHED; PG8_LDA(At, 0, 0); PG8_STAGE(PG8_SA(1, 1), a1 + hstepA, voffA);
            PG8_WAIT_L(8); PG8_BAR; PG8_WAIT_L(0); PG8_MMA(0, 0, At, B0); PG8_BAR; PG8_SCHED;
            PG8_LDB(B1, 0, 1); PG8_STAGE(PG8_SB(0, 0), b2, voffB);
            PG8_BAR; PG8_WAIT_L(0); PG8_MMA(0, 1, At, B1); PG8_BAR;
            PG8_LDA(At, 0, 1); PG8_STAGE(PG8_SA(0, 0), a2, voffA);
            PG8_BAR; PG8_WAIT_L(0); PG8_MMA(1, 0, At, B0); PG8_BAR; PG8_SCHED;
            PG8_STAGE(PG8_SB(0, 1), b2 + hstepB, voffB);
            PG8_WAIT_V(6); PG8_BAR; PG8_MMA(1, 1, At, B1); PG8_BAR;
            PG8_LDB(B0, 1, 0); PG8_SCHED; PG8_LDA(At, 1, 0); PG8_STAGE(PG8_SA(0, 1), a2 + hstepA, voffA);
            PG8_WAIT_L(8); PG8_BAR; PG8_WAIT_L(0); PG8_MMA(0, 0, At, B0); PG8_BAR; PG8_SCHED;
            PG8_LDB(B1, 1, 1); PG8_STAGE(PG8_SB(1, 0), b3, voffB);
            PG8_BAR; PG8_WAIT_L(0); PG8_MMA(0, 1, At, B1); PG8_BAR;
            PG8_LDA(At, 1, 1); PG8_STAGE(PG8_SA(1, 0), a3, voffA);
            PG8_BAR; PG8_WAIT_L(0); PG8_MMA(1, 0, At, B0); PG8_BAR; PG8_SCHED;
            PG8_STAGE(PG8_SB(1, 1), b3 + hstepB, voffB);
            PG8_WAIT_V(6); PG8_BAR; PG8_MMA(1, 1, At, B1); PG8_BAR;
        }
        { int t2 = tid; asm volatile("" : "+v"(t2)); const int l2 = t2 & 63; E(acc, cur, wr, wc, l2 & 15, l2 >> 4); }
        if (!has_next) break;
#pragma unroll
        for (int a = 0; a < 2; ++a)
#pragma unroll
            for (int b = 0; b < 2; ++b)
#pragma unroll
                for (int m = 0; m < 4; ++m)
#pragma unroll
                    for (int n = 0; n < 2; ++n) acc[a][b][m][n] = (f4){0.f, 0.f, 0.f, 0.f};
        cur = nxt; cA = nA; cB = nB; ++ui;
    }
    PG8_WAIT_V(0);
    if (wr == 0) PG8_BAR;
    PG8_BAR;
#undef PG8_SA
#undef PG8_SB
#undef PG8_STAGE
#undef PG8_LDA
#undef PG8_LDB
#undef PG8_MMA
#undef PG8_WAIT_V
#undef PG8_WAIT_L
#undef PG8_BAR
#undef PG8_SCHED
}

typedef f4 Acc[2][2][4][2];
#define EPI_ROWS for (int ai = 0; ai < 2; ++ai) _Pragma("unroll") for (int m = 0; m < 4; ++m)

#define ROW_OF(r) (rowb + ((r) >> 2) * HALF + ((r) & 3) * 16)
struct EpiZ {
    static constexpr bool PERM = true;
    h16* z; float* sv; const float* st; const float* cv; const float* dv; bool fold;
    DEVI void operator()(const Acc& acc, const Unit& u, int wr, int wc, int fr, int fq) const {
        const int rowb = u.pm * BM + wr * 64 + fr, colb = u.pn * BM + wc * 32 + fq * 8;
        float mean[8], rstd[8]; f4 c[2][2], d[2][2];
#pragma unroll
        for (int r = 0; r < 8; ++r) { mean[r] = 0.f; rstd[r] = 1.f; }
#pragma unroll
        for (int bj = 0; bj < 2; ++bj)
#pragma unroll
            for (int n = 0; n < 2; ++n) { c[bj][n] = (f4){0.f, 0.f, 0.f, 0.f}; d[bj][n] = c[bj][n]; }
        if (fold) {
#pragma unroll
            for (int r = 0; r < 8; ++r) { const int row = ROW_OF(r); const float sm = st[2 * row], sq = st[2 * row + 1]; mean[r] = sm * (1.f / DM); rstd[r] = rsqrtf(sq * (1.f / DM) - mean[r] * mean[r] + 1e-5f); }
#pragma unroll
            for (int bj = 0; bj < 2; ++bj)
#pragma unroll
                for (int n = 0; n < 2; ++n) { c[bj][n] = *(const f4*)(cv + colb + bj * HALF + 4 * n); d[bj][n] = *(const f4*)(dv + colb + bj * HALF + 4 * n); } }
#pragma unroll
        for (int bj = 0; bj < 2; ++bj) { const int col = colb + bj * HALF; const bool act = col < 512 || (col >= 1440 && col < 1696);
#pragma unroll
            for (int r = 0; r < 8; ++r) { const int row = ROW_OF(r);
                f4 v0 = (acc[r >> 2][bj][r & 3][0] - c[bj][0] * mean[r]) * rstd[r] + d[bj][0], v1 = (acc[r >> 2][bj][r & 3][1] - c[bj][1] * mean[r]) * rstd[r] + d[bj][1];
                if (act) {
#pragma unroll
                    for (int e = 0; e < 4; ++e) { v0[e] = gelu_f(v0[e]); v1[e] = gelu_f(v1[e]); } }
                *(h8*)(z + (size_t)row * ZW + col) = pack8(v0, v1);
                if (row >= MP && col >= 256 && col < 512) { float* o = sv + (size_t)(row - MP) * 256 + (col - 256); *(f4*)o = v0; *(f4*)(o + 4) = v1; } } }
    }
};
struct EpiQ {
    static constexpr bool PERM = true;
    h16* q; h16* qlat; const float* ropec; const float* ropes;
    DEVI void operator()(const Acc& acc, const Unit& u, int wr, int wc, int fr, int fq) const {
        const bool samp = u.pm * BM >= MP;
        if (u.pn < 2) { if (samp) return;
#pragma unroll
            EPI_ROWS { const int row = u.pm * BM + ai * HALF + wr * 64 + m * 16 + fr;
#pragma unroll
                for (int bj = 0; bj < 2; ++bj) { const int col = u.pn * BM + bj * HALF + wc * 32 + fq * 8;
                    *(h8*)(q + (size_t)row * QW + (col >> 6) * 96 + (col & 63)) = pack8(acc[ai][bj][m][0] * QSCALE, acc[ai][bj][m][1] * QSCALE); } }
        } else {
            const int j = wc * 32 + fq * 8, head = j >> 4, i0 = j & 15; const int rowb = u.pm * BM + wr * 64 + fr;
#pragma unroll
            for (int r = 0; r < 8; ++r) { const int row = ROW_OF(r); const int pidx = samp ? SEQ + ((row - MP) & 31) : (row & (SEQ - 1));
                const size_t po = samp ? (W_QLAT - W_Q) / 2 + (size_t)(row - MP) * QLW + head * 288 + 256 + i0 : (size_t)row * QW + head * 96 + 64 + i0;
#pragma unroll
                for (int n = 0; n < 2; ++n) { const f4 cc = *(const f4*)(ropec + pidx * 16 + i0 + 4 * n), ss = *(const f4*)(ropes + pidx * 16 + i0 + 4 * n);
                    const f4 a0 = acc[r >> 2][0][r & 3][n], b0 = acc[r >> 2][1][r & 3][n];
                    *(h4*)(q + po + 4 * n) = pack4((a0 * cc - b0 * ss) * QSCALE); *(h4*)(q + po + 16 + 4 * n) = pack4((a0 * ss + b0 * cc) * QSCALE); } }
        }
    }
};
struct EpiKV {
    static constexpr bool PERM = true;
    h16* k; h16* v;
    DEVI void operator()(const Acc& acc, const Unit& u, int wr, int wc, int fr, int fq) const {
#pragma unroll
        EPI_ROWS { const int row = u.pm * BM + ai * HALF + wr * 64 + m * 16 + fr;
#pragma unroll
            for (int bj = 0; bj < 2; ++bj) { const int col = u.pn * BM + bj * HALF + wc * 32 + fq * 8; const h8 o = pack8(acc[ai][bj][m][0], acc[ai][bj][m][1]);
                if (u.pn < 2) *(h8*)(k + (size_t)row * KW + (col >> 6) * 96 + (col & 63)) = o; else *(h8*)(v + (size_t)row * VW + (col - 512)) = o; } }
    }
};
DEVI float one_minus_exp(float x) {
    const float pser = -x * (1.f + x * (0.5f + x * (0.16666667f + x * (0.041666668f + x * (0.0083333338f + x * 0.0013888889f)))));
    return x > -0.25f ? pser : 1.f - __builtin_amdgcn_exp2f(1.4426950408889634f * x);
}
struct EpiGate {
    static constexpr bool PERM = false;
    const h16* xc; float* a; float* b; const float* br; const float* bi; const float* sp;
    DEVI void operator()(const Acc& acc, const Unit& u, int wr, int wc, int fr, int fq) const {
        const int rowb = u.pm * BM + wr * 64 + fr, chb = u.pn * 128 + wc * 32 + fq * 4;
        f4 vbr[2], vbi[2], vsp[2]; h4 xv[2][8];
#pragma unroll
        for (int n = 0; n < 2; ++n) { const int ch = chb + n * 16; vbr[n] = *(const f4*)(br + ch); vbi[n] = *(const f4*)(bi + ch); vsp[n] = *(const f4*)(sp + ch) * -8.f;
#pragma unroll
            for (int r = 0; r < 8; ++r) xv[n][r] = *(const h4*)(xc + (size_t)ROW_OF(r) * 256 + ch); }
#pragma unroll
        for (int n = 0; n < 2; ++n) { const int ch = chb + n * 16;
#pragma unroll
            for (int r = 0; r < 8; ++r) { const int row = ROW_OF(r); f4 oa, ob;
#pragma unroll
                for (int e = 0; e < 4; ++e) { const float rg = sigmoid_f(acc[r >> 2][0][r & 3][n][e] + vbr[n][e]), ig = sigmoid_f(acc[r >> 2][1][r & 3][n][e] + vbi[n][e]);
                    const float la = rg * vsp[n][e]; oa[e] = __builtin_amdgcn_exp2f(1.4426950408889634f * la); ob[e] = __builtin_amdgcn_sqrtf(one_minus_exp(2.f * la)) * (ig * (float)xv[n][r][e]); }
                *(f4*)(a + (size_t)row * 256 + ch) = oa; *(f4*)(b + (size_t)row * 256 + ch) = ob; } }
    }
};
struct EpiQlat {
    static constexpr bool PERM = true;
    h16* qlat;
    DEVI void operator()(const Acc& acc, const Unit& u, int wr, int wc, int fr, int fq) const {
#pragma unroll
        EPI_ROWS { const int row = u.pm * BM + ai * HALF + wr * 64 + m * 16 + fr;
#pragma unroll
            for (int bj = 0; bj < 2; ++bj) { const int c = bj * HALF + wc * 32 + fq * 8;
                *(h8*)(qlat + (size_t)row * QLW + u.pn * 288 + c) = pack8(acc[ai][bj][m][0] * QSCALE, acc[ai][bj][m][1] * QSCALE); } }
    }
};
struct EpiRes {
    static constexpr bool PERM = true;
    h16* xh; const float* pst; const float* g; const float* b; bool ln; float* ost;
    DEVI void operator()(const Acc& acc, const Unit& u, int wr, int wc, int fr, int fq) const {
        const int rowb = u.pm * BM + wr * 64 + fr, colb = u.pn * BM + wc * 32 + fq * 8, lane = fq * 16 + fr;
        f4 gv[4], bv[4]; float mean[8], rstd[8];
#pragma unroll
        for (int k = 0; k < 4; ++k) { const int col = colb + (k >> 1) * HALF + (k & 1) * 4; gv[k] = ln ? *(const f4*)(g + col) : (f4){1.f, 1.f, 1.f, 1.f}; bv[k] = ln ? *(const f4*)(b + col) : (f4){0.f, 0.f, 0.f, 0.f}; }
#pragma unroll
        for (int r = 0; r < 8; ++r) { mean[r] = 0.f; rstd[r] = 1.f;
            if (ln) { const int row = ROW_OF(r); const float sm = pst[2 * row], sq = pst[2 * row + 1]; mean[r] = sm * (1.f / DM); rstd[r] = rsqrtf(sq * (1.f / DM) - mean[r] * mean[r] + 1e-5f); } }
        h8 cur[2], nxt[2];
#pragma unroll
        for (int bj = 0; bj < 2; ++bj) cur[bj] = *(const h8*)(xh + (size_t)ROW_OF(0) * DM + colb + bj * HALF);
#pragma unroll
        for (int r = 0; r < 8; ++r) { const int row = ROW_OF(r);
            if (r < 7) {
#pragma unroll
                for (int bj = 0; bj < 2; ++bj) nxt[bj] = *(const h8*)(xh + (size_t)ROW_OF(r + 1) * DM + colb + bj * HALF); }
            float s1 = 0.f, s2 = 0.f;
#pragma unroll
            for (int bj = 0; bj < 2; ++bj) { f4 y[2];
#pragma unroll
                for (int n = 0; n < 2; ++n) { const int k = bj * 2 + n;
                    const f4 xv = (f4){(float)cur[bj][4 * n], (float)cur[bj][4 * n + 1], (float)cur[bj][4 * n + 2], (float)cur[bj][4 * n + 3]};
                    y[n] = ((xv - mean[r]) * rstd[r] * gv[k] + bv[k]) * ALPHA + acc[r >> 2][bj][r & 3][n];
                    s1 += (y[n][0] + y[n][1]) + (y[n][2] + y[n][3]); s2 += (y[n][0] * y[n][0] + y[n][1] * y[n][1]) + (y[n][2] * y[n][2] + y[n][3] * y[n][3]); }
                *(h8*)(xh + (size_t)row * DM + colb + bj * HALF) = pack8(y[0], y[1]); }
            s1 += shx(s1, 16, lane); s2 += shx(s2, 16, lane); s1 += shx(s1, 32, lane); s2 += shx(s2, 32, lane);
            if (fq == 0) { atomicAdd(ost + 2 * row, s1); atomicAdd(ost + 2 * row + 1, s2); }
#pragma unroll
            for (int bj = 0; bj < 2; ++bj) cur[bj] = nxt[bj]; }
    }
};
struct EpiUp {
    static constexpr bool PERM = true;
    h16* up; float* pfc; size_t sdelta; const float* st; const float* cv; const float* dv;
    DEVI void operator()(const Acc& acc, const Unit& u, int wr, int wc, int fr, int fq) const {
        const int rowb = u.pm * BM + wr * 64 + fr, colb = u.pn * BM + wc * 32 + fq * 8;
        float mean[8], rstd[8]; f4 c[2][2], d[2][2];
#pragma unroll
        for (int r = 0; r < 8; ++r) { const int row = ROW_OF(r); const float sm = st[2 * row], sq = st[2 * row + 1]; mean[r] = sm * (1.f / DM); rstd[r] = rsqrtf(sq * (1.f / DM) - mean[r] * mean[r] + 1e-5f); }
#pragma unroll
        for (int bj = 0; bj < 2; ++bj)
#pragma unroll
            for (int n = 0; n < 2; ++n) { c[bj][n] = *(const f4*)(cv + colb + bj * HALF + 4 * n); d[bj][n] = *(const f4*)(dv + colb + bj * HALF + 4 * n); }
#pragma unroll
        for (int r = 0; r < 8; ++r) { const int row = ROW_OF(r);
            bool has_st; size_t so;
            if (row < MP) { const int t = row & (SEQ - 1); has_st = t >= SEQ - 2; so = ((size_t)(row >> 11) * 2 + (t - (SEQ - 2))) * DFF2; }
            else { const int rs = row - MP, t = rs & 31; has_st = t >= DSEQ - 2; so = sdelta + ((size_t)(rs >> 5) * 2 + (t - (DSEQ - 2))) * DFF2; }
#pragma unroll
            for (int bj = 0; bj < 2; ++bj) { const int col = colb + bj * HALF;
                const f4 v0 = (acc[r >> 2][bj][r & 3][0] - c[bj][0] * mean[r]) * rstd[r] + d[bj][0], v1 = (acc[r >> 2][bj][r & 3][1] - c[bj][1] * mean[r]) * rstd[r] + d[bj][1];
                *(h8*)(up + (size_t)row * DFF2 + col) = pack8(v0, v1);
                if (has_st) { float* sp = pfc + so + col; *(f4*)sp = v0; *(f4*)(sp + 4) = v1; } } }
    }
};

template <int MODE>
DEVI void transpose_item(const float* W, int ldw, int nblk, h16* WT, int ldd, LAS float* scr, int item, int lane, const float* gs = nullptr, const float* bs = nullptr, float* csum = nullptr, float* dsum = nullptr) {
    const int kb = item / nblk, nb = item % nblk, k0 = 64 * kb, n0 = 32 * nb;
    int nsrc = n0 + (lane & 31);
    if (MODE == 1) { const int n = nsrc; if (n < 512) nsrc = (n >> 6) * 96 + (n & 63); else if (n < 640) nsrc = ((n - 512) >> 4) * 96 + 64 + ((n - 512) & 15); else nsrc = ((n - 640) >> 4) * 96 + 80 + ((n - 640) & 15); }
    float cs = 0.f, ds = 0.f;
#pragma unroll 8
    for (int i = 0; i < 32; ++i) { const int kk = 2 * i + (lane >> 5); float w = W[(size_t)(k0 + kk) * ldw + nsrc]; if (gs) { ds += bs[k0 + kk] * w; w *= gs[k0 + kk]; cs += w; } scr[kk * 33 + (lane & 31)] = w; }
    if (gs && csum) { atomicAdd(csum + nsrc, cs); atomicAdd(dsum + nsrc, ds); }
    __builtin_amdgcn_fence(__ATOMIC_RELEASE, "wavefront"); asm volatile("s_waitcnt lgkmcnt(0)" ::: "memory");
    const int c = lane & 7;
#pragma unroll
    for (int j = 0; j < 4; ++j) { const int n = (lane >> 3) + 8 * j; const LAS float* s = scr + (8 * c) * 33 + n;
        h8 o; o[0] = (h16)s[0 * 33]; o[1] = (h16)s[1 * 33]; o[2] = (h16)s[2 * 33]; o[3] = (h16)s[3 * 33]; o[4] = (h16)s[4 * 33]; o[5] = (h16)s[5 * 33]; o[6] = (h16)s[6 * 33]; o[7] = (h16)s[7 * 33];
        *(h8*)(WT + (size_t)(n0 + n) * ldd + k0 + 8 * c) = o; }
    asm volatile("s_waitcnt lgkmcnt(0)" ::: "memory");
}

template <int NKS, int NCT, int NQS, int KSTR>
DEVI void attn_qk(LAS unsigned char* kbase, const h8 (&qf)[NQS][NKS], f4 (&o)[NQS][NCT], float (&mrow)[NQS], float (&lrow)[NQS], h8 (&pf)[NQS][2], const int nkt, const int lane) {
    const int fr = lane & 15, g = lane >> 4;
    f4 s[NQS][4];
#pragma unroll
    for (int qs = 0; qs < NQS; ++qs)
#pragma unroll
        for (int kt = 0; kt < 4; ++kt) s[qs][kt] = (f4){-1e30f, -1e30f, -1e30f, -1e30f};
#pragma unroll
    for (int kt = 0; kt < 4; ++kt) if (kt < nkt) {
#pragma unroll
        for (int qs = 0; qs < NQS; ++qs) s[qs][kt] = (f4){0.f, 0.f, 0.f, 0.f};
#pragma unroll
        for (int ks = 0; ks < NKS; ++ks) { const h8 kf = *(const LAS h8*)(kbase + (kt * 16 + fr) * KSTR + ks * 64 + g * 16);
#pragma unroll
            for (int qs = 0; qs < NQS; ++qs) s[qs][kt] = __builtin_amdgcn_mfma_f32_16x16x32_f16(kf, qf[qs][ks], s[qs][kt], 0, 0, 0); } }
    __builtin_amdgcn_sched_barrier(0);
#pragma unroll
    for (int qs = 0; qs < NQS; ++qs) {
        float mx = -1e30f;
#pragma unroll
        for (int kt = 0; kt < 4; ++kt)
#pragma unroll
            for (int e = 0; e < 4; ++e) mx = fmaxf(mx, s[qs][kt][e]);
        mx = fmaxf(mx, shx(mx, 16, lane)); mx = fmaxf(mx, shx(mx, 32, lane));
        const float mnew = fmaxf(mrow[qs], mx), alpha = __builtin_amdgcn_exp2f(mrow[qs] - mnew); mrow[qs] = mnew;
        float ps = 0.f;
#pragma unroll
        for (int kt = 0; kt < 4; ++kt)
#pragma unroll
            for (int e = 0; e < 4; ++e) { const float p = __builtin_amdgcn_exp2f(s[qs][kt][e] - mnew); s[qs][kt][e] = p; ps += p; }
        lrow[qs] = lrow[qs] * alpha + ps;
#pragma unroll
        for (int ct = 0; ct < NCT; ++ct) o[qs][ct] *= alpha;
#pragma unroll
        for (int k2 = 0; k2 < 2; ++k2) pf[qs][k2] = pack8(s[qs][2 * k2], s[qs][2 * k2 + 1]);
    }
    __builtin_amdgcn_sched_barrier(0);
}
template <int NCT, int NQS, int VSTR>
DEVI void attn_pv(LAS unsigned char* vbase, f4 (&o)[NQS][NCT], const h8 (&pf)[NQS][2], const int nkt, const int lane) {
    const int fr = lane & 15, g = lane >> 4, q_ = fr >> 2, p_ = fr & 3;
#pragma unroll
    for (int k2 = 0; k2 < 2; ++k2) if (2 * k2 < nkt) {
#pragma unroll
        for (int ct = 0; ct < NCT; ++ct) {
            const h4 lo = trrd(vbase + (32 * k2 + 4 * g + q_) * VSTR + (16 * ct + 4 * p_) * 2);
            const h4 hi = trrd(vbase + (32 * k2 + 16 + 4 * g + q_) * VSTR + (16 * ct + 4 * p_) * 2);
            const h8 vf = cat44(lo, hi);
#pragma unroll
            for (int qs = 0; qs < NQS; ++qs) o[qs][ct] = __builtin_amdgcn_mfma_f32_16x16x32_f16(vf, pf[qs][k2], o[qs][ct], 0, 0, 0); } }
    __builtin_amdgcn_sched_barrier(0);
}
template <int NKS, int NCT, int NQS, int KSTR, int VSTR>
DEVI void attn_tile(LAS unsigned char* kbase, LAS unsigned char* vbase, const h8 (&qf)[NQS][NKS], f4 (&o)[NQS][NCT], float (&mrow)[NQS], float (&lrow)[NQS], const int nkt, const int lane) {
    h8 pf[NQS][2];
    attn_qk<NKS, NCT, NQS, KSTR>(kbase, qf, o, mrow, lrow, pf, nkt, lane);
    attn_pv<NCT, NQS, VSTR>(vbase, o, pf, nkt, lane);
}


DEVI void conv_gate_items(unsigned it_begin, unsigned it_end, unsigned it_step, const int rseg, const h16* up, h16* act, const float* fw, const float* fb, const float* stf) {
    constexpr int NCG = DFF / 8;
    for (unsigned it = it_begin; it < it_end; it += it_step) { const int seg = (int)(it / (unsigned)NCG), cg = (int)(it - (unsigned)seg * NCG), j0 = cg * 8, row0 = seg * rseg;
        const bool samp = row0 >= MP; const int t0 = samp ? ((row0 - MP) & 31) : (row0 & (SEQ - 1)), bb = (row0 - MP) >> 5;
        const f4 bg0 = *(const f4*)(fb + j0), bg1 = *(const f4*)(fb + j0 + 4), bv0 = *(const f4*)(fb + DFF + j0), bv1 = *(const f4*)(fb + DFF + j0 + 4);
        f4 wg0[3], wg1[3], wv0[3], wv1[3];
#pragma unroll
        for (int j = 0; j < 3; ++j) { const float* wj = fw + (size_t)j * DFF2; wg0[j] = *(const f4*)(wj + j0); wg1[j] = *(const f4*)(wj + j0 + 4); wv0[j] = *(const f4*)(wj + DFF + j0); wv1[j] = *(const f4*)(wj + DFF + j0 + 4); }
        f4 ag0, ag1, av0, av1, bg0_, bg1_, bv0_, bv1_;
        if (t0 > 0) { const h16* u2 = up + (size_t)(row0 - 2) * DFF2; const h16* u1 = u2 + DFF2;
            const h8 a = *(const h8*)(u2 + j0), c = *(const h8*)(u2 + DFF + j0), d = *(const h8*)(u1 + j0), e = *(const h8*)(u1 + DFF + j0);
            ag0 = (f4){(float)a[0], (float)a[1], (float)a[2], (float)a[3]}; ag1 = (f4){(float)a[4], (float)a[5], (float)a[6], (float)a[7]};
            av0 = (f4){(float)c[0], (float)c[1], (float)c[2], (float)c[3]}; av1 = (f4){(float)c[4], (float)c[5], (float)c[6], (float)c[7]};
            bg0_ = (f4){(float)d[0], (float)d[1], (float)d[2], (float)d[3]}; bg1_ = (f4){(float)d[4], (float)d[5], (float)d[6], (float)d[7]};
            bv0_ = (f4){(float)e[0], (float)e[1], (float)e[2], (float)e[3]}; bv1_ = (f4){(float)e[4], (float)e[5], (float)e[6], (float)e[7]}; }
        else if (samp) { const float* s2 = stf + (size_t)bb * 2 * DFF2; const float* s1 = s2 + DFF2;
            ag0 = *(const f4*)(s2 + j0); ag1 = *(const f4*)(s2 + j0 + 4); av0 = *(const f4*)(s2 + DFF + j0); av1 = *(const f4*)(s2 + DFF + j0 + 4);
            bg0_ = *(const f4*)(s1 + j0); bg1_ = *(const f4*)(s1 + j0 + 4); bv0_ = *(const f4*)(s1 + DFF + j0); bv1_ = *(const f4*)(s1 + DFF + j0 + 4); }
        else { ag0 = ag1 = av0 = av1 = bg0_ = bg1_ = bv0_ = bv1_ = (f4){0.f, 0.f, 0.f, 0.f}; }
        const h16* ur = up + (size_t)row0 * DFF2 + j0; h16* ar = act + (size_t)row0 * DFF + j0;
#pragma unroll 4
        for (int r = 0; r < rseg; ++r) { const h8 a = *(const h8*)(ur + (size_t)r * DFF2), c = *(const h8*)(ur + (size_t)r * DFF2 + DFF);
            const f4 cg0 = (f4){(float)a[0], (float)a[1], (float)a[2], (float)a[3]}, cg1 = (f4){(float)a[4], (float)a[5], (float)a[6], (float)a[7]};
            const f4 cv0 = (f4){(float)c[0], (float)c[1], (float)c[2], (float)c[3]}, cv1 = (f4){(float)c[4], (float)c[5], (float)c[6], (float)c[7]};
            const f4 g0 = bg0 + ag0 * wg0[0] + bg0_ * wg0[1] + cg0 * wg0[2], g1 = bg1 + ag1 * wg1[0] + bg1_ * wg1[1] + cg1 * wg1[2];
            const f4 v0 = bv0 + av0 * wv0[0] + bv0_ * wv0[1] + cv0 * wv0[2], v1 = bv1 + av1 * wv1[0] + bv1_ * wv1[1] + cv1 * wv1[2];
            h8 o;
#pragma unroll
            for (int e = 0; e < 4; ++e) { o[e] = (h16)(gelu_f(g0[e]) * v0[e]); o[4 + e] = (h16)(gelu_f(g1[e]) * v1[e]); }
            *(h8*)(ar + (size_t)r * DFF) = o;
            ag0 = bg0_; ag1 = bg1_; av0 = bv0_; av1 = bv1_; bg0_ = cg0; bg1_ = cg1; bv0_ = cv0; bv1_ = cv1; } }
}


#define XB_TMO      128
#define XB_XCNT(j)  (256  + 64 * (j))
#define XB_XSUB(j)  (1280 + 64 * (j))
#define XB_XGEN(j)  (2304 + 64 * (j))
#define XB_TOP      3328
#define XB_TOPGEN   3392
#define XCD_BAR_WORDS 3456
#define XB_SPIN_CAP (1u << 18)
DEVI unsigned xb_ld(unsigned* p)              { return __hip_atomic_load(p, __ATOMIC_RELAXED, __HIP_MEMORY_SCOPE_AGENT); }
DEVI unsigned xb_add(unsigned* p, unsigned v) { return __hip_atomic_fetch_add(p, v, __ATOMIC_RELAXED, __HIP_MEMORY_SCOPE_AGENT); }
DEVI unsigned xb_xcc_id() { return (unsigned)__builtin_amdgcn_s_getreg((3 << 11) | 20) & 0xFu; }
#define XB_SPIN(cond, bar) do { unsigned _sp = 0; while (cond) { __builtin_amdgcn_s_sleep(1); \
    if ((++_sp & 255u) == 0u) { if (xb_ld(&(bar)[XB_TMO])) break; if (_sp > XB_SPIN_CAP) { atomicAdd(&(bar)[XB_TMO], 1u); break; } } } } while (0)
DEVI void xb_complete(unsigned* bar, unsigned x, unsigned& nloc, unsigned& nx, unsigned G) {
    unsigned sum, cnt, mine, sp = 0u;
    for (;;) {
        sum = 0u; cnt = 0u; mine = 0u;
#pragma unroll
        for (unsigned j = 0; j < 16; ++j) { const unsigned c = xb_ld(&bar[XB_XCNT(j)]); sum += c; cnt += (c > 0u) ? 1u : 0u; mine = (j == x) ? c : mine; }
        if (sum == G) break;
        __builtin_amdgcn_s_sleep(1);
        if ((++sp & 255u) == 0u) { if (xb_ld(&bar[XB_TMO])) break; if (sp > XB_SPIN_CAP) { atomicAdd(&bar[XB_TMO], 1u); break; } }
    }
    nloc = mine > 0u ? mine : 1u; nx = cnt > 0u ? cnt : 1u;
}
DEVI void xbar(unsigned* bar, volatile LAS unsigned* st, int tid, unsigned G) {
    asm volatile("s_waitcnt vmcnt(0)" ::: "memory");
    __syncthreads();
    if (tid == 0) {
        const unsigned x = xb_xcc_id();
        __builtin_amdgcn_s_waitcnt(0);
        unsigned nloc = st[0], nx = st[1];
        if (nloc == 0u) { xb_complete(bar, x, nloc, nx, G); st[0] = nloc; st[1] = nx; }
        const unsigned old = xb_add(&bar[XB_XSUB(x)], 1u);
        const unsigned gen = old / nloc;
        if (old + 1u == (gen + 1u) * nloc) {
            __builtin_amdgcn_fence(__ATOMIC_RELEASE, "agent");
            asm volatile("s_waitcnt vmcnt(0)" ::: "memory");
            const unsigned og = xb_add(&bar[XB_TOP], 1u);
            const unsigned tg = og / nx;
            if (og + 1u == (tg + 1u) * nx) xb_add(&bar[XB_TOPGEN], 1u);
            else XB_SPIN(xb_ld(&bar[XB_TOPGEN]) == tg, bar);
            __builtin_amdgcn_fence(__ATOMIC_ACQUIRE, "agent");
            xb_add(&bar[XB_XGEN(x)], 1u);
            asm volatile("s_waitcnt vmcnt(0)" ::: "memory");
        } else {
            XB_SPIN(xb_ld(&bar[XB_XGEN(x)]) == gen, bar);
            __builtin_amdgcn_fence(__ATOMIC_ACQUIRE, "agent");
            asm volatile("s_waitcnt vmcnt(0)" ::: "memory");
        }
    }
    __syncthreads();
}
#ifndef PHM
#define PHM 0xFFFFFFFFu
#endif
#ifndef DBL
#define DBL 0u
#endif
#define NREP(k) (((DBL >> (k)) & 1u) ? 2 : 1)
__global__ void __launch_bounds__(512, 2) trunk_fwd(Params p) {
    extern __shared__ __attribute__((aligned(16))) unsigned char shm_raw[];
    LAS unsigned char* lds = (LAS unsigned char*)shm_raw;
    __shared__ uint4 s_ctl;
#define s_item (*(LAS int*)&s_ctl)
    cg::grid_group grid = cg::this_grid();
    const int wave_s = __builtin_amdgcn_readfirstlane((int)threadIdx.x >> 6);
    if (threadIdx.x == 0) { s_ctl = make_uint4(0u, 0u, 0u, 0u); (void)xb_add((unsigned*)(p.ws + W_BAR) + XB_XCNT(xb_xcc_id()), 1u); }
    __syncthreads();
#define GSYNC() do { const __attribute__((address_space(4))) Params* kq = (const __attribute__((address_space(4))) Params*)__builtin_amdgcn_kernarg_segment_ptr(); asm volatile("" : "+s"(kq)); \
        unsigned Gq = gridDim.x; asm volatile("" : "+s"(Gq)); xbar((unsigned*)(kq->ws + W_BAR), (volatile LAS unsigned*)&s_ctl + 1, wave_s * 64 + opaque_lane(), Gq); } while (0)
#define PH_BEGIN \
    int tid = wave_s * 64 + opaque_lane(); asm volatile("" : "+v"(tid)); \
    int bid = blockIdx.x, G = gridDim.x, lq = l; asm volatile("" : "+s"(bid), "+s"(G), "+s"(lq)); \
    const int lane = tid & 63, wave = __builtin_amdgcn_readfirstlane(tid >> 6); \
    const int gw = bid * 8 + wave, NGW = G * 8; const size_t gtid = (size_t)bid * 512 + tid, NGT = (size_t)G * 512; \
    const __attribute__((address_space(4))) Params* kp = (const __attribute__((address_space(4))) Params*)__builtin_amdgcn_kernarg_segment_ptr(); asm volatile("" : "+s"(kp)); \
    unsigned char* ws = kp->ws; float* out = kp->out; \
    (void)lane; (void)wave; (void)gw; (void)NGW; (void)gtid; (void)NGT; (void)out; (void)lq;
#define WSP(T, off) ((T*)(ws + (off)))
    for (int rep = 0; rep < NREP(0); ++rep) if (PHM & 1u) {
        int tid = wave_s * 64 + opaque_lane(); asm volatile("" : "+v"(tid));
        const int bid = blockIdx.x, G = gridDim.x, lane = tid & 63, wave = __builtin_amdgcn_readfirstlane(tid >> 6);
        const int gw = bid * 8 + wave, NGW = G * 8; const size_t gtid = (size_t)bid * 512 + tid, NGT = (size_t)G * 512;
        unsigned char* ws = p.ws;
        h16* xh = WSP(h16, W_XH); float* ropec = WSP(float, W_ROPE); float* ropes = ropec + NPOS * 16;
        for (size_t i = gtid; i < (size_t)MT * DM / 8; i += NGT) { const size_t e = i * 8; const float* src = e < (size_t)MP * DM ? p.in[0] + e : p.in[1] + (e - (size_t)MP * DM);
            *(h8*)(xh + e) = pack8(*(const f4*)src, *(const f4*)(src + 4)); }
        for (size_t i = gtid; i < (size_t)NPOS * 16; i += NGT) { const int pi = (int)(i >> 4), fi = (int)(i & 15); const double pos = pi < SEQ ? (double)pi : (double)(PAST + pi - SEQ);
            const double ang = pos * exp(-(double)fi / 16.0 * 9.210340371976184); ropec[i] = (float)cos(ang); ropes[i] = (float)sin(ang); }
        for (size_t i = gtid; i < (size_t)DEPTH * 256; i += NGT) WSP(float, W_SP)[i] = log1pf(expf(-p.in[26][i]));
        LAS float* scr = (LAS float*)(lds + wave * 8448);
        for (int l = 0; l < DEPTH; ++l) {
            h16* wt_in = WSP(h16, W_WIN + l * SZ_WIN); h16* wt_uq = WSP(h16, W_WUQ + l * SZ_WUQ); h16* wt_kv = WSP(h16, W_WKV + l * SZ_WKV);
            h16* wt_o = WSP(h16, W_WO + l * SZ_WO); h16* wt_os = WSP(h16, W_WOS + l * SZ_WOS); h16* wt_up = WSP(h16, W_WUP + l * SZ_WUP); h16* wt_dn = WSP(h16, W_WDN + l * SZ_WDN);
            h16* wt_ql = WSP(h16, W_WQL + l * SZ_WQL); h16* wt_g = WSP(h16, W_WG + l * SZ_WG);
            const float* w_in = p.in[11] + (size_t)l * DM * DIN; const float* w_o = p.in[12] + (size_t)l * DM * DM; const float* w_uq = p.in[16] + (size_t)l * 384 * 768;
            const float* w_uk = p.in[18] + (size_t)l * 256 * 512; const float* w_uv = p.in[19] + (size_t)l * 256 * 512; const float* w_up = p.in[27] + (size_t)l * DM * DFF2; const float* w_dn = p.in[30] + (size_t)l * DFF * DM;
            const float* w_r = p.in[22] + (size_t)l * 4 * 64 * 64; const float* w_i = p.in[24] + (size_t)l * 4 * 64 * 64;
            for (int it = gw; it < 16 * 53; it += NGW) transpose_item<0>(w_in, DIN, 53, wt_in, 1024, scr, it, lane, l > 0 ? p.in[9] + (l - 1) * DM : nullptr, l > 0 ? p.in[10] + (l - 1) * DM : nullptr, rep ? nullptr : WSP(float, W_CD + l * SZ_CD), WSP(float, W_CD + l * SZ_CD) + ZW);
            for (int it = gw; it < 6 * 24; it += NGW) transpose_item<1>(w_uq, 768, 24, wt_uq, 384, scr, it, lane);
            for (int it = gw; it < 4 * 16; it += NGW) transpose_item<0>(w_uk, 512, 16, wt_kv, 256, scr, it, lane);
            for (int it = gw; it < 4 * 16; it += NGW) transpose_item<0>(w_uv, 512, 16, wt_kv + 512 * 256, 256, scr, it, lane);
            for (int it = gw; it < 16 * 32; it += NGW) transpose_item<0>(w_o, 1024, 32, wt_o, 1024, scr, it, lane);
            for (int it = gw; it < 16 * 176; it += NGW) transpose_item<0>(w_up, DFF2, 176, wt_up, 1024, scr, it, lane, p.in[7] + l * DM, p.in[8] + l * DM, rep ? nullptr : WSP(float, W_CD + l * SZ_CD) + 2 * ZW, WSP(float, W_CD + l * SZ_CD) + 2 * ZW + DFF2);
            for (int it = gw; it < 44 * 32; it += NGW) transpose_item<0>(w_dn, 1024, 32, wt_dn, DFF, scr, it, lane);
            for (size_t i = gtid; i < (size_t)(ZW - DIN) * 1024 / 8; i += NGT) *(h8*)(wt_in + (size_t)DIN * 1024 + i * 8) = (h8){0, 0, 0, 0, 0, 0, 0, 0};
            for (size_t i = gtid; i < (size_t)512 * 256; i += NGT) { const int n = (int)(i >> 8), k = (int)(i & 255); const int pn = n >> 8, jj = n & 127, isI = (n >> 7) & 1, ch = pn * 128 + jj;
                float v = 0.f; if ((k >> 6) == (ch >> 6)) v = (isI ? w_i : w_r)[((ch >> 6) * 64 + (k & 63)) * 64 + (ch & 63)];
                wt_g[i] = (h16)v; }
            for (int it = gw; it < 8 * 24 * 16; it += NGW) { const int hh = it / (24 * 16), kt = (it / 16) % 24, ct = it % 16, fr = lane & 15, g4 = lane >> 4;
                f4 accq = (f4){0.f, 0.f, 0.f, 0.f};
#pragma unroll
                for (int ks = 0; ks < 2; ++ks) { const float* ap = w_uq + (size_t)(16 * kt + fr) * 768 + hh * 96 + 32 * ks + 8 * g4; const float* bp = w_uk + (size_t)(16 * ct + fr) * 512 + hh * 64 + 32 * ks + 8 * g4;
                    accq = __builtin_amdgcn_mfma_f32_16x16x32_f16(pack8(*(const f4*)ap, *(const f4*)(ap + 4)), pack8(*(const f4*)bp, *(const f4*)(bp + 4)), accq, 0, 0, 0); }
                *(h4*)(wt_ql + (size_t)(hh * 256 + 16 * ct + fr) * 384 + 16 * kt + 4 * g4) = pack4(accq); }
            for (size_t i = gtid; i < (size_t)8 * 64 * 256; i += NGT) { const int c = (int)(i & 255), hd = (int)(i >> 8); wt_os[i] = (h16)w_uv[(size_t)c * 512 + hd]; }
        }
    }
    grid.sync();

    for (int l = 0; l < DEPTH; ++l) {
        for (int rep = 0; rep < NREP(1); ++rep) if (PHM & (1u << 1)) { PH_BEGIN
          Gemm g{WSP(h16, W_XH), WSP(h16, W_WIN + lq * SZ_WIN), MT, ZW, 1024, 1024, 1024}; StaticOrder S; S.init(MT, ZW, G, bid); const int lp = lq > 0 ? lq - 1 : 0; EpiZ E{WSP(h16, W_Z), out + O_SV + (size_t)lq * MS * 256, WSP(float, W_STATS + (size_t)(lp * 2 + 1) * SZ_STATS), WSP(float, W_CD + lq * SZ_CD), WSP(float, W_CD + lq * SZ_CD) + ZW, lq > 0}; gemm_phase(lds, g, S, E, tid); }
        GSYNC();

        for (int rep = 0; rep < NREP(2); ++rep) if (PHM & (1u << 2)) { PH_BEGIN
            const float* qn_g = kp->in[15] + lq * 384; const float* kvn_g = kp->in[17] + lq * 256;
            const float* cw = kp->in[20] + (size_t)lq * 4 * 256; const float* cb = kp->in[21] + lq * 256; const float* stc = kp->in[5] + (size_t)lq * DBATCH * 3 * 256;
            const h16* z = WSP(h16, W_Z); h16* cqn = WSP(h16, W_CQN); h16* ckvn = WSP(h16, W_CKVN); h16* knew = WSP(h16, W_KNEW); h16* kb = WSP(h16, W_K); h16* xc = WSP(h16, W_XC);
            const float* ropec = WSP(float, W_ROPE); const float* ropes = ropec + NPOS * 16;
            for (int row = gw; row < MT; row += NGW) {
                const h16* zr = z + (size_t)row * ZW; const bool samp = row >= MP; const int rs = row - MP;
                const int t = samp ? (rs & 31) : (row & (SEQ - 1)), bb = samp ? (rs >> 5) : (row >> 11);
                { float v[6]; float ss = 0.f;
#pragma unroll
                    for (int i = 0; i < 3; ++i) { const h2 x = *(const h2*)(zr + 512 + 2 * lane + 128 * i); v[2 * i] = (float)x[0]; v[2 * i + 1] = (float)x[1]; ss += v[2 * i] * v[2 * i] + v[2 * i + 1] * v[2 * i + 1]; }
                    const float rr = rsqrtf(wave_sum(ss, lane) * (1.f / 384.f) + 1e-6f);
#pragma unroll
                    for (int i = 0; i < 3; ++i) { const int c = 2 * lane + 128 * i; h2 o; o[0] = (h16)(v[2 * i] * rr * qn_g[c]); o[1] = (h16)(v[2 * i + 1] * rr * qn_g[c + 1]); *(h2*)(cqn + (size_t)row * 384 + c) = o; } }
                { const h4 x = *(const h4*)(zr + 896 + 4 * lane); f4 v; float ss = 0.f;
#pragma unroll
                    for (int e = 0; e < 4; ++e) { v[e] = (float)x[e]; ss += v[e] * v[e]; }
                    const float rr = rsqrtf(wave_sum(ss, lane) * (1.f / 256.f) + 1e-6f); const f4 gg = *(const f4*)(kvn_g + 4 * lane); v = v * rr * gg;
                    if (!samp) { *(f4*)(out + O_PLAT + ((size_t)lq * MP + row) * 256 + 4 * lane) = v; *(h4*)(ckvn + (size_t)row * 256 + 4 * lane) = pack4(v); }
                    else { *(f4*)(out + O_SLAT + ((size_t)lq * MS + rs) * 256 + 4 * lane) = v; *(h4*)(knew + (size_t)rs * KNW + 4 * lane) = pack4(v); } }
                if (lane < 16) { const int pidx = samp ? SEQ + t : t; const float c = ropec[pidx * 16 + lane], s = ropes[pidx * 16 + lane];
                    const float x1 = (float)zr[1152 + lane], x2 = (float)zr[1168 + lane], o1 = x1 * c - x2 * s, o2 = x1 * s + x2 * c;
                    if (!samp) { float* o = out + O_PKR + ((size_t)lq * MP + row) * 32; o[lane] = o1; o[16 + lane] = o2;
                        h16* kr = kb + (size_t)row * KW + 64;
#pragma unroll
                        for (int hh = 0; hh < 8; ++hh) { kr[hh * 96 + lane] = (h16)o1; kr[hh * 96 + 16 + lane] = (h16)o2; } }
                    else { float* o = out + O_SKR + ((size_t)lq * MS + rs) * 32; o[lane] = o1; o[16 + lane] = o2; knew[(size_t)rs * KNW + 256 + lane] = (h16)o1; knew[(size_t)rs * KNW + 272 + lane] = (h16)o2; } }
                { const int c = 4 * lane; f4 accv = *(const f4*)(cb + c);
#pragma unroll
                    for (int j = 0; j < 4; ++j) { const int tau = t - 3 + j; f4 xv;
                        if (tau >= 0) { const h4 x = *(const h4*)(zr - (ptrdiff_t)(3 - j) * ZW + 1184 + c); xv = (f4){(float)x[0], (float)x[1], (float)x[2], (float)x[3]}; }
                        else if (samp) xv = *(const f4*)(stc + ((size_t)bb * 3 + (3 + tau)) * 256 + c);
                        else xv = (f4){0.f, 0.f, 0.f, 0.f};
                        accv += xv * *(const f4*)(cw + j * 256 + c);
                        if (j == 3) { const int T = samp ? DSEQ : SEQ; if (t >= T - 3) { float* o = samp ? out + O_SLC + (((size_t)lq * DBATCH + bb) * 3 + (t - (T - 3))) * 256 : out + O_PLC + (((size_t)lq * NB + bb) * 3 + (t - (T - 3))) * 256; *(f4*)(o + c) = xv; } } }
                    *(h4*)(xc + (size_t)row * 256 + c) = pack4(accv); }
            }
        }
        GSYNC();

        for (int rep = 0; rep < NREP(3); ++rep) if (PHM & (1u << 3)) { PH_BEGIN
          Gemm g{WSP(h16, W_CQN), WSP(h16, W_WUQ + lq * SZ_WUQ), MT, 768, 384, 384, 384}; StaticOrder S; S.init(MT, 768, G, bid);
          EpiQ E{WSP(h16, W_Q), WSP(h16, W_QLAT), WSP(float, W_ROPE), WSP(float, W_ROPE) + NPOS * 16}; gemm_phase(lds, g, S, E, tid); }
        for (int rep = 0; rep < NREP(4); ++rep) if (PHM & (1u << 4)) { PH_BEGIN
          Gemm g{WSP(h16, W_CKVN), WSP(h16, W_WKV + lq * SZ_WKV), MP, 1024, 256, 256, 256}; StaticOrder S; S.init(MP, 1024, G, (bid + G - (396 % G)) % G); EpiKV E{WSP(h16, W_K), WSP(h16, W_V)}; gemm_phase(lds, g, S, E, tid); }
        for (int rep = 0; rep < NREP(5); ++rep) if (PHM & (1u << 5)) { PH_BEGIN
          Gemm g{WSP(h16, W_XC), WSP(h16, W_WG + lq * SZ_WG), MT, 512, 256, 256, 256}; StaticOrder S; S.init(MT, 512, G, (bid + G - (908 % G)) % G);
          EpiGate E{WSP(h16, W_XC), WSP(float, W_A), WSP(float, W_B), kp->in[23] + lq * 256, kp->in[25] + lq * 256, WSP(float, W_SP) + lq * 256}; gemm_phase(lds, g, S, E, tid); }
        for (int rep = 0; rep < NREP(6); ++rep) if (PHM & (1u << 6)) { PH_BEGIN
          Gemm g{WSP(h16, W_CQN) + (size_t)MP * 384, WSP(h16, W_WQL + lq * SZ_WQL), MS, 2048, 384, 384, 384}; StaticOrder S; S.init(MS, 2048, G, (bid + G - (1172 % G)) % G); EpiQlat E{WSP(h16, W_QLAT)}; gemm_phase(lds, g, S, E, tid); }
        for (int rep = 0; rep < NREP(7); ++rep) if (PHM & (1u << 7)) { PH_BEGIN
            const float* gw_s = kp->in[13] + (size_t)lq * 4 * 128 * 128; const float* gb_s = kp->in[14] + (size_t)lq * 4 * 128;
            const h16* z = WSP(h16, W_Z); h16* cat = WSP(h16, W_CAT); h16* cats = WSP(h16, W_CATS);
            const int fr = lane & 15, g4 = lane >> 4, q_ = fr >> 2, p_ = fr & 3;
            for (int item = (bid + G - (1204 % G)) % G; item < 1024 + 128; item += G) {
                const bool samp = item >= 1024; const int head = item & 3; const int ci = samp ? (item - 1024) >> 2 : item >> 2;
                const int R0 = samp ? MP + ci * 32 : ci * 128, L = samp ? 32 : 128;
                __syncthreads();
                for (int id = tid; id < L * 8; id += 512) { const int j = id >> 3, part = id & 7; *(LAS h8*)(lds + j * 144 + part * 16) = *(const h8*)(z + (size_t)(R0 + j) * ZW + 256 + head * 64 + part * 8); }
                __syncthreads();
                const int i0 = 16 * wave;
                if (i0 < L) {
                    f4 sacc[4];
#pragma unroll
                    for (int ct = 0; ct < 4; ++ct) sacc[ct] = (f4){0.f, 0.f, 0.f, 0.f};
                    const int i = i0 + fr;
#pragma unroll
                    for (int ks = 0; ks < 4; ++ks) if (32 * ks <= i0 + 15 && 32 * ks < L) {
                        const int j0 = 32 * ks + 8 * g4; const float* wp = gw_s + ((size_t)head * 128 + i) * 128 + j0; const f4 w0 = *(const f4*)wp, w1 = *(const f4*)(wp + 4);
                        h8 wf;
#pragma unroll
                        for (int e = 0; e < 4; ++e) { wf[e] = (h16)((j0 + e <= i) ? w0[e] : 0.f); wf[4 + e] = (h16)((j0 + 4 + e <= i) ? w1[e] : 0.f); }
#pragma unroll
                        for (int ct = 0; ct < 4; ++ct) { const h4 lo = trrd(lds + (32 * ks + 8 * g4 + q_) * 144 + (16 * ct + 4 * p_) * 2), hi = trrd(lds + (32 * ks + 8 * g4 + 4 + q_) * 144 + (16 * ct + 4 * p_) * 2);
                            sacc[ct] = __builtin_amdgcn_mfma_f32_16x16x32_f16(wf, cat44(lo, hi), sacc[ct], 0, 0, 0); } }
#pragma unroll
                    for (int jx = 0; jx < 4; ++jx) { const int ii = i0 + 4 * g4 + jx; const float bs = gb_s[head * 128 + ii]; const size_t r = (size_t)R0 + ii;
#pragma unroll
                        for (int ct = 0; ct < 4; ++ct) { const int d = head * 64 + 16 * ct + fr; const float uval = (float)z[r * ZW + d]; const h16 o = (h16)(uval * (sacc[ct][jx] + bs));
                            cat[r * 1024 + d] = o; } }
                }
            }
            __syncthreads();
        }
        GSYNC();

        for (int rep = 0; rep < NREP(8); ++rep) if (PHM & (1u << 8)) { PH_BEGIN
            unsigned* counter = WSP(unsigned, W_CTR) + lq * 16 + rep * 8;
            const int fr = lane & 15, g4 = lane >> 4;
            constexpr int N_SA = 256, N_PA = 1024, N_PS = 128, N_SS = 16, N_ALL = N_SA + N_PA + N_PS + N_SS;
            for (;;) {
                __syncthreads();
                if (tid == 0) s_item = (int)atomicAdd(counter, 1u);
                __syncthreads();
                const int qi = s_item;
                if (qi >= N_ALL) break;
                int tix = tid; asm volatile("" : "+v"(tix));
                const int item = qi < N_PS + N_SS ? qi + N_SA + N_PA : qi - (N_PS + N_SS);
                if (item < N_SA) {
                    constexpr int KS = 592;
                    const float* clat = kp->in[2] + (size_t)lq * DBATCH * PAST * 256; const float* ckr = kp->in[3] + (size_t)lq * DBATCH * PAST * 32;
                    const h16* qlat = WSP(h16, W_QLAT); const h16* knew = WSP(h16, W_KNEW); h16* cats = WSP(h16, W_CATS);
                    const int b = item >> 3, hg = (item >> 2) & 1, sp = item & 3, head = 4 * hg + (wave >> 1), tq = 16 * (wave & 1) + fr, t0 = sp * 16;
                    h8 qf[1][9];
#pragma unroll
                    for (int ks = 0; ks < 9; ++ks) qf[0][ks] = *(const h8*)(qlat + (size_t)(b * 32 + tq) * QLW + head * 288 + 32 * ks + 8 * g4);
                    f4 o[1][16]; float mrow[1] = {-1e30f}, lrow[1] = {0.f};
#pragma unroll
                    for (int ct = 0; ct < 16; ++ct) o[0][ct] = (f4){0.f, 0.f, 0.f, 0.f};
                    const float* lb = clat + (size_t)b * PAST * 256 + (size_t)(t0 * 64 + (tix >> 6)) * 256 + (tix & 63) * 4; const float* rb = ckr + (size_t)b * PAST * 32 + (size_t)(t0 * 64 + (tix >> 3)) * 32 + (tix & 7) * 4;
                    const int wl = (tix >> 6) * KS + (tix & 63) * 8, wr_ = (tix >> 3) * KS + 512 + (tix & 7) * 8;
                    f4 pl[4]; f4 pr;
#pragma unroll
                    for (int hf = 0; hf < 2; ++hf) {
#pragma unroll
                        for (int i = 0; i < 4; ++i) pl[i] = *(const f4*)(lb + (size_t)(hf * 4 + i) * 8 * 256);
#pragma unroll
                        for (int i = 0; i < 4; ++i) *(LAS h4*)(lds + wl + (hf * 4 + i) * 8 * KS) = pack4(pl[i]); }
                    pr = *(const f4*)rb;
                    *(LAS h4*)(lds + wr_) = pack4(pr);
                    __syncthreads();
                    for (int t = 0; t < 16; ++t) {
                        LAS unsigned char* cur = lds + (t & 1) * (64 * KS); LAS unsigned char* nxt = lds + ((t + 1) & 1) * (64 * KS);
                        const bool more = t + 1 < 16;
                        if (more) {
#pragma unroll
                            for (int i = 0; i < 4; ++i) pl[i] = *(const f4*)(lb + ((size_t)(t + 1) * 64 + i * 8) * 256);
                            pr = *(const f4*)(rb + (size_t)(t + 1) * 64 * 32);
                        }
                        h8 pf[1][2];
                        attn_qk<9, 16, 1, KS>(cur, qf, o, mrow, lrow, pf, 4, lane);
                        if (more) {
#pragma unroll
                            for (int i = 0; i < 4; ++i) *(LAS h4*)(nxt + wl + i * 8 * KS) = pack4(pl[i]);
                            *(LAS h4*)(nxt + wr_) = pack4(pr);
#pragma unroll
                            for (int i = 0; i < 4; ++i) pl[i] = *(const f4*)(lb + ((size_t)(t + 1) * 64 + (4 + i) * 8) * 256);
                        }
                        attn_pv<16, 1, KS>(cur, o, pf, 4, lane);
                        if (more) {
#pragma unroll
                            for (int i = 0; i < 4; ++i) *(LAS h4*)(nxt + wl + (4 + i) * 8 * KS) = pack4(pl[i]);
                        } else if (sp == 3) {
                            for (int id = tix; id < 32 * 36; id += 512) { const int key = id / 36, part = id % 36; *(LAS h8*)(nxt + key * KS + part * 16) = *(const h8*)(knew + (size_t)(b * 32 + key) * KNW + part * 8); }
                        }
                        __syncthreads();
                    }
                    if (sp == 3) attn_tile<9, 16, 1, KS, KS>(lds, lds, qf, o, mrow, lrow, 2, lane);
                    { unsigned char* pw = ws + W_PART + ((size_t)item * 8 + wave) * SZ_PARTW;
#pragma unroll
                      for (int ct = 0; ct < 16; ++ct) *(f4*)(pw + ct * 1024 + lane * 16) = o[0][ct];
                      *(float*)(pw + 16384 + lane * 4) = mrow[0]; *(float*)(pw + 16640 + lane * 4) = lrow[0]; }
                    asm volatile("s_waitcnt vmcnt(0)" ::: "memory");
                    __syncthreads();
                    if (tix == 0) { __builtin_amdgcn_fence(__ATOMIC_RELEASE, "agent"); asm volatile("s_waitcnt vmcnt(0)" ::: "memory");
                        const unsigned old = xb_add(WSP(unsigned, W_CTR) + 256 + lq * 64 + rep * 512 + (item >> 2), 1u);
                        if (old == 3u) { __builtin_amdgcn_fence(__ATOMIC_ACQUIRE, "agent"); asm volatile("s_waitcnt vmcnt(0)" ::: "memory"); }
                        *((LAS int*)&s_ctl + 3) = (int)old; }
                    __syncthreads();
                    if (*((LAS int*)&s_ctl + 3) == 3) {
                        const unsigned char* p0 = ws + W_PART + ((size_t)(item & ~3) * 8 + wave) * SZ_PARTW;
                        float mi[4], M = -1e30f;
#pragma unroll
                        for (int i = 0; i < 4; ++i) { mi[i] = *(const float*)(p0 + (size_t)i * 8 * SZ_PARTW + 16384 + lane * 4); M = fmaxf(M, mi[i]); }
                        float L = 0.f;
#pragma unroll
                        for (int i = 0; i < 4; ++i) { mi[i] = __builtin_amdgcn_exp2f(mi[i] - M); L += mi[i] * *(const float*)(p0 + (size_t)i * 8 * SZ_PARTW + 16640 + lane * 4); }
                        L += shx(L, 16, lane); L += shx(L, 32, lane); const float inv = 1.f / L;
                        h8 bf[8];
#pragma unroll
                        for (int ks = 0; ks < 8; ++ks) { f4 u0 = (f4){0.f, 0.f, 0.f, 0.f}, u1 = u0;
#pragma unroll
                            for (int i = 0; i < 4; ++i) { u0 += *(const f4*)(p0 + (size_t)i * 8 * SZ_PARTW + (2 * ks) * 1024 + lane * 16) * mi[i]; u1 += *(const f4*)(p0 + (size_t)i * 8 * SZ_PARTW + (2 * ks + 1) * 1024 + lane * 16) * mi[i]; }
                            bf[ks] = pack8(u0 * inv, u1 * inv); }
                        const h16* wuvt = WSP(h16, W_WOS + lq * SZ_WOS) + (size_t)head * 64 * 256;
                        h16* dst = cats + (size_t)(b * 32 + tq) * 1024 + 256 + head * 64 + 4 * g4;
#pragma unroll
                        for (int dt = 0; dt < 4; ++dt) { f4 od = (f4){0.f, 0.f, 0.f, 0.f};
#pragma unroll
                            for (int ks = 0; ks < 8; ++ks) { const h16* wp = wuvt + (size_t)(16 * dt + fr) * 256 + 32 * ks + 4 * g4;
                                od = __builtin_amdgcn_mfma_f32_16x16x32_f16(cat44(*(const h4*)wp, *(const h4*)(wp + 16)), bf[ks], od, 0, 0, 0); }
                            *(h4*)(dst + 16 * dt) = pack4(od); }
                    }
                } else if (item < N_SA + N_PA) {
                    constexpr int KS = 208, VS = 144, KBUF = 64 * KS, VBUF = 64 * VS;
                    const h16* qb = WSP(h16, W_Q); const h16* kb = WSP(h16, W_K); const h16* vb = WSP(h16, W_V); h16* cat = WSP(h16, W_CAT);
                    const int it = item - N_SA, qblk = 7 - (it >> 7), bh = it & 127, b = bh >> 3, head = bh & 7;
                    const int r0 = qblk * 256 + 32 * wave, ntw = (r0 >> 6) + 1, ntb = 4 * (qblk + 1);
                    h8 qf[2][3];
#pragma unroll
                    for (int qs = 0; qs < 2; ++qs)
#pragma unroll
                        for (int ks = 0; ks < 3; ++ks) qf[qs][ks] = *(const h8*)(qb + (size_t)(b * SEQ + r0 + 16 * qs + fr) * QW + head * 96 + 32 * ks + 8 * g4);
                    f4 o[2][4]; float mrow[2] = {-1e30f, -1e30f}, lrow[2] = {0.f, 0.f};
#pragma unroll
                    for (int qs = 0; qs < 2; ++qs)
#pragma unroll
                        for (int ct = 0; ct < 4; ++ct) o[qs][ct] = (f4){0.f, 0.f, 0.f, 0.f};
                    const int k0key = tix / 12, k0part = tix % 12, k1key = (tix + 512) / 12, k1part = (tix + 512) % 12, vkey = tix >> 3, vpart = tix & 7;
                    const h16* kg0 = kb + (size_t)b * SEQ * KW + head * 96 + (size_t)k0key * KW + k0part * 8; const h16* kg1 = kb + (size_t)b * SEQ * KW + head * 96 + (size_t)k1key * KW + k1part * 8;
                    const h16* vg = vb + (size_t)b * SEQ * VW + head * 64 + (size_t)vkey * VW + vpart * 8;
                    const int lk0 = k0key * KS + k0part * 16, lk1 = k1key * KS + k1part * 16, lv = 2 * KBUF + vkey * VS + vpart * 16;
                    h8 pk0, pk1 = (h8){0, 0, 0, 0, 0, 0, 0, 0}, pv;
                    pk0 = *(const h8*)kg0; if (tix < 256) pk1 = *(const h8*)kg1; pv = *(const h8*)vg;
                    *(LAS h8*)(lds + lk0) = pk0; if (tix < 256) *(LAS h8*)(lds + lk1) = pk1; *(LAS h8*)(lds + lv) = pv;
                    __syncthreads();
                    for (int t = 0; t < ntb; ++t) {
                        const int co = (t & 1), no = ((t + 1) & 1);
                        if (t + 1 < ntb) { const size_t ro = (size_t)(t + 1) * 64;
                            pk0 = *(const h8*)(kg0 + ro * KW); if (tix < 256) pk1 = *(const h8*)(kg1 + ro * KW); pv = *(const h8*)(vg + ro * VW); }
                        if (t < ntw) attn_tile<3, 4, 2, KS, VS>(lds + co * KBUF, lds + 2 * KBUF + co * VBUF, qf, o, mrow, lrow, 4, lane);
                        if (t + 1 < ntb) { *(LAS h8*)(lds + no * KBUF + lk0) = pk0; if (tix < 256) *(LAS h8*)(lds + no * KBUF + lk1) = pk1; *(LAS h8*)(lds + no * VBUF + lv) = pv; }
                        __syncthreads();
                    }
#pragma unroll
                    for (int qs = 0; qs < 2; ++qs) { float lt = lrow[qs]; lt += shx(lt, 16, lane); lt += shx(lt, 32, lane); const float inv = 1.f / lt;
                        h16* dst = cat + (size_t)(b * SEQ + r0 + 16 * qs + fr) * 1024 + 256 + head * 64 + 4 * g4;
#pragma unroll
                        for (int ct = 0; ct < 4; ++ct) *(h4*)(dst + 16 * ct) = pack4(o[qs][ct] * inv); }
                } else if (item < N_SA + N_PA + N_PS) {
                    const float* abuf = WSP(float, W_A); const float* bbuf = WSP(float, W_B); const h16* z = WSP(h16, W_Z); h16* cat = WSP(h16, W_CAT);
                    const int it = item - N_SA - N_PA, b = it >> 3, ch = (it & 7) * 32 + (lane & 31), seg = wave * 2 + (lane >> 5), tl = seg * 32 + (lane & 31);
                    const size_t rbase = (size_t)b * SEQ + seg * 128;
                    float A = 1.f, B = 0.f;
#pragma unroll 16
                    for (int i = 0; i < 128; ++i) { const float a = abuf[(rbase + i) * 256 + ch], bb = bbuf[(rbase + i) * 256 + ch]; B = a * B + bb; A *= a; }
                    LAS float* sA = (LAS float*)lds; LAS float* sB = sA + 512;
                    sA[tl] = A; sB[tl] = B;
                    __syncthreads();
                    float h = 0.f;
                    for (int s2 = 0; s2 < seg; ++s2) h = sA[s2 * 32 + (lane & 31)] * h + sB[s2 * 32 + (lane & 31)];
#pragma unroll 16
                    for (int i = 0; i < 128; ++i) { const float a = abuf[(rbase + i) * 256 + ch], bb = bbuf[(rbase + i) * 256 + ch]; h = a * h + bb;
                        const float gt = (float)z[(rbase + i) * ZW + 1440 + ch]; cat[(rbase + i) * 1024 + 768 + ch] = (h16)(h * gt); }
                    if (seg == 15) out[O_PH + ((size_t)lq * NB + b) * 256 + ch] = h;
                } else {
                    const float* abuf = WSP(float, W_A); const float* bbuf = WSP(float, W_B); const h16* z = WSP(h16, W_Z); h16* cats = WSP(h16, W_CATS);
                    const int it = item - N_SA - N_PA - N_PS, idx = it * 512 + tix, b = idx >> 8, ch = idx & 255;
                    float h = kp->in[4][((size_t)lq * DBATCH + b) * 256 + ch];
                    for (int t = 0; t < DSEQ; ++t) { const size_t r = (size_t)MP + b * 32 + t; h = abuf[r * 256 + ch] * h + bbuf[r * 256 + ch];
                        const float gt = (float)z[r * ZW + 1440 + ch]; cats[(size_t)(b * 32 + t) * 1024 + 768 + ch] = (h16)(h * gt); }
                    out[O_SH + ((size_t)lq * DBATCH + b) * 256 + ch] = h;
                }
            }
        }
        GSYNC();

        for (int rep = 0; rep < NREP(9); ++rep) if (PHM & (1u << 9)) { PH_BEGIN
          const int lp = lq > 0 ? lq - 1 : 0;
          Gemm g{WSP(h16, W_CAT), WSP(h16, W_WO + lq * SZ_WO), MT, 1024, 1024, 1024, 1024}; StaticOrder S; S.init(MT, 1024, G, bid);
          EpiRes E{WSP(h16, W_XH), WSP(float, W_STATS + (size_t)(lp * 2 + 1) * SZ_STATS), kp->in[9] + lp * DM, kp->in[10] + lp * DM, lq > 0, WSP(float, W_STATS + (size_t)(lq * 2) * SZ_STATS)}; gemm_phase(lds, g, S, E, tid); }
        GSYNC();

        for (int rep = 0; rep < NREP(12); ++rep) if (PHM & (1u << 12)) { PH_BEGIN
          Gemm g{WSP(h16, W_XH), WSP(h16, W_WUP + lq * SZ_WUP), MT, DFF2, 1024, 1024, 1024}; StaticOrder S; S.init(MT, DFF2, G, bid);
          EpiUp E{WSP(h16, W_UP), out + O_PFC + (size_t)lq * NB * 2 * DFF2, (O_SFC + (size_t)lq * DBATCH * 2 * DFF2) - (O_PFC + (size_t)lq * NB * 2 * DFF2), WSP(float, W_STATS + (size_t)(lq * 2) * SZ_STATS), WSP(float, W_CD + lq * SZ_CD) + 2 * ZW, WSP(float, W_CD + lq * SZ_CD) + 2 * ZW + DFF2}; gemm_phase(lds, g, S, E, tid); }
        GSYNC();

        for (int rep = 0; rep < NREP(13); ++rep) if (PHM & (1u << 13)) { PH_BEGIN
            conv_gate_items((unsigned)((MP / 4) * (DFF / 8)) + (unsigned)gtid, (unsigned)((MT / 4) * (DFF / 8)), (unsigned)NGT, 4, WSP(h16, W_UP), WSP(h16, W_ACT),
                            kp->in[28] + (size_t)lq * 3 * DFF2, kp->in[29] + (size_t)lq * DFF2, kp->in[6] + (size_t)lq * DBATCH * 2 * DFF2); }
        GSYNC();
        for (int rep = 0; rep < NREP(13); ++rep) if (PHM & (1u << 13)) { PH_BEGIN
            if (bid < 16) { const size_t ro = (size_t)(MP / BM + (bid >> 2)) * BM;
                Gemm g{WSP(h16, W_ACT) + ro * DFF, WSP(h16, W_WDN + lq * SZ_WDN), BM, 1024, DFF, DFF, DFF}; StaticOrder S; S.init(BM, 1024, 4, bid & 3);
                EpiRes E{WSP(h16, W_XH) + ro * DM, WSP(float, W_STATS + (size_t)(lq * 2) * SZ_STATS) + 2 * ro, kp->in[7] + lq * DM, kp->in[8] + lq * DM, true, WSP(float, W_STATS + (size_t)(lq * 2 + 1) * SZ_STATS) + 2 * ro}; gemm_phase(lds, g, S, E, tid); }
            else conv_gate_items((unsigned)(gtid - 16 * 512), (unsigned)((DFF / 8) * (MP / 32)), (unsigned)(NGT - 16 * 512), 32, WSP(h16, W_UP), WSP(h16, W_ACT),
                                 kp->in[28] + (size_t)lq * 3 * DFF2, kp->in[29] + (size_t)lq * DFF2, kp->in[6] + (size_t)lq * DBATCH * 2 * DFF2); }
        GSYNC();

        for (int rep = 0; rep < NREP(14); ++rep) if (PHM & (1u << 14)) { PH_BEGIN
          Gemm g{WSP(h16, W_ACT), WSP(h16, W_WDN + lq * SZ_WDN), MP, 1024, DFF, DFF, DFF}; StaticOrder S; S.init(MP, 1024, G, bid); EpiRes E{WSP(h16, W_XH), WSP(float, W_STATS + (size_t)(lq * 2) * SZ_STATS), kp->in[7] + lq * DM, kp->in[8] + lq * DM, true, WSP(float, W_STATS + (size_t)(lq * 2 + 1) * SZ_STATS)}; gemm_phase(lds, g, S, E, tid); }
        GSYNC();

    }
    { const int l = DEPTH - 1; PH_BEGIN
        const float* gg = kp->in[9] + lq * DM; const float* bb = kp->in[10] + lq * DM; const h16* pre2 = WSP(h16, W_XH); const float* st = WSP(float, W_STATS + (size_t)(lq * 2 + 1) * SZ_STATS);
        for (size_t i = gtid; i < (size_t)MT * (DM / 4); i += NGT) { const int row = (int)(i >> 8), c = (int)(i & 255) * 4;
            const float sm = st[2 * row], sq = st[2 * row + 1], mean = sm * (1.f / DM), rstd = rsqrtf(sq * (1.f / DM) - mean * mean + 1e-5f);
            const h4 xv = *(const h4*)(pre2 + (size_t)row * DM + c);
            *(f4*)(out + O_Y + (size_t)row * DM + c) = ((f4){(float)xv[0], (float)xv[1], (float)xv[2], (float)xv[3]} - mean) * rstd * *(const f4*)(gg + c) + *(const f4*)(bb + c); }
    }
}

extern "C" void kernel_launch(void* const* d_in, const int* in_sizes, int n_in, void* d_out, int out_size, void* d_ws, size_t ws_size, hipStream_t stream) {
    constexpr size_t kDynLds = STAGE_BYTES;
    static int grid_blocks = 0;
    if (!grid_blocks) {
        if (n_in != 31 || (size_t)out_size != O_END || ws_size < W_END) { fprintf(stderr, "kernel_launch: unexpected shapes n_in %d out %d ws %zu (need %zu)\n", n_in, out_size, ws_size, (size_t)W_END); grid_blocks = -1; return; }
        int dev = 0, cus = 0, per_cu = 0;
        hipGetDevice(&dev);
        hipDeviceGetAttribute(&cus, hipDeviceAttributeMultiprocessorCount, dev);
        hipFuncSetAttribute((const void*)trunk_fwd, hipFuncAttributeMaxDynamicSharedMemorySize, (int)kDynLds);
        hipOccupancyMaxActiveBlocksPerMultiprocessor(&per_cu, (const void*)trunk_fwd, 512, kDynLds);
        if (per_cu < 1) per_cu = 1;
        grid_blocks = cus * per_cu;
        if (grid_blocks > 256) grid_blocks = 256;
        if (grid_blocks < 32) { fprintf(stderr, "kernel_launch: grid %d too small\n", grid_blocks); grid_blocks = -1; return; }
    }
    if (grid_blocks < 0) return;
    hipMemsetAsync((char*)d_ws + W_CTR, 0, W_ZERO_END, stream);
    Params p{};
    for (int i = 0; i < 31; ++i) p.in[i] = (const float*)d_in[i];
    p.out = (float*)d_out; p.ws = (unsigned char*)d_ws;
    void* args[] = {&p};
    hipError_t e = hipLaunchCooperativeKernel((const void*)trunk_fwd, dim3(grid_blocks), dim3(512), args, kDynLds, stream);
    if (e != hipSuccess) fprintf(stderr, "cooperative launch failed: %s (grid %d)\n", hipGetErrorString(e), grid_blocks);
}
```

```cpp
#include <hip/hip_runtime.h>
#include <hip/hip_cooperative_groups.h>
#include <cstdio>
#include <cstdint>
namespace cg = cooperative_groups;

typedef _Float16 h16;
typedef _Float16 h8 __attribute__((ext_vector_type(8)));
typedef _Float16 h4 __attribute__((ext_vector_type(4)));
typedef _Float16 h2 __attribute__((ext_vector_type(2)));
typedef float f4 __attribute__((ext_vector_type(4)));
typedef short s4v __attribute__((__vector_size__(8)));
#define LAS __attribute__((address_space(3)))
#define DEVI __device__ __forceinline__

constexpr int DM = 1024, NB = 16, SEQ = 2048, DEPTH = 4, DBATCH = 32, DSEQ = 32, PAST = 4096;
constexpr int MP = NB * SEQ, MS = DBATCH * DSEQ, MT = MP + MS;
constexpr int DIN = 1696, ZW = 1792, DFF = 2816, DFF2 = 5632;
constexpr int QW = 768, KW = 768, VW = 512, QLW = 2304, CSW = 2560, KNW = 288;
constexpr float ALPHA = 1.681792830507429f;
constexpr float QSCALE = 0.14724444f;
constexpr int NPOS = SEQ + DSEQ;

constexpr size_t O_Y = 0;
constexpr size_t O_PLAT = (size_t)MT * DM;
constexpr size_t O_PKR = O_PLAT + (size_t)DEPTH * MP * 256;
constexpr size_t O_PH = O_PKR + (size_t)DEPTH * MP * 32;
constexpr size_t O_PLC = O_PH + (size_t)DEPTH * NB * 256;
constexpr size_t O_PFC = O_PLC + (size_t)DEPTH * NB * 3 * 256;
constexpr size_t O_SLAT = O_PFC + (size_t)DEPTH * NB * 2 * DFF2;
constexpr size_t O_SKR = O_SLAT + (size_t)DEPTH * MS * 256;
constexpr size_t O_SV = O_SKR + (size_t)DEPTH * MS * 32;
constexpr size_t O_SH = O_SV + (size_t)DEPTH * MS * 256;
constexpr size_t O_SLC = O_SH + (size_t)DEPTH * DBATCH * 256;
constexpr size_t O_SFC = O_SLC + (size_t)DEPTH * DBATCH * 3 * 256;
constexpr size_t O_END = O_SFC + (size_t)DEPTH * DBATCH * 2 * DFF2;

constexpr size_t al(size_t x) { return (x + 255) & ~(size_t)255; }
constexpr size_t W_CTR = 0;
constexpr size_t W_PARAMS = 2048;
constexpr size_t W_BAR = 4096;
constexpr size_t W_CD = 4096 + 16384;
constexpr size_t SZ_CD = (size_t)(2 * ZW + 2 * DFF2) * 4;
constexpr size_t W_STATS = W_CD + DEPTH * SZ_CD;
constexpr size_t SZ_STATS = (size_t)MT * 2 * 4;
constexpr size_t W_ZERO_END = W_STATS + (size_t)DEPTH * 2 * SZ_STATS;
constexpr size_t W_ROPE = al(W_ZERO_END);
constexpr size_t W_SP = al(W_ROPE + (size_t)NPOS * 16 * 2 * 4);
constexpr size_t W_WIN = al(W_SP + (size_t)DEPTH * 256 * 4);
constexpr size_t SZ_WIN = (size_t)ZW * 1024 * 2;
constexpr size_t W_WUQ = W_WIN + DEPTH * SZ_WIN;   constexpr size_t SZ_WUQ = (size_t)768 * 384 * 2;
constexpr size_t W_WQL = W_WUQ + DEPTH * SZ_WUQ;   constexpr size_t SZ_WQL = (size_t)2048 * 384 * 2;
constexpr size_t W_WKV = W_WQL + DEPTH * SZ_WQL;   constexpr size_t SZ_WKV = (size_t)1024 * 256 * 2;
constexpr size_t W_WG = W_WKV + DEPTH * SZ_WKV;    constexpr size_t SZ_WG = (size_t)512 * 256 * 2;
constexpr size_t W_WO = W_WG + DEPTH * SZ_WG;      constexpr size_t SZ_WO = (size_t)1024 * 1024 * 2;
constexpr size_t W_WOS = W_WO + DEPTH * SZ_WO;     constexpr size_t SZ_WOS = (size_t)8 * 64 * 256 * 2;
constexpr size_t W_WUP = W_WOS + DEPTH * SZ_WOS;   constexpr size_t SZ_WUP = (size_t)DFF2 * 1024 * 2;
constexpr size_t W_WDN = W_WUP + DEPTH * SZ_WUP;   constexpr size_t SZ_WDN = (size_t)1024 * DFF * 2;
constexpr size_t W_XH = W_WDN + DEPTH * SZ_WDN;
constexpr size_t W_Z = W_XH + (size_t)MT * 1024 * 2;
constexpr size_t W_CQN = W_Z + (size_t)MT * ZW * 2;
constexpr size_t W_CKVN = W_CQN + (size_t)MT * 384 * 2;
constexpr size_t W_XC = W_CKVN + (size_t)MP * 256 * 2;
constexpr size_t W_Q = W_XC + (size_t)MT * 256 * 2;
constexpr size_t W_K = W_Q + (size_t)MP * QW * 2;
constexpr size_t W_V = W_K + (size_t)MP * KW * 2;
constexpr size_t W_A = W_V + (size_t)MP * VW * 2;
constexpr size_t W_B = W_A + (size_t)MT * 256 * 4;
constexpr size_t W_CAT = W_B + (size_t)MT * 256 * 4;
constexpr size_t W_CATS = W_CAT + (size_t)MP * 1024 * 2;
constexpr size_t W_QLAT = W_CATS + (size_t)MS * 1024 * 2;
constexpr size_t W_KNEW = W_QLAT + (size_t)MS * QLW * 2;
constexpr size_t W_PRE = al(W_KNEW + (size_t)MS * KNW * 2);
constexpr size_t W_X1F = W_PRE + (size_t)MT * 1024 * 4;
constexpr size_t W_UP = W_X1F + (size_t)MT * 1024 * 4;
constexpr size_t W_ACT = W_UP + (size_t)MT * DFF2 * 2;
constexpr size_t W_PART = W_ACT + (size_t)MT * DFF * 2;
constexpr size_t SZ_PARTW = 16 * 1024 + 512;
constexpr size_t W_END = W_PART + (size_t)256 * 8 * SZ_PARTW;

struct Params { const float* in[31]; float* out; unsigned char* ws; };

DEVI float gelu_f(float x) { const float u = -2.302208198f * (x + 0.044715f * x * x * x); return x * __builtin_amdgcn_rcpf(1.f + __builtin_amdgcn_exp2f(u)); }
DEVI float sigmoid_f(float x) { return __builtin_amdgcn_rcpf(1.f + __builtin_amdgcn_exp2f(-1.4426950408889634f * x)); }
DEVI h8 pack8(f4 a, f4 b) { h8 r; r[0] = (h16)a[0]; r[1] = (h16)a[1]; r[2] = (h16)a[2]; r[3] = (h16)a[3]; r[4] = (h16)b[0]; r[5] = (h16)b[1]; r[6] = (h16)b[2]; r[7] = (h16)b[3]; return r; }
DEVI h4 pack4(f4 a) { h4 r; r[0] = (h16)a[0]; r[1] = (h16)a[1]; r[2] = (h16)a[2]; r[3] = (h16)a[3]; return r; }
DEVI float shx(float v, int o, int lane) { return __builtin_bit_cast(float, __builtin_amdgcn_ds_bpermute((lane ^ o) << 2, __builtin_bit_cast(int, v))); }
DEVI float wave_sum(float v, int lane) {
#pragma unroll
    for (int o = 1; o < 64; o <<= 1) v += shx(v, o, lane);
    return v;
}
DEVI int opaque_lane() { unsigned ones = ~0u; asm volatile("" : "+s"(ones)); return (int)__builtin_amdgcn_mbcnt_hi(ones, __builtin_amdgcn_mbcnt_lo(ones, 0u)); }
DEVI h4 trrd(LAS unsigned char* p) { s4v r = __builtin_amdgcn_ds_read_tr16_b64_v4i16((LAS s4v*)p); return __builtin_bit_cast(h4, r); }
DEVI h8 cat44(h4 a, h4 b) { return __builtin_shufflevector(a, b, 0, 1, 2, 3, 4, 5, 6, 7); }

constexpr int BM = 256, BK = 64, HALF = 128, HTB = HALF * BK * 2, STAGE_BYTES = 8 * HTB, NXCD = 8, WGM = 8;
DEVI int lds_byte(int r, int c) { const int st = (r >> 4) * 2 + (c >> 5), rr = r & 15, cc = c & 31, ob = rr * 64 + cc * 2; return st * 1024 + (ob ^ (((ob >> 9) & 1) << 5)); }
DEVI void stage_rc(int b, int& R, int& C) { const int st = b / 1024, sb = b % 1024, swz = sb ^ (((sb >> 9) & 1) << 5); R = (st >> 1) * 16 + swz / 64; C = (st & 1) * 32 + (swz % 64) / 2; }
DEVI int perm32(int rho) { const int n = rho >> 4, i = rho & 15; return 8 * (i >> 2) + 4 * n + (i & 3); }
struct Unit { int pm, pn; };
struct Gemm { const h16* A; const h16* Bt; int M, N, K, lda, ldb; };
struct StaticOrder {
    int nM, nN, nwg, G, c;
    DEVI void init(int M, int N, int G_, int c_) { nM = M / BM; nN = N / BM; nwg = nM * nN; G = G_; c = c_; }
    DEVI bool next(int i, Unit& u) const {
        if (c < 0) return false;
        const long L = (long)i * G + c; if (L >= nwg) return false;
        int wgid = (int)L; { const int q = nwg / NXCD, r = nwg % NXCD, xcd = wgid % NXCD, off = wgid / NXCD; wgid = (xcd < r ? xcd * (q + 1) : r * (q + 1) + (xcd - r) * q) + off; }
        const int nig = WGM * nN, gid = wgid / nig, fm = gid * WGM, gsz = (nM - fm) < WGM ? (nM - fm) : WGM;
        u.pm = fm + ((wgid % nig) % gsz); u.pn = (wgid % nig) / gsz; return true;
    }
};
template <class Epi>
DEVI void gemm_phase(LAS unsigned char* lds, const Gemm g, const StaticOrder& S, const Epi& E, const int tid) {
    const int wid = __builtin_amdgcn_readfirstlane(tid >> 6), lane = tid & 63, wr = wid >> 2, wc = wid & 3, fr = lane & 15, fq = lane >> 4;
    const int K = g.K, nt = K / BK;
    unsigned voffA[2], voffB[2];
#pragma unroll
    for (int i = 0; i < 2; ++i) { int R, C; stage_rc(tid * 16 + i * 8192, R, C); const int Rb = Epi::PERM ? ((R & ~31) + perm32(R & 31)) : R;
        voffA[i] = (unsigned)(R * g.lda + C) * 2u; voffB[i] = (unsigned)(Rb * g.ldb + C) * 2u; }
    const size_t kstep = (size_t)(BK * 2);
    const size_t hstepA = (size_t)HALF * g.lda * 2, hstepB = (size_t)HALF * g.ldb * 2;
    const size_t tstepA = 2 * hstepA, tstepB = 2 * hstepB;
    const unsigned ldsw = (unsigned)wid * 1024u;
    const int aoff = lds_byte(wr * 64 + fr, fq * 8), boff = lds_byte(wc * 32 + fr, fq * 8);
#define PG8_SA(b, h) (((b) * 2 + (h)) * HTB)
#define PG8_SB(b, h) ((4 + (b) * 2 + (h)) * HTB)
#define PG8_STAGE(bufoff, gbase, voff) do { _Pragma("unroll") for (int _i = 0; _i < 2; ++_i) \
        __builtin_amdgcn_global_load_lds((const unsigned*)((const char*)(gbase) + (voff)[_i]), (LAS unsigned*)(lds + (bufoff) + ldsw + _i * 8192), 16, 0, 0); } while (0)
#define PG8_LDA(dst, b, h) do { _Pragma("unroll") for (int m = 0; m < 4; ++m) _Pragma("unroll") for (int k = 0; k < 2; ++k) dst[m][k] = *(const LAS h8*)(lds + PG8_SA(b, h) + aoff + m * 2048 + k * 1024); } while (0)
#define PG8_LDB(dst, b, h) do { _Pragma("unroll") for (int n = 0; n < 2; ++n) _Pragma("unroll") for (int k = 0; k < 2; ++k) dst[n][k] = *(const LAS h8*)(lds + PG8_SB(b, h) + boff + n * 2048 + k * 1024); } while (0)
#define PG8_MMA(ai, bj, At, Bt) do { __builtin_amdgcn_s_setprio(1); _Pragma("unroll") for (int m = 0; m < 4; ++m) _Pragma("unroll") for (int n = 0; n < 2; ++n) _Pragma("unroll") for (int k = 0; k < 2; ++k) \
        acc[ai][bj][m][n] = __builtin_amdgcn_mfma_f32_16x16x32_f16(Bt[n][k], At[m][k], acc[ai][bj][m][n], 0, 0, 0); __builtin_amdgcn_s_setprio(0); } while (0)
#define PG8_WAIT_V(n) asm volatile("s_waitcnt vmcnt(" #n ")" ::: "memory")
#define PG8_WAIT_L(n) asm volatile("s_waitcnt lgkmcnt(" #n ")" ::: "memory")
#define PG8_BAR __builtin_amdgcn_s_barrier()
#define PG8_SCHED __builtin_amdgcn_sched_barrier(0)
    Unit cur, nxt; int ui = 0;
    if (!S.next(0, cur)) return;
    f4 acc[2][2][4][2];
#pragma unroll
    for (int a = 0; a < 2; ++a)
#pragma unroll
        for (int b = 0; b < 2; ++b)
#pragma unroll
            for (int m = 0; m < 4; ++m)
#pragma unroll
                for (int n = 0; n < 2; ++n) acc[a][b][m][n] = (f4){0.f, 0.f, 0.f, 0.f};
    h8 At[4][2], B0[2][2], B1[2][2];
    const char* cA = (const char*)g.A + (size_t)cur.pm * tstepA; const char* cB = (const char*)g.Bt + (size_t)cur.pn * tstepB;
    PG8_STAGE(PG8_SB(0, 0), cB, voffB); PG8_STAGE(PG8_SA(0, 0), cA, voffA); PG8_STAGE(PG8_SB(0, 1), cB + hstepB, voffB); PG8_STAGE(PG8_SA(0, 1), cA + hstepA, voffA);
    if (wr == 1) PG8_BAR;
    PG8_WAIT_V(4); PG8_BAR;
    PG8_STAGE(PG8_SB(1, 0), cB + kstep, voffB); PG8_STAGE(PG8_SA(1, 0), cA + kstep, voffA); PG8_STAGE(PG8_SB(1, 1), cB + hstepB + kstep, voffB);
    PG8_WAIT_V(6); PG8_BAR;
    for (;;) {
        const bool has_next = S.next(ui + 1, nxt);
        const char* nA = has_next ? (const char*)g.A + (size_t)nxt.pm * tstepA : cA; const char* nB = has_next ? (const char*)g.Bt + (size_t)nxt.pn * tstepB : cB;
        for (int t = 0; t < nt; t += 2) {
            const bool last = (t == nt - 2);
            const char* a1 = cA + (size_t)(t + 1) * kstep;
            const char* a2 = last ? nA : cA + (size_t)(t + 2) * kstep; const char* b2 = last ? nB : cB + (size_t)(t + 2) * kstep;
            const char* a3 = a2 + kstep; const char* b3 = b2 + kstep;
            PG8_LDB(B0, 0, 0); PG8_SCHED; PG8_LDA(At, 0, 0); PG8_STAGE(PG8_SA(1, 1), a1 + hstepA, voffA);
            PG8_WAIT_L(8); PG8_BAR; PG8_WAIT_L(0); PG8_MMA(0, 0, At, B0); PG8_BAR; PG8_SCHED;
            PG8_LDB(B1, 0, 1); PG8_STAGE(PG8_SB(0, 0), b2, voffB);
            PG8_BAR; PG8_WAIT_L(0); PG8_MMA(0, 1, At, B1); PG8_BAR;
            PG8_LDA(At, 0, 1); PG8_STAGE(PG8_SA(0, 0), a2, voffA);
            PG8_BAR; PG8_WAIT_L(0); PG8_MMA(1, 0, At, B0); PG8_BAR; PG8_SCHED;
            PG8_STAGE(PG8_SB(0, 1), b2 + hstepB, voffB);
            PG8_WAIT_V(6); PG8_BAR; PG8_MMA(1, 1, At, B1); PG8_BAR;
            PG8_LDB(B0, 1, 0); PG8_SCHED; PG8_LDA(At, 1, 0); PG8_STAGE(PG8_SA(0, 1), a2 + hstepA, voffA);
            PG8_WAIT_L(8); PG8_BAR; PG8_WAIT_L(0); PG8_MMA(0, 0, At, B0); PG8_BAR; PG8_SCHED;
            PG8_LDB(B1, 1, 1); PG8_STAGE(PG8_SB(1, 0), b3, voffB);
            PG8_BAR; PG8_WAIT_L(0); PG8_MMA(0, 1, At, B1); PG8_BAR;
            PG8_LDA(At, 1, 1); PG8_STAGE(PG8_SA(1, 0), a3, voffA);
            PG8_BAR; PG8_WAIT_L(0); PG8_MMA(1, 0, At, B0); PG8_BAR; PG8_SCHED;
            PG8_STAGE(PG8_SB(1, 1), b3 + hstepB, voffB);
            PG8_WAIT_V(6); PG8_BAR; PG8_MMA(1, 1, At, B1); PG8_BAR;
        }
        { int t2 = tid; asm volatile("" : "+v"(t2)); const int l2 = t2 & 63; E(acc, cur, wr, wc, l2 & 15, l2 >> 4); }
        if (!has_next) break;
#pragma unroll
        for (int a = 0; a < 2; ++a)
#pragma unroll
            for (int b = 0; b < 2; ++b)
#pragma unroll
                for (int m = 0; m < 4; ++m)
#pragma unroll
                    for (int n = 0; n < 2; ++n) acc[a][b][m][n] = (f4){0.f, 0.f, 0.f, 0.f};
        cur = nxt; cA = nA; cB = nB; ++ui;
    }
    PG8_WAIT_V(0);
    if (wr == 0) PG8_BAR;
    PG8_BAR;
#undef PG8_SA
#undef PG8_SB
#undef PG8_STAGE
#undef PG8_LDA
#undef PG8_LDB
#undef PG8_MMA
#undef PG8_WAIT_V
#undef PG8_WAIT_L
#undef PG8_BAR
#undef PG8_SCHED
}

typedef f4 Acc[2][2][4][2];
#define EPI_ROWS for (int ai = 0; ai < 2; ++ai) _Pragma("unroll") for (int m = 0; m < 4; ++m)

#define ROW_OF(r) (rowb + ((r) >> 2) * HALF + ((r) & 3) * 16)
struct EpiZ {
    static constexpr bool PERM = true;
    h16* z; float* sv; const float* st; const float* cv; const float* dv; bool fold;
    DEVI void operator()(const Acc& acc, const Unit& u, int wr, int wc, int fr, int fq) const {
        const int rowb = u.pm * BM + wr * 64 + fr, colb = u.pn * BM + wc * 32 + fq * 8;
        float mean[8], rstd[8]; f4 c[2][2], d[2][2];
#pragma unroll
        for (int r = 0; r < 8; ++r) { mean[r] = 0.f; rstd[r] = 1.f; }
#pragma unroll
        for (int bj = 0; bj < 2; ++bj)
#pragma unroll
            for (int n = 0; n < 2; ++n) { c[bj][n] = (f4){0.f, 0.f, 0.f, 0.f}; d[bj][n] = c[bj][n]; }
        if (fold) {
#pragma unroll
            for (int r = 0; r < 8; ++r) { const int row = ROW_OF(r); const float sm = st[2 * row], sq = st[2 * row + 1]; mean[r] = sm * (1.f / DM); rstd[r] = rsqrtf(sq * (1.f / DM) - mean[r] * mean[r] + 1e-5f); }
#pragma unroll
            for (int bj = 0; bj < 2; ++bj)
#pragma unroll
                for (int n = 0; n < 2; ++n) { c[bj][n] = *(const f4*)(cv + colb + bj * HALF + 4 * n); d[bj][n] = *(const f4*)(dv + colb + bj * HALF + 4 * n); } }
#pragma unroll
        for (int bj = 0; bj < 2; ++bj) { const int col = colb + bj * HALF; const bool act = col < 512 || (col >= 1440 && col < 1696);
#pragma unroll
            for (int r = 0; r < 8; ++r) { const int row = ROW_OF(r);
                f4 v0 = (acc[r >> 2][bj][r & 3][0] - c[bj][0] * mean[r]) * rstd[r] + d[bj][0], v1 = (acc[r >> 2][bj][r & 3][1] - c[bj][1] * mean[r]) * rstd[r] + d[bj][1];
                if (act) {
#pragma unroll
                    for (int e = 0; e < 4; ++e) { v0[e] = gelu_f(v0[e]); v1[e] = gelu_f(v1[e]); } }
                *(h8*)(z + (size_t)row * ZW + col) = pack8(v0, v1);
                if (row >= MP && col >= 256 && col < 512) { float* o = sv + (size_t)(row - MP) * 256 + (col - 256); *(f4*)o = v0; *(f4*)(o + 4) = v1; } } }
    }
};
struct EpiQ {
    static constexpr bool PERM = true;
    h16* q; h16* qlat; const float* ropec; const float* ropes;
    DEVI void operator()(const Acc& acc, const Unit& u, int wr, int wc, int fr, int fq) const {
        const bool samp = u.pm * BM >= MP;
        if (u.pn < 2) { if (samp) return;
#pragma unroll
            EPI_ROWS { const int row = u.pm * BM + ai * HALF + wr * 64 + m * 16 + fr;
#pragma unroll
                for (int bj = 0; bj < 2; ++bj) { const int col = u.pn * BM + bj * HALF + wc * 32 + fq * 8;
                    *(h8*)(q + (size_t)row * QW + (col >> 6) * 96 + (col & 63)) = pack8(acc[ai][bj][m][0] * QSCALE, acc[ai][bj][m][1] * QSCALE); } }
        } else {
            const int j = wc * 32 + fq * 8, head = j >> 4, i0 = j & 15; const int rowb = u.pm * BM + wr * 64 + fr;
#pragma unroll
            for (int r = 0; r < 8; ++r) { const int row = ROW_OF(r); const int pidx = samp ? SEQ + ((row - MP) & 31) : (row & (SEQ - 1));
                const size_t po = samp ? (W_QLAT - W_Q) / 2 + (size_t)(row - MP) * QLW + head * 288 + 256 + i0 : (size_t)row * QW + head * 96 + 64 + i0;
#pragma unroll
                for (int n = 0; n < 2; ++n) { const f4 cc = *(const f4*)(ropec + pidx * 16 + i0 + 4 * n), ss = *(const f4*)(ropes + pidx * 16 + i0 + 4 * n);
                    const f4 a0 = acc[r >> 2][0][r & 3][n], b0 = acc[r >> 2][1][r & 3][n];
                    *(h4*)(q + po + 4 * n) = pack4((a0 * cc - b0 * ss) * QSCALE); *(h4*)(q + po + 16 + 4 * n) = pack4((a0 * ss + b0 * cc) * QSCALE); } }
        }
    }
};
struct EpiKV {
    static constexpr bool PERM = true;
    h16* k; h16* v;
    DEVI void operator()(const Acc& acc, const Unit& u, int wr, int wc, int fr, int fq) const {
#pragma unroll
        EPI_ROWS { const int row = u.pm * BM + ai * HALF + wr * 64 + m * 16 + fr;
#pragma unroll
            for (int bj = 0; bj < 2; ++bj) { const int col = u.pn * BM + bj * HALF + wc * 32 + fq * 8; const h8 o = pack8(acc[ai][bj][m][0], acc[ai][bj][m][1]);
                if (u.pn < 2) *(h8*)(k + (size_t)row * KW + (col >> 6) * 96 + (col & 63)) = o; else *(h8*)(v + (size_t)row * VW + (col - 512)) = o; } }
    }
};
DEVI float one_minus_exp(float x) {
    const float pser = -x * (1.f + x * (0.5f + x * (0.16666667f + x * (0.041666668f + x * (0.0083333338f + x * 0.0013888889f)))));
    return x > -0.25f ? pser : 1.f - __builtin_amdgcn_exp2f(1.4426950408889634f * x);
}
struct EpiGate {
    static constexpr bool PERM = false;
    const h16* xc; float* a; float* b; const float* br; const float* bi; const float* sp;
    DEVI void operator()(const Acc& acc, const Unit& u, int wr, int wc, int fr, int fq) const {
        const int rowb = u.pm * BM + wr * 64 + fr, chb = u.pn * 128 + wc * 32 + fq * 4;
        f4 vbr[2], vbi[2], vsp[2]; h4 xv[2][8];
#pragma unroll
        for (int n = 0; n < 2; ++n) { const int ch = chb + n * 16; vbr[n] = *(const f4*)(br + ch); vbi[n] = *(const f4*)(bi + ch); vsp[n] = *(const f4*)(sp + ch) * -8.f;
#pragma unroll
            for (int r = 0; r < 8; ++r) xv[n][r] = *(const h4*)(xc + (size_t)ROW_OF(r) * 256 + ch); }
#pragma unroll
        for (int n = 0; n < 2; ++n) { const int ch = chb + n * 16;
#pragma unroll
            for (int r = 0; r < 8; ++r) { const int row = ROW_OF(r); f4 oa, ob;
#pragma unroll
                for (int e = 0; e < 4; ++e) { const float rg = sigmoid_f(acc[r >> 2][0][r & 3][n][e] + vbr[n][e]), ig = sigmoid_f(acc[r >> 2][1][r & 3][n][e] + vbi[n][e]);
                    const float la = rg * vsp[n][e]; oa[e] = __builtin_amdgcn_exp2f(1.4426950408889634f * la); ob[e] = __builtin_amdgcn_sqrtf(one_minus_exp(2.f * la)) * (ig * (float)xv[n][r][e]); }
                *(f4*)(a + (size_t)row * 256 + ch) = oa; *(f4*)(b + (size_t)row * 256 + ch) = ob; } }
    }
};
struct EpiQlat {
    static constexpr bool PERM = true;
    h16* qlat;
    DEVI void operator()(const Acc& acc, const Unit& u, int wr, int wc, int fr, int fq) const {
#pragma unroll
        EPI_ROWS { const int row = u.pm * BM + ai * HALF + wr * 64 + m * 16 + fr;
#pragma unroll
            for (int bj = 0; bj < 2; ++bj) { const int c = bj * HALF + wc * 32 + fq * 8;
                *(h8*)(qlat + (size_t)row * QLW + u.pn * 288 + c) = pack8(acc[ai][bj][m][0] * QSCALE, acc[ai][bj][m][1] * QSCALE); } }
    }
};
struct EpiRes {
    static constexpr bool PERM = true;
    h16* xh; const float* pst; const float* g; const float* b; bool ln; float* ost;
    DEVI void operator()(const Acc& acc, const Unit& u, int wr, int wc, int fr, int fq) const {
        const int rowb = u.pm * BM + wr * 64 + fr, colb = u.pn * BM + wc * 32 + fq * 8, lane = fq * 16 + fr;
        f4 gv[4], bv[4]; float mean[8], rstd[8];
#pragma unroll
        for (int k = 0; k < 4; ++k) { const int col = colb + (k >> 1) * HALF + (k & 1) * 4; gv[k] = ln ? *(const f4*)(g + col) : (f4){1.f, 1.f, 1.f, 1.f}; bv[k] = ln ? *(const f4*)(b + col) : (f4){0.f, 0.f, 0.f, 0.f}; }
#pragma unroll
        for (int r = 0; r < 8; ++r) { mean[r] = 0.f; rstd[r] = 1.f;
            if (ln) { const int row = ROW_OF(r); const float sm = pst[2 * row], sq = pst[2 * row + 1]; mean[r] = sm * (1.f / DM); rstd[r] = rsqrtf(sq * (1.f / DM) - mean[r] * mean[r] + 1e-5f); } }
        h8 cur[2], nxt[2];
#pragma unroll
        for (int bj = 0; bj < 2; ++bj) cur[bj] = *(const h8*)(xh + (size_t)ROW_OF(0) * DM + colb + bj * HALF);
#pragma unroll
        for (int r = 0; r < 8; ++r) { const int row = ROW_OF(r);
            if (r < 7) {
#pragma unroll
                for (int bj = 0; bj < 2; ++bj) nxt[bj] = *(const h8*)(xh + (size_t)ROW_OF(r + 1) * DM + colb + bj * HALF); }
            float s1 = 0.f, s2 = 0.f;
#pragma unroll
            for (int bj = 0; bj < 2; ++bj) { f4 y[2];
#pragma unroll
                for (int n = 0; n < 2; ++n) { const int k = bj * 2 + n;
                    const f4 xv = (f4){(float)cur[bj][4 * n], (float)cur[bj][4 * n + 1], (float)cur[bj][4 * n + 2], (float)cur[bj][4 * n + 3]};
                    y[n] = ((xv - mean[r]) * rstd[r] * gv[k] + bv[k]) * ALPHA + acc[r >> 2][bj][r & 3][n];
                    s1 += (y[n][0] + y[n][1]) + (y[n][2] + y[n][3]); s2 += (y[n][0] * y[n][0] + y[n][1] * y[n][1]) + (y[n][2] * y[n][2] + y[n][3] * y[n][3]); }
                *(h8*)(xh + (size_t)row * DM + colb + bj * HALF) = pack8(y[0], y[1]); }
            s1 += shx(s1, 16, lane); s2 += shx(s2, 16, lane); s1 += shx(s1, 32, lane); s2 += shx(s2, 32, lane);
            if (fq == 0) { atomicAdd(ost + 2 * row, s1); atomicAdd(ost + 2 * row + 1, s2); }
#pragma unroll
            for (int bj = 0; bj < 2; ++bj) cur[bj] = nxt[bj]; }
    }
};
struct EpiUp {
    static constexpr bool PERM = true;
    h16* up; float* pfc; size_t sdelta; const float* st; const float* cv; const float* dv; int rowoff;
    DEVI void operator()(const Acc& acc, const Unit& u, int wr, int wc, int fr, int fq) const {
        const int rowb = rowoff + u.pm * BM + wr * 64 + fr, colb = u.pn * BM + wc * 32 + fq * 8;
        float mean[8], rstd[8]; f4 c[2][2], d[2][2];
#pragma unroll
        for (int r = 0; r < 8; ++r) { const int row = ROW_OF(r); const float sm = st[2 * row], sq = st[2 * row + 1]; mean[r] = sm * (1.f / DM); rstd[r] = rsqrtf(sq * (1.f / DM) - mean[r] * mean[r] + 1e-5f); }
#pragma unroll
        for (int bj = 0; bj < 2; ++bj)
#pragma unroll
            for (int n = 0; n < 2; ++n) { c[bj][n] = *(const f4*)(cv + colb + bj * HALF + 4 * n); d[bj][n] = *(const f4*)(dv + colb + bj * HALF + 4 * n); }
#pragma unroll
        for (int r = 0; r < 8; ++r) { const int row = ROW_OF(r);
            bool has_st; size_t so;
            if (row < MP) { const int t = row & (SEQ - 1); has_st = t >= SEQ - 2; so = ((size_t)(row >> 11) * 2 + (t - (SEQ - 2))) * DFF2; }
            else { const int rs = row - MP, t = rs & 31; has_st = t >= DSEQ - 2; so = sdelta + ((size_t)(rs >> 5) * 2 + (t - (DSEQ - 2))) * DFF2; }
#pragma unroll
            for (int bj = 0; bj < 2; ++bj) { const int col = colb + bj * HALF;
                const f4 v0 = (acc[r >> 2][bj][r & 3][0] - c[bj][0] * mean[r]) * rstd[r] + d[bj][0], v1 = (acc[r >> 2][bj][r & 3][1] - c[bj][1] * mean[r]) * rstd[r] + d[bj][1];
                *(h8*)(up + (size_t)row * DFF2 + col) = pack8(v0, v1);
                if (has_st) { float* sp = pfc + so + col; *(f4*)sp = v0; *(f4*)(sp + 4) = v1; } } }
    }
};

template <int MODE>
DEVI void transpose_item(const float* W, int ldw, int nblk, h16* WT, int ldd, LAS float* scr, int item, int lane, const float* gs = nullptr, const float* bs = nullptr, float* csum = nullptr, float* dsum = nullptr) {
    const int kb = item / nblk, nb = item % nblk, k0 = 64 * kb, n0 = 32 * nb;
    int nsrc = n0 + (lane & 31);
    if (MODE == 1) { const int n = nsrc; if (n < 512) nsrc = (n >> 6) * 96 + (n & 63); else if (n < 640) nsrc = ((n - 512) >> 4) * 96 + 64 + ((n - 512) & 15); else nsrc = ((n - 640) >> 4) * 96 + 80 + ((n - 640) & 15); }
    float cs = 0.f, ds = 0.f;
#pragma unroll 8
    for (int i = 0; i < 32; ++i) { const int kk = 2 * i + (lane >> 5); float w = W[(size_t)(k0 + kk) * ldw + nsrc]; if (gs) { ds += bs[k0 + kk] * w; w *= gs[k0 + kk]; cs += w; } scr[kk * 33 + (lane & 31)] = w; }
    if (gs && csum) { atomicAdd(csum + nsrc, cs); atomicAdd(dsum + nsrc, ds); }
    __builtin_amdgcn_fence(__ATOMIC_RELEASE, "wavefront"); asm volatile("s_waitcnt lgkmcnt(0)" ::: "memory");
    const int c = lane & 7;
#pragma unroll
    for (int j = 0; j < 4; ++j) { const int n = (lane >> 3) + 8 * j; const LAS float* s = scr + (8 * c) * 33 + n;
        h8 o; o[0] = (h16)s[0 * 33]; o[1] = (h16)s[1 * 33]; o[2] = (h16)s[2 * 33]; o[3] = (h16)s[3 * 33]; o[4] = (h16)s[4 * 33]; o[5] = (h16)s[5 * 33]; o[6] = (h16)s[6 * 33]; o[7] = (h16)s[7 * 33];
        *(h8*)(WT + (size_t)(n0 + n) * ldd + k0 + 8 * c) = o; }
    asm volatile("s_waitcnt lgkmcnt(0)" ::: "memory");
}

template <int NKS, int NCT, int NQS, int KSTR>
DEVI void attn_qk(LAS unsigned char* kbase, const h8 (&qf)[NQS][NKS], f4 (&o)[NQS][NCT], float (&mrow)[NQS], float (&lrow)[NQS], h8 (&pf)[NQS][2], const int nkt, const int lane) {
    const int fr = lane & 15, g = lane >> 4;
    f4 s[NQS][4];
#pragma unroll
    for (int qs = 0; qs < NQS; ++qs)
#pragma unroll
        for (int kt = 0; kt < 4; ++kt) s[qs][kt] = (f4){-1e30f, -1e30f, -1e30f, -1e30f};
#pragma unroll
    for (int kt = 0; kt < 4; ++kt) if (kt < nkt) {
#pragma unroll
        for (int qs = 0; qs < NQS; ++qs) s[qs][kt] = (f4){0.f, 0.f, 0.f, 0.f};
#pragma unroll
        for (int ks = 0; ks < NKS; ++ks) { const h8 kf = *(const LAS h8*)(kbase + (kt * 16 + fr) * KSTR + ks * 64 + g * 16);
#pragma unroll
            for (int qs = 0; qs < NQS; ++qs) s[qs][kt] = __builtin_amdgcn_mfma_f32_16x16x32_f16(kf, qf[qs][ks], s[qs][kt], 0, 0, 0); } }
    __builtin_amdgcn_sched_barrier(0);
#pragma unroll
    for (int qs = 0; qs < NQS; ++qs) {
        float mx = -1e30f;
#pragma unroll
        for (int kt = 0; kt < 4; ++kt)
#pragma unroll
            for (int e = 0; e < 4; ++e) mx = fmaxf(mx, s[qs][kt][e]);
        mx = fmaxf(mx, shx(mx, 16, lane)); mx = fmaxf(mx, shx(mx, 32, lane));
        const float mnew = fmaxf(mrow[qs], mx), alpha = __builtin_amdgcn_exp2f(mrow[qs] - mnew); mrow[qs] = mnew;
        float ps = 0.f;
#pragma unroll
        for (int kt = 0; kt < 4; ++kt)
#pragma unroll
            for (int e = 0; e < 4; ++e) { const float p = __builtin_amdgcn_exp2f(s[qs][kt][e] - mnew); s[qs][kt][e] = p; ps += p; }
        lrow[qs] = lrow[qs] * alpha + ps;
#pragma unroll
        for (int ct = 0; ct < NCT; ++ct) o[qs][ct] *= alpha;
#pragma unroll
        for (int k2 = 0; k2 < 2; ++k2) pf[qs][k2] = pack8(s[qs][2 * k2], s[qs][2 * k2 + 1]);
    }
    __builtin_amdgcn_sched_barrier(0);
}
template <int NCT, int NQS, int VSTR>
DEVI void attn_pv(LAS unsigned char* vbase, f4 (&o)[NQS][NCT], const h8 (&pf)[NQS][2], const int nkt, const int lane) {
    const int fr = lane & 15, g = lane >> 4, q_ = fr >> 2, p_ = fr & 3;
#pragma unroll
    for (int k2 = 0; k2 < 2; ++k2) if (2 * k2 < nkt) {
#pragma unroll
        for (int ct = 0; ct < NCT; ++ct) {
            const h4 lo = trrd(vbase + (32 * k2 + 4 * g + q_) * VSTR + (16 * ct + 4 * p_) * 2);
            const h4 hi = trrd(vbase + (32 * k2 + 16 + 4 * g + q_) * VSTR + (16 * ct + 4 * p_) * 2);
            const h8 vf = cat44(lo, hi);
#pragma unroll
            for (int qs = 0; qs < NQS; ++qs) o[qs][ct] = __builtin_amdgcn_mfma_f32_16x16x32_f16(vf, pf[qs][k2], o[qs][ct], 0, 0, 0); } }
    __builtin_amdgcn_sched_barrier(0);
}
template <int NKS, int NCT, int NQS, int KSTR, int VSTR>
DEVI void attn_tile(LAS unsigned char* kbase, LAS unsigned char* vbase, const h8 (&qf)[NQS][NKS], f4 (&o)[NQS][NCT], float (&mrow)[NQS], float (&lrow)[NQS], const int nkt, const int lane) {
    h8 pf[NQS][2];
    attn_qk<NKS, NCT, NQS, KSTR>(kbase, qf, o, mrow, lrow, pf, nkt, lane);
    attn_pv<NCT, NQS, VSTR>(vbase, o, pf, nkt, lane);
}


DEVI void conv_gate_items(unsigned it_begin, unsigned it_end, unsigned it_step, const int rseg, const h16* up, h16* act, const float* fw, const float* fb, const float* stf) {
    constexpr int NCG = DFF / 8;
    for (unsigned it = it_begin; it < it_end; it += it_step) { const int seg = (int)(it / (unsigned)NCG), cg = (int)(it - (unsigned)seg * NCG), j0 = cg * 8, row0 = seg * rseg;
        const bool samp = row0 >= MP; const int t0 = samp ? ((row0 - MP) & 31) : (row0 & (SEQ - 1)), bb = (row0 - MP) >> 5;
        const f4 bg0 = *(const f4*)(fb + j0), bg1 = *(const f4*)(fb + j0 + 4), bv0 = *(const f4*)(fb + DFF + j0), bv1 = *(const f4*)(fb + DFF + j0 + 4);
        f4 wg0[3], wg1[3], wv0[3], wv1[3];
#pragma unroll
        for (int j = 0; j < 3; ++j) { const float* wj = fw + (size_t)j * DFF2; wg0[j] = *(const f4*)(wj + j0); wg1[j] = *(const f4*)(wj + j0 + 4); wv0[j] = *(const f4*)(wj + DFF + j0); wv1[j] = *(const f4*)(wj + DFF + j0 + 4); }
        f4 ag0, ag1, av0, av1, bg0_, bg1_, bv0_, bv1_;
        if (t0 > 0) { const h16* u2 = up + (size_t)(row0 - 2) * DFF2; const h16* u1 = u2 + DFF2;
            const h8 a = *(const h8*)(u2 + j0), c = *(const h8*)(u2 + DFF + j0), d = *(const h8*)(u1 + j0), e = *(const h8*)(u1 + DFF + j0);
            ag0 = (f4){(float)a[0], (float)a[1], (float)a[2], (float)a[3]}; ag1 = (f4){(float)a[4], (float)a[5], (float)a[6], (float)a[7]};
            av0 = (f4){(float)c[0], (float)c[1], (float)c[2], (float)c[3]}; av1 = (f4){(float)c[4], (float)c[5], (float)c[6], (float)c[7]};
            bg0_ = (f4){(float)d[0], (float)d[1], (float)d[2], (float)d[3]}; bg1_ = (f4){(float)d[4], (float)d[5], (float)d[6], (float)d[7]};
            bv0_ = (f4){(float)e[0], (float)e[1], (float)e[2], (float)e[3]}; bv1_ = (f4){(float)e[4], (float)e[5], (float)e[6], (float)e[7]}; }
        else if (samp) { const float* s2 = stf + (size_t)bb * 2 * DFF2; const float* s1 = s2 + DFF2;
            ag0 = *(const f4*)(s2 + j0); ag1 = *(const f4*)(s2 + j0 + 4); av0 = *(const f4*)(s2 + DFF + j0); av1 = *(const f4*)(s2 + DFF + j0 + 4);
            bg0_ = *(const f4*)(s1 + j0); bg1_ = *(const f4*)(s1 + j0 + 4); bv0_ = *(const f4*)(s1 + DFF + j0); bv1_ = *(const f4*)(s1 + DFF + j0 + 4); }
        else { ag0 = ag1 = av0 = av1 = bg0_ = bg1_ = bv0_ = bv1_ = (f4){0.f, 0.f, 0.f, 0.f}; }
        const h16* ur = up + (size_t)row0 * DFF2 + j0; h16* ar = act + (size_t)row0 * DFF + j0;
#pragma unroll 4
        for (int r = 0; r < rseg; ++r) { const h8 a = *(const h8*)(ur + (size_t)r * DFF2), c = *(const h8*)(ur + (size_t)r * DFF2 + DFF);
            const f4 cg0 = (f4){(float)a[0], (float)a[1], (float)a[2], (float)a[3]}, cg1 = (f4){(float)a[4], (float)a[5], (float)a[6], (float)a[7]};
            const f4 cv0 = (f4){(float)c[0], (float)c[1], (float)c[2], (float)c[3]}, cv1 = (f4){(float)c[4], (float)c[5], (float)c[6], (float)c[7]};
            const f4 g0 = bg0 + ag0 * wg0[0] + bg0_ * wg0[1] + cg0 * wg0[2], g1 = bg1 + ag1 * wg1[0] + bg1_ * wg1[1] + cg1 * wg1[2];
            const f4 v0 = bv0 + av0 * wv0[0] + bv0_ * wv0[1] + cv0 * wv0[2], v1 = bv1 + av1 * wv1[0] + bv1_ * wv1[1] + cv1 * wv1[2];
            h8 o;
#pragma unroll
            for (int e = 0; e < 4; ++e) { o[e] = (h16)(gelu_f(g0[e]) * v0[e]); o[4 + e] = (h16)(gelu_f(g1[e]) * v1[e]); }
            *(h8*)(ar + (size_t)r * DFF) = o;
            ag0 = bg0_; ag1 = bg1_; av0 = bv0_; av1 = bv1_; bg0_ = cg0; bg1_ = cg1; bv0_ = cv0; bv1_ = cv1; } }
}


#define XB_TMO      128
#define XB_XCNT(j)  (256  + 64 * (j))
#define XB_XSUB(j)  (1280 + 64 * (j))
#define XB_XGEN(j)  (2304 + 64 * (j))
#define XB_TOP      3328
#define XB_TOPGEN   3392
#define XCD_BAR_WORDS 3456
#define XB_SPIN_CAP (1u << 18)
DEVI unsigned xb_ld(unsigned* p)              { return __hip_atomic_load(p, __ATOMIC_RELAXED, __HIP_MEMORY_SCOPE_AGENT); }
DEVI unsigned xb_add(unsigned* p, unsigned v) { return __hip_atomic_fetch_add(p, v, __ATOMIC_RELAXED, __HIP_MEMORY_SCOPE_AGENT); }
DEVI unsigned xb_xcc_id() { return (unsigned)__builtin_amdgcn_s_getreg((3 << 11) | 20) & 0xFu; }
#define XB_SPIN(cond, bar) do { unsigned _sp = 0; while (cond) { __builtin_amdgcn_s_sleep(1); \
    if ((++_sp & 255u) == 0u) { if (xb_ld(&(bar)[XB_TMO])) break; if (_sp > XB_SPIN_CAP) { atomicAdd(&(bar)[XB_TMO], 1u); break; } } } } while (0)
DEVI void xb_complete(unsigned* bar, unsigned x, unsigned& nloc, unsigned& nx, unsigned G) {
    unsigned sum, cnt, mine, sp = 0u;
    for (;;) {
        sum = 0u; cnt = 0u; mine = 0u;
#pragma unroll
        for (unsigned j = 0; j < 16; ++j) { const unsigned c = xb_ld(&bar[XB_XCNT(j)]); sum += c; cnt += (c > 0u) ? 1u : 0u; mine = (j == x) ? c : mine; }
        if (sum == G) break;
        __builtin_amdgcn_s_sleep(1);
        if ((++sp & 255u) == 0u) { if (xb_ld(&bar[XB_TMO])) break; if (sp > XB_SPIN_CAP) { atomicAdd(&bar[XB_TMO], 1u); break; } }
    }
    nloc = mine > 0u ? mine : 1u; nx = cnt > 0u ? cnt : 1u;
}
DEVI void xbar(unsigned* bar, volatile LAS unsigned* st, int tid, unsigned G) {
    asm volatile("s_waitcnt vmcnt(0)" ::: "memory");
    __syncthreads();
    if (tid == 0) {
        const unsigned x = xb_xcc_id();
        __builtin_amdgcn_s_waitcnt(0);
        unsigned nloc = st[0], nx = st[1];
        if (nloc == 0u) { xb_complete(bar, x, nloc, nx, G); st[0] = nloc; st[1] = nx; }
        const unsigned old = xb_add(&bar[XB_XSUB(x)], 1u);
        const unsigned gen = old / nloc;
        if (old + 1u == (gen + 1u) * nloc) {
            __builtin_amdgcn_fence(__ATOMIC_RELEASE, "agent");
            asm volatile("s_waitcnt vmcnt(0)" ::: "memory");
            const unsigned og = xb_add(&bar[XB_TOP], 1u);
            const unsigned tg = og / nx;
            if (og + 1u == (tg + 1u) * nx) xb_add(&bar[XB_TOPGEN], 1u);
            else XB_SPIN(xb_ld(&bar[XB_TOPGEN]) == tg, bar);
            __builtin_amdgcn_fence(__ATOMIC_ACQUIRE, "agent");
            xb_add(&bar[XB_XGEN(x)], 1u);
            asm volatile("s_waitcnt vmcnt(0)" ::: "memory");
        } else {
            XB_SPIN(xb_ld(&bar[XB_XGEN(x)]) == gen, bar);
            __builtin_amdgcn_fence(__ATOMIC_ACQUIRE, "agent");
            asm volatile("s_waitcnt vmcnt(0)" ::: "memory");
        }
    }
    __syncthreads();
}
#ifndef PHM
#define PHM 0xFFFFFFFFu
#endif
#ifndef DBL
#define DBL 0u
#endif
#define NREP(k) (((DBL >> (k)) & 1u) ? 2 : 1)
__global__ void __launch_bounds__(512, 2) trunk_fwd(Params p) {
    extern __shared__ __attribute__((aligned(16))) unsigned char shm_raw[];
    LAS unsigned char* lds = (LAS unsigned char*)shm_raw;
    __shared__ uint4 s_ctl;
#define s_item (*(LAS int*)&s_ctl)
    cg::grid_group grid = cg::this_grid();
    const int wave_s = __builtin_amdgcn_readfirstlane((int)threadIdx.x >> 6);
    if (threadIdx.x == 0) { s_ctl = make_uint4(0u, 0u, 0u, 0u); (void)xb_add((unsigned*)(p.ws + W_BAR) + XB_XCNT(xb_xcc_id()), 1u); }
    __syncthreads();
#define GSYNC() do { const __attribute__((address_space(4))) Params* kq = (const __attribute__((address_space(4))) Params*)__builtin_amdgcn_kernarg_segment_ptr(); asm volatile("" : "+s"(kq)); \
        unsigned Gq = gridDim.x; asm volatile("" : "+s"(Gq)); xbar((unsigned*)(kq->ws + W_BAR), (volatile LAS unsigned*)&s_ctl + 1, wave_s * 64 + opaque_lane(), Gq); } while (0)
#define PH_BEGIN \
    int tid = wave_s * 64 + opaque_lane(); asm volatile("" : "+v"(tid)); \
    int bid = blockIdx.x, G = gridDim.x, lq = l; asm volatile("" : "+s"(bid), "+s"(G), "+s"(lq)); \
    const int lane = tid & 63, wave = __builtin_amdgcn_readfirstlane(tid >> 6); \
    const int gw = bid * 8 + wave, NGW = G * 8; const size_t gtid = (size_t)bid * 512 + tid, NGT = (size_t)G * 512; \
    const __attribute__((address_space(4))) Params* kp = (const __attribute__((address_space(4))) Params*)__builtin_amdgcn_kernarg_segment_ptr(); asm volatile("" : "+s"(kp)); \
    unsigned char* ws = kp->ws; float* out = kp->out; \
    (void)lane; (void)wave; (void)gw; (void)NGW; (void)gtid; (void)NGT; (void)out; (void)lq;
#define WSP(T, off) ((T*)(ws + (off)))
    for (int rep = 0; rep < NREP(0); ++rep) if (PHM & 1u) {
        int tid = wave_s * 64 + opaque_lane(); asm volatile("" : "+v"(tid));
        const int bid = blockIdx.x, G = gridDim.x, lane = tid & 63, wave = __builtin_amdgcn_readfirstlane(tid >> 6);
        const int gw = bid * 8 + wave, NGW = G * 8; const size_t gtid = (size_t)bid * 512 + tid, NGT = (size_t)G * 512;
        unsigned char* ws = p.ws;
        h16* xh = WSP(h16, W_XH); float* ropec = WSP(float, W_ROPE); float* ropes = ropec + NPOS * 16;
        for (size_t i = gtid; i < (size_t)MT * DM / 8; i += NGT) { const size_t e = i * 8; const float* src = e < (size_t)MP * DM ? p.in[0] + e : p.in[1] + (e - (size_t)MP * DM);
            *(h8*)(xh + e) = pack8(*(const f4*)src, *(const f4*)(src + 4)); }
        for (size_t i = gtid; i < (size_t)NPOS * 16; i += NGT) { const int pi = (int)(i >> 4), fi = (int)(i & 15); const double pos = pi < SEQ ? (double)pi : (double)(PAST + pi - SEQ);
            const double ang = pos * exp(-(double)fi / 16.0 * 9.210340371976184); ropec[i] = (float)cos(ang); ropes[i] = (float)sin(ang); }
        for (size_t i = gtid; i < (size_t)DEPTH * 256; i += NGT) WSP(float, W_SP)[i] = log1pf(expf(-p.in[26][i]));
        LAS float* scr = (LAS float*)(lds + wave * 8448);
        for (int l = 0; l < DEPTH; ++l) {
            h16* wt_in = WSP(h16, W_WIN + l * SZ_WIN); h16* wt_uq = WSP(h16, W_WUQ + l * SZ_WUQ); h16* wt_kv = WSP(h16, W_WKV + l * SZ_WKV);
            h16* wt_o = WSP(h16, W_WO + l * SZ_WO); h16* wt_os = WSP(h16, W_WOS + l * SZ_WOS); h16* wt_up = WSP(h16, W_WUP + l * SZ_WUP); h16* wt_dn = WSP(h16, W_WDN + l * SZ_WDN);
            h16* wt_ql = WSP(h16, W_WQL + l * SZ_WQL); h16* wt_g = WSP(h16, W_WG + l * SZ_WG);
            const float* w_in = p.in[11] + (size_t)l * DM * DIN; const float* w_o = p.in[12] + (size_t)l * DM * DM; const float* w_uq = p.in[16] + (size_t)l * 384 * 768;
            const float* w_uk = p.in[18] + (size_t)l * 256 * 512; const float* w_uv = p.in[19] + (size_t)l * 256 * 512; const float* w_up = p.in[27] + (size_t)l * DM * DFF2; const float* w_dn = p.in[30] + (size_t)l * DFF * DM;
            const float* w_r = p.in[22] + (size_t)l * 4 * 64 * 64; const float* w_i = p.in[24] + (size_t)l * 4 * 64 * 64;
            for (int it = gw; it < 16 * 53; it += NGW) transpose_item<0>(w_in, DIN, 53, wt_in, 1024, scr, it, lane, l > 0 ? p.in[9] + (l - 1) * DM : nullptr, l > 0 ? p.in[10] + (l - 1) * DM : nullptr, rep ? nullptr : WSP(float, W_CD + l * SZ_CD), WSP(float, W_CD + l * SZ_CD) + ZW);
            for (int it = gw; it < 6 * 24; it += NGW) transpose_item<1>(w_uq, 768, 24, wt_uq, 384, scr, it, lane);
            for (int it = gw; it < 4 * 16; it += NGW) transpose_item<0>(w_uk, 512, 16, wt_kv, 256, scr, it, lane);
            for (int it = gw; it < 4 * 16; it += NGW) transpose_item<0>(w_uv, 512, 16, wt_kv + 512 * 256, 256, scr, it, lane);
            for (int it = gw; it < 16 * 32; it += NGW) transpose_item<0>(w_o, 1024, 32, wt_o, 1024, scr, it, lane);
            for (int it = gw; it < 16 * 176; it += NGW) transpose_item<0>(w_up, DFF2, 176, wt_up, 1024, scr, it, lane, p.in[7] + l * DM, p.in[8] + l * DM, rep ? nullptr : WSP(float, W_CD + l * SZ_CD) + 2 * ZW, WSP(float, W_CD + l * SZ_CD) + 2 * ZW + DFF2);
            for (int it = gw; it < 44 * 32; it += NGW) transpose_item<0>(w_dn, 1024, 32, wt_dn, DFF, scr, it, lane);
            for (size_t i = gtid; i < (size_t)(ZW - DIN) * 1024 / 8; i += NGT) *(h8*)(wt_in + (size_t)DIN * 1024 + i * 8) = (h8){0, 0, 0, 0, 0, 0, 0, 0};
            for (size_t i = gtid; i < (size_t)512 * 256; i += NGT) { const int n = (int)(i >> 8), k = (int)(i & 255); const int pn = n >> 8, jj = n & 127, isI = (n >> 7) & 1, ch = pn * 128 + jj;
                float v = 0.f; if ((k >> 6) == (ch >> 6)) v = (isI ? w_i : w_r)[((ch >> 6) * 64 + (k & 63)) * 64 + (ch & 63)];
                wt_g[i] = (h16)v; }
            for (int it = gw; it < 8 * 24 * 16; it += NGW) { const int hh = it / (24 * 16), kt = (it / 16) % 24, ct = it % 16, fr = lane & 15, g4 = lane >> 4;
                f4 accq = (f4){0.f, 0.f, 0.f, 0.f};
#pragma unroll
                for (int ks = 0; ks < 2; ++ks) { const float* ap = w_uq + (size_t)(16 * kt + fr) * 768 + hh * 96 + 32 * ks + 8 * g4; const float* bp = w_uk + (size_t)(16 * ct + fr) * 512 + hh * 64 + 32 * ks + 8 * g4;
                    accq = __builtin_amdgcn_mfma_f32_16x16x32_f16(pack8(*(const f4*)ap, *(const f4*)(ap + 4)), pack8(*(const f4*)bp, *(const f4*)(bp + 4)), accq, 0, 0, 0); }
                *(h4*)(wt_ql + (size_t)(hh * 256 + 16 * ct + fr) * 384 + 16 * kt + 4 * g4) = pack4(accq); }
            for (size_t i = gtid; i < (size_t)8 * 64 * 256; i += NGT) { const int c = (int)(i & 255), hd = (int)(i >> 8); wt_os[i] = (h16)w_uv[(size_t)c * 512 + hd]; }
        }
    }
    grid.sync();

    for (int l = 0; l < DEPTH; ++l) {
        for (int rep = 0; rep < NREP(1); ++rep) if (PHM & (1u << 1)) { PH_BEGIN
          Gemm g{WSP(h16, W_XH), WSP(h16, W_WIN + lq * SZ_WIN), MT, ZW, 1024, 1024, 1024}; StaticOrder S; S.init(MT, ZW, G, bid); const int lp = lq > 0 ? lq - 1 : 0; EpiZ E{WSP(h16, W_Z), out + O_SV + (size_t)lq * MS * 256, WSP(float, W_STATS + (size_t)(lp * 2 + 1) * SZ_STATS), WSP(float, W_CD + lq * SZ_CD), WSP(float, W_CD + lq * SZ_CD) + ZW, lq > 0}; gemm_phase(lds, g, S, E, tid); }
        GSYNC();

        for (int rep = 0; rep < NREP(2); ++rep) if (PHM & (1u << 2)) { PH_BEGIN
            const float* qn_g = kp->in[15] + lq * 384; const float* kvn_g = kp->in[17] + lq * 256;
            const float* cw = kp->in[20] + (size_t)lq * 4 * 256; const float* cb = kp->in[21] + lq * 256; const float* stc = kp->in[5] + (size_t)lq * DBATCH * 3 * 256;
            const h16* z = WSP(h16, W_Z); h16* cqn = WSP(h16, W_CQN); h16* ckvn = WSP(h16, W_CKVN); h16* knew = WSP(h16, W_KNEW); h16* kb = WSP(h16, W_K); h16* xc = WSP(h16, W_XC);
            const float* ropec = WSP(float, W_ROPE); const float* ropes = ropec + NPOS * 16;
            for (int row = gw; row < MT; row += NGW) {
                const h16* zr = z + (size_t)row * ZW; const bool samp = row >= MP; const int rs = row - MP;
                const int t = samp ? (rs & 31) : (row & (SEQ - 1)), bb = samp ? (rs >> 5) : (row >> 11);
                { float v[6]; float ss = 0.f;
#pragma unroll
                    for (int i = 0; i < 3; ++i) { const h2 x = *(const h2*)(zr + 512 + 2 * lane + 128 * i); v[2 * i] = (float)x[0]; v[2 * i + 1] = (float)x[1]; ss += v[2 * i] * v[2 * i] + v[2 * i + 1] * v[2 * i + 1]; }
                    const float rr = rsqrtf(wave_sum(ss, lane) * (1.f / 384.f) + 1e-6f);
#pragma unroll
                    for (int i = 0; i < 3; ++i) { const int c = 2 * lane + 128 * i; h2 o; o[0] = (h16)(v[2 * i] * rr * qn_g[c]); o[1] = (h16)(v[2 * i + 1] * rr * qn_g[c + 1]); *(h2*)(cqn + (size_t)row * 384 + c) = o; } }
                { const h4 x = *(const h4*)(zr + 896 + 4 * lane); f4 v; float ss = 0.f;
#pragma unroll
                    for (int e = 0; e < 4; ++e) { v[e] = (float)x[e]; ss += v[e] * v[e]; }
                    const float rr = rsqrtf(wave_sum(ss, lane) * (1.f / 256.f) + 1e-6f); const f4 gg = *(const f4*)(kvn_g + 4 * lane); v = v * rr * gg;
                    if (!samp) { *(f4*)(out + O_PLAT + ((size_t)lq * MP + row) * 256 + 4 * lane) = v; *(h4*)(ckvn + (size_t)row * 256 + 4 * lane) = pack4(v); }
                    else { *(f4*)(out + O_SLAT + ((size_t)lq * MS + rs) * 256 + 4 * lane) = v; *(h4*)(knew + (size_t)rs * KNW + 4 * lane) = pack4(v); } }
                if (lane < 16) { const int pidx = samp ? SEQ + t : t; const float c = ropec[pidx * 16 + lane], s = ropes[pidx * 16 + lane];
                    const float x1 = (float)zr[1152 + lane], x2 = (float)zr[1168 + lane], o1 = x1 * c - x2 * s, o2 = x1 * s + x2 * c;
                    if (!samp) { float* o = out + O_PKR + ((size_t)lq * MP + row) * 32; o[lane] = o1; o[16 + lane] = o2;
                        h16* kr = kb + (size_t)row * KW + 64;
#pragma unroll
                        for (int hh = 0; hh < 8; ++hh) { kr[hh * 96 + lane] = (h16)o1; kr[hh * 96 + 16 + lane] = (h16)o2; } }
                    else { float* o = out + O_SKR + ((size_t)lq * MS + rs) * 32; o[lane] = o1; o[16 + lane] = o2; knew[(size_t)rs * KNW + 256 + lane] = (h16)o1; knew[(size_t)rs * KNW + 272 + lane] = (h16)o2; } }
                { const int c = 4 * lane; f4 accv = *(const f4*)(cb + c);
#pragma unroll
                    for (int j = 0; j < 4; ++j) { const int tau = t - 3 + j; f4 xv;
                        if (tau >= 0) { const h4 x = *(const h4*)(zr - (ptrdiff_t)(3 - j) * ZW + 1184 + c); xv = (f4){(float)x[0], (float)x[1], (float)x[2], (float)x[3]}; }
                        else if (samp) xv = *(const f4*)(stc + ((size_t)bb * 3 + (3 + tau)) * 256 + c);
                        else xv = (f4){0.f, 0.f, 0.f, 0.f};
                        accv += xv * *(const f4*)(cw + j * 256 + c);
                        if (j == 3) { const int T = samp ? DSEQ : SEQ; if (t >= T - 3) { float* o = samp ? out + O_SLC + (((size_t)lq * DBATCH + bb) * 3 + (t - (T - 3))) * 256 : out + O_PLC + (((size_t)lq * NB + bb) * 3 + (t - (T - 3))) * 256; *(f4*)(o + c) = xv; } } }
                    *(h4*)(xc + (size_t)row * 256 + c) = pack4(accv); }
            }
        }
        GSYNC();

        for (int rep = 0; rep < NREP(3); ++rep) if (PHM & (1u << 3)) { PH_BEGIN
          Gemm g{WSP(h16, W_CQN), WSP(h16, W_WUQ + lq * SZ_WUQ), MT, 768, 384, 384, 384}; StaticOrder S; S.init(MT, 768, G, bid);
          EpiQ E{WSP(h16, W_Q), WSP(h16, W_QLAT), WSP(float, W_ROPE), WSP(float, W_ROPE) + NPOS * 16}; gemm_phase(lds, g, S, E, tid); }
        for (int rep = 0; rep < NREP(4); ++rep) if (PHM & (1u << 4)) { PH_BEGIN
          Gemm g{WSP(h16, W_CKVN), WSP(h16, W_WKV + lq * SZ_WKV), MP, 1024, 256, 256, 256}; StaticOrder S; S.init(MP, 1024, G, (bid + G - (396 % G)) % G); EpiKV E{WSP(h16, W_K), WSP(h16, W_V)}; gemm_phase(lds, g, S, E, tid); }
        for (int rep = 0; rep < NREP(5); ++rep) if (PHM & (1u << 5)) { PH_BEGIN
          Gemm g{WSP(h16, W_XC), WSP(h16, W_WG + lq * SZ_WG), MT, 512, 256, 256, 256}; StaticOrder S; S.init(MT, 512, G, (bid + G - (908 % G)) % G);
          EpiGate E{WSP(h16, W_XC), WSP(float, W_A), WSP(float, W_B), kp->in[23] + lq * 256, kp->in[25] + lq * 256, WSP(float, W_SP) + lq * 256}; gemm_phase(lds, g, S, E, tid); }
        for (int rep = 0; rep < NREP(6); ++rep) if (PHM & (1u << 6)) { PH_BEGIN
          Gemm g{WSP(h16, W_CQN) + (size_t)MP * 384, WSP(h16, W_WQL + lq * SZ_WQL), MS, 2048, 384, 384, 384}; StaticOrder S; S.init(MS, 2048, G, (bid + G - (1172 % G)) % G); EpiQlat E{WSP(h16, W_QLAT)}; gemm_phase(lds, g, S, E, tid); }
        for (int rep = 0; rep < NREP(7); ++rep) if (PHM & (1u << 7)) { PH_BEGIN
            const float* gw_s = kp->in[13] + (size_t)lq * 4 * 128 * 128; const float* gb_s = kp->in[14] + (size_t)lq * 4 * 128;
            const h16* z = WSP(h16, W_Z); h16* cat = WSP(h16, W_CAT); h16* cats = WSP(h16, W_CATS);
            const int fr = lane & 15, g4 = lane >> 4, q_ = fr >> 2, p_ = fr & 3;
            for (int item = (bid + G - (1204 % G)) % G; item < 1024 + 128; item += G) {
                const bool samp = item >= 1024; const int head = item & 3; const int ci = samp ? (item - 1024) >> 2 : item >> 2;
                const int R0 = samp ? MP + ci * 32 : ci * 128, L = samp ? 32 : 128;
                __syncthreads();
                for (int id = tid; id < L * 8; id += 512) { const int j = id >> 3, part = id & 7; *(LAS h8*)(lds + j * 144 + part * 16) = *(const h8*)(z + (size_t)(R0 + j) * ZW + 256 + head * 64 + part * 8); }
                __syncthreads();
                const int i0 = 16 * wave;
                if (i0 < L) {
                    f4 sacc[4];
#pragma unroll
                    for (int ct = 0; ct < 4; ++ct) sacc[ct] = (f4){0.f, 0.f, 0.f, 0.f};
                    const int i = i0 + fr;
#pragma unroll
                    for (int ks = 0; ks < 4; ++ks) if (32 * ks <= i0 + 15 && 32 * ks < L) {
                        const int j0 = 32 * ks + 8 * g4; const float* wp = gw_s + ((size_t)head * 128 + i) * 128 + j0; const f4 w0 = *(const f4*)wp, w1 = *(const f4*)(wp + 4);
                        h8 wf;
#pragma unroll
                        for (int e = 0; e < 4; ++e) { wf[e] = (h16)((j0 + e <= i) ? w0[e] : 0.f); wf[4 + e] = (h16)((j0 + 4 + e <= i) ? w1[e] : 0.f); }
#pragma unroll
                        for (int ct = 0; ct < 4; ++ct) { const h4 lo = trrd(lds + (32 * ks + 8 * g4 + q_) * 144 + (16 * ct + 4 * p_) * 2), hi = trrd(lds + (32 * ks + 8 * g4 + 4 + q_) * 144 + (16 * ct + 4 * p_) * 2);
                            sacc[ct] = __builtin_amdgcn_mfma_f32_16x16x32_f16(wf, cat44(lo, hi), sacc[ct], 0, 0, 0); } }
#pragma unroll
                    for (int jx = 0; jx < 4; ++jx) { const int ii = i0 + 4 * g4 + jx; const float bs = gb_s[head * 128 + ii]; const size_t r = (size_t)R0 + ii;
#pragma unroll
                        for (int ct = 0; ct < 4; ++ct) { const int d = head * 64 + 16 * ct + fr; const float uval = (float)z[r * ZW + d]; const h16 o = (h16)(uval * (sacc[ct][jx] + bs));
                            cat[r * 1024 + d] = o; } }
                }
            }
            __syncthreads();
        }
        GSYNC();

        for (int rep = 0; rep < NREP(8); ++rep) if (PHM & (1u << 8)) { PH_BEGIN
            unsigned* counter = WSP(unsigned, W_CTR) + lq * 16 + rep * 8;
            constexpr int N_SA = 256, N_PA = 1024, N_PS = 128, N_SS = 16, N_WO = 16, N_UP = 88, N_ALL = N_SA + N_PA + N_PS + N_SS + N_WO + N_UP, Q_WO = N_PS + N_SS + N_SA + 256, Q_UP = Q_WO + N_WO + 256;
            unsigned* wdone = WSP(unsigned, W_CTR) + 800 + lq * 8 + rep * 4;
            unsigned* sdone = WSP(unsigned, W_CTR) + 768 + lq * 2 + rep;
            for (;;) {
                __syncthreads();
                if (tid == 0) s_item = (int)atomicAdd(counter, 1u);
                __syncthreads();
                const int qi = s_item;
                if (qi >= N_ALL) break;
                int tix = tid; asm volatile("" : "+v"(tix));
                const int ln = tix & 63, fr = ln & 15, g4 = ln >> 4;
                const int qj = qi < Q_WO ? qi : (qi < Q_WO + N_WO ? -1 : (qi < Q_UP ? qi - N_WO : (qi < Q_UP + N_UP ? -2 : qi - N_WO - N_UP)));
                const int item = qj < 0 ? qj : (qj < N_PS + N_SS ? qj + N_SA + N_PA : qj - (N_PS + N_SS));
                if (item == -2) {
                    const int ui = qi - Q_UP, pnl = ui / 22, pnc = ui - pnl * 22;
                    if (tix == 0) { unsigned sp = 0; while (xb_ld(wdone + pnl) < 4u) { __builtin_amdgcn_s_sleep(4); if (++sp > (1u << 22)) break; }
                        __builtin_amdgcn_fence(__ATOMIC_ACQUIRE, "agent"); asm volatile("s_waitcnt vmcnt(0)" ::: "memory"); }
                    __syncthreads();
                    const int ro = (MP / BM + pnl) * BM;
                    Gemm g{WSP(h16, W_XH) + (size_t)ro * DM, WSP(h16, W_WUP + lq * SZ_WUP), BM, DFF2, 1024, 1024, 1024}; StaticOrder S; S.init(BM, DFF2, 22, pnc);
                    EpiUp E{WSP(h16, W_UP), out + O_PFC + (size_t)lq * NB * 2 * DFF2, (O_SFC + (size_t)lq * DBATCH * 2 * DFF2) - (O_PFC + (size_t)lq * NB * 2 * DFF2), WSP(float, W_STATS + (size_t)(lq * 2) * SZ_STATS), WSP(float, W_CD + lq * SZ_CD) + 2 * ZW, WSP(float, W_CD + lq * SZ_CD) + 2 * ZW + DFF2, ro};
                    gemm_phase(lds, g, S, E, tix);
                } else if (item < 0) {
                    if (tix == 0) { unsigned sp = 0; while (xb_ld(sdone) < 80u) { __builtin_amdgcn_s_sleep(4); if (++sp > (1u << 22)) break; }
                        __builtin_amdgcn_fence(__ATOMIC_ACQUIRE, "agent"); asm volatile("s_waitcnt vmcnt(0)" ::: "memory"); }
                    __syncthreads();
                    const int wi = qi - Q_WO, lp = lq > 0 ? lq - 1 : 0; const size_t ro = (size_t)(MP / BM + (wi >> 2)) * BM;
                    Gemm g{WSP(h16, W_CAT) + ro * 1024, WSP(h16, W_WO + lq * SZ_WO), BM, 1024, 1024, 1024, 1024}; StaticOrder S; S.init(BM, 1024, 4, wi & 3);
                    EpiRes E{WSP(h16, W_XH) + ro * DM, WSP(float, W_STATS + (size_t)(lp * 2 + 1) * SZ_STATS) + 2 * ro, kp->in[9] + lp * DM, kp->in[10] + lp * DM, lq > 0, WSP(float, W_STATS + (size_t)(lq * 2) * SZ_STATS) + 2 * ro};
                    gemm_phase(lds, g, S, E, tix);
                    __syncthreads();
                    if (tix == 0) { __builtin_amdgcn_fence(__ATOMIC_RELEASE, "agent"); asm volatile("s_waitcnt vmcnt(0)" ::: "memory"); (void)xb_add(wdone + (wi >> 2), 1u); }
                } else if (item < N_SA) {
                    constexpr int KS = 592;
                    const float* clat = kp->in[2] + (size_t)lq * DBATCH * PAST * 256; const float* ckr = kp->in[3] + (size_t)lq * DBATCH * PAST * 32;
                    const h16* qlat = WSP(h16, W_QLAT); const h16* knew = WSP(h16, W_KNEW); h16* cats = WSP(h16, W_CATS);
                    const int b = item >> 3, hg = (item >> 2) & 1, sp = item & 3, head = 4 * hg + (wave >> 1), tq = 16 * (wave & 1) + fr, t0 = sp * 16;
                    h8 qf[1][9];
#pragma unroll
                    for (int ks = 0; ks < 9; ++ks) qf[0][ks] = *(const h8*)(qlat + (size_t)(b * 32 + tq) * QLW + head * 288 + 32 * ks + 8 * g4);
                    f4 o[1][16]; float mrow[1] = {-1e30f}, lrow[1] = {0.f};
#pragma unroll
                    for (int ct = 0; ct < 16; ++ct) o[0][ct] = (f4){0.f, 0.f, 0.f, 0.f};
                    const float* lb = clat + (size_t)b * PAST * 256 + (size_t)(t0 * 64 + (tix >> 6)) * 256 + (tix & 63) * 4; const float* rb = ckr + (size_t)b * PAST * 32 + (size_t)(t0 * 64 + (tix >> 3)) * 32 + (tix & 7) * 4;
                    const int wl = (tix >> 6) * KS + (tix & 63) * 8, wr_ = (tix >> 3) * KS + 512 + (tix & 7) * 8;
                    f4 pl[4]; f4 pr;
#pragma unroll
                    for (int hf = 0; hf < 2; ++hf) {
#pragma unroll
                        for (int i = 0; i < 4; ++i) pl[i] = *(const f4*)(lb + (size_t)(hf * 4 + i) * 8 * 256);
#pragma unroll
                        for (int i = 0; i < 4; ++i) *(LAS h4*)(lds + wl + (hf * 4 + i) * 8 * KS) = pack4(pl[i]); }
                    pr = *(const f4*)rb;
                    *(LAS h4*)(lds + wr_) = pack4(pr);
                    __syncthreads();
                    for (int t = 0; t < 16; ++t) {
                        LAS unsigned char* cur = lds + (t & 1) * (64 * KS); LAS unsigned char* nxt = lds + ((t + 1) & 1) * (64 * KS);
                        const bool more = t + 1 < 16;
                        if (more) {
#pragma unroll
                            for (int i = 0; i < 4; ++i) pl[i] = *(const f4*)(lb + ((size_t)(t + 1) * 64 + i * 8) * 256);
                            pr = *(const f4*)(rb + (size_t)(t + 1) * 64 * 32);
                        }
                        h8 pf[1][2];
                        attn_qk<9, 16, 1, KS>(cur, qf, o, mrow, lrow, pf, 4, ln);
                        if (more) {
#pragma unroll
                            for (int i = 0; i < 4; ++i) *(LAS h4*)(nxt + wl + i * 8 * KS) = pack4(pl[i]);
                            *(LAS h4*)(nxt + wr_) = pack4(pr);
#pragma unroll
                            for (int i = 0; i < 4; ++i) pl[i] = *(const f4*)(lb + ((size_t)(t + 1) * 64 + (4 + i) * 8) * 256);
                        }
                        attn_pv<16, 1, KS>(cur, o, pf, 4, ln);
                        if (more) {
#pragma unroll
                            for (int i = 0; i < 4; ++i) *(LAS h4*)(nxt + wl + (4 + i) * 8 * KS) = pack4(pl[i]);
                        } else if (sp == 3) {
                            for (int id = tix; id < 32 * 36; id += 512) { const int key = id / 36, part = id % 36; *(LAS h8*)(nxt + key * KS + part * 16) = *(const h8*)(knew + (size_t)(b * 32 + key) * KNW + part * 8); }
                        }
                        __syncthreads();
                    }
                    if (sp == 3) attn_tile<9, 16, 1, KS, KS>(lds, lds, qf, o, mrow, lrow, 2, ln);
                    { unsigned char* pw = ws + W_PART + ((size_t)item * 8 + wave) * SZ_PARTW;
#pragma unroll
                      for (int ct = 0; ct < 16; ++ct) *(f4*)(pw + ct * 1024 + ln * 16) = o[0][ct];
                      *(float*)(pw + 16384 + ln * 4) = mrow[0]; *(float*)(pw + 16640 + ln * 4) = lrow[0]; }
                    asm volatile("s_waitcnt vmcnt(0)" ::: "memory");
                    __syncthreads();
                    if (tix == 0) { __builtin_amdgcn_fence(__ATOMIC_RELEASE, "agent"); asm volatile("s_waitcnt vmcnt(0)" ::: "memory");
                        const unsigned old = xb_add(WSP(unsigned, W_CTR) + 256 + lq * 64 + rep * 512 + (item >> 2), 1u);
                        if (old == 3u) { __builtin_amdgcn_fence(__ATOMIC_ACQUIRE, "agent"); asm volatile("s_waitcnt vmcnt(0)" ::: "memory"); }
                        *((LAS int*)&s_ctl + 3) = (int)old; }
                    __syncthreads();
                    if (*((LAS int*)&s_ctl + 3) == 3) {
                        const unsigned char* p0 = ws + W_PART + ((size_t)(item & ~3) * 8 + wave) * SZ_PARTW;
                        float mi[4], M = -1e30f;
#pragma unroll
                        for (int i = 0; i < 4; ++i) { mi[i] = *(const float*)(p0 + (size_t)i * 8 * SZ_PARTW + 16384 + ln * 4); M = fmaxf(M, mi[i]); }
                        float L = 0.f;
#pragma unroll
                        for (int i = 0; i < 4; ++i) { mi[i] = __builtin_amdgcn_exp2f(mi[i] - M); L += mi[i] * *(const float*)(p0 + (size_t)i * 8 * SZ_PARTW + 16640 + ln * 4); }
                        L += shx(L, 16, ln); L += shx(L, 32, ln); const float inv = 1.f / L;
                        h8 bf[8];
#pragma unroll
                        for (int ks = 0; ks < 8; ++ks) { f4 u0 = (f4){0.f, 0.f, 0.f, 0.f}, u1 = u0;
#pragma unroll
                            for (int i = 0; i < 4; ++i) { u0 += *(const f4*)(p0 + (size_t)i * 8 * SZ_PARTW + (2 * ks) * 1024 + ln * 16) * mi[i]; u1 += *(const f4*)(p0 + (size_t)i * 8 * SZ_PARTW + (2 * ks + 1) * 1024 + ln * 16) * mi[i]; }
                            bf[ks] = pack8(u0 * inv, u1 * inv); }
                        const h16* wuvt = WSP(h16, W_WOS + lq * SZ_WOS) + (size_t)head * 64 * 256;
                        h16* dst = cats + (size_t)(b * 32 + tq) * 1024 + 256 + head * 64 + 4 * g4;
#pragma unroll
                        for (int dt = 0; dt < 4; ++dt) { f4 od = (f4){0.f, 0.f, 0.f, 0.f};
#pragma unroll
                            for (int ks = 0; ks < 8; ++ks) { const h16* wp = wuvt + (size_t)(16 * dt + fr) * 256 + 32 * ks + 4 * g4;
                                od = __builtin_amdgcn_mfma_f32_16x16x32_f16(cat44(*(const h4*)wp, *(const h4*)(wp + 16)), bf[ks], od, 0, 0, 0); }
                            *(h4*)(dst + 16 * dt) = pack4(od); }
                        asm volatile("s_waitcnt vmcnt(0)" ::: "memory"); __syncthreads();
                        if (tix == 0) { __builtin_amdgcn_fence(__ATOMIC_RELEASE, "agent"); asm volatile("s_waitcnt vmcnt(0)" ::: "memory"); (void)xb_add(sdone, 1u); }
                    }
                } else if (item < N_SA + N_PA) {
                    constexpr int KS = 208, VS = 144, KBUF = 64 * KS, VBUF = 64 * VS;
                    const h16* qb = WSP(h16, W_Q); const h16* kb = WSP(h16, W_K); const h16* vb = WSP(h16, W_V); h16* cat = WSP(h16, W_CAT);
                    const int it = item - N_SA, qblk = 7 - (it >> 7), bh = it & 127, b = bh >> 3, head = bh & 7;
                    const int r0 = qblk * 256 + 32 * wave, ntw = (r0 >> 6) + 1, ntb = 4 * (qblk + 1);
                    h8 qf[2][3];
#pragma unroll
                    for (int qs = 0; qs < 2; ++qs)
#pragma unroll
                        for (int ks = 0; ks < 3; ++ks) qf[qs][ks] = *(const h8*)(qb + (size_t)(b * SEQ + r0 + 16 * qs + fr) * QW + head * 96 + 32 * ks + 8 * g4);
                    f4 o[2][4]; float mrow[2] = {-1e30f, -1e30f}, lrow[2] = {0.f, 0.f};
#pragma unroll
                    for (int qs = 0; qs < 2; ++qs)
#pragma unroll
                        for (int ct = 0; ct < 4; ++ct) o[qs][ct] = (f4){0.f, 0.f, 0.f, 0.f};
                    const int k0key = tix / 12, k0part = tix % 12, k1key = (tix + 512) / 12, k1part = (tix + 512) % 12, vkey = tix >> 3, vpart = tix & 7;
                    const h16* kg0 = kb + (size_t)b * SEQ * KW + head * 96 + (size_t)k0key * KW + k0part * 8; const h16* kg1 = kb + (size_t)b * SEQ * KW + head * 96 + (size_t)k1key * KW + k1part * 8;
                    const h16* vg = vb + (size_t)b * SEQ * VW + head * 64 + (size_t)vkey * VW + vpart * 8;
                    const int lk0 = k0key * KS + k0part * 16, lk1 = k1key * KS + k1part * 16, lv = 2 * KBUF + vkey * VS + vpart * 16;
                    h8 pk0, pk1 = (h8){0, 0, 0, 0, 0, 0, 0, 0}, pv;
                    pk0 = *(const h8*)kg0; if (tix < 256) pk1 = *(const h8*)kg1; pv = *(const h8*)vg;
                    *(LAS h8*)(lds + lk0) = pk0; if (tix < 256) *(LAS h8*)(lds + lk1) = pk1; *(LAS h8*)(lds + lv) = pv;
                    __syncthreads();
                    for (int t = 0; t < ntb; ++t) {
                        const int co = (t & 1), no = ((t + 1) & 1);
                        if (t + 1 < ntb) { const size_t ro = (size_t)(t + 1) * 64;
                            pk0 = *(const h8*)(kg0 + ro * KW); if (tix < 256) pk1 = *(const h8*)(kg1 + ro * KW); pv = *(const h8*)(vg + ro * VW); }
                        if (t < ntw) attn_tile<3, 4, 2, KS, VS>(lds + co * KBUF, lds + 2 * KBUF + co * VBUF, qf, o, mrow, lrow, 4, ln);
                        if (t + 1 < ntb) { *(LAS h8*)(lds + no * KBUF + lk0) = pk0; if (tix < 256) *(LAS h8*)(lds + no * KBUF + lk1) = pk1; *(LAS h8*)(lds + no * VBUF + lv) = pv; }
                        __syncthreads();
                    }
#pragma unroll
                    for (int qs = 0; qs < 2; ++qs) { float lt = lrow[qs]; lt += shx(lt, 16, ln); lt += shx(lt, 32, ln); const float inv = 1.f / lt;
                        h16* dst = cat + (size_t)(b * SEQ + r0 + 16 * qs + fr) * 1024 + 256 + head * 64 + 4 * g4;
#pragma unroll
                        for (int ct = 0; ct < 4; ++ct) *(h4*)(dst + 16 * ct) = pack4(o[qs][ct] * inv); }
                } else if (item < N_SA + N_PA + N_PS) {
                    const float* abuf = WSP(float, W_A); const float* bbuf = WSP(float, W_B); const h16* z = WSP(h16, W_Z); h16* cat = WSP(h16, W_CAT);
                    const int it = item - N_SA - N_PA, b = it >> 3, ch = (it & 7) * 32 + (ln & 31), seg = wave * 2 + (ln >> 5), tl = seg * 32 + (ln & 31);
                    const size_t rbase = (size_t)b * SEQ + seg * 128;
                    float A = 1.f, B = 0.f;
#pragma unroll 16
                    for (int i = 0; i < 128; ++i) { const float a = abuf[(rbase + i) * 256 + ch], bb = bbuf[(rbase + i) * 256 + ch]; B = a * B + bb; A *= a; }
                    LAS float* sA = (LAS float*)lds; LAS float* sB = sA + 512;
                    sA[tl] = A; sB[tl] = B;
                    __syncthreads();
                    float h = 0.f;
                    for (int s2 = 0; s2 < seg; ++s2) h = sA[s2 * 32 + (ln & 31)] * h + sB[s2 * 32 + (ln & 31)];
#pragma unroll 16
                    for (int i = 0; i < 128; ++i) { const float a = abuf[(rbase + i) * 256 + ch], bb = bbuf[(rbase + i) * 256 + ch]; h = a * h + bb;
                        const float gt = (float)z[(rbase + i) * ZW + 1440 + ch]; cat[(rbase + i) * 1024 + 768 + ch] = (h16)(h * gt); }
                    if (seg == 15) out[O_PH + ((size_t)lq * NB + b) * 256 + ch] = h;
                } else {
                    const float* abuf = WSP(float, W_A); const float* bbuf = WSP(float, W_B); const h16* z = WSP(h16, W_Z); h16* cats = WSP(h16, W_CATS);
                    const int it = item - N_SA - N_PA - N_PS, idx = it * 512 + tix, b = idx >> 8, ch = idx & 255;
                    float h = kp->in[4][((size_t)lq * DBATCH + b) * 256 + ch];
                    for (int t = 0; t < DSEQ; ++t) { const size_t r = (size_t)MP + b * 32 + t; h = abuf[r * 256 + ch] * h + bbuf[r * 256 + ch];
                        const float gt = (float)z[r * ZW + 1440 + ch]; cats[(size_t)(b * 32 + t) * 1024 + 768 + ch] = (h16)(h * gt); }
                    out[O_SH + ((size_t)lq * DBATCH + b) * 256 + ch] = h;
                    asm volatile("s_waitcnt vmcnt(0)" ::: "memory"); __syncthreads();
                    if (tix == 0) { __builtin_amdgcn_fence(__ATOMIC_RELEASE, "agent"); asm volatile("s_waitcnt vmcnt(0)" ::: "memory"); (void)xb_add(sdone, 1u); }
                }
            }
        }
        GSYNC();

        for (int rep = 0; rep < NREP(9); ++rep) if (PHM & (1u << 9)) { PH_BEGIN
          conv_gate_items((unsigned)((MP / 4) * (DFF / 8)) + (unsigned)gtid, (unsigned)((MT / 4) * (DFF / 8)), (unsigned)NGT, 4, WSP(h16, W_UP), WSP(h16, W_ACT),
                          kp->in[28] + (size_t)lq * 3 * DFF2, kp->in[29] + (size_t)lq * DFF2, kp->in[6] + (size_t)lq * DBATCH * 2 * DFF2);
          const int lp = lq > 0 ? lq - 1 : 0;
          Gemm g{WSP(h16, W_CAT), WSP(h16, W_WO + lq * SZ_WO), MP, 1024, 1024, 1024, 1024}; StaticOrder S; S.init(MP, 1024, G, bid);
          EpiRes E{WSP(h16, W_XH), WSP(float, W_STATS + (size_t)(lp * 2 + 1) * SZ_STATS), kp->in[9] + lp * DM, kp->in[10] + lp * DM, lq > 0, WSP(float, W_STATS + (size_t)(lq * 2) * SZ_STATS)}; gemm_phase(lds, g, S, E, tid); }
        GSYNC();

        for (int rep = 0; rep < NREP(12); ++rep) if (PHM & (1u << 12)) { PH_BEGIN
          Gemm g{WSP(h16, W_XH), WSP(h16, W_WUP + lq * SZ_WUP), MP, DFF2, 1024, 1024, 1024}; StaticOrder S; S.init(MP, DFF2, G, bid);
          EpiUp E{WSP(h16, W_UP), out + O_PFC + (size_t)lq * NB * 2 * DFF2, (O_SFC + (size_t)lq * DBATCH * 2 * DFF2) - (O_PFC + (size_t)lq * NB * 2 * DFF2), WSP(float, W_STATS + (size_t)(lq * 2) * SZ_STATS), WSP(float, W_CD + lq * SZ_CD) + 2 * ZW, WSP(float, W_CD + lq * SZ_CD) + 2 * ZW + DFF2, 0}; gemm_phase(lds, g, S, E, tid); }
        GSYNC();

        for (int rep = 0; rep < NREP(13); ++rep) if (PHM & (1u << 13)) { PH_BEGIN
            if (bid < 16) { const size_t ro = (size_t)(MP / BM + (bid >> 2)) * BM;
                Gemm g{WSP(h16, W_ACT) + ro * DFF, WSP(h16, W_WDN + lq * SZ_WDN), BM, 1024, DFF, DFF, DFF}; StaticOrder S; S.init(BM, 1024, 4, bid & 3);
                EpiRes E{WSP(h16, W_XH) + ro * DM, WSP(float, W_STATS + (size_t)(lq * 2) * SZ_STATS) + 2 * ro, kp->in[7] + lq * DM, kp->in[8] + lq * DM, true, WSP(float, W_STATS + (size_t)(lq * 2 + 1) * SZ_STATS) + 2 * ro}; gemm_phase(lds, g, S, E, tid); }
            else conv_gate_items((unsigned)(gtid - 16 * 512), (unsigned)((DFF / 8) * (MP / 32)), (unsigned)(NGT - 16 * 512), 32, WSP(h16, W_UP), WSP(h16, W_ACT),
                                 kp->in[28] + (size_t)lq * 3 * DFF2, kp->in[29] + (size_t)lq * DFF2, kp->in[6] + (size_t)lq * DBATCH * 2 * DFF2); }
        GSYNC();

        for (int rep = 0; rep < NREP(14); ++rep) if (PHM & (1u << 14)) { PH_BEGIN
          Gemm g{WSP(h16, W_ACT), WSP(h16, W_WDN + lq * SZ_WDN), MP, 1024, DFF, DFF, DFF}; StaticOrder S; S.init(MP, 1024, G, bid); EpiRes E{WSP(h16, W_XH), WSP(float, W_STATS + (size_t)(lq * 2) * SZ_STATS), kp->in[7] + lq * DM, kp->in[8] + lq * DM, true, WSP(float, W_STATS + (size_t)(lq * 2 + 1) * SZ_STATS)}; gemm_phase(lds, g, S, E, tid); }
        GSYNC();

    }
    { const int l = DEPTH - 1; PH_BEGIN
        const float* gg = kp->in[9] + lq * DM; const float* bb = kp->in[10] + lq * DM; const h16* pre2 = WSP(h16, W_XH); const float* st = WSP(float, W_STATS + (size_t)(lq * 2 + 1) * SZ_STATS);
        for (size_t i = gtid; i < (size_t)MT * (DM / 4); i += NGT) { const int row = (int)(i >> 8), c = (int)(i & 255) * 4;
            const float sm = st[2 * row], sq = st[2 * row + 1], mean = sm * (1.f / DM), rstd = rsqrtf(sq * (1.f / DM) - mean * mean + 1e-5f);
            const h4 xv = *(const h4*)(pre2 + (size_t)row * DM + c);
            *(f4*)(out + O_Y + (size_t)row * DM + c) = ((f4){(float)xv[0], (float)xv[1], (float)xv[2], (float)xv[3]} - mean) * rstd * *(const f4*)(gg + c) + *(const f4*)(bb + c); }
    }
}

extern "C" void kernel_launch(void* const* d_in, const int* in_sizes, int n_in, void* d_out, int out_size, void* d_ws, size_t ws_size, hipStream_t stream) {
    constexpr size_t kDynLds = STAGE_BYTES;
    static int grid_blocks = 0;
    if (!grid_blocks) {
        if (n_in != 31 || (size_t)out_size != O_END || ws_size < W_END) { fprintf(stderr, "kernel_launch: unexpected shapes n_in %d out %d ws %zu (need %zu)\n", n_in, out_size, ws_size, (size_t)W_END); grid_blocks = -1; return; }
        int dev = 0, cus = 0, per_cu = 0;
        hipGetDevice(&dev);
        hipDeviceGetAttribute(&cus, hipDeviceAttributeMultiprocessorCount, dev);
        hipFuncSetAttribute((const void*)trunk_fwd, hipFuncAttributeMaxDynamicSharedMemorySize, (int)kDynLds);
        hipOccupancyMaxActiveBlocksPerMultiprocessor(&per_cu, (const void*)trunk_fwd, 512, kDynLds);
        if (per_cu < 1) per_cu = 1;
        grid_blocks = cus * per_cu;
        if (grid_blocks > 256) grid_blocks = 256;
        if (grid_blocks < 32) { fprintf(stderr, "kernel_launch: grid %d too small\n", grid_blocks); grid_blocks = -1; return; }
    }
    if (grid_blocks < 0) return;
    hipMemsetAsync((char*)d_ws + W_CTR, 0, W_ZERO_END, stream);
    Params p{};
    for (int i = 0; i < 31; ++i) p.in[i] = (const float*)d_in[i];
    p.out = (float*)d_out; p.ws = (unsigned char*)d_ws;
    void* args[] = {&p};
    hipError_t e = hipLaunchCooperativeKernel((const void*)trunk_fwd, dim3(grid_blocks), dim3(512), args, kDynLds, stream);
    if (e != hipSuccess) fprintf(stderr, "cooperative launch failed: %s (grid %d)\n", hipGetErrorString(e), grid_blocks);
}
```

```cpp
#include <hip/hip_runtime.h>
#include <hip/hip_cooperative_groups.h>
#include <cstdio>
#include <cstdint>
namespace cg = cooperative_groups;

typedef _Float16 h16;
typedef _Float16 h8 __attribute__((ext_vector_type(8)));
typedef _Float16 h4 __attribute__((ext_vector_type(4)));
typedef _Float16 h2 __attribute__((ext_vector_type(2)));
typedef float f4 __attribute__((ext_vector_type(4)));
typedef short s4v __attribute__((__vector_size__(8)));
#define LAS __attribute__((address_space(3)))
#define DEVI __device__ __forceinline__

constexpr int DM = 1024, NB = 16, SEQ = 2048, DEPTH = 4, DBATCH = 32, DSEQ = 32, PAST = 4096;
constexpr int MP = NB * SEQ, MS = DBATCH * DSEQ, MT = MP + MS;
constexpr int DIN = 1696, ZW = 1792, DFF = 2816, DFF2 = 5632;
constexpr int QW = 768, KW = 768, VW = 512, QLW = 2304, CSW = 2560, KNW = 288;
constexpr float ALPHA = 1.681792830507429f;
constexpr float QSCALE = 0.14724444f;
constexpr int NPOS = SEQ + DSEQ;

constexpr size_t O_Y = 0;
constexpr size_t O_PLAT = (size_t)MT * DM;
constexpr size_t O_PKR = O_PLAT + (size_t)DEPTH * MP * 256;
constexpr size_t O_PH = O_PKR + (size_t)DEPTH * MP * 32;
constexpr size_t O_PLC = O_PH + (size_t)DEPTH * NB * 256;
constexpr size_t O_PFC = O_PLC + (size_t)DEPTH * NB * 3 * 256;
constexpr size_t O_SLAT = O_PFC + (size_t)DEPTH * NB * 2 * DFF2;
constexpr size_t O_SKR = O_SLAT + (size_t)DEPTH * MS * 256;
constexpr size_t O_SV = O_SKR + (size_t)DEPTH * MS * 32;
constexpr size_t O_SH = O_SV + (size_t)DEPTH * MS * 256;
constexpr size_t O_SLC = O_SH + (size_t)DEPTH * DBATCH * 256;
constexpr size_t O_SFC = O_SLC + (size_t)DEPTH * DBATCH * 3 * 256;
constexpr size_t O_END = O_SFC + (size_t)DEPTH * DBATCH * 2 * DFF2;

constexpr size_t al(size_t x) { return (x + 255) & ~(size_t)255; }
constexpr size_t W_CTR = 0;
constexpr size_t W_PARAMS = 2048;
constexpr size_t W_BAR = 4096;
constexpr size_t W_CD = 4096 + 16384;
constexpr size_t SZ_CD = (size_t)(2 * ZW + 2 * DFF2) * 4;
constexpr size_t W_STATS = W_CD + DEPTH * SZ_CD;
constexpr size_t SZ_STATS = (size_t)MT * 2 * 4;
constexpr size_t W_ZERO_END = W_STATS + (size_t)DEPTH * 2 * SZ_STATS;
constexpr size_t W_ROPE = al(W_ZERO_END);
constexpr size_t W_SP = al(W_ROPE + (size_t)NPOS * 16 * 2 * 4);
constexpr size_t W_WIN = al(W_SP + (size_t)DEPTH * 256 * 4);
constexpr size_t SZ_WIN = (size_t)ZW * 1024 * 2;
constexpr size_t W_WUQ = W_WIN + DEPTH * SZ_WIN;   constexpr size_t SZ_WUQ = (size_t)768 * 384 * 2;
constexpr size_t W_WQL = W_WUQ + DEPTH * SZ_WUQ;   constexpr size_t SZ_WQL = (size_t)2048 * 384 * 2;
constexpr size_t W_WKV = W_WQL + DEPTH * SZ_WQL;   constexpr size_t SZ_WKV = (size_t)1024 * 256 * 2;
constexpr size_t W_WG = W_WKV + DEPTH * SZ_WKV;    constexpr size_t SZ_WG = (size_t)512 * 256 * 2;
constexpr size_t W_WO = W_WG + DEPTH * SZ_WG;      constexpr size_t SZ_WO = (size_t)1024 * 1024 * 2;
constexpr size_t W_WOS = W_WO + DEPTH * SZ_WO;     constexpr size_t SZ_WOS = (size_t)8 * 64 * 256 * 2;
constexpr size_t W_WUP = W_WOS + DEPTH * SZ_WOS;   constexpr size_t SZ_WUP = (size_t)DFF2 * 1024 * 2;
constexpr size_t W_WDN = W_WUP + DEPTH * SZ_WUP;   constexpr size_t SZ_WDN = (size_t)1024 * DFF * 2;
constexpr size_t W_XH = W_WDN + DEPTH * SZ_WDN;
constexpr size_t W_Z = W_XH + (size_t)MT * 1024 * 2;
constexpr size_t W_CQN = W_Z + (size_t)MT * ZW * 2;
constexpr size_t W_CKVN = W_CQN + (size_t)MT * 384 * 2;
constexpr size_t W_XC = W_CKVN + (size_t)MP * 256 * 2;
constexpr size_t W_Q = W_XC + (size_t)MT * 256 * 2;
constexpr size_t W_K = W_Q + (size_t)MP * QW * 2;
constexpr size_t W_V = W_K + (size_t)MP * KW * 2;
constexpr size_t W_A = W_V + (size_t)MP * VW * 2;
constexpr size_t W_B = W_A + (size_t)MT * 256 * 4;
constexpr size_t W_CAT = W_B + (size_t)MT * 256 * 4;
constexpr size_t W_CATS = W_CAT + (size_t)MP * 1024 * 2;
constexpr size_t W_QLAT = W_CATS + (size_t)MS * 1024 * 2;
constexpr size_t W_KNEW = W_QLAT + (size_t)MS * QLW * 2;
constexpr size_t W_PRE = al(W_KNEW + (size_t)MS * KNW * 2);
constexpr size_t W_X1F = W_PRE + (size_t)MT * 1024 * 4;
constexpr size_t W_UP = W_X1F + (size_t)MT * 1024 * 4;
constexpr size_t W_ACT = W_UP + (size_t)MT * DFF2 * 2;
constexpr size_t W_PART = W_ACT + (size_t)MT * DFF * 2;
constexpr size_t SZ_PARTW = 16 * 1024 + 512;
constexpr size_t W_END = W_PART + (size_t)256 * 8 * SZ_PARTW;

struct Params { const float* in[31]; float* out; unsigned char* ws; };

DEVI float gelu_f(float x) { const float u = -2.302208198f * (x + 0.044715f * x * x * x); return x * __builtin_amdgcn_rcpf(1.f + __builtin_amdgcn_exp2f(u)); }
DEVI float sigmoid_f(float x) { return __builtin_amdgcn_rcpf(1.f + __builtin_amdgcn_exp2f(-1.4426950408889634f * x)); }
DEVI h8 pack8(f4 a, f4 b) { h8 r; r[0] = (h16)a[0]; r[1] = (h16)a[1]; r[2] = (h16)a[2]; r[3] = (h16)a[3]; r[4] = (h16)b[0]; r[5] = (h16)b[1]; r[6] = (h16)b[2]; r[7] = (h16)b[3]; return r; }
DEVI h4 pack4(f4 a) { h4 r; r[0] = (h16)a[0]; r[1] = (h16)a[1]; r[2] = (h16)a[2]; r[3] = (h16)a[3]; return r; }
DEVI float shx(float v, int o, int lane) { return __builtin_bit_cast(float, __builtin_amdgcn_ds_bpermute((lane ^ o) << 2, __builtin_bit_cast(int, v))); }
DEVI float wave_sum(float v, int lane) {
#pragma unroll
    for (int o = 1; o < 64; o <<= 1) v += shx(v, o, lane);
    return v;
}
DEVI int opaque_lane() { unsigned ones = ~0u; asm volatile("" : "+s"(ones)); return (int)__builtin_amdgcn_mbcnt_hi(ones, __builtin_amdgcn_mbcnt_lo(ones, 0u)); }
DEVI h4 trrd(LAS unsigned char* p) { s4v r = __builtin_amdgcn_ds_read_tr16_b64_v4i16((LAS s4v*)p); return __builtin_bit_cast(h4, r); }
DEVI h8 cat44(h4 a, h4 b) { return __builtin_shufflevector(a, b, 0, 1, 2, 3, 4, 5, 6, 7); }

constexpr int BM = 256, BK = 64, HALF = 128, HTB = HALF * BK * 2, STAGE_BYTES = 8 * HTB, NXCD = 8, WGM = 8;
DEVI int lds_byte(int r, int c) { const int st = (r >> 4) * 2 + (c >> 5), rr = r & 15, cc = c & 31, ob = rr * 64 + cc * 2; return st * 1024 + (ob ^ (((ob >> 9) & 1) << 5)); }
DEVI void stage_rc(int b, int& R, int& C) { const int st = b / 1024, sb = b % 1024, swz = sb ^ (((sb >> 9) & 1) << 5); R = (st >> 1) * 16 + swz / 64; C = (st & 1) * 32 + (swz % 64) / 2; }
DEVI int perm32(int rho) { const int n = rho >> 4, i = rho & 15; return 8 * (i >> 2) + 4 * n + (i & 3); }
struct Unit { int pm, pn; };
struct Gemm { const h16* A; const h16* Bt; int M, N, K, lda, ldb; };
struct StaticOrder {
    int nM, nN, nwg, G, c;
    DEVI void init(int M, int N, int G_, int c_) { nM = M / BM; nN = N / BM; nwg = nM * nN; G = G_; c = c_; }
    DEVI bool next(int i, Unit& u) const {
        if (c < 0) return false;
        const long L = (long)i * G + c; if (L >= nwg) return false;
        int wgid = (int)L; { const int q = nwg / NXCD, r = nwg % NXCD, xcd = wgid % NXCD, off = wgid / NXCD; wgid = (xcd < r ? xcd * (q + 1) : r * (q + 1) + (xcd - r) * q) + off; }
        const int nig = WGM * nN, gid = wgid / nig, fm = gid * WGM, gsz = (nM - fm) < WGM ? (nM - fm) : WGM;
        u.pm = fm + ((wgid % nig) % gsz); u.pn = (wgid % nig) / gsz; return true;
    }
};
template <class Epi>
DEVI void gemm_phase(LAS unsigned char* lds, const Gemm g, const StaticOrder& S, const Epi& E, const int tid) {
    const int wid = __builtin_amdgcn_readfirstlane(tid >> 6), lane = tid & 63, wr = wid >> 2, wc = wid & 3, fr = lane & 15, fq = lane >> 4;
    const int K = g.K, nt = K / BK;
    unsigned voffA[2], voffB[2];
#pragma unroll
    for (int i = 0; i < 2; ++i) { int R, C; stage_rc(tid * 16 + i * 8192, R, C); const int Rb = Epi::PERM ? ((R & ~31) + perm32(R & 31)) : R;
        voffA[i] = (unsigned)(R * g.lda + C) * 2u; voffB[i] = (unsigned)(Rb * g.ldb + C) * 2u; }
    const size_t kstep = (size_t)(BK * 2);
    const size_t hstepA = (size_t)HALF * g.lda * 2, hstepB = (size_t)HALF * g.ldb * 2;
    const size_t tstepA = 2 * hstepA, tstepB = 2 * hstepB;
    const unsigned ldsw = (unsigned)wid * 1024u;
    const int aoff = lds_byte(wr * 64 + fr, fq * 8), boff = lds_byte(wc * 32 + fr, fq * 8);
#define PG8_SA(b, h) (((b) * 2 + (h)) * HTB)
#define PG8_SB(b, h) ((4 + (b) * 2 + (h)) * HTB)
#define PG8_STAGE(bufoff, gbase, voff) do { _Pragma("unroll") for (int _i = 0; _i < 2; ++_i) \
        __builtin_amdgcn_global_load_lds((const unsigned*)((const char*)(gbase) + (voff)[_i]), (LAS unsigned*)(lds + (bufoff) + ldsw + _i * 8192), 16, 0, 0); } while (0)
#define PG8_LDA(dst, b, h) do { _Pragma("unroll") for (int m = 0; m < 4; ++m) _Pragma("unroll") for (int k = 0; k < 2; ++k) dst[m][k] = *(const LAS h8*)(lds + PG8_SA(b, h) + aoff + m * 2048 + k * 1024); } while (0)
#define PG8_LDB(dst, b, h) do { _Pragma("unroll") for (int n = 0; n < 2; ++n) _Pragma("unroll") for (int k = 0; k < 2; ++k) dst[n][k] = *(const LAS h8*)(lds + PG8_SB(b, h) + boff + n * 2048 + k * 1024); } while (0)
#define PG8_MMA(ai, bj, At, Bt) do { __builtin_amdgcn_s_setprio(1); _Pragma("unroll") for (int m = 0; m < 4; ++m) _Pragma("unroll") for (int n = 0; n < 2; ++n) _Pragma("unroll") for (int k = 0; k < 2; ++k) \
        acc[ai][bj][m][n] = __builtin_amdgcn_mfma_f32_16x16x32_f16(Bt[n][k], At[m][k], acc[ai][bj][m][n], 0, 0, 0); __builtin_amdgcn_s_setprio(0); } while (0)
#define PG8_WAIT_V(n) asm volatile("s_waitcnt vmcnt(" #n ")" ::: "memory")
#define PG8_WAIT_L(n) asm volatile("s_waitcnt lgkmcnt(" #n ")" ::: "memory")
#define PG8_BAR __builtin_amdgcn_s_barrier()
#define PG8_SCHED __builtin_amdgcn_sched_barrier(0)
    Unit cur, nxt; int ui = 0;
    if (!S.next(0, cur)) return;
    f4 acc[2][2][4][2];
#pragma unroll
    for (int a = 0; a < 2; ++a)
#pragma unroll
        for (int b = 0; b < 2; ++b)
#pragma unroll
            for (int m = 0; m < 4; ++m)
#pragma unroll
                for (int n = 0; n < 2; ++n) acc[a][b][m][n] = (f4){0.f, 0.f, 0.f, 0.f};
    h8 At[4][2], B0[2][2], B1[2][2];
    const char* cA = (const char*)g.A + (size_t)cur.pm * tstepA; const char* cB = (const char*)g.Bt + (size_t)cur.pn * tstepB;
    PG8_STAGE(PG8_SB(0, 0), cB, voffB); PG8_STAGE(PG8_SA(0, 0), cA, voffA); PG8_STAGE(PG8_SB(0, 1), cB + hstepB, voffB); PG8_STAGE(PG8_SA(0, 1), cA + hstepA, voffA);
    if (wr == 1) PG8_BAR;
    PG8_WAIT_V(4); PG8_BAR;
    PG8_STAGE(PG8_SB(1, 0), cB + kstep, voffB); PG8_STAGE(PG8_SA(1, 0), cA + kstep, voffA); PG8_STAGE(PG8_SB(1, 1), cB + hstepB + kstep, voffB);
    PG8_WAIT_V(6); PG8_BAR;
    for (;;) {
        const bool has_next = S.next(ui + 1, nxt);
        const char* nA = has_next ? (const char*)g.A + (size_t)nxt.pm * tstepA : cA; const char* nB = has_next ? (const char*)g.Bt + (size_t)nxt.pn * tstepB : cB;
        for (int t = 0; t < nt; t += 2) {
            const bool last = (t == nt - 2);
            const char* a1 = cA + (size_t)(t + 1) * kstep;
            const char* a2 = last ? nA : cA + (size_t)(t + 2) * kstep; const char* b2 = last ? nB : cB + (size_t)(t + 2) * kstep;
            const char* a3 = a2 + kstep; const char* b3 = b2 + kstep;
            PG8_LDB(B0, 0, 0); PG8_SCHED; PG8_LDA(At, 0, 0); PG8_STAGE(PG8_SA(1, 1), a1 + hstepA, voffA);
            PG8_WAIT_L(8); PG8_BAR; PG8_WAIT_L(0); PG8_MMA(0, 0, At, B0); PG8_BAR; PG8_SCHED;
            PG8_LDB(B1, 0, 1); PG8_STAGE(PG8_SB(0, 0), b2, voffB);
            PG8_BAR; PG8_WAIT_L(0); PG8_MMA(0, 1, At, B1); PG8_BAR;
            PG8_LDA(At, 0, 1); PG8_STAGE(PG8_SA(0, 0), a2, voffA);
            PG8_BAR; PG8_WAIT_L(0); PG8_MMA(1, 0, At, B0); PG8_BAR; PG8_SCHED;
            PG8_STAGE(PG8_SB(0, 1), b2 + hstepB, voffB);
            PG8_WAIT_V(6); PG8_BAR; PG8_MMA(1, 1, At, B1); PG8_BAR;
            PG8_LDB(B0, 1, 0); PG8_SCHED; PG8_LDA(At, 1, 0); PG8_STAGE(PG8_SA(0, 1), a2 + hstepA, voffA);
            PG8_WAIT_L(8); PG8_BAR; PG8_WAIT_L(0); PG8_MMA(0, 0, At, B0); PG8_BAR; PG8_SCHED;
            PG8_LDB(B1, 1, 1); PG8_STAGE(PG8_SB(1, 0), b3, voffB);
            PG8_BAR; PG8_WAIT_L(0); PG8_MMA(0, 1, At, B1); PG8_BAR;
            PG8_LDA(At, 1, 1); PG8_STAGE(PG8_SA(1, 0), a3, voffA);
            PG8_BAR; PG8_WAIT_L(0); PG8_MMA(1, 0, At, B0); PG8_BAR; PG8_SCHED;
            PG8_STAGE(PG8_SB(1, 1), b3 + hstepB, voffB);
            PG8_WAIT_V(6); PG8_BAR; PG8_MMA(1, 1, At, B1); PG8_BAR;
        }
        { int t2 = tid; asm volatile("" : "+v"(t2)); const int l2 = t2 & 63; E(acc, cur, wr, wc, l2 & 15, l2 >> 4); }
        if (!has_next) break;
#pragma unroll
        for (int a = 0; a < 2; ++a)
#pragma unroll
            for (int b = 0; b < 2; ++b)
#pragma unroll
                for (int m = 0; m < 4; ++m)
#pragma unroll
                    for (int n = 0; n < 2; ++n) acc[a][b][m][n] = (f4){0.f, 0.f, 0.f, 0.f};
        cur = nxt; cA = nA; cB = nB; ++ui;
    }
    PG8_WAIT_V(0);
    if (wr == 0) PG8_BAR;
    PG8_BAR;
#undef PG8_SA
#undef PG8_SB
#undef PG8_STAGE
#undef PG8_LDA
#undef PG8_LDB
#undef PG8_MMA
#undef PG8_WAIT_V
#undef PG8_WAIT_L
#undef PG8_BAR
#undef PG8_SCHED
}

typedef f4 Acc[2][2][4][2];
#define EPI_ROWS for (int ai = 0; ai < 2; ++ai) _Pragma("unroll") for (int m = 0; m < 4; ++m)

#define ROW_OF(r) (rowb + ((r) >> 2) * HALF + ((r) & 3) * 16)
struct EpiZ {
    static constexpr bool PERM = true;
    h16* z; float* sv; const float* st; const float* cv; const float* dv; bool fold;
    DEVI void operator()(const Acc& acc, const Unit& u, int wr, int wc, int fr, int fq) const {
        const int rowb = u.pm * BM + wr * 64 + fr, colb = u.pn * BM + wc * 32 + fq * 8;
        float mean[8], rstd[8]; f4 c[2][2], d[2][2];
#pragma unroll
        for (int r = 0; r < 8; ++r) { mean[r] = 0.f; rstd[r] = 1.f; }
#pragma unroll
        for (int bj = 0; bj < 2; ++bj)
#pragma unroll
            for (int n = 0; n < 2; ++n) { c[bj][n] = (f4){0.f, 0.f, 0.f, 0.f}; d[bj][n] = c[bj][n]; }
        if (fold) {
#pragma unroll
            for (int r = 0; r < 8; ++r) { const int row = ROW_OF(r); const float sm = st[2 * row], sq = st[2 * row + 1]; mean[r] = sm * (1.f / DM); rstd[r] = rsqrtf(sq * (1.f / DM) - mean[r] * mean[r] + 1e-5f); }
#pragma unroll
            for (int bj = 0; bj < 2; ++bj)
#pragma unroll
                for (int n = 0; n < 2; ++n) { c[bj][n] = *(const f4*)(cv + colb + bj * HALF + 4 * n); d[bj][n] = *(const f4*)(dv + colb + bj * HALF + 4 * n); } }
#pragma unroll
        for (int bj = 0; bj < 2; ++bj) { const int col = colb + bj * HALF; const bool act = col < 512 || (col >= 1440 && col < 1696);
#pragma unroll
            for (int r = 0; r < 8; ++r) { const int row = ROW_OF(r);
                f4 v0 = (acc[r >> 2][bj][r & 3][0] - c[bj][0] * mean[r]) * rstd[r] + d[bj][0], v1 = (acc[r >> 2][bj][r & 3][1] - c[bj][1] * mean[r]) * rstd[r] + d[bj][1];
                if (act) {
#pragma unroll
                    for (int e = 0; e < 4; ++e) { v0[e] = gelu_f(v0[e]); v1[e] = gelu_f(v1[e]); } }
                *(h8*)(z + (size_t)row * ZW + col) = pack8(v0, v1);
                if (row >= MP && col >= 256 && col < 512) { float* o = sv + (size_t)(row - MP) * 256 + (col - 256); *(f4*)o = v0; *(f4*)(o + 4) = v1; } } }
    }
};
struct EpiQ {
    static constexpr bool PERM = true;
    h16* q; h16* qlat; const float* ropec; const float* ropes;
    DEVI void operator()(const Acc& acc, const Unit& u, int wr, int wc, int fr, int fq) const {
        const bool samp = u.pm * BM >= MP;
        if (u.pn < 2) { if (samp) return;
#pragma unroll
            EPI_ROWS { const int row = u.pm * BM + ai * HALF + wr * 64 + m * 16 + fr;
#pragma unroll
                for (int bj = 0; bj < 2; ++bj) { const int col = u.pn * BM + bj * HALF + wc * 32 + fq * 8;
                    *(h8*)(q + (size_t)row * QW + (col >> 6) * 96 + (col & 63)) = pack8(acc[ai][bj][m][0] * QSCALE, acc[ai][bj][m][1] * QSCALE); } }
        } else {
            const int j = wc * 32 + fq * 8, head = j >> 4, i0 = j & 15; const int rowb = u.pm * BM + wr * 64 + fr;
#pragma unroll
            for (int r = 0; r < 8; ++r) { const int row = ROW_OF(r); const int pidx = samp ? SEQ + ((row - MP) & 31) : (row & (SEQ - 1));
                const size_t po = samp ? (W_QLAT - W_Q) / 2 + (size_t)(row - MP) * QLW + head * 288 + 256 + i0 : (size_t)row * QW + head * 96 + 64 + i0;
#pragma unroll
                for (int n = 0; n < 2; ++n) { const f4 cc = *(const f4*)(ropec + pidx * 16 + i0 + 4 * n), ss = *(const f4*)(ropes + pidx * 16 + i0 + 4 * n);
                    const f4 a0 = acc[r >> 2][0][r & 3][n], b0 = acc[r >> 2][1][r & 3][n];
                    *(h4*)(q + po + 4 * n) = pack4((a0 * cc - b0 * ss) * QSCALE); *(h4*)(q + po + 16 + 4 * n) = pack4((a0 * ss + b0 * cc) * QSCALE); } }
        }
    }
};
struct EpiKV {
    static constexpr bool PERM = true;
    h16* k; h16* v;
    DEVI void operator()(const Acc& acc, const Unit& u, int wr, int wc, int fr, int fq) const {
#pragma unroll
        EPI_ROWS { const int row = u.pm * BM + ai * HALF + wr * 64 + m * 16 + fr;
#pragma unroll
            for (int bj = 0; bj < 2; ++bj) { const int col = u.pn * BM + bj * HALF + wc * 32 + fq * 8; const h8 o = pack8(acc[ai][bj][m][0], acc[ai][bj][m][1]);
                if (u.pn < 2) *(h8*)(k + (size_t)row * KW + (col >> 6) * 96 + (col & 63)) = o; else *(h8*)(v + (size_t)row * VW + (col - 512)) = o; } }
    }
};
DEVI float one_minus_exp(float x) {
    const float pser = -x * (1.f + x * (0.5f + x * (0.16666667f + x * (0.041666668f + x * (0.0083333338f + x * 0.0013888889f)))));
    return x > -0.25f ? pser : 1.f - __builtin_amdgcn_exp2f(1.4426950408889634f * x);
}
struct EpiGate {
    static constexpr bool PERM = false;
    const h16* xc; float* a; float* b; const float* br; const float* bi; const float* sp;
    DEVI void operator()(const Acc& acc, const Unit& u, int wr, int wc, int fr, int fq) const {
        const int rowb = u.pm * BM + wr * 64 + fr, chb = u.pn * 128 + wc * 32 + fq * 4;
        f4 vbr[2], vbi[2], vsp[2]; h4 xv[2][8];
#pragma unroll
        for (int n = 0; n < 2; ++n) { const int ch = chb + n * 16; vbr[n] = *(const f4*)(br + ch); vbi[n] = *(const f4*)(bi + ch); vsp[n] = *(const f4*)(sp + ch) * -8.f;
#pragma unroll
            for (int r = 0; r < 8; ++r) xv[n][r] = *(const h4*)(xc + (size_t)ROW_OF(r) * 256 + ch); }
#pragma unroll
        for (int n = 0; n < 2; ++n) { const int ch = chb + n * 16;
#pragma unroll
            for (int r = 0; r < 8; ++r) { const int row = ROW_OF(r); f4 oa, ob;
#pragma unroll
                for (int e = 0; e < 4; ++e) { const float rg = sigmoid_f(acc[r >> 2][0][r & 3][n][e] + vbr[n][e]), ig = sigmoid_f(acc[r >> 2][1][r & 3][n][e] + vbi[n][e]);
                    const float la = rg * vsp[n][e]; oa[e] = __builtin_amdgcn_exp2f(1.4426950408889634f * la); ob[e] = __builtin_amdgcn_sqrtf(one_minus_exp(2.f * la)) * (ig * (float)xv[n][r][e]); }
                *(f4*)(a + (size_t)row * 256 + ch) = oa; *(f4*)(b + (size_t)row * 256 + ch) = ob; } }
    }
};
struct EpiQlat {
    static constexpr bool PERM = true;
    h16* qlat;
    DEVI void operator()(const Acc& acc, const Unit& u, int wr, int wc, int fr, int fq) const {
#pragma unroll
        EPI_ROWS { const int row = u.pm * BM + ai * HALF + wr * 64 + m * 16 + fr;
#pragma unroll
            for (int bj = 0; bj < 2; ++bj) { const int c = bj * HALF + wc * 32 + fq * 8;
                *(h8*)(qlat + (size_t)row * QLW + u.pn * 288 + c) = pack8(acc[ai][bj][m][0] * QSCALE, acc[ai][bj][m][1] * QSCALE); } }
    }
};
struct EpiRes {
    static constexpr bool PERM = true;
    h16* xh; const float* pst; const float* g; const float* b; bool ln; float* ost;
    DEVI void operator()(const Acc& acc, const Unit& u, int wr, int wc, int fr, int fq) const {
        const int rowb = u.pm * BM + wr * 64 + fr, colb = u.pn * BM + wc * 32 + fq * 8, lane = fq * 16 + fr;
        f4 gv[4], bv[4]; float mean[8], rstd[8];
#pragma unroll
        for (int k = 0; k < 4; ++k) { const int col = colb + (k >> 1) * HALF + (k & 1) * 4; gv[k] = ln ? *(const f4*)(g + col) : (f4){1.f, 1.f, 1.f, 1.f}; bv[k] = ln ? *(const f4*)(b + col) : (f4){0.f, 0.f, 0.f, 0.f}; }
#pragma unroll
        for (int r = 0; r < 8; ++r) { mean[r] = 0.f; rstd[r] = 1.f;
            if (ln) { const int row = ROW_OF(r); const float sm = pst[2 * row], sq = pst[2 * row + 1]; mean[r] = sm * (1.f / DM); rstd[r] = rsqrtf(sq * (1.f / DM) - mean[r] * mean[r] + 1e-5f); } }
        h8 cur[2], nxt[2];
#pragma unroll
        for (int bj = 0; bj < 2; ++bj) cur[bj] = *(const h8*)(xh + (size_t)ROW_OF(0) * DM + colb + bj * HALF);
#pragma unroll
        for (int r = 0; r < 8; ++r) { const int row = ROW_OF(r);
            if (r < 7) {
#pragma unroll
                for (int bj = 0; bj < 2; ++bj) nxt[bj] = *(const h8*)(xh + (size_t)ROW_OF(r + 1) * DM + colb + bj * HALF); }
            float s1 = 0.f, s2 = 0.f;
#pragma unroll
            for (int bj = 0; bj < 2; ++bj) { f4 y[2];
#pragma unroll
                for (int n = 0; n < 2; ++n) { const int k = bj * 2 + n;
                    const f4 xv = (f4){(float)cur[bj][4 * n], (float)cur[bj][4 * n + 1], (float)cur[bj][4 * n + 2], (float)cur[bj][4 * n + 3]};
                    y[n] = ((xv - mean[r]) * rstd[r] * gv[k] + bv[k]) * ALPHA + acc[r >> 2][bj][r & 3][n];
                    s1 += (y[n][0] + y[n][1]) + (y[n][2] + y[n][3]); s2 += (y[n][0] * y[n][0] + y[n][1] * y[n][1]) + (y[n][2] * y[n][2] + y[n][3] * y[n][3]); }
                *(h8*)(xh + (size_t)row * DM + colb + bj * HALF) = pack8(y[0], y[1]); }
            s1 += shx(s1, 16, lane); s2 += shx(s2, 16, lane); s1 += shx(s1, 32, lane); s2 += shx(s2, 32, lane);
            if (fq == 0) { atomicAdd(ost + 2 * row, s1); atomicAdd(ost + 2 * row + 1, s2); }
#pragma unroll
            for (int bj = 0; bj < 2; ++bj) cur[bj] = nxt[bj]; }
    }
};
struct EpiUp {
    static constexpr bool PERM = true;
    h16* up; int rowoff;
    DEVI void operator()(const Acc& acc, const Unit& u, int wr, int wc, int fr, int fq) const {
        const int rowb = rowoff + u.pm * BM + wr * 64 + fr, colb = u.pn * BM + wc * 32 + fq * 8;
#pragma unroll
        for (int r = 0; r < 8; ++r) { h16* p = up + (size_t)ROW_OF(r) * DFF2 + colb;
#pragma unroll
            for (int bj = 0; bj < 2; ++bj) __builtin_nontemporal_store(pack8(acc[r >> 2][bj][r & 3][0], acc[r >> 2][bj][r & 3][1]), (h8*)(p + bj * HALF)); }
    }
};

template <int MODE>
DEVI void transpose_item(const float* W, int ldw, int nblk, h16* WT, int ldd, LAS float* scr, int item, int lane, const float* gs = nullptr, const float* bs = nullptr, float* csum = nullptr, float* dsum = nullptr) {
    const int kb = item / nblk, nb = item % nblk, k0 = 64 * kb, n0 = 32 * nb;
    int nsrc = n0 + (lane & 31);
    if (MODE == 1) { const int n = nsrc; if (n < 512) nsrc = (n >> 6) * 96 + (n & 63); else if (n < 640) nsrc = ((n - 512) >> 4) * 96 + 64 + ((n - 512) & 15); else nsrc = ((n - 640) >> 4) * 96 + 80 + ((n - 640) & 15); }
    float cs = 0.f, ds = 0.f;
#pragma unroll 8
    for (int i = 0; i < 32; ++i) { const int kk = 2 * i + (lane >> 5); float w = W[(size_t)(k0 + kk) * ldw + nsrc]; if (gs) { ds += bs[k0 + kk] * w; w *= gs[k0 + kk]; cs += w; } scr[kk * 33 + (lane & 31)] = w; }
    if (gs && csum) { atomicAdd(csum + nsrc, cs); atomicAdd(dsum + nsrc, ds); }
    __builtin_amdgcn_fence(__ATOMIC_RELEASE, "wavefront"); asm volatile("s_waitcnt lgkmcnt(0)" ::: "memory");
    const int c = lane & 7;
#pragma unroll
    for (int j = 0; j < 4; ++j) { const int n = (lane >> 3) + 8 * j; const LAS float* s = scr + (8 * c) * 33 + n;
        h8 o; o[0] = (h16)s[0 * 33]; o[1] = (h16)s[1 * 33]; o[2] = (h16)s[2 * 33]; o[3] = (h16)s[3 * 33]; o[4] = (h16)s[4 * 33]; o[5] = (h16)s[5 * 33]; o[6] = (h16)s[6 * 33]; o[7] = (h16)s[7 * 33];
        *(h8*)(WT + (size_t)(n0 + n) * ldd + k0 + 8 * c) = o; }
    asm volatile("s_waitcnt lgkmcnt(0)" ::: "memory");
}

template <int NKS, int NCT, int NQS, int KSTR>
DEVI void attn_qk(LAS unsigned char* kbase, const h8 (&qf)[NQS][NKS], f4 (&o)[NQS][NCT], float (&mrow)[NQS], float (&lrow)[NQS], h8 (&pf)[NQS][2], const int nkt, const int lane) {
    const int fr = lane & 15, g = lane >> 4;
    f4 s[NQS][4];
#pragma unroll
    for (int qs = 0; qs < NQS; ++qs)
#pragma unroll
        for (int kt = 0; kt < 4; ++kt) s[qs][kt] = (f4){-1e30f, -1e30f, -1e30f, -1e30f};
#pragma unroll
    for (int kt = 0; kt < 4; ++kt) if (kt < nkt) {
#pragma unroll
        for (int qs = 0; qs < NQS; ++qs) s[qs][kt] = (f4){0.f, 0.f, 0.f, 0.f};
#pragma unroll
        for (int ks = 0; ks < NKS; ++ks) { const h8 kf = *(const LAS h8*)(kbase + (kt * 16 + fr) * KSTR + ks * 64 + g * 16);
#pragma unroll
            for (int qs = 0; qs < NQS; ++qs) s[qs][kt] = __builtin_amdgcn_mfma_f32_16x16x32_f16(kf, qf[qs][ks], s[qs][kt], 0, 0, 0); } }
    __builtin_amdgcn_sched_barrier(0);
#pragma unroll
    for (int qs = 0; qs < NQS; ++qs) {
        float mx = -1e30f;
#pragma unroll
        for (int kt = 0; kt < 4; ++kt)
#pragma unroll
            for (int e = 0; e < 4; ++e) mx = fmaxf(mx, s[qs][kt][e]);
        mx = fmaxf(mx, shx(mx, 16, lane)); mx = fmaxf(mx, shx(mx, 32, lane));
        const float mnew = fmaxf(mrow[qs], mx), alpha = __builtin_amdgcn_exp2f(mrow[qs] - mnew); mrow[qs] = mnew;
        float ps = 0.f;
#pragma unroll
        for (int kt = 0; kt < 4; ++kt)
#pragma unroll
            for (int e = 0; e < 4; ++e) { const float p = __builtin_amdgcn_exp2f(s[qs][kt][e] - mnew); s[qs][kt][e] = p; ps += p; }
        lrow[qs] = lrow[qs] * alpha + ps;
#pragma unroll
        for (int ct = 0; ct < NCT; ++ct) o[qs][ct] *= alpha;
#pragma unroll
        for (int k2 = 0; k2 < 2; ++k2) pf[qs][k2] = pack8(s[qs][2 * k2], s[qs][2 * k2 + 1]);
    }
    __builtin_amdgcn_sched_barrier(0);
}
template <int NCT, int NQS, int VSTR>
DEVI void attn_pv(LAS unsigned char* vbase, f4 (&o)[NQS][NCT], const h8 (&pf)[NQS][2], const int nkt, const int lane) {
    const int fr = lane & 15, g = lane >> 4, q_ = fr >> 2, p_ = fr & 3;
#pragma unroll
    for (int k2 = 0; k2 < 2; ++k2) if (2 * k2 < nkt) {
#pragma unroll
        for (int ct = 0; ct < NCT; ++ct) {
            const h4 lo = trrd(vbase + (32 * k2 + 4 * g + q_) * VSTR + (16 * ct + 4 * p_) * 2);
            const h4 hi = trrd(vbase + (32 * k2 + 16 + 4 * g + q_) * VSTR + (16 * ct + 4 * p_) * 2);
            const h8 vf = cat44(lo, hi);
#pragma unroll
            for (int qs = 0; qs < NQS; ++qs) o[qs][ct] = __builtin_amdgcn_mfma_f32_16x16x32_f16(vf, pf[qs][k2], o[qs][ct], 0, 0, 0); } }
    __builtin_amdgcn_sched_barrier(0);
}
template <int NKS, int NCT, int NQS, int KSTR, int VSTR>
DEVI void attn_tile(LAS unsigned char* kbase, LAS unsigned char* vbase, const h8 (&qf)[NQS][NKS], f4 (&o)[NQS][NCT], float (&mrow)[NQS], float (&lrow)[NQS], const int nkt, const int lane) {
    h8 pf[NQS][2];
    attn_qk<NKS, NCT, NQS, KSTR>(kbase, qf, o, mrow, lrow, pf, nkt, lane);
    attn_pv<NCT, NQS, VSTR>(vbase, o, pf, nkt, lane);
}


struct ConvP { const h16* up; h16* act; const float* fw; const float* fb; const float* stf; const float* st; const float* cv; const float* dv; float* pfc; size_t sdelta; };
DEVI void conv_gate_items(unsigned it_begin, unsigned it_end, unsigned it_step, const int rseg, const ConvP P) {
    constexpr int NCG = DFF / 8;
    for (unsigned it = it_begin; it < it_end; it += it_step) { const int seg = (int)(it / (unsigned)NCG), cg = (int)(it - (unsigned)seg * NCG), j0 = cg * 8, row0 = seg * rseg;
        const bool samp = row0 >= MP; const int t0 = samp ? ((row0 - MP) & 31) : (row0 & (SEQ - 1)), bb = (row0 - MP) >> 5, T = samp ? DSEQ : SEQ;
        const f4 bg0 = *(const f4*)(P.fb + j0), bg1 = *(const f4*)(P.fb + j0 + 4), bv0 = *(const f4*)(P.fb + DFF + j0), bv1 = *(const f4*)(P.fb + DFF + j0 + 4);
        const f4 cg0_ = *(const f4*)(P.cv + j0), cg1_ = *(const f4*)(P.cv + j0 + 4), cv0_ = *(const f4*)(P.cv + DFF + j0), cv1_ = *(const f4*)(P.cv + DFF + j0 + 4);
        const f4 dg0_ = *(const f4*)(P.dv + j0), dg1_ = *(const f4*)(P.dv + j0 + 4), dv0_ = *(const f4*)(P.dv + DFF + j0), dv1_ = *(const f4*)(P.dv + DFF + j0 + 4);
        f4 wg0[3], wg1[3], wv0[3], wv1[3];
#pragma unroll
        for (int j = 0; j < 3; ++j) { const float* wj = P.fw + (size_t)j * DFF2; wg0[j] = *(const f4*)(wj + j0); wg1[j] = *(const f4*)(wj + j0 + 4); wv0[j] = *(const f4*)(wj + DFF + j0); wv1[j] = *(const f4*)(wj + DFF + j0 + 4); }
#define CG_LOADROW(row, G0, G1, V0, V1) do { const h16* _u = P.up + (size_t)(row) * DFF2 + j0; const h8 _a = *(const h8*)_u, _c = *(const h8*)(_u + DFF); \
            const float _sm = P.st[2 * (row)], _sq = P.st[2 * (row) + 1], _mean = _sm * (1.f / DM), _rstd = __builtin_amdgcn_rsqf(_sq * (1.f / DM) - _mean * _mean + 1e-5f); \
            G0 = ((f4){(float)_a[0], (float)_a[1], (float)_a[2], (float)_a[3]} - cg0_ * _mean) * _rstd + dg0_; G1 = ((f4){(float)_a[4], (float)_a[5], (float)_a[6], (float)_a[7]} - cg1_ * _mean) * _rstd + dg1_; \
            V0 = ((f4){(float)_c[0], (float)_c[1], (float)_c[2], (float)_c[3]} - cv0_ * _mean) * _rstd + dv0_; V1 = ((f4){(float)_c[4], (float)_c[5], (float)_c[6], (float)_c[7]} - cv1_ * _mean) * _rstd + dv1_; } while (0)
        f4 ag0, ag1, av0, av1, bg0_, bg1_, bv0_, bv1_;
        if (t0 > 0) { CG_LOADROW(row0 - 2, ag0, ag1, av0, av1); CG_LOADROW(row0 - 1, bg0_, bg1_, bv0_, bv1_); }
        else if (samp) { const float* s2 = P.stf + (size_t)bb * 2 * DFF2; const float* s1 = s2 + DFF2;
            ag0 = *(const f4*)(s2 + j0); ag1 = *(const f4*)(s2 + j0 + 4); av0 = *(const f4*)(s2 + DFF + j0); av1 = *(const f4*)(s2 + DFF + j0 + 4);
            bg0_ = *(const f4*)(s1 + j0); bg1_ = *(const f4*)(s1 + j0 + 4); bv0_ = *(const f4*)(s1 + DFF + j0); bv1_ = *(const f4*)(s1 + DFF + j0 + 4); }
        else { ag0 = ag1 = av0 = av1 = bg0_ = bg1_ = bv0_ = bv1_ = (f4){0.f, 0.f, 0.f, 0.f}; }
        h16* ar = P.act + (size_t)row0 * DFF + j0;
        for (int r0 = 0; r0 < rseg; r0 += 4) { h8 ra[4], rc[4]; float rsm[4], rsq[4];
#pragma unroll
            for (int k = 0; k < 4; ++k) { const int row = row0 + r0 + k; const h16* u_ = P.up + (size_t)row * DFF2 + j0; ra[k] = *(const h8*)u_; rc[k] = *(const h8*)(u_ + DFF); rsm[k] = P.st[2 * row]; rsq[k] = P.st[2 * row + 1]; }
#pragma unroll
            for (int k = 0; k < 4; ++k) { const int r = r0 + k; const float mean = rsm[k] * (1.f / DM), rstd = __builtin_amdgcn_rsqf(rsq[k] * (1.f / DM) - mean * mean + 1e-5f);
                const f4 cg0 = ((f4){(float)ra[k][0], (float)ra[k][1], (float)ra[k][2], (float)ra[k][3]} - cg0_ * mean) * rstd + dg0_, cg1 = ((f4){(float)ra[k][4], (float)ra[k][5], (float)ra[k][6], (float)ra[k][7]} - cg1_ * mean) * rstd + dg1_;
                const f4 cv0 = ((f4){(float)rc[k][0], (float)rc[k][1], (float)rc[k][2], (float)rc[k][3]} - cv0_ * mean) * rstd + dv0_, cv1 = ((f4){(float)rc[k][4], (float)rc[k][5], (float)rc[k][6], (float)rc[k][7]} - cv1_ * mean) * rstd + dv1_;
                const f4 g0 = bg0 + ag0 * wg0[0] + bg0_ * wg0[1] + cg0 * wg0[2], g1 = bg1 + ag1 * wg1[0] + bg1_ * wg1[1] + cg1 * wg1[2];
                const f4 v0 = bv0 + av0 * wv0[0] + bv0_ * wv0[1] + cv0 * wv0[2], v1 = bv1 + av1 * wv1[0] + bv1_ * wv1[1] + cv1 * wv1[2];
                h8 o;
#pragma unroll
                for (int e = 0; e < 4; ++e) { o[e] = (h16)(gelu_f(g0[e]) * v0[e]); o[4 + e] = (h16)(gelu_f(g1[e]) * v1[e]); }
                __builtin_nontemporal_store(o, (h8*)(ar + (size_t)r * DFF));
                const int t = t0 + r;
                if (t >= T - 2) { float* so = P.pfc + (samp ? P.sdelta + ((size_t)bb * 2 + (t - (T - 2))) * DFF2 : ((size_t)(row0 >> 11) * 2 + (t - (T - 2))) * DFF2) + j0;
                    *(f4*)so = cg0; *(f4*)(so + 4) = cg1; *(f4*)(so + DFF) = cv0; *(f4*)(so + DFF + 4) = cv1; }
                ag0 = bg0_; ag1 = bg1_; av0 = bv0_; av1 = bv1_; bg0_ = cg0; bg1_ = cg1; bv0_ = cv0; bv1_ = cv1; } } }
#undef CG_LOADROW
}

#define XB_TMO      128
#define XB_XCNT(j)  (256  + 64 * (j))
#define XB_XSUB(j)  (1280 + 64 * (j))
#define XB_XGEN(j)  (2304 + 64 * (j))
#define XB_TOP      3328
#define XB_TOPGEN   3392
#define XCD_BAR_WORDS 3456
#define XB_SPIN_CAP (1u << 18)
DEVI unsigned xb_ld(unsigned* p)              { return __hip_atomic_load(p, __ATOMIC_RELAXED, __HIP_MEMORY_SCOPE_AGENT); }
DEVI unsigned xb_add(unsigned* p, unsigned v) { return __hip_atomic_fetch_add(p, v, __ATOMIC_RELAXED, __HIP_MEMORY_SCOPE_AGENT); }
DEVI unsigned xb_xcc_id() { return (unsigned)__builtin_amdgcn_s_getreg((3 << 11) | 20) & 0xFu; }
#define XB_SPIN(cond, bar) do { unsigned _sp = 0; while (cond) { __builtin_amdgcn_s_sleep(1); \
    if ((++_sp & 255u) == 0u) { if (xb_ld(&(bar)[XB_TMO])) break; if (_sp > XB_SPIN_CAP) { atomicAdd(&(bar)[XB_TMO], 1u); break; } } } } while (0)
DEVI void xb_complete(unsigned* bar, unsigned x, unsigned& nloc, unsigned& nx, unsigned G) {
    unsigned sum, cnt, mine, sp = 0u;
    for (;;) {
        sum = 0u; cnt = 0u; mine = 0u;
#pragma unroll
        for (unsigned j = 0; j < 16; ++j) { const unsigned c = xb_ld(&bar[XB_XCNT(j)]); sum += c; cnt += (c > 0u) ? 1u : 0u; mine = (j == x) ? c : mine; }
        if (sum == G) break;
        __builtin_amdgcn_s_sleep(1);
        if ((++sp & 255u) == 0u) { if (xb_ld(&bar[XB_TMO])) break; if (sp > XB_SPIN_CAP) { atomicAdd(&bar[XB_TMO], 1u); break; } }
    }
    nloc = mine > 0u ? mine : 1u; nx = cnt > 0u ? cnt : 1u;
}
DEVI void xbar(unsigned* bar, volatile LAS unsigned* st, int tid, unsigned G) {
    asm volatile("s_waitcnt vmcnt(0)" ::: "memory");
    __syncthreads();
    if (tid == 0) {
        const unsigned x = xb_xcc_id();
        __builtin_amdgcn_s_waitcnt(0);
        unsigned nloc = st[0], nx = st[1];
        if (nloc == 0u) { xb_complete(bar, x, nloc, nx, G); st[0] = nloc; st[1] = nx; }
        const unsigned old = xb_add(&bar[XB_XSUB(x)], 1u);
        const unsigned gen = old / nloc;
        if (old + 1u == (gen + 1u) * nloc) {
            __builtin_amdgcn_fence(__ATOMIC_RELEASE, "agent");
            asm volatile("s_waitcnt vmcnt(0)" ::: "memory");
            const unsigned og = xb_add(&bar[XB_TOP], 1u);
            const unsigned tg = og / nx;
            if (og + 1u == (tg + 1u) * nx) xb_add(&bar[XB_TOPGEN], 1u);
            else XB_SPIN(xb_ld(&bar[XB_TOPGEN]) == tg, bar);
            __builtin_amdgcn_fence(__ATOMIC_ACQUIRE, "agent");
            xb_add(&bar[XB_XGEN(x)], 1u);
            asm volatile("s_waitcnt vmcnt(0)" ::: "memory");
        } else {
            XB_SPIN(xb_ld(&bar[XB_XGEN(x)]) == gen, bar);
            __builtin_amdgcn_fence(__ATOMIC_ACQUIRE, "agent");
            asm volatile("s_waitcnt vmcnt(0)" ::: "memory");
        }
    }
    __syncthreads();
}
#ifndef PHM
#define PHM 0xFFFFFFFFu
#endif
#ifndef DBL
#define DBL 0u
#endif
#define NREP(k) (((DBL >> (k)) & 1u) ? 2 : 1)
__global__ void __launch_bounds__(512, 2) trunk_fwd(Params p) {
    extern __shared__ __attribute__((aligned(16))) unsigned char shm_raw[];
    LAS unsigned char* lds = (LAS unsigned char*)shm_raw;
    __shared__ uint4 s_ctl;
#define s_item (*(LAS int*)&s_ctl)
    cg::grid_group grid = cg::this_grid();
    const int wave_s = __builtin_amdgcn_readfirstlane((int)threadIdx.x >> 6);
    if (threadIdx.x == 0) { s_ctl = make_uint4(0u, 0u, 0u, 0u); (void)xb_add((unsigned*)(p.ws + W_BAR) + XB_XCNT(xb_xcc_id()), 1u); }
    __syncthreads();
#define GSYNC() do { const __attribute__((address_space(4))) Params* kq = (const __attribute__((address_space(4))) Params*)__builtin_amdgcn_kernarg_segment_ptr(); asm volatile("" : "+s"(kq)); \
        unsigned Gq = gridDim.x; asm volatile("" : "+s"(Gq)); xbar((unsigned*)(kq->ws + W_BAR), (volatile LAS unsigned*)&s_ctl + 1, wave_s * 64 + opaque_lane(), Gq); } while (0)
#define PH_BEGIN \
    int tid = wave_s * 64 + opaque_lane(); asm volatile("" : "+v"(tid)); \
    int bid = blockIdx.x, G = gridDim.x, lq = l; asm volatile("" : "+s"(bid), "+s"(G), "+s"(lq)); \
    const int lane = tid & 63, wave = __builtin_amdgcn_readfirstlane(tid >> 6); \
    const int gw = bid * 8 + wave, NGW = G * 8; const size_t gtid = (size_t)bid * 512 + tid, NGT = (size_t)G * 512; \
    const __attribute__((address_space(4))) Params* kp = (const __attribute__((address_space(4))) Params*)__builtin_amdgcn_kernarg_segment_ptr(); asm volatile("" : "+s"(kp)); \
    unsigned char* ws = kp->ws; float* out = kp->out; \
    (void)lane; (void)wave; (void)gw; (void)NGW; (void)gtid; (void)NGT; (void)out; (void)lq;
#define WSP(T, off) ((T*)(ws + (off)))
    for (int rep = 0; rep < NREP(0); ++rep) if (PHM & 1u) {
        int tid = wave_s * 64 + opaque_lane(); asm volatile("" : "+v"(tid));
        const int bid = blockIdx.x, G = gridDim.x, lane = tid & 63, wave = __builtin_amdgcn_readfirstlane(tid >> 6);
        const int gw = bid * 8 + wave, NGW = G * 8; const size_t gtid = (size_t)bid * 512 + tid, NGT = (size_t)G * 512;
        unsigned char* ws = p.ws;
        h16* xh = WSP(h16, W_XH); float* ropec = WSP(float, W_ROPE); float* ropes = ropec + NPOS * 16;
        for (size_t i = gtid; i < (size_t)MT * DM / 8; i += NGT) { const size_t e = i * 8; const float* src = e < (size_t)MP * DM ? p.in[0] + e : p.in[1] + (e - (size_t)MP * DM);
            *(h8*)(xh + e) = pack8(*(const f4*)src, *(const f4*)(src + 4)); }
        for (size_t i = gtid; i < (size_t)NPOS * 16; i += NGT) { const int pi = (int)(i >> 4), fi = (int)(i & 15); const double pos = pi < SEQ ? (double)pi : (double)(PAST + pi - SEQ);
            const double ang = pos * exp(-(double)fi / 16.0 * 9.210340371976184); ropec[i] = (float)cos(ang); ropes[i] = (float)sin(ang); }
        for (size_t i = gtid; i < (size_t)DEPTH * 256; i += NGT) WSP(float, W_SP)[i] = log1pf(expf(-p.in[26][i]));
        LAS float* scr = (LAS float*)(lds + wave * 8448);
        for (int l = 0; l < DEPTH; ++l) {
            h16* wt_in = WSP(h16, W_WIN + l * SZ_WIN); h16* wt_uq = WSP(h16, W_WUQ + l * SZ_WUQ); h16* wt_kv = WSP(h16, W_WKV + l * SZ_WKV);
            h16* wt_o = WSP(h16, W_WO + l * SZ_WO); h16* wt_os = WSP(h16, W_WOS + l * SZ_WOS); h16* wt_up = WSP(h16, W_WUP + l * SZ_WUP); h16* wt_dn = WSP(h16, W_WDN + l * SZ_WDN);
            h16* wt_ql = WSP(h16, W_WQL + l * SZ_WQL); h16* wt_g = WSP(h16, W_WG + l * SZ_WG);
            const float* w_in = p.in[11] + (size_t)l * DM * DIN; const float* w_o = p.in[12] + (size_t)l * DM * DM; const float* w_uq = p.in[16] + (size_t)l * 384 * 768;
            const float* w_uk = p.in[18] + (size_t)l * 256 * 512; const float* w_uv = p.in[19] + (size_t)l * 256 * 512; const float* w_up = p.in[27] + (size_t)l * DM * DFF2; const float* w_dn = p.in[30] + (size_t)l * DFF * DM;
            const float* w_r = p.in[22] + (size_t)l * 4 * 64 * 64; const float* w_i = p.in[24] + (size_t)l * 4 * 64 * 64;
            for (int it = gw; it < 16 * 53; it += NGW) transpose_item<0>(w_in, DIN, 53, wt_in, 1024, scr, it, lane, l > 0 ? p.in[9] + (l - 1) * DM : nullptr, l > 0 ? p.in[10] + (l - 1) * DM : nullptr, rep ? nullptr : WSP(float, W_CD + l * SZ_CD), WSP(float, W_CD + l * SZ_CD) + ZW);
            for (int it = gw; it < 6 * 24; it += NGW) transpose_item<1>(w_uq, 768, 24, wt_uq, 384, scr, it, lane);
            for (int it = gw; it < 4 * 16; it += NGW) transpose_item<0>(w_uk, 512, 16, wt_kv, 256, scr, it, lane);
            for (int it = gw; it < 4 * 16; it += NGW) transpose_item<0>(w_uv, 512, 16, wt_kv + 512 * 256, 256, scr, it, lane);
            for (int it = gw; it < 16 * 32; it += NGW) transpose_item<0>(w_o, 1024, 32, wt_o, 1024, scr, it, lane);
            for (int it = gw; it < 16 * 176; it += NGW) transpose_item<0>(w_up, DFF2, 176, wt_up, 1024, scr, it, lane, p.in[7] + l * DM, p.in[8] + l * DM, rep ? nullptr : WSP(float, W_CD + l * SZ_CD) + 2 * ZW, WSP(float, W_CD + l * SZ_CD) + 2 * ZW + DFF2);
            for (int it = gw; it < 44 * 32; it += NGW) transpose_item<0>(w_dn, 1024, 32, wt_dn, DFF, scr, it, lane);
            for (size_t i = gtid; i < (size_t)(ZW - DIN) * 1024 / 8; i += NGT) *(h8*)(wt_in + (size_t)DIN * 1024 + i * 8) = (h8){0, 0, 0, 0, 0, 0, 0, 0};
            for (size_t i = gtid; i < (size_t)512 * 256; i += NGT) { const int n = (int)(i >> 8), k = (int)(i & 255); const int pn = n >> 8, jj = n & 127, isI = (n >> 7) & 1, ch = pn * 128 + jj;
                float v = 0.f; if ((k >> 6) == (ch >> 6)) v = (isI ? w_i : w_r)[((ch >> 6) * 64 + (k & 63)) * 64 + (ch & 63)];
                wt_g[i] = (h16)v; }
            for (int it = gw; it < 8 * 24 * 16; it += NGW) { const int hh = it / (24 * 16), kt = (it / 16) % 24, ct = it % 16, fr = lane & 15, g4 = lane >> 4;
                f4 accq = (f4){0.f, 0.f, 0.f, 0.f};
#pragma unroll
                for (int ks = 0; ks < 2; ++ks) { const float* ap = w_uq + (size_t)(16 * kt + fr) * 768 + hh * 96 + 32 * ks + 8 * g4; const float* bp = w_uk + (size_t)(16 * ct + fr) * 512 + hh * 64 + 32 * ks + 8 * g4;
                    accq = __builtin_amdgcn_mfma_f32_16x16x32_f16(pack8(*(const f4*)ap, *(const f4*)(ap + 4)), pack8(*(const f4*)bp, *(const f4*)(bp + 4)), accq, 0, 0, 0); }
                *(h4*)(wt_ql + (size_t)(hh * 256 + 16 * ct + fr) * 384 + 16 * kt + 4 * g4) = pack4(accq); }
            for (size_t i = gtid; i < (size_t)8 * 64 * 256; i += NGT) { const int c = (int)(i & 255), hd = (int)(i >> 8); wt_os[i] = (h16)w_uv[(size_t)c * 512 + hd]; }
        }
    }
    grid.sync();

    for (int l = 0; l < DEPTH; ++l) {
        for (int rep = 0; rep < NREP(1); ++rep) if (PHM & (1u << 1)) { PH_BEGIN
          Gemm g{WSP(h16, W_XH), WSP(h16, W_WIN + lq * SZ_WIN), MT, ZW, 1024, 1024, 1024}; StaticOrder S; S.init(MT, ZW, G, bid); const int lp = lq > 0 ? lq - 1 : 0; EpiZ E{WSP(h16, W_Z), out + O_SV + (size_t)lq * MS * 256, WSP(float, W_STATS + (size_t)(lp * 2 + 1) * SZ_STATS), WSP(float, W_CD + lq * SZ_CD), WSP(float, W_CD + lq * SZ_CD) + ZW, lq > 0}; gemm_phase(lds, g, S, E, tid); }
        GSYNC();

        for (int rep = 0; rep < NREP(2); ++rep) if (PHM & (1u << 2)) { PH_BEGIN
            const float* qn_g = kp->in[15] + lq * 384; const float* kvn_g = kp->in[17] + lq * 256;
            const float* cw = kp->in[20] + (size_t)lq * 4 * 256; const float* cb = kp->in[21] + lq * 256; const float* stc = kp->in[5] + (size_t)lq * DBATCH * 3 * 256;
            const h16* __restrict__ z = WSP(h16, W_Z); h16* __restrict__ cqn = WSP(h16, W_CQN); h16* __restrict__ ckvn = WSP(h16, W_CKVN); h16* __restrict__ knew = WSP(h16, W_KNEW); h16* __restrict__ kb = WSP(h16, W_K); h16* __restrict__ xc = WSP(h16, W_XC);
            const float* __restrict__ ropec = WSP(float, W_ROPE); const float* __restrict__ ropes = ropec + NPOS * 16;
            for (int row = gw; row < MT; row += NGW) {
                const h16* zr = z + (size_t)row * ZW; const bool samp = row >= MP; const int rs = row - MP;
                const int t = samp ? (rs & 31) : (row & (SEQ - 1)), bb = samp ? (rs >> 5) : (row >> 11), T = samp ? DSEQ : SEQ;
                h2 xq[3];
#pragma unroll
                for (int i = 0; i < 3; ++i) xq[i] = *(const h2*)(zr + 512 + 2 * lane + 128 * i);
                const h4 xkv = *(const h4*)(zr + 896 + 4 * lane);
                const int pidx = samp ? SEQ + t : t, l16 = lane & 15;
                const float rc = ropec[pidx * 16 + l16], rsn = ropes[pidx * 16 + l16], kx1 = (float)zr[1152 + l16], kx2 = (float)zr[1168 + l16];
                const int c = 4 * lane; f4 xl[4];
#pragma unroll
                for (int j = 0; j < 4; ++j) { const int tau = t - 3 + j;
                    if (tau >= 0) { const h4 x = *(const h4*)(zr - (ptrdiff_t)(3 - j) * ZW + 1184 + c); xl[j] = (f4){(float)x[0], (float)x[1], (float)x[2], (float)x[3]}; }
                    else if (samp) xl[j] = *(const f4*)(stc + ((size_t)bb * 3 + (3 + tau)) * 256 + c);
                    else xl[j] = (f4){0.f, 0.f, 0.f, 0.f}; }
                float vq[6], ssq = 0.f, sskv = 0.f; f4 vkv;
#pragma unroll
                for (int i = 0; i < 3; ++i) { vq[2 * i] = (float)xq[i][0]; vq[2 * i + 1] = (float)xq[i][1]; ssq += vq[2 * i] * vq[2 * i] + vq[2 * i + 1] * vq[2 * i + 1]; }
#pragma unroll
                for (int e = 0; e < 4; ++e) { vkv[e] = (float)xkv[e]; sskv += vkv[e] * vkv[e]; }
#pragma unroll
                for (int o = 1; o < 64; o <<= 1) { ssq += shx(ssq, o, lane); sskv += shx(sskv, o, lane); }
                { const float rr = rsqrtf(ssq * (1.f / 384.f) + 1e-6f);
#pragma unroll
                  for (int i = 0; i < 3; ++i) { const int cc = 2 * lane + 128 * i; h2 o; o[0] = (h16)(vq[2 * i] * rr * qn_g[cc]); o[1] = (h16)(vq[2 * i + 1] * rr * qn_g[cc + 1]); *(h2*)(cqn + (size_t)row * 384 + cc) = o; } }
                { const float rr = rsqrtf(sskv * (1.f / 256.f) + 1e-6f); const f4 v = vkv * rr * *(const f4*)(kvn_g + 4 * lane);
                  if (!samp) { *(f4*)(out + O_PLAT + ((size_t)lq * MP + row) * 256 + 4 * lane) = v; *(h4*)(ckvn + (size_t)row * 256 + 4 * lane) = pack4(v); }
                  else { *(f4*)(out + O_SLAT + ((size_t)lq * MS + rs) * 256 + 4 * lane) = v; *(h4*)(knew + (size_t)rs * KNW + 4 * lane) = pack4(v); } }
                if (lane < 16) { const float o1 = kx1 * rc - kx2 * rsn, o2 = kx1 * rsn + kx2 * rc;
                    if (!samp) { float* o = out + O_PKR + ((size_t)lq * MP + row) * 32; o[lane] = o1; o[16 + lane] = o2;
                        h16* kr = kb + (size_t)row * KW + 64;
#pragma unroll
                        for (int hh = 0; hh < 8; ++hh) { kr[hh * 96 + lane] = (h16)o1; kr[hh * 96 + 16 + lane] = (h16)o2; } }
                    else { float* o = out + O_SKR + ((size_t)lq * MS + rs) * 32; o[lane] = o1; o[16 + lane] = o2; knew[(size_t)rs * KNW + 256 + lane] = (h16)o1; knew[(size_t)rs * KNW + 272 + lane] = (h16)o2; } }
                { f4 accv = *(const f4*)(cb + c);
#pragma unroll
                  for (int j = 0; j < 4; ++j) accv += xl[j] * *(const f4*)(cw + j * 256 + c);
                  if (t >= T - 3) { float* o = samp ? out + O_SLC + (((size_t)lq * DBATCH + bb) * 3 + (t - (T - 3))) * 256 : out + O_PLC + (((size_t)lq * NB + bb) * 3 + (t - (T - 3))) * 256; *(f4*)(o + c) = xl[3]; }
                  *(h4*)(xc + (size_t)row * 256 + c) = pack4(accv); }
            }
        }
        GSYNC();

        for (int rep = 0; rep < NREP(3); ++rep) if (PHM & (1u << 3)) { PH_BEGIN
          Gemm g{WSP(h16, W_CQN), WSP(h16, W_WUQ + lq * SZ_WUQ), MT, 768, 384, 384, 384}; StaticOrder S; S.init(MT, 768, G, bid);
          EpiQ E{WSP(h16, W_Q), WSP(h16, W_QLAT), WSP(float, W_ROPE), WSP(float, W_ROPE) + NPOS * 16}; gemm_phase(lds, g, S, E, tid); }
        for (int rep = 0; rep < NREP(4); ++rep) if (PHM & (1u << 4)) { PH_BEGIN
          Gemm g{WSP(h16, W_CKVN), WSP(h16, W_WKV + lq * SZ_WKV), MP, 1024, 256, 256, 256}; StaticOrder S; S.init(MP, 1024, G, (bid + G - (396 % G)) % G); EpiKV E{WSP(h16, W_K), WSP(h16, W_V)}; gemm_phase(lds, g, S, E, tid); }
        for (int rep = 0; rep < NREP(5); ++rep) if (PHM & (1u << 5)) { PH_BEGIN
          Gemm g{WSP(h16, W_XC), WSP(h16, W_WG + lq * SZ_WG), MT, 512, 256, 256, 256}; StaticOrder S; S.init(MT, 512, G, (bid + G - (908 % G)) % G);
          EpiGate E{WSP(h16, W_XC), WSP(float, W_A), WSP(float, W_B), kp->in[23] + lq * 256, kp->in[25] + lq * 256, WSP(float, W_SP) + lq * 256}; gemm_phase(lds, g, S, E, tid); }
        for (int rep = 0; rep < NREP(6); ++rep) if (PHM & (1u << 6)) { PH_BEGIN
          Gemm g{WSP(h16, W_CQN) + (size_t)MP * 384, WSP(h16, W_WQL + lq * SZ_WQL), MS, 2048, 384, 384, 384}; StaticOrder S; S.init(MS, 2048, G, (bid + G - (1172 % G)) % G); EpiQlat E{WSP(h16, W_QLAT)}; gemm_phase(lds, g, S, E, tid); }
        for (int rep = 0; rep < NREP(7); ++rep) if (PHM & (1u << 7)) { PH_BEGIN
            const float* gw_s = kp->in[13] + (size_t)lq * 4 * 128 * 128; const float* gb_s = kp->in[14] + (size_t)lq * 4 * 128;
            const h16* z = WSP(h16, W_Z); h16* cat = WSP(h16, W_CAT); h16* cats = WSP(h16, W_CATS);
            const int fr = lane & 15, g4 = lane >> 4, q_ = fr >> 2, p_ = fr & 3;
            for (int item = (bid + G - (1204 % G)) % G; item < 1024 + 128; item += G) {
                const bool samp = item >= 1024; const int head = item & 3; const int ci = samp ? (item - 1024) >> 2 : item >> 2;
                const int R0 = samp ? MP + ci * 32 : ci * 128, L = samp ? 32 : 128;
                __syncthreads();
                for (int id = tid; id < L * 8; id += 512) { const int j = id >> 3, part = id & 7; *(LAS h8*)(lds + j * 144 + part * 16) = *(const h8*)(z + (size_t)(R0 + j) * ZW + 256 + head * 64 + part * 8); }
                __syncthreads();
                const int i0 = 16 * wave;
                if (i0 < L) {
                    f4 sacc[4];
#pragma unroll
                    for (int ct = 0; ct < 4; ++ct) sacc[ct] = (f4){0.f, 0.f, 0.f, 0.f};
                    const int i = i0 + fr;
#pragma unroll
                    for (int ks = 0; ks < 4; ++ks) if (32 * ks <= i0 + 15 && 32 * ks < L) {
                        const int j0 = 32 * ks + 8 * g4; const float* wp = gw_s + ((size_t)head * 128 + i) * 128 + j0; const f4 w0 = *(const f4*)wp, w1 = *(const f4*)(wp + 4);
                        h8 wf;
#pragma unroll
                        for (int e = 0; e < 4; ++e) { wf[e] = (h16)((j0 + e <= i) ? w0[e] : 0.f); wf[4 + e] = (h16)((j0 + 4 + e <= i) ? w1[e] : 0.f); }
#pragma unroll
                        for (int ct = 0; ct < 4; ++ct) { const h4 lo = trrd(lds + (32 * ks + 8 * g4 + q_) * 144 + (16 * ct + 4 * p_) * 2), hi = trrd(lds + (32 * ks + 8 * g4 + 4 + q_) * 144 + (16 * ct + 4 * p_) * 2);
                            sacc[ct] = __builtin_amdgcn_mfma_f32_16x16x32_f16(wf, cat44(lo, hi), sacc[ct], 0, 0, 0); } }
                    float uval[4][4], bsv[4];
#pragma unroll
                    for (int jx = 0; jx < 4; ++jx) { const int ii = i0 + 4 * g4 + jx; bsv[jx] = gb_s[head * 128 + ii];
#pragma unroll
                        for (int ct = 0; ct < 4; ++ct) uval[jx][ct] = (float)z[((size_t)R0 + ii) * ZW + head * 64 + 16 * ct + fr]; }
#pragma unroll
                    for (int jx = 0; jx < 4; ++jx) { const size_t r = (size_t)R0 + i0 + 4 * g4 + jx;
#pragma unroll
                        for (int ct = 0; ct < 4; ++ct) cat[r * 1024 + head * 64 + 16 * ct + fr] = (h16)(uval[jx][ct] * (sacc[ct][jx] + bsv[jx])); }
                }
            }
            __syncthreads();
        }
        GSYNC();

        for (int rep = 0; rep < NREP(8); ++rep) if (PHM & (1u << 8)) { PH_BEGIN
            unsigned* counter = WSP(unsigned, W_CTR) + lq * 16 + rep * 8;
            constexpr int N_SA = 256, N_PA = 1024, N_PS = 128, N_SS = 16, N_WO = 16, N_UP = 88, N_ALL = N_SA + N_PA + N_PS + N_SS + N_WO + N_UP, Q_WO = N_PS + N_SS + N_SA + 256, Q_UP = Q_WO + N_WO + 256;
            unsigned* wdone = WSP(unsigned, W_CTR) + 800 + lq * 8 + rep * 4;
            unsigned* sdone = WSP(unsigned, W_CTR) + 768 + lq * 2 + rep;
            for (;;) {
                __syncthreads();
                if (tid == 0) s_item = (int)atomicAdd(counter, 1u);
                __syncthreads();
                const int qi = s_item;
                if (qi >= N_ALL) break;
                int tix = tid; asm volatile("" : "+v"(tix));
                const int ln = tix & 63, fr = ln & 15, g4 = ln >> 4;
                const int qj = qi < Q_WO ? qi : (qi < Q_WO + N_WO ? -1 : (qi < Q_UP ? qi - N_WO : (qi < Q_UP + N_UP ? -2 : qi - N_WO - N_UP)));
                const int item = qj < 0 ? qj : (qj < N_PS + N_SS ? qj + N_SA + N_PA : qj - (N_PS + N_SS));
                if (item == -2) {
                    const int ui = qi - Q_UP, pnl = ui / 22, pnc = ui - pnl * 22;
                    if (tix == 0) { unsigned sp = 0; while (xb_ld(wdone + pnl) < 4u) { __builtin_amdgcn_s_sleep(4); if (++sp > (1u << 22)) break; }
                        __builtin_amdgcn_fence(__ATOMIC_ACQUIRE, "agent"); asm volatile("s_waitcnt vmcnt(0)" ::: "memory"); }
                    __syncthreads();
                    const int ro = (MP / BM + pnl) * BM;
                    Gemm g{WSP(h16, W_XH) + (size_t)ro * DM, WSP(h16, W_WUP + lq * SZ_WUP), BM, DFF2, 1024, 1024, 1024}; StaticOrder S; S.init(BM, DFF2, 22, pnc);
                    EpiUp E{WSP(h16, W_UP), ro};
                    gemm_phase(lds, g, S, E, tix);
                } else if (item < 0) {
                    if (tix == 0) { unsigned sp = 0; while (xb_ld(sdone) < 80u) { __builtin_amdgcn_s_sleep(4); if (++sp > (1u << 22)) break; }
                        __builtin_amdgcn_fence(__ATOMIC_ACQUIRE, "agent"); asm volatile("s_waitcnt vmcnt(0)" ::: "memory"); }
                    __syncthreads();
                    const int wi = qi - Q_WO, lp = lq > 0 ? lq - 1 : 0; const size_t ro = (size_t)(MP / BM + (wi >> 2)) * BM;
                    Gemm g{WSP(h16, W_CAT) + ro * 1024, WSP(h16, W_WO + lq * SZ_WO), BM, 1024, 1024, 1024, 1024}; StaticOrder S; S.init(BM, 1024, 4, wi & 3);
                    EpiRes E{WSP(h16, W_XH) + ro * DM, WSP(float, W_STATS + (size_t)(lp * 2 + 1) * SZ_STATS) + 2 * ro, kp->in[9] + lp * DM, kp->in[10] + lp * DM, lq > 0, WSP(float, W_STATS + (size_t)(lq * 2) * SZ_STATS) + 2 * ro};
                    gemm_phase(lds, g, S, E, tix);
                    __syncthreads();
                    if (tix == 0) { __builtin_amdgcn_fence(__ATOMIC_RELEASE, "agent"); asm volatile("s_waitcnt vmcnt(0)" ::: "memory"); (void)xb_add(wdone + (wi >> 2), 1u); }
                } else if (item < N_SA) {
                    constexpr int KS = 592;
                    const float* clat = kp->in[2] + (size_t)lq * DBATCH * PAST * 256; const float* ckr = kp->in[3] + (size_t)lq * DBATCH * PAST * 32;
                    const h16* qlat = WSP(h16, W_QLAT); const h16* knew = WSP(h16, W_KNEW); h16* cats = WSP(h16, W_CATS);
                    const int b = item >> 3, hg = (item >> 2) & 1, sp = item & 3, head = 4 * hg + (wave >> 1), tq = 16 * (wave & 1) + fr, t0 = sp * 16;
                    h8 qf[1][9];
#pragma unroll
                    for (int ks = 0; ks < 9; ++ks) qf[0][ks] = *(const h8*)(qlat + (size_t)(b * 32 + tq) * QLW + head * 288 + 32 * ks + 8 * g4);
                    f4 o[1][16]; float mrow[1] = {-1e30f}, lrow[1] = {0.f};
#pragma unroll
                    for (int ct = 0; ct < 16; ++ct) o[0][ct] = (f4){0.f, 0.f, 0.f, 0.f};
                    const float* lb = clat + (size_t)b * PAST * 256 + (size_t)(t0 * 64 + (tix >> 6)) * 256 + (tix & 63) * 4; const float* rb = ckr + (size_t)b * PAST * 32 + (size_t)(t0 * 64 + (tix >> 3)) * 32 + (tix & 7) * 4;
                    const int wl = (tix >> 6) * KS + (tix & 63) * 8, wr_ = (tix >> 3) * KS + 512 + (tix & 7) * 8;
                    f4 pl[4]; f4 pr;
#pragma unroll
                    for (int hf = 0; hf < 2; ++hf) {
#pragma unroll
                        for (int i = 0; i < 4; ++i) pl[i] = *(const f4*)(lb + (size_t)(hf * 4 + i) * 8 * 256);
#pragma unroll
                        for (int i = 0; i < 4; ++i) *(LAS h4*)(lds + wl + (hf * 4 + i) * 8 * KS) = pack4(pl[i]); }
                    pr = *(const f4*)rb;
                    *(LAS h4*)(lds + wr_) = pack4(pr);
                    __syncthreads();
                    for (int t = 0; t < 16; ++t) {
                        LAS unsigned char* cur = lds + (t & 1) * (64 * KS); LAS unsigned char* nxt = lds + ((t + 1) & 1) * (64 * KS);
                        const bool more = t + 1 < 16;
                        if (more) {
#pragma unroll
                            for (int i = 0; i < 4; ++i) pl[i] = *(const f4*)(lb + ((size_t)(t + 1) * 64 + i * 8) * 256);
                            pr = *(const f4*)(rb + (size_t)(t + 1) * 64 * 32);
                        }
                        h8 pf[1][2];
                        attn_qk<9, 16, 1, KS>(cur, qf, o, mrow, lrow, pf, 4, ln);
                        if (more) {
#pragma unroll
                            for (int i = 0; i < 4; ++i) *(LAS h4*)(nxt + wl + i * 8 * KS) = pack4(pl[i]);
                            *(LAS h4*)(nxt + wr_) = pack4(pr);
#pragma unroll
                            for (int i = 0; i < 4; ++i) pl[i] = *(const f4*)(lb + ((size_t)(t + 1) * 64 + (4 + i) * 8) * 256);
                        }
                        attn_pv<16, 1, KS>(cur, o, pf, 4, ln);
                        if (more) {
#pragma unroll
                            for (int i = 0; i < 4; ++i) *(LAS h4*)(nxt + wl + (4 + i) * 8 * KS) = pack4(pl[i]);
                        } else if (sp == 3) {
                            for (int id = tix; id < 32 * 36; id += 512) { const int key = id / 36, part = id % 36; *(LAS h8*)(nxt + key * KS + part * 16) = *(const h8*)(knew + (size_t)(b * 32 + key) * KNW + part * 8); }
                        }
                        __syncthreads();
                    }
                    if (sp == 3) attn_tile<9, 16, 1, KS, KS>(lds, lds, qf, o, mrow, lrow, 2, ln);
                    { unsigned char* pw = ws + W_PART + ((size_t)item * 8 + wave) * SZ_PARTW;
#pragma unroll
                      for (int ct = 0; ct < 16; ++ct) *(f4*)(pw + ct * 1024 + ln * 16) = o[0][ct];
                      *(float*)(pw + 16384 + ln * 4) = mrow[0]; *(float*)(pw + 16640 + ln * 4) = lrow[0]; }
                    asm volatile("s_waitcnt vmcnt(0)" ::: "memory");
                    __syncthreads();
                    if (tix == 0) { __builtin_amdgcn_fence(__ATOMIC_RELEASE, "agent"); asm volatile("s_waitcnt vmcnt(0)" ::: "memory");
                        const unsigned old = xb_add(WSP(unsigned, W_CTR) + 256 + lq * 64 + rep * 512 + (item >> 2), 1u);
                        if (old == 3u) { __builtin_amdgcn_fence(__ATOMIC_ACQUIRE, "agent"); asm volatile("s_waitcnt vmcnt(0)" ::: "memory"); }
                        *((LAS int*)&s_ctl + 3) = (int)old; }
                    __syncthreads();
                    if (*((LAS int*)&s_ctl + 3) == 3) {
                        const unsigned char* p0 = ws + W_PART + ((size_t)(item & ~3) * 8 + wave) * SZ_PARTW;
                        float mi[4], M = -1e30f;
#pragma unroll
                        for (int i = 0; i < 4; ++i) { mi[i] = *(const float*)(p0 + (size_t)i * 8 * SZ_PARTW + 16384 + ln * 4); M = fmaxf(M, mi[i]); }
                        float L = 0.f;
#pragma unroll
                        for (int i = 0; i < 4; ++i) { mi[i] = __builtin_amdgcn_exp2f(mi[i] - M); L += mi[i] * *(const float*)(p0 + (size_t)i * 8 * SZ_PARTW + 16640 + ln * 4); }
                        L += shx(L, 16, ln); L += shx(L, 32, ln); const float inv = 1.f / L;
                        h8 bf[8];
#pragma unroll
                        for (int ks = 0; ks < 8; ++ks) { f4 u0 = (f4){0.f, 0.f, 0.f, 0.f}, u1 = u0;
#pragma unroll
                            for (int i = 0; i < 4; ++i) { u0 += *(const f4*)(p0 + (size_t)i * 8 * SZ_PARTW + (2 * ks) * 1024 + ln * 16) * mi[i]; u1 += *(const f4*)(p0 + (size_t)i * 8 * SZ_PARTW + (2 * ks + 1) * 1024 + ln * 16) * mi[i]; }
                            bf[ks] = pack8(u0 * inv, u1 * inv); }
                        const h16* wuvt = WSP(h16, W_WOS + lq * SZ_WOS) + (size_t)head * 64 * 256;
                        h16* dst = cats + (size_t)(b * 32 + tq) * 1024 + 256 + head * 64 + 4 * g4;
#pragma unroll
                        for (int dt = 0; dt < 4; ++dt) { f4 od = (f4){0.f, 0.f, 0.f, 0.f};
#pragma unroll
                            for (int ks = 0; ks < 8; ++ks) { const h16* wp = wuvt + (size_t)(16 * dt + fr) * 256 + 32 * ks + 4 * g4;
                                od = __builtin_amdgcn_mfma_f32_16x16x32_f16(cat44(*(const h4*)wp, *(const h4*)(wp + 16)), bf[ks], od, 0, 0, 0); }
                            *(h4*)(dst + 16 * dt) = pack4(od); }
                        asm volatile("s_waitcnt vmcnt(0)" ::: "memory"); __syncthreads();
                        if (tix == 0) { __builtin_amdgcn_fence(__ATOMIC_RELEASE, "agent"); asm volatile("s_waitcnt vmcnt(0)" ::: "memory"); (void)xb_add(sdone, 1u); }
                    }
                } else if (item < N_SA + N_PA) {
                    constexpr int KS = 208, VS = 144, KBUF = 64 * KS, VBUF = 64 * VS;
                    const h16* qb = WSP(h16, W_Q); const h16* kb = WSP(h16, W_K); const h16* vb = WSP(h16, W_V); h16* cat = WSP(h16, W_CAT);
                    const int it = item - N_SA, qblk = 7 - (it >> 7), bh = it & 127, b = bh >> 3, head = bh & 7;
                    const int r0 = qblk * 256 + 32 * wave, ntw = (r0 >> 6) + 1, ntb = 4 * (qblk + 1);
                    h8 qf[2][3];
#pragma unroll
                    for (int qs = 0; qs < 2; ++qs)
#pragma unroll
                        for (int ks = 0; ks < 3; ++ks) qf[qs][ks] = *(const h8*)(qb + (size_t)(b * SEQ + r0 + 16 * qs + fr) * QW + head * 96 + 32 * ks + 8 * g4);
                    f4 o[2][4]; float mrow[2] = {-1e30f, -1e30f}, lrow[2] = {0.f, 0.f};
#pragma unroll
                    for (int qs = 0; qs < 2; ++qs)
#pragma unroll
                        for (int ct = 0; ct < 4; ++ct) o[qs][ct] = (f4){0.f, 0.f, 0.f, 0.f};
                    const int k0key = tix / 12, k0part = tix % 12, k1key = (tix + 512) / 12, k1part = (tix + 512) % 12, vkey = tix >> 3, vpart = tix & 7;
                    const h16* kg0 = kb + (size_t)b * SEQ * KW + head * 96 + (size_t)k0key * KW + k0part * 8; const h16* kg1 = kb + (size_t)b * SEQ * KW + head * 96 + (size_t)k1key * KW + k1part * 8;
                    const h16* vg = vb + (size_t)b * SEQ * VW + head * 64 + (size_t)vkey * VW + vpart * 8;
                    const int lk0 = k0key * KS + k0part * 16, lk1 = k1key * KS + k1part * 16, lv = 2 * KBUF + vkey * VS + vpart * 16;
                    h8 pk0, pk1 = (h8){0, 0, 0, 0, 0, 0, 0, 0}, pv;
                    pk0 = *(const h8*)kg0; if (tix < 256) pk1 = *(const h8*)kg1; pv = *(const h8*)vg;
                    *(LAS h8*)(lds + lk0) = pk0; if (tix < 256) *(LAS h8*)(lds + lk1) = pk1; *(LAS h8*)(lds + lv) = pv;
                    __syncthreads();
                    for (int t = 0; t < ntb; ++t) {
                        const int co = (t & 1), no = ((t + 1) & 1);
                        if (t + 1 < ntb) { const size_t ro = (size_t)(t + 1) * 64;
                            pk0 = *(const h8*)(kg0 + ro * KW); if (tix < 256) pk1 = *(const h8*)(kg1 + ro * KW); pv = *(const h8*)(vg + ro * VW); }
                        if (t < ntw) attn_tile<3, 4, 2, KS, VS>(lds + co * KBUF, lds + 2 * KBUF + co * VBUF, qf, o, mrow, lrow, 4, ln);
                        if (t + 1 < ntb) { *(LAS h8*)(lds + no * KBUF + lk0) = pk0; if (tix < 256) *(LAS h8*)(lds + no * KBUF + lk1) = pk1; *(LAS h8*)(lds + no * VBUF + lv) = pv; }
                        __syncthreads();
                    }
#pragma unroll
                    for (int qs = 0; qs < 2; ++qs) { float lt = lrow[qs]; lt += shx(lt, 16, ln); lt += shx(lt, 32, ln); const float inv = 1.f / lt;
                        h16* dst = cat + (size_t)(b * SEQ + r0 + 16 * qs + fr) * 1024 + 256 + head * 64 + 4 * g4;
#pragma unroll
                        for (int ct = 0; ct < 4; ++ct) *(h4*)(dst + 16 * ct) = pack4(o[qs][ct] * inv); }
                } else if (item < N_SA + N_PA + N_PS) {
                    const float* abuf = WSP(float, W_A); const float* bbuf = WSP(float, W_B); const h16* z = WSP(h16, W_Z); h16* cat = WSP(h16, W_CAT);
                    const int it = item - N_SA - N_PA, b = it >> 3, ch = (it & 7) * 32 + (ln & 31), seg = wave * 2 + (ln >> 5), tl = seg * 32 + (ln & 31);
                    const size_t rbase = (size_t)b * SEQ + seg * 128;
                    float A = 1.f, B = 0.f;
#pragma unroll 16
                    for (int i = 0; i < 128; ++i) { const float a = abuf[(rbase + i) * 256 + ch], bb = bbuf[(rbase + i) * 256 + ch]; B = a * B + bb; A *= a; }
                    LAS float* sA = (LAS float*)lds; LAS float* sB = sA + 512;
                    sA[tl] = A; sB[tl] = B;
                    __syncthreads();
                    float h = 0.f;
                    for (int s2 = 0; s2 < seg; ++s2) h = sA[s2 * 32 + (ln & 31)] * h + sB[s2 * 32 + (ln & 31)];
                    for (int i0 = 0; i0 < 128; i0 += 16) { float av[16], bv[16], gv[16];
#pragma unroll
                        for (int k = 0; k < 16; ++k) { av[k] = abuf[(rbase + i0 + k) * 256 + ch]; bv[k] = bbuf[(rbase + i0 + k) * 256 + ch]; gv[k] = (float)z[(rbase + i0 + k) * ZW + 1440 + ch]; }
#pragma unroll
                        for (int k = 0; k < 16; ++k) { h = av[k] * h + bv[k]; cat[(rbase + i0 + k) * 1024 + 768 + ch] = (h16)(h * gv[k]); } }
                    if (seg == 15) out[O_PH + ((size_t)lq * NB + b) * 256 + ch] = h;
                } else {
                    const float* abuf = WSP(float, W_A); const float* bbuf = WSP(float, W_B); const h16* z = WSP(h16, W_Z); h16* cats = WSP(h16, W_CATS);
                    const int it = item - N_SA - N_PA - N_PS, idx = it * 512 + tix, b = idx >> 8, ch = idx & 255;
                    float h = kp->in[4][((size_t)lq * DBATCH + b) * 256 + ch];
                    for (int t0 = 0; t0 < DSEQ; t0 += 16) { float av[16], bv[16], gv[16];
#pragma unroll
                        for (int k = 0; k < 16; ++k) { const size_t r = (size_t)MP + b * 32 + t0 + k; av[k] = abuf[r * 256 + ch]; bv[k] = bbuf[r * 256 + ch]; gv[k] = (float)z[r * ZW + 1440 + ch]; }
#pragma unroll
                        for (int k = 0; k < 16; ++k) { h = av[k] * h + bv[k]; cats[(size_t)(b * 32 + t0 + k) * 1024 + 768 + ch] = (h16)(h * gv[k]); } }
                    out[O_SH + ((size_t)lq * DBATCH + b) * 256 + ch] = h;
                    asm volatile("s_waitcnt vmcnt(0)" ::: "memory"); __syncthreads();
                    if (tix == 0) { __builtin_amdgcn_fence(__ATOMIC_RELEASE, "agent"); asm volatile("s_waitcnt vmcnt(0)" ::: "memory"); (void)xb_add(sdone, 1u); }
                }
            }
        }
        GSYNC();

        for (int rep = 0; rep < NREP(9); ++rep) if (PHM & (1u << 9)) { PH_BEGIN
          conv_gate_items((unsigned)((MP / 4) * (DFF / 8)) + (unsigned)gtid, (unsigned)((MT / 4) * (DFF / 8)), (unsigned)NGT, 4, ConvP{WSP(h16, W_UP), WSP(h16, W_ACT), kp->in[28] + (size_t)lq * 3 * DFF2, kp->in[29] + (size_t)lq * DFF2, kp->in[6] + (size_t)lq * DBATCH * 2 * DFF2, WSP(float, W_STATS + (size_t)(lq * 2) * SZ_STATS), WSP(float, W_CD + lq * SZ_CD) + 2 * ZW, WSP(float, W_CD + lq * SZ_CD) + 2 * ZW + DFF2, out + O_PFC + (size_t)lq * NB * 2 * DFF2, (O_SFC + (size_t)lq * DBATCH * 2 * DFF2) - (O_PFC + (size_t)lq * NB * 2 * DFF2)});
          const int lp = lq > 0 ? lq - 1 : 0;
          Gemm g{WSP(h16, W_CAT), WSP(h16, W_WO + lq * SZ_WO), MP, 1024, 1024, 1024, 1024}; StaticOrder S; S.init(MP, 1024, G, bid);
          EpiRes E{WSP(h16, W_XH), WSP(float, W_STATS + (size_t)(lp * 2 + 1) * SZ_STATS), kp->in[9] + lp * DM, kp->in[10] + lp * DM, lq > 0, WSP(float, W_STATS + (size_t)(lq * 2) * SZ_STATS)}; gemm_phase(lds, g, S, E, tid); }
        GSYNC();

        for (int rep = 0; rep < NREP(12); ++rep) if (PHM & (1u << 12)) { PH_BEGIN
          Gemm g{WSP(h16, W_XH), WSP(h16, W_WUP + lq * SZ_WUP), MP, DFF2, 1024, 1024, 1024}; StaticOrder S; S.init(MP, DFF2, G, bid);
          EpiUp E{WSP(h16, W_UP), 0}; gemm_phase(lds, g, S, E, tid); }
        GSYNC();

        for (int rep = 0; rep < NREP(13); ++rep) if (PHM & (1u << 13)) { PH_BEGIN
            if (bid < 16) { const size_t ro = (size_t)(MP / BM + (bid >> 2)) * BM;
                Gemm g{WSP(h16, W_ACT) + ro * DFF, WSP(h16, W_WDN + lq * SZ_WDN), BM, 1024, DFF, DFF, DFF}; StaticOrder S; S.init(BM, 1024, 4, bid & 3);
                EpiRes E{WSP(h16, W_XH) + ro * DM, WSP(float, W_STATS + (size_t)(lq * 2) * SZ_STATS) + 2 * ro, kp->in[7] + lq * DM, kp->in[8] + lq * DM, true, WSP(float, W_STATS + (size_t)(lq * 2 + 1) * SZ_STATS) + 2 * ro}; gemm_phase(lds, g, S, E, tid); }
            else conv_gate_items((unsigned)(gtid - 16 * 512), (unsigned)((DFF / 8) * (MP / 32)), (unsigned)(NGT - 16 * 512), 32, ConvP{WSP(h16, W_UP), WSP(h16, W_ACT), kp->in[28] + (size_t)lq * 3 * DFF2, kp->in[29] + (size_t)lq * DFF2, kp->in[6] + (size_t)lq * DBATCH * 2 * DFF2, WSP(float, W_STATS + (size_t)(lq * 2) * SZ_STATS), WSP(float, W_CD + lq * SZ_CD) + 2 * ZW, WSP(float, W_CD + lq * SZ_CD) + 2 * ZW + DFF2, out + O_PFC + (size_t)lq * NB * 2 * DFF2, (O_SFC + (size_t)lq * DBATCH * 2 * DFF2) - (O_PFC + (size_t)lq * NB * 2 * DFF2)}); }
        GSYNC();

        for (int rep = 0; rep < NREP(14); ++rep) if (PHM & (1u << 14)) { PH_BEGIN
          Gemm g{WSP(h16, W_ACT), WSP(h16, W_WDN + lq * SZ_WDN), MP, 1024, DFF, DFF, DFF}; StaticOrder S; S.init(MP, 1024, G, bid); EpiRes E{WSP(h16, W_XH), WSP(float, W_STATS + (size_t)(lq * 2) * SZ_STATS), kp->in[7] + lq * DM, kp->in[8] + lq * DM, true, WSP(float, W_STATS + (size_t)(lq * 2 + 1) * SZ_STATS)}; gemm_phase(lds, g, S, E, tid); }
        GSYNC();

    }
    { const int l = DEPTH - 1; PH_BEGIN
        const float* gg = kp->in[9] + lq * DM; const float* bb = kp->in[10] + lq * DM; const h16* pre2 = WSP(h16, W_XH); const float* st = WSP(float, W_STATS + (size_t)(lq * 2 + 1) * SZ_STATS);
        for (size_t i0 = gtid; i0 < (size_t)MT * (DM / 4); i0 += 4 * NGT) { h4 xv[4]; float sm[4], sq[4];
#pragma unroll
            for (int u = 0; u < 4; ++u) { const size_t i = i0 + u * NGT; if (i < (size_t)MT * (DM / 4)) { const int row = (int)(i >> 8), c = (int)(i & 255) * 4; xv[u] = *(const h4*)(pre2 + (size_t)row * DM + c); sm[u] = st[2 * row]; sq[u] = st[2 * row + 1]; } }
#pragma unroll
            for (int u = 0; u < 4; ++u) { const size_t i = i0 + u * NGT; if (i < (size_t)MT * (DM / 4)) { const int row = (int)(i >> 8), c = (int)(i & 255) * 4;
                const float mean = sm[u] * (1.f / DM), rstd = rsqrtf(sq[u] * (1.f / DM) - mean * mean + 1e-5f);
                *(f4*)(out + O_Y + (size_t)row * DM + c) = ((f4){(float)xv[u][0], (float)xv[u][1], (float)xv[u][2], (float)xv[u][3]} - mean) * rstd * *(const f4*)(gg + c) + *(const f4*)(bb + c); } } }
    }
}

extern "C" void kernel_launch(void* const* d_in, const int* in_sizes, int n_in, void* d_out, int out_size, void* d_ws, size_t ws_size, hipStream_t stream) {
    constexpr size_t kDynLds = STAGE_BYTES;
    static int grid_blocks = 0;
    if (!grid_blocks) {
        if (n_in != 31 || (size_t)out_size != O_END || ws_size < W_END) { fprintf(stderr, "kernel_launch: unexpected shapes n_in %d out %d ws %zu (need %zu)\n", n_in, out_size, ws_size, (size_t)W_END); grid_blocks = -1; return; }
        int dev = 0, cus = 0, per_cu = 0;
        hipGetDevice(&dev);
        hipDeviceGetAttribute(&cus, hipDeviceAttributeMultiprocessorCount, dev);
        hipFuncSetAttribute((const void*)trunk_fwd, hipFuncAttributeMaxDynamicSharedMemorySize, (int)kDynLds);
        hipOccupancyMaxActiveBlocksPerMultiprocessor(&per_cu, (const void*)trunk_fwd, 512, kDynLds);
        if (per_cu < 1) per_cu = 1;
        grid_blocks = cus * per_cu;
        if (grid_blocks > 256) grid_blocks = 256;
        if (grid_blocks < 32) { fprintf(stderr, "kernel_launch: grid %d too small\n", grid_blocks); grid_blocks = -1; return; }
    }
    if (grid_blocks < 0) return;
    hipMemsetAsync((char*)d_ws + W_CTR, 0, W_ZERO_END, stream);
    Params p{};
    for (int i = 0; i < 31; ++i) p.in[i] = (const float*)d_in[i];
    p.out = (float*)d_out; p.ws = (unsigned char*)d_ws;
    void* args[] = {&p};
    hipError_t e = hipLaunchCooperativeKernel((const void*)trunk_fwd, dim3(grid_blocks), dim3(512), args, kDynLds, stream);
    if (e != hipSuccess) fprintf(stderr, "cooperative launch failed: %s (grid %d)\n", hipGetErrorString(e), grid_blocks);
}
```

```cpp
#include <hip/hip_runtime.h>
#include <hip/hip_cooperative_groups.h>
#include <cstdio>
#include <cstdint>
namespace cg = cooperative_groups;

typedef _Float16 h16;
typedef _Float16 h8 __attribute__((ext_vector_type(8)));
typedef _Float16 h4 __attribute__((ext_vector_type(4)));
typedef _Float16 h2 __attribute__((ext_vector_type(2)));
typedef float f4 __attribute__((ext_vector_type(4)));
typedef short s4v __attribute__((__vector_size__(8)));
#define LAS __attribute__((address_space(3)))
#define DEVI __device__ __forceinline__

constexpr int DM = 1024, NB = 16, SEQ = 2048, DEPTH = 4, DBATCH = 32, DSEQ = 32, PAST = 4096;
constexpr int MP = NB * SEQ, MS = DBATCH * DSEQ, MT = MP + MS;
constexpr int DIN = 1696, ZW = 1792, DFF = 2816, DFF2 = 5632;
constexpr int QW = 768, KW = 768, VW = 512, QLW = 2304, CSW = 2560, KNW = 288;
constexpr float ALPHA = 1.681792830507429f;
constexpr float QSCALE = 0.14724444f;
constexpr int NPOS = SEQ + DSEQ;

constexpr size_t O_Y = 0;
constexpr size_t O_PLAT = (size_t)MT * DM;
constexpr size_t O_PKR = O_PLAT + (size_t)DEPTH * MP * 256;
constexpr size_t O_PH = O_PKR + (size_t)DEPTH * MP * 32;
constexpr size_t O_PLC = O_PH + (size_t)DEPTH * NB * 256;
constexpr size_t O_PFC = O_PLC + (size_t)DEPTH * NB * 3 * 256;
constexpr size_t O_SLAT = O_PFC + (size_t)DEPTH * NB * 2 * DFF2;
constexpr size_t O_SKR = O_SLAT + (size_t)DEPTH * MS * 256;
constexpr size_t O_SV = O_SKR + (size_t)DEPTH * MS * 32;
constexpr size_t O_SH = O_SV + (size_t)DEPTH * MS * 256;
constexpr size_t O_SLC = O_SH + (size_t)DEPTH * DBATCH * 256;
constexpr size_t O_SFC = O_SLC + (size_t)DEPTH * DBATCH * 3 * 256;
constexpr size_t O_END = O_SFC + (size_t)DEPTH * DBATCH * 2 * DFF2;

constexpr size_t al(size_t x) { return (x + 255) & ~(size_t)255; }
constexpr size_t W_CTR = 0;
constexpr size_t W_PARAMS = 2048;
constexpr size_t W_BAR = 4096;
constexpr size_t W_CD = 4096 + 16384;
constexpr size_t SZ_CD = (size_t)(2 * ZW + 2 * DFF2) * 4;
constexpr size_t W_STATS = W_CD + DEPTH * SZ_CD;
constexpr size_t SZ_STATS = (size_t)MT * 2 * 4;
constexpr size_t W_ZERO_END = W_STATS + (size_t)DEPTH * 2 * SZ_STATS;
constexpr size_t W_ROPE = al(W_ZERO_END);
constexpr size_t W_SP = al(W_ROPE + (size_t)NPOS * 16 * 2 * 4);
constexpr size_t W_WIN = al(W_SP + (size_t)DEPTH * 256 * 4);
constexpr size_t SZ_WIN = (size_t)ZW * 1024 * 2;
constexpr size_t W_WUQ = W_WIN + DEPTH * SZ_WIN;   constexpr size_t SZ_WUQ = (size_t)768 * 384 * 2;
constexpr size_t W_WQL = W_WUQ + DEPTH * SZ_WUQ;   constexpr size_t SZ_WQL = (size_t)2048 * 384 * 2;
constexpr size_t W_WKV = W_WQL + DEPTH * SZ_WQL;   constexpr size_t SZ_WKV = (size_t)1024 * 256 * 2;
constexpr size_t W_WG = W_WKV + DEPTH * SZ_WKV;    constexpr size_t SZ_WG = (size_t)512 * 256 * 2;
constexpr size_t W_WO = W_WG + DEPTH * SZ_WG;      constexpr size_t SZ_WO = (size_t)1024 * 1024 * 2;
constexpr size_t W_WOS = W_WO + DEPTH * SZ_WO;     constexpr size_t SZ_WOS = (size_t)8 * 64 * 256 * 2;
constexpr size_t W_WUP = W_WOS + DEPTH * SZ_WOS;   constexpr size_t SZ_WUP = (size_t)DFF2 * 1024 * 2;
constexpr size_t W_WDN = W_WUP + DEPTH * SZ_WUP;   constexpr size_t SZ_WDN = (size_t)1024 * DFF * 2;
constexpr size_t W_XH = W_WDN + DEPTH * SZ_WDN;
constexpr size_t W_Z = W_XH + (size_t)MT * 1024 * 2;
constexpr size_t W_CQN = W_Z + (size_t)MT * ZW * 2;
constexpr size_t W_CKVN = W_CQN + (size_t)MT * 384 * 2;
constexpr size_t W_XC = W_CKVN + (size_t)MP * 256 * 2;
constexpr size_t W_Q = W_XC + (size_t)MT * 256 * 2;
constexpr size_t W_K = W_Q + (size_t)MP * QW * 2;
constexpr size_t W_V = W_K + (size_t)MP * KW * 2;
constexpr size_t W_A = W_V + (size_t)MP * VW * 2;
constexpr size_t W_B = W_A + (size_t)MT * 256 * 4;
constexpr size_t W_CAT = W_B + (size_t)MT * 256 * 4;
constexpr size_t W_CATS = W_CAT + (size_t)MP * 1024 * 2;
constexpr size_t W_QLAT = W_CATS + (size_t)MS * 1024 * 2;
constexpr size_t W_KNEW = W_QLAT + (size_t)MS * QLW * 2;
constexpr size_t W_PRE = al(W_KNEW + (size_t)MS * KNW * 2);
constexpr size_t W_X1F = W_PRE + (size_t)MT * 1024 * 4;
constexpr size_t W_UP = W_X1F + (size_t)MT * 1024 * 4;
constexpr size_t W_ACT = W_UP + (size_t)MT * DFF2 * 2;
constexpr size_t W_PART = W_ACT + (size_t)MT * DFF * 2;
constexpr size_t SZ_PARTW = 16 * 1024 + 512;
constexpr size_t W_END = W_PART + (size_t)256 * 8 * SZ_PARTW;

struct Params { const float* in[31]; float* out; unsigned char* ws; };

DEVI float gelu_f(float x) { const float u = -2.302208198f * (x + 0.044715f * x * x * x); return x * __builtin_amdgcn_rcpf(1.f + __builtin_amdgcn_exp2f(u)); }
DEVI float sigmoid_f(float x) { return __builtin_amdgcn_rcpf(1.f + __builtin_amdgcn_exp2f(-1.4426950408889634f * x)); }
DEVI h8 pack8(f4 a, f4 b) { h8 r; r[0] = (h16)a[0]; r[1] = (h16)a[1]; r[2] = (h16)a[2]; r[3] = (h16)a[3]; r[4] = (h16)b[0]; r[5] = (h16)b[1]; r[6] = (h16)b[2]; r[7] = (h16)b[3]; return r; }
DEVI h4 pack4(f4 a) { h4 r; r[0] = (h16)a[0]; r[1] = (h16)a[1]; r[2] = (h16)a[2]; r[3] = (h16)a[3]; return r; }
DEVI float shx(float v, int o, int lane) { return __builtin_bit_cast(float, __builtin_amdgcn_ds_bpermute((lane ^ o) << 2, __builtin_bit_cast(int, v))); }
DEVI float wave_sum(float v, int lane) {
#pragma unroll
    for (int o = 1; o < 64; o <<= 1) v += shx(v, o, lane);
    return v;
}
DEVI int opaque_lane() { unsigned ones = ~0u; asm volatile("" : "+s"(ones)); return (int)__builtin_amdgcn_mbcnt_hi(ones, __builtin_amdgcn_mbcnt_lo(ones, 0u)); }
DEVI h4 trrd(LAS unsigned char* p) { s4v r = __builtin_amdgcn_ds_read_tr16_b64_v4i16((LAS s4v*)p); return __builtin_bit_cast(h4, r); }
DEVI h8 cat44(h4 a, h4 b) { return __builtin_shufflevector(a, b, 0, 1, 2, 3, 4, 5, 6, 7); }

constexpr int BM = 256, BK = 64, HALF = 128, HTB = HALF * BK * 2, STAGE_BYTES = 8 * HTB, NXCD = 8, WGM = 8;
DEVI int lds_byte(int r, int c) { const int st = (r >> 4) * 2 + (c >> 5), rr = r & 15, cc = c & 31, ob = rr * 64 + cc * 2; return st * 1024 + (ob ^ (((ob >> 9) & 1) << 5)); }
DEVI void stage_rc(int b, int& R, int& C) { const int st = b / 1024, sb = b % 1024, swz = sb ^ (((sb >> 9) & 1) << 5); R = (st >> 1) * 16 + swz / 64; C = (st & 1) * 32 + (swz % 64) / 2; }
DEVI int perm32(int rho) { const int n = rho >> 4, i = rho & 15; return 8 * (i >> 2) + 4 * n + (i & 3); }
struct Unit { int pm, pn; };
struct Gemm { const h16* A; const h16* Bt; int M, N, K, lda, ldb; };
struct StaticOrder {
    int nM, nN, nwg, G, c;
    DEVI void init(int M, int N, int G_, int c_) { nM = M / BM; nN = N / BM; nwg = nM * nN; G = G_; c = c_; }
    DEVI bool next(int i, Unit& u) const {
        if (c < 0) return false;
        const long L = (long)i * G + c; if (L >= nwg) return false;
        int wgid = (int)L; { const int q = nwg / NXCD, r = nwg % NXCD, xcd = wgid % NXCD, off = wgid / NXCD; wgid = (xcd < r ? xcd * (q + 1) : r * (q + 1) + (xcd - r) * q) + off; }
        const int nig = WGM * nN, gid = wgid / nig, fm = gid * WGM, gsz = (nM - fm) < WGM ? (nM - fm) : WGM;
        u.pm = fm + ((wgid % nig) % gsz); u.pn = (wgid % nig) / gsz; return true;
    }
};
template <class Epi>
DEVI void gemm_phase(LAS unsigned char* lds, const Gemm g, const StaticOrder& S, const Epi& E, const int tid) {
    const int wid = __builtin_amdgcn_readfirstlane(tid >> 6), lane = tid & 63, wr = wid >> 2, wc = wid & 3, fr = lane & 15, fq = lane >> 4;
    const int K = g.K, nt = K / BK;
    unsigned voffA[2], voffB[2];
#pragma unroll
    for (int i = 0; i < 2; ++i) { int R, C; stage_rc(tid * 16 + i * 8192, R, C); const int Rb = Epi::PERM ? ((R & ~31) + perm32(R & 31)) : R;
        voffA[i] = (unsigned)(R * g.lda + C) * 2u; voffB[i] = (unsigned)(Rb * g.ldb + C) * 2u; }
    const size_t kstep = (size_t)(BK * 2);
    const size_t hstepA = (size_t)HALF * g.lda * 2, hstepB = (size_t)HALF * g.ldb * 2;
    const size_t tstepA = 2 * hstepA, tstepB = 2 * hstepB;
    const unsigned ldsw = (unsigned)wid * 1024u;
    const int aoff = lds_byte(wr * 64 + fr, fq * 8), boff = lds_byte(wc * 32 + fr, fq * 8);
#define PG8_SA(b, h) (((b) * 2 + (h)) * HTB)
#define PG8_SB(b, h) ((4 + (b) * 2 + (h)) * HTB)
#define PG8_STAGE(bufoff, gbase, voff) do { _Pragma("unroll") for (int _i = 0; _i < 2; ++_i) \
        __builtin_amdgcn_global_load_lds((const unsigned*)((const char*)(gbase) + (voff)[_i]), (LAS unsigned*)(lds + (bufoff) + ldsw + _i * 8192), 16, 0, 0); } while (0)
#define PG8_LDA(dst, b, h) do { _Pragma("unroll") for (int m = 0; m < 4; ++m) _Pragma("unroll") for (int k = 0; k < 2; ++k) dst[m][k] = *(const LAS h8*)(lds + PG8_SA(b, h) + aoff + m * 2048 + k * 1024); } while (0)
#define PG8_LDB(dst, b, h) do { _Pragma("unroll") for (int n = 0; n < 2; ++n) _Pragma("unroll") for (int k = 0; k < 2; ++k) dst[n][k] = *(const LAS h8*)(lds + PG8_SB(b, h) + boff + n * 2048 + k * 1024); } while (0)
#define PG8_MMA(ai, bj, At, Bt) do { __builtin_amdgcn_s_setprio(1); _Pragma("unroll") for (int m = 0; m < 4; ++m) _Pragma("unroll") for (int n = 0; n < 2; ++n) _Pragma("unroll") for (int k = 0; k < 2; ++k) \
        acc[ai][bj][m][n] = __builtin_amdgcn_mfma_f32_16x16x32_f16(Bt[n][k], At[m][k], acc[ai][bj][m][n], 0, 0, 0); __builtin_amdgcn_s_setprio(0); } while (0)
#define PG8_WAIT_V(n) asm volatile("s_waitcnt vmcnt(" #n ")" ::: "memory")
#define PG8_WAIT_L(n) asm volatile("s_waitcnt lgkmcnt(" #n ")" ::: "memory")
#define PG8_BAR __builtin_amdgcn_s_barrier()
#define PG8_SCHED __builtin_amdgcn_sched_barrier(0)
    Unit cur, nxt; int ui = 0;
    if (!S.next(0, cur)) return;
    f4 acc[2][2][4][2];
#pragma unroll
    for (int a = 0; a < 2; ++a)
#pragma unroll
        for (int b = 0; b < 2; ++b)
#pragma unroll
            for (int m = 0; m < 4; ++m)
#pragma unroll
                for (int n = 0; n < 2; ++n) acc[a][b][m][n] = (f4){0.f, 0.f, 0.f, 0.f};
    h8 At[4][2], B0[2][2], B1[2][2];
    const char* cA = (const char*)g.A + (size_t)cur.pm * tstepA; const char* cB = (const char*)g.Bt + (size_t)cur.pn * tstepB;
    PG8_STAGE(PG8_SB(0, 0), cB, voffB); PG8_STAGE(PG8_SA(0, 0), cA, voffA); PG8_STAGE(PG8_SB(0, 1), cB + hstepB, voffB); PG8_STAGE(PG8_SA(0, 1), cA + hstepA, voffA);
    if (wr == 1) PG8_BAR;
    PG8_WAIT_V(4); PG8_BAR;
    PG8_STAGE(PG8_SB(1, 0), cB + kstep, voffB); PG8_STAGE(PG8_SA(1, 0), cA + kstep, voffA); PG8_STAGE(PG8_SB(1, 1), cB + hstepB + kstep, voffB);
    PG8_WAIT_V(6); PG8_BAR;
    for (;;) {
        const bool has_next = S.next(ui + 1, nxt);
        const char* nA = has_next ? (const char*)g.A + (size_t)nxt.pm * tstepA : cA; const char* nB = has_next ? (const char*)g.Bt + (size_t)nxt.pn * tstepB : cB;
        for (int t = 0; t < nt; t += 2) {
            const bool last = (t == nt - 2);
            const char* a1 = cA + (size_t)(t + 1) * kstep;
            const char* a2 = last ? nA : cA + (size_t)(t + 2) * kstep; const char* b2 = last ? nB : cB + (size_t)(t + 2) * kstep;
            const char* a3 = a2 + kstep; const char* b3 = b2 + kstep;
            PG8_LDB(B0, 0, 0); PG8_SCHED; PG8_LDA(At, 0, 0); PG8_STAGE(PG8_SA(1, 1), a1 + hstepA, voffA);
            PG8_WAIT_L(8); PG8_BAR; PG8_WAIT_L(0); PG8_MMA(0, 0, At, B0); PG8_BAR; PG8_SCHED;
            PG8_LDB(B1, 0, 1); PG8_STAGE(PG8_SB(0, 0), b2, voffB);
            PG8_BAR; PG8_WAIT_L(0); PG8_MMA(0, 1, At, B1); PG8_BAR;
            PG8_LDA(At, 0, 1); PG8_STAGE(PG8_SA(0, 0), a2, voffA);
            PG8_BAR; PG8_WAIT_L(0); PG8_MMA(1, 0, At, B0); PG8_BAR; PG8_SCHED;
            PG8_STAGE(PG8_SB(0, 1), b2 + hstepB, voffB);
            PG8_WAIT_V(6); PG8_BAR; PG8_MMA(1, 1, At, B1); PG8_BAR;
            PG8_LDB(B0, 1, 0); PG8_SCHED; PG8_LDA(At, 1, 0); PG8_STAGE(PG8_SA(0, 1), a2 + hstepA, voffA);
            PG8_WAIT_L(8); PG8_BAR; PG8_WAIT_L(0); PG8_MMA(0, 0, At, B0); PG8_BAR; PG8_SCHED;
            PG8_LDB(B1, 1, 1); PG8_STAGE(PG8_SB(1, 0), b3, voffB);
            PG8_BAR; PG8_WAIT_L(0); PG8_MMA(0, 1, At, B1); PG8_BAR;
            PG8_LDA(At, 1, 1); PG8_STAGE(PG8_SA(1, 0), a3, voffA);
            PG8_BAR; PG8_WAIT_L(0); PG8_MMA(1, 0, At, B0); PG8_BAR; PG8_SCHED;
            PG8_STAGE(PG8_SB(1, 1), b3 + hstepB, voffB);
            PG8_WAIT_V(6); PG8_BAR; PG8_MMA(1, 1, At, B1); PG8_BAR;
        }
        { int t2 = tid; asm volatile("" : "+v"(t2)); const int l2 = t2 & 63; E(acc, cur, wr, wc, l2 & 15, l2 >> 4); }
        if (!has_next) break;
#pragma unroll
        for (int a = 0; a < 2; ++a)
#pragma unroll
            for (int b = 0; b < 2; ++b)
#pragma unroll
                for (int m = 0; m < 4; ++m)
#pragma unroll
                    for (int n = 0; n < 2; ++n) acc[a][b][m][n] = (f4){0.f, 0.f, 0.f, 0.f};
        cur = nxt; cA = nA; cB = nB; ++ui;
    }
    PG8_WAIT_V(0);
    if (wr == 0) PG8_BAR;
    PG8_BAR;
#undef PG8_SA
#undef PG8_SB
#undef PG8_STAGE
#undef PG8_LDA
#undef PG8_LDB
#undef PG8_MMA
#undef PG8_WAIT_V
#undef PG8_WAIT_L
#undef PG8_BAR
#undef PG8_SCHED
}

typedef f4 Acc[2][2][4][2];
#define EPI_ROWS for (int ai = 0; ai < 2; ++ai) _Pragma("unroll") for (int m = 0; m < 4; ++m)

#define ROW_OF(r) (rowb + ((r) >> 2) * HALF + ((r) & 3) * 16)
struct EpiZ {
    static constexpr bool PERM = true;
    h16* z; float* sv; const float* st; const float* cv; const float* dv; bool fold;
    DEVI void operator()(const Acc& acc, const Unit& u, int wr, int wc, int fr, int fq) const {
        const int rowb = u.pm * BM + wr * 64 + fr, colb = u.pn * BM + wc * 32 + fq * 8;
        float mean[8], rstd[8]; f4 c[2][2], d[2][2];
#pragma unroll
        for (int r = 0; r < 8; ++r) { mean[r] = 0.f; rstd[r] = 1.f; }
#pragma unroll
        for (int bj = 0; bj < 2; ++bj)
#pragma unroll
            for (int n = 0; n < 2; ++n) { c[bj][n] = (f4){0.f, 0.f, 0.f, 0.f}; d[bj][n] = c[bj][n]; }
        if (fold) {
#pragma unroll
            for (int r = 0; r < 8; ++r) { const int row = ROW_OF(r); const float sm = st[2 * row], sq = st[2 * row + 1]; mean[r] = sm * (1.f / DM); rstd[r] = rsqrtf(sq * (1.f / DM) - mean[r] * mean[r] + 1e-5f); }
#pragma unroll
            for (int bj = 0; bj < 2; ++bj)
#pragma unroll
                for (int n = 0; n < 2; ++n) { c[bj][n] = *(const f4*)(cv + colb + bj * HALF + 4 * n); d[bj][n] = *(const f4*)(dv + colb + bj * HALF + 4 * n); } }
#pragma unroll
        for (int bj = 0; bj < 2; ++bj) { const int col = colb + bj * HALF; const bool act = col < 512 || (col >= 1440 && col < 1696);
#pragma unroll
            for (int r = 0; r < 8; ++r) { const int row = ROW_OF(r);
                f4 v0 = (acc[r >> 2][bj][r & 3][0] - c[bj][0] * mean[r]) * rstd[r] + d[bj][0], v1 = (acc[r >> 2][bj][r & 3][1] - c[bj][1] * mean[r]) * rstd[r] + d[bj][1];
                if (act) {
#pragma unroll
                    for (int e = 0; e < 4; ++e) { v0[e] = gelu_f(v0[e]); v1[e] = gelu_f(v1[e]); } }
                *(h8*)(z + (size_t)row * ZW + col) = pack8(v0, v1);
                if (row >= MP && col >= 256 && col < 512) { float* o = sv + (size_t)(row - MP) * 256 + (col - 256); *(f4*)o = v0; *(f4*)(o + 4) = v1; } } }
    }
};
struct EpiQ {
    static constexpr bool PERM = true;
    h16* q; h16* qlat; const float* ropec; const float* ropes;
    DEVI void operator()(const Acc& acc, const Unit& u, int wr, int wc, int fr, int fq) const {
        const bool samp = u.pm * BM >= MP;
        if (u.pn < 2) { if (samp) return;
#pragma unroll
            EPI_ROWS { const int row = u.pm * BM + ai * HALF + wr * 64 + m * 16 + fr;
#pragma unroll
                for (int bj = 0; bj < 2; ++bj) { const int col = u.pn * BM + bj * HALF + wc * 32 + fq * 8;
                    *(h8*)(q + (size_t)row * QW + (col >> 6) * 96 + (col & 63)) = pack8(acc[ai][bj][m][0] * QSCALE, acc[ai][bj][m][1] * QSCALE); } }
        } else {
            const int j = wc * 32 + fq * 8, head = j >> 4, i0 = j & 15; const int rowb = u.pm * BM + wr * 64 + fr;
#pragma unroll
            for (int r = 0; r < 8; ++r) { const int row = ROW_OF(r); const int pidx = samp ? SEQ + ((row - MP) & 31) : (row & (SEQ - 1));
                const size_t po = samp ? (W_QLAT - W_Q) / 2 + (size_t)(row - MP) * QLW + head * 288 + 256 + i0 : (size_t)row * QW + head * 96 + 64 + i0;
#pragma unroll
                for (int n = 0; n < 2; ++n) { const f4 cc = *(const f4*)(ropec + pidx * 16 + i0 + 4 * n), ss = *(const f4*)(ropes + pidx * 16 + i0 + 4 * n);
                    const f4 a0 = acc[r >> 2][0][r & 3][n], b0 = acc[r >> 2][1][r & 3][n];
                    *(h4*)(q + po + 4 * n) = pack4((a0 * cc - b0 * ss) * QSCALE); *(h4*)(q + po + 16 + 4 * n) = pack4((a0 * ss + b0 * cc) * QSCALE); } }
        }
    }
};
struct EpiKV {
    static constexpr bool PERM = true;
    h16* k; h16* v;
    DEVI void operator()(const Acc& acc, const Unit& u, int wr, int wc, int fr, int fq) const {
#pragma unroll
        EPI_ROWS { const int row = u.pm * BM + ai * HALF + wr * 64 + m * 16 + fr;
#pragma unroll
            for (int bj = 0; bj < 2; ++bj) { const int col = u.pn * BM + bj * HALF + wc * 32 + fq * 8; const h8 o = pack8(acc[ai][bj][m][0], acc[ai][bj][m][1]);
                if (u.pn < 2) *(h8*)(k + (size_t)row * KW + (col >> 6) * 96 + (col & 63)) = o; else *(h8*)(v + (size_t)row * VW + (col - 512)) = o; } }
    }
};
DEVI float one_minus_exp(float x) {
    const float pser = -x * (1.f + x * (0.5f + x * (0.16666667f + x * (0.041666668f + x * (0.0083333338f + x * 0.0013888889f)))));
    return x > -0.25f ? pser : 1.f - __builtin_amdgcn_exp2f(1.4426950408889634f * x);
}
struct EpiGate {
    static constexpr bool PERM = false;
    const h16* xc; float* a; float* b; const float* br; const float* bi; const float* sp;
    DEVI void operator()(const Acc& acc, const Unit& u, int wr, int wc, int fr, int fq) const {
        const int rowb = u.pm * BM + wr * 64 + fr, chb = u.pn * 128 + wc * 32 + fq * 4;
        f4 vbr[2], vbi[2], vsp[2]; h4 xv[2][8];
#pragma unroll
        for (int n = 0; n < 2; ++n) { const int ch = chb + n * 16; vbr[n] = *(const f4*)(br + ch); vbi[n] = *(const f4*)(bi + ch); vsp[n] = *(const f4*)(sp + ch) * -8.f;
#pragma unroll
            for (int r = 0; r < 8; ++r) xv[n][r] = *(const h4*)(xc + (size_t)ROW_OF(r) * 256 + ch); }
#pragma unroll
        for (int n = 0; n < 2; ++n) { const int ch = chb + n * 16;
#pragma unroll
            for (int r = 0; r < 8; ++r) { const int row = ROW_OF(r); f4 oa, ob;
#pragma unroll
                for (int e = 0; e < 4; ++e) { const float rg = sigmoid_f(acc[r >> 2][0][r & 3][n][e] + vbr[n][e]), ig = sigmoid_f(acc[r >> 2][1][r & 3][n][e] + vbi[n][e]);
                    const float la = rg * vsp[n][e]; oa[e] = __builtin_amdgcn_exp2f(1.4426950408889634f * la); ob[e] = __builtin_amdgcn_sqrtf(one_minus_exp(2.f * la)) * (ig * (float)xv[n][r][e]); }
                *(f4*)(a + (size_t)row * 256 + ch) = oa; *(f4*)(b + (size_t)row * 256 + ch) = ob; } }
    }
};
struct EpiQlat {
    static constexpr bool PERM = true;
    h16* qlat;
    DEVI void operator()(const Acc& acc, const Unit& u, int wr, int wc, int fr, int fq) const {
#pragma unroll
        EPI_ROWS { const int row = u.pm * BM + ai * HALF + wr * 64 + m * 16 + fr;
#pragma unroll
            for (int bj = 0; bj < 2; ++bj) { const int c = bj * HALF + wc * 32 + fq * 8;
                *(h8*)(qlat + (size_t)row * QLW + u.pn * 288 + c) = pack8(acc[ai][bj][m][0] * QSCALE, acc[ai][bj][m][1] * QSCALE); } }
    }
};
struct EpiRes {
    static constexpr bool PERM = true;
    h16* xh; const float* pst; const float* g; const float* b; bool ln; float* ost;
    DEVI void operator()(const Acc& acc, const Unit& u, int wr, int wc, int fr, int fq) const {
        const int rowb = u.pm * BM + wr * 64 + fr, colb = u.pn * BM + wc * 32 + fq * 8, lane = fq * 16 + fr;
        f4 gv[4], bv[4]; float mean[8], rstd[8];
#pragma unroll
        for (int k = 0; k < 4; ++k) { const int col = colb + (k >> 1) * HALF + (k & 1) * 4; gv[k] = ln ? *(const f4*)(g + col) : (f4){1.f, 1.f, 1.f, 1.f}; bv[k] = ln ? *(const f4*)(b + col) : (f4){0.f, 0.f, 0.f, 0.f}; }
#pragma unroll
        for (int r = 0; r < 8; ++r) { mean[r] = 0.f; rstd[r] = 1.f;
            if (ln) { const int row = ROW_OF(r); const float sm = pst[2 * row], sq = pst[2 * row + 1]; mean[r] = sm * (1.f / DM); rstd[r] = rsqrtf(sq * (1.f / DM) - mean[r] * mean[r] + 1e-5f); } }
        h8 cur[2], nxt[2];
#pragma unroll
        for (int bj = 0; bj < 2; ++bj) cur[bj] = *(const h8*)(xh + (size_t)ROW_OF(0) * DM + colb + bj * HALF);
#pragma unroll
        for (int r = 0; r < 8; ++r) { const int row = ROW_OF(r);
            if (r < 7) {
#pragma unroll
                for (int bj = 0; bj < 2; ++bj) nxt[bj] = *(const h8*)(xh + (size_t)ROW_OF(r + 1) * DM + colb + bj * HALF); }
            float s1 = 0.f, s2 = 0.f;
#pragma unroll
            for (int bj = 0; bj < 2; ++bj) { f4 y[2];
#pragma unroll
                for (int n = 0; n < 2; ++n) { const int k = bj * 2 + n;
                    const f4 xv = (f4){(float)cur[bj][4 * n], (float)cur[bj][4 * n + 1], (float)cur[bj][4 * n + 2], (float)cur[bj][4 * n + 3]};
                    y[n] = ((xv - mean[r]) * rstd[r] * gv[k] + bv[k]) * ALPHA + acc[r >> 2][bj][r & 3][n];
                    s1 += (y[n][0] + y[n][1]) + (y[n][2] + y[n][3]); s2 += (y[n][0] * y[n][0] + y[n][1] * y[n][1]) + (y[n][2] * y[n][2] + y[n][3] * y[n][3]); }
                *(h8*)(xh + (size_t)row * DM + colb + bj * HALF) = pack8(y[0], y[1]); }
            s1 += shx(s1, 16, lane); s2 += shx(s2, 16, lane); s1 += shx(s1, 32, lane); s2 += shx(s2, 32, lane);
            if (fq == 0) { atomicAdd(ost + 2 * row, s1); atomicAdd(ost + 2 * row + 1, s2); }
#pragma unroll
            for (int bj = 0; bj < 2; ++bj) cur[bj] = nxt[bj]; }
    }
};
struct EpiUp {
    static constexpr bool PERM = true;
    h16* up; int rowoff;
    DEVI void operator()(const Acc& acc, const Unit& u, int wr, int wc, int fr, int fq) const {
        const int rowb = rowoff + u.pm * BM + wr * 64 + fr, colb = u.pn * BM + wc * 32 + fq * 8;
#pragma unroll
        for (int r = 0; r < 8; ++r) { h16* p = up + (size_t)ROW_OF(r) * DFF2 + colb;
#pragma unroll
            for (int bj = 0; bj < 2; ++bj) __builtin_nontemporal_store(pack8(acc[r >> 2][bj][r & 3][0], acc[r >> 2][bj][r & 3][1]), (h8*)(p + bj * HALF)); }
    }
};

template <int MODE>
DEVI void transpose_item(const float* W, int ldw, int nblk, h16* WT, int ldd, LAS float* scr, int item, int lane, const float* gs = nullptr, const float* bs = nullptr, float* csum = nullptr, float* dsum = nullptr) {
    const int kb = item / nblk, nb = item % nblk, k0 = 64 * kb, n0 = 32 * nb;
    int nsrc = n0 + (lane & 31);
    if (MODE == 1) { const int n = nsrc; if (n < 512) nsrc = (n >> 6) * 96 + (n & 63); else if (n < 640) nsrc = ((n - 512) >> 4) * 96 + 64 + ((n - 512) & 15); else nsrc = ((n - 640) >> 4) * 96 + 80 + ((n - 640) & 15); }
    float cs = 0.f, ds = 0.f;
#pragma unroll 8
    for (int i = 0; i < 32; ++i) { const int kk = 2 * i + (lane >> 5); float w = W[(size_t)(k0 + kk) * ldw + nsrc]; if (gs) { ds += bs[k0 + kk] * w; w *= gs[k0 + kk]; cs += w; } scr[kk * 33 + (lane & 31)] = w; }
    if (gs && csum) { atomicAdd(csum + nsrc, cs); atomicAdd(dsum + nsrc, ds); }
    __builtin_amdgcn_fence(__ATOMIC_RELEASE, "wavefront"); asm volatile("s_waitcnt lgkmcnt(0)" ::: "memory");
    const int c = lane & 7;
#pragma unroll
    for (int j = 0; j < 4; ++j) { const int n = (lane >> 3) + 8 * j; const LAS float* s = scr + (8 * c) * 33 + n;
        h8 o; o[0] = (h16)s[0 * 33]; o[1] = (h16)s[1 * 33]; o[2] = (h16)s[2 * 33]; o[3] = (h16)s[3 * 33]; o[4] = (h16)s[4 * 33]; o[5] = (h16)s[5 * 33]; o[6] = (h16)s[6 * 33]; o[7] = (h16)s[7 * 33];
        *(h8*)(WT + (size_t)(n0 + n) * ldd + k0 + 8 * c) = o; }
    asm volatile("s_waitcnt lgkmcnt(0)" ::: "memory");
}

template <int NKS, int NCT, int NQS, int KSTR>
DEVI void attn_qk(LAS unsigned char* kbase, const h8 (&qf)[NQS][NKS], f4 (&o)[NQS][NCT], float (&mrow)[NQS], float (&lrow)[NQS], h8 (&pf)[NQS][2], const int nkt, const int lane) {
    const int fr = lane & 15, g = lane >> 4;
    f4 s[NQS][4];
#pragma unroll
    for (int qs = 0; qs < NQS; ++qs)
#pragma unroll
        for (int kt = 0; kt < 4; ++kt) s[qs][kt] = (f4){-1e30f, -1e30f, -1e30f, -1e30f};
#pragma unroll
    for (int kt = 0; kt < 4; ++kt) if (kt < nkt) {
#pragma unroll
        for (int qs = 0; qs < NQS; ++qs) s[qs][kt] = (f4){0.f, 0.f, 0.f, 0.f};
#pragma unroll
        for (int ks = 0; ks < NKS; ++ks) { const h8 kf = *(const LAS h8*)(kbase + (kt * 16 + fr) * KSTR + ks * 64 + g * 16);
#pragma unroll
            for (int qs = 0; qs < NQS; ++qs) s[qs][kt] = __builtin_amdgcn_mfma_f32_16x16x32_f16(kf, qf[qs][ks], s[qs][kt], 0, 0, 0); } }
    __builtin_amdgcn_sched_barrier(0);
#pragma unroll
    for (int qs = 0; qs < NQS; ++qs) {
        float mx = -1e30f;
#pragma unroll
        for (int kt = 0; kt < 4; ++kt)
#pragma unroll
            for (int e = 0; e < 4; ++e) mx = fmaxf(mx, s[qs][kt][e]);
        mx = fmaxf(mx, shx(mx, 16, lane)); mx = fmaxf(mx, shx(mx, 32, lane));
        const float mnew = fmaxf(mrow[qs], mx), alpha = __builtin_amdgcn_exp2f(mrow[qs] - mnew); mrow[qs] = mnew;
        float ps = 0.f;
#pragma unroll
        for (int kt = 0; kt < 4; ++kt)
#pragma unroll
            for (int e = 0; e < 4; ++e) { const float p = __builtin_amdgcn_exp2f(s[qs][kt][e] - mnew); s[qs][kt][e] = p; ps += p; }
        lrow[qs] = lrow[qs] * alpha + ps;
#pragma unroll
        for (int ct = 0; ct < NCT; ++ct) o[qs][ct] *= alpha;
#pragma unroll
        for (int k2 = 0; k2 < 2; ++k2) pf[qs][k2] = pack8(s[qs][2 * k2], s[qs][2 * k2 + 1]);
    }
    __builtin_amdgcn_sched_barrier(0);
}
template <int NCT, int NQS, int VSTR>
DEVI void attn_pv(LAS unsigned char* vbase, f4 (&o)[NQS][NCT], const h8 (&pf)[NQS][2], const int nkt, const int lane) {
    const int fr = lane & 15, g = lane >> 4, q_ = fr >> 2, p_ = fr & 3;
#pragma unroll
    for (int k2 = 0; k2 < 2; ++k2) if (2 * k2 < nkt) {
#pragma unroll
        for (int ct = 0; ct < NCT; ++ct) {
            const h4 lo = trrd(vbase + (32 * k2 + 4 * g + q_) * VSTR + (16 * ct + 4 * p_) * 2);
            const h4 hi = trrd(vbase + (32 * k2 + 16 + 4 * g + q_) * VSTR + (16 * ct + 4 * p_) * 2);
            const h8 vf = cat44(lo, hi);
#pragma unroll
            for (int qs = 0; qs < NQS; ++qs) o[qs][ct] = __builtin_amdgcn_mfma_f32_16x16x32_f16(vf, pf[qs][k2], o[qs][ct], 0, 0, 0); } }
    __builtin_amdgcn_sched_barrier(0);
}
template <int NKS, int NCT, int NQS, int KSTR, int VSTR>
DEVI void attn_tile(LAS unsigned char* kbase, LAS unsigned char* vbase, const h8 (&qf)[NQS][NKS], f4 (&o)[NQS][NCT], float (&mrow)[NQS], float (&lrow)[NQS], const int nkt, const int lane) {
    h8 pf[NQS][2];
    attn_qk<NKS, NCT, NQS, KSTR>(kbase, qf, o, mrow, lrow, pf, nkt, lane);
    attn_pv<NCT, NQS, VSTR>(vbase, o, pf, nkt, lane);
}


struct ConvP { const h16* up; h16* act; const float* fw; const float* fb; const float* stf; const float* st; const float* cv; const float* dv; float* pfc; size_t sdelta; };
DEVI void conv_gate_items(unsigned it_begin, unsigned it_end, unsigned it_step, const int rseg, const ConvP P) {
    constexpr int NCG = DFF / 8;
    for (unsigned it = it_begin; it < it_end; it += it_step) { const int seg = (int)(it / (unsigned)NCG), cg = (int)(it - (unsigned)seg * NCG), j0 = cg * 8, row0 = seg * rseg;
        const bool samp = row0 >= MP; const int t0 = samp ? ((row0 - MP) & 31) : (row0 & (SEQ - 1)), bb = (row0 - MP) >> 5, T = samp ? DSEQ : SEQ;
        const f4 bg0 = *(const f4*)(P.fb + j0), bg1 = *(const f4*)(P.fb + j0 + 4), bv0 = *(const f4*)(P.fb + DFF + j0), bv1 = *(const f4*)(P.fb + DFF + j0 + 4);
        const f4 cg0_ = *(const f4*)(P.cv + j0), cg1_ = *(const f4*)(P.cv + j0 + 4), cv0_ = *(const f4*)(P.cv + DFF + j0), cv1_ = *(const f4*)(P.cv + DFF + j0 + 4);
        const f4 dg0_ = *(const f4*)(P.dv + j0), dg1_ = *(const f4*)(P.dv + j0 + 4), dv0_ = *(const f4*)(P.dv + DFF + j0), dv1_ = *(const f4*)(P.dv + DFF + j0 + 4);
        f4 wg0[3], wg1[3], wv0[3], wv1[3];
#pragma unroll
        for (int j = 0; j < 3; ++j) { const float* wj = P.fw + (size_t)j * DFF2; wg0[j] = *(const f4*)(wj + j0); wg1[j] = *(const f4*)(wj + j0 + 4); wv0[j] = *(const f4*)(wj + DFF + j0); wv1[j] = *(const f4*)(wj + DFF + j0 + 4); }
#define CG_LOADROW(row, G0, G1, V0, V1) do { const h16* _u = P.up + (size_t)(row) * DFF2 + j0; const h8 _a = *(const h8*)_u, _c = *(const h8*)(_u + DFF); \
            const float _sm = P.st[2 * (row)], _sq = P.st[2 * (row) + 1], _mean = _sm * (1.f / DM), _rstd = __builtin_amdgcn_rsqf(_sq * (1.f / DM) - _mean * _mean + 1e-5f); \
            G0 = ((f4){(float)_a[0], (float)_a[1], (float)_a[2], (float)_a[3]} - cg0_ * _mean) * _rstd + dg0_; G1 = ((f4){(float)_a[4], (float)_a[5], (float)_a[6], (float)_a[7]} - cg1_ * _mean) * _rstd + dg1_; \
            V0 = ((f4){(float)_c[0], (float)_c[1], (float)_c[2], (float)_c[3]} - cv0_ * _mean) * _rstd + dv0_; V1 = ((f4){(float)_c[4], (float)_c[5], (float)_c[6], (float)_c[7]} - cv1_ * _mean) * _rstd + dv1_; } while (0)
        f4 ag0, ag1, av0, av1, bg0_, bg1_, bv0_, bv1_;
        if (t0 > 0) { CG_LOADROW(row0 - 2, ag0, ag1, av0, av1); CG_LOADROW(row0 - 1, bg0_, bg1_, bv0_, bv1_); }
        else if (samp) { const float* s2 = P.stf + (size_t)bb * 2 * DFF2; const float* s1 = s2 + DFF2;
            ag0 = *(const f4*)(s2 + j0); ag1 = *(const f4*)(s2 + j0 + 4); av0 = *(const f4*)(s2 + DFF + j0); av1 = *(const f4*)(s2 + DFF + j0 + 4);
            bg0_ = *(const f4*)(s1 + j0); bg1_ = *(const f4*)(s1 + j0 + 4); bv0_ = *(const f4*)(s1 + DFF + j0); bv1_ = *(const f4*)(s1 + DFF + j0 + 4); }
        else { ag0 = ag1 = av0 = av1 = bg0_ = bg1_ = bv0_ = bv1_ = (f4){0.f, 0.f, 0.f, 0.f}; }
        h16* ar = P.act + (size_t)row0 * DFF + j0;
        for (int r0 = 0; r0 < rseg; r0 += 4) { h8 ra[4], rc[4]; float rsm[4], rsq[4];
#pragma unroll
            for (int k = 0; k < 4; ++k) { const int row = row0 + r0 + k; const h16* u_ = P.up + (size_t)row * DFF2 + j0; ra[k] = *(const h8*)u_; rc[k] = *(const h8*)(u_ + DFF); rsm[k] = P.st[2 * row]; rsq[k] = P.st[2 * row + 1]; }
#pragma unroll
            for (int k = 0; k < 4; ++k) { const int r = r0 + k; const float mean = rsm[k] * (1.f / DM), rstd = __builtin_amdgcn_rsqf(rsq[k] * (1.f / DM) - mean * mean + 1e-5f);
                const f4 cg0 = ((f4){(float)ra[k][0], (float)ra[k][1], (float)ra[k][2], (float)ra[k][3]} - cg0_ * mean) * rstd + dg0_, cg1 = ((f4){(float)ra[k][4], (float)ra[k][5], (float)ra[k][6], (float)ra[k][7]} - cg1_ * mean) * rstd + dg1_;
                const f4 cv0 = ((f4){(float)rc[k][0], (float)rc[k][1], (float)rc[k][2], (float)rc[k][3]} - cv0_ * mean) * rstd + dv0_, cv1 = ((f4){(float)rc[k][4], (float)rc[k][5], (float)rc[k][6], (float)rc[k][7]} - cv1_ * mean) * rstd + dv1_;
                const f4 g0 = bg0 + ag0 * wg0[0] + bg0_ * wg0[1] + cg0 * wg0[2], g1 = bg1 + ag1 * wg1[0] + bg1_ * wg1[1] + cg1 * wg1[2];
                const f4 v0 = bv0 + av0 * wv0[0] + bv0_ * wv0[1] + cv0 * wv0[2], v1 = bv1 + av1 * wv1[0] + bv1_ * wv1[1] + cv1 * wv1[2];
                h8 o;
#pragma unroll
                for (int e = 0; e < 4; ++e) { o[e] = (h16)(gelu_f(g0[e]) * v0[e]); o[4 + e] = (h16)(gelu_f(g1[e]) * v1[e]); }
                __builtin_nontemporal_store(o, (h8*)(ar + (size_t)r * DFF));
                const int t = t0 + r;
                if (t >= T - 2) { float* so = P.pfc + (samp ? P.sdelta + ((size_t)bb * 2 + (t - (T - 2))) * DFF2 : ((size_t)(row0 >> 11) * 2 + (t - (T - 2))) * DFF2) + j0;
                    *(f4*)so = cg0; *(f4*)(so + 4) = cg1; *(f4*)(so + DFF) = cv0; *(f4*)(so + DFF + 4) = cv1; }
                ag0 = bg0_; ag1 = bg1_; av0 = bv0_; av1 = bv1_; bg0_ = cg0; bg1_ = cg1; bv0_ = cv0; bv1_ = cv1; } } }
#undef CG_LOADROW
}

#define XB_TMO      128
#define XB_XCNT(j)  (256  + 64 * (j))
#define XB_XSUB(j)  (1280 + 64 * (j))
#define XB_XGEN(j)  (2304 + 64 * (j))
#define XB_TOP      3328
#define XB_TOPGEN   3392
#define XCD_BAR_WORDS 3456
#define XB_SPIN_CAP (1u << 18)
DEVI unsigned xb_ld(unsigned* p)              { return __hip_atomic_load(p, __ATOMIC_RELAXED, __HIP_MEMORY_SCOPE_AGENT); }
DEVI unsigned xb_add(unsigned* p, unsigned v) { return __hip_atomic_fetch_add(p, v, __ATOMIC_RELAXED, __HIP_MEMORY_SCOPE_AGENT); }
DEVI unsigned xb_xcc_id() { return (unsigned)__builtin_amdgcn_s_getreg((3 << 11) | 20) & 0xFu; }
#define XB_SPIN(cond, bar) do { unsigned _sp = 0; while (cond) { __builtin_amdgcn_s_sleep(1); \
    if ((++_sp & 255u) == 0u) { if (xb_ld(&(bar)[XB_TMO])) break; if (_sp > XB_SPIN_CAP) { atomicAdd(&(bar)[XB_TMO], 1u); break; } } } } while (0)
DEVI void xb_complete(unsigned* bar, unsigned x, unsigned& nloc, unsigned& nx, unsigned G) {
    unsigned sum, cnt, mine, sp = 0u;
    for (;;) {
        sum = 0u; cnt = 0u; mine = 0u;
#pragma unroll
        for (unsigned j = 0; j < 16; ++j) { const unsigned c = xb_ld(&bar[XB_XCNT(j)]); sum += c; cnt += (c > 0u) ? 1u : 0u; mine = (j == x) ? c : mine; }
        if (sum == G) break;
        __builtin_amdgcn_s_sleep(1);
        if ((++sp & 255u) == 0u) { if (xb_ld(&bar[XB_TMO])) break; if (sp > XB_SPIN_CAP) { atomicAdd(&bar[XB_TMO], 1u); break; } }
    }
    nloc = mine > 0u ? mine : 1u; nx = cnt > 0u ? cnt : 1u;
}
DEVI void xbar(unsigned* bar, volatile LAS unsigned* st, int tid, unsigned G) {
    asm volatile("s_waitcnt vmcnt(0)" ::: "memory");
    __syncthreads();
    if (tid == 0) {
        const unsigned x = xb_xcc_id();
        __builtin_amdgcn_s_waitcnt(0);
        unsigned nloc = st[0], nx = st[1];
        if (nloc == 0u) { xb_complete(bar, x, nloc, nx, G); st[0] = nloc; st[1] = nx; }
        const unsigned old = xb_add(&bar[XB_XSUB(x)], 1u);
        const unsigned gen = old / nloc;
        if (old + 1u == (gen + 1u) * nloc) {
            __builtin_amdgcn_fence(__ATOMIC_RELEASE, "agent");
            asm volatile("s_waitcnt vmcnt(0)" ::: "memory");
            const unsigned og = xb_add(&bar[XB_TOP], 1u);
            const unsigned tg = og / nx;
            if (og + 1u == (tg + 1u) * nx) xb_add(&bar[XB_TOPGEN], 1u);
            else XB_SPIN(xb_ld(&bar[XB_TOPGEN]) == tg, bar);
            __builtin_amdgcn_fence(__ATOMIC_ACQUIRE, "agent");
            xb_add(&bar[XB_XGEN(x)], 1u);
            asm volatile("s_waitcnt vmcnt(0)" ::: "memory");
        } else {
            XB_SPIN(xb_ld(&bar[XB_XGEN(x)]) == gen, bar);
            __builtin_amdgcn_fence(__ATOMIC_ACQUIRE, "agent");
            asm volatile("s_waitcnt vmcnt(0)" ::: "memory");
        }
    }
    __syncthreads();
}
#ifndef PHM
#define PHM 0xFFFFFFFFu
#endif
#ifndef DBL
#define DBL 0u
#endif
#define NREP(k) (((DBL >> (k)) & 1u) ? 2 : 1)
__global__ void __launch_bounds__(512, 2) trunk_fwd(Params p) {
    extern __shared__ __attribute__((aligned(16))) unsigned char shm_raw[];
    LAS unsigned char* lds = (LAS unsigned char*)shm_raw;
    __shared__ uint4 s_ctl;
#define s_item (*(LAS int*)&s_ctl)
    cg::grid_group grid = cg::this_grid();
    const int wave_s = __builtin_amdgcn_readfirstlane((int)threadIdx.x >> 6);
    if (threadIdx.x == 0) { s_ctl = make_uint4(0u, 0u, 0u, 0u); (void)xb_add((unsigned*)(p.ws + W_BAR) + XB_XCNT(xb_xcc_id()), 1u); }
    __syncthreads();
#define GSYNC() do { const __attribute__((address_space(4))) Params* kq = (const __attribute__((address_space(4))) Params*)__builtin_amdgcn_kernarg_segment_ptr(); asm volatile("" : "+s"(kq)); \
        unsigned Gq = gridDim.x; asm volatile("" : "+s"(Gq)); xbar((unsigned*)(kq->ws + W_BAR), (volatile LAS unsigned*)&s_ctl + 1, wave_s * 64 + opaque_lane(), Gq); } while (0)
#define PH_BEGIN \
    int tid = wave_s * 64 + opaque_lane(); asm volatile("" : "+v"(tid)); \
    int bid = blockIdx.x, G = gridDim.x, lq = l; asm volatile("" : "+s"(bid), "+s"(G), "+s"(lq)); \
    const int lane = tid & 63, wave = __builtin_amdgcn_readfirstlane(tid >> 6); \
    const int gw = bid * 8 + wave, NGW = G * 8; const size_t gtid = (size_t)bid * 512 + tid, NGT = (size_t)G * 512; \
    const __attribute__((address_space(4))) Params* kp = (const __attribute__((address_space(4))) Params*)__builtin_amdgcn_kernarg_segment_ptr(); asm volatile("" : "+s"(kp)); \
    unsigned char* ws = kp->ws; float* out = kp->out; \
    (void)lane; (void)wave; (void)gw; (void)NGW; (void)gtid; (void)NGT; (void)out; (void)lq;
#define WSP(T, off) ((T*)(ws + (off)))
    for (int rep = 0; rep < NREP(0); ++rep) if (PHM & 1u) {
        int tid = wave_s * 64 + opaque_lane(); asm volatile("" : "+v"(tid));
        const int bid = blockIdx.x, G = gridDim.x, lane = tid & 63, wave = __builtin_amdgcn_readfirstlane(tid >> 6);
        const int gw = bid * 8 + wave, NGW = G * 8; const size_t gtid = (size_t)bid * 512 + tid, NGT = (size_t)G * 512;
        unsigned char* ws = p.ws;
        h16* xh = WSP(h16, W_XH); float* ropec = WSP(float, W_ROPE); float* ropes = ropec + NPOS * 16;
        for (size_t i = gtid; i < (size_t)MT * DM / 8; i += NGT) { const size_t e = i * 8; const float* src = e < (size_t)MP * DM ? p.in[0] + e : p.in[1] + (e - (size_t)MP * DM);
            *(h8*)(xh + e) = pack8(*(const f4*)src, *(const f4*)(src + 4)); }
        for (size_t i = gtid; i < (size_t)NPOS * 16; i += NGT) { const int pi = (int)(i >> 4), fi = (int)(i & 15); const double pos = pi < SEQ ? (double)pi : (double)(PAST + pi - SEQ);
            const double ang = pos * exp(-(double)fi / 16.0 * 9.210340371976184); ropec[i] = (float)cos(ang); ropes[i] = (float)sin(ang); }
        for (size_t i = gtid; i < (size_t)DEPTH * 256; i += NGT) WSP(float, W_SP)[i] = log1pf(expf(-p.in[26][i]));
        LAS float* scr = (LAS float*)(lds + wave * 8448);
        for (int l = 0; l < DEPTH; ++l) {
            h16* wt_in = WSP(h16, W_WIN + l * SZ_WIN); h16* wt_uq = WSP(h16, W_WUQ + l * SZ_WUQ); h16* wt_kv = WSP(h16, W_WKV + l * SZ_WKV);
            h16* wt_o = WSP(h16, W_WO + l * SZ_WO); h16* wt_os = WSP(h16, W_WOS + l * SZ_WOS); h16* wt_up = WSP(h16, W_WUP + l * SZ_WUP); h16* wt_dn = WSP(h16, W_WDN + l * SZ_WDN);
            h16* wt_ql = WSP(h16, W_WQL + l * SZ_WQL); h16* wt_g = WSP(h16, W_WG + l * SZ_WG);
            const float* w_in = p.in[11] + (size_t)l * DM * DIN; const float* w_o = p.in[12] + (size_t)l * DM * DM; const float* w_uq = p.in[16] + (size_t)l * 384 * 768;
            const float* w_uk = p.in[18] + (size_t)l * 256 * 512; const float* w_uv = p.in[19] + (size_t)l * 256 * 512; const float* w_up = p.in[27] + (size_t)l * DM * DFF2; const float* w_dn = p.in[30] + (size_t)l * DFF * DM;
            const float* w_r = p.in[22] + (size_t)l * 4 * 64 * 64; const float* w_i = p.in[24] + (size_t)l * 4 * 64 * 64;
            for (int it = gw; it < 16 * 53; it += NGW) transpose_item<0>(w_in, DIN, 53, wt_in, 1024, scr, it, lane, l > 0 ? p.in[9] + (l - 1) * DM : nullptr, l > 0 ? p.in[10] + (l - 1) * DM : nullptr, rep ? nullptr : WSP(float, W_CD + l * SZ_CD), WSP(float, W_CD + l * SZ_CD) + ZW);
            for (int it = gw; it < 6 * 24; it += NGW) transpose_item<1>(w_uq, 768, 24, wt_uq, 384, scr, it, lane);
            for (int it = gw; it < 4 * 16; it += NGW) transpose_item<0>(w_uk, 512, 16, wt_kv, 256, scr, it, lane);
            for (int it = gw; it < 4 * 16; it += NGW) transpose_item<0>(w_uv, 512, 16, wt_kv + 512 * 256, 256, scr, it, lane);
            for (int it = gw; it < 16 * 32; it += NGW) transpose_item<0>(w_o, 1024, 32, wt_o, 1024, scr, it, lane);
            for (int it = gw; it < 16 * 176; it += NGW) transpose_item<0>(w_up, DFF2, 176, wt_up, 1024, scr, it, lane, p.in[7] + l * DM, p.in[8] + l * DM, rep ? nullptr : WSP(float, W_CD + l * SZ_CD) + 2 * ZW, WSP(float, W_CD + l * SZ_CD) + 2 * ZW + DFF2);
            for (int it = gw; it < 44 * 32; it += NGW) transpose_item<0>(w_dn, 1024, 32, wt_dn, DFF, scr, it, lane);
            for (size_t i = gtid; i < (size_t)(ZW - DIN) * 1024 / 8; i += NGT) *(h8*)(wt_in + (size_t)DIN * 1024 + i * 8) = (h8){0, 0, 0, 0, 0, 0, 0, 0};
            for (size_t i = gtid; i < (size_t)512 * 256; i += NGT) { const int n = (int)(i >> 8), k = (int)(i & 255); const int pn = n >> 8, jj = n & 127, isI = (n >> 7) & 1, ch = pn * 128 + jj;
                float v = 0.f; if ((k >> 6) == (ch >> 6)) v = (isI ? w_i : w_r)[((ch >> 6) * 64 + (k & 63)) * 64 + (ch & 63)];
                wt_g[i] = (h16)v; }
            for (int it = gw; it < 8 * 24 * 16; it += NGW) { const int hh = it / (24 * 16), kt = (it / 16) % 24, ct = it % 16, fr = lane & 15, g4 = lane >> 4;
                f4 accq = (f4){0.f, 0.f, 0.f, 0.f};
#pragma unroll
                for (int ks = 0; ks < 2; ++ks) { const float* ap = w_uq + (size_t)(16 * kt + fr) * 768 + hh * 96 + 32 * ks + 8 * g4; const float* bp = w_uk + (size_t)(16 * ct + fr) * 512 + hh * 64 + 32 * ks + 8 * g4;
                    accq = __builtin_amdgcn_mfma_f32_16x16x32_f16(pack8(*(const f4*)ap, *(const f4*)(ap + 4)), pack8(*(const f4*)bp, *(const f4*)(bp + 4)), accq, 0, 0, 0); }
                *(h4*)(wt_ql + (size_t)(hh * 256 + 16 * ct + fr) * 384 + 16 * kt + 4 * g4) = pack4(accq); }
            for (size_t i = gtid; i < (size_t)8 * 64 * 256; i += NGT) { const int c = (int)(i & 255), hd = (int)(i >> 8); wt_os[i] = (h16)w_uv[(size_t)c * 512 + hd]; }
        }
    }
    grid.sync();

    for (int l = 0; l < DEPTH; ++l) {
        for (int rep = 0; rep < NREP(1); ++rep) if (PHM & (1u << 1)) { PH_BEGIN
          Gemm g{WSP(h16, W_XH), WSP(h16, W_WIN + lq * SZ_WIN), MT, ZW, 1024, 1024, 1024}; StaticOrder S; S.init(MT, ZW, G, bid); const int lp = lq > 0 ? lq - 1 : 0; EpiZ E{WSP(h16, W_Z), out + O_SV + (size_t)lq * MS * 256, WSP(float, W_STATS + (size_t)(lp * 2 + 1) * SZ_STATS), WSP(float, W_CD + lq * SZ_CD), WSP(float, W_CD + lq * SZ_CD) + ZW, lq > 0}; gemm_phase(lds, g, S, E, tid); }
        GSYNC();

        for (int rep = 0; rep < NREP(2); ++rep) if (PHM & (1u << 2)) { PH_BEGIN
            const float* qn_g = kp->in[15] + lq * 384; const float* kvn_g = kp->in[17] + lq * 256;
            const float* cw = kp->in[20] + (size_t)lq * 4 * 256; const float* cb = kp->in[21] + lq * 256; const float* stc = kp->in[5] + (size_t)lq * DBATCH * 3 * 256;
            const h16* __restrict__ z = WSP(h16, W_Z); h16* __restrict__ cqn = WSP(h16, W_CQN); h16* __restrict__ ckvn = WSP(h16, W_CKVN); h16* __restrict__ knew = WSP(h16, W_KNEW); h16* __restrict__ kb = WSP(h16, W_K); h16* __restrict__ xc = WSP(h16, W_XC);
            const float* __restrict__ ropec = WSP(float, W_ROPE); const float* __restrict__ ropes = ropec + NPOS * 16;
            for (int row = gw; row < MT; row += NGW) {
                const h16* zr = z + (size_t)row * ZW; const bool samp = row >= MP; const int rs = row - MP;
                const int t = samp ? (rs & 31) : (row & (SEQ - 1)), bb = samp ? (rs >> 5) : (row >> 11), T = samp ? DSEQ : SEQ;
                h2 xq[3];
#pragma unroll
                for (int i = 0; i < 3; ++i) xq[i] = *(const h2*)(zr + 512 + 2 * lane + 128 * i);
                const h4 xkv = *(const h4*)(zr + 896 + 4 * lane);
                const int pidx = samp ? SEQ + t : t, l16 = lane & 15;
                const float rc = ropec[pidx * 16 + l16], rsn = ropes[pidx * 16 + l16], kx1 = (float)zr[1152 + l16], kx2 = (float)zr[1168 + l16];
                const int c = 4 * lane; f4 xl[4];
#pragma unroll
                for (int j = 0; j < 4; ++j) { const int tau = t - 3 + j;
                    if (tau >= 0) { const h4 x = *(const h4*)(zr - (ptrdiff_t)(3 - j) * ZW + 1184 + c); xl[j] = (f4){(float)x[0], (float)x[1], (float)x[2], (float)x[3]}; }
                    else if (samp) xl[j] = *(const f4*)(stc + ((size_t)bb * 3 + (3 + tau)) * 256 + c);
                    else xl[j] = (f4){0.f, 0.f, 0.f, 0.f}; }
                float vq[6], ssq = 0.f, sskv = 0.f; f4 vkv;
#pragma unroll
                for (int i = 0; i < 3; ++i) { vq[2 * i] = (float)xq[i][0]; vq[2 * i + 1] = (float)xq[i][1]; ssq += vq[2 * i] * vq[2 * i] + vq[2 * i + 1] * vq[2 * i + 1]; }
#pragma unroll
                for (int e = 0; e < 4; ++e) { vkv[e] = (float)xkv[e]; sskv += vkv[e] * vkv[e]; }
#pragma unroll
                for (int o = 1; o < 64; o <<= 1) { ssq += shx(ssq, o, lane); sskv += shx(sskv, o, lane); }
                { const float rr = rsqrtf(ssq * (1.f / 384.f) + 1e-6f);
#pragma unroll
                  for (int i = 0; i < 3; ++i) { const int cc = 2 * lane + 128 * i; h2 o; o[0] = (h16)(vq[2 * i] * rr * qn_g[cc]); o[1] = (h16)(vq[2 * i + 1] * rr * qn_g[cc + 1]); *(h2*)(cqn + (size_t)row * 384 + cc) = o; } }
                { const float rr = rsqrtf(sskv * (1.f / 256.f) + 1e-6f); const f4 v = vkv * rr * *(const f4*)(kvn_g + 4 * lane);
                  if (!samp) { *(f4*)(out + O_PLAT + ((size_t)lq * MP + row) * 256 + 4 * lane) = v; *(h4*)(ckvn + (size_t)row * 256 + 4 * lane) = pack4(v); }
                  else { *(f4*)(out + O_SLAT + ((size_t)lq * MS + rs) * 256 + 4 * lane) = v; *(h4*)(knew + (size_t)rs * KNW + 4 * lane) = pack4(v); } }
                if (lane < 16) { const float o1 = kx1 * rc - kx2 * rsn, o2 = kx1 * rsn + kx2 * rc;
                    if (!samp) { float* o = out + O_PKR + ((size_t)lq * MP + row) * 32; o[lane] = o1; o[16 + lane] = o2;
                        h16* kr = kb + (size_t)row * KW + 64;
#pragma unroll
                        for (int hh = 0; hh < 8; ++hh) { kr[hh * 96 + lane] = (h16)o1; kr[hh * 96 + 16 + lane] = (h16)o2; } }
                    else { float* o = out + O_SKR + ((size_t)lq * MS + rs) * 32; o[lane] = o1; o[16 + lane] = o2; knew[(size_t)rs * KNW + 256 + lane] = (h16)o1; knew[(size_t)rs * KNW + 272 + lane] = (h16)o2; } }
                { f4 accv = *(const f4*)(cb + c);
#pragma unroll
                  for (int j = 0; j < 4; ++j) accv += xl[j] * *(const f4*)(cw + j * 256 + c);
                  if (t >= T - 3) { float* o = samp ? out + O_SLC + (((size_t)lq * DBATCH + bb) * 3 + (t - (T - 3))) * 256 : out + O_PLC + (((size_t)lq * NB + bb) * 3 + (t - (T - 3))) * 256; *(f4*)(o + c) = xl[3]; }
                  *(h4*)(xc + (size_t)row * 256 + c) = pack4(accv); }
            }
        }
        GSYNC();

        for (int rep = 0; rep < NREP(3); ++rep) if (PHM & (1u << 3)) { PH_BEGIN
          Gemm g{WSP(h16, W_CQN), WSP(h16, W_WUQ + lq * SZ_WUQ), MT, 768, 384, 384, 384}; StaticOrder S; S.init(MT, 768, G, bid);
          EpiQ E{WSP(h16, W_Q), WSP(h16, W_QLAT), WSP(float, W_ROPE), WSP(float, W_ROPE) + NPOS * 16}; gemm_phase(lds, g, S, E, tid); }
        for (int rep = 0; rep < NREP(4); ++rep) if (PHM & (1u << 4)) { PH_BEGIN
          Gemm g{WSP(h16, W_CKVN), WSP(h16, W_WKV + lq * SZ_WKV), MP, 1024, 256, 256, 256}; StaticOrder S; S.init(MP, 1024, G, (bid + G - (396 % G)) % G); EpiKV E{WSP(h16, W_K), WSP(h16, W_V)}; gemm_phase(lds, g, S, E, tid); }
        for (int rep = 0; rep < NREP(5); ++rep) if (PHM & (1u << 5)) { PH_BEGIN
          Gemm g{WSP(h16, W_XC), WSP(h16, W_WG + lq * SZ_WG), MT, 512, 256, 256, 256}; StaticOrder S; S.init(MT, 512, G, (bid + G - (908 % G)) % G);
          EpiGate E{WSP(h16, W_XC), WSP(float, W_A), WSP(float, W_B), kp->in[23] + lq * 256, kp->in[25] + lq * 256, WSP(float, W_SP) + lq * 256}; gemm_phase(lds, g, S, E, tid); }
        for (int rep = 0; rep < NREP(6); ++rep) if (PHM & (1u << 6)) { PH_BEGIN
          Gemm g{WSP(h16, W_CQN) + (size_t)MP * 384, WSP(h16, W_WQL + lq * SZ_WQL), MS, 2048, 384, 384, 384}; StaticOrder S; S.init(MS, 2048, G, (bid + G - (1172 % G)) % G); EpiQlat E{WSP(h16, W_QLAT)}; gemm_phase(lds, g, S, E, tid); }
        for (int rep = 0; rep < NREP(7); ++rep) if (PHM & (1u << 7)) { PH_BEGIN
            const float* gw_s = kp->in[13] + (size_t)lq * 4 * 128 * 128; const float* gb_s = kp->in[14] + (size_t)lq * 4 * 128;
            const h16* z = WSP(h16, W_Z); h16* cat = WSP(h16, W_CAT); h16* cats = WSP(h16, W_CATS);
            const int fr = lane & 15, g4 = lane >> 4, q_ = fr >> 2, p_ = fr & 3;
            for (int item = (bid + G - (1204 % G)) % G; item < 1024 + 128; item += G) {
                const bool samp = item >= 1024; const int head = item & 3; const int ci = samp ? (item - 1024) >> 2 : item >> 2;
                const int R0 = samp ? MP + ci * 32 : ci * 128, L = samp ? 32 : 128;
                __syncthreads();
                for (int id = tid; id < L * 8; id += 512) { const int j = id >> 3, part = id & 7; *(LAS h8*)(lds + j * 144 + part * 16) = *(const h8*)(z + (size_t)(R0 + j) * ZW + 256 + head * 64 + part * 8); }
                __syncthreads();
                const int i0 = 16 * wave;
                if (i0 < L) {
                    f4 sacc[4];
#pragma unroll
                    for (int ct = 0; ct < 4; ++ct) sacc[ct] = (f4){0.f, 0.f, 0.f, 0.f};
                    const int i = i0 + fr;
#pragma unroll
                    for (int ks = 0; ks < 4; ++ks) if (32 * ks <= i0 + 15 && 32 * ks < L) {
                        const int j0 = 32 * ks + 8 * g4; const float* wp = gw_s + ((size_t)head * 128 + i) * 128 + j0; const f4 w0 = *(const f4*)wp, w1 = *(const f4*)(wp + 4);
                        h8 wf;
#pragma unroll
                        for (int e = 0; e < 4; ++e) { wf[e] = (h16)((j0 + e <= i) ? w0[e] : 0.f); wf[4 + e] = (h16)((j0 + 4 + e <= i) ? w1[e] : 0.f); }
#pragma unroll
                        for (int ct = 0; ct < 4; ++ct) { const h4 lo = trrd(lds + (32 * ks + 8 * g4 + q_) * 144 + (16 * ct + 4 * p_) * 2), hi = trrd(lds + (32 * ks + 8 * g4 + 4 + q_) * 144 + (16 * ct + 4 * p_) * 2);
                            sacc[ct] = __builtin_amdgcn_mfma_f32_16x16x32_f16(wf, cat44(lo, hi), sacc[ct], 0, 0, 0); } }
                    float uval[4][4], bsv[4];
#pragma unroll
                    for (int jx = 0; jx < 4; ++jx) { const int ii = i0 + 4 * g4 + jx; bsv[jx] = gb_s[head * 128 + ii];
#pragma unroll
                        for (int ct = 0; ct < 4; ++ct) uval[jx][ct] = (float)z[((size_t)R0 + ii) * ZW + head * 64 + 16 * ct + fr]; }
#pragma unroll
                    for (int jx = 0; jx < 4; ++jx) { const size_t r = (size_t)R0 + i0 + 4 * g4 + jx;
#pragma unroll
                        for (int ct = 0; ct < 4; ++ct) cat[r * 1024 + head * 64 + 16 * ct + fr] = (h16)(uval[jx][ct] * (sacc[ct][jx] + bsv[jx])); }
                }
            }
            __syncthreads();
        }
        GSYNC();

        for (int rep = 0; rep < NREP(8); ++rep) if (PHM & (1u << 8)) { PH_BEGIN
            unsigned* counter = WSP(unsigned, W_CTR) + lq * 16 + rep * 8;
            constexpr int N_SA = 256, N_PA = 1024, N_PS = 128, N_SS = 16, N_WO = 16, N_UP = 88, N_ALL = N_SA + N_PA + N_PS + N_SS + N_WO + N_UP, Q_WO = N_PS + N_SS + N_SA + 256, Q_UP = Q_WO + N_WO + 256;
            unsigned* wdone = WSP(unsigned, W_CTR) + 800 + lq * 8 + rep * 4;
            unsigned* sdone = WSP(unsigned, W_CTR) + 768 + lq * 2 + rep;
            for (;;) {
                __syncthreads();
                if (tid == 0) s_item = (int)atomicAdd(counter, 1u);
                __syncthreads();
                const int qi = s_item;
                if (qi >= N_ALL) break;
                int tix = tid; asm volatile("" : "+v"(tix));
                const int ln = tix & 63, fr = ln & 15, g4 = ln >> 4;
                const int qj = qi < Q_WO ? qi : (qi < Q_WO + N_WO ? -1 : (qi < Q_UP ? qi - N_WO : (qi < Q_UP + N_UP ? -2 : qi - N_WO - N_UP)));
                const int item = qj < 0 ? qj : (qj < N_PS + N_SS ? qj + N_SA + N_PA : qj - (N_PS + N_SS));
                if (item == -2) {
                    const int ui = qi - Q_UP, pnl = ui / 22, pnc = ui - pnl * 22;
                    if (tix == 0) { unsigned sp = 0; while (xb_ld(wdone + pnl) < 4u) { __builtin_amdgcn_s_sleep(4); if (++sp > (1u << 22)) break; }
                        __builtin_amdgcn_fence(__ATOMIC_ACQUIRE, "agent"); asm volatile("s_waitcnt vmcnt(0)" ::: "memory"); }
                    __syncthreads();
                    const int ro = (MP / BM + pnl) * BM;
                    Gemm g{WSP(h16, W_XH) + (size_t)ro * DM, WSP(h16, W_WUP + lq * SZ_WUP), BM, DFF2, 1024, 1024, 1024}; StaticOrder S; S.init(BM, DFF2, 22, pnc);
                    EpiUp E{WSP(h16, W_UP), ro};
                    gemm_phase(lds, g, S, E, tix);
                } else if (item < 0) {
                    if (tix == 0) { unsigned sp = 0; while (xb_ld(sdone) < 80u) { __builtin_amdgcn_s_sleep(4); if (++sp > (1u << 22)) break; }
                        __builtin_amdgcn_fence(__ATOMIC_ACQUIRE, "agent"); asm volatile("s_waitcnt vmcnt(0)" ::: "memory"); }
                    __syncthreads();
                    const int wi = qi - Q_WO, lp = lq > 0 ? lq - 1 : 0; const size_t ro = (size_t)(MP / BM + (wi >> 2)) * BM;
                    Gemm g{WSP(h16, W_CAT) + ro * 1024, WSP(h16, W_WO + lq * SZ_WO), BM, 1024, 1024, 1024, 1024}; StaticOrder S; S.init(BM, 1024, 4, wi & 3);
                    EpiRes E{WSP(h16, W_XH) + ro * DM, WSP(float, W_STATS + (size_t)(lp * 2 + 1) * SZ_STATS) + 2 * ro, kp->in[9] + lp * DM, kp->in[10] + lp * DM, lq > 0, WSP(float, W_STATS + (size_t)(lq * 2) * SZ_STATS) + 2 * ro};
                    gemm_phase(lds, g, S, E, tix);
                    __syncthreads();
                    if (tix == 0) { __builtin_amdgcn_fence(__ATOMIC_RELEASE, "agent"); asm volatile("s_waitcnt vmcnt(0)" ::: "memory"); (void)xb_add(wdone + (wi >> 2), 1u); }
                } else if (item < N_SA) {
                    constexpr int KS = 608;
                    const float* clat = kp->in[2] + (size_t)lq * DBATCH * PAST * 256; const float* ckr = kp->in[3] + (size_t)lq * DBATCH * PAST * 32;
                    const h16* qlat = WSP(h16, W_QLAT); const h16* knew = WSP(h16, W_KNEW); h16* cats = WSP(h16, W_CATS);
                    const int b = item >> 3, hg = (item >> 2) & 1, sp = item & 3, head = 4 * hg + (wave >> 1), tq = 16 * (wave & 1) + fr, t0 = sp * 16;
                    h8 qf[1][9];
#pragma unroll
                    for (int ks = 0; ks < 9; ++ks) qf[0][ks] = *(const h8*)(qlat + (size_t)(b * 32 + tq) * QLW + head * 288 + 32 * ks + 8 * g4);
                    f4 o[1][16]; float mrow[1] = {-1e30f}, lrow[1] = {0.f};
#pragma unroll
                    for (int ct = 0; ct < 16; ++ct) o[0][ct] = (f4){0.f, 0.f, 0.f, 0.f};
                    const float* lb = clat + (size_t)b * PAST * 256 + (size_t)(t0 * 64 + (tix >> 6)) * 256 + (tix & 63) * 4; const float* rb = ckr + (size_t)b * PAST * 32 + (size_t)(t0 * 64 + (tix >> 3)) * 32 + (tix & 7) * 4;
                    const int wl = (tix >> 6) * KS + (tix & 63) * 8, wr_ = (tix >> 3) * KS + 512 + (tix & 7) * 8;
                    f4 pl[4]; f4 pr;
#pragma unroll
                    for (int hf = 0; hf < 2; ++hf) {
#pragma unroll
                        for (int i = 0; i < 4; ++i) pl[i] = *(const f4*)(lb + (size_t)(hf * 4 + i) * 8 * 256);
#pragma unroll
                        for (int i = 0; i < 4; ++i) *(LAS h4*)(lds + wl + (hf * 4 + i) * 8 * KS) = pack4(pl[i]); }
                    pr = *(const f4*)rb;
                    *(LAS h4*)(lds + wr_) = pack4(pr);
                    __syncthreads();
                    for (int t = 0; t < 16; ++t) {
                        LAS unsigned char* cur = lds + (t & 1) * (64 * KS); LAS unsigned char* nxt = lds + ((t + 1) & 1) * (64 * KS);
                        const bool more = t + 1 < 16;
                        if (more) {
#pragma unroll
                            for (int i = 0; i < 4; ++i) pl[i] = *(const f4*)(lb + ((size_t)(t + 1) * 64 + i * 8) * 256);
                            pr = *(const f4*)(rb + (size_t)(t + 1) * 64 * 32);
                        }
                        h8 pf[1][2];
                        attn_qk<9, 16, 1, KS>(cur, qf, o, mrow, lrow, pf, 4, ln);
                        if (more) {
#pragma unroll
                            for (int i = 0; i < 4; ++i) *(LAS h4*)(nxt + wl + i * 8 * KS) = pack4(pl[i]);
                            *(LAS h4*)(nxt + wr_) = pack4(pr);
#pragma unroll
                            for (int i = 0; i < 4; ++i) pl[i] = *(const f4*)(lb + ((size_t)(t + 1) * 64 + (4 + i) * 8) * 256);
                        }
                        attn_pv<16, 1, KS>(cur, o, pf, 4, ln);
                        if (more) {
#pragma unroll
                            for (int i = 0; i < 4; ++i) *(LAS h4*)(nxt + wl + (4 + i) * 8 * KS) = pack4(pl[i]);
                        } else if (sp == 3) {
                            for (int id = tix; id < 32 * 36; id += 512) { const int key = id / 36, part = id % 36; *(LAS h8*)(nxt + key * KS + part * 16) = *(const h8*)(knew + (size_t)(b * 32 + key) * KNW + part * 8); }
                        }
                        __syncthreads();
                    }
                    if (sp == 3) attn_tile<9, 16, 1, KS, KS>(lds, lds, qf, o, mrow, lrow, 2, ln);
                    { unsigned char* pw = ws + W_PART + ((size_t)item * 8 + wave) * SZ_PARTW;
#pragma unroll
                      for (int ct = 0; ct < 16; ++ct) *(f4*)(pw + ct * 1024 + ln * 16) = o[0][ct];
                      *(float*)(pw + 16384 + ln * 4) = mrow[0]; *(float*)(pw + 16640 + ln * 4) = lrow[0]; }
                    asm volatile("s_waitcnt vmcnt(0)" ::: "memory");
                    __syncthreads();
                    if (tix == 0) { __builtin_amdgcn_fence(__ATOMIC_RELEASE, "agent"); asm volatile("s_waitcnt vmcnt(0)" ::: "memory");
                        const unsigned old = xb_add(WSP(unsigned, W_CTR) + 256 + lq * 64 + rep * 512 + (item >> 2), 1u);
                        if (old == 3u) { __builtin_amdgcn_fence(__ATOMIC_ACQUIRE, "agent"); asm volatile("s_waitcnt vmcnt(0)" ::: "memory"); }
                        *((LAS int*)&s_ctl + 3) = (int)old; }
                    __syncthreads();
                    if (*((LAS int*)&s_ctl + 3) == 3) {
                        const unsigned char* p0 = ws + W_PART + ((size_t)(item & ~3) * 8 + wave) * SZ_PARTW;
                        float mi[4], M = -1e30f;
#pragma unroll
                        for (int i = 0; i < 4; ++i) { mi[i] = *(const float*)(p0 + (size_t)i * 8 * SZ_PARTW + 16384 + ln * 4); M = fmaxf(M, mi[i]); }
                        float L = 0.f;
#pragma unroll
                        for (int i = 0; i < 4; ++i) { mi[i] = __builtin_amdgcn_exp2f(mi[i] - M); L += mi[i] * *(const float*)(p0 + (size_t)i * 8 * SZ_PARTW + 16640 + ln * 4); }
                        L += shx(L, 16, ln); L += shx(L, 32, ln); const float inv = 1.f / L;
                        h8 bf[8];
#pragma unroll
                        for (int ks = 0; ks < 8; ++ks) { f4 u0 = (f4){0.f, 0.f, 0.f, 0.f}, u1 = u0;
#pragma unroll
                            for (int i = 0; i < 4; ++i) { u0 += *(const f4*)(p0 + (size_t)i * 8 * SZ_PARTW + (2 * ks) * 1024 + ln * 16) * mi[i]; u1 += *(const f4*)(p0 + (size_t)i * 8 * SZ_PARTW + (2 * ks + 1) * 1024 + ln * 16) * mi[i]; }
                            bf[ks] = pack8(u0 * inv, u1 * inv); }
                        const h16* wuvt = WSP(h16, W_WOS + lq * SZ_WOS) + (size_t)head * 64 * 256;
                        h16* dst = cats + (size_t)(b * 32 + tq) * 1024 + 256 + head * 64 + 4 * g4;
#pragma unroll
                        for (int dt = 0; dt < 4; ++dt) { f4 od = (f4){0.f, 0.f, 0.f, 0.f};
#pragma unroll
                            for (int ks = 0; ks < 8; ++ks) { const h16* wp = wuvt + (size_t)(16 * dt + fr) * 256 + 32 * ks + 4 * g4;
                                od = __builtin_amdgcn_mfma_f32_16x16x32_f16(cat44(*(const h4*)wp, *(const h4*)(wp + 16)), bf[ks], od, 0, 0, 0); }
                            *(h4*)(dst + 16 * dt) = pack4(od); }
                        asm volatile("s_waitcnt vmcnt(0)" ::: "memory"); __syncthreads();
                        if (tix == 0) { __builtin_amdgcn_fence(__ATOMIC_RELEASE, "agent"); asm volatile("s_waitcnt vmcnt(0)" ::: "memory"); (void)xb_add(sdone, 1u); }
                    }
                } else if (item < N_SA + N_PA) {
                    constexpr int KS = 224, VS = 160, KBUF = 64 * KS, VBUF = 64 * VS;
                    const h16* qb = WSP(h16, W_Q); const h16* kb = WSP(h16, W_K); const h16* vb = WSP(h16, W_V); h16* cat = WSP(h16, W_CAT);
                    const int it = item - N_SA, qblk = 7 - (it >> 7), bh = it & 127, b = bh >> 3, head = bh & 7;
                    const int r0 = qblk * 256 + 32 * wave, ntw = (r0 >> 6) + 1, ntb = 4 * (qblk + 1);
                    h8 qf[2][3];
#pragma unroll
                    for (int qs = 0; qs < 2; ++qs)
#pragma unroll
                        for (int ks = 0; ks < 3; ++ks) qf[qs][ks] = *(const h8*)(qb + (size_t)(b * SEQ + r0 + 16 * qs + fr) * QW + head * 96 + 32 * ks + 8 * g4);
                    f4 o[2][4]; float mrow[2] = {-1e30f, -1e30f}, lrow[2] = {0.f, 0.f};
#pragma unroll
                    for (int qs = 0; qs < 2; ++qs)
#pragma unroll
                        for (int ct = 0; ct < 4; ++ct) o[qs][ct] = (f4){0.f, 0.f, 0.f, 0.f};
                    const int k0key = tix / 12, k0part = tix % 12, k1key = (tix + 512) / 12, k1part = (tix + 512) % 12, vkey = tix >> 3, vpart = tix & 7;
                    const h16* kg0 = kb + (size_t)b * SEQ * KW + head * 96 + (size_t)k0key * KW + k0part * 8; const h16* kg1 = kb + (size_t)b * SEQ * KW + head * 96 + (size_t)k1key * KW + k1part * 8;
                    const h16* vg = vb + (size_t)b * SEQ * VW + head * 64 + (size_t)vkey * VW + vpart * 8;
                    const int lk0 = k0key * KS + k0part * 16, lk1 = k1key * KS + k1part * 16, lv = 2 * KBUF + vkey * VS + vpart * 16;
                    h8 pk0, pk1 = (h8){0, 0, 0, 0, 0, 0, 0, 0}, pv;
                    pk0 = *(const h8*)kg0; if (tix < 256) pk1 = *(const h8*)kg1; pv = *(const h8*)vg;
                    *(LAS h8*)(lds + lk0) = pk0; if (tix < 256) *(LAS h8*)(lds + lk1) = pk1; *(LAS h8*)(lds + lv) = pv;
                    __syncthreads();
                    for (int t = 0; t < ntb; ++t) {
                        const int co = (t & 1), no = ((t + 1) & 1);
                        if (t + 1 < ntb) { const size_t ro = (size_t)(t + 1) * 64;
                            pk0 = *(const h8*)(kg0 + ro * KW); if (tix < 256) pk1 = *(const h8*)(kg1 + ro * KW); pv = *(const h8*)(vg + ro * VW); }
                        if (t < ntw) attn_tile<3, 4, 2, KS, VS>(lds + co * KBUF, lds + 2 * KBUF + co * VBUF, qf, o, mrow, lrow, 4, ln);
                        if (t + 1 < ntb) { *(LAS h8*)(lds + no * KBUF + lk0) = pk0; if (tix < 256) *(LAS h8*)(lds + no * KBUF + lk1) = pk1; *(LAS h8*)(lds + no * VBUF + lv) = pv; }
                        __syncthreads();
                    }
#pragma unroll
                    for (int qs = 0; qs < 2; ++qs) { float lt = lrow[qs]; lt += shx(lt, 16, ln); lt += shx(lt, 32, ln); const float inv = 1.f / lt;
                        h16* dst = cat + (size_t)(b * SEQ + r0 + 16 * qs + fr) * 1024 + 256 + head * 64 + 4 * g4;
#pragma unroll
                        for (int ct = 0; ct < 4; ++ct) *(h4*)(dst + 16 * ct) = pack4(o[qs][ct] * inv); }
                } else if (item < N_SA + N_PA + N_PS) {
                    const float* abuf = WSP(float, W_A); const float* bbuf = WSP(float, W_B); const h16* z = WSP(h16, W_Z); h16* cat = WSP(h16, W_CAT);
                    const int it = item - N_SA - N_PA, b = it >> 3, ch = (it & 7) * 32 + (ln & 31), seg = wave * 2 + (ln >> 5), tl = seg * 32 + (ln & 31);
                    const size_t rbase = (size_t)b * SEQ + seg * 128;
                    float A = 1.f, B = 0.f;
#pragma unroll 16
                    for (int i = 0; i < 128; ++i) { const float a = abuf[(rbase + i) * 256 + ch], bb = bbuf[(rbase + i) * 256 + ch]; B = a * B + bb; A *= a; }
                    LAS float* sA = (LAS float*)lds; LAS float* sB = sA + 512;
                    sA[tl] = A; sB[tl] = B;
                    __syncthreads();
                    float h = 0.f;
                    for (int s2 = 0; s2 < seg; ++s2) h = sA[s2 * 32 + (ln & 31)] * h + sB[s2 * 32 + (ln & 31)];
                    for (int i0 = 0; i0 < 128; i0 += 16) { float av[16], bv[16], gv[16];
#pragma unroll
                        for (int k = 0; k < 16; ++k) { av[k] = abuf[(rbase + i0 + k) * 256 + ch]; bv[k] = bbuf[(rbase + i0 + k) * 256 + ch]; gv[k] = (float)z[(rbase + i0 + k) * ZW + 1440 + ch]; }
#pragma unroll
                        for (int k = 0; k < 16; ++k) { h = av[k] * h + bv[k]; cat[(rbase + i0 + k) * 1024 + 768 + ch] = (h16)(h * gv[k]); } }
                    if (seg == 15) out[O_PH + ((size_t)lq * NB + b) * 256 + ch] = h;
                } else {
                    const float* abuf = WSP(float, W_A); const float* bbuf = WSP(float, W_B); const h16* z = WSP(h16, W_Z); h16* cats = WSP(h16, W_CATS);
                    const int it = item - N_SA - N_PA - N_PS, idx = it * 512 + tix, b = idx >> 8, ch = idx & 255;
                    float h = kp->in[4][((size_t)lq * DBATCH + b) * 256 + ch];
                    for (int t0 = 0; t0 < DSEQ; t0 += 16) { float av[16], bv[16], gv[16];
#pragma unroll
                        for (int k = 0; k < 16; ++k) { const size_t r = (size_t)MP + b * 32 + t0 + k; av[k] = abuf[r * 256 + ch]; bv[k] = bbuf[r * 256 + ch]; gv[k] = (float)z[r * ZW + 1440 + ch]; }
#pragma unroll
                        for (int k = 0; k < 16; ++k) { h = av[k] * h + bv[k]; cats[(size_t)(b * 32 + t0 + k) * 1024 + 768 + ch] = (h16)(h * gv[k]); } }
                    out[O_SH + ((size_t)lq * DBATCH + b) * 256 + ch] = h;
                    asm volatile("s_waitcnt vmcnt(0)" ::: "memory"); __syncthreads();
                    if (tix == 0) { __builtin_amdgcn_fence(__ATOMIC_RELEASE, "agent"); asm volatile("s_waitcnt vmcnt(0)" ::: "memory"); (void)xb_add(sdone, 1u); }
                }
            }
        }
        GSYNC();

        for (int rep = 0; rep < NREP(9); ++rep) if (PHM & (1u << 9)) { PH_BEGIN
          conv_gate_items((unsigned)((MP / 4) * (DFF / 8)) + (unsigned)gtid, (unsigned)((MT / 4) * (DFF / 8)), (unsigned)NGT, 4, ConvP{WSP(h16, W_UP), WSP(h16, W_ACT), kp->in[28] + (size_t)lq * 3 * DFF2, kp->in[29] + (size_t)lq * DFF2, kp->in[6] + (size_t)lq * DBATCH * 2 * DFF2, WSP(float, W_STATS + (size_t)(lq * 2) * SZ_STATS), WSP(float, W_CD + lq * SZ_CD) + 2 * ZW, WSP(float, W_CD + lq * SZ_CD) + 2 * ZW + DFF2, out + O_PFC + (size_t)lq * NB * 2 * DFF2, (O_SFC + (size_t)lq * DBATCH * 2 * DFF2) - (O_PFC + (size_t)lq * NB * 2 * DFF2)});
          const int lp = lq > 0 ? lq - 1 : 0;
          Gemm g{WSP(h16, W_CAT), WSP(h16, W_WO + lq * SZ_WO), MP, 1024, 1024, 1024, 1024}; StaticOrder S; S.init(MP, 1024, G, bid);
          EpiRes E{WSP(h16, W_XH), WSP(float, W_STATS + (size_t)(lp * 2 + 1) * SZ_STATS), kp->in[9] + lp * DM, kp->in[10] + lp * DM, lq > 0, WSP(float, W_STATS + (size_t)(lq * 2) * SZ_STATS)}; gemm_phase(lds, g, S, E, tid); }
        GSYNC();

        for (int rep = 0; rep < NREP(12); ++rep) if (PHM & (1u << 12)) { PH_BEGIN
          Gemm g{WSP(h16, W_XH), WSP(h16, W_WUP + lq * SZ_WUP), MP, DFF2, 1024, 1024, 1024}; StaticOrder S; S.init(MP, DFF2, G, bid);
          EpiUp E{WSP(h16, W_UP), 0}; gemm_phase(lds, g, S, E, tid); }
        GSYNC();

        for (int rep = 0; rep < NREP(13); ++rep) if (PHM & (1u << 13)) { PH_BEGIN
            if (bid < 16) { const size_t ro = (size_t)(MP / BM + (bid >> 2)) * BM;
                Gemm g{WSP(h16, W_ACT) + ro * DFF, WSP(h16, W_WDN + lq * SZ_WDN), BM, 1024, DFF, DFF, DFF}; StaticOrder S; S.init(BM, 1024, 4, bid & 3);
                EpiRes E{WSP(h16, W_XH) + ro * DM, WSP(float, W_STATS + (size_t)(lq * 2) * SZ_STATS) + 2 * ro, kp->in[7] + lq * DM, kp->in[8] + lq * DM, true, WSP(float, W_STATS + (size_t)(lq * 2 + 1) * SZ_STATS) + 2 * ro}; gemm_phase(lds, g, S, E, tid); }
            else conv_gate_items((unsigned)(gtid - 16 * 512), (unsigned)((DFF / 8) * (MP / 32)), (unsigned)(NGT - 16 * 512), 32, ConvP{WSP(h16, W_UP), WSP(h16, W_ACT), kp->in[28] + (size_t)lq * 3 * DFF2, kp->in[29] + (size_t)lq * DFF2, kp->in[6] + (size_t)lq * DBATCH * 2 * DFF2, WSP(float, W_STATS + (size_t)(lq * 2) * SZ_STATS), WSP(float, W_CD + lq * SZ_CD) + 2 * ZW, WSP(float, W_CD + lq * SZ_CD) + 2 * ZW + DFF2, out + O_PFC + (size_t)lq * NB * 2 * DFF2, (O_SFC + (size_t)lq * DBATCH * 2 * DFF2) - (O_PFC + (size_t)lq * NB * 2 * DFF2)}); }
        GSYNC();

        for (int rep = 0; rep < NREP(14); ++rep) if (PHM & (1u << 14)) { PH_BEGIN
          Gemm g{WSP(h16, W_ACT), WSP(h16, W_WDN + lq * SZ_WDN), MP, 1024, DFF, DFF, DFF}; StaticOrder S; S.init(MP, 1024, G, bid); EpiRes E{WSP(h16, W_XH), WSP(float, W_STATS + (size_t)(lq * 2) * SZ_STATS), kp->in[7] + lq * DM, kp->in[8] + lq * DM, true, WSP(float, W_STATS + (size_t)(lq * 2 + 1) * SZ_STATS)}; gemm_phase(lds, g, S, E, tid); }
        GSYNC();

    }
    { const int l = DEPTH - 1; PH_BEGIN
        const float* gg = kp->in[9] + lq * DM; const float* bb = kp->in[10] + lq * DM; const h16* pre2 = WSP(h16, W_XH); const float* st = WSP(float, W_STATS + (size_t)(lq * 2 + 1) * SZ_STATS);
        for (size_t i0 = gtid; i0 < (size_t)MT * (DM / 4); i0 += 4 * NGT) { h4 xv[4]; float sm[4], sq[4];
#pragma unroll
            for (int u = 0; u < 4; ++u) { const size_t i = i0 + u * NGT; if (i < (size_t)MT * (DM / 4)) { const int row = (int)(i >> 8), c = (int)(i & 255) * 4; xv[u] = *(const h4*)(pre2 + (size_t)row * DM + c); sm[u] = st[2 * row]; sq[u] = st[2 * row + 1]; } }
#pragma unroll
            for (int u = 0; u < 4; ++u) { const size_t i = i0 + u * NGT; if (i < (size_t)MT * (DM / 4)) { const int row = (int)(i >> 8), c = (int)(i & 255) * 4;
                const float mean = sm[u] * (1.f / DM), rstd = rsqrtf(sq[u] * (1.f / DM) - mean * mean + 1e-5f);
                *(f4*)(out + O_Y + (size_t)row * DM + c) = ((f4){(float)xv[u][0], (float)xv[u][1], (float)xv[u][2], (float)xv[u][3]} - mean) * rstd * *(const f4*)(gg + c) + *(const f4*)(bb + c); } } }
    }
}

extern "C" void kernel_launch(void* const* d_in, const int* in_sizes, int n_in, void* d_out, int out_size, void* d_ws, size_t ws_size, hipStream_t stream) {
    constexpr size_t kDynLds = STAGE_BYTES;
    static int grid_blocks = 0;
    if (!grid_blocks) {
        if (n_in != 31 || (size_t)out_size != O_END || ws_size < W_END) { fprintf(stderr, "kernel_launch: unexpected shapes n_in %d out %d ws %zu (need %zu)\n", n_in, out_size, ws_size, (size_t)W_END); grid_blocks = -1; return; }
        int dev = 0, cus = 0, per_cu = 0;
        hipGetDevice(&dev);
        hipDeviceGetAttribute(&cus, hipDeviceAttributeMultiprocessorCount, dev);
        hipFuncSetAttribute((const void*)trunk_fwd, hipFuncAttributeMaxDynamicSharedMemorySize, (int)kDynLds);
        hipOccupancyMaxActiveBlocksPerMultiprocessor(&per_cu, (const void*)trunk_fwd, 512, kDynLds);
        if (per_cu < 1) per_cu = 1;
        grid_blocks = cus * per_cu;
        if (grid_blocks > 256) grid_blocks = 256;
        if (grid_blocks < 32) { fprintf(stderr, "kernel_launch: grid %d too small\n", grid_blocks); grid_blocks = -1; return; }
    }
    if (grid_blocks < 0) return;
    hipMemsetAsync((char*)d_ws + W_CTR, 0, W_ZERO_END, stream);
    Params p{};
    for (int i = 0; i < 31; ++i) p.in[i] = (const float*)d_in[i];
    p.out = (float*)d_out; p.ws = (unsigned char*)d_ws;
    void* args[] = {&p};
    hipError_t e = hipLaunchCooperativeKernel((const void*)trunk_fwd, dim3(grid_blocks), dim3(512), args, kDynLds, stream);
    if (e != hipSuccess) fprintf(stderr, "cooperative launch failed: %s (grid %d)\n", hipGetErrorString(e), grid_blocks);
}
```

```cpp
#include <hip/hip_runtime.h>
#include <hip/hip_cooperative_groups.h>
#include <cstdio>
#include <cstdint>
namespace cg = cooperative_groups;

typedef _Float16 h16;
typedef _Float16 h8 __attribute__((ext_vector_type(8)));
typedef _Float16 h4 __attribute__((ext_vector_type(4)));
typedef _Float16 h2 __attribute__((ext_vector_type(2)));
typedef float f4 __attribute__((ext_vector_type(4)));
typedef short s4v __attribute__((__vector_size__(8)));
#define LAS __attribute__((address_space(3)))
#define DEVI __device__ __forceinline__

constexpr int DM = 1024, NB = 16, SEQ = 2048, DEPTH = 4, DBATCH = 32, DSEQ = 32, PAST = 4096;
constexpr int MP = NB * SEQ, MS = DBATCH * DSEQ, MT = MP + MS;
constexpr int DIN = 1696, ZW = 1792, DFF = 2816, DFF2 = 5632;
constexpr int QW = 768, KW = 768, VW = 512, QLW = 2304, CSW = 2560, KNW = 288;
constexpr float ALPHA = 1.681792830507429f;
constexpr float QSCALE = 0.14724444f;
constexpr int NPOS = SEQ + DSEQ;

constexpr size_t O_Y = 0;
constexpr size_t O_PLAT = (size_t)MT * DM;
constexpr size_t O_PKR = O_PLAT + (size_t)DEPTH * MP * 256;
constexpr size_t O_PH = O_PKR + (size_t)DEPTH * MP * 32;
constexpr size_t O_PLC = O_PH + (size_t)DEPTH * NB * 256;
constexpr size_t O_PFC = O_PLC + (size_t)DEPTH * NB * 3 * 256;
constexpr size_t O_SLAT = O_PFC + (size_t)DEPTH * NB * 2 * DFF2;
constexpr size_t O_SKR = O_SLAT + (size_t)DEPTH * MS * 256;
constexpr size_t O_SV = O_SKR + (size_t)DEPTH * MS * 32;
constexpr size_t O_SH = O_SV + (size_t)DEPTH * MS * 256;
constexpr size_t O_SLC = O_SH + (size_t)DEPTH * DBATCH * 256;
constexpr size_t O_SFC = O_SLC + (size_t)DEPTH * DBATCH * 3 * 256;
constexpr size_t O_END = O_SFC + (size_t)DEPTH * DBATCH * 2 * DFF2;

constexpr size_t al(size_t x) { return (x + 255) & ~(size_t)255; }
constexpr size_t W_CTR = 0;
constexpr size_t W_PARAMS = 2048;
constexpr size_t W_BAR = 4096;
constexpr size_t W_CD = 4096 + 16384;
constexpr size_t SZ_CD = (size_t)(2 * ZW + 2 * DFF2) * 4;
constexpr size_t W_STATS = W_CD + DEPTH * SZ_CD;
constexpr size_t SZ_STATS = (size_t)MT * 2 * 4;
constexpr size_t W_ZERO_END = W_STATS + (size_t)DEPTH * 2 * SZ_STATS;
constexpr size_t W_ROPE = al(W_ZERO_END);
constexpr size_t W_SP = al(W_ROPE + (size_t)NPOS * 16 * 2 * 4);
constexpr size_t W_WIN = al(W_SP + (size_t)DEPTH * 256 * 4);
constexpr size_t SZ_WIN = (size_t)ZW * 1024 * 2;
constexpr size_t W_WUQ = W_WIN + DEPTH * SZ_WIN;   constexpr size_t SZ_WUQ = (size_t)768 * 384 * 2;
constexpr size_t W_WQL = W_WUQ + DEPTH * SZ_WUQ;   constexpr size_t SZ_WQL = (size_t)2048 * 384 * 2;
constexpr size_t W_WKV = W_WQL + DEPTH * SZ_WQL;   constexpr size_t SZ_WKV = (size_t)1024 * 256 * 2;
constexpr size_t W_WG = W_WKV + DEPTH * SZ_WKV;    constexpr size_t SZ_WG = (size_t)512 * 256 * 2;
constexpr size_t W_WO = W_WG + DEPTH * SZ_WG;      constexpr size_t SZ_WO = (size_t)1024 * 1024 * 2;
constexpr size_t W_WOS = W_WO + DEPTH * SZ_WO;     constexpr size_t SZ_WOS = (size_t)8 * 64 * 256 * 2;
constexpr size_t W_WUP = W_WOS + DEPTH * SZ_WOS;   constexpr size_t SZ_WUP = (size_t)DFF2 * 1024 * 2;
constexpr size_t W_WDN = W_WUP + DEPTH * SZ_WUP;   constexpr size_t SZ_WDN = (size_t)1024 * DFF * 2;
constexpr size_t W_XH = W_WDN + DEPTH * SZ_WDN;
constexpr size_t W_Z = W_XH + (size_t)MT * 1024 * 2;
constexpr size_t W_CQN = W_Z + (size_t)MT * ZW * 2;
constexpr size_t W_CKVN = W_CQN + (size_t)MT * 384 * 2;
constexpr size_t W_XC = W_CKVN + (size_t)MP * 256 * 2;
constexpr size_t W_Q = W_XC + (size_t)MT * 256 * 2;
constexpr size_t W_K = W_Q + (size_t)MP * QW * 2;
constexpr size_t W_V = W_K + (size_t)MP * KW * 2;
constexpr size_t W_A = W_V + (size_t)MP * VW * 2;
constexpr size_t W_B = W_A + (size_t)MT * 256 * 4;
constexpr size_t W_CAT = W_B + (size_t)MT * 256 * 4;
constexpr size_t W_CATS = W_CAT + (size_t)MP * 1024 * 2;
constexpr size_t W_QLAT = W_CATS + (size_t)MS * 1024 * 2;
constexpr size_t W_KNEW = W_QLAT + (size_t)MS * QLW * 2;
constexpr size_t W_PRE = al(W_KNEW + (size_t)MS * KNW * 2);
constexpr size_t W_X1F = W_PRE + (size_t)MT * 1024 * 4;
constexpr size_t W_UP = W_X1F + (size_t)MT * 1024 * 4;
constexpr size_t W_ACT = W_UP + (size_t)MT * DFF2 * 2;
constexpr size_t W_PART = W_ACT + (size_t)MT * DFF * 2;
constexpr size_t SZ_PARTW = 16 * 1024 + 512;
constexpr size_t W_END = W_PART + (size_t)256 * 8 * SZ_PARTW;

struct Params { const float* in[31]; float* out; unsigned char* ws; };

DEVI float gelu_f(float x) { const float u = -2.302208198f * (x + 0.044715f * x * x * x); return x * __builtin_amdgcn_rcpf(1.f + __builtin_amdgcn_exp2f(u)); }
DEVI float sigmoid_f(float x) { return __builtin_amdgcn_rcpf(1.f + __builtin_amdgcn_exp2f(-1.4426950408889634f * x)); }
DEVI h8 pack8(f4 a, f4 b) { h8 r; r[0] = (h16)a[0]; r[1] = (h16)a[1]; r[2] = (h16)a[2]; r[3] = (h16)a[3]; r[4] = (h16)b[0]; r[5] = (h16)b[1]; r[6] = (h16)b[2]; r[7] = (h16)b[3]; return r; }
DEVI h4 pack4(f4 a) { h4 r; r[0] = (h16)a[0]; r[1] = (h16)a[1]; r[2] = (h16)a[2]; r[3] = (h16)a[3]; return r; }
DEVI float shx(float v, int o, int lane) { return __builtin_bit_cast(float, __builtin_amdgcn_ds_bpermute((lane ^ o) << 2, __builtin_bit_cast(int, v))); }
DEVI float wave_sum(float v, int lane) {
#pragma unroll
    for (int o = 1; o < 64; o <<= 1) v += shx(v, o, lane);
    return v;
}
DEVI int opaque_lane() { unsigned ones = ~0u; asm volatile("" : "+s"(ones)); return (int)__builtin_amdgcn_mbcnt_hi(ones, __builtin_amdgcn_mbcnt_lo(ones, 0u)); }
DEVI h4 trrd(LAS unsigned char* p) { s4v r = __builtin_amdgcn_ds_read_tr16_b64_v4i16((LAS s4v*)p); return __builtin_bit_cast(h4, r); }
DEVI h8 cat44(h4 a, h4 b) { return __builtin_shufflevector(a, b, 0, 1, 2, 3, 4, 5, 6, 7); }

constexpr int BM = 256, BK = 64, HALF = 128, HTB = HALF * BK * 2, STAGE_BYTES = 8 * HTB, NXCD = 8, WGM = 8;
DEVI int lds_byte(int r, int c) { const int st = (r >> 4) * 2 + (c >> 5), rr = r & 15, cc = c & 31, ob = rr * 64 + cc * 2; return st * 1024 + (ob ^ (((ob >> 9) & 1) << 5)); }
DEVI void stage_rc(int b, int& R, int& C) { const int st = b / 1024, sb = b % 1024, swz = sb ^ (((sb >> 9) & 1) << 5); R = (st >> 1) * 16 + swz / 64; C = (st & 1) * 32 + (swz % 64) / 2; }
DEVI int perm32(int rho) { const int n = rho >> 4, i = rho & 15; return 8 * (i >> 2) + 4 * n + (i & 3); }
struct Unit { int pm, pn; };
struct Gemm { const h16* A; const h16* Bt; int M, N, K, lda, ldb; };
struct StaticOrder {
    int nM, nN, nwg, G, c;
    DEVI void init(int M, int N, int G_, int c_) { nM = M / BM; nN = N / BM; nwg = nM * nN; G = G_; c = c_; }
    DEVI bool next(int i, Unit& u) const {
        if (c < 0) return false;
        const long L = (long)i * G + c; if (L >= nwg) return false;
        int wgid = (int)L; { const int q = nwg / NXCD, r = nwg % NXCD, xcd = wgid % NXCD, off = wgid / NXCD; wgid = (xcd < r ? xcd * (q + 1) : r * (q + 1) + (xcd - r) * q) + off; }
        const int nig = WGM * nN, gid = wgid / nig, fm = gid * WGM, gsz = (nM - fm) < WGM ? (nM - fm) : WGM;
        u.pm = fm + ((wgid % nig) % gsz); u.pn = (wgid % nig) / gsz; return true;
    }
};
template <class Epi>
DEVI void gemm_phase(LAS unsigned char* lds, const Gemm g, const StaticOrder& S, const Epi& E, const int tid) {
    const int wid = __builtin_amdgcn_readfirstlane(tid >> 6), lane = tid & 63, wr = wid >> 2, wc = wid & 3, fr = lane & 15, fq = lane >> 4;
    const int K = g.K, nt = K / BK;
    unsigned voffA[2], voffB[2];
#pragma unroll
    for (int i = 0; i < 2; ++i) { int R, C; stage_rc(tid * 16 + i * 8192, R, C); const int Rb = Epi::PERM ? ((R & ~31) + perm32(R & 31)) : R;
        voffA[i] = (unsigned)(R * g.lda + C) * 2u; voffB[i] = (unsigned)(Rb * g.ldb + C) * 2u; }
    const size_t kstep = (size_t)(BK * 2);
    const size_t hstepA = (size_t)HALF * g.lda * 2, hstepB = (size_t)HALF * g.ldb * 2;
    const size_t tstepA = 2 * hstepA, tstepB = 2 * hstepB;
    const unsigned ldsw = (unsigned)wid * 1024u;
    const int aoff = lds_byte(wr * 64 + fr, fq * 8), boff = lds_byte(wc * 32 + fr, fq * 8);
#define PG8_SA(b, h) (((b) * 2 + (h)) * HTB)
#define PG8_SB(b, h) ((4 + (b) * 2 + (h)) * HTB)
#define PG8_STAGE(bufoff, gbase, voff) do { _Pragma("unroll") for (int _i = 0; _i < 2; ++_i) \
        __builtin_amdgcn_global_load_lds((const unsigned*)((const char*)(gbase) + (voff)[_i]), (LAS unsigned*)(lds + (bufoff) + ldsw + _i * 8192), 16, 0, 0); } while (0)
#define PG8_LDA(dst, b, h) do { _Pragma("unroll") for (int m = 0; m < 4; ++m) _Pragma("unroll") for (int k = 0; k < 2; ++k) dst[m][k] = *(const LAS h8*)(lds + PG8_SA(b, h) + aoff + m * 2048 + k * 1024); } while (0)
#define PG8_LDB(dst, b, h) do { _Pragma("unroll") for (int n = 0; n < 2; ++n) _Pragma("unroll") for (int k = 0; k < 2; ++k) dst[n][k] = *(const LAS h8*)(lds + PG8_SB(b, h) + boff + n * 2048 + k * 1024); } while (0)
#define PG8_MMA(ai, bj, At, Bt) do { __builtin_amdgcn_s_setprio(1); _Pragma("unroll") for (int m = 0; m < 4; ++m) _Pragma("unroll") for (int n = 0; n < 2; ++n) _Pragma("unroll") for (int k = 0; k < 2; ++k) \
        acc[ai][bj][m][n] = __builtin_amdgcn_mfma_f32_16x16x32_f16(Bt[n][k], At[m][k], acc[ai][bj][m][n], 0, 0, 0); __builtin_amdgcn_s_setprio(0); } while (0)
#define PG8_WAIT_V(n) asm volatile("s_waitcnt vmcnt(" #n ")" ::: "memory")
#define PG8_WAIT_L(n) asm volatile("s_waitcnt lgkmcnt(" #n ")" ::: "memory")
#define PG8_BAR __builtin_amdgcn_s_barrier()
#define PG8_SCHED __builtin_amdgcn_sched_barrier(0)
    Unit cur, nxt; int ui = 0;
    if (!S.next(0, cur)) return;
    f4 acc[2][2][4][2];
#pragma unroll
    for (int a = 0; a < 2; ++a)
#pragma unroll
        for (int b = 0; b < 2; ++b)
#pragma unroll
            for (int m = 0; m < 4; ++m)
#pragma unroll
                for (int n = 0; n < 2; ++n) acc[a][b][m][n] = (f4){0.f, 0.f, 0.f, 0.f};
    h8 At[4][2], B0[2][2], B1[2][2];
    const char* cA = (const char*)g.A + (size_t)cur.pm * tstepA; const char* cB = (const char*)g.Bt + (size_t)cur.pn * tstepB;
    PG8_STAGE(PG8_SB(0, 0), cB, voffB); PG8_STAGE(PG8_SA(0, 0), cA, voffA); PG8_STAGE(PG8_SB(0, 1), cB + hstepB, voffB); PG8_STAGE(PG8_SA(0, 1), cA + hstepA, voffA);
    if (wr == 1) PG8_BAR;
    PG8_WAIT_V(4); PG8_BAR;
    PG8_STAGE(PG8_SB(1, 0), cB + kstep, voffB); PG8_STAGE(PG8_SA(1, 0), cA + kstep, voffA); PG8_STAGE(PG8_SB(1, 1), cB + hstepB + kstep, voffB);
    PG8_WAIT_V(6); PG8_BAR;
    for (;;) {
        const bool has_next = S.next(ui + 1, nxt);
        const char* nA = has_next ? (const char*)g.A + (size_t)nxt.pm * tstepA : cA; const char* nB = has_next ? (const char*)g.Bt + (size_t)nxt.pn * tstepB : cB;
        for (int t = 0; t < nt; t += 2) {
            const bool last = (t == nt - 2);
            const char* a1 = cA + (size_t)(t + 1) * kstep;
            const char* a2 = last ? nA : cA + (size_t)(t + 2) * kstep; const char* b2 = last ? nB : cB + (size_t)(t + 2) * kstep;
            const char* a3 = a2 + kstep; const char* b3 = b2 + kstep;
            PG8_LDB(B0, 0, 0); PG8_SCHED; PG8_LDA(At, 0, 0); PG8_STAGE(PG8_SA(1, 1), a1 + hstepA, voffA);
            PG8_WAIT_L(8); PG8_BAR; PG8_WAIT_L(0); PG8_MMA(0, 0, At, B0); PG8_BAR; PG8_SCHED;
            PG8_LDB(B1, 0, 1); PG8_STAGE(PG8_SB(0, 0), b2, voffB);
            PG8_BAR; PG8_WAIT_L(0); PG8_MMA(0, 1, At, B1); PG8_BAR;
            PG8_LDA(At, 0, 1); PG8_STAGE(PG8_SA(0, 0), a2, voffA);
            PG8_BAR; PG8_WAIT_L(0); PG8_MMA(1, 0, At, B0); PG8_BAR; PG8_SCHED;
            PG8_STAGE(PG8_SB(0, 1), b2 + hstepB, voffB);
            PG8_WAIT_V(6); PG8_BAR; PG8_MMA(1, 1, At, B1); PG8_BAR;
            PG8_LDB(B0, 1, 0); PG8_SCHED; PG8_LDA(At, 1, 0); PG8_STAGE(PG8_SA(0, 1), a2 + hstepA, voffA);
            PG8_WAIT_L(8); PG8_BAR; PG8_WAIT_L(0); PG8_MMA(0, 0, At, B0); PG8_BAR; PG8_SCHED;
            PG8_LDB(B1, 1, 1); PG8_STAGE(PG8_SB(1, 0), b3, voffB);
            PG8_BAR; PG8_WAIT_L(0); PG8_MMA(0, 1, At, B1); PG8_BAR;
            PG8_LDA(At, 1, 1); PG8_STAGE(PG8_SA(1, 0), a3, voffA);
            PG8_BAR; PG8_WAIT_L(0); PG8_MMA(1, 0, At, B0); PG8_BAR; PG8_SCHED;
            PG8_STAGE(PG8_SB(1, 1), b3 + hstepB, voffB);
            PG8_WAIT_V(6); PG8_BAR; PG8_MMA(1, 1, At, B1); PG8_BAR;
        }
        { int t2 = tid; asm volatile("" : "+v"(t2)); const int l2 = t2 & 63; E(acc, cur, wr, wc, l2 & 15, l2 >> 4); }
        if (!has_next) break;
#pragma unroll
        for (int a = 0; a < 2; ++a)
#pragma unroll
            for (int b = 0; b < 2; ++b)
#pragma unroll
                for (int m = 0; m < 4; ++m)
#pragma unroll
                    for (int n = 0; n < 2; ++n) acc[a][b][m][n] = (f4){0.f, 0.f, 0.f, 0.f};
        cur = nxt; cA = nA; cB = nB; ++ui;
    }
    PG8_WAIT_V(0);
    if (wr == 0) PG8_BAR;
    PG8_BAR;
#undef PG8_SA
#undef PG8_SB
#undef PG8_STAGE
#undef PG8_LDA
#undef PG8_LDB
#undef PG8_MMA
#undef PG8_WAIT_V
#undef PG8_WAIT_L
#undef PG8_BAR
#undef PG8_SCHED
}

typedef f4 Acc[2][2][4][2];
#define EPI_ROWS for (int ai = 0; ai < 2; ++ai) _Pragma("unroll") for (int m = 0; m < 4; ++m)

#define ROW_OF(r) (rowb + ((r) >> 2) * HALF + ((r) & 3) * 16)
struct EpiZ {
    static constexpr bool PERM = true;
    h16* z; float* sv; const float* st; const float* cv; const float* dv; bool fold;
    DEVI void operator()(const Acc& acc, const Unit& u, int wr, int wc, int fr, int fq) const {
        const int rowb = u.pm * BM + wr * 64 + fr, colb = u.pn * BM + wc * 32 + fq * 8;
        float mean[8], rstd[8]; f4 c[2][2], d[2][2];
#pragma unroll
        for (int r = 0; r < 8; ++r) { mean[r] = 0.f; rstd[r] = 1.f; }
#pragma unroll
        for (int bj = 0; bj < 2; ++bj)
#pragma unroll
            for (int n = 0; n < 2; ++n) { c[bj][n] = (f4){0.f, 0.f, 0.f, 0.f}; d[bj][n] = c[bj][n]; }
        if (fold) {
#pragma unroll
            for (int r = 0; r < 8; ++r) { const int row = ROW_OF(r); const float sm = st[2 * row], sq = st[2 * row + 1]; mean[r] = sm * (1.f / DM); rstd[r] = rsqrtf(sq * (1.f / DM) - mean[r] * mean[r] + 1e-5f); }
#pragma unroll
            for (int bj = 0; bj < 2; ++bj)
#pragma unroll
                for (int n = 0; n < 2; ++n) { c[bj][n] = *(const f4*)(cv + colb + bj * HALF + 4 * n); d[bj][n] = *(const f4*)(dv + colb + bj * HALF + 4 * n); } }
#pragma unroll
        for (int bj = 0; bj < 2; ++bj) { const int col = colb + bj * HALF; const bool act = col < 512 || (col >= 1440 && col < 1696);
#pragma unroll
            for (int r = 0; r < 8; ++r) { const int row = ROW_OF(r);
                f4 v0 = (acc[r >> 2][bj][r & 3][0] - c[bj][0] * mean[r]) * rstd[r] + d[bj][0], v1 = (acc[r >> 2][bj][r & 3][1] - c[bj][1] * mean[r]) * rstd[r] + d[bj][1];
                if (act) {
#pragma unroll
                    for (int e = 0; e < 4; ++e) { v0[e] = gelu_f(v0[e]); v1[e] = gelu_f(v1[e]); } }
                *(h8*)(z + (size_t)row * ZW + col) = pack8(v0, v1);
                if (row >= MP && col >= 256 && col < 512) { float* o = sv + (size_t)(row - MP) * 256 + (col - 256); *(f4*)o = v0; *(f4*)(o + 4) = v1; } } }
    }
};
struct EpiQ {
    static constexpr bool PERM = true;
    h16* q; h16* qlat; const float* ropec; const float* ropes;
    DEVI void operator()(const Acc& acc, const Unit& u, int wr, int wc, int fr, int fq) const {
        const bool samp = u.pm * BM >= MP;
        if (u.pn < 2) { if (samp) return;
#pragma unroll
            EPI_ROWS { const int row = u.pm * BM + ai * HALF + wr * 64 + m * 16 + fr;
#pragma unroll
                for (int bj = 0; bj < 2; ++bj) { const int col = u.pn * BM + bj * HALF + wc * 32 + fq * 8;
                    *(h8*)(q + (size_t)row * QW + (col >> 6) * 96 + (col & 63)) = pack8(acc[ai][bj][m][0] * QSCALE, acc[ai][bj][m][1] * QSCALE); } }
        } else {
            const int j = wc * 32 + fq * 8, head = j >> 4, i0 = j & 15; const int rowb = u.pm * BM + wr * 64 + fr;
#pragma unroll
            for (int r = 0; r < 8; ++r) { const int row = ROW_OF(r); const int pidx = samp ? SEQ + ((row - MP) & 31) : (row & (SEQ - 1));
                const size_t po = samp ? (W_QLAT - W_Q) / 2 + (size_t)(row - MP) * QLW + head * 288 + 256 + i0 : (size_t)row * QW + head * 96 + 64 + i0;
#pragma unroll
                for (int n = 0; n < 2; ++n) { const f4 cc = *(const f4*)(ropec + pidx * 16 + i0 + 4 * n), ss = *(const f4*)(ropes + pidx * 16 + i0 + 4 * n);
                    const f4 a0 = acc[r >> 2][0][r & 3][n], b0 = acc[r >> 2][1][r & 3][n];
                    *(h4*)(q + po + 4 * n) = pack4((a0 * cc - b0 * ss) * QSCALE); *(h4*)(q + po + 16 + 4 * n) = pack4((a0 * ss + b0 * cc) * QSCALE); } }
        }
    }
};
struct EpiKV {
    static constexpr bool PERM = true;
    h16* k; h16* v;
    DEVI void operator()(const Acc& acc, const Unit& u, int wr, int wc, int fr, int fq) const {
#pragma unroll
        EPI_ROWS { const int row = u.pm * BM + ai * HALF + wr * 64 + m * 16 + fr;
#pragma unroll
            for (int bj = 0; bj < 2; ++bj) { const int col = u.pn * BM + bj * HALF + wc * 32 + fq * 8; const h8 o = pack8(acc[ai][bj][m][0], acc[ai][bj][m][1]);
                if (u.pn < 2) *(h8*)(k + (size_t)row * KW + (col >> 6) * 96 + (col & 63)) = o; else *(h8*)(v + (size_t)row * VW + (col - 512)) = o; } }
    }
};
DEVI float one_minus_exp(float x) {
    const float pser = -x * (1.f + x * (0.5f + x * (0.16666667f + x * (0.041666668f + x * (0.0083333338f + x * 0.0013888889f)))));
    return x > -0.25f ? pser : 1.f - __builtin_amdgcn_exp2f(1.4426950408889634f * x);
}
struct EpiGate {
    static constexpr bool PERM = false;
    const h16* xc; float* a; float* b; const float* br; const float* bi; const float* sp;
    DEVI void operator()(const Acc& acc, const Unit& u, int wr, int wc, int fr, int fq) const {
        const int rowb = u.pm * BM + wr * 64 + fr, chb = u.pn * 128 + wc * 32 + fq * 4;
        f4 vbr[2], vbi[2], vsp[2]; h4 xv[2][8];
#pragma unroll
        for (int n = 0; n < 2; ++n) { const int ch = chb + n * 16; vbr[n] = *(const f4*)(br + ch); vbi[n] = *(const f4*)(bi + ch); vsp[n] = *(const f4*)(sp + ch) * -8.f;
#pragma unroll
            for (int r = 0; r < 8; ++r) xv[n][r] = *(const h4*)(xc + (size_t)ROW_OF(r) * 256 + ch); }
#pragma unroll
        for (int n = 0; n < 2; ++n) { const int ch = chb + n * 16;
#pragma unroll
            for (int r = 0; r < 8; ++r) { const int row = ROW_OF(r); f4 oa, ob;
#pragma unroll
                for (int e = 0; e < 4; ++e) { const float rg = sigmoid_f(acc[r >> 2][0][r & 3][n][e] + vbr[n][e]), ig = sigmoid_f(acc[r >> 2][1][r & 3][n][e] + vbi[n][e]);
                    const float la = rg * vsp[n][e]; oa[e] = __builtin_amdgcn_exp2f(1.4426950408889634f * la); ob[e] = __builtin_amdgcn_sqrtf(one_minus_exp(2.f * la)) * (ig * (float)xv[n][r][e]); }
                *(f4*)(a + (size_t)row * 256 + ch) = oa; *(f4*)(b + (size_t)row * 256 + ch) = ob; } }
    }
};
struct EpiQlat {
    static constexpr bool PERM = true;
    h16* qlat;
    DEVI void operator()(const Acc& acc, const Unit& u, int wr, int wc, int fr, int fq) const {
#pragma unroll
        EPI_ROWS { const int row = u.pm * BM + ai * HALF + wr * 64 + m * 16 + fr;
#pragma unroll
            for (int bj = 0; bj < 2; ++bj) { const int c = bj * HALF + wc * 32 + fq * 8;
                *(h8*)(qlat + (size_t)row * QLW + u.pn * 288 + c) = pack8(acc[ai][bj][m][0] * QSCALE, acc[ai][bj][m][1] * QSCALE); } }
    }
};
struct EpiRes {
    static constexpr bool PERM = true;
    h16* xh; const float* pst; const float* g; const float* b; bool ln; float* ost;
    DEVI void operator()(const Acc& acc, const Unit& u, int wr, int wc, int fr, int fq) const {
        const int rowb = u.pm * BM + wr * 64 + fr, colb = u.pn * BM + wc * 32 + fq * 8, lane = fq * 16 + fr;
        f4 gv[4], bv[4]; float mean[8], rstd[8];
#pragma unroll
        for (int k = 0; k < 4; ++k) { const int col = colb + (k >> 1) * HALF + (k & 1) * 4; gv[k] = ln ? *(const f4*)(g + col) : (f4){1.f, 1.f, 1.f, 1.f}; bv[k] = ln ? *(const f4*)(b + col) : (f4){0.f, 0.f, 0.f, 0.f}; }
#pragma unroll
        for (int r = 0; r < 8; ++r) { mean[r] = 0.f; rstd[r] = 1.f;
            if (ln) { const int row = ROW_OF(r); const float sm = pst[2 * row], sq = pst[2 * row + 1]; mean[r] = sm * (1.f / DM); rstd[r] = rsqrtf(sq * (1.f / DM) - mean[r] * mean[r] + 1e-5f); } }
        h8 cur[2], nxt[2];
#pragma unroll
        for (int bj = 0; bj < 2; ++bj) cur[bj] = *(const h8*)(xh + (size_t)ROW_OF(0) * DM + colb + bj * HALF);
#pragma unroll
        for (int r = 0; r < 8; ++r) { const int row = ROW_OF(r);
            if (r < 7) {
#pragma unroll
                for (int bj = 0; bj < 2; ++bj) nxt[bj] = *(const h8*)(xh + (size_t)ROW_OF(r + 1) * DM + colb + bj * HALF); }
            float s1 = 0.f, s2 = 0.f;
#pragma unroll
            for (int bj = 0; bj < 2; ++bj) { f4 y[2];
#pragma unroll
                for (int n = 0; n < 2; ++n) { const int k = bj * 2 + n;
                    const f4 xv = (f4){(float)cur[bj][4 * n], (float)cur[bj][4 * n + 1], (float)cur[bj][4 * n + 2], (float)cur[bj][4 * n + 3]};
                    y[n] = ((xv - mean[r]) * rstd[r] * gv[k] + bv[k]) * ALPHA + acc[r >> 2][bj][r & 3][n];
                    s1 += (y[n][0] + y[n][1]) + (y[n][2] + y[n][3]); s2 += (y[n][0] * y[n][0] + y[n][1] * y[n][1]) + (y[n][2] * y[n][2] + y[n][3] * y[n][3]); }
                *(h8*)(xh + (size_t)row * DM + colb + bj * HALF) = pack8(y[0], y[1]); }
            s1 += shx(s1, 16, lane); s2 += shx(s2, 16, lane); s1 += shx(s1, 32, lane); s2 += shx(s2, 32, lane);
            if (fq == 0) { atomicAdd(ost + 2 * row, s1); atomicAdd(ost + 2 * row + 1, s2); }
#pragma unroll
            for (int bj = 0; bj < 2; ++bj) cur[bj] = nxt[bj]; }
    }
};
struct EpiUp {
    static constexpr bool PERM = true;
    h16* up; int rowoff;
    DEVI void operator()(const Acc& acc, const Unit& u, int wr, int wc, int fr, int fq) const {
        const int rowb = rowoff + u.pm * BM + wr * 64 + fr, colb = u.pn * BM + wc * 32 + fq * 8;
#pragma unroll
        for (int r = 0; r < 8; ++r) { h16* p = up + (size_t)ROW_OF(r) * DFF2 + colb;
#pragma unroll
            for (int bj = 0; bj < 2; ++bj) __builtin_nontemporal_store(pack8(acc[r >> 2][bj][r & 3][0], acc[r >> 2][bj][r & 3][1]), (h8*)(p + bj * HALF)); }
    }
};

template <int MODE>
DEVI void transpose_item(const float* W, int ldw, int nblk, h16* WT, int ldd, LAS float* scr, int item, int lane, const float* gs = nullptr, const float* bs = nullptr, float* csum = nullptr, float* dsum = nullptr) {
    const int kb = item / nblk, nb = item % nblk, k0 = 64 * kb, n0 = 32 * nb;
    int nsrc = n0 + (lane & 31);
    if (MODE == 1) { const int n = nsrc; if (n < 512) nsrc = (n >> 6) * 96 + (n & 63); else if (n < 640) nsrc = ((n - 512) >> 4) * 96 + 64 + ((n - 512) & 15); else nsrc = ((n - 640) >> 4) * 96 + 80 + ((n - 640) & 15); }
    float cs = 0.f, ds = 0.f;
#pragma unroll 8
    for (int i = 0; i < 32; ++i) { const int kk = 2 * i + (lane >> 5); float w = W[(size_t)(k0 + kk) * ldw + nsrc]; if (gs) { ds += bs[k0 + kk] * w; w *= gs[k0 + kk]; cs += w; } scr[kk * 33 + (lane & 31)] = w; }
    if (gs && csum) { atomicAdd(csum + nsrc, cs); atomicAdd(dsum + nsrc, ds); }
    __builtin_amdgcn_fence(__ATOMIC_RELEASE, "wavefront"); asm volatile("s_waitcnt lgkmcnt(0)" ::: "memory");
    const int c = lane & 7;
#pragma unroll
    for (int j = 0; j < 4; ++j) { const int n = (lane >> 3) + 8 * j; const LAS float* s = scr + (8 * c) * 33 + n;
        h8 o; o[0] = (h16)s[0 * 33]; o[1] = (h16)s[1 * 33]; o[2] = (h16)s[2 * 33]; o[3] = (h16)s[3 * 33]; o[4] = (h16)s[4 * 33]; o[5] = (h16)s[5 * 33]; o[6] = (h16)s[6 * 33]; o[7] = (h16)s[7 * 33];
        *(h8*)(WT + (size_t)(n0 + n) * ldd + k0 + 8 * c) = o; }
    asm volatile("s_waitcnt lgkmcnt(0)" ::: "memory");
}

template <int NKS, int NCT, int NQS, int KSTR>
DEVI void attn_qk(LAS unsigned char* kbase, const h8 (&qf)[NQS][NKS], f4 (&o)[NQS][NCT], float (&mrow)[NQS], float (&lrow)[NQS], h8 (&pf)[NQS][2], const int nkt, const int lane) {
    const int fr = lane & 15, g = lane >> 4;
    f4 s[NQS][4];
#pragma unroll
    for (int qs = 0; qs < NQS; ++qs)
#pragma unroll
        for (int kt = 0; kt < 4; ++kt) s[qs][kt] = (f4){-1e30f, -1e30f, -1e30f, -1e30f};
#pragma unroll
    for (int kt = 0; kt < 4; ++kt) if (kt < nkt) {
#pragma unroll
        for (int qs = 0; qs < NQS; ++qs) s[qs][kt] = (f4){0.f, 0.f, 0.f, 0.f};
#pragma unroll
        for (int ks = 0; ks < NKS; ++ks) { const h8 kf = *(const LAS h8*)(kbase + (kt * 16 + fr) * KSTR + ks * 64 + g * 16);
#pragma unroll
            for (int qs = 0; qs < NQS; ++qs) s[qs][kt] = __builtin_amdgcn_mfma_f32_16x16x32_f16(kf, qf[qs][ks], s[qs][kt], 0, 0, 0); } }
    __builtin_amdgcn_sched_barrier(0);
#pragma unroll
    for (int qs = 0; qs < NQS; ++qs) {
        float mx = -1e30f;
#pragma unroll
        for (int kt = 0; kt < 4; ++kt)
#pragma unroll
            for (int e = 0; e < 4; ++e) mx = fmaxf(mx, s[qs][kt][e]);
        mx = fmaxf(mx, shx(mx, 16, lane)); mx = fmaxf(mx, shx(mx, 32, lane));
        const float mnew = fmaxf(mrow[qs], mx), alpha = __builtin_amdgcn_exp2f(mrow[qs] - mnew); mrow[qs] = mnew;
        float ps = 0.f;
#pragma unroll
        for (int kt = 0; kt < 4; ++kt)
#pragma unroll
            for (int e = 0; e < 4; ++e) { const float p = __builtin_amdgcn_exp2f(s[qs][kt][e] - mnew); s[qs][kt][e] = p; ps += p; }
        lrow[qs] = lrow[qs] * alpha + ps;
#pragma unroll
        for (int ct = 0; ct < NCT; ++ct) o[qs][ct] *= alpha;
#pragma unroll
        for (int k2 = 0; k2 < 2; ++k2) pf[qs][k2] = pack8(s[qs][2 * k2], s[qs][2 * k2 + 1]);
    }
    __builtin_amdgcn_sched_barrier(0);
}
template <int NCT, int NQS, int VSTR>
DEVI void attn_pv(LAS unsigned char* vbase, f4 (&o)[NQS][NCT], const h8 (&pf)[NQS][2], const int nkt, const int lane) {
    const int fr = lane & 15, g = lane >> 4, q_ = fr >> 2, p_ = fr & 3;
#pragma unroll
    for (int k2 = 0; k2 < 2; ++k2) if (2 * k2 < nkt) {
#pragma unroll
        for (int ct = 0; ct < NCT; ++ct) {
            const h4 lo = trrd(vbase + (32 * k2 + 4 * g + q_) * VSTR + (16 * ct + 4 * p_) * 2);
            const h4 hi = trrd(vbase + (32 * k2 + 16 + 4 * g + q_) * VSTR + (16 * ct + 4 * p_) * 2);
            const h8 vf = cat44(lo, hi);
#pragma unroll
            for (int qs = 0; qs < NQS; ++qs) o[qs][ct] = __builtin_amdgcn_mfma_f32_16x16x32_f16(vf, pf[qs][k2], o[qs][ct], 0, 0, 0); } }
    __builtin_amdgcn_sched_barrier(0);
}
template <int NKS, int NCT, int NQS, int KSTR, int VSTR>
DEVI void attn_tile(LAS unsigned char* kbase, LAS unsigned char* vbase, const h8 (&qf)[NQS][NKS], f4 (&o)[NQS][NCT], float (&mrow)[NQS], float (&lrow)[NQS], const int nkt, const int lane) {
    h8 pf[NQS][2];
    attn_qk<NKS, NCT, NQS, KSTR>(kbase, qf, o, mrow, lrow, pf, nkt, lane);
    attn_pv<NCT, NQS, VSTR>(vbase, o, pf, nkt, lane);
}


struct ConvP { const h16* up; h16* act; const float* fw; const float* fb; const float* stf; const float* st; const float* cv; const float* dv; float* pfc; size_t sdelta; };
DEVI void conv_gate_items(unsigned it_begin, unsigned it_end, unsigned it_step, const int rseg, const ConvP P) {
    constexpr int NCG = DFF / 8;
    for (unsigned it = it_begin; it < it_end; it += it_step) { const int seg = (int)(it / (unsigned)NCG), cg = (int)(it - (unsigned)seg * NCG), j0 = cg * 8, row0 = seg * rseg;
        const bool samp = row0 >= MP; const int t0 = samp ? ((row0 - MP) & 31) : (row0 & (SEQ - 1)), bb = (row0 - MP) >> 5, T = samp ? DSEQ : SEQ;
        const f4 bg0 = *(const f4*)(P.fb + j0), bg1 = *(const f4*)(P.fb + j0 + 4), bv0 = *(const f4*)(P.fb + DFF + j0), bv1 = *(const f4*)(P.fb + DFF + j0 + 4);
        const f4 cg0_ = *(const f4*)(P.cv + j0), cg1_ = *(const f4*)(P.cv + j0 + 4), cv0_ = *(const f4*)(P.cv + DFF + j0), cv1_ = *(const f4*)(P.cv + DFF + j0 + 4);
        const f4 dg0_ = *(const f4*)(P.dv + j0), dg1_ = *(const f4*)(P.dv + j0 + 4), dv0_ = *(const f4*)(P.dv + DFF + j0), dv1_ = *(const f4*)(P.dv + DFF + j0 + 4);
        f4 wg0[3], wg1[3], wv0[3], wv1[3];
#pragma unroll
        for (int j = 0; j < 3; ++j) { const float* wj = P.fw + (size_t)j * DFF2; wg0[j] = *(const f4*)(wj + j0); wg1[j] = *(const f4*)(wj + j0 + 4); wv0[j] = *(const f4*)(wj + DFF + j0); wv1[j] = *(const f4*)(wj + DFF + j0 + 4); }
#define CG_LOADROW(row, G0, G1, V0, V1) do { const h16* _u = P.up + (size_t)(row) * DFF2 + j0; const h8 _a = *(const h8*)_u, _c = *(const h8*)(_u + DFF); \
            const float _sm = P.st[2 * (row)], _sq = P.st[2 * (row) + 1], _mean = _sm * (1.f / DM), _rstd = __builtin_amdgcn_rsqf(_sq * (1.f / DM) - _mean * _mean + 1e-5f); \
            G0 = ((f4){(float)_a[0], (float)_a[1], (float)_a[2], (float)_a[3]} - cg0_ * _mean) * _rstd + dg0_; G1 = ((f4){(float)_a[4], (float)_a[5], (float)_a[6], (float)_a[7]} - cg1_ * _mean) * _rstd + dg1_; \
            V0 = ((f4){(float)_c[0], (float)_c[1], (float)_c[2], (float)_c[3]} - cv0_ * _mean) * _rstd + dv0_; V1 = ((f4){(float)_c[4], (float)_c[5], (float)_c[6], (float)_c[7]} - cv1_ * _mean) * _rstd + dv1_; } while (0)
        f4 ag0, ag1, av0, av1, bg0_, bg1_, bv0_, bv1_;
        if (t0 > 0) { CG_LOADROW(row0 - 2, ag0, ag1, av0, av1); CG_LOADROW(row0 - 1, bg0_, bg1_, bv0_, bv1_); }
        else if (samp) { const float* s2 = P.stf + (size_t)bb * 2 * DFF2; const float* s1 = s2 + DFF2;
            ag0 = *(const f4*)(s2 + j0); ag1 = *(const f4*)(s2 + j0 + 4); av0 = *(const f4*)(s2 + DFF + j0); av1 = *(const f4*)(s2 + DFF + j0 + 4);
            bg0_ = *(const f4*)(s1 + j0); bg1_ = *(const f4*)(s1 + j0 + 4); bv0_ = *(const f4*)(s1 + DFF + j0); bv1_ = *(const f4*)(s1 + DFF + j0 + 4); }
        else { ag0 = ag1 = av0 = av1 = bg0_ = bg1_ = bv0_ = bv1_ = (f4){0.f, 0.f, 0.f, 0.f}; }
        h16* ar = P.act + (size_t)row0 * DFF + j0;
        for (int r0 = 0; r0 < rseg; r0 += 4) { h8 ra[4], rc[4]; float rsm[4], rsq[4];
#pragma unroll
            for (int k = 0; k < 4; ++k) { const int row = row0 + r0 + k; const h16* u_ = P.up + (size_t)row * DFF2 + j0; ra[k] = *(const h8*)u_; rc[k] = *(const h8*)(u_ + DFF); rsm[k] = P.st[2 * row]; rsq[k] = P.st[2 * row + 1]; }
#pragma unroll
            for (int k = 0; k < 4; ++k) { const int r = r0 + k; const float mean = rsm[k] * (1.f / DM), rstd = __builtin_amdgcn_rsqf(rsq[k] * (1.f / DM) - mean * mean + 1e-5f);
                const f4 cg0 = ((f4){(float)ra[k][0], (float)ra[k][1], (float)ra[k][2], (float)ra[k][3]} - cg0_ * mean) * rstd + dg0_, cg1 = ((f4){(float)ra[k][4], (float)ra[k][5], (float)ra[k][6], (float)ra[k][7]} - cg1_ * mean) * rstd + dg1_;
                const f4 cv0 = ((f4){(float)rc[k][0], (float)rc[k][1], (float)rc[k][2], (float)rc[k][3]} - cv0_ * mean) * rstd + dv0_, cv1 = ((f4){(float)rc[k][4], (float)rc[k][5], (float)rc[k][6], (float)rc[k][7]} - cv1_ * mean) * rstd + dv1_;
                const f4 g0 = bg0 + ag0 * wg0[0] + bg0_ * wg0[1] + cg0 * wg0[2], g1 = bg1 + ag1 * wg1[0] + bg1_ * wg1[1] + cg1 * wg1[2];
                const f4 v0 = bv0 + av0 * wv0[0] + bv0_ * wv0[1] + cv0 * wv0[2], v1 = bv1 + av1 * wv1[0] + bv1_ * wv1[1] + cv1 * wv1[2];
                h8 o;
#pragma unroll
                for (int e = 0; e < 4; ++e) { o[e] = (h16)(gelu_f(g0[e]) * v0[e]); o[4 + e] = (h16)(gelu_f(g1[e]) * v1[e]); }
                __builtin_nontemporal_store(o, (h8*)(ar + (size_t)r * DFF));
                const int t = t0 + r;
                if (t >= T - 2) { float* so = P.pfc + (samp ? P.sdelta + ((size_t)bb * 2 + (t - (T - 2))) * DFF2 : ((size_t)(row0 >> 11) * 2 + (t - (T - 2))) * DFF2) + j0;
                    *(f4*)so = cg0; *(f4*)(so + 4) = cg1; *(f4*)(so + DFF) = cv0; *(f4*)(so + DFF + 4) = cv1; }
                ag0 = bg0_; ag1 = bg1_; av0 = bv0_; av1 = bv1_; bg0_ = cg0; bg1_ = cg1; bv0_ = cv0; bv1_ = cv1; } } }
#undef CG_LOADROW
}

#define XB_TMO      128
#define XB_XCNT(j)  (256  + 64 * (j))
#define XB_XSUB(j)  (1280 + 64 * (j))
#define XB_XGEN(j)  (2304 + 64 * (j))
#define XB_TOP      3328
#define XB_TOPGEN   3392
#define XCD_BAR_WORDS 3456
#define XB_SPIN_CAP (1u << 18)
DEVI unsigned xb_ld(unsigned* p)              { return __hip_atomic_load(p, __ATOMIC_RELAXED, __HIP_MEMORY_SCOPE_AGENT); }
DEVI unsigned xb_add(unsigned* p, unsigned v) { return __hip_atomic_fetch_add(p, v, __ATOMIC_RELAXED, __HIP_MEMORY_SCOPE_AGENT); }
DEVI unsigned xb_xcc_id() { return (unsigned)__builtin_amdgcn_s_getreg((3 << 11) | 20) & 0xFu; }
#define XB_SPIN(cond, bar) do { unsigned _sp = 0; while (cond) { __builtin_amdgcn_s_sleep(1); \
    if ((++_sp & 255u) == 0u) { if (xb_ld(&(bar)[XB_TMO])) break; if (_sp > XB_SPIN_CAP) { atomicAdd(&(bar)[XB_TMO], 1u); break; } } } } while (0)
DEVI void xb_complete(unsigned* bar, unsigned x, unsigned& nloc, unsigned& nx, unsigned G) {
    unsigned sum, cnt, mine, sp = 0u;
    for (;;) {
        sum = 0u; cnt = 0u; mine = 0u;
#pragma unroll
        for (unsigned j = 0; j < 16; ++j) { const unsigned c = xb_ld(&bar[XB_XCNT(j)]); sum += c; cnt += (c > 0u) ? 1u : 0u; mine = (j == x) ? c : mine; }
        if (sum == G) break;
        __builtin_amdgcn_s_sleep(1);
        if ((++sp & 255u) == 0u) { if (xb_ld(&bar[XB_TMO])) break; if (sp > XB_SPIN_CAP) { atomicAdd(&bar[XB_TMO], 1u); break; } }
    }
    nloc = mine > 0u ? mine : 1u; nx = cnt > 0u ? cnt : 1u;
}
DEVI void xbar(unsigned* bar, volatile LAS unsigned* st, int tid, unsigned G) {
    asm volatile("s_waitcnt vmcnt(0)" ::: "memory");
    __syncthreads();
    if (tid == 0) {
        const unsigned x = xb_xcc_id();
        __builtin_amdgcn_s_waitcnt(0);
        unsigned nloc = st[0], nx = st[1];
        if (nloc == 0u) { xb_complete(bar, x, nloc, nx, G); st[0] = nloc; st[1] = nx; }
        const unsigned old = xb_add(&bar[XB_XSUB(x)], 1u);
        const unsigned gen = old / nloc;
        if (old + 1u == (gen + 1u) * nloc) {
            __builtin_amdgcn_fence(__ATOMIC_RELEASE, "agent");
            asm volatile("s_waitcnt vmcnt(0)" ::: "memory");
            const unsigned og = xb_add(&bar[XB_TOP], 1u);
            const unsigned tg = og / nx;
            if (og + 1u == (tg + 1u) * nx) xb_add(&bar[XB_TOPGEN], 1u);
            else XB_SPIN(xb_ld(&bar[XB_TOPGEN]) == tg, bar);
            __builtin_amdgcn_fence(__ATOMIC_ACQUIRE, "agent");
            xb_add(&bar[XB_XGEN(x)], 1u);
            asm volatile("s_waitcnt vmcnt(0)" ::: "memory");
        } else {
            XB_SPIN(xb_ld(&bar[XB_XGEN(x)]) == gen, bar);
            __builtin_amdgcn_fence(__ATOMIC_ACQUIRE, "agent");
            asm volatile("s_waitcnt vmcnt(0)" ::: "memory");
        }
    }
    __syncthreads();
}
#ifndef PHM
#define PHM 0xFFFFFFFFu
#endif
#ifndef DBL
#define DBL 0u
#endif
#define NREP(k) (((DBL >> (k)) & 1u) ? 2 : 1)
__global__ void __launch_bounds__(512, 2) trunk_fwd(Params p) {
    extern __shared__ __attribute__((aligned(16))) unsigned char shm_raw[];
    LAS unsigned char* lds = (LAS unsigned char*)shm_raw;
    __shared__ uint4 s_ctl;
#define s_item (*(LAS int*)&s_ctl)
    cg::grid_group grid = cg::this_grid();
    const int wave_s = __builtin_amdgcn_readfirstlane((int)threadIdx.x >> 6);
    if (threadIdx.x == 0) { s_ctl = make_uint4(0u, 0u, 0u, 0u); (void)xb_add((unsigned*)(p.ws + W_BAR) + XB_XCNT(xb_xcc_id()), 1u); }
    __syncthreads();
#define GSYNC() do { const __attribute__((address_space(4))) Params* kq = (const __attribute__((address_space(4))) Params*)__builtin_amdgcn_kernarg_segment_ptr(); asm volatile("" : "+s"(kq)); \
        unsigned Gq = gridDim.x; asm volatile("" : "+s"(Gq)); xbar((unsigned*)(kq->ws + W_BAR), (volatile LAS unsigned*)&s_ctl + 1, wave_s * 64 + opaque_lane(), Gq); } while (0)
#define PH_BEGIN \
    int tid = wave_s * 64 + opaque_lane(); asm volatile("" : "+v"(tid)); \
    int bid = blockIdx.x, G = gridDim.x, lq = l; asm volatile("" : "+s"(bid), "+s"(G), "+s"(lq)); \
    const int lane = tid & 63, wave = __builtin_amdgcn_readfirstlane(tid >> 6); \
    const int gw = bid * 8 + wave, NGW = G * 8; const size_t gtid = (size_t)bid * 512 + tid, NGT = (size_t)G * 512; \
    const __attribute__((address_space(4))) Params* kp = (const __attribute__((address_space(4))) Params*)__builtin_amdgcn_kernarg_segment_ptr(); asm volatile("" : "+s"(kp)); \
    unsigned char* ws = kp->ws; float* out = kp->out; \
    (void)lane; (void)wave; (void)gw; (void)NGW; (void)gtid; (void)NGT; (void)out; (void)lq;
#define WSP(T, off) ((T*)(ws + (off)))
    for (int rep = 0; rep < NREP(0); ++rep) if (PHM & 1u) {
        int tid = wave_s * 64 + opaque_lane(); asm volatile("" : "+v"(tid));
        const int bid = blockIdx.x, G = gridDim.x, lane = tid & 63, wave = __builtin_amdgcn_readfirstlane(tid >> 6);
        const int gw = bid * 8 + wave, NGW = G * 8; const size_t gtid = (size_t)bid * 512 + tid, NGT = (size_t)G * 512;
        unsigned char* ws = p.ws;
        h16* xh = WSP(h16, W_XH); float* ropec = WSP(float, W_ROPE); float* ropes = ropec + NPOS * 16;
        for (size_t i = gtid; i < (size_t)MT * DM / 8; i += NGT) { const size_t e = i * 8; const float* src = e < (size_t)MP * DM ? p.in[0] + e : p.in[1] + (e - (size_t)MP * DM);
            *(h8*)(xh + e) = pack8(*(const f4*)src, *(const f4*)(src + 4)); }
        for (size_t i = gtid; i < (size_t)NPOS * 16; i += NGT) { const int pi = (int)(i >> 4), fi = (int)(i & 15); const double pos = pi < SEQ ? (double)pi : (double)(PAST + pi - SEQ);
            const double ang = pos * exp(-(double)fi / 16.0 * 9.210340371976184); ropec[i] = (float)cos(ang); ropes[i] = (float)sin(ang); }
        for (size_t i = gtid; i < (size_t)DEPTH * 256; i += NGT) WSP(float, W_SP)[i] = log1pf(expf(-p.in[26][i]));
        LAS float* scr = (LAS float*)(lds + wave * 8448);
        for (int l = 0; l < DEPTH; ++l) {
            h16* wt_in = WSP(h16, W_WIN + l * SZ_WIN); h16* wt_uq = WSP(h16, W_WUQ + l * SZ_WUQ); h16* wt_kv = WSP(h16, W_WKV + l * SZ_WKV);
            h16* wt_o = WSP(h16, W_WO + l * SZ_WO); h16* wt_os = WSP(h16, W_WOS + l * SZ_WOS); h16* wt_up = WSP(h16, W_WUP + l * SZ_WUP); h16* wt_dn = WSP(h16, W_WDN + l * SZ_WDN);
            h16* wt_ql = WSP(h16, W_WQL + l * SZ_WQL); h16* wt_g = WSP(h16, W_WG + l * SZ_WG);
            const float* w_in = p.in[11] + (size_t)l * DM * DIN; const float* w_o = p.in[12] + (size_t)l * DM * DM; const float* w_uq = p.in[16] + (size_t)l * 384 * 768;
            const float* w_uk = p.in[18] + (size_t)l * 256 * 512; const float* w_uv = p.in[19] + (size_t)l * 256 * 512; const float* w_up = p.in[27] + (size_t)l * DM * DFF2; const float* w_dn = p.in[30] + (size_t)l * DFF * DM;
            const float* w_r = p.in[22] + (size_t)l * 4 * 64 * 64; const float* w_i = p.in[24] + (size_t)l * 4 * 64 * 64;
            for (int it = gw; it < 16 * 53; it += NGW) transpose_item<0>(w_in, DIN, 53, wt_in, 1024, scr, it, lane, l > 0 ? p.in[9] + (l - 1) * DM : nullptr, l > 0 ? p.in[10] + (l - 1) * DM : nullptr, rep ? nullptr : WSP(float, W_CD + l * SZ_CD), WSP(float, W_CD + l * SZ_CD) + ZW);
            for (int it = gw; it < 6 * 24; it += NGW) transpose_item<1>(w_uq, 768, 24, wt_uq, 384, scr, it, lane);
            for (int it = gw; it < 4 * 16; it += NGW) transpose_item<0>(w_uk, 512, 16, wt_kv, 256, scr, it, lane);
            for (int it = gw; it < 4 * 16; it += NGW) transpose_item<0>(w_uv, 512, 16, wt_kv + 512 * 256, 256, scr, it, lane);
            for (int it = gw; it < 16 * 32; it += NGW) transpose_item<0>(w_o, 1024, 32, wt_o, 1024, scr, it, lane);
            for (int it = gw; it < 16 * 176; it += NGW) transpose_item<0>(w_up, DFF2, 176, wt_up, 1024, scr, it, lane, p.in[7] + l * DM, p.in[8] + l * DM, rep ? nullptr : WSP(float, W_CD + l * SZ_CD) + 2 * ZW, WSP(float, W_CD + l * SZ_CD) + 2 * ZW + DFF2);
            for (int it = gw; it < 44 * 32; it += NGW) transpose_item<0>(w_dn, 1024, 32, wt_dn, DFF, scr, it, lane);
            for (size_t i = gtid; i < (size_t)(ZW - DIN) * 1024 / 8; i += NGT) *(h8*)(wt_in + (size_t)DIN * 1024 + i * 8) = (h8){0, 0, 0, 0, 0, 0, 0, 0};
            for (size_t i = gtid; i < (size_t)512 * 256; i += NGT) { const int n = (int)(i >> 8), k = (int)(i & 255); const int pn = n >> 8, jj = n & 127, isI = (n >> 7) & 1, ch = pn * 128 + jj;
                float v = 0.f; if ((k >> 6) == (ch >> 6)) v = (isI ? w_i : w_r)[((ch >> 6) * 64 + (k & 63)) * 64 + (ch & 63)];
                wt_g[i] = (h16)v; }
            for (int it = gw; it < 8 * 24 * 16; it += NGW) { const int hh = it / (24 * 16), kt = (it / 16) % 24, ct = it % 16, fr = lane & 15, g4 = lane >> 4;
                f4 accq = (f4){0.f, 0.f, 0.f, 0.f};
#pragma unroll
                for (int ks = 0; ks < 2; ++ks) { const float* ap = w_uq + (size_t)(16 * kt + fr) * 768 + hh * 96 + 32 * ks + 8 * g4; const float* bp = w_uk + (size_t)(16 * ct + fr) * 512 + hh * 64 + 32 * ks + 8 * g4;
                    accq = __builtin_amdgcn_mfma_f32_16x16x32_f16(pack8(*(const f4*)ap, *(const f4*)(ap + 4)), pack8(*(const f4*)bp, *(const f4*)(bp + 4)), accq, 0, 0, 0); }
                *(h4*)(wt_ql + (size_t)(hh * 256 + 16 * ct + fr) * 384 + 16 * kt + 4 * g4) = pack4(accq); }
            for (size_t i = gtid; i < (size_t)8 * 64 * 256; i += NGT) { const int c = (int)(i & 255), hd = (int)(i >> 8); wt_os[i] = (h16)w_uv[(size_t)c * 512 + hd]; }
        }
    }
    grid.sync();

    for (int l = 0; l < DEPTH; ++l) {
        for (int rep = 0; rep < NREP(1); ++rep) if (PHM & (1u << 1)) { PH_BEGIN
          Gemm g{WSP(h16, W_XH), WSP(h16, W_WIN + lq * SZ_WIN), MT, ZW, 1024, 1024, 1024}; StaticOrder S; S.init(MT, ZW, G, bid); const int lp = lq > 0 ? lq - 1 : 0; EpiZ E{WSP(h16, W_Z), out + O_SV + (size_t)lq * MS * 256, WSP(float, W_STATS + (size_t)(lp * 2 + 1) * SZ_STATS), WSP(float, W_CD + lq * SZ_CD), WSP(float, W_CD + lq * SZ_CD) + ZW, lq > 0}; gemm_phase(lds, g, S, E, tid); }
        GSYNC();

        for (int rep = 0; rep < NREP(2); ++rep) if (PHM & (1u << 2)) { PH_BEGIN
            const float* qn_g = kp->in[15] + lq * 384; const float* kvn_g = kp->in[17] + lq * 256;
            const float* cw = kp->in[20] + (size_t)lq * 4 * 256; const float* cb = kp->in[21] + lq * 256; const float* stc = kp->in[5] + (size_t)lq * DBATCH * 3 * 256;
            const h16* __restrict__ z = WSP(h16, W_Z); h16* __restrict__ cqn = WSP(h16, W_CQN); h16* __restrict__ ckvn = WSP(h16, W_CKVN); h16* __restrict__ knew = WSP(h16, W_KNEW); h16* __restrict__ kb = WSP(h16, W_K); h16* __restrict__ xc = WSP(h16, W_XC);
            const float* __restrict__ ropec = WSP(float, W_ROPE); const float* __restrict__ ropes = ropec + NPOS * 16;
            for (int row = gw; row < MT; row += NGW) {
                const h16* zr = z + (size_t)row * ZW; const bool samp = row >= MP; const int rs = row - MP;
                const int t = samp ? (rs & 31) : (row & (SEQ - 1)), bb = samp ? (rs >> 5) : (row >> 11), T = samp ? DSEQ : SEQ;
                h2 xq[3];
#pragma unroll
                for (int i = 0; i < 3; ++i) xq[i] = *(const h2*)(zr + 512 + 2 * lane + 128 * i);
                const h4 xkv = *(const h4*)(zr + 896 + 4 * lane);
                const int pidx = samp ? SEQ + t : t, l16 = lane & 15;
                const float rc = ropec[pidx * 16 + l16], rsn = ropes[pidx * 16 + l16], kx1 = (float)zr[1152 + l16], kx2 = (float)zr[1168 + l16];
                const int c = 4 * lane; f4 xl[4];
#pragma unroll
                for (int j = 0; j < 4; ++j) { const int tau = t - 3 + j;
                    if (tau >= 0) { const h4 x = *(const h4*)(zr - (ptrdiff_t)(3 - j) * ZW + 1184 + c); xl[j] = (f4){(float)x[0], (float)x[1], (float)x[2], (float)x[3]}; }
                    else if (samp) xl[j] = *(const f4*)(stc + ((size_t)bb * 3 + (3 + tau)) * 256 + c);
                    else xl[j] = (f4){0.f, 0.f, 0.f, 0.f}; }
                float vq[6], ssq = 0.f, sskv = 0.f; f4 vkv;
#pragma unroll
                for (int i = 0; i < 3; ++i) { vq[2 * i] = (float)xq[i][0]; vq[2 * i + 1] = (float)xq[i][1]; ssq += vq[2 * i] * vq[2 * i] + vq[2 * i + 1] * vq[2 * i + 1]; }
#pragma unroll
                for (int e = 0; e < 4; ++e) { vkv[e] = (float)xkv[e]; sskv += vkv[e] * vkv[e]; }
#pragma unroll
                for (int o = 1; o < 64; o <<= 1) { ssq += shx(ssq, o, lane); sskv += shx(sskv, o, lane); }
                { const float rr = rsqrtf(ssq * (1.f / 384.f) + 1e-6f);
#pragma unroll
                  for (int i = 0; i < 3; ++i) { const int cc = 2 * lane + 128 * i; h2 o; o[0] = (h16)(vq[2 * i] * rr * qn_g[cc]); o[1] = (h16)(vq[2 * i + 1] * rr * qn_g[cc + 1]); *(h2*)(cqn + (size_t)row * 384 + cc) = o; } }
                { const float rr = rsqrtf(sskv * (1.f / 256.f) + 1e-6f); const f4 v = vkv * rr * *(const f4*)(kvn_g + 4 * lane);
                  if (!samp) { __builtin_nontemporal_store(v, (f4*)(out + O_PLAT + ((size_t)lq * MP + row) * 256 + 4 * lane)); *(h4*)(ckvn + (size_t)row * 256 + 4 * lane) = pack4(v); }
                  else { __builtin_nontemporal_store(v, (f4*)(out + O_SLAT + ((size_t)lq * MS + rs) * 256 + 4 * lane)); *(h4*)(knew + (size_t)rs * KNW + 4 * lane) = pack4(v); } }
                if (lane < 16) { const float o1 = kx1 * rc - kx2 * rsn, o2 = kx1 * rsn + kx2 * rc;
                    if (!samp) { float* o = out + O_PKR + ((size_t)lq * MP + row) * 32; o[lane] = o1; o[16 + lane] = o2;
                        h16* kr = kb + (size_t)row * KW + 64;
#pragma unroll
                        for (int hh = 0; hh < 8; ++hh) { kr[hh * 96 + lane] = (h16)o1; kr[hh * 96 + 16 + lane] = (h16)o2; } }
                    else { float* o = out + O_SKR + ((size_t)lq * MS + rs) * 32; o[lane] = o1; o[16 + lane] = o2; knew[(size_t)rs * KNW + 256 + lane] = (h16)o1; knew[(size_t)rs * KNW + 272 + lane] = (h16)o2; } }
                { f4 accv = *(const f4*)(cb + c);
#pragma unroll
                  for (int j = 0; j < 4; ++j) accv += xl[j] * *(const f4*)(cw + j * 256 + c);
                  if (t >= T - 3) { float* o = samp ? out + O_SLC + (((size_t)lq * DBATCH + bb) * 3 + (t - (T - 3))) * 256 : out + O_PLC + (((size_t)lq * NB + bb) * 3 + (t - (T - 3))) * 256; *(f4*)(o + c) = xl[3]; }
                  *(h4*)(xc + (size_t)row * 256 + c) = pack4(accv); }
            }
        }
        GSYNC();

        for (int rep = 0; rep < NREP(3); ++rep) if (PHM & (1u << 3)) { PH_BEGIN
          Gemm g{WSP(h16, W_CQN), WSP(h16, W_WUQ + lq * SZ_WUQ), MT, 768, 384, 384, 384}; StaticOrder S; S.init(MT, 768, G, bid);
          EpiQ E{WSP(h16, W_Q), WSP(h16, W_QLAT), WSP(float, W_ROPE), WSP(float, W_ROPE) + NPOS * 16}; gemm_phase(lds, g, S, E, tid); }
        for (int rep = 0; rep < NREP(4); ++rep) if (PHM & (1u << 4)) { PH_BEGIN
          Gemm g{WSP(h16, W_CKVN), WSP(h16, W_WKV + lq * SZ_WKV), MP, 1024, 256, 256, 256}; StaticOrder S; S.init(MP, 1024, G, (bid + G - (396 % G)) % G); EpiKV E{WSP(h16, W_K), WSP(h16, W_V)}; gemm_phase(lds, g, S, E, tid); }
        for (int rep = 0; rep < NREP(5); ++rep) if (PHM & (1u << 5)) { PH_BEGIN
          Gemm g{WSP(h16, W_XC), WSP(h16, W_WG + lq * SZ_WG), MT, 512, 256, 256, 256}; StaticOrder S; S.init(MT, 512, G, (bid + G - (908 % G)) % G);
          EpiGate E{WSP(h16, W_XC), WSP(float, W_A), WSP(float, W_B), kp->in[23] + lq * 256, kp->in[25] + lq * 256, WSP(float, W_SP) + lq * 256}; gemm_phase(lds, g, S, E, tid); }
        for (int rep = 0; rep < NREP(6); ++rep) if (PHM & (1u << 6)) { PH_BEGIN
          Gemm g{WSP(h16, W_CQN) + (size_t)MP * 384, WSP(h16, W_WQL + lq * SZ_WQL), MS, 2048, 384, 384, 384}; StaticOrder S; S.init(MS, 2048, G, (bid + G - (1172 % G)) % G); EpiQlat E{WSP(h16, W_QLAT)}; gemm_phase(lds, g, S, E, tid); }
        for (int rep = 0; rep < NREP(7); ++rep) if (PHM & (1u << 7)) { PH_BEGIN
            const float* gw_s = kp->in[13] + (size_t)lq * 4 * 128 * 128; const float* gb_s = kp->in[14] + (size_t)lq * 4 * 128;
            const h16* z = WSP(h16, W_Z); h16* cat = WSP(h16, W_CAT); h16* cats = WSP(h16, W_CATS);
            const int fr = lane & 15, g4 = lane >> 4, q_ = fr >> 2, p_ = fr & 3;
            for (int item = (bid + G - (1204 % G)) % G; item < 1024 + 128; item += G) {
                const bool samp = item >= 1024; const int head = item & 3; const int ci = samp ? (item - 1024) >> 2 : item >> 2;
                const int R0 = samp ? MP + ci * 32 : ci * 128, L = samp ? 32 : 128;
                __syncthreads();
                for (int id = tid; id < L * 8; id += 512) { const int j = id >> 3, part = id & 7; *(LAS h8*)(lds + j * 144 + part * 16) = *(const h8*)(z + (size_t)(R0 + j) * ZW + 256 + head * 64 + part * 8); }
                __syncthreads();
                const int i0 = 16 * wave;
                if (i0 < L) {
                    f4 sacc[4];
#pragma unroll
                    for (int ct = 0; ct < 4; ++ct) sacc[ct] = (f4){0.f, 0.f, 0.f, 0.f};
                    const int i = i0 + fr;
#pragma unroll
                    for (int ks = 0; ks < 4; ++ks) if (32 * ks <= i0 + 15 && 32 * ks < L) {
                        const int j0 = 32 * ks + 8 * g4; const float* wp = gw_s + ((size_t)head * 128 + i) * 128 + j0; const f4 w0 = *(const f4*)wp, w1 = *(const f4*)(wp + 4);
                        h8 wf;
#pragma unroll
                        for (int e = 0; e < 4; ++e) { wf[e] = (h16)((j0 + e <= i) ? w0[e] : 0.f); wf[4 + e] = (h16)((j0 + 4 + e <= i) ? w1[e] : 0.f); }
#pragma unroll
                        for (int ct = 0; ct < 4; ++ct) { const h4 lo = trrd(lds + (32 * ks + 8 * g4 + q_) * 144 + (16 * ct + 4 * p_) * 2), hi = trrd(lds + (32 * ks + 8 * g4 + 4 + q_) * 144 + (16 * ct + 4 * p_) * 2);
                            sacc[ct] = __builtin_amdgcn_mfma_f32_16x16x32_f16(wf, cat44(lo, hi), sacc[ct], 0, 0, 0); } }
                    float uval[4][4], bsv[4];
#pragma unroll
                    for (int jx = 0; jx < 4; ++jx) { const int ii = i0 + 4 * g4 + jx; bsv[jx] = gb_s[head * 128 + ii];
#pragma unroll
                        for (int ct = 0; ct < 4; ++ct) uval[jx][ct] = (float)z[((size_t)R0 + ii) * ZW + head * 64 + 16 * ct + fr]; }
#pragma unroll
                    for (int jx = 0; jx < 4; ++jx) { const size_t r = (size_t)R0 + i0 + 4 * g4 + jx;
#pragma unroll
                        for (int ct = 0; ct < 4; ++ct) cat[r * 1024 + head * 64 + 16 * ct + fr] = (h16)(uval[jx][ct] * (sacc[ct][jx] + bsv[jx])); }
                }
            }
            __syncthreads();
        }
        GSYNC();

        for (int rep = 0; rep < NREP(8); ++rep) if (PHM & (1u << 8)) { PH_BEGIN
            unsigned* counter = WSP(unsigned, W_CTR) + lq * 16 + rep * 8;
            constexpr int N_SA = 256, N_PA = 1024, N_PS = 128, N_SS = 16, N_WO = 16, N_UP = 88, N_ALL = N_SA + N_PA + N_PS + N_SS + N_WO + N_UP, Q_WO = N_PS + N_SS + N_SA + 256, Q_UP = Q_WO + N_WO + 256;
            unsigned* wdone = WSP(unsigned, W_CTR) + 800 + lq * 8 + rep * 4;
            unsigned* sdone = WSP(unsigned, W_CTR) + 768 + lq * 2 + rep;
            for (;;) {
                __syncthreads();
                if (tid == 0) s_item = (int)atomicAdd(counter, 1u);
                __syncthreads();
                const int qi = s_item;
                if (qi >= N_ALL) break;
                int tix = tid; asm volatile("" : "+v"(tix));
                const int ln = tix & 63, fr = ln & 15, g4 = ln >> 4;
                const int qj = qi < Q_WO ? qi : (qi < Q_WO + N_WO ? -1 : (qi < Q_UP ? qi - N_WO : (qi < Q_UP + N_UP ? -2 : qi - N_WO - N_UP)));
                const int item = qj < 0 ? qj : (qj < N_PS + N_SS ? qj + N_SA + N_PA : qj - (N_PS + N_SS));
                if (item == -2) {
                    const int ui = qi - Q_UP, pnl = ui / 22, pnc = ui - pnl * 22;
                    if (tix == 0) { unsigned sp = 0; while (xb_ld(wdone + pnl) < 4u) { __builtin_amdgcn_s_sleep(4); if (++sp > (1u << 22)) break; }
                        __builtin_amdgcn_fence(__ATOMIC_ACQUIRE, "agent"); asm volatile("s_waitcnt vmcnt(0)" ::: "memory"); }
                    __syncthreads();
                    const int ro = (MP / BM + pnl) * BM;
                    Gemm g{WSP(h16, W_XH) + (size_t)ro * DM, WSP(h16, W_WUP + lq * SZ_WUP), BM, DFF2, 1024, 1024, 1024}; StaticOrder S; S.init(BM, DFF2, 22, pnc);
                    EpiUp E{WSP(h16, W_UP), ro};
                    gemm_phase(lds, g, S, E, tix);
                } else if (item < 0) {
                    if (tix == 0) { unsigned sp = 0; while (xb_ld(sdone) < 80u) { __builtin_amdgcn_s_sleep(4); if (++sp > (1u << 22)) break; }
                        __builtin_amdgcn_fence(__ATOMIC_ACQUIRE, "agent"); asm volatile("s_waitcnt vmcnt(0)" ::: "memory"); }
                    __syncthreads();
                    const int wi = qi - Q_WO, lp = lq > 0 ? lq - 1 : 0; const size_t ro = (size_t)(MP / BM + (wi >> 2)) * BM;
                    Gemm g{WSP(h16, W_CAT) + ro * 1024, WSP(h16, W_WO + lq * SZ_WO), BM, 1024, 1024, 1024, 1024}; StaticOrder S; S.init(BM, 1024, 4, wi & 3);
                    EpiRes E{WSP(h16, W_XH) + ro * DM, WSP(float, W_STATS + (size_t)(lp * 2 + 1) * SZ_STATS) + 2 * ro, kp->in[9] + lp * DM, kp->in[10] + lp * DM, lq > 0, WSP(float, W_STATS + (size_t)(lq * 2) * SZ_STATS) + 2 * ro};
                    gemm_phase(lds, g, S, E, tix);
                    __syncthreads();
                    if (tix == 0) { __builtin_amdgcn_fence(__ATOMIC_RELEASE, "agent"); asm volatile("s_waitcnt vmcnt(0)" ::: "memory"); (void)xb_add(wdone + (wi >> 2), 1u); }
                } else if (item < N_SA) {
                    constexpr int KS = 608;
                    const float* clat = kp->in[2] + (size_t)lq * DBATCH * PAST * 256; const float* ckr = kp->in[3] + (size_t)lq * DBATCH * PAST * 32;
                    const h16* qlat = WSP(h16, W_QLAT); const h16* knew = WSP(h16, W_KNEW); h16* cats = WSP(h16, W_CATS);
                    const int b = item >> 3, hg = (item >> 2) & 1, sp = item & 3, head = 4 * hg + (wave >> 1), tq = 16 * (wave & 1) + fr, t0 = sp * 16;
                    h8 qf[1][9];
#pragma unroll
                    for (int ks = 0; ks < 9; ++ks) qf[0][ks] = *(const h8*)(qlat + (size_t)(b * 32 + tq) * QLW + head * 288 + 32 * ks + 8 * g4);
                    f4 o[1][16]; float mrow[1] = {-1e30f}, lrow[1] = {0.f};
#pragma unroll
                    for (int ct = 0; ct < 16; ++ct) o[0][ct] = (f4){0.f, 0.f, 0.f, 0.f};
                    const float* lb = clat + (size_t)b * PAST * 256 + (size_t)(t0 * 64 + (tix >> 6)) * 256 + (tix & 63) * 4; const float* rb = ckr + (size_t)b * PAST * 32 + (size_t)(t0 * 64 + (tix >> 3)) * 32 + (tix & 7) * 4;
                    const int wl = (tix >> 6) * KS + (tix & 63) * 8, wr_ = (tix >> 3) * KS + 512 + (tix & 7) * 8;
                    f4 pl[4]; f4 pr;
#pragma unroll
                    for (int hf = 0; hf < 2; ++hf) {
#pragma unroll
                        for (int i = 0; i < 4; ++i) pl[i] = *(const f4*)(lb + (size_t)(hf * 4 + i) * 8 * 256);
#pragma unroll
                        for (int i = 0; i < 4; ++i) *(LAS h4*)(lds + wl + (hf * 4 + i) * 8 * KS) = pack4(pl[i]); }
                    pr = *(const f4*)rb;
                    *(LAS h4*)(lds + wr_) = pack4(pr);
                    __syncthreads();
                    for (int t = 0; t < 16; ++t) {
                        LAS unsigned char* cur = lds + (t & 1) * (64 * KS); LAS unsigned char* nxt = lds + ((t + 1) & 1) * (64 * KS);
                        const bool more = t + 1 < 16;
                        if (more) {
#pragma unroll
                            for (int i = 0; i < 4; ++i) pl[i] = *(const f4*)(lb + ((size_t)(t + 1) * 64 + i * 8) * 256);
                            pr = *(const f4*)(rb + (size_t)(t + 1) * 64 * 32);
                        }
                        h8 pf[1][2];
                        attn_qk<9, 16, 1, KS>(cur, qf, o, mrow, lrow, pf, 4, ln);
                        if (more) {
#pragma unroll
                            for (int i = 0; i < 4; ++i) *(LAS h4*)(nxt + wl + i * 8 * KS) = pack4(pl[i]);
                            *(LAS h4*)(nxt + wr_) = pack4(pr);
#pragma unroll
                            for (int i = 0; i < 4; ++i) pl[i] = *(const f4*)(lb + ((size_t)(t + 1) * 64 + (4 + i) * 8) * 256);
                        }
                        attn_pv<16, 1, KS>(cur, o, pf, 4, ln);
                        if (more) {
#pragma unroll
                            for (int i = 0; i < 4; ++i) *(LAS h4*)(nxt + wl + (4 + i) * 8 * KS) = pack4(pl[i]);
                        } else if (sp == 3) {
                            for (int id = tix; id < 32 * 36; id += 512) { const int key = id / 36, part = id % 36; *(LAS h8*)(nxt + key * KS + part * 16) = *(const h8*)(knew + (size_t)(b * 32 + key) * KNW + part * 8); }
                        }
                        __syncthreads();
                    }
                    if (sp == 3) attn_tile<9, 16, 1, KS, KS>(lds, lds, qf, o, mrow, lrow, 2, ln);
                    { unsigned char* pw = ws + W_PART + ((size_t)item * 8 + wave) * SZ_PARTW;
#pragma unroll
                      for (int ct = 0; ct < 16; ++ct) *(f4*)(pw + ct * 1024 + ln * 16) = o[0][ct];
                      *(float*)(pw + 16384 + ln * 4) = mrow[0]; *(float*)(pw + 16640 + ln * 4) = lrow[0]; }
                    asm volatile("s_waitcnt vmcnt(0)" ::: "memory");
                    __syncthreads();
                    if (tix == 0) { __builtin_amdgcn_fence(__ATOMIC_RELEASE, "agent"); asm volatile("s_waitcnt vmcnt(0)" ::: "memory");
                        const unsigned old = xb_add(WSP(unsigned, W_CTR) + 256 + lq * 64 + rep * 512 + (item >> 2), 1u);
                        if (old == 3u) { __builtin_amdgcn_fence(__ATOMIC_ACQUIRE, "agent"); asm volatile("s_waitcnt vmcnt(0)" ::: "memory"); }
                        *((LAS int*)&s_ctl + 3) = (int)old; }
                    __syncthreads();
                    if (*((LAS int*)&s_ctl + 3) == 3) {
                        const unsigned char* p0 = ws + W_PART + ((size_t)(item & ~3) * 8 + wave) * SZ_PARTW;
                        float mi[4], M = -1e30f;
#pragma unroll
                        for (int i = 0; i < 4; ++i) { mi[i] = *(const float*)(p0 + (size_t)i * 8 * SZ_PARTW + 16384 + ln * 4); M = fmaxf(M, mi[i]); }
                        float L = 0.f;
#pragma unroll
                        for (int i = 0; i < 4; ++i) { mi[i] = __builtin_amdgcn_exp2f(mi[i] - M); L += mi[i] * *(const float*)(p0 + (size_t)i * 8 * SZ_PARTW + 16640 + ln * 4); }
                        L += shx(L, 16, ln); L += shx(L, 32, ln); const float inv = 1.f / L;
                        h8 bf[8];
#pragma unroll
                        for (int ks = 0; ks < 8; ++ks) { f4 u0 = (f4){0.f, 0.f, 0.f, 0.f}, u1 = u0;
#pragma unroll
                            for (int i = 0; i < 4; ++i) { u0 += *(const f4*)(p0 + (size_t)i * 8 * SZ_PARTW + (2 * ks) * 1024 + ln * 16) * mi[i]; u1 += *(const f4*)(p0 + (size_t)i * 8 * SZ_PARTW + (2 * ks + 1) * 1024 + ln * 16) * mi[i]; }
                            bf[ks] = pack8(u0 * inv, u1 * inv); }
                        const h16* wuvt = WSP(h16, W_WOS + lq * SZ_WOS) + (size_t)head * 64 * 256;
                        h16* dst = cats + (size_t)(b * 32 + tq) * 1024 + 256 + head * 64 + 4 * g4;
#pragma unroll
                        for (int dt = 0; dt < 4; ++dt) { f4 od = (f4){0.f, 0.f, 0.f, 0.f};
#pragma unroll
                            for (int ks = 0; ks < 8; ++ks) { const h16* wp = wuvt + (size_t)(16 * dt + fr) * 256 + 32 * ks + 4 * g4;
                                od = __builtin_amdgcn_mfma_f32_16x16x32_f16(cat44(*(const h4*)wp, *(const h4*)(wp + 16)), bf[ks], od, 0, 0, 0); }
                            *(h4*)(dst + 16 * dt) = pack4(od); }
                        asm volatile("s_waitcnt vmcnt(0)" ::: "memory"); __syncthreads();
                        if (tix == 0) { __builtin_amdgcn_fence(__ATOMIC_RELEASE, "agent"); asm volatile("s_waitcnt vmcnt(0)" ::: "memory"); (void)xb_add(sdone, 1u); }
                    }
                } else if (item < N_SA + N_PA) {
                    constexpr int KS = 224, VS = 160, KBUF = 64 * KS, VBUF = 64 * VS;
                    const h16* qb = WSP(h16, W_Q); const h16* kb = WSP(h16, W_K); const h16* vb = WSP(h16, W_V); h16* cat = WSP(h16, W_CAT);
                    const int it = item - N_SA, qblk = 7 - (it >> 7), bh = it & 127, b = bh >> 3, head = bh & 7;
                    const int r0 = qblk * 256 + 32 * wave, ntw = (r0 >> 6) + 1, ntb = 4 * (qblk + 1);
                    h8 qf[2][3];
#pragma unroll
                    for (int qs = 0; qs < 2; ++qs)
#pragma unroll
                        for (int ks = 0; ks < 3; ++ks) qf[qs][ks] = *(const h8*)(qb + (size_t)(b * SEQ + r0 + 16 * qs + fr) * QW + head * 96 + 32 * ks + 8 * g4);
                    f4 o[2][4]; float mrow[2] = {-1e30f, -1e30f}, lrow[2] = {0.f, 0.f};
#pragma unroll
                    for (int qs = 0; qs < 2; ++qs)
#pragma unroll
                        for (int ct = 0; ct < 4; ++ct) o[qs][ct] = (f4){0.f, 0.f, 0.f, 0.f};
                    const int k0key = tix / 12, k0part = tix % 12, k1key = (tix + 512) / 12, k1part = (tix + 512) % 12, vkey = tix >> 3, vpart = tix & 7;
                    const h16* kg0 = kb + (size_t)b * SEQ * KW + head * 96 + (size_t)k0key * KW + k0part * 8; const h16* kg1 = kb + (size_t)b * SEQ * KW + head * 96 + (size_t)k1key * KW + k1part * 8;
                    const h16* vg = vb + (size_t)b * SEQ * VW + head * 64 + (size_t)vkey * VW + vpart * 8;
                    const int lk0 = k0key * KS + k0part * 16, lk1 = k1key * KS + k1part * 16, lv = 2 * KBUF + vkey * VS + vpart * 16;
                    h8 pk0, pk1 = (h8){0, 0, 0, 0, 0, 0, 0, 0}, pv;
                    pk0 = *(const h8*)kg0; if (tix < 256) pk1 = *(const h8*)kg1; pv = *(const h8*)vg;
                    *(LAS h8*)(lds + lk0) = pk0; if (tix < 256) *(LAS h8*)(lds + lk1) = pk1; *(LAS h8*)(lds + lv) = pv;
                    __syncthreads();
                    for (int t = 0; t < ntb; ++t) {
                        const int co = (t & 1), no = ((t + 1) & 1);
                        if (t + 1 < ntb) { const size_t ro = (size_t)(t + 1) * 64;
                            pk0 = *(const h8*)(kg0 + ro * KW); if (tix < 256) pk1 = *(const h8*)(kg1 + ro * KW); pv = *(const h8*)(vg + ro * VW); }
                        if (t < ntw) attn_tile<3, 4, 2, KS, VS>(lds + co * KBUF, lds + 2 * KBUF + co * VBUF, qf, o, mrow, lrow, 4, ln);
                        if (t + 1 < ntb) { *(LAS h8*)(lds + no * KBUF + lk0) = pk0; if (tix < 256) *(LAS h8*)(lds + no * KBUF + lk1) = pk1; *(LAS h8*)(lds + no * VBUF + lv) = pv; }
                        __syncthreads();
                    }
#pragma unroll
                    for (int qs = 0; qs < 2; ++qs) { float lt = lrow[qs]; lt += shx(lt, 16, ln); lt += shx(lt, 32, ln); const float inv = 1.f / lt;
                        h16* dst = cat + (size_t)(b * SEQ + r0 + 16 * qs + fr) * 1024 + 256 + head * 64 + 4 * g4;
#pragma unroll
                        for (int ct = 0; ct < 4; ++ct) *(h4*)(dst + 16 * ct) = pack4(o[qs][ct] * inv); }
                } else if (item < N_SA + N_PA + N_PS) {
                    const float* abuf = WSP(float, W_A); const float* bbuf = WSP(float, W_B); const h16* z = WSP(h16, W_Z); h16* cat = WSP(h16, W_CAT);
                    const int it = item - N_SA - N_PA, b = it >> 3, ch = (it & 7) * 32 + (ln & 31), seg = wave * 2 + (ln >> 5), tl = seg * 32 + (ln & 31);
                    const size_t rbase = (size_t)b * SEQ + seg * 128;
                    float A = 1.f, B = 0.f;
#pragma unroll 16
                    for (int i = 0; i < 128; ++i) { const float a = abuf[(rbase + i) * 256 + ch], bb = bbuf[(rbase + i) * 256 + ch]; B = a * B + bb; A *= a; }
                    LAS float* sA = (LAS float*)lds; LAS float* sB = sA + 512;
                    sA[tl] = A; sB[tl] = B;
                    __syncthreads();
                    float h = 0.f;
                    for (int s2 = 0; s2 < seg; ++s2) h = sA[s2 * 32 + (ln & 31)] * h + sB[s2 * 32 + (ln & 31)];
                    for (int i0 = 0; i0 < 128; i0 += 16) { float av[16], bv[16], gv[16];
#pragma unroll
                        for (int k = 0; k < 16; ++k) { av[k] = abuf[(rbase + i0 + k) * 256 + ch]; bv[k] = bbuf[(rbase + i0 + k) * 256 + ch]; gv[k] = (float)z[(rbase + i0 + k) * ZW + 1440 + ch]; }
#pragma unroll
                        for (int k = 0; k < 16; ++k) { h = av[k] * h + bv[k]; cat[(rbase + i0 + k) * 1024 + 768 + ch] = (h16)(h * gv[k]); } }
                    if (seg == 15) out[O_PH + ((size_t)lq * NB + b) * 256 + ch] = h;
                } else {
                    const float* abuf = WSP(float, W_A); const float* bbuf = WSP(float, W_B); const h16* z = WSP(h16, W_Z); h16* cats = WSP(h16, W_CATS);
                    const int it = item - N_SA - N_PA - N_PS, idx = it * 512 + tix, b = idx >> 8, ch = idx & 255;
                    float h = kp->in[4][((size_t)lq * DBATCH + b) * 256 + ch];
                    for (int t0 = 0; t0 < DSEQ; t0 += 16) { float av[16], bv[16], gv[16];
#pragma unroll
                        for (int k = 0; k < 16; ++k) { const size_t r = (size_t)MP + b * 32 + t0 + k; av[k] = abuf[r * 256 + ch]; bv[k] = bbuf[r * 256 + ch]; gv[k] = (float)z[r * ZW + 1440 + ch]; }
#pragma unroll
                        for (int k = 0; k < 16; ++k) { h = av[k] * h + bv[k]; cats[(size_t)(b * 32 + t0 + k) * 1024 + 768 + ch] = (h16)(h * gv[k]); } }
                    out[O_SH + ((size_t)lq * DBATCH + b) * 256 + ch] = h;
                    asm volatile("s_waitcnt vmcnt(0)" ::: "memory"); __syncthreads();
                    if (tix == 0) { __builtin_amdgcn_fence(__ATOMIC_RELEASE, "agent"); asm volatile("s_waitcnt vmcnt(0)" ::: "memory"); (void)xb_add(sdone, 1u); }
                }
            }
        }
        GSYNC();

        for (int rep = 0; rep < NREP(9); ++rep) if (PHM & (1u << 9)) { PH_BEGIN
          conv_gate_items((unsigned)((MP / 4) * (DFF / 8)) + (unsigned)gtid, (unsigned)((MT / 4) * (DFF / 8)), (unsigned)NGT, 4, ConvP{WSP(h16, W_UP), WSP(h16, W_ACT), kp->in[28] + (size_t)lq * 3 * DFF2, kp->in[29] + (size_t)lq * DFF2, kp->in[6] + (size_t)lq * DBATCH * 2 * DFF2, WSP(float, W_STATS + (size_t)(lq * 2) * SZ_STATS), WSP(float, W_CD + lq * SZ_CD) + 2 * ZW, WSP(float, W_CD + lq * SZ_CD) + 2 * ZW + DFF2, out + O_PFC + (size_t)lq * NB * 2 * DFF2, (O_SFC + (size_t)lq * DBATCH * 2 * DFF2) - (O_PFC + (size_t)lq * NB * 2 * DFF2)});
          const int lp = lq > 0 ? lq - 1 : 0;
          Gemm g{WSP(h16, W_CAT), WSP(h16, W_WO + lq * SZ_WO), MP, 1024, 1024, 1024, 1024}; StaticOrder S; S.init(MP, 1024, G, bid);
          EpiRes E{WSP(h16, W_XH), WSP(float, W_STATS + (size_t)(lp * 2 + 1) * SZ_STATS), kp->in[9] + lp * DM, kp->in[10] + lp * DM, lq > 0, WSP(float, W_STATS + (size_t)(lq * 2) * SZ_STATS)}; gemm_phase(lds, g, S, E, tid); }
        GSYNC();

        for (int rep = 0; rep < NREP(12); ++rep) if (PHM & (1u << 12)) { PH_BEGIN
          Gemm g{WSP(h16, W_XH), WSP(h16, W_WUP + lq * SZ_WUP), MP, DFF2, 1024, 1024, 1024}; StaticOrder S; S.init(MP, DFF2, G, bid);
          EpiUp E{WSP(h16, W_UP), 0}; gemm_phase(lds, g, S, E, tid); }
        GSYNC();

        for (int rep = 0; rep < NREP(13); ++rep) if (PHM & (1u << 13)) { PH_BEGIN
            if (bid < 16) { const size_t ro = (size_t)(MP / BM + (bid >> 2)) * BM;
                Gemm g{WSP(h16, W_ACT) + ro * DFF, WSP(h16, W_WDN + lq * SZ_WDN), BM, 1024, DFF, DFF, DFF}; StaticOrder S; S.init(BM, 1024, 4, bid & 3);
                EpiRes E{WSP(h16, W_XH) + ro * DM, WSP(float, W_STATS + (size_t)(lq * 2) * SZ_STATS) + 2 * ro, kp->in[7] + lq * DM, kp->in[8] + lq * DM, true, WSP(float, W_STATS + (size_t)(lq * 2 + 1) * SZ_STATS) + 2 * ro}; gemm_phase(lds, g, S, E, tid); }
            else conv_gate_items((unsigned)(gtid - 16 * 512), (unsigned)((DFF / 8) * (MP / 32)), (unsigned)(NGT - 16 * 512), 32, ConvP{WSP(h16, W_UP), WSP(h16, W_ACT), kp->in[28] + (size_t)lq * 3 * DFF2, kp->in[29] + (size_t)lq * DFF2, kp->in[6] + (size_t)lq * DBATCH * 2 * DFF2, WSP(float, W_STATS + (size_t)(lq * 2) * SZ_STATS), WSP(float, W_CD + lq * SZ_CD) + 2 * ZW, WSP(float, W_CD + lq * SZ_CD) + 2 * ZW + DFF2, out + O_PFC + (size_t)lq * NB * 2 * DFF2, (O_SFC + (size_t)lq * DBATCH * 2 * DFF2) - (O_PFC + (size_t)lq * NB * 2 * DFF2)}); }
        GSYNC();

        for (int rep = 0; rep < NREP(14); ++rep) if (PHM & (1u << 14)) { PH_BEGIN
          Gemm g{WSP(h16, W_ACT), WSP(h16, W_WDN + lq * SZ_WDN), MP, 1024, DFF, DFF, DFF}; StaticOrder S; S.init(MP, 1024, G, bid); EpiRes E{WSP(h16, W_XH), WSP(float, W_STATS + (size_t)(lq * 2) * SZ_STATS), kp->in[7] + lq * DM, kp->in[8] + lq * DM, true, WSP(float, W_STATS + (size_t)(lq * 2 + 1) * SZ_STATS)}; gemm_phase(lds, g, S, E, tid); }
        GSYNC();

    }
    { const int l = DEPTH - 1; PH_BEGIN
        const float* gg = kp->in[9] + lq * DM; const float* bb = kp->in[10] + lq * DM; const h16* pre2 = WSP(h16, W_XH); const float* st = WSP(float, W_STATS + (size_t)(lq * 2 + 1) * SZ_STATS);
        for (size_t i0 = gtid; i0 < (size_t)MT * (DM / 4); i0 += 4 * NGT) { h4 xv[4]; float sm[4], sq[4];
#pragma unroll
            for (int u = 0; u < 4; ++u) { const size_t i = i0 + u * NGT; if (i < (size_t)MT * (DM / 4)) { const int row = (int)(i >> 8), c = (int)(i & 255) * 4; xv[u] = *(const h4*)(pre2 + (size_t)row * DM + c); sm[u] = st[2 * row]; sq[u] = st[2 * row + 1]; } }
#pragma unroll
            for (int u = 0; u < 4; ++u) { const size_t i = i0 + u * NGT; if (i < (size_t)MT * (DM / 4)) { const int row = (int)(i >> 8), c = (int)(i & 255) * 4;
                const float mean = sm[u] * (1.f / DM), rstd = rsqrtf(sq[u] * (1.f / DM) - mean * mean + 1e-5f);
                __builtin_nontemporal_store(((f4){(float)xv[u][0], (float)xv[u][1], (float)xv[u][2], (float)xv[u][3]} - mean) * rstd * *(const f4*)(gg + c) + *(const f4*)(bb + c), (f4*)(out + O_Y + (size_t)row * DM + c)); } } }
    }
}

extern "C" void kernel_launch(void* const* d_in, const int* in_sizes, int n_in, void* d_out, int out_size, void* d_ws, size_t ws_size, hipStream_t stream) {
    constexpr size_t kDynLds = STAGE_BYTES;
    static int grid_blocks = 0;
    if (!grid_blocks) {
        if (n_in != 31 || (size_t)out_size != O_END || ws_size < W_END) { fprintf(stderr, "kernel_launch: unexpected shapes n_in %d out %d ws %zu (need %zu)\n", n_in, out_size, ws_size, (size_t)W_END); grid_blocks = -1; return; }
        int dev = 0, cus = 0, per_cu = 0;
        hipGetDevice(&dev);
        hipDeviceGetAttribute(&cus, hipDeviceAttributeMultiprocessorCount, dev);
        hipFuncSetAttribute((const void*)trunk_fwd, hipFuncAttributeMaxDynamicSharedMemorySize, (int)kDynLds);
        hipOccupancyMaxActiveBlocksPerMultiprocessor(&per_cu, (const void*)trunk_fwd, 512, kDynLds);
        if (per_cu < 1) per_cu = 1;
        grid_blocks = cus * per_cu;
        if (grid_blocks > 256) grid_blocks = 256;
        if (grid_blocks < 32) { fprintf(stderr, "kernel_launch: grid %d too small\n", grid_blocks); grid_blocks = -1; return; }
    }
    if (grid_blocks < 0) return;
    hipMemsetAsync((char*)d_ws + W_CTR, 0, W_ZERO_END, stream);
    Params p{};
    for (int i = 0; i < 31; ++i) p.in[i] = (const float*)d_in[i];
    p.out = (float*)d_out; p.ws = (unsigned char*)d_ws;
    void* args[] = {&p};
    hipError_t e = hipLaunchCooperativeKernel((const void*)trunk_fwd, dim3(grid_blocks), dim3(512), args, kDynLds, stream);
    if (e != hipSuccess) fprintf(stderr, "cooperative launch failed: %s (grid %d)\n", hipGetErrorString(e), grid_blocks);
}
```

```cpp
#include <hip/hip_runtime.h>
#include <hip/hip_cooperative_groups.h>
#include <cstdio>
#include <cstdint>
namespace cg = cooperative_groups;

typedef _Float16 h16;
typedef _Float16 h8 __attribute__((ext_vector_type(8)));
typedef _Float16 h4 __attribute__((ext_vector_type(4)));
typedef _Float16 h2 __attribute__((ext_vector_type(2)));
typedef float f4 __attribute__((ext_vector_type(4)));
typedef short s4v __attribute__((__vector_size__(8)));
#define LAS __attribute__((address_space(3)))
#define DEVI __device__ __forceinline__

constexpr int DM = 1024, NB = 16, SEQ = 2048, DEPTH = 4, DBATCH = 32, DSEQ = 32, PAST = 4096;
constexpr int MP = NB * SEQ, MS = DBATCH * DSEQ, MT = MP + MS;
constexpr int DIN = 1696, ZW = 1792, DFF = 2816, DFF2 = 5632;
constexpr int QW = 768, KW = 768, VW = 512, QLW = 2304, CSW = 2560, KNW = 288;
constexpr float ALPHA = 1.681792830507429f;
constexpr float QSCALE = 0.14724444f;
constexpr int NPOS = SEQ + DSEQ;

constexpr size_t O_Y = 0;
constexpr size_t O_PLAT = (size_t)MT * DM;
constexpr size_t O_PKR = O_PLAT + (size_t)DEPTH * MP * 256;
constexpr size_t O_PH = O_PKR + (size_t)DEPTH * MP * 32;
constexpr size_t O_PLC = O_PH + (size_t)DEPTH * NB * 256;
constexpr size_t O_PFC = O_PLC + (size_t)DEPTH * NB * 3 * 256;
constexpr size_t O_SLAT = O_PFC + (size_t)DEPTH * NB * 2 * DFF2;
constexpr size_t O_SKR = O_SLAT + (size_t)DEPTH * MS * 256;
constexpr size_t O_SV = O_SKR + (size_t)DEPTH * MS * 32;
constexpr size_t O_SH = O_SV + (size_t)DEPTH * MS * 256;
constexpr size_t O_SLC = O_SH + (size_t)DEPTH * DBATCH * 256;
constexpr size_t O_SFC = O_SLC + (size_t)DEPTH * DBATCH * 3 * 256;
constexpr size_t O_END = O_SFC + (size_t)DEPTH * DBATCH * 2 * DFF2;

constexpr size_t al(size_t x) { return (x + 255) & ~(size_t)255; }
constexpr size_t W_CTR = 0;
constexpr size_t W_PARAMS = 2048;
constexpr size_t W_BAR = 4096;
constexpr size_t W_CD = 4096 + 16384;
constexpr size_t SZ_CD = (size_t)(2 * ZW + 2 * DFF2) * 4;
constexpr size_t W_STATS = W_CD + DEPTH * SZ_CD;
constexpr size_t SZ_STATS = (size_t)MT * 2 * 4;
constexpr size_t W_ZERO_END = W_STATS + (size_t)DEPTH * 2 * SZ_STATS;
constexpr size_t W_ROPE = al(W_ZERO_END);
constexpr size_t W_SP = al(W_ROPE + (size_t)NPOS * 16 * 2 * 4);
constexpr size_t W_WIN = al(W_SP + (size_t)DEPTH * 256 * 4);
constexpr size_t SZ_WIN = (size_t)ZW * 1024 * 2;
constexpr size_t W_WUQ = W_WIN + DEPTH * SZ_WIN;   constexpr size_t SZ_WUQ = (size_t)768 * 384 * 2;
constexpr size_t W_WQL = W_WUQ + DEPTH * SZ_WUQ;   constexpr size_t SZ_WQL = (size_t)2048 * 384 * 2;
constexpr size_t W_WKV = W_WQL + DEPTH * SZ_WQL;   constexpr size_t SZ_WKV = (size_t)1024 * 256 * 2;
constexpr size_t W_WG = W_WKV + DEPTH * SZ_WKV;    constexpr size_t SZ_WG = (size_t)512 * 256 * 2;
constexpr size_t W_WO = W_WG + DEPTH * SZ_WG;      constexpr size_t SZ_WO = (size_t)1024 * 1024 * 2;
constexpr size_t W_WOS = W_WO + DEPTH * SZ_WO;     constexpr size_t SZ_WOS = (size_t)8 * 64 * 256 * 2;
constexpr size_t W_WUP = W_WOS + DEPTH * SZ_WOS;   constexpr size_t SZ_WUP = (size_t)DFF2 * 1024 * 2;
constexpr size_t W_WDN = W_WUP + DEPTH * SZ_WUP;   constexpr size_t SZ_WDN = (size_t)1024 * DFF * 2;
constexpr size_t W_XH = W_WDN + DEPTH * SZ_WDN;
constexpr size_t W_Z = W_XH + (size_t)MT * 1024 * 2;
constexpr size_t W_CQN = W_Z + (size_t)MT * ZW * 2;
constexpr size_t W_CKVN = W_CQN + (size_t)MT * 384 * 2;
constexpr size_t W_XC = W_CKVN + (size_t)MP * 256 * 2;
constexpr size_t W_Q = W_XC + (size_t)MT * 256 * 2;
constexpr size_t W_K = W_Q + (size_t)MP * QW * 2;
constexpr size_t W_V = W_K + (size_t)MP * KW * 2;
constexpr size_t W_A = W_V + (size_t)MP * VW * 2;
constexpr size_t W_B = W_A + (size_t)MT * 256 * 4;
constexpr size_t W_CAT = W_B + (size_t)MT * 256 * 4;
constexpr size_t W_CATS = W_CAT + (size_t)MP * 1024 * 2;
constexpr size_t W_QLAT = W_CATS + (size_t)MS * 1024 * 2;
constexpr size_t W_KNEW = W_QLAT + (size_t)MS * QLW * 2;
constexpr size_t W_PRE = al(W_KNEW + (size_t)MS * KNW * 2);
constexpr size_t W_X1F = W_PRE + (size_t)MT * 1024 * 4;
constexpr size_t W_UP = W_X1F + (size_t)MT * 1024 * 4;
constexpr size_t W_ACT = W_UP + (size_t)MT * DFF2 * 2;
constexpr size_t W_PART = W_ACT + (size_t)MT * DFF * 2;
constexpr size_t SZ_PARTW = 16 * 1024 + 512;
constexpr size_t W_END = W_PART + (size_t)256 * 8 * SZ_PARTW;

struct Params { const float* in[31]; float* out; unsigned char* ws; };

DEVI float gelu_f(float x) { const float u = -2.302208198f * (x + 0.044715f * x * x * x); return x * __builtin_amdgcn_rcpf(1.f + __builtin_amdgcn_exp2f(u)); }
DEVI float sigmoid_f(float x) { return __builtin_amdgcn_rcpf(1.f + __builtin_amdgcn_exp2f(-1.4426950408889634f * x)); }
DEVI h8 pack8(f4 a, f4 b) { h8 r; r[0] = (h16)a[0]; r[1] = (h16)a[1]; r[2] = (h16)a[2]; r[3] = (h16)a[3]; r[4] = (h16)b[0]; r[5] = (h16)b[1]; r[6] = (h16)b[2]; r[7] = (h16)b[3]; return r; }
DEVI h4 pack4(f4 a) { h4 r; r[0] = (h16)a[0]; r[1] = (h16)a[1]; r[2] = (h16)a[2]; r[3] = (h16)a[3]; return r; }
DEVI float shx(float v, int o, int lane) { return __builtin_bit_cast(float, __builtin_amdgcn_ds_bpermute((lane ^ o) << 2, __builtin_bit_cast(int, v))); }
DEVI float wave_sum(float v, int lane) {
#pragma unroll
    for (int o = 1; o < 64; o <<= 1) v += shx(v, o, lane);
    return v;
}
DEVI int opaque_lane() { unsigned ones = ~0u; asm volatile("" : "+s"(ones)); return (int)__builtin_amdgcn_mbcnt_hi(ones, __builtin_amdgcn_mbcnt_lo(ones, 0u)); }
DEVI h4 trrd(LAS unsigned char* p) { s4v r = __builtin_amdgcn_ds_read_tr16_b64_v4i16((LAS s4v*)p); return __builtin_bit_cast(h4, r); }
DEVI h8 cat44(h4 a, h4 b) { return __builtin_shufflevector(a, b, 0, 1, 2, 3, 4, 5, 6, 7); }

constexpr int BM = 256, BK = 64, HALF = 128, HTB = HALF * BK * 2, STAGE_BYTES = 8 * HTB, NXCD = 8, WGM = 8;
DEVI int lds_byte(int r, int c) { const int st = (r >> 4) * 2 + (c >> 5), rr = r & 15, cc = c & 31, ob = rr * 64 + cc * 2; return st * 1024 + (ob ^ (((ob >> 9) & 1) << 5)); }
DEVI void stage_rc(int b, int& R, int& C) { const int st = b / 1024, sb = b % 1024, swz = sb ^ (((sb >> 9) & 1) << 5); R = (st >> 1) * 16 + swz / 64; C = (st & 1) * 32 + (swz % 64) / 2; }
DEVI int perm32(int rho) { const int n = rho >> 4, i = rho & 15; return 8 * (i >> 2) + 4 * n + (i & 3); }
struct Unit { int pm, pn; };
struct Gemm { const h16* A; const h16* Bt; int M, N, K, lda, ldb; };
struct StaticOrder {
    int nM, nN, nwg, G, c;
    DEVI void init(int M, int N, int G_, int c_) { nM = M / BM; nN = N / BM; nwg = nM * nN; G = G_; c = c_; }
    DEVI bool next(int i, Unit& u) const {
        if (c < 0) return false;
        const long L = (long)i * G + c; if (L >= nwg) return false;
        int wgid = (int)L; { const int q = nwg / NXCD, r = nwg % NXCD, xcd = wgid % NXCD, off = wgid / NXCD; wgid = (xcd < r ? xcd * (q + 1) : r * (q + 1) + (xcd - r) * q) + off; }
        const int nig = WGM * nN, gid = wgid / nig, fm = gid * WGM, gsz = (nM - fm) < WGM ? (nM - fm) : WGM;
        u.pm = fm + ((wgid % nig) % gsz); u.pn = (wgid % nig) / gsz; return true;
    }
};
template <class Epi>
DEVI void gemm_phase(LAS unsigned char* lds, const Gemm g, const StaticOrder& S, const Epi& E, const int tid) {
    const int wid = __builtin_amdgcn_readfirstlane(tid >> 6), lane = tid & 63, wr = wid >> 2, wc = wid & 3, fr = lane & 15, fq = lane >> 4;
    const int K = g.K, nt = K / BK;
    unsigned voffA[2], voffB[2];
#pragma unroll
    for (int i = 0; i < 2; ++i) { int R, C; stage_rc(tid * 16 + i * 8192, R, C); const int Rb = Epi::PERM ? ((R & ~31) + perm32(R & 31)) : R;
        voffA[i] = (unsigned)(R * g.lda + C) * 2u; voffB[i] = (unsigned)(Rb * g.ldb + C) * 2u; }
    const size_t kstep = (size_t)(BK * 2);
    const size_t hstepA = (size_t)HALF * g.lda * 2, hstepB = (size_t)HALF * g.ldb * 2;
    const size_t tstepA = 2 * hstepA, tstepB = 2 * hstepB;
    const unsigned ldsw = (unsigned)wid * 1024u;
    const int aoff = lds_byte(wr * 64 + fr, fq * 8), boff = lds_byte(wc * 32 + fr, fq * 8);
#define PG8_SA(b, h) (((b) * 2 + (h)) * HTB)
#define PG8_SB(b, h) ((4 + (b) * 2 + (h)) * HTB)
#define PG8_STAGE(bufoff, gbase, voff) do { _Pragma("unroll") for (int _i = 0; _i < 2; ++_i) \
        __builtin_amdgcn_global_load_lds((const unsigned*)((const char*)(gbase) + (voff)[_i]), (LAS unsigned*)(lds + (bufoff) + ldsw + _i * 8192), 16, 0, 0); } while (0)
#define PG8_LDA(dst, b, h) do { _Pragma("unroll") for (int m = 0; m < 4; ++m) _Pragma("unroll") for (int k = 0; k < 2; ++k) dst[m][k] = *(const LAS h8*)(lds + PG8_SA(b, h) + aoff + m * 2048 + k * 1024); } while (0)
#define PG8_LDB(dst, b, h) do { _Pragma("unroll") for (int n = 0; n < 2; ++n) _Pragma("unroll") for (int k = 0; k < 2; ++k) dst[n][k] = *(const LAS h8*)(lds + PG8_SB(b, h) + boff + n * 2048 + k * 1024); } while (0)
#define PG8_MMA(ai, bj, At, Bt) do { __builtin_amdgcn_s_setprio(1); _Pragma("unroll") for (int m = 0; m < 4; ++m) _Pragma("unroll") for (int n = 0; n < 2; ++n) _Pragma("unroll") for (int k = 0; k < 2; ++k) \
        acc[ai][bj][m][n] = __builtin_amdgcn_mfma_f32_16x16x32_f16(Bt[n][k], At[m][k], acc[ai][bj][m][n], 0, 0, 0); __builtin_amdgcn_s_setprio(0); } while (0)
#define PG8_WAIT_V(n) asm volatile("s_waitcnt vmcnt(" #n ")" ::: "memory")
#define PG8_WAIT_L(n) asm volatile("s_waitcnt lgkmcnt(" #n ")" ::: "memory")
#define PG8_BAR __builtin_amdgcn_s_barrier()
#define PG8_SCHED __builtin_amdgcn_sched_barrier(0)
    Unit cur, nxt; int ui = 0;
    if (!S.next(0, cur)) return;
    f4 acc[2][2][4][2];
#pragma unroll
    for (int a = 0; a < 2; ++a)
#pragma unroll
        for (int b = 0; b < 2; ++b)
#pragma unroll
            for (int m = 0; m < 4; ++m)
#pragma unroll
                for (int n = 0; n < 2; ++n) acc[a][b][m][n] = (f4){0.f, 0.f, 0.f, 0.f};
    h8 At[4][2], B0[2][2], B1[2][2];
    const char* cA = (const char*)g.A + (size_t)cur.pm * tstepA; const char* cB = (const char*)g.Bt + (size_t)cur.pn * tstepB;
    PG8_STAGE(PG8_SB(0, 0), cB, voffB); PG8_STAGE(PG8_SA(0, 0), cA, voffA); PG8_STAGE(PG8_SB(0, 1), cB + hstepB, voffB); PG8_STAGE(PG8_SA(0, 1), cA + hstepA, voffA);
    if (wr == 1) PG8_BAR;
    PG8_WAIT_V(4); PG8_BAR;
    PG8_STAGE(PG8_SB(1, 0), cB + kstep, voffB); PG8_STAGE(PG8_SA(1, 0), cA + kstep, voffA); PG8_STAGE(PG8_SB(1, 1), cB + hstepB + kstep, voffB);
    PG8_WAIT_V(6); PG8_BAR;
    for (;;) {
        const bool has_next = S.next(ui + 1, nxt);
        const char* nA = has_next ? (const char*)g.A + (size_t)nxt.pm * tstepA : cA; const char* nB = has_next ? (const char*)g.Bt + (size_t)nxt.pn * tstepB : cB;
        for (int t = 0; t < nt; t += 2) {
            const bool last = (t == nt - 2);
            const char* a1 = cA + (size_t)(t + 1) * kstep;
            const char* a2 = last ? nA : cA + (size_t)(t + 2) * kstep; const char* b2 = last ? nB : cB + (size_t)(t + 2) * kstep;
            const char* a3 = a2 + kstep; const char* b3 = b2 + kstep;
            PG8_LDB(B0, 0, 0); PG8_SCHED; PG8_LDA(At, 0, 0); PG8_STAGE(PG8_SA(1, 1), a1 + hstepA, voffA);
            PG8_WAIT_L(8); PG8_BAR; PG8_WAIT_L(0); PG8_MMA(0, 0, At, B0); PG8_BAR; PG8_SCHED;
            PG8_LDB(B1, 0, 1); PG8_STAGE(PG8_SB(0, 0), b2, voffB);
            PG8_BAR; PG8_WAIT_L(0); PG8_MMA(0, 1, At, B1); PG8_BAR;
            PG8_LDA(At, 0, 1); PG8_STAGE(PG8_SA(0, 0), a2, voffA);
            PG8_BAR; PG8_WAIT_L(0); PG8_MMA(1, 0, At, B0); PG8_BAR; PG8_SCHED;
            PG8_STAGE(PG8_SB(0, 1), b2 + hstepB, voffB);
            PG8_WAIT_V(6); PG8_BAR; PG8_MMA(1, 1, At, B1); PG8_BAR;
            PG8_LDB(B0, 1, 0); PG8_SCHED; PG8_LDA(At, 1, 0); PG8_STAGE(PG8_SA(0, 1), a2 + hstepA, voffA);
            PG8_WAIT_L(8); PG8_BAR; PG8_WAIT_L(0); PG8_MMA(0, 0, At, B0); PG8_BAR; PG8_SCHED;
            PG8_LDB(B1, 1, 1); PG8_STAGE(PG8_SB(1, 0), b3, voffB);
            PG8_BAR; PG8_WAIT_L(0); PG8_MMA(0, 1, At, B1); PG8_BAR;
            PG8_LDA(At, 1, 1); PG8_STAGE(PG8_SA(1, 0), a3, voffA);
            PG8_BAR; PG8_WAIT_L(0); PG8_MMA(1, 0, At, B0); PG8_BAR; PG8_SCHED;
            PG8_STAGE(PG8_SB(1, 1), b3 + hstepB, voffB);
            PG8_WAIT_V(6); PG8_BAR; PG8_MMA(1, 1, At, B1); PG8_BAR;
        }
        { int t2 = tid; asm volatile("" : "+v"(t2)); const int l2 = t2 & 63; E(acc, cur, wr, wc, l2 & 15, l2 >> 4); }
        if (!has_next) break;
#pragma unroll
        for (int a = 0; a < 2; ++a)
#pragma unroll
            for (int b = 0; b < 2; ++b)
#pragma unroll
                for (int m = 0; m < 4; ++m)
#pragma unroll
                    for (int n = 0; n < 2; ++n) acc[a][b][m][n] = (f4){0.f, 0.f, 0.f, 0.f};
        cur = nxt; cA = nA; cB = nB; ++ui;
    }
    PG8_WAIT_V(0);
    if (wr == 0) PG8_BAR;
    PG8_BAR;
#undef PG8_SA
#undef PG8_SB
#undef PG8_STAGE
#undef PG8_LDA
#undef PG8_LDB
#undef PG8_MMA
#undef PG8_WAIT_V
#undef PG8_WAIT_L
#undef PG8_BAR
#undef PG8_SCHED
}

typedef f4 Acc[2][2][4][2];
#define EPI_ROWS for (int ai = 0; ai < 2; ++ai) _Pragma("unroll") for (int m = 0; m < 4; ++m)

#define ROW_OF(r) (rowb + ((r) >> 2) * HALF + ((r) & 3) * 16)
struct EpiZ {
    static constexpr bool PERM = true;
    h16* z; float* sv; const float* st; const float* cv; const float* dv; bool fold;
    DEVI void operator()(const Acc& acc, const Unit& u, int wr, int wc, int fr, int fq) const {
        const int rowb = u.pm * BM + wr * 64 + fr, colb = u.pn * BM + wc * 32 + fq * 8;
        float mean[8], rstd[8]; f4 c[2][2], d[2][2];
#pragma unroll
        for (int r = 0; r < 8; ++r) { mean[r] = 0.f; rstd[r] = 1.f; }
#pragma unroll
        for (int bj = 0; bj < 2; ++bj)
#pragma unroll
            for (int n = 0; n < 2; ++n) { c[bj][n] = (f4){0.f, 0.f, 0.f, 0.f}; d[bj][n] = c[bj][n]; }
        if (fold) {
#pragma unroll
            for (int r = 0; r < 8; ++r) { const int row = ROW_OF(r); const float sm = st[2 * row], sq = st[2 * row + 1]; mean[r] = sm * (1.f / DM); rstd[r] = rsqrtf(sq * (1.f / DM) - mean[r] * mean[r] + 1e-5f); }
#pragma unroll
            for (int bj = 0; bj < 2; ++bj)
#pragma unroll
                for (int n = 0; n < 2; ++n) { c[bj][n] = *(const f4*)(cv + colb + bj * HALF + 4 * n); d[bj][n] = *(const f4*)(dv + colb + bj * HALF + 4 * n); } }
#pragma unroll
        for (int bj = 0; bj < 2; ++bj) { const int col = colb + bj * HALF; const bool act = col < 512 || (col >= 1440 && col < 1696);
#pragma unroll
            for (int r = 0; r < 8; ++r) { const int row = ROW_OF(r);
                f4 v0 = (acc[r >> 2][bj][r & 3][0] - c[bj][0] * mean[r]) * rstd[r] + d[bj][0], v1 = (acc[r >> 2][bj][r & 3][1] - c[bj][1] * mean[r]) * rstd[r] + d[bj][1];
                if (act) {
#pragma unroll
                    for (int e = 0; e < 4; ++e) { v0[e] = gelu_f(v0[e]); v1[e] = gelu_f(v1[e]); } }
                *(h8*)(z + (size_t)row * ZW + col) = pack8(v0, v1);
                if (row >= MP && col >= 256 && col < 512) { float* o = sv + (size_t)(row - MP) * 256 + (col - 256); *(f4*)o = v0; *(f4*)(o + 4) = v1; } } }
    }
};
struct EpiQ {
    static constexpr bool PERM = true;
    h16* q; h16* qlat; const float* ropec; const float* ropes;
    DEVI void operator()(const Acc& acc, const Unit& u, int wr, int wc, int fr, int fq) const {
        const bool samp = u.pm * BM >= MP;
        if (u.pn < 2) { if (samp) return;
#pragma unroll
            EPI_ROWS { const int row = u.pm * BM + ai * HALF + wr * 64 + m * 16 + fr;
#pragma unroll
                for (int bj = 0; bj < 2; ++bj) { const int col = u.pn * BM + bj * HALF + wc * 32 + fq * 8;
                    *(h8*)(q + (size_t)row * QW + (col >> 6) * 96 + (col & 63)) = pack8(acc[ai][bj][m][0] * QSCALE, acc[ai][bj][m][1] * QSCALE); } }
        } else {
            const int j = wc * 32 + fq * 8, head = j >> 4, i0 = j & 15; const int rowb = u.pm * BM + wr * 64 + fr;
#pragma unroll
            for (int r = 0; r < 8; ++r) { const int row = ROW_OF(r); const int pidx = samp ? SEQ + ((row - MP) & 31) : (row & (SEQ - 1));
                const size_t po = samp ? (W_QLAT - W_Q) / 2 + (size_t)(row - MP) * QLW + head * 288 + 256 + i0 : (size_t)row * QW + head * 96 + 64 + i0;
#pragma unroll
                for (int n = 0; n < 2; ++n) { const f4 cc = *(const f4*)(ropec + pidx * 16 + i0 + 4 * n), ss = *(const f4*)(ropes + pidx * 16 + i0 + 4 * n);
                    const f4 a0 = acc[r >> 2][0][r & 3][n], b0 = acc[r >> 2][1][r & 3][n];
                    *(h4*)(q + po + 4 * n) = pack4((a0 * cc - b0 * ss) * QSCALE); *(h4*)(q + po + 16 + 4 * n) = pack4((a0 * ss + b0 * cc) * QSCALE); } }
        }
    }
};
struct EpiKV {
    static constexpr bool PERM = true;
    h16* k; h16* v;
    DEVI void operator()(const Acc& acc, const Unit& u, int wr, int wc, int fr, int fq) const {
#pragma unroll
        EPI_ROWS { const int row = u.pm * BM + ai * HALF + wr * 64 + m * 16 + fr;
#pragma unroll
            for (int bj = 0; bj < 2; ++bj) { const int col = u.pn * BM + bj * HALF + wc * 32 + fq * 8; const h8 o = pack8(acc[ai][bj][m][0], acc[ai][bj][m][1]);
                if (u.pn < 2) *(h8*)(k + (size_t)row * KW + (col >> 6) * 96 + (col & 63)) = o; else *(h8*)(v + (size_t)row * VW + (col - 512)) = o; } }
    }
};
DEVI float one_minus_exp(float x) {
    const float pser = -x * (1.f + x * (0.5f + x * (0.16666667f + x * (0.041666668f + x * (0.0083333338f + x * 0.0013888889f)))));
    return x > -0.25f ? pser : 1.f - __builtin_amdgcn_exp2f(1.4426950408889634f * x);
}
struct EpiGate {
    static constexpr bool PERM = false;
    const h16* xc; float* a; float* b; const float* br; const float* bi; const float* sp;
    DEVI void operator()(const Acc& acc, const Unit& u, int wr, int wc, int fr, int fq) const {
        const int rowb = u.pm * BM + wr * 64 + fr, chb = u.pn * 128 + wc * 32 + fq * 4;
        f4 vbr[2], vbi[2], vsp[2]; h4 xv[2][8];
#pragma unroll
        for (int n = 0; n < 2; ++n) { const int ch = chb + n * 16; vbr[n] = *(const f4*)(br + ch); vbi[n] = *(const f4*)(bi + ch); vsp[n] = *(const f4*)(sp + ch) * -8.f;
#pragma unroll
            for (int r = 0; r < 8; ++r) xv[n][r] = *(const h4*)(xc + (size_t)ROW_OF(r) * 256 + ch); }
#pragma unroll
        for (int n = 0; n < 2; ++n) { const int ch = chb + n * 16;
#pragma unroll
            for (int r = 0; r < 8; ++r) { const int row = ROW_OF(r); f4 oa, ob;
#pragma unroll
                for (int e = 0; e < 4; ++e) { const float rg = sigmoid_f(acc[r >> 2][0][r & 3][n][e] + vbr[n][e]), ig = sigmoid_f(acc[r >> 2][1][r & 3][n][e] + vbi[n][e]);
                    const float la = rg * vsp[n][e]; oa[e] = __builtin_amdgcn_exp2f(1.4426950408889634f * la); ob[e] = __builtin_amdgcn_sqrtf(one_minus_exp(2.f * la)) * (ig * (float)xv[n][r][e]); }
                *(f4*)(a + (size_t)row * 256 + ch) = oa; *(f4*)(b + (size_t)row * 256 + ch) = ob; } }
    }
};
struct EpiQlat {
    static constexpr bool PERM = true;
    h16* qlat;
    DEVI void operator()(const Acc& acc, const Unit& u, int wr, int wc, int fr, int fq) const {
#pragma unroll
        EPI_ROWS { const int row = u.pm * BM + ai * HALF + wr * 64 + m * 16 + fr;
#pragma unroll
            for (int bj = 0; bj < 2; ++bj) { const int c = bj * HALF + wc * 32 + fq * 8;
                *(h8*)(qlat + (size_t)row * QLW + u.pn * 288 + c) = pack8(acc[ai][bj][m][0] * QSCALE, acc[ai][bj][m][1] * QSCALE); } }
    }
};
struct EpiRes {
    static constexpr bool PERM = true;
    h16* xh; const float* pst; const float* g; const float* b; bool ln; float* ost;
    DEVI void operator()(const Acc& acc, const Unit& u, int wr, int wc, int fr, int fq) const {
        const int rowb = u.pm * BM + wr * 64 + fr, colb = u.pn * BM + wc * 32 + fq * 8, lane = fq * 16 + fr;
        f4 gv[4], bv[4]; float mean[8], rstd[8];
#pragma unroll
        for (int k = 0; k < 4; ++k) { const int col = colb + (k >> 1) * HALF + (k & 1) * 4; gv[k] = ln ? *(const f4*)(g + col) : (f4){1.f, 1.f, 1.f, 1.f}; bv[k] = ln ? *(const f4*)(b + col) : (f4){0.f, 0.f, 0.f, 0.f}; }
#pragma unroll
        for (int r = 0; r < 8; ++r) { mean[r] = 0.f; rstd[r] = 1.f;
            if (ln) { const int row = ROW_OF(r); const float sm = pst[2 * row], sq = pst[2 * row + 1]; mean[r] = sm * (1.f / DM); rstd[r] = rsqrtf(sq * (1.f / DM) - mean[r] * mean[r] + 1e-5f); } }
        h8 cur[2], nxt[2];
#pragma unroll
        for (int bj = 0; bj < 2; ++bj) cur[bj] = *(const h8*)(xh + (size_t)ROW_OF(0) * DM + colb + bj * HALF);
#pragma unroll
        for (int r = 0; r < 8; ++r) { const int row = ROW_OF(r);
            if (r < 7) {
#pragma unroll
                for (int bj = 0; bj < 2; ++bj) nxt[bj] = *(const h8*)(xh + (size_t)ROW_OF(r + 1) * DM + colb + bj * HALF); }
            float s1 = 0.f, s2 = 0.f;
#pragma unroll
            for (int bj = 0; bj < 2; ++bj) { f4 y[2];
#pragma unroll
                for (int n = 0; n < 2; ++n) { const int k = bj * 2 + n;
                    const f4 xv = (f4){(float)cur[bj][4 * n], (float)cur[bj][4 * n + 1], (float)cur[bj][4 * n + 2], (float)cur[bj][4 * n + 3]};
                    y[n] = ((xv - mean[r]) * rstd[r] * gv[k] + bv[k]) * ALPHA + acc[r >> 2][bj][r & 3][n];
                    s1 += (y[n][0] + y[n][1]) + (y[n][2] + y[n][3]); s2 += (y[n][0] * y[n][0] + y[n][1] * y[n][1]) + (y[n][2] * y[n][2] + y[n][3] * y[n][3]); }
                *(h8*)(xh + (size_t)row * DM + colb + bj * HALF) = pack8(y[0], y[1]); }
            s1 += shx(s1, 16, lane); s2 += shx(s2, 16, lane); s1 += shx(s1, 32, lane); s2 += shx(s2, 32, lane);
            if (fq == 0) { atomicAdd(ost + 2 * row, s1); atomicAdd(ost + 2 * row + 1, s2); }
#pragma unroll
            for (int bj = 0; bj < 2; ++bj) cur[bj] = nxt[bj]; }
    }
};
struct EpiUp {
    static constexpr bool PERM = true;
    h16* up; int rowoff;
    DEVI void operator()(const Acc& acc, const Unit& u, int wr, int wc, int fr, int fq) const {
        const int rowb = rowoff + u.pm * BM + wr * 64 + fr, colb = u.pn * BM + wc * 32 + fq * 8;
#pragma unroll
        for (int r = 0; r < 8; ++r) { h16* p = up + (size_t)ROW_OF(r) * DFF2 + colb;
#pragma unroll
            for (int bj = 0; bj < 2; ++bj) __builtin_nontemporal_store(pack8(acc[r >> 2][bj][r & 3][0], acc[r >> 2][bj][r & 3][1]), (h8*)(p + bj * HALF)); }
    }
};

template <int MODE>
DEVI void transpose_item(const float* W, int ldw, int nblk, h16* WT, int ldd, LAS float* scr, int item, int lane, const float* gs = nullptr, const float* bs = nullptr, float* csum = nullptr, float* dsum = nullptr) {
    const int kb = item / nblk, nb = item % nblk, k0 = 64 * kb, n0 = 32 * nb;
    int nsrc = n0 + (lane & 31);
    if (MODE == 1) { const int n = nsrc; if (n < 512) nsrc = (n >> 6) * 96 + (n & 63); else if (n < 640) nsrc = ((n - 512) >> 4) * 96 + 64 + ((n - 512) & 15); else nsrc = ((n - 640) >> 4) * 96 + 80 + ((n - 640) & 15); }
    float cs = 0.f, ds = 0.f;
#pragma unroll 8
    for (int i = 0; i < 32; ++i) { const int kk = 2 * i + (lane >> 5); float w = __builtin_nontemporal_load(W + (size_t)(k0 + kk) * ldw + nsrc); if (gs) { ds += bs[k0 + kk] * w; w *= gs[k0 + kk]; cs += w; } scr[kk * 33 + (lane & 31)] = w; }
    if (gs && csum) { atomicAdd(csum + nsrc, cs); atomicAdd(dsum + nsrc, ds); }
    __builtin_amdgcn_fence(__ATOMIC_RELEASE, "wavefront"); asm volatile("s_waitcnt lgkmcnt(0)" ::: "memory");
    const int c = lane & 7;
#pragma unroll
    for (int j = 0; j < 4; ++j) { const int n = (lane >> 3) + 8 * j; const LAS float* s = scr + (8 * c) * 33 + n;
        h8 o; o[0] = (h16)s[0 * 33]; o[1] = (h16)s[1 * 33]; o[2] = (h16)s[2 * 33]; o[3] = (h16)s[3 * 33]; o[4] = (h16)s[4 * 33]; o[5] = (h16)s[5 * 33]; o[6] = (h16)s[6 * 33]; o[7] = (h16)s[7 * 33];
        *(h8*)(WT + (size_t)(n0 + n) * ldd + k0 + 8 * c) = o; }
    asm volatile("s_waitcnt lgkmcnt(0)" ::: "memory");
}

template <int NKS, int NCT, int NQS, int KSTR>
DEVI void attn_qk(LAS unsigned char* kbase, const h8 (&qf)[NQS][NKS], f4 (&o)[NQS][NCT], float (&mrow)[NQS], float (&lrow)[NQS], h8 (&pf)[NQS][2], const int nkt, const int lane) {
    const int fr = lane & 15, g = lane >> 4;
    f4 s[NQS][4];
#pragma unroll
    for (int qs = 0; qs < NQS; ++qs)
#pragma unroll
        for (int kt = 0; kt < 4; ++kt) s[qs][kt] = (f4){-1e30f, -1e30f, -1e30f, -1e30f};
#pragma unroll
    for (int kt = 0; kt < 4; ++kt) if (kt < nkt) {
#pragma unroll
        for (int qs = 0; qs < NQS; ++qs) s[qs][kt] = (f4){0.f, 0.f, 0.f, 0.f};
#pragma unroll
        for (int ks = 0; ks < NKS; ++ks) { const h8 kf = *(const LAS h8*)(kbase + (kt * 16 + fr) * KSTR + ks * 64 + g * 16);
#pragma unroll
            for (int qs = 0; qs < NQS; ++qs) s[qs][kt] = __builtin_amdgcn_mfma_f32_16x16x32_f16(kf, qf[qs][ks], s[qs][kt], 0, 0, 0); } }
    __builtin_amdgcn_sched_barrier(0);
#pragma unroll
    for (int qs = 0; qs < NQS; ++qs) {
        float mx = -1e30f;
#pragma unroll
        for (int kt = 0; kt < 4; ++kt)
#pragma unroll
            for (int e = 0; e < 4; ++e) mx = fmaxf(mx, s[qs][kt][e]);
        mx = fmaxf(mx, shx(mx, 16, lane)); mx = fmaxf(mx, shx(mx, 32, lane));
        const float mnew = fmaxf(mrow[qs], mx), alpha = __builtin_amdgcn_exp2f(mrow[qs] - mnew); mrow[qs] = mnew;
        float ps = 0.f;
#pragma unroll
        for (int kt = 0; kt < 4; ++kt)
#pragma unroll
            for (int e = 0; e < 4; ++e) { const float p = __builtin_amdgcn_exp2f(s[qs][kt][e] - mnew); s[qs][kt][e] = p; ps += p; }
        lrow[qs] = lrow[qs] * alpha + ps;
#pragma unroll
        for (int ct = 0; ct < NCT; ++ct) o[qs][ct] *= alpha;
#pragma unroll
        for (int k2 = 0; k2 < 2; ++k2) pf[qs][k2] = pack8(s[qs][2 * k2], s[qs][2 * k2 + 1]);
    }
    __builtin_amdgcn_sched_barrier(0);
}
template <int NCT, int NQS, int VSTR>
DEVI void attn_pv(LAS unsigned char* vbase, f4 (&o)[NQS][NCT], const h8 (&pf)[NQS][2], const int nkt, const int lane) {
    const int fr = lane & 15, g = lane >> 4, q_ = fr >> 2, p_ = fr & 3;
#pragma unroll
    for (int k2 = 0; k2 < 2; ++k2) if (2 * k2 < nkt) {
#pragma unroll
        for (int ct = 0; ct < NCT; ++ct) {
            const h4 lo = trrd(vbase + (32 * k2 + 4 * g + q_) * VSTR + (16 * ct + 4 * p_) * 2);
            const h4 hi = trrd(vbase + (32 * k2 + 16 + 4 * g + q_) * VSTR + (16 * ct + 4 * p_) * 2);
            const h8 vf = cat44(lo, hi);
#pragma unroll
            for (int qs = 0; qs < NQS; ++qs) o[qs][ct] = __builtin_amdgcn_mfma_f32_16x16x32_f16(vf, pf[qs][k2], o[qs][ct], 0, 0, 0); } }
    __builtin_amdgcn_sched_barrier(0);
}
template <int NKS, int NCT, int NQS, int KSTR, int VSTR>
DEVI void attn_tile(LAS unsigned char* kbase, LAS unsigned char* vbase, const h8 (&qf)[NQS][NKS], f4 (&o)[NQS][NCT], float (&mrow)[NQS], float (&lrow)[NQS], const int nkt, const int lane) {
    h8 pf[NQS][2];
    attn_qk<NKS, NCT, NQS, KSTR>(kbase, qf, o, mrow, lrow, pf, nkt, lane);
    attn_pv<NCT, NQS, VSTR>(vbase, o, pf, nkt, lane);
}


struct ConvP { const h16* up; h16* act; const float* fw; const float* fb; const float* stf; const float* st; const float* cv; const float* dv; float* pfc; size_t sdelta; };
DEVI void conv_gate_items(unsigned it_begin, unsigned it_end, unsigned it_step, const int rseg, const ConvP P) {
    constexpr int NCG = DFF / 8;
    for (unsigned it = it_begin; it < it_end; it += it_step) { const int seg = (int)(it / (unsigned)NCG), cg = (int)(it - (unsigned)seg * NCG), j0 = cg * 8, row0 = seg * rseg;
        const bool samp = row0 >= MP; const int t0 = samp ? ((row0 - MP) & 31) : (row0 & (SEQ - 1)), bb = (row0 - MP) >> 5, T = samp ? DSEQ : SEQ;
        const f4 bg0 = *(const f4*)(P.fb + j0), bg1 = *(const f4*)(P.fb + j0 + 4), bv0 = *(const f4*)(P.fb + DFF + j0), bv1 = *(const f4*)(P.fb + DFF + j0 + 4);
        const f4 cg0_ = *(const f4*)(P.cv + j0), cg1_ = *(const f4*)(P.cv + j0 + 4), cv0_ = *(const f4*)(P.cv + DFF + j0), cv1_ = *(const f4*)(P.cv + DFF + j0 + 4);
        const f4 dg0_ = *(const f4*)(P.dv + j0), dg1_ = *(const f4*)(P.dv + j0 + 4), dv0_ = *(const f4*)(P.dv + DFF + j0), dv1_ = *(const f4*)(P.dv + DFF + j0 + 4);
        f4 wg0[3], wg1[3], wv0[3], wv1[3];
#pragma unroll
        for (int j = 0; j < 3; ++j) { const float* wj = P.fw + (size_t)j * DFF2; wg0[j] = *(const f4*)(wj + j0); wg1[j] = *(const f4*)(wj + j0 + 4); wv0[j] = *(const f4*)(wj + DFF + j0); wv1[j] = *(const f4*)(wj + DFF + j0 + 4); }
#define CG_LOADROW(row, G0, G1, V0, V1) do { const h16* _u = P.up + (size_t)(row) * DFF2 + j0; const h8 _a = *(const h8*)_u, _c = *(const h8*)(_u + DFF); \
            const float _sm = P.st[2 * (row)], _sq = P.st[2 * (row) + 1], _mean = _sm * (1.f / DM), _rstd = __builtin_amdgcn_rsqf(_sq * (1.f / DM) - _mean * _mean + 1e-5f); \
            G0 = ((f4){(float)_a[0], (float)_a[1], (float)_a[2], (float)_a[3]} - cg0_ * _mean) * _rstd + dg0_; G1 = ((f4){(float)_a[4], (float)_a[5], (float)_a[6], (float)_a[7]} - cg1_ * _mean) * _rstd + dg1_; \
            V0 = ((f4){(float)_c[0], (float)_c[1], (float)_c[2], (float)_c[3]} - cv0_ * _mean) * _rstd + dv0_; V1 = ((f4){(float)_c[4], (float)_c[5], (float)_c[6], (float)_c[7]} - cv1_ * _mean) * _rstd + dv1_; } while (0)
        f4 ag0, ag1, av0, av1, bg0_, bg1_, bv0_, bv1_;
        if (t0 > 0) { CG_LOADROW(row0 - 2, ag0, ag1, av0, av1); CG_LOADROW(row0 - 1, bg0_, bg1_, bv0_, bv1_); }
        else if (samp) { const float* s2 = P.stf + (size_t)bb * 2 * DFF2; const float* s1 = s2 + DFF2;
            ag0 = *(const f4*)(s2 + j0); ag1 = *(const f4*)(s2 + j0 + 4); av0 = *(const f4*)(s2 + DFF + j0); av1 = *(const f4*)(s2 + DFF + j0 + 4);
            bg0_ = *(const f4*)(s1 + j0); bg1_ = *(const f4*)(s1 + j0 + 4); bv0_ = *(const f4*)(s1 + DFF + j0); bv1_ = *(const f4*)(s1 + DFF + j0 + 4); }
        else { ag0 = ag1 = av0 = av1 = bg0_ = bg1_ = bv0_ = bv1_ = (f4){0.f, 0.f, 0.f, 0.f}; }
        h16* ar = P.act + (size_t)row0 * DFF + j0;
        for (int r0 = 0; r0 < rseg; r0 += 4) { h8 ra[4], rc[4]; float rsm[4], rsq[4];
#pragma unroll
            for (int k = 0; k < 4; ++k) { const int row = row0 + r0 + k; const h16* u_ = P.up + (size_t)row * DFF2 + j0; ra[k] = *(const h8*)u_; rc[k] = *(const h8*)(u_ + DFF); rsm[k] = P.st[2 * row]; rsq[k] = P.st[2 * row + 1]; }
#pragma unroll
            for (int k = 0; k < 4; ++k) { const int r = r0 + k; const float mean = rsm[k] * (1.f / DM), rstd = __builtin_amdgcn_rsqf(rsq[k] * (1.f / DM) - mean * mean + 1e-5f);
                const f4 cg0 = ((f4){(float)ra[k][0], (float)ra[k][1], (float)ra[k][2], (float)ra[k][3]} - cg0_ * mean) * rstd + dg0_, cg1 = ((f4){(float)ra[k][4], (float)ra[k][5], (float)ra[k][6], (float)ra[k][7]} - cg1_ * mean) * rstd + dg1_;
                const f4 cv0 = ((f4){(float)rc[k][0], (float)rc[k][1], (float)rc[k][2], (float)rc[k][3]} - cv0_ * mean) * rstd + dv0_, cv1 = ((f4){(float)rc[k][4], (float)rc[k][5], (float)rc[k][6], (float)rc[k][7]} - cv1_ * mean) * rstd + dv1_;
                const f4 g0 = bg0 + ag0 * wg0[0] + bg0_ * wg0[1] + cg0 * wg0[2], g1 = bg1 + ag1 * wg1[0] + bg1_ * wg1[1] + cg1 * wg1[2];
                const f4 v0 = bv0 + av0 * wv0[0] + bv0_ * wv0[1] + cv0 * wv0[2], v1 = bv1 + av1 * wv1[0] + bv1_ * wv1[1] + cv1 * wv1[2];
                h8 o;
#pragma unroll
                for (int e = 0; e < 4; ++e) { o[e] = (h16)(gelu_f(g0[e]) * v0[e]); o[4 + e] = (h16)(gelu_f(g1[e]) * v1[e]); }
                __builtin_nontemporal_store(o, (h8*)(ar + (size_t)r * DFF));
                const int t = t0 + r;
                if (t >= T - 2) { float* so = P.pfc + (samp ? P.sdelta + ((size_t)bb * 2 + (t - (T - 2))) * DFF2 : ((size_t)(row0 >> 11) * 2 + (t - (T - 2))) * DFF2) + j0;
                    *(f4*)so = cg0; *(f4*)(so + 4) = cg1; *(f4*)(so + DFF) = cv0; *(f4*)(so + DFF + 4) = cv1; }
                ag0 = bg0_; ag1 = bg1_; av0 = bv0_; av1 = bv1_; bg0_ = cg0; bg1_ = cg1; bv0_ = cv0; bv1_ = cv1; } } }
#undef CG_LOADROW
}

#define XB_TMO      128
#define XB_XCNT(j)  (256  + 64 * (j))
#define XB_XSUB(j)  (1280 + 64 * (j))
#define XB_XGEN(j)  (2304 + 64 * (j))
#define XB_TOP      3328
#define XB_TOPGEN   3392
#define XCD_BAR_WORDS 3456
#define XB_SPIN_CAP (1u << 18)
DEVI unsigned xb_ld(unsigned* p)              { return __hip_atomic_load(p, __ATOMIC_RELAXED, __HIP_MEMORY_SCOPE_AGENT); }
DEVI unsigned xb_add(unsigned* p, unsigned v) { return __hip_atomic_fetch_add(p, v, __ATOMIC_RELAXED, __HIP_MEMORY_SCOPE_AGENT); }
DEVI unsigned xb_xcc_id() { return (unsigned)__builtin_amdgcn_s_getreg((3 << 11) | 20) & 0xFu; }
#define XB_SPIN(cond, bar) do { unsigned _sp = 0; while (cond) { __builtin_amdgcn_s_sleep(1); \
    if ((++_sp & 255u) == 0u) { if (xb_ld(&(bar)[XB_TMO])) break; if (_sp > XB_SPIN_CAP) { atomicAdd(&(bar)[XB_TMO], 1u); break; } } } } while (0)
DEVI void xb_complete(unsigned* bar, unsigned x, unsigned& nloc, unsigned& nx, unsigned G) {
    unsigned sum, cnt, mine, sp = 0u;
    for (;;) {
        sum = 0u; cnt = 0u; mine = 0u;
#pragma unroll
        for (unsigned j = 0; j < 16; ++j) { const unsigned c = xb_ld(&bar[XB_XCNT(j)]); sum += c; cnt += (c > 0u) ? 1u : 0u; mine = (j == x) ? c : mine; }
        if (sum == G) break;
        __builtin_amdgcn_s_sleep(1);
        if ((++sp & 255u) == 0u) { if (xb_ld(&bar[XB_TMO])) break; if (sp > XB_SPIN_CAP) { atomicAdd(&bar[XB_TMO], 1u); break; } }
    }
    nloc = mine > 0u ? mine : 1u; nx = cnt > 0u ? cnt : 1u;
}
DEVI void xbar(unsigned* bar, volatile LAS unsigned* st, int tid, unsigned G) {
    asm volatile("s_waitcnt vmcnt(0)" ::: "memory");
    __syncthreads();
    if (tid == 0) {
        const unsigned x = xb_xcc_id();
        __builtin_amdgcn_s_waitcnt(0);
        unsigned nloc = st[0], nx = st[1];
        if (nloc == 0u) { xb_complete(bar, x, nloc, nx, G); st[0] = nloc; st[1] = nx; }
        const unsigned old = xb_add(&bar[XB_XSUB(x)], 1u);
        const unsigned gen = old / nloc;
        if (old + 1u == (gen + 1u) * nloc) {
            __builtin_amdgcn_fence(__ATOMIC_RELEASE, "agent");
            asm volatile("s_waitcnt vmcnt(0)" ::: "memory");
            const unsigned og = xb_add(&bar[XB_TOP], 1u);
            const unsigned tg = og / nx;
            if (og + 1u == (tg + 1u) * nx) xb_add(&bar[XB_TOPGEN], 1u);
            else XB_SPIN(xb_ld(&bar[XB_TOPGEN]) == tg, bar);
            __builtin_amdgcn_fence(__ATOMIC_ACQUIRE, "agent");
            xb_add(&bar[XB_XGEN(x)], 1u);
            asm volatile("s_waitcnt vmcnt(0)" ::: "memory");
        } else {
            XB_SPIN(xb_ld(&bar[XB_XGEN(x)]) == gen, bar);
            __builtin_amdgcn_fence(__ATOMIC_ACQUIRE, "agent");
            asm volatile("s_waitcnt vmcnt(0)" ::: "memory");
        }
    }
    __syncthreads();
}
#ifndef PHM
#define PHM 0xFFFFFFFFu
#endif
#ifndef DBL
#define DBL 0u
#endif
#define NREP(k) (((DBL >> (k)) & 1u) ? 2 : 1)
__global__ void __launch_bounds__(512, 2) trunk_fwd(Params p) {
    extern __shared__ __attribute__((aligned(16))) unsigned char shm_raw[];
    LAS unsigned char* lds = (LAS unsigned char*)shm_raw;
    __shared__ uint4 s_ctl;
#define s_item (*(LAS int*)&s_ctl)
    cg::grid_group grid = cg::this_grid();
    const int wave_s = __builtin_amdgcn_readfirstlane((int)threadIdx.x >> 6);
    if (threadIdx.x == 0) { s_ctl = make_uint4(0u, 0u, 0u, 0u); (void)xb_add((unsigned*)(p.ws + W_BAR) + XB_XCNT(xb_xcc_id()), 1u); }
    __syncthreads();
#define GSYNC() do { const __attribute__((address_space(4))) Params* kq = (const __attribute__((address_space(4))) Params*)__builtin_amdgcn_kernarg_segment_ptr(); asm volatile("" : "+s"(kq)); \
        unsigned Gq = gridDim.x; asm volatile("" : "+s"(Gq)); xbar((unsigned*)(kq->ws + W_BAR), (volatile LAS unsigned*)&s_ctl + 1, wave_s * 64 + opaque_lane(), Gq); } while (0)
#define PH_BEGIN \
    int tid = wave_s * 64 + opaque_lane(); asm volatile("" : "+v"(tid)); \
    int bid = blockIdx.x, G = gridDim.x, lq = l; asm volatile("" : "+s"(bid), "+s"(G), "+s"(lq)); \
    const int lane = tid & 63, wave = __builtin_amdgcn_readfirstlane(tid >> 6); \
    const int gw = bid * 8 + wave, NGW = G * 8; const size_t gtid = (size_t)bid * 512 + tid, NGT = (size_t)G * 512; \
    const __attribute__((address_space(4))) Params* kp = (const __attribute__((address_space(4))) Params*)__builtin_amdgcn_kernarg_segment_ptr(); asm volatile("" : "+s"(kp)); \
    unsigned char* ws = kp->ws; float* out = kp->out; \
    (void)lane; (void)wave; (void)gw; (void)NGW; (void)gtid; (void)NGT; (void)out; (void)lq;
#define WSP(T, off) ((T*)(ws + (off)))
    for (int rep = 0; rep < NREP(0); ++rep) if (PHM & 1u) {
        int tid = wave_s * 64 + opaque_lane(); asm volatile("" : "+v"(tid));
        const int bid = blockIdx.x, G = gridDim.x, lane = tid & 63, wave = __builtin_amdgcn_readfirstlane(tid >> 6);
        const int gw = bid * 8 + wave, NGW = G * 8; const size_t gtid = (size_t)bid * 512 + tid, NGT = (size_t)G * 512;
        unsigned char* ws = p.ws;
        h16* xh = WSP(h16, W_XH); float* ropec = WSP(float, W_ROPE); float* ropes = ropec + NPOS * 16;
        for (size_t i = gtid; i < (size_t)MT * DM / 8; i += NGT) { const size_t e = i * 8; const float* src = e < (size_t)MP * DM ? p.in[0] + e : p.in[1] + (e - (size_t)MP * DM);
            *(h8*)(xh + e) = pack8(__builtin_nontemporal_load((const f4*)src), __builtin_nontemporal_load((const f4*)(src + 4))); }
        for (size_t i = gtid; i < (size_t)NPOS * 16; i += NGT) { const int pi = (int)(i >> 4), fi = (int)(i & 15); const double pos = pi < SEQ ? (double)pi : (double)(PAST + pi - SEQ);
            const double ang = pos * exp(-(double)fi / 16.0 * 9.210340371976184); ropec[i] = (float)cos(ang); ropes[i] = (float)sin(ang); }
        for (size_t i = gtid; i < (size_t)DEPTH * 256; i += NGT) WSP(float, W_SP)[i] = log1pf(expf(-p.in[26][i]));
        LAS float* scr = (LAS float*)(lds + wave * 8448);
        for (int l = 0; l < DEPTH; ++l) {
            h16* wt_in = WSP(h16, W_WIN + l * SZ_WIN); h16* wt_uq = WSP(h16, W_WUQ + l * SZ_WUQ); h16* wt_kv = WSP(h16, W_WKV + l * SZ_WKV);
            h16* wt_o = WSP(h16, W_WO + l * SZ_WO); h16* wt_os = WSP(h16, W_WOS + l * SZ_WOS); h16* wt_up = WSP(h16, W_WUP + l * SZ_WUP); h16* wt_dn = WSP(h16, W_WDN + l * SZ_WDN);
            h16* wt_ql = WSP(h16, W_WQL + l * SZ_WQL); h16* wt_g = WSP(h16, W_WG + l * SZ_WG);
            const float* w_in = p.in[11] + (size_t)l * DM * DIN; const float* w_o = p.in[12] + (size_t)l * DM * DM; const float* w_uq = p.in[16] + (size_t)l * 384 * 768;
            const float* w_uk = p.in[18] + (size_t)l * 256 * 512; const float* w_uv = p.in[19] + (size_t)l * 256 * 512; const float* w_up = p.in[27] + (size_t)l * DM * DFF2; const float* w_dn = p.in[30] + (size_t)l * DFF * DM;
            const float* w_r = p.in[22] + (size_t)l * 4 * 64 * 64; const float* w_i = p.in[24] + (size_t)l * 4 * 64 * 64;
            for (int it = gw; it < 16 * 53; it += NGW) transpose_item<0>(w_in, DIN, 53, wt_in, 1024, scr, it, lane, l > 0 ? p.in[9] + (l - 1) * DM : nullptr, l > 0 ? p.in[10] + (l - 1) * DM : nullptr, rep ? nullptr : WSP(float, W_CD + l * SZ_CD), WSP(float, W_CD + l * SZ_CD) + ZW);
            for (int it = gw; it < 6 * 24; it += NGW) transpose_item<1>(w_uq, 768, 24, wt_uq, 384, scr, it, lane);
            for (int it = gw; it < 4 * 16; it += NGW) transpose_item<0>(w_uk, 512, 16, wt_kv, 256, scr, it, lane);
            for (int it = gw; it < 4 * 16; it += NGW) transpose_item<0>(w_uv, 512, 16, wt_kv + 512 * 256, 256, scr, it, lane);
            for (int it = gw; it < 16 * 32; it += NGW) transpose_item<0>(w_o, 1024, 32, wt_o, 1024, scr, it, lane);
            for (int it = gw; it < 16 * 176; it += NGW) transpose_item<0>(w_up, DFF2, 176, wt_up, 1024, scr, it, lane, p.in[7] + l * DM, p.in[8] + l * DM, rep ? nullptr : WSP(float, W_CD + l * SZ_CD) + 2 * ZW, WSP(float, W_CD + l * SZ_CD) + 2 * ZW + DFF2);
            for (int it = gw; it < 44 * 32; it += NGW) transpose_item<0>(w_dn, 1024, 32, wt_dn, DFF, scr, it, lane);
            for (size_t i = gtid; i < (size_t)(ZW - DIN) * 1024 / 8; i += NGT) *(h8*)(wt_in + (size_t)DIN * 1024 + i * 8) = (h8){0, 0, 0, 0, 0, 0, 0, 0};
            for (size_t i = gtid; i < (size_t)512 * 256; i += NGT) { const int n = (int)(i >> 8), k = (int)(i & 255); const int pn = n >> 8, jj = n & 127, isI = (n >> 7) & 1, ch = pn * 128 + jj;
                float v = 0.f; if ((k >> 6) == (ch >> 6)) v = (isI ? w_i : w_r)[((ch >> 6) * 64 + (k & 63)) * 64 + (ch & 63)];
                wt_g[i] = (h16)v; }
            for (int it = gw; it < 8 * 24 * 16; it += NGW) { const int hh = it / (24 * 16), kt = (it / 16) % 24, ct = it % 16, fr = lane & 15, g4 = lane >> 4;
                f4 accq = (f4){0.f, 0.f, 0.f, 0.f};
#pragma unroll
                for (int ks = 0; ks < 2; ++ks) { const float* ap = w_uq + (size_t)(16 * kt + fr) * 768 + hh * 96 + 32 * ks + 8 * g4; const float* bp = w_uk + (size_t)(16 * ct + fr) * 512 + hh * 64 + 32 * ks + 8 * g4;
                    accq = __builtin_amdgcn_mfma_f32_16x16x32_f16(pack8(*(const f4*)ap, *(const f4*)(ap + 4)), pack8(*(const f4*)bp, *(const f4*)(bp + 4)), accq, 0, 0, 0); }
                *(h4*)(wt_ql + (size_t)(hh * 256 + 16 * ct + fr) * 384 + 16 * kt + 4 * g4) = pack4(accq); }
            for (size_t i = gtid; i < (size_t)8 * 64 * 256; i += NGT) { const int c = (int)(i & 255), hd = (int)(i >> 8); wt_os[i] = (h16)w_uv[(size_t)c * 512 + hd]; }
        }
    }
    grid.sync();

    for (int l = 0; l < DEPTH; ++l) {
        for (int rep = 0; rep < NREP(1); ++rep) if (PHM & (1u << 1)) { PH_BEGIN
          Gemm g{WSP(h16, W_XH), WSP(h16, W_WIN + lq * SZ_WIN), MT, ZW, 1024, 1024, 1024}; StaticOrder S; S.init(MT, ZW, G, bid); const int lp = lq > 0 ? lq - 1 : 0; EpiZ E{WSP(h16, W_Z), out + O_SV + (size_t)lq * MS * 256, WSP(float, W_STATS + (size_t)(lp * 2 + 1) * SZ_STATS), WSP(float, W_CD + lq * SZ_CD), WSP(float, W_CD + lq * SZ_CD) + ZW, lq > 0}; gemm_phase(lds, g, S, E, tid); }
        GSYNC();

        for (int rep = 0; rep < NREP(2); ++rep) if (PHM & (1u << 2)) { PH_BEGIN
            const float* qn_g = kp->in[15] + lq * 384; const float* kvn_g = kp->in[17] + lq * 256;
            const float* cw = kp->in[20] + (size_t)lq * 4 * 256; const float* cb = kp->in[21] + lq * 256; const float* stc = kp->in[5] + (size_t)lq * DBATCH * 3 * 256;
            const h16* __restrict__ z = WSP(h16, W_Z); h16* __restrict__ cqn = WSP(h16, W_CQN); h16* __restrict__ ckvn = WSP(h16, W_CKVN); h16* __restrict__ knew = WSP(h16, W_KNEW); h16* __restrict__ kb = WSP(h16, W_K); h16* __restrict__ xc = WSP(h16, W_XC);
            const float* __restrict__ ropec = WSP(float, W_ROPE); const float* __restrict__ ropes = ropec + NPOS * 16;
            for (int row = gw; row < MT; row += NGW) {
                const h16* zr = z + (size_t)row * ZW; const bool samp = row >= MP; const int rs = row - MP;
                const int t = samp ? (rs & 31) : (row & (SEQ - 1)), bb = samp ? (rs >> 5) : (row >> 11), T = samp ? DSEQ : SEQ;
                h2 xq[3];
#pragma unroll
                for (int i = 0; i < 3; ++i) xq[i] = *(const h2*)(zr + 512 + 2 * lane + 128 * i);
                const h4 xkv = *(const h4*)(zr + 896 + 4 * lane);
                const int pidx = samp ? SEQ + t : t, l16 = lane & 15;
                const float rc = ropec[pidx * 16 + l16], rsn = ropes[pidx * 16 + l16], kx1 = (float)zr[1152 + l16], kx2 = (float)zr[1168 + l16];
                const int c = 4 * lane; f4 xl[4];
#pragma unroll
                for (int j = 0; j < 4; ++j) { const int tau = t - 3 + j;
                    if (tau >= 0) { const h4 x = *(const h4*)(zr - (ptrdiff_t)(3 - j) * ZW + 1184 + c); xl[j] = (f4){(float)x[0], (float)x[1], (float)x[2], (float)x[3]}; }
                    else if (samp) xl[j] = *(const f4*)(stc + ((size_t)bb * 3 + (3 + tau)) * 256 + c);
                    else xl[j] = (f4){0.f, 0.f, 0.f, 0.f}; }
                float vq[6], ssq = 0.f, sskv = 0.f; f4 vkv;
#pragma unroll
                for (int i = 0; i < 3; ++i) { vq[2 * i] = (float)xq[i][0]; vq[2 * i + 1] = (float)xq[i][1]; ssq += vq[2 * i] * vq[2 * i] + vq[2 * i + 1] * vq[2 * i + 1]; }
#pragma unroll
                for (int e = 0; e < 4; ++e) { vkv[e] = (float)xkv[e]; sskv += vkv[e] * vkv[e]; }
#pragma unroll
                for (int o = 1; o < 64; o <<= 1) { ssq += shx(ssq, o, lane); sskv += shx(sskv, o, lane); }
                { const float rr = rsqrtf(ssq * (1.f / 384.f) + 1e-6f);
#pragma unroll
                  for (int i = 0; i < 3; ++i) { const int cc = 2 * lane + 128 * i; h2 o; o[0] = (h16)(vq[2 * i] * rr * qn_g[cc]); o[1] = (h16)(vq[2 * i + 1] * rr * qn_g[cc + 1]); *(h2*)(cqn + (size_t)row * 384 + cc) = o; } }
                { const float rr = rsqrtf(sskv * (1.f / 256.f) + 1e-6f); const f4 v = vkv * rr * *(const f4*)(kvn_g + 4 * lane);
                  if (!samp) { __builtin_nontemporal_store(v, (f4*)(out + O_PLAT + ((size_t)lq * MP + row) * 256 + 4 * lane)); *(h4*)(ckvn + (size_t)row * 256 + 4 * lane) = pack4(v); }
                  else { __builtin_nontemporal_store(v, (f4*)(out + O_SLAT + ((size_t)lq * MS + rs) * 256 + 4 * lane)); *(h4*)(knew + (size_t)rs * KNW + 4 * lane) = pack4(v); } }
                if (lane < 16) { const float o1 = kx1 * rc - kx2 * rsn, o2 = kx1 * rsn + kx2 * rc;
                    if (!samp) { float* o = out + O_PKR + ((size_t)lq * MP + row) * 32; o[lane] = o1; o[16 + lane] = o2;
                        h16* kr = kb + (size_t)row * KW + 64;
#pragma unroll
                        for (int hh = 0; hh < 8; ++hh) { kr[hh * 96 + lane] = (h16)o1; kr[hh * 96 + 16 + lane] = (h16)o2; } }
                    else { float* o = out + O_SKR + ((size_t)lq * MS + rs) * 32; o[lane] = o1; o[16 + lane] = o2; knew[(size_t)rs * KNW + 256 + lane] = (h16)o1; knew[(size_t)rs * KNW + 272 + lane] = (h16)o2; } }
                { f4 accv = *(const f4*)(cb + c);
#pragma unroll
                  for (int j = 0; j < 4; ++j) accv += xl[j] * *(const f4*)(cw + j * 256 + c);
                  if (t >= T - 3) { float* o = samp ? out + O_SLC + (((size_t)lq * DBATCH + bb) * 3 + (t - (T - 3))) * 256 : out + O_PLC + (((size_t)lq * NB + bb) * 3 + (t - (T - 3))) * 256; *(f4*)(o + c) = xl[3]; }
                  *(h4*)(xc + (size_t)row * 256 + c) = pack4(accv); }
            }
        }
        GSYNC();

        for (int rep = 0; rep < NREP(3); ++rep) if (PHM & (1u << 3)) { PH_BEGIN
          Gemm g{WSP(h16, W_CQN), WSP(h16, W_WUQ + lq * SZ_WUQ), MT, 768, 384, 384, 384}; StaticOrder S; S.init(MT, 768, G, bid);
          EpiQ E{WSP(h16, W_Q), WSP(h16, W_QLAT), WSP(float, W_ROPE), WSP(float, W_ROPE) + NPOS * 16}; gemm_phase(lds, g, S, E, tid); }
        for (int rep = 0; rep < NREP(4); ++rep) if (PHM & (1u << 4)) { PH_BEGIN
          Gemm g{WSP(h16, W_CKVN), WSP(h16, W_WKV + lq * SZ_WKV), MP, 1024, 256, 256, 256}; StaticOrder S; S.init(MP, 1024, G, (bid + G - (396 % G)) % G); EpiKV E{WSP(h16, W_K), WSP(h16, W_V)}; gemm_phase(lds, g, S, E, tid); }
        for (int rep = 0; rep < NREP(5); ++rep) if (PHM & (1u << 5)) { PH_BEGIN
          Gemm g{WSP(h16, W_XC), WSP(h16, W_WG + lq * SZ_WG), MT, 512, 256, 256, 256}; StaticOrder S; S.init(MT, 512, G, (bid + G - (908 % G)) % G);
          EpiGate E{WSP(h16, W_XC), WSP(float, W_A), WSP(float, W_B), kp->in[23] + lq * 256, kp->in[25] + lq * 256, WSP(float, W_SP) + lq * 256}; gemm_phase(lds, g, S, E, tid); }
        for (int rep = 0; rep < NREP(6); ++rep) if (PHM & (1u << 6)) { PH_BEGIN
          Gemm g{WSP(h16, W_CQN) + (size_t)MP * 384, WSP(h16, W_WQL + lq * SZ_WQL), MS, 2048, 384, 384, 384}; StaticOrder S; S.init(MS, 2048, G, (bid + G - (1172 % G)) % G); EpiQlat E{WSP(h16, W_QLAT)}; gemm_phase(lds, g, S, E, tid); }
        for (int rep = 0; rep < NREP(7); ++rep) if (PHM & (1u << 7)) { PH_BEGIN
            const float* gw_s = kp->in[13] + (size_t)lq * 4 * 128 * 128; const float* gb_s = kp->in[14] + (size_t)lq * 4 * 128;
            const h16* z = WSP(h16, W_Z); h16* cat = WSP(h16, W_CAT); h16* cats = WSP(h16, W_CATS);
            const int fr = lane & 15, g4 = lane >> 4, q_ = fr >> 2, p_ = fr & 3;
            for (int item = (bid + G - (1204 % G)) % G; item < 1024 + 128; item += G) {
                const bool samp = item >= 1024; const int head = item & 3; const int ci = samp ? (item - 1024) >> 2 : item >> 2;
                const int R0 = samp ? MP + ci * 32 : ci * 128, L = samp ? 32 : 128;
                __syncthreads();
                for (int id = tid; id < L * 8; id += 512) { const int j = id >> 3, part = id & 7; *(LAS h8*)(lds + j * 144 + part * 16) = *(const h8*)(z + (size_t)(R0 + j) * ZW + 256 + head * 64 + part * 8); }
                __syncthreads();
                const int i0 = 16 * wave;
                if (i0 < L) {
                    f4 sacc[4];
#pragma unroll
                    for (int ct = 0; ct < 4; ++ct) sacc[ct] = (f4){0.f, 0.f, 0.f, 0.f};
                    const int i = i0 + fr;
#pragma unroll
                    for (int ks = 0; ks < 4; ++ks) if (32 * ks <= i0 + 15 && 32 * ks < L) {
                        const int j0 = 32 * ks + 8 * g4; const float* wp = gw_s + ((size_t)head * 128 + i) * 128 + j0; const f4 w0 = *(const f4*)wp, w1 = *(const f4*)(wp + 4);
                        h8 wf;
#pragma unroll
                        for (int e = 0; e < 4; ++e) { wf[e] = (h16)((j0 + e <= i) ? w0[e] : 0.f); wf[4 + e] = (h16)((j0 + 4 + e <= i) ? w1[e] : 0.f); }
#pragma unroll
                        for (int ct = 0; ct < 4; ++ct) { const h4 lo = trrd(lds + (32 * ks + 8 * g4 + q_) * 144 + (16 * ct + 4 * p_) * 2), hi = trrd(lds + (32 * ks + 8 * g4 + 4 + q_) * 144 + (16 * ct + 4 * p_) * 2);
                            sacc[ct] = __builtin_amdgcn_mfma_f32_16x16x32_f16(wf, cat44(lo, hi), sacc[ct], 0, 0, 0); } }
                    float uval[4][4], bsv[4];
#pragma unroll
                    for (int jx = 0; jx < 4; ++jx) { const int ii = i0 + 4 * g4 + jx; bsv[jx] = gb_s[head * 128 + ii];
#pragma unroll
                        for (int ct = 0; ct < 4; ++ct) uval[jx][ct] = (float)z[((size_t)R0 + ii) * ZW + head * 64 + 16 * ct + fr]; }
#pragma unroll
                    for (int jx = 0; jx < 4; ++jx) { const size_t r = (size_t)R0 + i0 + 4 * g4 + jx;
#pragma unroll
                        for (int ct = 0; ct < 4; ++ct) cat[r * 1024 + head * 64 + 16 * ct + fr] = (h16)(uval[jx][ct] * (sacc[ct][jx] + bsv[jx])); }
                }
            }
            __syncthreads();
        }
        GSYNC();

        for (int rep = 0; rep < NREP(8); ++rep) if (PHM & (1u << 8)) { PH_BEGIN
            unsigned* counter = WSP(unsigned, W_CTR) + lq * 16 + rep * 8;
            constexpr int N_SA = 256, N_PA = 1024, N_PS = 128, N_SS = 16, N_WO = 16, N_UP = 88, N_ALL = N_SA + N_PA + N_PS + N_SS + N_WO + N_UP, Q_WO = N_PS + N_SS + N_SA + 256, Q_UP = Q_WO + N_WO + 256;
            unsigned* wdone = WSP(unsigned, W_CTR) + 800 + lq * 8 + rep * 4;
            unsigned* sdone = WSP(unsigned, W_CTR) + 768 + lq * 2 + rep;
            for (;;) {
                __syncthreads();
                if (tid == 0) s_item = (int)atomicAdd(counter, 1u);
                __syncthreads();
                const int qi = s_item;
                if (qi >= N_ALL) break;
                int tix = tid; asm volatile("" : "+v"(tix));
                const int ln = tix & 63, fr = ln & 15, g4 = ln >> 4;
                const int qj = qi < Q_WO ? qi : (qi < Q_WO + N_WO ? -1 : (qi < Q_UP ? qi - N_WO : (qi < Q_UP + N_UP ? -2 : qi - N_WO - N_UP)));
                const int item = qj < 0 ? qj : (qj < N_PS + N_SS ? qj + N_SA + N_PA : qj - (N_PS + N_SS));
                if (item == -2) {
                    const int ui = qi - Q_UP, pnl = ui / 22, pnc = ui - pnl * 22;
                    if (tix == 0) { unsigned sp = 0; while (xb_ld(wdone + pnl) < 4u) { __builtin_amdgcn_s_sleep(4); if (++sp > (1u << 22)) break; }
                        __builtin_amdgcn_fence(__ATOMIC_ACQUIRE, "agent"); asm volatile("s_waitcnt vmcnt(0)" ::: "memory"); }
                    __syncthreads();
                    const int ro = (MP / BM + pnl) * BM;
                    Gemm g{WSP(h16, W_XH) + (size_t)ro * DM, WSP(h16, W_WUP + lq * SZ_WUP), BM, DFF2, 1024, 1024, 1024}; StaticOrder S; S.init(BM, DFF2, 22, pnc);
                    EpiUp E{WSP(h16, W_UP), ro};
                    gemm_phase(lds, g, S, E, tix);
                } else if (item < 0) {
                    if (tix == 0) { unsigned sp = 0; while (xb_ld(sdone) < 80u) { __builtin_amdgcn_s_sleep(4); if (++sp > (1u << 22)) break; }
                        __builtin_amdgcn_fence(__ATOMIC_ACQUIRE, "agent"); asm volatile("s_waitcnt vmcnt(0)" ::: "memory"); }
                    __syncthreads();
                    const int wi = qi - Q_WO, lp = lq > 0 ? lq - 1 : 0; const size_t ro = (size_t)(MP / BM + (wi >> 2)) * BM;
                    Gemm g{WSP(h16, W_CAT) + ro * 1024, WSP(h16, W_WO + lq * SZ_WO), BM, 1024, 1024, 1024, 1024}; StaticOrder S; S.init(BM, 1024, 4, wi & 3);
                    EpiRes E{WSP(h16, W_XH) + ro * DM, WSP(float, W_STATS + (size_t)(lp * 2 + 1) * SZ_STATS) + 2 * ro, kp->in[9] + lp * DM, kp->in[10] + lp * DM, lq > 0, WSP(float, W_STATS + (size_t)(lq * 2) * SZ_STATS) + 2 * ro};
                    gemm_phase(lds, g, S, E, tix);
                    __syncthreads();
                    if (tix == 0) { __builtin_amdgcn_fence(__ATOMIC_RELEASE, "agent"); asm volatile("s_waitcnt vmcnt(0)" ::: "memory"); (void)xb_add(wdone + (wi >> 2), 1u); }
                } else if (item < N_SA) {
                    constexpr int KS = 608;
                    const float* clat = kp->in[2] + (size_t)lq * DBATCH * PAST * 256; const float* ckr = kp->in[3] + (size_t)lq * DBATCH * PAST * 32;
                    const h16* qlat = WSP(h16, W_QLAT); const h16* knew = WSP(h16, W_KNEW); h16* cats = WSP(h16, W_CATS);
                    const int b = item >> 3, hg = (item >> 2) & 1, sp = item & 3, head = 4 * hg + (wave >> 1), tq = 16 * (wave & 1) + fr, t0 = sp * 16;
                    h8 qf[1][9];
#pragma unroll
                    for (int ks = 0; ks < 9; ++ks) qf[0][ks] = *(const h8*)(qlat + (size_t)(b * 32 + tq) * QLW + head * 288 + 32 * ks + 8 * g4);
                    f4 o[1][16]; float mrow[1] = {-1e30f}, lrow[1] = {0.f};
#pragma unroll
                    for (int ct = 0; ct < 16; ++ct) o[0][ct] = (f4){0.f, 0.f, 0.f, 0.f};
                    const float* lb = clat + (size_t)b * PAST * 256 + (size_t)(t0 * 64 + (tix >> 6)) * 256 + (tix & 63) * 4; const float* rb = ckr + (size_t)b * PAST * 32 + (size_t)(t0 * 64 + (tix >> 3)) * 32 + (tix & 7) * 4;
                    const int wl = (tix >> 6) * KS + (tix & 63) * 8, wr_ = (tix >> 3) * KS + 512 + (tix & 7) * 8;
                    f4 pl[4]; f4 pr;
#pragma unroll
                    for (int hf = 0; hf < 2; ++hf) {
#pragma unroll
                        for (int i = 0; i < 4; ++i) pl[i] = *(const f4*)(lb + (size_t)(hf * 4 + i) * 8 * 256);
#pragma unroll
                        for (int i = 0; i < 4; ++i) *(LAS h4*)(lds + wl + (hf * 4 + i) * 8 * KS) = pack4(pl[i]); }
                    pr = *(const f4*)rb;
                    *(LAS h4*)(lds + wr_) = pack4(pr);
                    __syncthreads();
                    for (int t = 0; t < 16; ++t) {
                        LAS unsigned char* cur = lds + (t & 1) * (64 * KS); LAS unsigned char* nxt = lds + ((t + 1) & 1) * (64 * KS);
                        const bool more = t + 1 < 16;
                        if (more) {
#pragma unroll
                            for (int i = 0; i < 4; ++i) pl[i] = *(const f4*)(lb + ((size_t)(t + 1) * 64 + i * 8) * 256);
                            pr = *(const f4*)(rb + (size_t)(t + 1) * 64 * 32);
                        }
                        h8 pf[1][2];
                        attn_qk<9, 16, 1, KS>(cur, qf, o, mrow, lrow, pf, 4, ln);
                        if (more) {
#pragma unroll
                            for (int i = 0; i < 4; ++i) *(LAS h4*)(nxt + wl + i * 8 * KS) = pack4(pl[i]);
                            *(LAS h4*)(nxt + wr_) = pack4(pr);
#pragma unroll
                            for (int i = 0; i < 4; ++i) pl[i] = *(const f4*)(lb + ((size_t)(t + 1) * 64 + (4 + i) * 8) * 256);
                        }
                        attn_pv<16, 1, KS>(cur, o, pf, 4, ln);
                        if (more) {
#pragma unroll
                            for (int i = 0; i < 4; ++i) *(LAS h4*)(nxt + wl + (4 + i) * 8 * KS) = pack4(pl[i]);
                        } else if (sp == 3) {
                            for (int id = tix; id < 32 * 36; id += 512) { const int key = id / 36, part = id % 36; *(LAS h8*)(nxt + key * KS + part * 16) = *(const h8*)(knew + (size_t)(b * 32 + key) * KNW + part * 8); }
                        }
                        __syncthreads();
                    }
                    if (sp == 3) attn_tile<9, 16, 1, KS, KS>(lds, lds, qf, o, mrow, lrow, 2, ln);
                    { unsigned char* pw = ws + W_PART + ((size_t)item * 8 + wave) * SZ_PARTW;
#pragma unroll
                      for (int ct = 0; ct < 16; ++ct) *(f4*)(pw + ct * 1024 + ln * 16) = o[0][ct];
                      *(float*)(pw + 16384 + ln * 4) = mrow[0]; *(float*)(pw + 16640 + ln * 4) = lrow[0]; }
                    asm volatile("s_waitcnt vmcnt(0)" ::: "memory");
                    __syncthreads();
                    if (tix == 0) { __builtin_amdgcn_fence(__ATOMIC_RELEASE, "agent"); asm volatile("s_waitcnt vmcnt(0)" ::: "memory");
                        const unsigned old = xb_add(WSP(unsigned, W_CTR) + 256 + lq * 64 + rep * 512 + (item >> 2), 1u);
                        if (old == 3u) { __builtin_amdgcn_fence(__ATOMIC_ACQUIRE, "agent"); asm volatile("s_waitcnt vmcnt(0)" ::: "memory"); }
                        *((LAS int*)&s_ctl + 3) = (int)old; }
                    __syncthreads();
                    if (*((LAS int*)&s_ctl + 3) == 3) {
                        const unsigned char* p0 = ws + W_PART + ((size_t)(item & ~3) * 8 + wave) * SZ_PARTW;
                        float mi[4], M = -1e30f;
#pragma unroll
                        for (int i = 0; i < 4; ++i) { mi[i] = *(const float*)(p0 + (size_t)i * 8 * SZ_PARTW + 16384 + ln * 4); M = fmaxf(M, mi[i]); }
                        float L = 0.f;
#pragma unroll
                        for (int i = 0; i < 4; ++i) { mi[i] = __builtin_amdgcn_exp2f(mi[i] - M); L += mi[i] * *(const float*)(p0 + (size_t)i * 8 * SZ_PARTW + 16640 + ln * 4); }
                        L += shx(L, 16, ln); L += shx(L, 32, ln); const float inv = 1.f / L;
                        h8 bf[8];
#pragma unroll
                        for (int ks = 0; ks < 8; ++ks) { f4 u0 = (f4){0.f, 0.f, 0.f, 0.f}, u1 = u0;
#pragma unroll
                            for (int i = 0; i < 4; ++i) { u0 += *(const f4*)(p0 + (size_t)i * 8 * SZ_PARTW + (2 * ks) * 1024 + ln * 16) * mi[i]; u1 += *(const f4*)(p0 + (size_t)i * 8 * SZ_PARTW + (2 * ks + 1) * 1024 + ln * 16) * mi[i]; }
                            bf[ks] = pack8(u0 * inv, u1 * inv); }
                        const h16* wuvt = WSP(h16, W_WOS + lq * SZ_WOS) + (size_t)head * 64 * 256;
                        h16* dst = cats + (size_t)(b * 32 + tq) * 1024 + 256 + head * 64 + 4 * g4;
#pragma unroll
                        for (int dt = 0; dt < 4; ++dt) { f4 od = (f4){0.f, 0.f, 0.f, 0.f};
#pragma unroll
                            for (int ks = 0; ks < 8; ++ks) { const h16* wp = wuvt + (size_t)(16 * dt + fr) * 256 + 32 * ks + 4 * g4;
                                od = __builtin_amdgcn_mfma_f32_16x16x32_f16(cat44(*(const h4*)wp, *(const h4*)(wp + 16)), bf[ks], od, 0, 0, 0); }
                            *(h4*)(dst + 16 * dt) = pack4(od); }
                        asm volatile("s_waitcnt vmcnt(0)" ::: "memory"); __syncthreads();
                        if (tix == 0) { __builtin_amdgcn_fence(__ATOMIC_RELEASE, "agent"); asm volatile("s_waitcnt vmcnt(0)" ::: "memory"); (void)xb_add(sdone, 1u); }
                    }
                } else if (item < N_SA + N_PA) {
                    constexpr int KS = 224, VS = 160, KBUF = 64 * KS, VBUF = 64 * VS;
                    const h16* qb = WSP(h16, W_Q); const h16* kb = WSP(h16, W_K); const h16* vb = WSP(h16, W_V); h16* cat = WSP(h16, W_CAT);
                    const int it = item - N_SA, qblk = 7 - (it >> 7), bh = it & 127, b = bh >> 3, head = bh & 7;
                    const int r0 = qblk * 256 + 32 * wave, ntw = (r0 >> 6) + 1, ntb = 4 * (qblk + 1);
                    h8 qf[2][3];
#pragma unroll
                    for (int qs = 0; qs < 2; ++qs)
#pragma unroll
                        for (int ks = 0; ks < 3; ++ks) qf[qs][ks] = *(const h8*)(qb + (size_t)(b * SEQ + r0 + 16 * qs + fr) * QW + head * 96 + 32 * ks + 8 * g4);
                    f4 o[2][4]; float mrow[2] = {-1e30f, -1e30f}, lrow[2] = {0.f, 0.f};
#pragma unroll
                    for (int qs = 0; qs < 2; ++qs)
#pragma unroll
                        for (int ct = 0; ct < 4; ++ct) o[qs][ct] = (f4){0.f, 0.f, 0.f, 0.f};
                    const int k0key = tix / 12, k0part = tix % 12, k1key = (tix + 512) / 12, k1part = (tix + 512) % 12, vkey = tix >> 3, vpart = tix & 7;
                    const h16* kg0 = kb + (size_t)b * SEQ * KW + head * 96 + (size_t)k0key * KW + k0part * 8; const h16* kg1 = kb + (size_t)b * SEQ * KW + head * 96 + (size_t)k1key * KW + k1part * 8;
                    const h16* vg = vb + (size_t)b * SEQ * VW + head * 64 + (size_t)vkey * VW + vpart * 8;
                    const int lk0 = k0key * KS + k0part * 16, lk1 = k1key * KS + k1part * 16, lv = 2 * KBUF + vkey * VS + vpart * 16;
                    h8 pk0, pk1 = (h8){0, 0, 0, 0, 0, 0, 0, 0}, pv;
                    pk0 = *(const h8*)kg0; if (tix < 256) pk1 = *(const h8*)kg1; pv = *(const h8*)vg;
                    *(LAS h8*)(lds + lk0) = pk0; if (tix < 256) *(LAS h8*)(lds + lk1) = pk1; *(LAS h8*)(lds + lv) = pv;
                    __syncthreads();
                    for (int t = 0; t < ntb; ++t) {
                        const int co = (t & 1), no = ((t + 1) & 1);
                        if (t + 1 < ntb) { const size_t ro = (size_t)(t + 1) * 64;
                            pk0 = *(const h8*)(kg0 + ro * KW); if (tix < 256) pk1 = *(const h8*)(kg1 + ro * KW); pv = *(const h8*)(vg + ro * VW); }
                        if (t < ntw) attn_tile<3, 4, 2, KS, VS>(lds + co * KBUF, lds + 2 * KBUF + co * VBUF, qf, o, mrow, lrow, 4, ln);
                        if (t + 1 < ntb) { *(LAS h8*)(lds + no * KBUF + lk0) = pk0; if (tix < 256) *(LAS h8*)(lds + no * KBUF + lk1) = pk1; *(LAS h8*)(lds + no * VBUF + lv) = pv; }
                        __syncthreads();
                    }
#pragma unroll
                    for (int qs = 0; qs < 2; ++qs) { float lt = lrow[qs]; lt += shx(lt, 16, ln); lt += shx(lt, 32, ln); const float inv = 1.f / lt;
                        h16* dst = cat + (size_t)(b * SEQ + r0 + 16 * qs + fr) * 1024 + 256 + head * 64 + 4 * g4;
#pragma unroll
                        for (int ct = 0; ct < 4; ++ct) *(h4*)(dst + 16 * ct) = pack4(o[qs][ct] * inv); }
                } else if (item < N_SA + N_PA + N_PS) {
                    const float* abuf = WSP(float, W_A); const float* bbuf = WSP(float, W_B); const h16* z = WSP(h16, W_Z); h16* cat = WSP(h16, W_CAT);
                    const int it = item - N_SA - N_PA, b = it >> 3, ch = (it & 7) * 32 + (ln & 31), seg = wave * 2 + (ln >> 5), tl = seg * 32 + (ln & 31);
                    const size_t rbase = (size_t)b * SEQ + seg * 128;
                    float A = 1.f, B = 0.f;
#pragma unroll 16
                    for (int i = 0; i < 128; ++i) { const float a = abuf[(rbase + i) * 256 + ch], bb = bbuf[(rbase + i) * 256 + ch]; B = a * B + bb; A *= a; }
                    LAS float* sA = (LAS float*)lds; LAS float* sB = sA + 512;
                    sA[tl] = A; sB[tl] = B;
                    __syncthreads();
                    float h = 0.f;
                    for (int s2 = 0; s2 < seg; ++s2) h = sA[s2 * 32 + (ln & 31)] * h + sB[s2 * 32 + (ln & 31)];
                    for (int i0 = 0; i0 < 128; i0 += 16) { float av[16], bv[16], gv[16];
#pragma unroll
                        for (int k = 0; k < 16; ++k) { av[k] = abuf[(rbase + i0 + k) * 256 + ch]; bv[k] = bbuf[(rbase + i0 + k) * 256 + ch]; gv[k] = (float)z[(rbase + i0 + k) * ZW + 1440 + ch]; }
#pragma unroll
                        for (int k = 0; k < 16; ++k) { h = av[k] * h + bv[k]; cat[(rbase + i0 + k) * 1024 + 768 + ch] = (h16)(h * gv[k]); } }
                    if (seg == 15) out[O_PH + ((size_t)lq * NB + b) * 256 + ch] = h;
                } else {
                    const float* abuf = WSP(float, W_A); const float* bbuf = WSP(float, W_B); const h16* z = WSP(h16, W_Z); h16* cats = WSP(h16, W_CATS);
                    const int it = item - N_SA - N_PA - N_PS, idx = it * 512 + tix, b = idx >> 8, ch = idx & 255;
                    float h = kp->in[4][((size_t)lq * DBATCH + b) * 256 + ch];
                    for (int t0 = 0; t0 < DSEQ; t0 += 16) { float av[16], bv[16], gv[16];
#pragma unroll
                        for (int k = 0; k < 16; ++k) { const size_t r = (size_t)MP + b * 32 + t0 + k; av[k] = abuf[r * 256 + ch]; bv[k] = bbuf[r * 256 + ch]; gv[k] = (float)z[r * ZW + 1440 + ch]; }
#pragma unroll
                        for (int k = 0; k < 16; ++k) { h = av[k] * h + bv[k]; cats[(size_t)(b * 32 + t0 + k) * 1024 + 768 + ch] = (h16)(h * gv[k]); } }
                    out[O_SH + ((size_t)lq * DBATCH + b) * 256 + ch] = h;
                    asm volatile("s_waitcnt vmcnt(0)" ::: "memory"); __syncthreads();
                    if (tix == 0) { __builtin_amdgcn_fence(__ATOMIC_RELEASE, "agent"); asm volatile("s_waitcnt vmcnt(0)" ::: "memory"); (void)xb_add(sdone, 1u); }
                }
            }
        }
        GSYNC();

        for (int rep = 0; rep < NREP(9); ++rep) if (PHM & (1u << 9)) { PH_BEGIN
          conv_gate_items((unsigned)((MP / 4) * (DFF / 8)) + (unsigned)gtid, (unsigned)((MT / 4) * (DFF / 8)), (unsigned)NGT, 4, ConvP{WSP(h16, W_UP), WSP(h16, W_ACT), kp->in[28] + (size_t)lq * 3 * DFF2, kp->in[29] + (size_t)lq * DFF2, kp->in[6] + (size_t)lq * DBATCH * 2 * DFF2, WSP(float, W_STATS + (size_t)(lq * 2) * SZ_STATS), WSP(float, W_CD + lq * SZ_CD) + 2 * ZW, WSP(float, W_CD + lq * SZ_CD) + 2 * ZW + DFF2, out + O_PFC + (size_t)lq * NB * 2 * DFF2, (O_SFC + (size_t)lq * DBATCH * 2 * DFF2) - (O_PFC + (size_t)lq * NB * 2 * DFF2)});
          const int lp = lq > 0 ? lq - 1 : 0;
          Gemm g{WSP(h16, W_CAT), WSP(h16, W_WO + lq * SZ_WO), MP, 1024, 1024, 1024, 1024}; StaticOrder S; S.init(MP, 1024, G, bid);
          EpiRes E{WSP(h16, W_XH), WSP(float, W_STATS + (size_t)(lp * 2 + 1) * SZ_STATS), kp->in[9] + lp * DM, kp->in[10] + lp * DM, lq > 0, WSP(float, W_STATS + (size_t)(lq * 2) * SZ_STATS)}; gemm_phase(lds, g, S, E, tid); }
        GSYNC();

        for (int rep = 0; rep < NREP(12); ++rep) if (PHM & (1u << 12)) { PH_BEGIN
          Gemm g{WSP(h16, W_XH), WSP(h16, W_WUP + lq * SZ_WUP), MP, DFF2, 1024, 1024, 1024}; StaticOrder S; S.init(MP, DFF2, G, bid);
          EpiUp E{WSP(h16, W_UP), 0}; gemm_phase(lds, g, S, E, tid); }
        GSYNC();

        for (int rep = 0; rep < NREP(13); ++rep) if (PHM & (1u << 13)) { PH_BEGIN
            if (bid < 16) { const size_t ro = (size_t)(MP / BM + (bid >> 2)) * BM;
                Gemm g{WSP(h16, W_ACT) + ro * DFF, WSP(h16, W_WDN + lq * SZ_WDN), BM, 1024, DFF, DFF, DFF}; StaticOrder S; S.init(BM, 1024, 4, bid & 3);
                EpiRes E{WSP(h16, W_XH) + ro * DM, WSP(float, W_STATS + (size_t)(lq * 2) * SZ_STATS) + 2 * ro, kp->in[7] + lq * DM, kp->in[8] + lq * DM, true, WSP(float, W_STATS + (size_t)(lq * 2 + 1) * SZ_STATS) + 2 * ro}; gemm_phase(lds, g, S, E, tid); }
            else conv_gate_items((unsigned)(gtid - 16 * 512), (unsigned)((DFF / 8) * (MP / 32)), (unsigned)(NGT - 16 * 512), 32, ConvP{WSP(h16, W_UP), WSP(h16, W_ACT), kp->in[28] + (size_t)lq * 3 * DFF2, kp->in[29] + (size_t)lq * DFF2, kp->in[6] + (size_t)lq * DBATCH * 2 * DFF2, WSP(float, W_STATS + (size_t)(lq * 2) * SZ_STATS), WSP(float, W_CD + lq * SZ_CD) + 2 * ZW, WSP(float, W_CD + lq * SZ_CD) + 2 * ZW + DFF2, out + O_PFC + (size_t)lq * NB * 2 * DFF2, (O_SFC + (size_t)lq * DBATCH * 2 * DFF2) - (O_PFC + (size_t)lq * NB * 2 * DFF2)}); }
        GSYNC();

        for (int rep = 0; rep < NREP(14); ++rep) if (PHM & (1u << 14)) { PH_BEGIN
          Gemm g{WSP(h16, W_ACT), WSP(h16, W_WDN + lq * SZ_WDN), MP, 1024, DFF, DFF, DFF}; StaticOrder S; S.init(MP, 1024, G, bid); EpiRes E{WSP(h16, W_XH), WSP(float, W_STATS + (size_t)(lq * 2) * SZ_STATS), kp->in[7] + lq * DM, kp->in[8] + lq * DM, true, WSP(float, W_STATS + (size_t)(lq * 2 + 1) * SZ_STATS)}; gemm_phase(lds, g, S, E, tid); }
        GSYNC();

    }
    { const int l = DEPTH - 1; PH_BEGIN
        const float* gg = kp->in[9] + lq * DM; const float* bb = kp->in[10] + lq * DM; const h16* pre2 = WSP(h16, W_XH); const float* st = WSP(float, W_STATS + (size_t)(lq * 2 + 1) * SZ_STATS);
        for (size_t i0 = gtid; i0 < (size_t)MT * (DM / 4); i0 += 4 * NGT) { h4 xv[4]; float sm[4], sq[4];
#pragma unroll
            for (int u = 0; u < 4; ++u) { const size_t i = i0 + u * NGT; if (i < (size_t)MT * (DM / 4)) { const int row = (int)(i >> 8), c = (int)(i & 255) * 4; xv[u] = *(const h4*)(pre2 + (size_t)row * DM + c); sm[u] = st[2 * row]; sq[u] = st[2 * row + 1]; } }
#pragma unroll
            for (int u = 0; u < 4; ++u) { const size_t i = i0 + u * NGT; if (i < (size_t)MT * (DM / 4)) { const int row = (int)(i >> 8), c = (int)(i & 255) * 4;
                const float mean = sm[u] * (1.f / DM), rstd = rsqrtf(sq[u] * (1.f / DM) - mean * mean + 1e-5f);
                __builtin_nontemporal_store(((f4){(float)xv[u][0], (float)xv[u][1], (float)xv[u][2], (float)xv[u][3]} - mean) * rstd * *(const f4*)(gg + c) + *(const f4*)(bb + c), (f4*)(out + O_Y + (size_t)row * DM + c)); } } }
    }
}

extern "C" void kernel_launch(void* const* d_in, const int* in_sizes, int n_in, void* d_out, int out_size, void* d_ws, size_t ws_size, hipStream_t stream) {
    constexpr size_t kDynLds = STAGE_BYTES;
    static int grid_blocks = 0;
    if (!grid_blocks) {
        if (n_in != 31 || (size_t)out_size != O_END || ws_size < W_END) { fprintf(stderr, "kernel_launch: unexpected shapes n_in %d out %d ws %zu (need %zu)\n", n_in, out_size, ws_size, (size_t)W_END); grid_blocks = -1; return; }
        int dev = 0, cus = 0, per_cu = 0;
        hipGetDevice(&dev);
        hipDeviceGetAttribute(&cus, hipDeviceAttributeMultiprocessorCount, dev);
        hipFuncSetAttribute((const void*)trunk_fwd, hipFuncAttributeMaxDynamicSharedMemorySize, (int)kDynLds);
        hipOccupancyMaxActiveBlocksPerMultiprocessor(&per_cu, (const void*)trunk_fwd, 512, kDynLds);
        if (per_cu < 1) per_cu = 1;
        grid_blocks = cus * per_cu;
        if (grid_blocks > 256) grid_blocks = 256;
        if (grid_blocks < 32) { fprintf(stderr, "kernel_launch: grid %d too small\n", grid_blocks); grid_blocks = -1; return; }
    }
    if (grid_blocks < 0) return;
    hipMemsetAsync((char*)d_ws + W_CTR, 0, W_ZERO_END, stream);
    Params p{};
    for (int i = 0; i < 31; ++i) p.in[i] = (const float*)d_in[i];
    p.out = (float*)d_out; p.ws = (unsigned char*)d_ws;
    void* args[] = {&p};
    hipError_t e = hipLaunchCooperativeKernel((const void*)trunk_fwd, dim3(grid_blocks), dim3(512), args, kDynLds, stream);
    if (e != hipSuccess) fprintf(stderr, "cooperative launch failed: %s (grid %d)\n", hipGetErrorString(e), grid_blocks);
}
```
